# Optimizing an MI355X kernel written in HIP

```python
import math
import jax, jax.numpy as jnp
from jax import lax
import numpy as np


D_MODEL = 1024
BATCH = 8
SEQ = 2048
DEPTH = 4

MEM_LEN = 256
N_EVEN = (DEPTH + 1) // 2
N_ODD = DEPTH // 2
EPS = 1e-6
NEG = -1e30
Q_BLOCK = 128

HY_WIDTH = D_MODEL // 2
HY_ORDER = 2
HY_EMB = 33
HY_BANDS = (HY_EMB - 1) // 2
HY_FILT_HIDDEN = 64
HY_CONV = 3
HY_DECAY_TARGET = 1e-2
HY_FAST_PCT = 0.3
HY_SLOW_PCT = 1.5
HY_FILT_STD = 0.02
DIFF_WIDTH = D_MODEL // 2
DIFF_HEADS = 4
DIFF_HEAD_DIM = DIFF_WIDTH // DIFF_HEADS // 2
E_IN = 3 * HY_WIDTH + 3 * DIFF_WIDTH
E_MIX = HY_WIDTH + DIFF_WIDTH

WIN = 128
GQA_HEADS = 16
GQA_KV = 4
GQA_HD = 64
GQA_GROUP = GQA_HEADS // GQA_KV
O_Q = GQA_HEADS * GQA_HD
O_KV = GQA_KV * GQA_HD
O_IN = O_Q + 2 * O_KV

X_HEADS = 4
X_HD = 128
X_W = X_HEADS * X_HD

N_GROUPS = 4
EXP_PER_GROUP = 8
N_EXPERTS = N_GROUPS * EXP_PER_GROUP
TOP_K = 2
EXP_HIDDEN = 512
MOE_BLOCK = 128

kernel_name = 'hybrid_hyena_diffattn_swa_hmoe_encoder'

F32 = jnp.float32


def rmsnorm(x, g):
    x32 = x.astype(F32)
    y = x32 * lax.rsqrt(jnp.mean(x32 * x32, axis=-1, keepdims=True) + EPS)
    return (y * g.astype(F32)).astype(x.dtype)


def alibi_slopes(n):
    return 2.0 ** (-8.0 * jnp.arange(1, n + 1, dtype=F32) / n)


def short_conv3(u, w, b):
    up = jnp.pad(u, ((0, 0), (1, 1), (0, 0)))
    return up[:, :-2] * w[0] + up[:, 1:-1] * w[1] + up[:, 2:] * w[2] + b


def hyena_filters(L, w1, b1, w2, b2, w3, freq):
    pos = jnp.arange(L, dtype=F32)
    t = jnp.linspace(0.0, 1.0, L, dtype=F32)[:, None]
    bands = jnp.linspace(1e-4, HY_BANDS - 1, HY_BANDS, dtype=F32)[None]
    ang = bands * (2.0 * math.pi * pos[:, None] / L)
    z = jnp.concatenate([t, jnp.cos(ang), -jnp.sin(ang)], axis=-1)
    f = freq.astype(F32)
    a = jnp.sin(f * (z @ w1.astype(F32) + b1.astype(F32)))
    a = jnp.sin(f * (a @ w2.astype(F32) + b2.astype(F32)))
    h = (a @ w3.astype(F32)).reshape(L, HY_ORDER, 2, HY_WIDTH)
    max_decay = math.log(HY_DECAY_TARGET) / HY_FAST_PCT
    min_decay = math.log(HY_DECAY_TARGET) / HY_SLOW_PCT
    deltas = jnp.linspace(min_decay, max_decay, HY_WIDTH, dtype=F32)
    decay = jnp.exp(-t * jnp.abs(deltas))
    h = h * decay[:, None, None, :]
    k = jnp.concatenate([h[:, :, 0], jnp.zeros((1, HY_ORDER, HY_WIDTH), F32), h[:0:-1, :, 1]], axis=0)
    return jnp.fft.rfft(k, n=2 * L, axis=0)


def fft_conv(z, kf, bias):
    L = z.shape[1]
    z32 = z.astype(F32)
    zf = jnp.fft.rfft(z32, n=2 * L, axis=1)
    y = jnp.fft.irfft(zf * kf[None], n=2 * L, axis=1)[:, :L]
    return (y + z32 * bias.astype(F32)).astype(z.dtype)


def hyena_mixer(u, conv_w, conv_b, w1, b1, w2, b2, w3, freq, hy_bias):
    L = u.shape[1]
    u = short_conv3(u, conv_w, conv_b)
    v, g1, g2 = jnp.split(u, 3, axis=-1)
    kf = hyena_filters(L, w1, b1, w2, b2, w3, freq)
    z = g1 * fft_conv(v, kf[:, 0], hy_bias[0])
    z = g2 * fft_conv(z, kf[:, 1], hy_bias[1])
    return z


def diff_attention(q, k, v, lam, subln, layer_idx):
    B, S, _ = q.shape
    H, d = DIFF_HEADS, DIFF_HEAD_DIM
    nb = S // Q_BLOCK
    lam_init = 0.8 - 0.6 * math.exp(-0.3 * layer_idx)
    l32 = lam.astype(F32)
    lam_full = jnp.exp(jnp.sum(l32[0] * l32[1])) - jnp.exp(jnp.sum(l32[2] * l32[3])) + lam_init
    qb_all = q.reshape(B, nb, Q_BLOCK, 2 * H, d).transpose(1, 0, 2, 3, 4)
    k = k.reshape(B, S, 2 * H, d)
    v = v.reshape(B, S, H, 2 * d)
    slopes = jnp.repeat(alibi_slopes(H), 2)
    kpos = jnp.arange(S)
    scale = d ** -0.5

    def block(args):
        qb, j = args
        qpos = j * Q_BLOCK + jnp.arange(Q_BLOCK)
        dist = jnp.abs(qpos[:, None] - kpos[None]).astype(F32)
        s = jnp.einsum('bqhd,bkhd->bhqk', qb, k).astype(F32) * scale - slopes[:, None, None] * dist
        p = jax.nn.softmax(s, axis=-1).reshape(B, H, 2, Q_BLOCK, S)
        a = p[:, :, 0] - lam_full * p[:, :, 1]
        return jnp.einsum('bhqk,bkhe->bqhe', a.astype(v.dtype), v)

    o = lax.map(block, (qb_all, jnp.arange(nb)))
    o = o.transpose(1, 0, 2, 3, 4).reshape(B, S, H, 2 * d)
    o = rmsnorm(o, subln) * (1.0 - lam_init)
    return o.reshape(B, S, H * 2 * d)


def window_gqa(q, k, v, sink):
    B, S, _ = q.shape
    nb = S // Q_BLOCK
    span = Q_BLOCK + 2 * WIN
    qb_all = q.reshape(B, nb, Q_BLOCK, GQA_KV, GQA_GROUP, GQA_HD).transpose(1, 0, 2, 3, 4, 5)
    pad = ((0, 0), (WIN, WIN), (0, 0), (0, 0))
    kp = jnp.pad(k.reshape(B, S, GQA_KV, GQA_HD), pad)
    vp = jnp.pad(v.reshape(B, S, GQA_KV, GQA_HD), pad)
    slopes = alibi_slopes(GQA_HEADS).reshape(GQA_KV, GQA_GROUP)
    sink32 = sink.astype(F32).reshape(GQA_KV, GQA_GROUP)
    scale = GQA_HD ** -0.5

    def block(args):
        qb, j = args
        start = j * Q_BLOCK
        kb = lax.dynamic_slice_in_dim(kp, start, span, axis=1)
        vb = lax.dynamic_slice_in_dim(vp, start, span, axis=1)
        qpos = start + jnp.arange(Q_BLOCK)
        kpos = start - WIN + jnp.arange(span)
        rel = jnp.abs(qpos[:, None] - kpos[None])
        valid = (rel <= WIN) & (kpos >= 0)[None] & (kpos < S)[None]
        s = jnp.einsum('bqkgd,bckd->bkgqc', qb, kb).astype(F32) * scale - slopes[..., None, None] * rel.astype(F32)
        s = jnp.where(valid, s, NEG)
        sk = jnp.broadcast_to(sink32[None, :, :, None, None], s.shape[:-1] + (1,))
        p = jax.nn.softmax(jnp.concatenate([s, sk], axis=-1), axis=-1)[..., :-1]
        return jnp.einsum('bkgqc,bckd->bqkgd', p.astype(vb.dtype), vb)

    o = lax.map(block, (qb_all, jnp.arange(nb)))
    return o.transpose(1, 0, 2, 3, 4, 5).reshape(B, S, O_Q)


def cross_attention(h, memn, wq, wkv, wo):
    B, S, _ = h.shape
    M = memn.shape[1]
    q = (h @ wq).reshape(B, S, X_HEADS, X_HD)
    kv = (memn @ wkv).reshape(B, M, 2, X_HEADS, X_HD)
    s = jnp.einsum('bqhd,bkhd->bhqk', q, kv[:, :, 0]).astype(F32) * (X_HD ** -0.5)
    p = jax.nn.softmax(s, axis=-1)
    o = jnp.einsum('bhqk,bkhd->bqhd', p.astype(kv.dtype), kv[:, :, 1]).reshape(B, S, X_W)
    return o @ wo


def hier_moe(h, w_grp, b_grp, w_exp, b_exp, w_gate, w_up, w_down):
    B, S, D = h.shape
    N = B * S
    xf = h.reshape(N, D)
    g_logits = (xf @ w_grp + b_grp).astype(F32)
    g_prob = jax.nn.softmax(g_logits, axis=-1)
    g_sel = jnp.argmax(g_logits, axis=-1).astype(jnp.int32)
    g_gate = jnp.take_along_axis(g_prob, g_sel[:, None], axis=-1)
    e_logits = (xf @ w_exp + b_exp).astype(F32).reshape(N, N_GROUPS, EXP_PER_GROUP)
    e_logits = jnp.take_along_axis(e_logits, g_sel[:, None, None], axis=1)[:, 0]
    top_v, top_i = lax.top_k(e_logits, TOP_K)
    weights = g_gate * jax.nn.softmax(top_v, axis=-1)
    eid = (g_sel[:, None] * EXP_PER_GROUP + top_i).reshape(-1)
    tok = jnp.repeat(jnp.arange(N, dtype=jnp.int32), TOP_K)
    wt = weights.reshape(-1)
    P = N * TOP_K
    order = jnp.argsort(eid)
    s_eid, s_tok, s_wt = eid[order], tok[order], wt[order]
    counts = jnp.bincount(eid, length=N_EXPERTS)
    starts = jnp.cumsum(counts) - counts
    padded = (counts + MOE_BLOCK - 1) // MOE_BLOCK * MOE_BLOCK
    p_ends = jnp.cumsum(padded)
    p_starts = p_ends - padded
    dest = p_starts[s_eid] + (jnp.arange(P) - starts[s_eid])
    cap = P + N_EXPERTS * MOE_BLOCK
    nblk = cap // MOE_BLOCK
    buf_tok = jnp.full((cap,), N, jnp.int32).at[dest].set(s_tok)
    buf_wt = jnp.zeros((cap,), F32).at[dest].set(s_wt)
    blk_e = jnp.minimum(jnp.searchsorted(p_ends, jnp.arange(nblk) * MOE_BLOCK, side='right'), N_EXPERTS - 1)
    xpad = jnp.concatenate([xf, jnp.zeros((1, D), xf.dtype)], axis=0)
    xb = xpad[buf_tok].reshape(nblk, MOE_BLOCK, D)

    def expert_block(args):
        xblk, e = args
        a = xblk @ w_gate[e]
        b = xblk @ w_up[e]
        return (jax.nn.silu(a) * b) @ w_down[e]

    yb = lax.map(expert_block, (xb, blk_e)).reshape(cap, D)
    y = jnp.zeros((N + 1, D), F32).at[buf_tok].add(yb.astype(F32) * buf_wt[:, None])[:N]
    return y.astype(h.dtype).reshape(B, S, D)


def setup_inputs(seed: int = 0) -> dict:
    key = jax.random.key(seed)
    ks = iter(jax.random.split(key, 48))

    def nrm(shape, scale):
        return jax.random.normal(next(ks), shape, F32) * scale

    def gain(shape):
        return 1.0 + nrm(shape, 0.02)

    D = D_MODEL
    return {
        'x': nrm((BATCH, SEQ, D), 1.0),
        'mem': nrm((BATCH, MEM_LEN, D), 1.0),
        'e_norm': gain((N_EVEN, D)),
        'e_w_in': nrm((N_EVEN, D, E_IN), D ** -0.5),
        'e_conv_w': nrm((N_EVEN, HY_CONV, 3 * HY_WIDTH), HY_CONV ** -0.5),
        'e_conv_b': nrm((N_EVEN, 3 * HY_WIDTH), 0.02),
        'e_filt_w1': nrm((N_EVEN, HY_EMB, HY_FILT_HIDDEN), HY_EMB ** -0.5),
        'e_filt_b1': nrm((N_EVEN, HY_FILT_HIDDEN), 0.02),
        'e_filt_w2': nrm((N_EVEN, HY_FILT_HIDDEN, HY_FILT_HIDDEN), HY_FILT_HIDDEN ** -0.5),
        'e_filt_b2': nrm((N_EVEN, HY_FILT_HIDDEN), 0.02),
        'e_filt_w3': nrm((N_EVEN, HY_FILT_HIDDEN, HY_ORDER * 2 * HY_WIDTH), HY_FILT_STD),
        'e_filt_freq': gain((N_EVEN, HY_FILT_HIDDEN)),
        'e_hy_bias': nrm((N_EVEN, HY_ORDER, HY_WIDTH), 1.0),
        'e_lam': nrm((N_EVEN, 4, DIFF_HEAD_DIM), 0.1),
        'e_subln': gain((N_EVEN, 2 * DIFF_HEAD_DIM)),
        'e_w_out': nrm((N_EVEN, E_MIX, D), E_MIX ** -0.5),
        'o_norm': gain((N_ODD, D)),
        'o_w_in': nrm((N_ODD, D, O_IN), D ** -0.5),
        'o_sink': nrm((N_ODD, GQA_HEADS), 0.5),
        'o_w_out': nrm((N_ODD, O_Q, D), O_Q ** -0.5),
        'c_norm': gain((DEPTH, D)),
        'c_wq': nrm((DEPTH, D, X_W), D ** -0.5),
        'c_wkv': nrm((DEPTH, D, 2 * X_W), D ** -0.5),
        'c_wo': nrm((DEPTH, X_W, D), X_W ** -0.5),
        'f_norm': gain((DEPTH, D)),
        'f_w_grp': nrm((DEPTH, D, N_GROUPS), D ** -0.5),
        'f_b_grp': nrm((DEPTH, N_GROUPS), 0.01),
        'f_w_exp': nrm((DEPTH, D, N_EXPERTS), D ** -0.5),
        'f_b_exp': nrm((DEPTH, N_EXPERTS), 0.01),
        'f_w_gate': nrm((DEPTH, N_EXPERTS, D, EXP_HIDDEN), D ** -0.5),
        'f_w_up': nrm((DEPTH, N_EXPERTS, D, EXP_HIDDEN), D ** -0.5),
        'f_w_down': nrm((DEPTH, N_EXPERTS, EXP_HIDDEN, D), EXP_HIDDEN ** -0.5),
        'g_mem': gain((D,)),
        'g_final': gain((D,)),
    }


def reference(x, mem, e_norm, e_w_in, e_conv_w, e_conv_b, e_filt_w1, e_filt_b1, e_filt_w2, e_filt_b2,
              e_filt_w3, e_filt_freq, e_hy_bias, e_lam, e_subln, e_w_out, o_norm, o_w_in, o_sink, o_w_out,
              c_norm, c_wq, c_wkv, c_wo, f_norm, f_w_grp, f_b_grp, f_w_exp, f_b_exp, f_w_gate, f_w_up,
              f_w_down, g_mem, g_final):
    memn = rmsnorm(mem, g_mem)
    for i in range(DEPTH):
        j = i // 2
        if i % 2 == 0:
            h = rmsnorm(x, e_norm[j])
            proj = h @ e_w_in[j]
            hy_u, q, k, v = jnp.split(proj, [3 * HY_WIDTH, 3 * HY_WIDTH + DIFF_WIDTH,
                                             3 * HY_WIDTH + 2 * DIFF_WIDTH], axis=-1)
            y_hy = hyena_mixer(hy_u, e_conv_w[j], e_conv_b[j], e_filt_w1[j], e_filt_b1[j], e_filt_w2[j],
                               e_filt_b2[j], e_filt_w3[j], e_filt_freq[j], e_hy_bias[j])
            y_df = diff_attention(q, k, v, e_lam[j], e_subln[j], i)
            x = x + jnp.concatenate([y_hy, y_df], axis=-1) @ e_w_out[j]
        else:
            h = rmsnorm(x, o_norm[j])
            proj = h @ o_w_in[j]
            q, k, v = jnp.split(proj, [O_Q, O_Q + O_KV], axis=-1)
            x = x + window_gqa(q, k, v, o_sink[j]) @ o_w_out[j]
        h = rmsnorm(x, c_norm[i])
        x = x + cross_attention(h, memn, c_wq[i], c_wkv[i], c_wo[i])
        h = rmsnorm(x, f_norm[i])
        x = x + hier_moe(h, f_w_grp[i], f_b_grp[i], f_w_exp[i], f_b_exp[i], f_w_gate[i], f_w_up[i], f_w_down[i])
    return rmsnorm(x, g_final)
```

```cpp
#include <hip/hip_runtime.h>
#include <stdint.h>
#include <stdio.h>

#ifndef ONE_LAUNCH
#define ONE_LAUNCH 1
#endif

typedef unsigned short bf16_t;
typedef short bf16x8 __attribute__((ext_vector_type(8)));
typedef float f32x4 __attribute__((ext_vector_type(4)));
typedef unsigned u32x4 __attribute__((ext_vector_type(4)));
typedef unsigned u32x2 __attribute__((ext_vector_type(2)));

constexpr int Bb = 8, S = 2048, D = 1024, NTOK = Bb * S, DEPTH = 4, MEM = 256;
constexpr int NEXP = 32, EH = 512;
constexpr int NT = 512;
constexpr float EPS = 1e-6f;

constexpr size_t al256(size_t x) { return (x + 255) & ~(size_t)255; }
constexpr size_t WS_BAR   = 0;
constexpr size_t WS_CNT   = 16384;
constexpr size_t WS_ZERO_BYTES = 16384 + 4096;
constexpr size_t WS_MISC  = WS_ZERO_BYTES;
constexpr size_t WS_W_EIN = 32768;
constexpr size_t WS_W_EOUT = WS_W_EIN + (size_t)2 * 3072 * 1024 * 2;
constexpr size_t WS_W_OIN = WS_W_EOUT + (size_t)2 * 1024 * 1024 * 2;
constexpr size_t WS_W_OOUT = WS_W_OIN + (size_t)2 * 1536 * 1024 * 2;
constexpr size_t WS_W_CQ  = WS_W_OOUT + (size_t)2 * 1024 * 1024 * 2;
constexpr size_t WS_W_CKV = WS_W_CQ + (size_t)4 * 512 * 1024 * 2;
constexpr size_t WS_W_CO  = WS_W_CKV + (size_t)4 * 1024 * 1024 * 2;
constexpr size_t WS_W_GU  = WS_W_CO + (size_t)4 * 1024 * 512 * 2;
constexpr size_t WS_W_DN  = WS_W_GU + (size_t)4 * 32 * 1024 * 1024 * 2;
constexpr size_t WS_MEMN  = WS_W_DN + (size_t)4 * 32 * 1024 * 512 * 2;
constexpr size_t WS_XK    = WS_MEMN + (size_t)2048 * 1024 * 2;
constexpr size_t WS_XVT   = WS_XK + (size_t)4 * 2048 * 512 * 2;
constexpr size_t WS_A2    = WS_XVT + (size_t)4 * 2048 * 512 * 2;
constexpr size_t WS_FILT  = WS_A2 + (size_t)2 * 2048 * 64 * 4;
constexpr size_t WS_X     = WS_FILT + (size_t)2 * 2 * 512 * 4096 * 2;
constexpr size_t WS_H     = WS_X + (size_t)NTOK * D * 4;
constexpr size_t WS_PROJ  = WS_H + al256((size_t)(NTOK + 1) * D * 2);
constexpr size_t WS_YMIX  = WS_PROJ + (size_t)NTOK * 3072 * 2;
constexpr size_t WS_QX    = WS_YMIX + (size_t)NTOK * D * 2;
constexpr size_t WS_OX    = WS_QX + (size_t)NTOK * 512 * 2;
constexpr size_t WS_ACT   = WS_OX + (size_t)NTOK * 512 * 2;
constexpr size_t WS_Y     = WS_ACT + al256((size_t)(2 * NTOK + 1) * EH * 2);
constexpr size_t WS_LIST  = WS_Y + (size_t)2 * NTOK * D * 2;
constexpr size_t WS_WT    = WS_LIST + (size_t)NEXP * NTOK * 4;
constexpr size_t WS_END   = WS_WT + (size_t)2 * NTOK * 4;
constexpr size_t PR_HYT   = 0;
constexpr size_t PR_QK    = (size_t)1536 * NTOK * 2;
constexpr size_t PR_VT    = PR_QK + (size_t)NTOK * 1024 * 2;
constexpr size_t PR_OVT   = (size_t)NTOK * 1280 * 2;

constexpr int LDS_XB = 147456;
constexpr int LDS_BYTES = LDS_XB + 64;

struct Params {
    const float* in[34];
    float* out;
    unsigned char* ws;
};

extern __shared__ __attribute__((aligned(16))) bf16_t shm[];

__device__ __forceinline__ unsigned cvt_pk_bf16(float lo, float hi) { unsigned r; asm("v_cvt_pk_bf16_f32 %0, %1, %2" : "=v"(r) : "v"(lo), "v"(hi)); return r; }
__device__ __forceinline__ float bf2f(unsigned short b) { return __uint_as_float((unsigned)b << 16); }
__device__ __forceinline__ float bflo(unsigned w) { return __uint_as_float(w << 16); }
__device__ __forceinline__ float bfhi(unsigned w) { return __uint_as_float(w & 0xffff0000u); }
__device__ __forceinline__ float shx(float v, int m, int lane) { return __int_as_float(__builtin_amdgcn_ds_bpermute((lane ^ m) << 2, __float_as_int(v))); }
__device__ __forceinline__ float shl(float v, int src) { return __int_as_float(__builtin_amdgcn_ds_bpermute(src << 2, __float_as_int(v))); }
__device__ __forceinline__ float wave_sum(float v, int lane) {
    v += shx(v, 1, lane); v += shx(v, 2, lane); v += shx(v, 4, lane); v += shx(v, 8, lane); v += shx(v, 16, lane); v += shx(v, 32, lane); return v;
}

__device__ __forceinline__ int hidden_tid(int wv) { int l; asm volatile("v_mbcnt_lo_u32_b32 %0, -1, 0\n\tv_mbcnt_hi_u32_b32 %0, -1, %0" : "=&v"(l)); return (wv << 6) | l; }

#define XB_TMO      128
#define XB_XCNT(j)  (256  + 64 * (j))
#define XB_XSUB(j)  (1280 + 64 * (j))
#define XB_XGEN(j)  (2304 + 64 * (j))
#define XB_TOP      3328
#define XB_TOPGEN   3392
#define XCD_BAR_WORDS 3456
#define XB_SPIN_CAP (1u << 22)
#define LAS __attribute__((address_space(3)))

__device__ __forceinline__ unsigned xb_ld(unsigned* p)              { return __hip_atomic_load(p, __ATOMIC_RELAXED, __HIP_MEMORY_SCOPE_AGENT); }
__device__ __forceinline__ unsigned xb_add(unsigned* p, unsigned v) { return __hip_atomic_fetch_add(p, v, __ATOMIC_RELAXED, __HIP_MEMORY_SCOPE_AGENT); }
__device__ __forceinline__ unsigned xb_xcc_id() { return (unsigned)__builtin_amdgcn_s_getreg((3 << 11) | 20) & 0xFu; }
#define XB_SPIN(cond, bar) do { unsigned _sp = 0; while (cond) { __builtin_amdgcn_s_sleep(1); \
    if ((++_sp & 255u) == 0u) { if (xb_ld(&(bar)[XB_TMO])) break; if (_sp > XB_SPIN_CAP) { atomicAdd(&(bar)[XB_TMO], 1u); break; } } } } while (0)

struct XcdBarrier { unsigned* bar; unsigned x; volatile LAS unsigned* st; };

__device__ __forceinline__ XcdBarrier xcd_barrier_post(unsigned* bar, volatile LAS unsigned* st) {
    XcdBarrier b; b.bar = bar; b.x = xb_xcc_id(); b.st = st;
    if (threadIdx.x == 0) (void)xb_add(&bar[XB_XCNT(b.x)], 1u);
    return b;
}
__device__ __forceinline__ void xcd_barrier_complete(unsigned* bar, unsigned x, unsigned& nloc, unsigned& nx) {
    const unsigned G = gridDim.x * gridDim.y * gridDim.z;
    unsigned sum, cnt, mine, sp = 0u;
    for (;;) {
        sum = 0u; cnt = 0u; mine = 0u;
#pragma unroll
        for (unsigned j = 0; j < 16; ++j) { const unsigned c = xb_ld(&bar[XB_XCNT(j)]); sum += c; cnt += (c > 0u) ? 1u : 0u; mine = (j == x) ? c : mine; }
        if (sum == G) break;
        __builtin_amdgcn_s_sleep(1);
        if ((++sp & 255u) == 0u) { if (xb_ld(&bar[XB_TMO])) break; if (sp > XB_SPIN_CAP) { atomicAdd(&bar[XB_TMO], 1u); break; } }
    }
    nloc = mine > 0u ? mine : 1u; nx = cnt > 0u ? cnt : 1u;
}
__device__ __forceinline__ void xcd_barrier(const XcdBarrier& b) {
    asm volatile("s_waitcnt vmcnt(0)" ::: "memory");
    __syncthreads();
    if (threadIdx.x == 0) {
        unsigned* bar = b.bar; unsigned bx = b.x;
        asm volatile("" : "+s"(bar), "+s"(bx));
        __builtin_amdgcn_s_waitcnt(0);
        unsigned nloc = b.st[0], nx = b.st[1];
        if (nloc == 0u) { xcd_barrier_complete(bar, bx, nloc, nx); b.st[0] = nloc; b.st[1] = nx; }
        const unsigned old = xb_add(&bar[XB_XSUB(bx)], 1u);
        const unsigned gen = old / nloc;
        if (old + 1u == (gen + 1u) * nloc) {
            __builtin_amdgcn_fence(__ATOMIC_RELEASE, "agent");
            asm volatile("s_waitcnt vmcnt(0)" ::: "memory");
            const unsigned og = xb_add(&bar[XB_TOP], 1u);
            const unsigned tg = og / nx;
            if (og + 1u == (tg + 1u) * nx) xb_add(&bar[XB_TOPGEN], 1u);
            else XB_SPIN(xb_ld(&bar[XB_TOPGEN]) == tg, bar);
            __builtin_amdgcn_fence(__ATOMIC_ACQUIRE, "agent");
            xb_add(&bar[XB_XGEN(bx)], 1u);
            asm volatile("s_waitcnt vmcnt(0)" ::: "memory");
        } else {
            XB_SPIN(xb_ld(&bar[XB_XGEN(bx)]) == gen, bar);
            __builtin_amdgcn_fence(__ATOMIC_ACQUIRE, "agent");
            asm volatile("s_waitcnt vmcnt(0)" ::: "memory");
        }
    }
    __syncthreads();
}

constexpr int HT = 128 * 64;
__device__ __forceinline__ int lds_byte(int r, int c) {
    int st = (r >> 4) * 2 + (c >> 5), rr = r & 15, cc = c & 31, ob = rr * 64 + cc * 2;
    return st * 1024 + (ob ^ (((ob >> 9) & 1) << 5));
}
__device__ __forceinline__ void stage_rc(int b, int& R, int& C) {
    int st = b / 1024, sb = b % 1024, swz = sb ^ (((sb >> 9) & 1) << 5);
    R = (st >> 1) * 16 + swz / 64; C = (st & 1) * 32 + (swz % 64) / 2;
}
#define SA(b, h) (shm + ((b) * 2 + (h)) * HT)
#define SB(b, h) (shm + (4 + (b) * 2 + (h)) * HT)
#define G_STAGE_A(P_, h, kt) do { _Pragma("unroll") for (int _i = 0; _i < 2; ++_i) \
    __builtin_amdgcn_global_load_lds((const unsigned*)((const char*)A + (size_t)((kt) * 128 + (RowSrc::DENSE ? (h) * 256 * K : 0)) + aoff[RowSrc::DENSE ? 0 : (h)][_i]), (unsigned*)((char*)(P_) + tid * 16 + _i * 8192), 16, 0, 0); } while (0)
#define G_STAGE_B(P_, h, kt) do { _Pragma("unroll") for (int _i = 0; _i < 2; ++_i) \
    __builtin_amdgcn_global_load_lds((const unsigned*)((const char*)Bt + (size_t)((kt) * 128 + (h) * 256 * K) + boff[_i]), (unsigned*)((char*)(P_) + tid * 16 + _i * 8192), 16, 0, 0); } while (0)
#define G_LDA(dst, b, h) _Pragma("unroll") for (int m = 0; m < 4; ++m) _Pragma("unroll") for (int k = 0; k < 2; ++k) \
    dst[m][k] = *reinterpret_cast<const bf16x8*>((char*)SA(b, h) + lds_byte(wr * 64 + m * 16 + fr, k * 32 + fq * 8))
#define G_LDB(dst, b, h) _Pragma("unroll") for (int n = 0; n < 2; ++n) _Pragma("unroll") for (int k = 0; k < 2; ++k) \
    dst[n][k] = *reinterpret_cast<const bf16x8*>((char*)SB(b, h) + lds_byte(wc * 32 + n * 16 + fr, k * 32 + fq * 8))
#define G_MMA(ai, bj, At_, Bt_) do { __builtin_amdgcn_s_setprio(1); \
    _Pragma("unroll") for (int m = 0; m < 4; ++m) _Pragma("unroll") for (int n = 0; n < 2; ++n) _Pragma("unroll") for (int k = 0; k < 2; ++k) \
      acc[ai][bj][m][n] = __builtin_amdgcn_mfma_f32_16x16x32_bf16(Bt_[n][k], At_[m][k], acc[ai][bj][m][n], 0, 0, 0); \
    __builtin_amdgcn_s_setprio(0); } while (0)
#define WAIT_V(n) asm volatile("s_waitcnt vmcnt(" #n ")" ::: "memory")
#define WAIT_L(n) asm volatile("s_waitcnt lgkmcnt(" #n ")" ::: "memory")
#define BAR __builtin_amdgcn_s_barrier()
#define SCHED __builtin_amdgcn_sched_barrier(0)

typedef f32x4 AccT[2][2][4][2];

template <class RowSrc, class Epi>
__device__ __forceinline__ void gemm_tile(const bf16_t* __restrict__ A, const bf16_t* __restrict__ Bt, const int K,
                                          const int bcol, const RowSrc& rs, const Epi& epi, const int wv) {
    const int tid = hidden_tid(wv);
    int wid = tid >> 6, lane = tid & 63, wr = wid >> 2, wc = wid & 3, fr = lane & 15, fq = lane >> 4;
    unsigned aoff[2][2], boff[2];
#pragma unroll
    for (int i = 0; i < 2; ++i) {
        int R, C; stage_rc(tid * 16 + i * 8192, R, C);
        boff[i] = (unsigned)(((bcol + R) * K + C) * 2);
        if (RowSrc::DENSE) { aoff[0][i] = (unsigned)((R * K + C) * 2); aoff[1][i] = 0u; }
        else {
#pragma unroll
            for (int h = 0; h < 2; ++h) aoff[h][i] = (unsigned)((rs(h * 128 + R) * K + C) * 2);
        }
    }
    WAIT_V(0);
    AccT acc = {};
    bf16x8 At[4][2], B0[2][2], B1[2][2];
    const int nt = K / 64;
    G_STAGE_B(SB(0, 0), 0, 0); G_STAGE_A(SA(0, 0), 0, 0);
    G_STAGE_B(SB(0, 1), 1, 0); G_STAGE_A(SA(0, 1), 1, 0);
    if (wr == 1) BAR;
    WAIT_V(4); BAR;
    G_STAGE_B(SB(1, 0), 0, 1); G_STAGE_A(SA(1, 0), 0, 1); G_STAGE_B(SB(1, 1), 1, 1);
    WAIT_V(6); BAR;
    for (int t = 0; t < nt - 2; t += 2) {
        G_LDB(B0, 0, 0); SCHED; G_LDA(At, 0, 0); G_STAGE_A(SA(1, 1), 1, t + 1);
        WAIT_L(8); BAR; WAIT_L(0); G_MMA(0, 0, At, B0); BAR; SCHED;
        G_LDB(B1, 0, 1); G_STAGE_B(SB(0, 0), 0, t + 2);
        BAR; WAIT_L(0); G_MMA(0, 1, At, B1); BAR;
        G_LDA(At, 0, 1); G_STAGE_A(SA(0, 0), 0, t + 2);
        BAR; WAIT_L(0); G_MMA(1, 0, At, B0); BAR; SCHED;
        G_STAGE_B(SB(0, 1), 1, t + 2);
        WAIT_V(6); BAR; G_MMA(1, 1, At, B1); BAR;
        G_LDB(B0, 1, 0); SCHED; G_LDA(At, 1, 0); G_STAGE_A(SA(0, 1), 1, t + 2);
        WAIT_L(8); BAR; WAIT_L(0); G_MMA(0, 0, At, B0); BAR; SCHED;
        G_LDB(B1, 1, 1); G_STAGE_B(SB(1, 0), 0, t + 3);
        BAR; WAIT_L(0); G_MMA(0, 1, At, B1); BAR;
        G_LDA(At, 1, 1); G_STAGE_A(SA(1, 0), 0, t + 3);
        BAR; WAIT_L(0); G_MMA(1, 0, At, B0); BAR; SCHED;
        G_STAGE_B(SB(1, 1), 1, t + 3);
        WAIT_V(6); BAR; G_MMA(1, 1, At, B1); BAR;
    }
    { G_LDB(B0, 0, 0); WAIT_V(0); G_LDA(At, 0, 0); G_STAGE_A(SA(1, 1), 1, nt - 1);
      BAR; WAIT_L(0); G_MMA(0, 0, At, B0); BAR;
      G_LDB(B1, 0, 1); BAR; WAIT_L(0); G_MMA(0, 1, At, B1); BAR;
      G_LDA(At, 0, 1); WAIT_V(4); BAR; WAIT_L(0); G_MMA(1, 0, At, B0); G_MMA(1, 1, At, B1); BAR; }
    { G_LDB(B0, 1, 0); G_LDA(At, 1, 0); WAIT_V(2); BAR; WAIT_L(0); G_MMA(0, 0, At, B0); BAR;
      G_LDB(B1, 1, 1); WAIT_V(0); BAR; WAIT_L(0); G_MMA(0, 1, At, B1); BAR;
      G_LDA(At, 1, 1); BAR; WAIT_L(0); G_MMA(1, 0, At, B0); G_MMA(1, 1, At, B1); BAR; }
    if (wr == 0) BAR;
    int tz = hidden_tid(wv); wid = tz >> 6; lane = tz & 63; wr = wid >> 2; wc = wid & 3; fr = lane & 15; fq = lane >> 4;
    epi(acc, wr * 64 + fr, bcol + wc * 32 + fq * 4);
}

struct RowIdent { static constexpr bool DENSE = true; __device__ __forceinline__ int operator()(int r) const { return r; } };

__device__ __forceinline__ void st_bf16x4(bf16_t* p, const f32x4& v) { u32x2 w; w.x = cvt_pk_bf16(v[0], v[1]); w.y = cvt_pk_bf16(v[2], v[3]); *(u32x2*)p = w; }
__device__ __forceinline__ void st_chan4(bf16_t* q, size_t ld, const f32x4& v) {
    const unsigned a = cvt_pk_bf16(v[0], v[1]), b = cvt_pk_bf16(v[2], v[3]);
    q[0] = (bf16_t)(a & 0xffff); q[ld] = (bf16_t)(a >> 16); q[2 * ld] = (bf16_t)(b & 0xffff); q[3 * ld] = (bf16_t)(b >> 16);
}
#define EPI_LOOP_AM _Pragma("unroll") for (int ai = 0; ai < 2; ++ai) _Pragma("unroll") for (int m = 0; m < 4; ++m)
#define EPI_LOOP_BN _Pragma("unroll") for (int bj = 0; bj < 2; ++bj) _Pragma("unroll") for (int n = 0; n < 2; ++n)
struct EpiRes {
    float* X; int brow;
    __device__ __forceinline__ void operator()(AccT& acc, int r0, int c0) const {
        EPI_LOOP_AM {
            float* q = X + (size_t)(brow + r0 + ai * 128 + m * 16) * D + c0;
            EPI_LOOP_BN { float* qq = q + bj * 128 + n * 16; *(f32x4*)qq = *(const f32x4*)qq + acc[ai][bj][m][n]; }
            asm volatile("" ::: "memory");
        }
    }
};
struct EpiSplit {
    bf16_t* Ca; bf16_t* T; bf16_t* Cb; int c0s, c1s, ldT; size_t ldC; int brow;
    __device__ __forceinline__ void chan(AccT& acc, bf16_t* base, int r0, int c) const {
        EPI_LOOP_AM { bf16_t* q = base + (size_t)c * ldC + (brow + r0 + ai * 128 + m * 16);
            EPI_LOOP_BN st_chan4(q + (size_t)(bj * 128 + n * 16) * ldC, ldC, acc[ai][bj][m][n]); }
    }
    __device__ __forceinline__ void operator()(AccT& acc, int r0, int c0) const {
        const int tilec = __builtin_amdgcn_readfirstlane(c0) & ~255;
        if (tilec < c0s) chan(acc, Ca, r0, c0);
        else if (tilec < c1s) {
            EPI_LOOP_AM { bf16_t* q = T + (size_t)(brow + r0 + ai * 128 + m * 16) * ldT + (c0 - c0s);
                EPI_LOOP_BN st_bf16x4(q + bj * 128 + n * 16, acc[ai][bj][m][n]); }
        } else chan(acc, Cb, r0, c0 - c1s);
    }
};
struct EpiGateUp {
    bf16_t* act; const int* list; int cnt, pos0;
    __device__ __forceinline__ void operator()(AccT& acc, int r0, int c0) const {
        EPI_LOOP_AM {
            const int pos = pos0 + r0 + ai * 128 + m * 16;
            if (pos < cnt) {
                const int a = list[pos];
#pragma unroll
                for (int bj = 0; bj < 2; ++bj) {
                    const f32x4 g = acc[ai][bj][m][0], u = acc[ai][bj][m][1]; f32x4 o;
#pragma unroll
                    for (int j = 0; j < 4; ++j) o[j] = g[j] / (1.0f + __expf(-g[j])) * u[j];
                    const int col = c0 + bj * 128;
                    st_bf16x4(act + (size_t)a * EH + (col >> 5) * 16 + (col & 15), o);
                }
            }
        }
    }
};
struct EpiDown {
    bf16_t* y; const int* list; int cnt, pos0;
    __device__ __forceinline__ void operator()(AccT& acc, int r0, int c0) const {
        EPI_LOOP_AM {
            const int pos = pos0 + r0 + ai * 128 + m * 16;
            if (pos < cnt) { bf16_t* q = y + (size_t)list[pos] * D + c0; EPI_LOOP_BN st_bf16x4(q + bj * 128 + n * 16, acc[ai][bj][m][n]); }
        }
    }
};
struct RowTok { static constexpr bool DENSE = false; const int* list; int cnt, pos0; __device__ __forceinline__ int operator()(int r) const { const int pos = pos0 + r; return pos < cnt ? (list[pos] >> 1) : NTOK; } };
struct RowAsg { static constexpr bool DENSE = false; const int* list; int cnt, pos0; __device__ __forceinline__ int operator()(int r) const { const int pos = pos0 + r; return pos < cnt ? list[pos] : 2 * NTOK; } };

constexpr int ATT_VOFF = 16384;
template <int MODE> struct ACfg;
template <> struct ACfg<0> { static constexpr int DQK = 64, DV = 128, NMAP = 2, KBLK = 2; };
template <> struct ACfg<1> { static constexpr int DQK = 64, DV = 64, NMAP = 1, KBLK = 1; };
template <> struct ACfg<2> { static constexpr int DQK = 128, DV = 128, NMAP = 1, KBLK = 2; };

template <int MODE>
__device__ __forceinline__ void attn_unit(const bf16_t* __restrict__ Qp, const int ldq,
                                          const bf16_t* __restrict__ Kp, const int ldk,
                                          const bf16_t* __restrict__ Vt, const size_t ldvt,
                                          const int q0, const int kbeg, const int kend,
                                          const float scale, const float slope, const float m_init, const float l_init,
                                          bf16_t* __restrict__ Op, const int ldo,
                                          const float lam, const float outscale, const float* __restrict__ subln, const int wv) {
    constexpr int DQK = ACfg<MODE>::DQK, DV = ACfg<MODE>::DV, NMAP = ACfg<MODE>::NMAP, KBLK = ACfg<MODE>::KBLK;
    const int tid = hidden_tid(wv), w = tid >> 6, lane = tid & 63, fr = lane & 15, fq = lane >> 4;
    const int qrow = q0 + w * 16 + fr;
    bf16x8 Qf[NMAP][DQK / 32];
#pragma unroll
    for (int m = 0; m < NMAP; ++m)
#pragma unroll
        for (int kk = 0; kk < DQK / 32; ++kk) Qf[m][kk] = *(const bf16x8*)(Qp + (size_t)qrow * ldq + m * DQK + kk * 32 + fq * 8);
    f32x4 O[NMAP][DV / 16];
    float mrun[NMAP], lrun[NMAP];
#pragma unroll
    for (int m = 0; m < NMAP; ++m) {
        mrun[m] = m_init; lrun[m] = (fq == 0) ? l_init : 0.f;
#pragma unroll
        for (int et = 0; et < DV / 16; ++et) O[m][et] = (f32x4){0.f, 0.f, 0.f, 0.f};
    }
    char* const lds = (char*)shm;
    for (int k0 = kbeg; k0 < kend; k0 += 64) {
        __syncthreads();
        for (int c = tid; c < 64 * KBLK * 8; c += NT) {
            const int key = c / (KBLK * 8), col = (c % (KBLK * 8)) * 8;
            const u32x4 v = *(const u32x4*)(Kp + (size_t)(k0 + key) * ldk + col);
            *(u32x4*)(lds + (col >> 6) * 8192 + lds_byte(key, col & 63)) = v;
        }
        for (int c = tid; c < DV * 8; c += NT) {
            const int e = c >> 3, kc = c & 7;
            const u32x4 v = *(const u32x4*)(Vt + (size_t)e * ldvt + k0 + kc * 8);
            *(u32x4*)(lds + ATT_VOFF + e * 144 + kc * 16) = v;
        }
        __syncthreads();
        bf16x8 Pf[NMAP][2];
#pragma unroll
        for (int m = 0; m < NMAP; ++m) {
            f32x4 s[4];
#pragma unroll
            for (int t = 0; t < 4; ++t) {
                s[t] = (f32x4){0.f, 0.f, 0.f, 0.f};
#pragma unroll
                for (int kk = 0; kk < DQK / 32; ++kk) {
                    const int blk = (MODE == 2) ? (kk >> 1) : m, kcol = (MODE == 2) ? (kk & 1) * 32 : kk * 32;
                    const bf16x8 kf = *(const bf16x8*)(lds + blk * 8192 + lds_byte(t * 16 + fr, kcol + fq * 8));
                    s[t] = __builtin_amdgcn_mfma_f32_16x16x32_bf16(kf, Qf[m][kk], s[t], 0, 0, 0);
                }
            }
            float mx = -1e30f;
#pragma unroll
            for (int t = 0; t < 4; ++t)
#pragma unroll
                for (int r = 0; r < 4; ++r) {
                    float v = s[t][r] * scale;
                    if (MODE != 2) {
                        const int key = k0 + t * 16 + fq * 4 + r;
                        const int dd = qrow - key; const float ad = (float)(dd < 0 ? -dd : dd);
                        v -= slope * ad;
                        if (MODE == 1) v = (ad > 128.0f) ? -1e30f : v;
                    }
                    s[t][r] = v; mx = fmaxf(mx, v);
                }
            mx = fmaxf(mx, shx(mx, 16, lane)); mx = fmaxf(mx, shx(mx, 32, lane));
            const float mnew = fmaxf(mrun[m], mx), alpha = __expf(mrun[m] - mnew);
            mrun[m] = mnew;
            float ps = 0.f;
#pragma unroll
            for (int t = 0; t < 4; ++t)
#pragma unroll
                for (int r = 0; r < 4; ++r) { const float pv = __expf(s[t][r] - mnew); s[t][r] = pv; ps += pv; }
            lrun[m] = lrun[m] * alpha + ps;
#pragma unroll
            for (int et = 0; et < DV / 16; ++et) O[m][et] *= alpha;
#pragma unroll
            for (int c = 0; c < 2; ++c) {
                u32x4 pk; pk.x = cvt_pk_bf16(s[2 * c][0], s[2 * c][1]); pk.y = cvt_pk_bf16(s[2 * c][2], s[2 * c][3]);
                pk.z = cvt_pk_bf16(s[2 * c + 1][0], s[2 * c + 1][1]); pk.w = cvt_pk_bf16(s[2 * c + 1][2], s[2 * c + 1][3]);
                Pf[m][c] = __builtin_bit_cast(bf16x8, pk);
            }
        }
#pragma unroll
        for (int et = 0; et < DV / 16; ++et)
#pragma unroll
            for (int c = 0; c < 2; ++c) {
                const char* vb = lds + ATT_VOFF + (et * 16 + fr) * 144 + (32 * c + 4 * fq) * 2;
                const u32x2 lo = *(const u32x2*)vb, hi = *(const u32x2*)(vb + 32);
                u32x4 vv; vv.x = lo.x; vv.y = lo.y; vv.z = hi.x; vv.w = hi.y;
                const bf16x8 vf = __builtin_bit_cast(bf16x8, vv);
#pragma unroll
                for (int m = 0; m < NMAP; ++m) O[m][et] = __builtin_amdgcn_mfma_f32_16x16x32_bf16(vf, Pf[m][c], O[m][et], 0, 0, 0);
            }
    }
    float linv[NMAP];
#pragma unroll
    for (int m = 0; m < NMAP; ++m) { float l = lrun[m]; l += shx(l, 16, lane); l += shx(l, 32, lane); linv[m] = 1.0f / l; }
    if (MODE == 0) {
        float ss = 0.f;
#pragma unroll
        for (int et = 0; et < DV / 16; ++et)
#pragma unroll
            for (int r = 0; r < 4; ++r) { const float v = O[0][et][r] * linv[0] - lam * (O[NMAP - 1][et][r] * linv[NMAP - 1]); O[0][et][r] = v; ss += v * v; }
        ss += shx(ss, 16, lane); ss += shx(ss, 32, lane);
        const float rs = rsqrtf(ss * (1.0f / 128.0f) + EPS) * outscale;
#pragma unroll
        for (int et = 0; et < DV / 16; ++et) {
            const f32x4 g = *(const f32x4*)(subln + et * 16 + fq * 4);
            st_bf16x4(Op + (size_t)qrow * ldo + et * 16 + fq * 4, O[0][et] * rs * g);
        }
    } else {
#pragma unroll
        for (int et = 0; et < DV / 16; ++et) st_bf16x4(Op + (size_t)qrow * ldo + et * 16 + fq * 4, O[0][et] * linv[0]);
    }
}

constexpr int HZ_RS = 4896;
constexpr int HZ_PAD = 192;
constexpr int H_CPS = 8256;
constexpr int H_ZOFF = 0, H_CPOFF = 8 * HZ_RS, H_RAWOFF = H_CPOFF + 8 * H_CPS;

__device__ __forceinline__ void hyena_unit(const Params& p, const int lj  , const int c, const int wv) {
    const int tid = hidden_tid(wv), w = tid >> 6, lane = tid & 63, fr = lane & 15, fq = lane >> 4;
    char* const lds = (char*)shm;
    const bf16_t* hyT = (const bf16_t*)(p.ws + WS_PROJ + PR_HYT);
    const float* cw = p.in[4] + (size_t)lj * 3 * 1536; const float* cb = p.in[5] + (size_t)lj * 1536;
    __syncthreads();
    for (int i = tid; i < 8 * 2 * (HZ_PAD / 8); i += NT) {
        const int b = i / (2 * (HZ_PAD / 8)), r = i % (2 * (HZ_PAD / 8)), side = r / (HZ_PAD / 8), k = r % (HZ_PAD / 8);
        unsigned zz0 = 0u; asm volatile("" : "+v"(zz0));
        *(u32x4*)(lds + H_ZOFF + b * HZ_RS + (side ? (HZ_PAD + 2048) * 2 : 0) + k * 16) = (u32x4){zz0, zz0, zz0, zz0};
    }
    {
        const float w0 = cw[c], w1 = cw[1536 + c], w2 = cw[2 * 1536 + c], bb = cb[c];
        const bf16_t* src = hyT + (size_t)c * NTOK;
        for (int i = tid; i < 8 * 256; i += NT) {
            const int b = i >> 8, s0 = (i & 255) * 8;
            const bf16_t* q = src + b * S + s0;
            const u32x4 v = *(const u32x4*)q;
            float u[10];
            u[0] = (s0 > 0) ? bf2f(q[-1]) : 0.f; u[9] = (s0 + 8 < S) ? bf2f(q[8]) : 0.f;
            u[1] = bflo(v.x); u[2] = bfhi(v.x); u[3] = bflo(v.y); u[4] = bfhi(v.y); u[5] = bflo(v.z); u[6] = bfhi(v.z); u[7] = bflo(v.w); u[8] = bfhi(v.w);
            float o[8];
#pragma unroll
            for (int j = 0; j < 8; ++j) o[j] = w0 * u[j] + w1 * u[j + 1] + w2 * u[j + 2] + bb;
            u32x4 ov; ov.x = cvt_pk_bf16(o[0], o[1]); ov.y = cvt_pk_bf16(o[2], o[3]); ov.z = cvt_pk_bf16(o[4], o[5]); ov.w = cvt_pk_bf16(o[6], o[7]);
            *(u32x4*)(lds + H_ZOFF + b * HZ_RS + (HZ_PAD + s0) * 2) = ov;
        }
    }
#pragma unroll 1
    for (int order = 0; order < 2; ++order) {
        {
            const bf16_t* f = (const bf16_t*)(p.ws + WS_FILT) + ((size_t)(lj * 2 + order) * 512 + c) * 4096;
            *(u32x4*)(lds + H_RAWOFF + tid * 16) = *(const u32x4*)(f + tid * 8);
        }
        __syncthreads();
        {
            const bf16_t* raw = (const bf16_t*)(lds + H_RAWOFF);
            const int o = w;
            for (int a = lane; a < 512; a += 64) {
                unsigned short e[8];
#pragma unroll
                for (int j = 0; j < 8; ++j) { const int idx = 8 * a + o + j; e[j] = (idx < 4096) ? raw[idx] : (unsigned short)0; }
                u32x4 ov; ov.x = e[0] | ((unsigned)e[1] << 16); ov.y = e[2] | ((unsigned)e[3] << 16); ov.z = e[4] | ((unsigned)e[5] << 16); ov.w = e[6] | ((unsigned)e[7] << 16);
                *(u32x4*)(lds + H_CPOFF + o * H_CPS + a * 16) = ov;
            }
        }
        __syncthreads();
        f32x4 acc[2][4];
#pragma unroll
        for (int ci = 0; ci < 2; ++ci)
#pragma unroll
            for (int mt = 0; mt < 4; ++mt) acc[ci][mt] = (f32x4){0.f, 0.f, 0.f, 0.f};
        {
            const int nb = fr >> 1, tbp = fr & 1;
            const int acp = H_CPOFF + (7 - (fr & 7)) * H_CPS + (255 - (fr >> 3) + fq) * 16;
            const int zb = H_ZOFF + nb * HZ_RS + (HZ_PAD + 8 * fq) * 2;
            for (int dl = 4 * w - 31; dl <= 4 * w + 3; ++dl) {
#pragma unroll
                for (int kh = 0; kh < 2; ++kh) {
                    bf16x8 Bf[2];
#pragma unroll
                    for (int ci = 0; ci < 2; ++ci) {
                        const int sblk = 4 * w + 2 * ci + tbp - dl;
                        Bf[ci] = *(const bf16x8*)(lds + zb + (64 * sblk + 32 * kh) * 2);
                    }
#pragma unroll
                    for (int mt = 0; mt < 4; ++mt) {
                        const int q = 4 * dl + mt - 2 * kh;
                        const bf16x8 Af = *(const bf16x8*)(lds + acp - 32 * q);
#pragma unroll
                        for (int ci = 0; ci < 2; ++ci) acc[ci][mt] = __builtin_amdgcn_mfma_f32_16x16x32_bf16(Af, Bf[ci], acc[ci][mt], 0, 0, 0);
                    }
                }
            }
        }
        const float hb = p.in[12][(size_t)(lj * 2 + order) * 512 + c];
        const int gch = 512 * (order + 1) + c;
        const float w0 = cw[gch], w1 = cw[1536 + gch], w2 = cw[2 * 1536 + gch], bb = cb[gch];
        const bf16_t* gsrc = hyT + (size_t)gch * NTOK;
        const int nb = fr >> 1, tbp = fr & 1;
        u32x2 zout[2][4];
#pragma unroll
        for (int ci = 0; ci < 2; ++ci)
#pragma unroll
            for (int mt = 0; mt < 4; ++mt) {
                const int t = 64 * (4 * w + 2 * ci + tbp) + 16 * mt + 4 * fq;
                const u32x2 zz = *(const u32x2*)(lds + H_ZOFF + nb * HZ_RS + (HZ_PAD + t) * 2);
                const bf16_t* gq = gsrc + nb * S + t;
                const u32x2 gv = *(const u32x2*)gq;
                float u[6];
                u[0] = (t > 0) ? bf2f(gq[-1]) : 0.f; u[5] = (t + 4 < S) ? bf2f(gq[4]) : 0.f;
                u[1] = bflo(gv.x); u[2] = bfhi(gv.x); u[3] = bflo(gv.y); u[4] = bfhi(gv.y);
                const float z[4] = {bflo(zz.x), bfhi(zz.x), bflo(zz.y), bfhi(zz.y)};
                float o[4];
#pragma unroll
                for (int r = 0; r < 4; ++r) {
                    const float gate = w0 * u[r] + w1 * u[r + 1] + w2 * u[r + 2] + bb;
                    o[r] = gate * (acc[ci][mt][r] + hb * z[r]);
                }
                zout[ci][mt].x = cvt_pk_bf16(o[0], o[1]); zout[ci][mt].y = cvt_pk_bf16(o[2], o[3]);
            }
        __syncthreads();
        if (order == 0) {
#pragma unroll
            for (int ci = 0; ci < 2; ++ci)
#pragma unroll
                for (int mt = 0; mt < 4; ++mt) {
                    const int t = 64 * (4 * w + 2 * ci + tbp) + 16 * mt + 4 * fq;
                    *(u32x2*)(lds + H_ZOFF + nb * HZ_RS + (HZ_PAD + t) * 2) = zout[ci][mt];
                }
        } else {
            bf16_t* ym = (bf16_t*)(p.ws + WS_YMIX);
#pragma unroll
            for (int ci = 0; ci < 2; ++ci)
#pragma unroll
                for (int mt = 0; mt < 4; ++mt) {
                    const int t = 64 * (4 * w + 2 * ci + tbp) + 16 * mt + 4 * fq;
                    bf16_t* q = ym + (size_t)(nb * S + t) * D + c;
                    q[0] = (bf16_t)(zout[ci][mt].x & 0xffff); q[D] = (bf16_t)(zout[ci][mt].x >> 16);
                    q[2 * D] = (bf16_t)(zout[ci][mt].y & 0xffff); q[3 * D] = (bf16_t)(zout[ci][mt].y >> 16);
                }
        }
        __syncthreads();
    }
}

struct Row16 { f32x4 v[4]; };
__device__ __forceinline__ void ld_row(Row16& r, const float* src, int lane) {
#pragma unroll
    for (int i = 0; i < 4; ++i) r.v[i] = *(const f32x4*)(src + 256 * i + 4 * lane);
}
__device__ __forceinline__ float row_rstd(const Row16& r, int lane) {
    float ss = 0.f;
#pragma unroll
    for (int i = 0; i < 4; ++i) ss += r.v[i][0] * r.v[i][0] + r.v[i][1] * r.v[i][1] + r.v[i][2] * r.v[i][2] + r.v[i][3] * r.v[i][3];
    ss = wave_sum(ss, lane);
    return rsqrtf(ss * (1.0f / 1024.0f) + EPS);
}
template <int KIND  >
__device__ __forceinline__ void norm_phase(const Params& p, const int layer, const float* __restrict__ gain, const int bid, const int nb, const int wv) {
    const int tid_ = hidden_tid(wv), lane = tid_ & 63, w = tid_ >> 6;
    float* X = (float*)(p.ws + WS_X);
    bf16_t* H = (bf16_t*)(p.ws + WS_H);
    const bf16_t* Y = (const bf16_t*)(p.ws + WS_Y);
    const float* WT = (const float*)(p.ws + WS_WT);
    Row16 g; ld_row(g, gain, lane);
    for (int tok = bid * 8 + w; tok < NTOK; tok += nb * 8) {
        Row16 x;
        if (KIND == 0 && layer == 0) ld_row(x, p.in[0] + (size_t)tok * D, lane); else ld_row(x, X + (size_t)tok * D, lane);
        if ((KIND == 0 && layer > 0) || KIND == 2) {
            const float w0 = WT[2 * tok], w1 = WT[2 * tok + 1];
            const bf16_t* y0 = Y + (size_t)(2 * tok) * D; const bf16_t* y1 = y0 + D;
#pragma unroll
            for (int i = 0; i < 4; ++i) {
                const u32x2 a = *(const u32x2*)(y0 + 256 * i + 4 * lane), b = *(const u32x2*)(y1 + 256 * i + 4 * lane);
                x.v[i][0] += w0 * bflo(a.x) + w1 * bflo(b.x); x.v[i][1] += w0 * bfhi(a.x) + w1 * bfhi(b.x);
                x.v[i][2] += w0 * bflo(a.y) + w1 * bflo(b.y); x.v[i][3] += w0 * bfhi(a.y) + w1 * bfhi(b.y);
            }
        }
        const float rstd = row_rstd(x, lane);
        if (KIND == 2) {
#pragma unroll
            for (int i = 0; i < 4; ++i) *(f32x4*)(p.out + (size_t)tok * D + 256 * i + 4 * lane) = x.v[i] * rstd * g.v[i];
        } else {
            if (KIND == 0) {
#pragma unroll
                for (int i = 0; i < 4; ++i) *(f32x4*)(X + (size_t)tok * D + 256 * i + 4 * lane) = x.v[i];
            }
#pragma unroll
            for (int i = 0; i < 4; ++i) st_bf16x4(H + (size_t)tok * D + 256 * i + 4 * lane, x.v[i] * rstd * g.v[i]);
        }
    }
}

__device__ __forceinline__ void route_phase(const Params& p, const int layer, const int bid, const int nb, const int wv) {
    const int tid = hidden_tid(wv), lane = tid & 63, w = tid >> 6;
    float* WTl = (float*)shm;
    const float* wg = p.in[25] + (size_t)layer * D * 4; const float* we = p.in[27] + (size_t)layer * D * NEXP;
    __syncthreads();
    for (int i = tid; i < D * 4; i += NT) WTl[(i & 3) * 1024 + (i >> 2)] = wg[i];
    for (int i = tid; i < D * NEXP; i += NT) WTl[(4 + (i & 31)) * 1024 + (i >> 5)] = we[i];
    __syncthreads();
    const float* X = (const float*)(p.ws + WS_X);
    bf16_t* H = (bf16_t*)(p.ws + WS_H);
    float* WT = (float*)(p.ws + WS_WT);
    int* LIST = (int*)(p.ws + WS_LIST);
    int* CNT = (int*)(p.ws + WS_CNT) + layer * NEXP;
    const float* bg = p.in[26] + layer * 4; const float* be = p.in[28] + layer * NEXP;
    Row16 g; ld_row(g, p.in[24] + (size_t)layer * D, lane);
    for (int tok = bid * 8 + w; tok < NTOK; tok += nb * 8) {
        Row16 x; ld_row(x, X + (size_t)tok * D, lane);
        const float rstd = row_rstd(x, lane);
#pragma unroll
        for (int i = 0; i < 4; ++i) { x.v[i] = x.v[i] * rstd * g.v[i]; st_bf16x4(H + (size_t)tok * D + 256 * i + 4 * lane, x.v[i]); }
        float lg[36];
#pragma unroll
        for (int j = 0; j < 36; ++j) {
            float s = 0.f;
#pragma unroll
            for (int i = 0; i < 4; ++i) { const f32x4 wv = *(const f32x4*)(WTl + j * 1024 + 256 * i + 4 * lane); s += x.v[i][0] * wv[0] + x.v[i][1] * wv[1] + x.v[i][2] * wv[2] + x.v[i][3] * wv[3]; }
            lg[j] = wave_sum(s, lane);
        }
        float g0 = lg[0] + bg[0], g1 = lg[1] + bg[1], g2 = lg[2] + bg[2], g3 = lg[3] + bg[3];
        int gs = 0; float gm = g0;
        if (g1 > gm) { gm = g1; gs = 1; } if (g2 > gm) { gm = g2; gs = 2; } if (g3 > gm) { gm = g3; gs = 3; }
        const float gden = __expf(g0 - gm) + __expf(g1 - gm) + __expf(g2 - gm) + __expf(g3 - gm);
        const float ggate = 1.0f / gden;
        float ev[8];
#pragma unroll
        for (int j = 0; j < 8; ++j) {
            const float a0 = lg[4 + j] + be[j], a1 = lg[12 + j] + be[8 + j], a2 = lg[20 + j] + be[16 + j], a3 = lg[28 + j] + be[24 + j];
            ev[j] = gs == 0 ? a0 : gs == 1 ? a1 : gs == 2 ? a2 : a3;
        }
        int i0 = 0; float v0 = ev[0];
#pragma unroll
        for (int j = 1; j < 8; ++j) if (ev[j] > v0) { v0 = ev[j]; i0 = j; }
        int i1 = -1; float v1 = -3.0e38f;
#pragma unroll
        for (int j = 0; j < 8; ++j) if (j != i0 && ev[j] > v1) { v1 = ev[j]; i1 = j; }
        const float e1 = __expf(v1 - v0), sden = 1.0f / (1.0f + e1);
        if (lane == 0) {
            const int ea = gs * 8 + i0, eb = gs * 8 + i1;
            const int pa = atomicAdd(&CNT[ea], 1), pb = atomicAdd(&CNT[eb], 1);
            LIST[ea * NTOK + pa] = 2 * tok; LIST[eb * NTOK + pb] = 2 * tok + 1;
            WT[2 * tok] = ggate * sden; WT[2 * tok + 1] = ggate * e1 * sden;
        }
    }
}

template <int MODE>
__device__ __forceinline__ void cvt_job(const float* __restrict__ src, bf16_t* __restrict__ dst, const int K, const int N, const int nmat,
                                        const size_t dst_mat_stride, const int bid, const int nb, const int wv) {
    float* T = (float*)shm;
    const int tid = hidden_tid(wv);
    const int tk = K / 64, tn = N / 64, per = tk * tn, total = per * nmat;
    for (int t = bid; t < total; t += nb) {
        const int mat = t / per, r = t % per, k0 = (r / tn) * 64, n0 = (r % tn) * 64;
        const float* s = src + (size_t)mat * K * N;
        bf16_t* d = dst + (size_t)mat * dst_mat_stride;
        __syncthreads();
#pragma unroll
        for (int i = 0; i < 2; ++i) {
            const int kr = (tid >> 4) + 32 * i, nc = (tid & 15) * 4;
            const f32x4 v = *(const f32x4*)(s + (size_t)(k0 + kr) * N + n0 + nc);
            T[kr * 65 + nc] = v[0]; T[kr * 65 + nc + 1] = v[1]; T[kr * 65 + nc + 2] = v[2]; T[kr * 65 + nc + 3] = v[3];
        }
        __syncthreads();
        const int n = tid >> 3, kc = (tid & 7) * 8;
        float e[8];
#pragma unroll
        for (int j = 0; j < 8; ++j) e[j] = T[(kc + j) * 65 + n];
        u32x4 ov; ov.x = cvt_pk_bf16(e[0], e[1]); ov.y = cvt_pk_bf16(e[2], e[3]); ov.z = cvt_pk_bf16(e[4], e[5]); ov.w = cvt_pk_bf16(e[6], e[7]);
        const int ng = n0 + n;
        const int row = (MODE == 0) ? ng : ((ng >> 4) * 32 + (ng & 15) + (MODE == 2 ? 16 : 0));
        *(u32x4*)(d + (size_t)row * K + k0 + kc) = ov;
    }
}

__device__ __forceinline__ void prologue0(const Params& p, const int bid, const int nb, const int wv) {
    unsigned char* ws = p.ws;
    cvt_job<0>(p.in[3], (bf16_t*)(ws + WS_W_EIN), 1024, 3072, 2, (size_t)3072 * 1024, bid, nb, wv);
    cvt_job<0>(p.in[15], (bf16_t*)(ws + WS_W_EOUT), 1024, 1024, 2, (size_t)1024 * 1024, bid, nb, wv);
    cvt_job<0>(p.in[17], (bf16_t*)(ws + WS_W_OIN), 1024, 1536, 2, (size_t)1536 * 1024, bid, nb, wv);
    cvt_job<0>(p.in[19], (bf16_t*)(ws + WS_W_OOUT), 1024, 1024, 2, (size_t)1024 * 1024, bid, nb, wv);
    cvt_job<0>(p.in[21], (bf16_t*)(ws + WS_W_CQ), 1024, 512, 4, (size_t)512 * 1024, bid, nb, wv);
    cvt_job<0>(p.in[22], (bf16_t*)(ws + WS_W_CKV), 1024, 1024, 4, (size_t)1024 * 1024, bid, nb, wv);
    cvt_job<0>(p.in[23], (bf16_t*)(ws + WS_W_CO), 512, 1024, 4, (size_t)1024 * 512, bid, nb, wv);
    cvt_job<1>(p.in[29], (bf16_t*)(ws + WS_W_GU), 1024, 512, 128, (size_t)1024 * 1024, bid, nb, wv);
    cvt_job<2>(p.in[30], (bf16_t*)(ws + WS_W_GU), 1024, 512, 128, (size_t)1024 * 1024, bid, nb, wv);
    cvt_job<0>(p.in[31], (bf16_t*)(ws + WS_W_DN), 512, 1024, 128, (size_t)1024 * 512, bid, nb, wv);
    const int tid = hidden_tid(wv), lane = tid & 63, w = tid >> 6;
    {
        Row16 g; ld_row(g, p.in[32], lane);
        bf16_t* MN = (bf16_t*)(ws + WS_MEMN);
        for (int r = bid * 8 + w; r < Bb * MEM; r += nb * 8) {
            Row16 x; ld_row(x, p.in[1] + (size_t)r * D, lane);
            const float rstd = row_rstd(x, lane);
#pragma unroll
            for (int i = 0; i < 4; ++i) st_bf16x4(MN + (size_t)r * D + 256 * i + 4 * lane, x.v[i] * rstd * g.v[i]);
        }
    }
    {
        float* A2 = (float*)(ws + WS_A2);
        for (int r = bid * 8 + w; r < 2 * S; r += nb * 8) {
            const int lj = r / S, pos = r % S;
            const float* w1 = p.in[6] + (size_t)lj * 33 * 64; const float* b1 = p.in[7] + lj * 64;
            const float* w2 = p.in[8] + (size_t)lj * 64 * 64; const float* b2 = p.in[9] + lj * 64;
            const float fr_ = p.in[11][lj * 64 + lane];
            float a = ((float)pos / 2047.0f) * w1[lane];
#pragma unroll 1
            for (int k = 0; k < 16; ++k) {
                const float band = 1e-4f + (float)k * ((15.0f - 1e-4f) / 15.0f);
                const float ang = band * (6.283185307179586f * (float)pos / 2048.0f);
                a += cosf(ang) * w1[(1 + k) * 64 + lane] - sinf(ang) * w1[(17 + k) * 64 + lane];
            }
            const float a1 = sinf(fr_ * (a + b1[lane]));
            float a2 = 0.f;
#pragma unroll 1
            for (int i = 0; i < 64; ++i) a2 += shl(a1, i) * w2[i * 64 + lane];
            A2[(size_t)r * 64 + lane] = sinf(fr_ * (a2 + b2[lane]));
        }
    }
    if (bid == 0) {
        if (tid < 2) {
            const float* lm = p.in[13] + (size_t)tid * 4 * 64;
            float s01 = 0.f, s23 = 0.f;
            for (int i = 0; i < 64; ++i) { s01 += lm[i] * lm[64 + i]; s23 += lm[128 + i] * lm[192 + i]; }
            const float lam_init = 0.8f - 0.6f * expf(-0.3f * (float)(2 * tid));
            ((float*)(ws + WS_MISC))[tid] = expf(s01) - expf(s23) + lam_init;
        }
        bf16_t* hz = (bf16_t*)(ws + WS_H) + (size_t)NTOK * D; bf16_t* az = (bf16_t*)(ws + WS_ACT) + (size_t)2 * NTOK * EH;
        for (int i = tid; i < D; i += NT) hz[i] = 0;
        for (int i = tid; i < EH; i += NT) az[i] = 0;
    }
}

__device__ __forceinline__ void filter_taps(const Params& p, const int bid, const int nb, const int wv) {
    float* sA = (float*)shm;
    float* sW = sA + 64 * 65;
    const int tid = hidden_tid(wv);
    const float* A2 = (const float*)(p.ws + WS_A2);
    bf16_t* FL = (bf16_t*)(p.ws + WS_FILT);
    for (int job = bid; job < 2 * 4 * 8 * 32; job += nb) {
        const int pt = job & 31, ct = (job >> 5) & 7, od = (job >> 8) & 3, lj = job >> 10;
        const int pos0 = pt * 64, ch0 = ct * 64, order = od >> 1, dir = od & 1;
        const float* w3 = p.in[10] + (size_t)lj * 64 * 2048 + od * 512 + ch0;
        __syncthreads();
        for (int i = tid; i < 4096; i += NT) { sA[(i >> 6) * 65 + (i & 63)] = A2[((size_t)lj * S + pos0 + (i >> 6)) * 64 + (i & 63)]; sW[i] = w3[(size_t)(i >> 6) * 2048 + (i & 63)]; }
        __syncthreads();
        const int pl = tid & 63, cg = tid >> 6, pos = pos0 + pl;
        float acc[8];
#pragma unroll
        for (int k = 0; k < 8; ++k) acc[k] = 0.f;
#pragma unroll 2
        for (int j = 0; j < 64; ++j) {
            const float a = sA[pl * 65 + j];
#pragma unroll
            for (int k = 0; k < 8; ++k) acc[k] += a * sW[j * 64 + cg * 8 + k];
        }
        const float tpos = (float)pos / 2047.0f;
        const float mind = logf(1e-2f) / 1.5f, maxd = logf(1e-2f) / 0.3f;
#pragma unroll
        for (int k = 0; k < 8; ++k) {
            const int ch = ch0 + cg * 8 + k;
            const float delta = mind + (float)ch * ((maxd - mind) / 511.0f);
            const float v = acc[k] * expf(-tpos * fabsf(delta));
            bf16_t* f = FL + ((size_t)(lj * 2 + order) * 512 + ch) * 4096;
            const unsigned short hv = (unsigned short)(cvt_pk_bf16(v, 0.f) & 0xffff);
            if (dir == 0) f[2047 - pos] = hv;
            else { if (pos >= 1) f[2047 + pos] = hv; if (pos == 2047) f[4095] = 0; }
        }
    }
}

enum { PH_P0 = 0, PH_P1, PH_N1, PH_GIN, PH_MIX, PH_GOUT, PH_N2, PH_GQ, PH_XATT, PH_GO, PH_ROUTE, PH_G1, PH_G2, PH_FINAL, PH_COUNT };

template <class Epi>
__device__ __forceinline__ void gemm_dense(const bf16_t* A, const bf16_t* Bt, const int K, const int nM, const int nN, Epi epi, const int bid, const int nb, const int wv) {
    for (int u = bid; u < nM * nN; u += nb) {
        const int pm = u / nN, pn = u % nN;
        epi.brow = pm * 256;
        gemm_tile(A + (size_t)pm * 256 * K, Bt, K, pn * 256, RowIdent{}, epi, wv);
    }
}

typedef const __attribute__((address_space(4))) Params* ParamsK;
#define PHASE_FN __forceinline__
template <int PH>
__device__ PHASE_FN void run_phase(ParamsK pk_, const int layer, const int bid_, const int nb_, const int wv_) {
    ParamsK pk = pk_; asm volatile("" : "+s"(pk));
    int bid = bid_, nb = nb_, wv = wv_; asm volatile("" : "+s"(bid), "+s"(nb), "+s"(wv));
    const Params& p = *(const Params*)pk;
    unsigned char* ws = p.ws;
    const int lj = layer >> 1; const bool even = (layer & 1) == 0;
    bf16_t* H = (bf16_t*)(ws + WS_H);
    float* X = (float*)(ws + WS_X);
    bf16_t* YMIX = (bf16_t*)(ws + WS_YMIX);
    bf16_t* QX = (bf16_t*)(ws + WS_QX);
    bf16_t* OX = (bf16_t*)(ws + WS_OX);
    if constexpr (PH == PH_P0) { prologue0(p, bid, nb, wv); }
    if constexpr (PH == PH_P1) {
        for (int u = bid; u < 4 * 8 * 4; u += nb) {
            const int l = u >> 5, pm = (u >> 2) & 7, pn = u & 3;
            EpiSplit e{nullptr, (bf16_t*)(ws + WS_XK) + (size_t)l * 2048 * 512, (bf16_t*)(ws + WS_XVT) + (size_t)l * 512 * 2048, 0, 512, 512, (size_t)2048, pm * 256};
            gemm_tile((const bf16_t*)(ws + WS_MEMN) + (size_t)pm * 256 * 1024, (const bf16_t*)(ws + WS_W_CKV) + (size_t)l * 1024 * 1024, 1024, pn * 256, RowIdent{}, e, wv);
        }
        filter_taps(p, bid, nb, wv);
    }
    if constexpr (PH == PH_N1) { norm_phase<0>(p, layer, (even ? p.in[2] : p.in[16]) + (size_t)lj * D, bid, nb, wv); }
    if constexpr (PH == PH_GIN) {
        if (even) {
            EpiSplit e{(bf16_t*)(ws + WS_PROJ + PR_HYT), (bf16_t*)(ws + WS_PROJ + PR_QK), (bf16_t*)(ws + WS_PROJ + PR_VT), 1536, 2560, 1024, (size_t)NTOK, 0};
            gemm_dense(H, (const bf16_t*)(ws + WS_W_EIN) + (size_t)lj * 3072 * 1024, 1024, 64, 12, e, bid, nb, wv);
        } else {
            EpiSplit e{nullptr, (bf16_t*)(ws + WS_PROJ), (bf16_t*)(ws + WS_PROJ + PR_OVT), 0, 1280, 1280, (size_t)NTOK, 0};
            gemm_dense(H, (const bf16_t*)(ws + WS_W_OIN) + (size_t)lj * 1536 * 1024, 1024, 64, 6, e, bid, nb, wv);
        }
    }
    if constexpr (PH == PH_MIX) {
        if (even) {
            const bf16_t* qk = (const bf16_t*)(ws + WS_PROJ + PR_QK);
            const bf16_t* vT = (const bf16_t*)(ws + WS_PROJ + PR_VT);
            const float lam = ((const float*)(ws + WS_MISC))[lj];
            const float lam_init = 0.8f - 0.6f * expf(-0.3f * (float)layer);
            for (int u = bid; u < 1024; u += nb) {
                if (u < 512) hyena_unit(p, lj, u, wv);
                else {
                    const int id = u - 512, b = id >> 6, h = (id >> 4) & 3, qb = id & 15;
                    attn_unit<0>(qk + (size_t)(b * S) * 1024 + 2 * h * 64, 1024, qk + (size_t)(b * S) * 1024 + 512 + 2 * h * 64, 1024,
                                 vT + (size_t)(h * 128) * NTOK + b * S, (size_t)NTOK, qb * 128, 0, S,
                                 0.125f, exp2f(-2.0f * (float)(h + 1)), -1e30f, 0.f,
                                 YMIX + (size_t)(b * S) * D + 512 + h * 128, D, lam, 1.0f - lam_init, p.in[14] + (size_t)lj * 128, wv);
                }
            }
        } else {
            const bf16_t* qk = (const bf16_t*)(ws + WS_PROJ);
            const bf16_t* vT = (const bf16_t*)(ws + WS_PROJ + PR_OVT);
            for (int u = bid; u < 2048; u += nb) {
                const int b = u >> 8, hq = (u >> 4) & 15, qb = u & 15, kv = hq >> 2, q0 = qb * 128;
                const int kbeg = q0 - 128 < 0 ? 0 : q0 - 128, kend = q0 + 256 > S ? S : q0 + 256;
                attn_unit<1>(qk + (size_t)(b * S) * 1280 + hq * 64, 1280, qk + (size_t)(b * S) * 1280 + 1024 + kv * 64, 1280,
                             vT + (size_t)(kv * 64) * NTOK + b * S, (size_t)NTOK, q0, kbeg, kend,
                             0.125f, exp2f(-0.5f * (float)(hq + 1)), p.in[18][lj * 16 + hq], 1.0f,
                             YMIX + (size_t)(b * S) * D + hq * 64, D, 0.f, 1.f, nullptr, wv);
            }
        }
    }
    if constexpr (PH == PH_GOUT) {
        EpiRes e{X, 0};
        gemm_dense(YMIX, (const bf16_t*)(ws + (even ? WS_W_EOUT : WS_W_OOUT)) + (size_t)lj * 1024 * 1024, 1024, 64, 4, e, bid, nb, wv);
    }
    if constexpr (PH == PH_N2) { norm_phase<1>(p, layer, p.in[20] + (size_t)layer * D, bid, nb, wv); }
    if constexpr (PH == PH_GQ) {
        EpiSplit e{nullptr, QX, nullptr, 0, 512, 512, (size_t)NTOK, 0};
        gemm_dense(H, (const bf16_t*)(ws + WS_W_CQ) + (size_t)layer * 512 * 1024, 1024, 64, 2, e, bid, nb, wv);
    }
    if constexpr (PH == PH_XATT) {
        const bf16_t* xk = (const bf16_t*)(ws + WS_XK) + (size_t)layer * 2048 * 512;
        const bf16_t* xvt = (const bf16_t*)(ws + WS_XVT) + (size_t)layer * 512 * 2048;
        for (int u = bid; u < 512; u += nb) {
            const int b = u >> 6, h = (u >> 4) & 3, qb = u & 15;
            attn_unit<2>(QX + (size_t)(b * S) * 512 + h * 128, 512, xk + (size_t)(b * MEM) * 512 + h * 128, 512,
                         xvt + (size_t)(h * 128) * 2048 + b * MEM, (size_t)2048, qb * 128, 0, MEM,
                         0.08838834764831845f, 0.f, -1e30f, 0.f, OX + (size_t)(b * S) * 512 + h * 128, 512, 0.f, 1.f, nullptr, wv);
        }
    }
    if constexpr (PH == PH_GO) {
        EpiRes e{X, 0};
        gemm_dense(OX, (const bf16_t*)(ws + WS_W_CO) + (size_t)layer * 1024 * 512, 512, 64, 4, e, bid, nb, wv);
    }
    if constexpr (PH == PH_ROUTE) { route_phase(p, layer, bid, nb, wv); }
    if constexpr (PH == PH_G1 || PH == PH_G2) {
        const int* CNT = (const int*)(ws + WS_CNT) + layer * NEXP;
        const int* LIST = (const int*)(ws + WS_LIST);
        int total = 0;
        for (int e = 0; e < NEXP; ++e) total += (CNT[e] + 255) >> 8;
        total = __builtin_amdgcn_readfirstlane(total);
        for (int u = bid; u < total * 4; u += nb) {
            int e = 0, base = 0, tl = 0, cnt = 0;
            for (; e < NEXP; ++e) { cnt = __builtin_amdgcn_readfirstlane(CNT[e]); tl = (cnt + 255) >> 8; if (u < base + tl * 4) break; base += tl * 4; }
            const int r = u - base, pn = r / tl, pm = r % tl;
            const int* list = LIST + (size_t)e * NTOK;
            if constexpr (PH == PH_G1) {
                EpiGateUp ep{(bf16_t*)(ws + WS_ACT), list, cnt, pm * 256};
                gemm_tile(H, (const bf16_t*)(ws + WS_W_GU) + ((size_t)layer * NEXP + e) * 1024 * 1024, 1024, pn * 256, RowTok{list, cnt, pm * 256}, ep, wv);
            } else {
                EpiDown ep{(bf16_t*)(ws + WS_Y), list, cnt, pm * 256};
                gemm_tile((const bf16_t*)(ws + WS_ACT), (const bf16_t*)(ws + WS_W_DN) + ((size_t)layer * NEXP + e) * 1024 * 512, 512, pn * 256, RowAsg{list, cnt, pm * 256}, ep, wv);
            }
        }
    }
    if constexpr (PH == PH_FINAL) { norm_phase<2>(p, DEPTH, p.in[33], bid, nb, wv); }
}

#if ONE_LAUNCH
__global__ void __launch_bounds__(NT, 2) k_mega(Params p_) {
    ParamsK p = (ParamsK)__builtin_amdgcn_kernarg_segment_ptr();
    volatile LAS unsigned* st = (volatile LAS unsigned*)((char*)shm + LDS_XB);
    if (threadIdx.x < 4) st[threadIdx.x] = 0u;
    __syncthreads();
    const XcdBarrier bar = xcd_barrier_post((unsigned*)(p->ws + WS_BAR), st);
    const int bid = blockIdx.x, nb = gridDim.x, wv = __builtin_amdgcn_readfirstlane(threadIdx.x >> 6);
    run_phase<PH_P0>(p, 0, bid, nb, wv); xcd_barrier(bar);
    run_phase<PH_P1>(p, 0, bid, nb, wv); xcd_barrier(bar);
#pragma unroll 1
    for (int layer = 0; layer < DEPTH; ++layer) {
        run_phase<PH_N1>(p, layer, bid, nb, wv); xcd_barrier(bar);
        run_phase<PH_GIN>(p, layer, bid, nb, wv); xcd_barrier(bar);
        run_phase<PH_MIX>(p, layer, bid, nb, wv); xcd_barrier(bar);
        run_phase<PH_GOUT>(p, layer, bid, nb, wv); xcd_barrier(bar);
        run_phase<PH_N2>(p, layer, bid, nb, wv); xcd_barrier(bar);
        run_phase<PH_GQ>(p, layer, bid, nb, wv); xcd_barrier(bar);
        run_phase<PH_XATT>(p, layer, bid, nb, wv); xcd_barrier(bar);
        run_phase<PH_GO>(p, layer, bid, nb, wv); xcd_barrier(bar);
        run_phase<PH_ROUTE>(p, layer, bid, nb, wv); xcd_barrier(bar);
        run_phase<PH_G1>(p, layer, bid, nb, wv); xcd_barrier(bar);
        run_phase<PH_G2>(p, layer, bid, nb, wv); xcd_barrier(bar);
    }
    run_phase<PH_FINAL>(p, DEPTH, bid, nb, wv);
}
#else
template <int PH>
__global__ void __launch_bounds__(NT, 2) k_phase(Params p_, int layer) {
    run_phase<PH>((ParamsK)__builtin_amdgcn_kernarg_segment_ptr(), layer, blockIdx.x, gridDim.x, __builtin_amdgcn_readfirstlane(threadIdx.x >> 6));
}
template <int PH> static void launch_phase(const Params& p, int layer, int grid, hipStream_t stream) {
    static bool init = false;
    if (!init) { (void)hipFuncSetAttribute((const void*)k_phase<PH>, hipFuncAttributeMaxDynamicSharedMemorySize, LDS_BYTES); init = true; }
    hipLaunchKernelGGL(k_phase<PH>, dim3(grid), dim3(NT), LDS_BYTES, stream, p, layer);
}
#endif

extern "C" void kernel_launch(void* const* d_in, const int* in_sizes, int n_in, void* d_out, int out_size, void* d_ws, size_t ws_size, hipStream_t stream) {
    if (n_in != 34 || ws_size < WS_END) { fprintf(stderr, "kernel_launch: unexpected n_in %d or ws_size %zu (need %zu)\n", n_in, ws_size, (size_t)WS_END); return; }
    Params p{};
    for (int i = 0; i < 34; ++i) p.in[i] = (const float*)d_in[i];
    p.out = (float*)d_out; p.ws = (unsigned char*)d_ws;
    (void)hipMemsetAsync(d_ws, 0, WS_ZERO_BYTES, stream);
#if ONE_LAUNCH
    static int grid = 0;
    if (grid == 0) {
        int dev = 0, cus = 0, per_cu = 0;
        (void)hipGetDevice(&dev); (void)hipDeviceGetAttribute(&cus, hipDeviceAttributeMultiprocessorCount, dev);
        (void)hipFuncSetAttribute((const void*)k_mega, hipFuncAttributeMaxDynamicSharedMemorySize, LDS_BYTES);
        (void)hipOccupancyMaxActiveBlocksPerMultiprocessor(&per_cu, (const void*)k_mega, NT, LDS_BYTES);
        (void)hipGetLastError();
        grid = cus > 0 ? cus : 256;
    }
    hipLaunchKernelGGL(k_mega, dim3(grid), dim3(NT), LDS_BYTES, stream, p);
#else
    const int grid = 256;
    launch_phase<PH_P0>(p, 0, grid, stream);
    launch_phase<PH_P1>(p, 0, grid, stream);
    for (int layer = 0; layer < DEPTH; ++layer) {
        launch_phase<PH_N1>(p, layer, grid, stream);
        launch_phase<PH_GIN>(p, layer, grid, stream);
        launch_phase<PH_MIX>(p, layer, grid, stream);
        launch_phase<PH_GOUT>(p, layer, grid, stream);
        launch_phase<PH_N2>(p, layer, grid, stream);
        launch_phase<PH_GQ>(p, layer, grid, stream);
        launch_phase<PH_XATT>(p, layer, grid, stream);
        launch_phase<PH_GO>(p, layer, grid, stream);
        launch_phase<PH_ROUTE>(p, layer, grid, stream);
        launch_phase<PH_G1>(p, layer, grid, stream);
        launch_phase<PH_G2>(p, layer, grid, stream);
    }
    launch_phase<PH_FINAL>(p, DEPTH, grid, stream);
#endif
}
```

```cpp
#include <hip/hip_runtime.h>
#include <stdint.h>
#include <stdio.h>

#ifndef DUP
#define DUP -1
#endif
#ifndef DUPSEL
#define DUPSEL 0
#endif
#ifndef ONE_LAUNCH
#define ONE_LAUNCH 1
#endif

typedef unsigned short bf16_t;
typedef short bf16x8 __attribute__((ext_vector_type(8)));
typedef float f32x4 __attribute__((ext_vector_type(4)));
typedef unsigned u32x4 __attribute__((ext_vector_type(4)));
typedef unsigned u32x2 __attribute__((ext_vector_type(2)));

constexpr int Bb = 8, S = 2048, D = 1024, NTOK = Bb * S, DEPTH = 4, MEM = 256;
constexpr int NEXP = 32, EH = 512;
constexpr int NT = 512;
constexpr float EPS = 1e-6f;

constexpr size_t al256(size_t x) { return (x + 255) & ~(size_t)255; }
constexpr size_t WS_BAR   = 0;
constexpr size_t WS_CNT   = 16384;
constexpr int    CNT_STRIDE = 64;
constexpr size_t WS_ZERO_BYTES = 16384 + 65536;
constexpr size_t WS_MISC  = WS_ZERO_BYTES;
constexpr size_t WS_W_EIN = 131072;
constexpr size_t WS_W_EOUT = WS_W_EIN + (size_t)2 * 3072 * 1024 * 2;
constexpr size_t WS_W_OIN = WS_W_EOUT + (size_t)2 * 1024 * 1024 * 2;
constexpr size_t WS_W_OOUT = WS_W_OIN + (size_t)2 * 1536 * 1024 * 2;
constexpr size_t WS_W_CQ  = WS_W_OOUT + (size_t)2 * 1024 * 1024 * 2;
constexpr size_t WS_W_CKV = WS_W_CQ + (size_t)4 * 512 * 1024 * 2;
constexpr size_t WS_W_CO  = WS_W_CKV + (size_t)4 * 1024 * 1024 * 2;
constexpr size_t WS_W_GU  = WS_W_CO + (size_t)4 * 1024 * 512 * 2;
constexpr size_t WS_W_DN  = WS_W_GU + (size_t)4 * 32 * 1024 * 1024 * 2;
constexpr size_t WS_MEMN  = WS_W_DN + (size_t)4 * 32 * 1024 * 512 * 2;
constexpr size_t WS_XK    = WS_MEMN + (size_t)2048 * 1024 * 2;
constexpr size_t WS_XVT   = WS_XK + (size_t)4 * 2048 * 512 * 2;
constexpr size_t WS_A2    = WS_XVT + (size_t)4 * 2048 * 512 * 2;
constexpr size_t WS_FILT  = WS_A2 + (size_t)2 * 2048 * 64 * 4;
constexpr size_t WS_X     = WS_FILT + (size_t)2 * 2 * 512 * 4096 * 2;
constexpr size_t WS_H     = WS_X + (size_t)NTOK * D * 4;
constexpr size_t WS_PROJ  = WS_H + al256((size_t)(NTOK + 1) * D * 2);
constexpr size_t WS_YMIX  = WS_PROJ + (size_t)NTOK * 3072 * 2;
constexpr size_t WS_QX    = WS_YMIX + (size_t)NTOK * D * 2;
constexpr size_t WS_OX    = WS_QX + (size_t)NTOK * 512 * 2;
constexpr size_t WS_ACT   = WS_OX + (size_t)NTOK * 512 * 2;
constexpr size_t WS_Y     = WS_ACT + al256((size_t)(2 * NTOK + 1) * EH * 2);
constexpr size_t WS_LIST  = WS_Y + (size_t)2 * NTOK * D * 2;
constexpr size_t WS_WT    = WS_LIST + (size_t)NEXP * NTOK * 4;
constexpr size_t WS_RSTD  = WS_WT + (size_t)2 * NTOK * 4;
constexpr size_t WS_WRT   = WS_RSTD + (size_t)NTOK * 4;
constexpr size_t WS_END   = WS_WRT + (size_t)4 * 2 * 48 * 1024 * 2;
constexpr size_t PR_HYT   = 0;
constexpr size_t PR_QK    = (size_t)1536 * NTOK * 2;
constexpr size_t PR_VT    = PR_QK + (size_t)NTOK * 1024 * 2;
constexpr size_t PR_OVT   = (size_t)NTOK * 1280 * 2;

constexpr int LDS_XB = 147456;
constexpr int LDS_ROUTE = LDS_XB + 64;
constexpr int LDS_BYTES = LDS_ROUTE + 2048;

struct Params {
    const float* in[34];
    float* out;
    unsigned char* ws;
};

extern __shared__ __attribute__((aligned(16))) bf16_t shm[];

typedef float f32x2 __attribute__((ext_vector_type(2)));
typedef __bf16 bf16x2v __attribute__((ext_vector_type(2)));
__device__ __forceinline__ unsigned cvt_pk_bf16(float lo, float hi) { const f32x2 v = {lo, hi}; return __builtin_bit_cast(unsigned, __builtin_convertvector(v, bf16x2v)); }
__device__ __forceinline__ float bf2f(unsigned short b) { return __uint_as_float((unsigned)b << 16); }
__device__ __forceinline__ float bflo(unsigned w) { return __uint_as_float(w << 16); }
__device__ __forceinline__ float bfhi(unsigned w) { return __uint_as_float(w & 0xffff0000u); }
__device__ __forceinline__ float shx(float v, int m, int lane) { return __int_as_float(__builtin_amdgcn_ds_bpermute((lane ^ m) << 2, __float_as_int(v))); }
__device__ __forceinline__ float shl(float v, int src) { return __int_as_float(__builtin_amdgcn_ds_bpermute(src << 2, __float_as_int(v))); }
__device__ __forceinline__ float wave_sum(float v, int lane) {
    v += shx(v, 1, lane); v += shx(v, 2, lane); v += shx(v, 4, lane); v += shx(v, 8, lane); v += shx(v, 16, lane); v += shx(v, 32, lane); return v;
}

__device__ __forceinline__ int hidden_tid(int wv) { int l; asm volatile("v_mbcnt_lo_u32_b32 %0, -1, 0\n\tv_mbcnt_hi_u32_b32 %0, -1, %0" : "=&v"(l)); return (wv << 6) | l; }

#define XB_TMO      128
#define XB_XCNT(j)  (256  + 64 * (j))
#define XB_XSUB(j)  (1280 + 64 * (j))
#define XB_XGEN(j)  (2304 + 64 * (j))
#define XB_TOP      3328
#define XB_TOPGEN   3392
#define XCD_BAR_WORDS 3456
#define XB_SPIN_CAP (1u << 22)
#define LAS __attribute__((address_space(3)))

__device__ __forceinline__ unsigned xb_ld(unsigned* p)              { return __hip_atomic_load(p, __ATOMIC_RELAXED, __HIP_MEMORY_SCOPE_AGENT); }
__device__ __forceinline__ unsigned xb_add(unsigned* p, unsigned v) { return __hip_atomic_fetch_add(p, v, __ATOMIC_RELAXED, __HIP_MEMORY_SCOPE_AGENT); }
__device__ __forceinline__ unsigned xb_xcc_id() { return (unsigned)__builtin_amdgcn_s_getreg((3 << 11) | 20) & 0xFu; }
#define XB_SPIN(cond, bar) do { unsigned _sp = 0; while (cond) { __builtin_amdgcn_s_sleep(1); \
    if ((++_sp & 255u) == 0u) { if (xb_ld(&(bar)[XB_TMO])) break; if (_sp > XB_SPIN_CAP) { atomicAdd(&(bar)[XB_TMO], 1u); break; } } } } while (0)

struct XcdBarrier { unsigned* bar; unsigned x; volatile LAS unsigned* st; };

__device__ __forceinline__ XcdBarrier xcd_barrier_post(unsigned* bar, volatile LAS unsigned* st) {
    XcdBarrier b; b.bar = bar; b.x = xb_xcc_id(); b.st = st;
    if (threadIdx.x == 0) (void)xb_add(&bar[XB_XCNT(b.x)], 1u);
    return b;
}
__device__ __forceinline__ void xcd_barrier_complete(unsigned* bar, unsigned x, unsigned& nloc, unsigned& nx) {
    const unsigned G = gridDim.x * gridDim.y * gridDim.z;
    unsigned sum, cnt, mine, sp = 0u;
    for (;;) {
        sum = 0u; cnt = 0u; mine = 0u;
#pragma unroll
        for (unsigned j = 0; j < 16; ++j) { const unsigned c = xb_ld(&bar[XB_XCNT(j)]); sum += c; cnt += (c > 0u) ? 1u : 0u; mine = (j == x) ? c : mine; }
        if (sum == G) break;
        __builtin_amdgcn_s_sleep(1);
        if ((++sp & 255u) == 0u) { if (xb_ld(&bar[XB_TMO])) break; if (sp > XB_SPIN_CAP) { atomicAdd(&bar[XB_TMO], 1u); break; } }
    }
    nloc = mine > 0u ? mine : 1u; nx = cnt > 0u ? cnt : 1u;
}
__device__ __forceinline__ void xcd_barrier(const XcdBarrier& b) {
    asm volatile("s_waitcnt vmcnt(0)" ::: "memory");
    __syncthreads();
    if (threadIdx.x == 0) {
        unsigned* bar = b.bar; unsigned bx = b.x;
        asm volatile("" : "+s"(bar), "+s"(bx));
        __builtin_amdgcn_s_waitcnt(0);
        unsigned nloc = b.st[0], nx = b.st[1];
        if (nloc == 0u) { xcd_barrier_complete(bar, bx, nloc, nx); b.st[0] = nloc; b.st[1] = nx; }
        const unsigned old = xb_add(&bar[XB_XSUB(bx)], 1u);
        const unsigned gen = old / nloc;
        if (old + 1u == (gen + 1u) * nloc) {
            __builtin_amdgcn_fence(__ATOMIC_RELEASE, "agent");
            asm volatile("s_waitcnt vmcnt(0)" ::: "memory");
            const unsigned og = xb_add(&bar[XB_TOP], 1u);
            const unsigned tg = og / nx;
            if (og + 1u == (tg + 1u) * nx) xb_add(&bar[XB_TOPGEN], 1u);
            else XB_SPIN(xb_ld(&bar[XB_TOPGEN]) == tg, bar);
            __builtin_amdgcn_fence(__ATOMIC_ACQUIRE, "agent");
            xb_add(&bar[XB_XGEN(bx)], 1u);
            asm volatile("s_waitcnt vmcnt(0)" ::: "memory");
        } else {
            XB_SPIN(xb_ld(&bar[XB_XGEN(bx)]) == gen, bar);
            __builtin_amdgcn_fence(__ATOMIC_ACQUIRE, "agent");
            asm volatile("s_waitcnt vmcnt(0)" ::: "memory");
        }
    }
    __syncthreads();
}

constexpr int HT = 128 * 64;
__device__ __forceinline__ int lds_byte(int r, int c) {
    int st = (r >> 4) * 2 + (c >> 5), rr = r & 15, cc = c & 31, ob = rr * 64 + cc * 2;
    return st * 1024 + (ob ^ (((ob >> 9) & 1) << 5));
}
__device__ __forceinline__ void stage_rc(int b, int& R, int& C) {
    int st = b / 1024, sb = b % 1024, swz = sb ^ (((sb >> 9) & 1) << 5);
    R = (st >> 1) * 16 + swz / 64; C = (st & 1) * 32 + (swz % 64) / 2;
}
#define SA(b, h) (shm + ((b) * 2 + (h)) * HT)
#define SB(b, h) (shm + (4 + (b) * 2 + (h)) * HT)
#define G_STAGE_A(P_, h, kt) do { _Pragma("unroll") for (int _i = 0; _i < 2; ++_i) \
    __builtin_amdgcn_global_load_lds((const unsigned*)((const char*)A + (size_t)((kt) * 128 + (RowSrc::DENSE ? (h) * 256 * K : 0)) + aoff[RowSrc::DENSE ? 0 : (h)][_i]), (unsigned*)((char*)(P_) + tid * 16 + _i * 8192), 16, 0, 0); } while (0)
#define G_STAGE_B(P_, h, kt) do { _Pragma("unroll") for (int _i = 0; _i < 2; ++_i) \
    __builtin_amdgcn_global_load_lds((const unsigned*)((const char*)Bt + (size_t)((kt) * 128 + (h) * 256 * K) + boff[_i]), (unsigned*)((char*)(P_) + tid * 16 + _i * 8192), 16, 0, 0); } while (0)
#define G_LDA(dst, b, h) _Pragma("unroll") for (int m = 0; m < 4; ++m) _Pragma("unroll") for (int k = 0; k < 2; ++k) \
    dst[m][k] = *reinterpret_cast<const bf16x8*>((char*)SA(b, h) + lds_byte(wr * 64 + m * 16 + fr, k * 32 + fq * 8))
#define G_LDB(dst, b, h) _Pragma("unroll") for (int n = 0; n < 2; ++n) _Pragma("unroll") for (int k = 0; k < 2; ++k) \
    dst[n][k] = *reinterpret_cast<const bf16x8*>((char*)SB(b, h) + lds_byte(wc * 32 + n * 16 + fr, k * 32 + fq * 8))
#define G_MMA(ai, bj, At_, Bt_) do { __builtin_amdgcn_s_setprio(1); \
    _Pragma("unroll") for (int m = 0; m < 4; ++m) _Pragma("unroll") for (int n = 0; n < 2; ++n) _Pragma("unroll") for (int k = 0; k < 2; ++k) \
      acc[ai][bj][m][n] = __builtin_amdgcn_mfma_f32_16x16x32_bf16(Bt_[n][k], At_[m][k], acc[ai][bj][m][n], 0, 0, 0); \
    __builtin_amdgcn_s_setprio(0); } while (0)
#define WAIT_V(n) asm volatile("s_waitcnt vmcnt(" #n ")" ::: "memory")
#define WAIT_L(n) asm volatile("s_waitcnt lgkmcnt(" #n ")" ::: "memory")
#define BAR __builtin_amdgcn_s_barrier()
#define SCHED __builtin_amdgcn_sched_barrier(0)

typedef f32x4 AccT[2][2][4][2];

template <class RowSrc, class Epi>
__device__ __forceinline__ void gemm_tile(const bf16_t* __restrict__ A, const bf16_t* __restrict__ Bt, const int K,
                                          const int bcol, const RowSrc& rs, const Epi& epi, const int wv) {
    const int tid = hidden_tid(wv);
    int wid = tid >> 6, lane = tid & 63, wr = wid >> 2, wc = wid & 3, fr = lane & 15, fq = lane >> 4;
    unsigned aoff[2][2], boff[2];
#pragma unroll
    for (int i = 0; i < 2; ++i) {
        int R, C; stage_rc(tid * 16 + i * 8192, R, C);
        boff[i] = (unsigned)(((bcol + R) * K + C) * 2);
        if (RowSrc::DENSE) { aoff[0][i] = (unsigned)((R * K + C) * 2); aoff[1][i] = 0u; }
        else {
#pragma unroll
            for (int h = 0; h < 2; ++h) aoff[h][i] = (unsigned)((rs(h * 128 + R) * K + C) * 2);
        }
    }
    WAIT_V(0);
    AccT acc = {};
    bf16x8 At[4][2], B0[2][2], B1[2][2];
    const int nt = K / 64;
    G_STAGE_B(SB(0, 0), 0, 0); G_STAGE_A(SA(0, 0), 0, 0);
    G_STAGE_B(SB(0, 1), 1, 0); G_STAGE_A(SA(0, 1), 1, 0);
    if (wr == 1) BAR;
    WAIT_V(4); BAR;
    G_STAGE_B(SB(1, 0), 0, 1); G_STAGE_A(SA(1, 0), 0, 1); G_STAGE_B(SB(1, 1), 1, 1);
    WAIT_V(6); BAR;
    for (int t = 0; t < nt - 2; t += 2) {
        G_LDB(B0, 0, 0); SCHED; G_LDA(At, 0, 0); G_STAGE_A(SA(1, 1), 1, t + 1);
        WAIT_L(8); BAR; WAIT_L(0); G_MMA(0, 0, At, B0); BAR; SCHED;
        G_LDB(B1, 0, 1); G_STAGE_B(SB(0, 0), 0, t + 2);
        BAR; WAIT_L(0); G_MMA(0, 1, At, B1); BAR;
        G_LDA(At, 0, 1); G_STAGE_A(SA(0, 0), 0, t + 2);
        BAR; WAIT_L(0); G_MMA(1, 0, At, B0); BAR; SCHED;
        G_STAGE_B(SB(0, 1), 1, t + 2);
        WAIT_V(6); BAR; G_MMA(1, 1, At, B1); BAR;
        G_LDB(B0, 1, 0); SCHED; G_LDA(At, 1, 0); G_STAGE_A(SA(0, 1), 1, t + 2);
        WAIT_L(8); BAR; WAIT_L(0); G_MMA(0, 0, At, B0); BAR; SCHED;
        G_LDB(B1, 1, 1); G_STAGE_B(SB(1, 0), 0, t + 3);
        BAR; WAIT_L(0); G_MMA(0, 1, At, B1); BAR;
        G_LDA(At, 1, 1); G_STAGE_A(SA(1, 0), 0, t + 3);
        BAR; WAIT_L(0); G_MMA(1, 0, At, B0); BAR; SCHED;
        G_STAGE_B(SB(1, 1), 1, t + 3);
        WAIT_V(6); BAR; G_MMA(1, 1, At, B1); BAR;
    }
    { G_LDB(B0, 0, 0); WAIT_V(0); G_LDA(At, 0, 0); G_STAGE_A(SA(1, 1), 1, nt - 1);
      BAR; WAIT_L(0); G_MMA(0, 0, At, B0); BAR;
      G_LDB(B1, 0, 1); BAR; WAIT_L(0); G_MMA(0, 1, At, B1); BAR;
      G_LDA(At, 0, 1); WAIT_V(4); BAR; WAIT_L(0); G_MMA(1, 0, At, B0); G_MMA(1, 1, At, B1); BAR; }
    { G_LDB(B0, 1, 0); G_LDA(At, 1, 0); WAIT_V(2); BAR; WAIT_L(0); G_MMA(0, 0, At, B0); BAR;
      G_LDB(B1, 1, 1); WAIT_V(0); BAR; WAIT_L(0); G_MMA(0, 1, At, B1); BAR;
      G_LDA(At, 1, 1); BAR; WAIT_L(0); G_MMA(1, 0, At, B0); G_MMA(1, 1, At, B1); BAR; }
    if (wr == 0) BAR;
    int tz = hidden_tid(wv); wid = tz >> 6; lane = tz & 63; wr = wid >> 2; wc = wid & 3; fr = lane & 15; fq = lane >> 4;
    epi(acc, wr * 64 + fr, bcol + wc * 32 + fq * 4);
}

struct RowIdent { static constexpr bool DENSE = true; __device__ __forceinline__ int operator()(int r) const { return r; } };

__device__ __forceinline__ void st_bf16x4(bf16_t* p, const f32x4& v) { u32x2 w; w.x = cvt_pk_bf16(v[0], v[1]); w.y = cvt_pk_bf16(v[2], v[3]); *(u32x2*)p = w; }
__device__ __forceinline__ void st_chan4(bf16_t* q, size_t ld, const f32x4& v) {
    const unsigned a = cvt_pk_bf16(v[0], v[1]), b = cvt_pk_bf16(v[2], v[3]);
    q[0] = (bf16_t)(a & 0xffff); q[ld] = (bf16_t)(a >> 16); q[2 * ld] = (bf16_t)(b & 0xffff); q[3 * ld] = (bf16_t)(b >> 16);
}
#define EPI_LOOP_AM _Pragma("unroll") for (int ai = 0; ai < 2; ++ai) _Pragma("unroll") for (int m = 0; m < 4; ++m)
#define EPI_LOOP_BN _Pragma("unroll") for (int bj = 0; bj < 2; ++bj) _Pragma("unroll") for (int n = 0; n < 2; ++n)
struct EpiRes {
    float* X; int brow; float* Xo;
    __device__ __forceinline__ void operator()(AccT& acc, int r0, int c0) const {
        EPI_LOOP_AM {
            const size_t off = (size_t)(brow + r0 + ai * 128 + m * 16) * D + c0;
            float* q = X + off; float* qo = Xo + off;
            EPI_LOOP_BN { *(f32x4*)(qo + bj * 128 + n * 16) = *(const f32x4*)(q + bj * 128 + n * 16) + acc[ai][bj][m][n]; }
            asm volatile("" ::: "memory");
        }
    }
};
struct EpiSplit {
    bf16_t* Ca; bf16_t* T; bf16_t* Cb; int c0s, c1s, ldT; size_t ldC; int brow;
    __device__ __forceinline__ void chan(AccT& acc, bf16_t* base, int r0, int c) const {
        EPI_LOOP_AM { bf16_t* q = base + (size_t)c * ldC + (brow + r0 + ai * 128 + m * 16);
            EPI_LOOP_BN st_chan4(q + (size_t)(bj * 128 + n * 16) * ldC, ldC, acc[ai][bj][m][n]); }
    }
    __device__ __forceinline__ void operator()(AccT& acc, int r0, int c0) const {
        const int tilec = __builtin_amdgcn_readfirstlane(c0) & ~255;
        if (tilec < c0s) chan(acc, Ca, r0, c0);
        else if (tilec < c1s) {
            EPI_LOOP_AM { bf16_t* q = T + (size_t)(brow + r0 + ai * 128 + m * 16) * ldT + (c0 - c0s);
                EPI_LOOP_BN st_bf16x4(q + bj * 128 + n * 16, acc[ai][bj][m][n]); }
        } else chan(acc, Cb, r0, c0 - c1s);
    }
};
struct EpiGateUp {
    bf16_t* act; const int* list; int cnt, pos0; const float* rstd;
    __device__ __forceinline__ void operator()(AccT& acc, int r0, int c0) const {
        EPI_LOOP_AM {
            const int pos = pos0 + r0 + ai * 128 + m * 16;
            if (pos < cnt) {
                const int a = list[pos];
                const float rs = rstd[a >> 1];
#pragma unroll
                for (int bj = 0; bj < 2; ++bj) {
                    const f32x4 g = acc[ai][bj][m][0] * rs, u = acc[ai][bj][m][1] * rs; f32x4 o;
#pragma unroll
                    for (int j = 0; j < 4; ++j) o[j] = g[j] / (1.0f + __expf(-g[j])) * u[j];
                    const int col = c0 + bj * 128;
                    st_bf16x4(act + (size_t)a * EH + (col >> 5) * 16 + (col & 15), o);
                }
            }
        }
    }
};
struct EpiDown {
    bf16_t* y; const int* list; int cnt, pos0;
    __device__ __forceinline__ void operator()(AccT& acc, int r0, int c0) const {
        EPI_LOOP_AM {
            const int pos = pos0 + r0 + ai * 128 + m * 16;
            if (pos < cnt) { bf16_t* q = y + (size_t)list[pos] * D + c0; EPI_LOOP_BN st_bf16x4(q + bj * 128 + n * 16, acc[ai][bj][m][n]); }
        }
    }
};
struct RowTok { static constexpr bool DENSE = false; const int* list; int cnt, pos0; __device__ __forceinline__ int operator()(int r) const { const int pos = pos0 + r; return pos < cnt ? (list[pos] >> 1) : NTOK; } };
struct RowAsg { static constexpr bool DENSE = false; const int* list; int cnt, pos0; __device__ __forceinline__ int operator()(int r) const { const int pos = pos0 + r; return pos < cnt ? list[pos] : 2 * NTOK; } };

constexpr int ATT_VOFF = 16384;
template <int MODE> struct ACfg;
template <> struct ACfg<0> { static constexpr int DQK = 64, DV = 128, NMAP = 2, KBLK = 2; };
template <> struct ACfg<1> { static constexpr int DQK = 64, DV = 64, NMAP = 1, KBLK = 1; };
template <> struct ACfg<2> { static constexpr int DQK = 128, DV = 128, NMAP = 1, KBLK = 2; };

template <int MODE>
__device__ __forceinline__ void attn_unit(const bf16_t* __restrict__ Qp, const int ldq,
                                          const bf16_t* __restrict__ Kp, const int ldk,
                                          const bf16_t* __restrict__ Vt, const size_t ldvt,
                                          const int q0, const int kbeg, const int kend,
                                          const float scale, const float slope, const float m_init, const float l_init,
                                          bf16_t* __restrict__ Op, const int ldo,
                                          const float lam, const float outscale, const float* __restrict__ subln, const int wv) {
    constexpr int DQK = ACfg<MODE>::DQK, DV = ACfg<MODE>::DV, NMAP = ACfg<MODE>::NMAP, KBLK = ACfg<MODE>::KBLK;
    const int tid = hidden_tid(wv), w = tid >> 6, lane = tid & 63, fr = lane & 15, fq = lane >> 4;
    const int qrow = q0 + w * 16 + fr;
    bf16x8 Qf[NMAP][DQK / 32];
#pragma unroll
    for (int m = 0; m < NMAP; ++m)
#pragma unroll
        for (int kk = 0; kk < DQK / 32; ++kk) Qf[m][kk] = *(const bf16x8*)(Qp + (size_t)qrow * ldq + m * DQK + kk * 32 + fq * 8);
    f32x4 O[NMAP][DV / 16];
    float mrun[NMAP], lrun[NMAP];
#pragma unroll
    for (int m = 0; m < NMAP; ++m) {
        mrun[m] = m_init * 1.4426950408889634f; lrun[m] = (fq == 0) ? l_init : 0.f;
#pragma unroll
        for (int et = 0; et < DV / 16; ++et) O[m][et] = (f32x4){0.f, 0.f, 0.f, 0.f};
    }
    char* const lds = (char*)shm;
    constexpr int KN = KBLK, VN = DV / 64;
    constexpr float LOG2E = 1.4426950408889634f;
    const float scale2 = scale * LOG2E, slope2 = slope * LOG2E;
    u32x4 kreg[KN], vreg[VN];
#define ATT_LOAD(k0_) do { \
        _Pragma("unroll") for (int i_ = 0; i_ < KN; ++i_) { const int c_ = tid + i_ * NT; const int key_ = c_ / (KBLK * 8), col_ = (c_ % (KBLK * 8)) * 8; \
            kreg[i_] = *(const u32x4*)(Kp + (size_t)((k0_) + key_) * ldk + col_); } \
        _Pragma("unroll") for (int i_ = 0; i_ < VN; ++i_) { const int c_ = tid + i_ * NT; const int e_ = c_ >> 3, kc_ = c_ & 7; \
            vreg[i_] = *(const u32x4*)(Vt + (size_t)e_ * ldvt + (k0_) + kc_ * 8); } } while (0)
    ATT_LOAD(kbeg);
    for (int k0 = kbeg; k0 < kend; k0 += 64) {
        __syncthreads();
#pragma unroll
        for (int i = 0; i < KN; ++i) { const int c = tid + i * NT; const int key = c / (KBLK * 8), col = (c % (KBLK * 8)) * 8;
            *(u32x4*)(lds + (col >> 6) * 8192 + lds_byte(key, col & 63)) = kreg[i]; }
#pragma unroll
        for (int i = 0; i < VN; ++i) { const int c = tid + i * NT; const int e = c >> 3, kc = c & 7;
            *(u32x4*)(lds + ATT_VOFF + e * 144 + kc * 16) = vreg[i]; }
        __syncthreads();
        if (k0 + 64 < kend) ATT_LOAD(k0 + 64);
        bf16x8 Pf[NMAP][2];
#pragma unroll
        for (int m = 0; m < NMAP; ++m) {
            f32x4 s[4];
            bf16x8 kf[4][DQK / 32];
#pragma unroll
            for (int t = 0; t < 4; ++t)
#pragma unroll
                for (int kk = 0; kk < DQK / 32; ++kk) {
                    const int blk = (MODE == 2) ? (kk >> 1) : m, kcol = (MODE == 2) ? (kk & 1) * 32 : kk * 32;
                    kf[t][kk] = *(const bf16x8*)(lds + blk * 8192 + lds_byte(t * 16 + fr, kcol + fq * 8));
                }
#pragma unroll
            for (int t = 0; t < 4; ++t) {
                s[t] = (f32x4){0.f, 0.f, 0.f, 0.f};
#pragma unroll
                for (int kk = 0; kk < DQK / 32; ++kk) s[t] = __builtin_amdgcn_mfma_f32_16x16x32_bf16(kf[t][kk], Qf[m][kk], s[t], 0, 0, 0);
            }
            float mx = -1e30f;
            const float d0 = (float)(qrow - k0 - 4 * fq);
#pragma unroll
            for (int t = 0; t < 4; ++t)
#pragma unroll
                for (int r = 0; r < 4; ++r) {
                    float v;
                    if (MODE != 2) {
                        const float ad = fabsf(d0 - (float)(16 * t + r));
                        v = s[t][r] * scale2 - slope2 * ad;
                        if (MODE == 1) v = (ad > 128.0f) ? -1e30f : v;
                    } else v = s[t][r] * scale2;
                    s[t][r] = v; mx = fmaxf(mx, v);
                }
            mx = fmaxf(mx, shx(mx, 16, lane)); mx = fmaxf(mx, shx(mx, 32, lane));
            const float mnew = fmaxf(mrun[m], mx), alpha = __builtin_amdgcn_exp2f(mrun[m] - mnew);
            mrun[m] = mnew;
            float ps = 0.f;
#pragma unroll
            for (int t = 0; t < 4; ++t)
#pragma unroll
                for (int r = 0; r < 4; ++r) { const float pv = __builtin_amdgcn_exp2f(s[t][r] - mnew); s[t][r] = pv; ps += pv; }
            lrun[m] = lrun[m] * alpha + ps;
#pragma unroll
            for (int et = 0; et < DV / 16; ++et) O[m][et] *= alpha;
#pragma unroll
            for (int c = 0; c < 2; ++c) {
                u32x4 pk; pk.x = cvt_pk_bf16(s[2 * c][0], s[2 * c][1]); pk.y = cvt_pk_bf16(s[2 * c][2], s[2 * c][3]);
                pk.z = cvt_pk_bf16(s[2 * c + 1][0], s[2 * c + 1][1]); pk.w = cvt_pk_bf16(s[2 * c + 1][2], s[2 * c + 1][3]);
                Pf[m][c] = __builtin_bit_cast(bf16x8, pk);
            }
        }
#pragma unroll
        for (int c = 0; c < 2; ++c) {
            bf16x8 vf[DV / 16];
#pragma unroll
            for (int et = 0; et < DV / 16; ++et) {
                const char* vb = lds + ATT_VOFF + (et * 16 + fr) * 144 + (32 * c + 4 * fq) * 2;
                const u32x2 lo = *(const u32x2*)vb, hi = *(const u32x2*)(vb + 32);
                u32x4 vv; vv.x = lo.x; vv.y = lo.y; vv.z = hi.x; vv.w = hi.y;
                vf[et] = __builtin_bit_cast(bf16x8, vv);
            }
#pragma unroll
            for (int et = 0; et < DV / 16; ++et)
#pragma unroll
                for (int m = 0; m < NMAP; ++m) O[m][et] = __builtin_amdgcn_mfma_f32_16x16x32_bf16(vf[et], Pf[m][c], O[m][et], 0, 0, 0);
        }
    }
    float linv[NMAP];
#pragma unroll
    for (int m = 0; m < NMAP; ++m) { float l = lrun[m]; l += shx(l, 16, lane); l += shx(l, 32, lane); linv[m] = 1.0f / l; }
    if (MODE == 0) {
        float ss = 0.f;
#pragma unroll
        for (int et = 0; et < DV / 16; ++et)
#pragma unroll
            for (int r = 0; r < 4; ++r) { const float v = O[0][et][r] * linv[0] - lam * (O[NMAP - 1][et][r] * linv[NMAP - 1]); O[0][et][r] = v; ss += v * v; }
        ss += shx(ss, 16, lane); ss += shx(ss, 32, lane);
        const float rs = rsqrtf(ss * (1.0f / 128.0f) + EPS) * outscale;
#pragma unroll
        for (int et = 0; et < DV / 16; ++et) {
            const f32x4 g = *(const f32x4*)(subln + et * 16 + fq * 4);
            st_bf16x4(Op + (size_t)qrow * ldo + et * 16 + fq * 4, O[0][et] * rs * g);
        }
    } else {
#pragma unroll
        for (int et = 0; et < DV / 16; ++et) st_bf16x4(Op + (size_t)qrow * ldo + et * 16 + fq * 4, O[0][et] * linv[0]);
    }
}

constexpr int HZ_RS = 4896;
constexpr int HZ_PAD = 192;
constexpr int H_CPS = 8256;
constexpr int H_ZOFF = 0, H_CPOFF = 8 * HZ_RS, H_RAWOFF = H_CPOFF + 8 * H_CPS;

template <bool ALT>
__device__ __forceinline__ void hyena_unit(const Params& p, const int lj  , const int c, const int wv) {
    const int tid = hidden_tid(wv), w = tid >> 6, lane = tid & 63, fr = lane & 15, fq = lane >> 4;
    char* const lds = (char*)shm;
    const bf16_t* hyT = (const bf16_t*)(p.ws + WS_PROJ + PR_HYT);
    const float* cw = p.in[4] + (size_t)lj * 3 * 1536; const float* cb = p.in[5] + (size_t)lj * 1536;
    const int nb = fr >> 1, tbp = fr & 1;
    __syncthreads();
    for (int i = tid; i < 8 * 2 * (HZ_PAD / 8); i += NT) {
        const int b = i / (2 * (HZ_PAD / 8)), r = i % (2 * (HZ_PAD / 8)), side = r / (HZ_PAD / 8), k = r % (HZ_PAD / 8);
        unsigned zz0 = 0u; asm volatile("" : "+v"(zz0));
        *(u32x4*)(lds + H_ZOFF + b * HZ_RS + (side ? (HZ_PAD + 2048) * 2 : 0) + k * 16) = (u32x4){zz0, zz0, zz0, zz0};
        if (i < 2) *(u32x4*)(lds + H_RAWOFF + 8192 + i * 16) = (u32x4){zz0, zz0, zz0, zz0};
    }
    {
        const float w0 = cw[c], w1 = cw[1536 + c], w2 = cw[2 * 1536 + c], bb = cb[c];
        const bf16_t* src = hyT + (size_t)c * NTOK;
        u32x4 v[4]; unsigned short um[4], up[4];
#pragma unroll
        for (int k = 0; k < 4; ++k) {
            const int i = tid + k * NT, b = i >> 8, s0 = (i & 255) * 8;
            const bf16_t* q = src + b * S + s0;
            v[k] = *(const u32x4*)q; um[k] = q[s0 > 0 ? -1 : 0]; up[k] = q[s0 + 8 < S ? 8 : 7];
        }
#pragma unroll
        for (int k = 0; k < 4; ++k) {
            const int i = tid + k * NT, b = i >> 8, s0 = (i & 255) * 8;
            float u[10];
            u[0] = (s0 > 0) ? bf2f(um[k]) : 0.f; u[9] = (s0 + 8 < S) ? bf2f(up[k]) : 0.f;
            u[1] = bflo(v[k].x); u[2] = bfhi(v[k].x); u[3] = bflo(v[k].y); u[4] = bfhi(v[k].y); u[5] = bflo(v[k].z); u[6] = bfhi(v[k].z); u[7] = bflo(v[k].w); u[8] = bfhi(v[k].w);
            float o[8];
#pragma unroll
            for (int j = 0; j < 8; ++j) o[j] = w0 * u[j] + w1 * u[j + 1] + w2 * u[j + 2] + bb;
            u32x4 ov; ov.x = cvt_pk_bf16(o[0], o[1]); ov.y = cvt_pk_bf16(o[2], o[3]); ov.z = cvt_pk_bf16(o[4], o[5]); ov.w = cvt_pk_bf16(o[6], o[7]);
            *(u32x4*)(lds + H_ZOFF + b * HZ_RS + (HZ_PAD + s0) * 2) = ov;
        }
    }
#pragma unroll 1
    for (int order = 0; order < 2; ++order) {
        const int gch = 512 * (order + 1) + c;
        const bf16_t* gsrc = hyT + (size_t)gch * NTOK;
        u32x2 gv[2][4]; unsigned short gm[2][4], gp[2][4];
        u32x4 rawv;
        {
            const bf16_t* f = (const bf16_t*)(p.ws + WS_FILT) + ((size_t)(lj * 2 + order) * 512 + c) * 4096;
            rawv = *(const u32x4*)(f + tid * 8);
#pragma unroll
            for (int ci = 0; ci < 2; ++ci)
#pragma unroll
                for (int mt = 0; mt < 4; ++mt) {
                    const int t = 64 * (4 * w + 2 * ci + tbp) + 16 * mt + 4 * fq;
                    const bf16_t* gq = gsrc + nb * S + t;
                    gv[ci][mt] = *(const u32x2*)gq; gm[ci][mt] = gq[t > 0 ? -1 : 0]; gp[ci][mt] = gq[t + 4 < S ? 4 : 3];
                }
        }
        *(u32x4*)(lds + H_RAWOFF + tid * 16) = rawv;
        __syncthreads();
        {
            const bf16_t* raw = (const bf16_t*)(lds + H_RAWOFF);
            const int o = w;
#pragma unroll
            for (int k = 0; k < 8; ++k) {
                const int a = lane + 64 * k;
                unsigned short e[8];
#pragma unroll
                for (int j = 0; j < 8; ++j) e[j] = raw[8 * a + o + j];
                u32x4 ov; ov.x = e[0] | ((unsigned)e[1] << 16); ov.y = e[2] | ((unsigned)e[3] << 16); ov.z = e[4] | ((unsigned)e[5] << 16); ov.w = e[6] | ((unsigned)e[7] << 16);
                *(u32x4*)(lds + H_CPOFF + o * H_CPS + a * 16) = ov;
            }
        }
        __syncthreads();
        f32x4 acc[2][4];
#pragma unroll
        for (int ci = 0; ci < 2; ++ci)
#pragma unroll
            for (int mt = 0; mt < 4; ++mt) acc[ci][mt] = (f32x4){0.f, 0.f, 0.f, 0.f};
        {
            const int acp = H_CPOFF + (7 - (fr & 7)) * H_CPS + (255 - (fr >> 3) + fq) * 16;
            const int zb = H_ZOFF + nb * HZ_RS + (HZ_PAD + 8 * fq) * 2;
            for (int dl = 4 * w - 31; dl <= ((ALT && DUPSEL >= 5) ? 4 * w - 31 : 4 * w + 3); ++dl) {
#pragma unroll
                for (int kh = 0; kh < 2; ++kh) {
                    bf16x8 Bf[2];
#pragma unroll
                    for (int ci = 0; ci < 2; ++ci) {
                        const int sblk = 4 * w + 2 * ci + tbp - dl;
                        Bf[ci] = *(const bf16x8*)(lds + zb + (64 * sblk + 32 * kh) * 2);
                    }
#pragma unroll
                    for (int mt = 0; mt < 4; ++mt) {
                        const int q = 4 * dl + mt - 2 * kh;
                        const bf16x8 Af = *(const bf16x8*)(lds + acp - 32 * q);
#pragma unroll
                        for (int ci = 0; ci < 2; ++ci) acc[ci][mt] = __builtin_amdgcn_mfma_f32_16x16x32_bf16(Af, Bf[ci], acc[ci][mt], 0, 0, 0);
                    }
                }
            }
        }
        const float hb = p.in[12][(size_t)(lj * 2 + order) * 512 + c];
        const float w0 = cw[gch], w1 = cw[1536 + gch], w2 = cw[2 * 1536 + gch], bb = cb[gch];
        u32x2 zout[2][4];
#pragma unroll
        for (int ci = 0; ci < 2; ++ci)
#pragma unroll
            for (int mt = 0; mt < 4; ++mt) {
                const int t = 64 * (4 * w + 2 * ci + tbp) + 16 * mt + 4 * fq;
                const u32x2 zz = *(const u32x2*)(lds + H_ZOFF + nb * HZ_RS + (HZ_PAD + t) * 2);
                float u[6];
                u[0] = (t > 0) ? bf2f(gm[ci][mt]) : 0.f; u[5] = (t + 4 < S) ? bf2f(gp[ci][mt]) : 0.f;
                u[1] = bflo(gv[ci][mt].x); u[2] = bfhi(gv[ci][mt].x); u[3] = bflo(gv[ci][mt].y); u[4] = bfhi(gv[ci][mt].y);
                const float z[4] = {bflo(zz.x), bfhi(zz.x), bflo(zz.y), bfhi(zz.y)};
                float o[4];
#pragma unroll
                for (int r = 0; r < 4; ++r) {
                    const float gate = w0 * u[r] + w1 * u[r + 1] + w2 * u[r + 2] + bb;
                    o[r] = gate * (acc[ci][mt][r] + hb * z[r]);
                }
                zout[ci][mt].x = cvt_pk_bf16(o[0], o[1]); zout[ci][mt].y = cvt_pk_bf16(o[2], o[3]);
            }
        __syncthreads();
        if (order == 0) {
#pragma unroll
            for (int ci = 0; ci < 2; ++ci)
#pragma unroll
                for (int mt = 0; mt < 4; ++mt) {
                    const int t = 64 * (4 * w + 2 * ci + tbp) + 16 * mt + 4 * fq;
                    *(u32x2*)(lds + H_ZOFF + nb * HZ_RS + (HZ_PAD + t) * 2) = zout[ci][mt];
                }
        } else if (!(ALT && DUPSEL >= 6)) {
            bf16_t* ym = (bf16_t*)(p.ws + (ALT ? WS_Y : WS_YMIX));
#pragma unroll
            for (int ci = 0; ci < 2; ++ci)
#pragma unroll
                for (int mt = 0; mt < 4; ++mt) {
                    const int t = 64 * (4 * w + 2 * ci + tbp) + 16 * mt + 4 * fq;
                    bf16_t* q = ym + (size_t)(nb * S + t) * D + c;
                    q[0] = (bf16_t)(zout[ci][mt].x & 0xffff); q[D] = (bf16_t)(zout[ci][mt].x >> 16);
                    q[2 * D] = (bf16_t)(zout[ci][mt].y & 0xffff); q[3 * D] = (bf16_t)(zout[ci][mt].y >> 16);
                }
        }
        __syncthreads();
    }
}

struct Row16 { f32x4 v[4]; };
__device__ __forceinline__ void ld_row(Row16& r, const float* src, int lane) {
#pragma unroll
    for (int i = 0; i < 4; ++i) r.v[i] = *(const f32x4*)(src + 256 * i + 4 * lane);
}
__device__ __forceinline__ float row_rstd(const Row16& r, int lane) {
    float ss = 0.f;
#pragma unroll
    for (int i = 0; i < 4; ++i) ss += r.v[i][0] * r.v[i][0] + r.v[i][1] * r.v[i][1] + r.v[i][2] * r.v[i][2] + r.v[i][3] * r.v[i][3];
    ss = wave_sum(ss, lane);
    return rsqrtf(ss * (1.0f / 1024.0f) + EPS);
}
template <int KIND  , bool ALT = false>
__device__ __forceinline__ void norm_phase(const Params& p, const int layer, const float* __restrict__ gain, const int bid, const int nb, const int wv) {
    const int tid_ = hidden_tid(wv), lane = tid_ & 63, w = tid_ >> 6;
    float* X = (float*)(p.ws + WS_X);
    float* Xo = ALT ? (float*)(p.ws + WS_PROJ) : X;
    bf16_t* H = (bf16_t*)(p.ws + (ALT ? WS_QX : WS_H));
    const bf16_t* Y = (const bf16_t*)(p.ws + WS_Y);
    const float* WT = (const float*)(p.ws + WS_WT);
    Row16 g; ld_row(g, gain, lane);
    for (int tok = bid * 8 + w; tok < NTOK; tok += nb * 8) {
        Row16 x;
        if (KIND == 0 && layer == 0) ld_row(x, p.in[0] + (size_t)tok * D, lane); else ld_row(x, X + (size_t)tok * D, lane);
        if ((KIND == 0 && layer > 0) || KIND == 2) {
            const float w0 = WT[2 * tok], w1 = WT[2 * tok + 1];
            const bf16_t* y0 = Y + (size_t)(2 * tok) * D; const bf16_t* y1 = y0 + D;
#pragma unroll
            for (int i = 0; i < 4; ++i) {
                const u32x2 a = *(const u32x2*)(y0 + 256 * i + 4 * lane), b = *(const u32x2*)(y1 + 256 * i + 4 * lane);
                x.v[i][0] += w0 * bflo(a.x) + w1 * bflo(b.x); x.v[i][1] += w0 * bfhi(a.x) + w1 * bfhi(b.x);
                x.v[i][2] += w0 * bflo(a.y) + w1 * bflo(b.y); x.v[i][3] += w0 * bfhi(a.y) + w1 * bfhi(b.y);
            }
        }
        const float rstd = row_rstd(x, lane);
        if (KIND == 2) {
#pragma unroll
            for (int i = 0; i < 4; ++i) *(f32x4*)(p.out + (size_t)tok * D + 256 * i + 4 * lane) = x.v[i] * rstd * g.v[i];
        } else {
            if (KIND == 0) {
#pragma unroll
                for (int i = 0; i < 4; ++i) *(f32x4*)(Xo + (size_t)tok * D + 256 * i + 4 * lane) = x.v[i];
            }
#pragma unroll
            for (int i = 0; i < 4; ++i) st_bf16x4(H + (size_t)tok * D + 256 * i + 4 * lane, x.v[i] * rstd * g.v[i]);
        }
    }
}

template <bool ALT>
__device__ __forceinline__ void route_phase(const Params& p, const int layer, const int bid, const int nb, const int wv) {
    const int tid = hidden_tid(wv), lane = tid & 63, w = tid >> 6, fr = lane & 15, fq = lane >> 4;
    float* part = (float*)shm;
    float* ssql = part + 2 * 64 * 48;
    int* cntl = (int*)((char*)shm + LDS_ROUTE);
    int* basel = cntl + 32;
    int* sel = basel + 32;
    int* posl = sel + 128;
    const float* X = (const float*)(p.ws + WS_X);
    bf16_t* H = (bf16_t*)(p.ws + WS_H);
    float* WT = (float*)(p.ws + (ALT ? WS_ACT + (size_t)4 * 1024 * 1024 : WS_WT));
    float* RSTD = (float*)(p.ws + (ALT ? WS_ACT + (size_t)5 * 1024 * 1024 : WS_RSTD));
    int* LIST = (int*)(p.ws + (ALT ? WS_ACT : WS_LIST));
    int* CNT = (int*)(p.ws + WS_CNT) + (layer + (ALT ? 4 : 0)) * NEXP * CNT_STRIDE;
    const float* bg = p.in[26] + layer * 4; const float* be = p.in[28] + layer * NEXP;
    const float* gain = p.in[24] + (size_t)layer * D;
    const bf16_t* Wh = (const bf16_t*)(p.ws + WS_WRT) + (size_t)layer * 2 * 48 * 1024; const bf16_t* Wl = Wh + 48 * 1024;
    const int mt = w & 3, kh = w >> 2;
    for (int chunk = bid; chunk < NTOK / 64; chunk += nb) {
        __syncthreads();
        if (tid < 32) cntl[tid] = 0;
        const int tok = chunk * 64 + mt * 16 + fr;
        const float* xr = X + (size_t)tok * D + kh * 512 + fq * 8;
        f32x4 acc[3];
#pragma unroll
        for (int nt = 0; nt < 3; ++nt) acc[nt] = (f32x4){0.f, 0.f, 0.f, 0.f};
        float ssq = 0.f;
#pragma unroll 2
        for (int ks = 0; ks < 16; ++ks) {
            const int kcol = kh * 512 + ks * 32 + fq * 8;
            const f32x4 x0 = *(const f32x4*)(xr + ks * 32), x1 = *(const f32x4*)(xr + ks * 32 + 4);
            const f32x4 g0 = *(const f32x4*)(gain + kcol), g1 = *(const f32x4*)(gain + kcol + 4);
            bf16x8 Bh[3], Bl[3];
#pragma unroll
            for (int nt = 0; nt < 3; ++nt) { Bh[nt] = *(const bf16x8*)(Wh + (size_t)(nt * 16 + fr) * 1024 + kcol); Bl[nt] = *(const bf16x8*)(Wl + (size_t)(nt * 16 + fr) * 1024 + kcol); }
            ssq += x0[0] * x0[0] + x0[1] * x0[1] + x0[2] * x0[2] + x0[3] * x0[3] + x1[0] * x1[0] + x1[1] * x1[1] + x1[2] * x1[2] + x1[3] * x1[3];
            u32x4 hi; hi.x = cvt_pk_bf16(x0[0], x0[1]); hi.y = cvt_pk_bf16(x0[2], x0[3]); hi.z = cvt_pk_bf16(x1[0], x1[1]); hi.w = cvt_pk_bf16(x1[2], x1[3]);
            u32x4 lo;
            lo.x = cvt_pk_bf16(x0[0] - bflo(hi.x), x0[1] - bfhi(hi.x)); lo.y = cvt_pk_bf16(x0[2] - bflo(hi.y), x0[3] - bfhi(hi.y));
            lo.z = cvt_pk_bf16(x1[0] - bflo(hi.z), x1[1] - bfhi(hi.z)); lo.w = cvt_pk_bf16(x1[2] - bflo(hi.w), x1[3] - bfhi(hi.w));
            u32x4 hg; hg.x = cvt_pk_bf16(x0[0] * g0[0], x0[1] * g0[1]); hg.y = cvt_pk_bf16(x0[2] * g0[2], x0[3] * g0[3]);
            hg.z = cvt_pk_bf16(x1[0] * g1[0], x1[1] * g1[1]); hg.w = cvt_pk_bf16(x1[2] * g1[2], x1[3] * g1[3]);
            *(u32x4*)(H + (size_t)tok * D + kcol) = hg;
            const bf16x8 Ah = __builtin_bit_cast(bf16x8, hi), Al = __builtin_bit_cast(bf16x8, lo);
#pragma unroll
            for (int nt = 0; nt < 3; ++nt) {
                acc[nt] = __builtin_amdgcn_mfma_f32_16x16x32_bf16(Ah, Bh[nt], acc[nt], 0, 0, 0);
                acc[nt] = __builtin_amdgcn_mfma_f32_16x16x32_bf16(Ah, Bl[nt], acc[nt], 0, 0, 0);
                acc[nt] = __builtin_amdgcn_mfma_f32_16x16x32_bf16(Al, Bh[nt], acc[nt], 0, 0, 0);
            }
        }
        ssq += shx(ssq, 16, lane); ssq += shx(ssq, 32, lane);
        if (fq == 0) ssql[kh * 64 + mt * 16 + fr] = ssq;
#pragma unroll
        for (int nt = 0; nt < 3; ++nt)
#pragma unroll
            for (int r = 0; r < 4; ++r) part[(kh * 64 + mt * 16 + fq * 4 + r) * 48 + nt * 16 + fr] = acc[nt][r];
        __syncthreads();
        if (tid < 64) {
            const int tl = tid, tk = chunk * 64 + tl;
            const float rstd = rsqrtf((ssql[tl] + ssql[64 + tl]) * (1.0f / 1024.0f) + EPS);
            const float* p0 = part + tl * 48; const float* p1 = part + (64 + tl) * 48;
            float lg[36];
#pragma unroll
            for (int j = 0; j < 36; ++j) lg[j] = (p0[j] + p1[j]) * rstd;
            float g0 = lg[0] + bg[0], g1 = lg[1] + bg[1], g2 = lg[2] + bg[2], g3 = lg[3] + bg[3];
            int gs = 0; float gm = g0;
            if (g1 > gm) { gm = g1; gs = 1; } if (g2 > gm) { gm = g2; gs = 2; } if (g3 > gm) { gm = g3; gs = 3; }
            const float gden = __expf(g0 - gm) + __expf(g1 - gm) + __expf(g2 - gm) + __expf(g3 - gm);
            const float ggate = 1.0f / gden;
            float ev[8];
#pragma unroll
            for (int j = 0; j < 8; ++j) {
                const float a0 = lg[4 + j] + be[j], a1 = lg[12 + j] + be[8 + j], a2 = lg[20 + j] + be[16 + j], a3 = lg[28 + j] + be[24 + j];
                ev[j] = gs == 0 ? a0 : gs == 1 ? a1 : gs == 2 ? a2 : a3;
            }
            int i0 = 0; float v0 = ev[0];
#pragma unroll
            for (int j = 1; j < 8; ++j) if (ev[j] > v0) { v0 = ev[j]; i0 = j; }
            int i1 = -1; float v1 = -3.0e38f;
#pragma unroll
            for (int j = 0; j < 8; ++j) if (j != i0 && ev[j] > v1) { v1 = ev[j]; i1 = j; }
            const float e1 = __expf(v1 - v0), sden = 1.0f / (1.0f + e1);
            const int ea = gs * 8 + i0, eb = gs * 8 + i1;
            sel[2 * tl] = ea; posl[2 * tl] = atomicAdd(&cntl[ea], 1);
            sel[2 * tl + 1] = eb; posl[2 * tl + 1] = atomicAdd(&cntl[eb], 1);
            WT[2 * tk] = ggate * sden; WT[2 * tk + 1] = ggate * e1 * sden;
            RSTD[tk] = rstd;
        }
        __syncthreads();
        if (tid < 32) { const int c = cntl[tid]; basel[tid] = c > 0 ? atomicAdd(&CNT[tid * CNT_STRIDE], c) : 0; }
        __syncthreads();
        if (tid < 128) { const int e = sel[tid]; LIST[(size_t)e * NTOK + basel[e] + posl[tid]] = 128 * chunk + tid; }
    }
}

template <int MODE>
__device__ __forceinline__ void cvt_job(const float* __restrict__ src, bf16_t* __restrict__ dst, const int K, const int N, const int nmat,
                                        const size_t dst_mat_stride, const int bid, const int nb, const int wv) {
    float* T = (float*)shm;
    const int tid = hidden_tid(wv);
    const int tk = K / 64, tn = N / 64, per = tk * tn, total = per * nmat;
    for (int t = bid; t < total; t += nb) {
        const int mat = t / per, r = t % per, k0 = (r / tn) * 64, n0 = (r % tn) * 64;
        const float* s = src + (size_t)mat * K * N;
        bf16_t* d = dst + (size_t)mat * dst_mat_stride;
        __syncthreads();
#pragma unroll
        for (int i = 0; i < 2; ++i) {
            const int kr = (tid >> 4) + 32 * i, nc = (tid & 15) * 4;
            const f32x4 v = *(const f32x4*)(s + (size_t)(k0 + kr) * N + n0 + nc);
            T[kr * 65 + nc] = v[0]; T[kr * 65 + nc + 1] = v[1]; T[kr * 65 + nc + 2] = v[2]; T[kr * 65 + nc + 3] = v[3];
        }
        __syncthreads();
        const int n = tid >> 3, kc = (tid & 7) * 8;
        float e[8];
#pragma unroll
        for (int j = 0; j < 8; ++j) e[j] = T[(kc + j) * 65 + n];
        u32x4 ov; ov.x = cvt_pk_bf16(e[0], e[1]); ov.y = cvt_pk_bf16(e[2], e[3]); ov.z = cvt_pk_bf16(e[4], e[5]); ov.w = cvt_pk_bf16(e[6], e[7]);
        const int ng = n0 + n;
        const int row = (MODE == 0) ? ng : ((ng >> 4) * 32 + (ng & 15) + (MODE == 2 ? 16 : 0));
        *(u32x4*)(d + (size_t)row * K + k0 + kc) = ov;
    }
}

__device__ __forceinline__ void prologue0(const Params& p, const int bid, const int nb, const int wv) {
    unsigned char* ws = p.ws;
    cvt_job<0>(p.in[3], (bf16_t*)(ws + WS_W_EIN), 1024, 3072, 2, (size_t)3072 * 1024, bid, nb, wv);
    cvt_job<0>(p.in[15], (bf16_t*)(ws + WS_W_EOUT), 1024, 1024, 2, (size_t)1024 * 1024, bid, nb, wv);
    cvt_job<0>(p.in[17], (bf16_t*)(ws + WS_W_OIN), 1024, 1536, 2, (size_t)1536 * 1024, bid, nb, wv);
    cvt_job<0>(p.in[19], (bf16_t*)(ws + WS_W_OOUT), 1024, 1024, 2, (size_t)1024 * 1024, bid, nb, wv);
    cvt_job<0>(p.in[21], (bf16_t*)(ws + WS_W_CQ), 1024, 512, 4, (size_t)512 * 1024, bid, nb, wv);
    cvt_job<0>(p.in[22], (bf16_t*)(ws + WS_W_CKV), 1024, 1024, 4, (size_t)1024 * 1024, bid, nb, wv);
    cvt_job<0>(p.in[23], (bf16_t*)(ws + WS_W_CO), 512, 1024, 4, (size_t)1024 * 512, bid, nb, wv);
    cvt_job<1>(p.in[29], (bf16_t*)(ws + WS_W_GU), 1024, 512, 128, (size_t)1024 * 1024, bid, nb, wv);
    cvt_job<2>(p.in[30], (bf16_t*)(ws + WS_W_GU), 1024, 512, 128, (size_t)1024 * 1024, bid, nb, wv);
    cvt_job<0>(p.in[31], (bf16_t*)(ws + WS_W_DN), 512, 1024, 128, (size_t)1024 * 512, bid, nb, wv);
    const int tid = hidden_tid(wv), lane = tid & 63, w = tid >> 6;
    {
        Row16 g; ld_row(g, p.in[32], lane);
        bf16_t* MN = (bf16_t*)(ws + WS_MEMN);
        for (int r = bid * 8 + w; r < Bb * MEM; r += nb * 8) {
            Row16 x; ld_row(x, p.in[1] + (size_t)r * D, lane);
            const float rstd = row_rstd(x, lane);
#pragma unroll
            for (int i = 0; i < 4; ++i) st_bf16x4(MN + (size_t)r * D + 256 * i + 4 * lane, x.v[i] * rstd * g.v[i]);
        }
    }
    {
        float* A2 = (float*)(ws + WS_A2);
        for (int r = bid * 8 + w; r < 2 * S; r += nb * 8) {
            const int lj = r / S, pos = r % S;
            const float* w1 = p.in[6] + (size_t)lj * 33 * 64; const float* b1 = p.in[7] + lj * 64;
            const float* w2 = p.in[8] + (size_t)lj * 64 * 64; const float* b2 = p.in[9] + lj * 64;
            const float fr_ = p.in[11][lj * 64 + lane];
            float a = ((float)pos / 2047.0f) * w1[lane];
#pragma unroll 1
            for (int k = 0; k < 16; ++k) {
                const float band = 1e-4f + (float)k * ((15.0f - 1e-4f) / 15.0f);
                const float ang = band * (6.283185307179586f * (float)pos / 2048.0f);
                a += cosf(ang) * w1[(1 + k) * 64 + lane] - sinf(ang) * w1[(17 + k) * 64 + lane];
            }
            const float a1 = sinf(fr_ * (a + b1[lane]));
            float a2 = 0.f;
#pragma unroll 1
            for (int i = 0; i < 64; ++i) a2 += shl(a1, i) * w2[i * 64 + lane];
            A2[(size_t)r * 64 + lane] = sinf(fr_ * (a2 + b2[lane]));
        }
    }
    {
        bf16_t* WR = (bf16_t*)(ws + WS_WRT);
        for (int i = bid * NT + tid; i < 4 * 48 * 1024; i += nb * NT) {
            const int l = i / (48 * 1024), r = i % (48 * 1024), j = r >> 10, k = r & 1023;
            float v = 0.f;
            if (j < 4) v = p.in[25][((size_t)l * D + k) * 4 + j]; else if (j < 36) v = p.in[27][((size_t)l * D + k) * NEXP + (j - 4)];
            v *= p.in[24][(size_t)l * D + k];
            const unsigned h = cvt_pk_bf16(v, 0.f) & 0xffffu;
            const unsigned lo = cvt_pk_bf16(v - bflo(h), 0.f) & 0xffffu;
            WR[(size_t)l * 2 * 48 * 1024 + r] = (bf16_t)h; WR[(size_t)l * 2 * 48 * 1024 + 48 * 1024 + r] = (bf16_t)lo;
        }
    }
    if (bid == 0) {
        if (tid < 2) {
            const float* lm = p.in[13] + (size_t)tid * 4 * 64;
            float s01 = 0.f, s23 = 0.f;
            for (int i = 0; i < 64; ++i) { s01 += lm[i] * lm[64 + i]; s23 += lm[128 + i] * lm[192 + i]; }
            const float lam_init = 0.8f - 0.6f * expf(-0.3f * (float)(2 * tid));
            ((float*)(ws + WS_MISC))[tid] = expf(s01) - expf(s23) + lam_init;
        }
        bf16_t* hz = (bf16_t*)(ws + WS_H) + (size_t)NTOK * D; bf16_t* az = (bf16_t*)(ws + WS_ACT) + (size_t)2 * NTOK * EH;
        for (int i = tid; i < D; i += NT) hz[i] = 0;
        for (int i = tid; i < EH; i += NT) az[i] = 0;
    }
}

__device__ __forceinline__ void filter_taps(const Params& p, const int bid, const int nb, const int wv) {
    float* sA = (float*)shm;
    float* sW = sA + 64 * 65;
    const int tid = hidden_tid(wv);
    const float* A2 = (const float*)(p.ws + WS_A2);
    bf16_t* FL = (bf16_t*)(p.ws + WS_FILT);
    for (int job = bid; job < 2 * 4 * 8 * 32; job += nb) {
        const int pt = job & 31, ct = (job >> 5) & 7, od = (job >> 8) & 3, lj = job >> 10;
        const int pos0 = pt * 64, ch0 = ct * 64, order = od >> 1, dir = od & 1;
        const float* w3 = p.in[10] + (size_t)lj * 64 * 2048 + od * 512 + ch0;
        __syncthreads();
        for (int i = tid; i < 4096; i += NT) { sA[(i >> 6) * 65 + (i & 63)] = A2[((size_t)lj * S + pos0 + (i >> 6)) * 64 + (i & 63)]; sW[i] = w3[(size_t)(i >> 6) * 2048 + (i & 63)]; }
        __syncthreads();
        const int pl = tid & 63, cg = tid >> 6, pos = pos0 + pl;
        float acc[8];
#pragma unroll
        for (int k = 0; k < 8; ++k) acc[k] = 0.f;
#pragma unroll 2
        for (int j = 0; j < 64; ++j) {
            const float a = sA[pl * 65 + j];
#pragma unroll
            for (int k = 0; k < 8; ++k) acc[k] += a * sW[j * 64 + cg * 8 + k];
        }
        const float tpos = (float)pos / 2047.0f;
        const float mind = logf(1e-2f) / 1.5f, maxd = logf(1e-2f) / 0.3f;
#pragma unroll
        for (int k = 0; k < 8; ++k) {
            const int ch = ch0 + cg * 8 + k;
            const float delta = mind + (float)ch * ((maxd - mind) / 511.0f);
            const float v = acc[k] * expf(-tpos * fabsf(delta));
            bf16_t* f = FL + ((size_t)(lj * 2 + order) * 512 + ch) * 4096;
            const unsigned short hv = (unsigned short)(cvt_pk_bf16(v, 0.f) & 0xffff);
            if (dir == 0) f[2047 - pos] = hv;
            else { if (pos >= 1) f[2047 + pos] = hv; if (pos == 2047) f[4095] = 0; }
        }
    }
}

enum { PH_P0 = 0, PH_P1, PH_N1, PH_GIN, PH_MIX, PH_GOUT, PH_N2, PH_GQ, PH_XATT, PH_GO, PH_ROUTE, PH_G1, PH_G2, PH_FINAL, PH_COUNT };

template <class Epi>
__device__ __forceinline__ void gemm_dense(const bf16_t* A, const bf16_t* Bt, const int K, const int nM, const int nN, Epi epi, const int bid, const int nb, const int wv) {
    for (int u = bid; u < nM * nN; u += nb) {
        const int pm = u / nN, pn = u % nN;
        epi.brow = pm * 256;
        gemm_tile(A + (size_t)pm * 256 * K, Bt, K, pn * 256, RowIdent{}, epi, wv);
    }
}

typedef const __attribute__((address_space(4))) Params* ParamsK;
#define PHASE_FN __forceinline__
template <int PH, bool ALT = false>
__device__ PHASE_FN void run_phase(ParamsK pk_, const int layer, const int bid_, const int nb_, const int wv_) {
    ParamsK pk = pk_; asm volatile("" : "+s"(pk));
    int bid = bid_, nb = nb_, wv = wv_; asm volatile("" : "+s"(bid), "+s"(nb), "+s"(wv));
    const Params& p = *(const Params*)pk;
    unsigned char* ws = p.ws;
    const int lj = layer >> 1; const bool even = (layer & 1) == 0;
    bf16_t* H = (bf16_t*)(ws + WS_H);
    float* X = (float*)(ws + WS_X);
    bf16_t* YMIX = (bf16_t*)(ws + WS_YMIX);
    bf16_t* QX = (bf16_t*)(ws + WS_QX);
    bf16_t* OX = (bf16_t*)(ws + WS_OX);
    if constexpr (PH == PH_P0) { prologue0(p, bid, nb, wv); }
    if constexpr (PH == PH_P1) {
        for (int u = bid; u < 4 * 8 * 4; u += nb) {
            const int l = u >> 5, pm = (u >> 2) & 7, pn = u & 3;
            EpiSplit e{nullptr, (bf16_t*)(ws + WS_XK) + (size_t)l * 2048 * 512, (bf16_t*)(ws + WS_XVT) + (size_t)l * 512 * 2048, 0, 512, 512, (size_t)2048, pm * 256};
            gemm_tile((const bf16_t*)(ws + WS_MEMN) + (size_t)pm * 256 * 1024, (const bf16_t*)(ws + WS_W_CKV) + (size_t)l * 1024 * 1024, 1024, pn * 256, RowIdent{}, e, wv);
        }
        filter_taps(p, bid, nb, wv);
    }
    if constexpr (PH == PH_N1) { norm_phase<0, ALT>(p, layer, (even ? p.in[2] : p.in[16]) + (size_t)lj * D, bid, nb, wv); }
    if constexpr (PH == PH_GIN) {
        if (even) {
            EpiSplit e{(bf16_t*)(ws + WS_PROJ + PR_HYT), (bf16_t*)(ws + WS_PROJ + PR_QK), (bf16_t*)(ws + WS_PROJ + PR_VT), 1536, 2560, 1024, (size_t)NTOK, 0};
            gemm_dense(H, (const bf16_t*)(ws + WS_W_EIN) + (size_t)lj * 3072 * 1024, 1024, 64, 12, e, bid, nb, wv);
        } else {
            EpiSplit e{nullptr, (bf16_t*)(ws + WS_PROJ), (bf16_t*)(ws + WS_PROJ + PR_OVT), 0, 1280, 1280, (size_t)NTOK, 0};
            gemm_dense(H, (const bf16_t*)(ws + WS_W_OIN) + (size_t)lj * 1536 * 1024, 1024, 64, 6, e, bid, nb, wv);
        }
    }
    if constexpr (PH == PH_MIX) {
        if (even) {
            const bf16_t* qk = (const bf16_t*)(ws + WS_PROJ + PR_QK);
            const bf16_t* vT = (const bf16_t*)(ws + WS_PROJ + PR_VT);
            const float lam = ((const float*)(ws + WS_MISC))[lj];
            const float lam_init = 0.8f - 0.6f * expf(-0.3f * (float)layer);
            for (int u = bid + ((ALT && DUPSEL == 4) ? 512 : 0); u < ((ALT && (DUPSEL == 3 || DUPSEL >= 5)) ? 512 : 1024); u += nb) {
                if (u < 512) hyena_unit<ALT>(p, lj, u, wv);
                else {
                    const int id = u - 512, b = id >> 6, h = (id >> 4) & 3, qb = id & 15;
                    attn_unit<0>(qk + (size_t)(b * S) * 1024 + 2 * h * 64, 1024, qk + (size_t)(b * S) * 1024 + 512 + 2 * h * 64, 1024,
                                 vT + (size_t)(h * 128) * NTOK + b * S, (size_t)NTOK, qb * 128, 0, S,
                                 0.125f, exp2f(-2.0f * (float)(h + 1)), -1e30f, 0.f,
                                 YMIX + (size_t)(b * S) * D + 512 + h * 128, D, lam, 1.0f - lam_init, p.in[14] + (size_t)lj * 128, wv);
                }
            }
        } else {
            const bf16_t* qk = (const bf16_t*)(ws + WS_PROJ);
            const bf16_t* vT = (const bf16_t*)(ws + WS_PROJ + PR_OVT);
            for (int u = bid; u < 2048; u += nb) {
                const int b = u >> 8, hq = (u >> 4) & 15, qb = u & 15, kv = hq >> 2, q0 = qb * 128;
                const int kbeg = q0 - 128 < 0 ? 0 : q0 - 128, kend = q0 + 256 > S ? S : q0 + 256;
                attn_unit<1>(qk + (size_t)(b * S) * 1280 + hq * 64, 1280, qk + (size_t)(b * S) * 1280 + 1024 + kv * 64, 1280,
                             vT + (size_t)(kv * 64) * NTOK + b * S, (size_t)NTOK, q0, kbeg, kend,
                             0.125f, exp2f(-0.5f * (float)(hq + 1)), p.in[18][lj * 16 + hq], 1.0f,
                             YMIX + (size_t)(b * S) * D + hq * 64, D, 0.f, 1.f, nullptr, wv);
            }
        }
    }
    if constexpr (PH == PH_GOUT) {
        EpiRes e{X, 0, ALT ? (float*)(ws + WS_Y) : X};
        gemm_dense(YMIX, (const bf16_t*)(ws + (even ? WS_W_EOUT : WS_W_OOUT)) + (size_t)lj * 1024 * 1024, 1024, 64, 4, e, bid, nb, wv);
    }
    if constexpr (PH == PH_N2) { norm_phase<1>(p, layer, p.in[20] + (size_t)layer * D, bid, nb, wv); }
    if constexpr (PH == PH_GQ) {
        EpiSplit e{nullptr, QX, nullptr, 0, 512, 512, (size_t)NTOK, 0};
        gemm_dense(H, (const bf16_t*)(ws + WS_W_CQ) + (size_t)layer * 512 * 1024, 1024, 64, 2, e, bid, nb, wv);
    }
    if constexpr (PH == PH_XATT) {
        const bf16_t* xk = (const bf16_t*)(ws + WS_XK) + (size_t)layer * 2048 * 512;
        const bf16_t* xvt = (const bf16_t*)(ws + WS_XVT) + (size_t)layer * 512 * 2048;
        for (int u = bid; u < 512; u += nb) {
            const int b = u >> 6, h = (u >> 4) & 3, qb = u & 15;
            attn_unit<2>(QX + (size_t)(b * S) * 512 + h * 128, 512, xk + (size_t)(b * MEM) * 512 + h * 128, 512,
                         xvt + (size_t)(h * 128) * 2048 + b * MEM, (size_t)2048, qb * 128, 0, MEM,
                         0.08838834764831845f, 0.f, -1e30f, 0.f, OX + (size_t)(b * S) * 512 + h * 128, 512, 0.f, 1.f, nullptr, wv);
        }
    }
    if constexpr (PH == PH_GO) {
        EpiRes e{X, 0, ALT ? (float*)(ws + WS_Y) : X};
        gemm_dense(OX, (const bf16_t*)(ws + WS_W_CO) + (size_t)layer * 1024 * 512, 512, 64, 4, e, bid, nb, wv);
    }
    if constexpr (PH == PH_ROUTE) { route_phase<ALT>(p, layer, bid, nb, wv); }
    if constexpr (PH == PH_G1 || PH == PH_G2) {
        const int* CNT = (const int*)(ws + WS_CNT) + layer * NEXP * CNT_STRIDE;
        const int* LIST = (const int*)(ws + WS_LIST);
        int total = 0;
        for (int e = 0; e < NEXP; ++e) total += (CNT[e * CNT_STRIDE] + 255) >> 8;
        total = __builtin_amdgcn_readfirstlane(total);
        for (int u = bid; u < total * 4; u += nb) {
            int e = 0, base = 0, tl = 0, cnt = 0;
            for (; e < NEXP; ++e) { cnt = __builtin_amdgcn_readfirstlane(CNT[e * CNT_STRIDE]); tl = (cnt + 255) >> 8; if (u < base + tl * 4) break; base += tl * 4; }
            const int r = u - base, pn = r / tl, pm = r % tl;
            const int* list = LIST + (size_t)e * NTOK;
            if constexpr (PH == PH_G1) {
                EpiGateUp ep{(bf16_t*)(ws + WS_ACT), list, cnt, pm * 256, (const float*)(ws + WS_RSTD)};
                gemm_tile(H, (const bf16_t*)(ws + WS_W_GU) + ((size_t)layer * NEXP + e) * 1024 * 1024, 1024, pn * 256, RowTok{list, cnt, pm * 256}, ep, wv);
            } else {
                EpiDown ep{(bf16_t*)(ws + WS_Y), list, cnt, pm * 256};
                gemm_tile((const bf16_t*)(ws + WS_ACT), (const bf16_t*)(ws + WS_W_DN) + ((size_t)layer * NEXP + e) * 1024 * 512, 512, pn * 256, RowAsg{list, cnt, pm * 256}, ep, wv);
            }
        }
    }
    if constexpr (PH == PH_FINAL) { norm_phase<2>(p, DEPTH, p.in[33], bid, nb, wv); }
}

#if ONE_LAUNCH
__global__ void __launch_bounds__(NT, 2) k_mega(Params p_) {
    ParamsK p = (ParamsK)__builtin_amdgcn_kernarg_segment_ptr();
    volatile LAS unsigned* st = (volatile LAS unsigned*)((char*)shm + LDS_XB);
    if (threadIdx.x < 4) st[threadIdx.x] = 0u;
    __syncthreads();
    const XcdBarrier bar = xcd_barrier_post((unsigned*)(p->ws + WS_BAR), st);
    const int bid = blockIdx.x, nb = gridDim.x, wv = __builtin_amdgcn_readfirstlane(threadIdx.x >> 6);
    run_phase<PH_P0>(p, 0, bid, nb, wv); xcd_barrier(bar); if (DUP == PH_P0) { run_phase<PH_P0, true>(p, 0, bid, nb, wv); xcd_barrier(bar); }
    run_phase<PH_P1>(p, 0, bid, nb, wv); xcd_barrier(bar); if (DUP == PH_P1) { run_phase<PH_P1, true>(p, 0, bid, nb, wv); xcd_barrier(bar); }
#pragma unroll 1
    for (int layer = 0; layer < DEPTH; ++layer) {
        run_phase<PH_N1>(p, layer, bid, nb, wv); xcd_barrier(bar); if (DUP == PH_N1) { run_phase<PH_N1, true>(p, layer, bid, nb, wv); xcd_barrier(bar); }
        run_phase<PH_GIN>(p, layer, bid, nb, wv); xcd_barrier(bar); if (DUP == PH_GIN) { run_phase<PH_GIN, true>(p, layer, bid, nb, wv); xcd_barrier(bar); }
        run_phase<PH_MIX>(p, layer, bid, nb, wv); xcd_barrier(bar); if (DUP == PH_MIX && (DUPSEL == 0 || (DUPSEL != 2 && (layer & 1) == 0) || (DUPSEL == 2 && (layer & 1) == 1))) { run_phase<PH_MIX, true>(p, layer, bid, nb, wv); xcd_barrier(bar); }
        run_phase<PH_GOUT>(p, layer, bid, nb, wv); xcd_barrier(bar); if (DUP == PH_GOUT) { run_phase<PH_GOUT, true>(p, layer, bid, nb, wv); xcd_barrier(bar); }
        run_phase<PH_N2>(p, layer, bid, nb, wv); xcd_barrier(bar); if (DUP == PH_N2) { run_phase<PH_N2, true>(p, layer, bid, nb, wv); xcd_barrier(bar); }
        run_phase<PH_GQ>(p, layer, bid, nb, wv); xcd_barrier(bar); if (DUP == PH_GQ) { run_phase<PH_GQ, true>(p, layer, bid, nb, wv); xcd_barrier(bar); }
        run_phase<PH_XATT>(p, layer, bid, nb, wv); xcd_barrier(bar); if (DUP == PH_XATT) { run_phase<PH_XATT, true>(p, layer, bid, nb, wv); xcd_barrier(bar); }
        run_phase<PH_GO>(p, layer, bid, nb, wv); xcd_barrier(bar); if (DUP == PH_GO) { run_phase<PH_GO, true>(p, layer, bid, nb, wv); xcd_barrier(bar); }
        run_phase<PH_ROUTE>(p, layer, bid, nb, wv); xcd_barrier(bar); if (DUP == PH_ROUTE) { run_phase<PH_ROUTE, true>(p, layer, bid, nb, wv); xcd_barrier(bar); }
        run_phase<PH_G1>(p, layer, bid, nb, wv); xcd_barrier(bar); if (DUP == PH_G1) { run_phase<PH_G1, true>(p, layer, bid, nb, wv); xcd_barrier(bar); }
        run_phase<PH_G2>(p, layer, bid, nb, wv); xcd_barrier(bar); if (DUP == PH_G2) { run_phase<PH_G2, true>(p, layer, bid, nb, wv); xcd_barrier(bar); }
    }
    run_phase<PH_FINAL>(p, DEPTH, bid, nb, wv);
}
#else
template <int PH>
__global__ void __launch_bounds__(NT, 2) k_phase(Params p_, int layer) {
    run_phase<PH>((ParamsK)__builtin_amdgcn_kernarg_segment_ptr(), layer, blockIdx.x, gridDim.x, __builtin_amdgcn_readfirstlane(threadIdx.x >> 6));
}
template <int PH> static void launch_phase(const Params& p, int layer, int grid, hipStream_t stream) {
    static bool init = false;
    if (!init) { (void)hipFuncSetAttribute((const void*)k_phase<PH>, hipFuncAttributeMaxDynamicSharedMemorySize, LDS_BYTES); init = true; }
    hipLaunchKernelGGL(k_phase<PH>, dim3(grid), dim3(NT), LDS_BYTES, stream, p, layer);
}
#endif

extern "C" void kernel_launch(void* const* d_in, const int* in_sizes, int n_in, void* d_out, int out_size, void* d_ws, size_t ws_size, hipStream_t stream) {
    if (n_in != 34 || ws_size < WS_END) { fprintf(stderr, "kernel_launch: unexpected n_in %d or ws_size %zu (need %zu)\n", n_in, ws_size, (size_t)WS_END); return; }
    Params p{};
    for (int i = 0; i < 34; ++i) p.in[i] = (const float*)d_in[i];
    p.out = (float*)d_out; p.ws = (unsigned char*)d_ws;
    (void)hipMemsetAsync(d_ws, 0, WS_ZERO_BYTES, stream);
#if ONE_LAUNCH
    static int grid = 0;
    if (grid == 0) {
        int dev = 0, cus = 0, per_cu = 0;
        (void)hipGetDevice(&dev); (void)hipDeviceGetAttribute(&cus, hipDeviceAttributeMultiprocessorCount, dev);
        (void)hipFuncSetAttribute((const void*)k_mega, hipFuncAttributeMaxDynamicSharedMemorySize, LDS_BYTES);
        (void)hipOccupancyMaxActiveBlocksPerMultiprocessor(&per_cu, (const void*)k_mega, NT, LDS_BYTES);
        (void)hipGetLastError();
        grid = cus > 0 ? cus : 256;
    }
    hipLaunchKernelGGL(k_mega, dim3(grid), dim3(NT), LDS_BYTES, stream, p);
#else
    const int grid = 256;
    launch_phase<PH_P0>(p, 0, grid, stream);
    launch_phase<PH_P1>(p, 0, grid, stream);
    for (int layer = 0; layer < DEPTH; ++layer) {
        launch_phase<PH_N1>(p, layer, grid, stream);
        launch_phase<PH_GIN>(p, layer, grid, stream);
        launch_phase<PH_MIX>(p, layer, grid, stream);
        launch_phase<PH_GOUT>(p, layer, grid, stream);
        launch_phase<PH_N2>(p, layer, grid, stream);
        launch_phase<PH_GQ>(p, layer, grid, stream);
        launch_phase<PH_XATT>(p, layer, grid, stream);
        launch_phase<PH_GO>(p, layer, grid, stream);
        launch_phase<PH_ROUTE>(p, layer, grid, stream);
        launch_phase<PH_G1>(p, layer, grid, stream);
        launch_phase<PH_G2>(p, layer, grid, stream);
    }
    launch_phase<PH_FINAL>(p, DEPTH, grid, stream);
#endif
}
```

```cpp
#include <hip/hip_runtime.h>
#include <stdint.h>
#include <stdio.h>

#ifndef DUP
#define DUP -1
#endif
#ifndef DUPSEL
#define DUPSEL 0
#endif
#ifndef ONE_LAUNCH
#define ONE_LAUNCH 1
#endif

typedef unsigned short bf16_t;
typedef short bf16x8 __attribute__((ext_vector_type(8)));
typedef float f32x4 __attribute__((ext_vector_type(4)));
typedef unsigned u32x4 __attribute__((ext_vector_type(4)));
typedef unsigned u32x2 __attribute__((ext_vector_type(2)));

constexpr int Bb = 8, S = 2048, D = 1024, NTOK = Bb * S, DEPTH = 4, MEM = 256;
constexpr int NEXP = 32, EH = 512;
constexpr int NT = 512;
constexpr float EPS = 1e-6f;

constexpr size_t al256(size_t x) { return (x + 255) & ~(size_t)255; }
constexpr size_t WS_BAR   = 0;
constexpr size_t WS_CNT   = 16384;
constexpr int    CNT_STRIDE = 64;
constexpr size_t WS_QHEAD = 16384 + 65536;
constexpr size_t WS_DONE  = WS_QHEAD + 4096;
constexpr size_t WS_ZERO_BYTES = WS_DONE + (size_t)4 * 32 * 64 * 4;
constexpr size_t WS_MISC  = WS_ZERO_BYTES;
constexpr size_t WS_W_EIN = 131072;
constexpr size_t WS_W_EOUT = WS_W_EIN + (size_t)2 * 3072 * 1024 * 2;
constexpr size_t WS_W_OIN = WS_W_EOUT + (size_t)2 * 1024 * 1024 * 2;
constexpr size_t WS_W_OOUT = WS_W_OIN + (size_t)2 * 1536 * 1024 * 2;
constexpr size_t WS_W_CQ  = WS_W_OOUT + (size_t)2 * 1024 * 1024 * 2;
constexpr size_t WS_W_CKV = WS_W_CQ + (size_t)4 * 512 * 1024 * 2;
constexpr size_t WS_W_CO  = WS_W_CKV + (size_t)4 * 1024 * 1024 * 2;
constexpr size_t WS_W_GU  = WS_W_CO + (size_t)4 * 1024 * 512 * 2;
constexpr size_t WS_W_DN  = WS_W_GU + (size_t)4 * 32 * 1024 * 1024 * 2;
constexpr size_t WS_MEMN  = WS_W_DN + (size_t)4 * 32 * 1024 * 512 * 2;
constexpr size_t WS_XK    = WS_MEMN + (size_t)2048 * 1024 * 2;
constexpr size_t WS_XVT   = WS_XK + (size_t)4 * 2048 * 512 * 2;
constexpr size_t WS_A2    = WS_XVT + (size_t)4 * 2048 * 512 * 2;
constexpr size_t WS_FILT  = WS_A2 + (size_t)2 * 2048 * 64 * 4;
constexpr size_t WS_X     = WS_FILT + (size_t)2 * 2 * 512 * 4096 * 2;
constexpr size_t WS_H     = WS_X + (size_t)NTOK * D * 4;
constexpr size_t WS_PROJ  = WS_H + al256((size_t)(NTOK + 1) * D * 2);
constexpr size_t WS_YMIX  = WS_PROJ + (size_t)NTOK * 3072 * 2;
constexpr size_t WS_QX    = WS_YMIX + (size_t)NTOK * D * 2;
constexpr size_t WS_OX    = WS_QX + (size_t)NTOK * 512 * 2;
constexpr size_t WS_ACT   = WS_OX + (size_t)NTOK * 512 * 2;
constexpr size_t WS_Y     = WS_ACT + al256((size_t)(2 * NTOK + 1) * EH * 2);
constexpr size_t WS_LIST  = WS_Y + (size_t)2 * NTOK * D * 2;
constexpr size_t WS_WT    = WS_LIST + (size_t)NEXP * NTOK * 4;
constexpr size_t WS_RSTD  = WS_WT + (size_t)2 * NTOK * 4;
constexpr size_t WS_WRT   = WS_RSTD + (size_t)NTOK * 4;
constexpr size_t WS_END   = WS_WRT + (size_t)4 * 2 * 48 * 1024 * 2;
constexpr size_t PR_HYT   = 0;
constexpr size_t PR_QK    = (size_t)1536 * NTOK * 2;
constexpr size_t PR_VT    = PR_QK + (size_t)NTOK * 1024 * 2;
constexpr size_t PR_OVT   = (size_t)NTOK * 1280 * 2;

constexpr int LDS_XB = 147456;
constexpr int LDS_ROUTE = LDS_XB + 64;
constexpr int LDS_BYTES = LDS_ROUTE + 2048;

struct Params {
    const float* in[34];
    float* out;
    unsigned char* ws;
};

extern __shared__ __attribute__((aligned(16))) bf16_t shm[];

typedef float f32x2 __attribute__((ext_vector_type(2)));
typedef __bf16 bf16x2v __attribute__((ext_vector_type(2)));
__device__ __forceinline__ unsigned cvt_pk_bf16(float lo, float hi) { const f32x2 v = {lo, hi}; return __builtin_bit_cast(unsigned, __builtin_convertvector(v, bf16x2v)); }
__device__ __forceinline__ float bf2f(unsigned short b) { return __uint_as_float((unsigned)b << 16); }
__device__ __forceinline__ float bflo(unsigned w) { return __uint_as_float(w << 16); }
__device__ __forceinline__ float bfhi(unsigned w) { return __uint_as_float(w & 0xffff0000u); }
__device__ __forceinline__ float shx(float v, int m, int lane) { return __int_as_float(__builtin_amdgcn_ds_bpermute((lane ^ m) << 2, __float_as_int(v))); }
__device__ __forceinline__ float shl(float v, int src) { return __int_as_float(__builtin_amdgcn_ds_bpermute(src << 2, __float_as_int(v))); }
__device__ __forceinline__ float wave_sum(float v, int lane) {
    v += shx(v, 1, lane); v += shx(v, 2, lane); v += shx(v, 4, lane); v += shx(v, 8, lane); v += shx(v, 16, lane); v += shx(v, 32, lane); return v;
}

__device__ __forceinline__ float uni(float x) { return __builtin_bit_cast(float, __builtin_amdgcn_readfirstlane(__builtin_bit_cast(int, x))); }
__device__ __forceinline__ int hidden_tid(int wv) { int l; asm volatile("v_mbcnt_lo_u32_b32 %0, -1, 0\n\tv_mbcnt_hi_u32_b32 %0, -1, %0" : "=&v"(l)); return (wv << 6) | l; }

#define XB_TMO      128
#define XB_XCNT(j)  (256  + 64 * (j))
#define XB_XSUB(j)  (1280 + 64 * (j))
#define XB_XGEN(j)  (2304 + 64 * (j))
#define XB_TOP      3328
#define XB_TOPGEN   3392
#define XCD_BAR_WORDS 3456
#define XB_SPIN_CAP (1u << 22)
#define LAS __attribute__((address_space(3)))

__device__ __forceinline__ unsigned xb_ld(unsigned* p)              { return __hip_atomic_load(p, __ATOMIC_RELAXED, __HIP_MEMORY_SCOPE_AGENT); }
__device__ __forceinline__ unsigned xb_add(unsigned* p, unsigned v) { return __hip_atomic_fetch_add(p, v, __ATOMIC_RELAXED, __HIP_MEMORY_SCOPE_AGENT); }
__device__ __forceinline__ unsigned xb_xcc_id() { return (unsigned)__builtin_amdgcn_s_getreg((3 << 11) | 20) & 0xFu; }
#define XB_SPIN(cond, bar) do { unsigned _sp = 0; while (cond) { __builtin_amdgcn_s_sleep(1); \
    if ((++_sp & 255u) == 0u) { if (xb_ld(&(bar)[XB_TMO])) break; if (_sp > XB_SPIN_CAP) { atomicAdd(&(bar)[XB_TMO], 1u); break; } } } } while (0)

struct XcdBarrier { unsigned* bar; unsigned x; volatile LAS unsigned* st; };

__device__ __forceinline__ XcdBarrier xcd_barrier_post(unsigned* bar, volatile LAS unsigned* st) {
    XcdBarrier b; b.bar = bar; b.x = xb_xcc_id(); b.st = st;
    if (threadIdx.x == 0) (void)xb_add(&bar[XB_XCNT(b.x)], 1u);
    return b;
}
__device__ __forceinline__ void xcd_barrier_complete(unsigned* bar, unsigned x, unsigned& nloc, unsigned& nx) {
    const unsigned G = gridDim.x * gridDim.y * gridDim.z;
    unsigned sum, cnt, mine, sp = 0u;
    for (;;) {
        sum = 0u; cnt = 0u; mine = 0u;
#pragma unroll
        for (unsigned j = 0; j < 16; ++j) { const unsigned c = xb_ld(&bar[XB_XCNT(j)]); sum += c; cnt += (c > 0u) ? 1u : 0u; mine = (j == x) ? c : mine; }
        if (sum == G) break;
        __builtin_amdgcn_s_sleep(1);
        if ((++sp & 255u) == 0u) { if (xb_ld(&bar[XB_TMO])) break; if (sp > XB_SPIN_CAP) { atomicAdd(&bar[XB_TMO], 1u); break; } }
    }
    nloc = mine > 0u ? mine : 1u; nx = cnt > 0u ? cnt : 1u;
}
__device__ __forceinline__ void xcd_barrier(const XcdBarrier& b) {
    asm volatile("s_waitcnt vmcnt(0)" ::: "memory");
    __syncthreads();
    if (threadIdx.x == 0) {
        unsigned* bar = b.bar; unsigned bx = b.x;
        asm volatile("" : "+s"(bar), "+s"(bx));
        __builtin_amdgcn_s_waitcnt(0);
        unsigned nloc = b.st[0], nx = b.st[1];
        if (nloc == 0u) { xcd_barrier_complete(bar, bx, nloc, nx); b.st[0] = nloc; b.st[1] = nx; }
        const unsigned old = xb_add(&bar[XB_XSUB(bx)], 1u);
        const unsigned gen = old / nloc;
        if (old + 1u == (gen + 1u) * nloc) {
            __builtin_amdgcn_fence(__ATOMIC_RELEASE, "agent");
            asm volatile("s_waitcnt vmcnt(0)" ::: "memory");
            const unsigned og = xb_add(&bar[XB_TOP], 1u);
            const unsigned tg = og / nx;
            if (og + 1u == (tg + 1u) * nx) xb_add(&bar[XB_TOPGEN], 1u);
            else XB_SPIN(xb_ld(&bar[XB_TOPGEN]) == tg, bar);
            __builtin_amdgcn_fence(__ATOMIC_ACQUIRE, "agent");
            xb_add(&bar[XB_XGEN(bx)], 1u);
            asm volatile("s_waitcnt vmcnt(0)" ::: "memory");
        } else {
            XB_SPIN(xb_ld(&bar[XB_XGEN(bx)]) == gen, bar);
            __builtin_amdgcn_fence(__ATOMIC_ACQUIRE, "agent");
            asm volatile("s_waitcnt vmcnt(0)" ::: "memory");
        }
    }
    __syncthreads();
}

constexpr int HT = 128 * 64;
__device__ __forceinline__ int lds_byte(int r, int c) {
    int st = (r >> 4) * 2 + (c >> 5), rr = r & 15, cc = c & 31, ob = rr * 64 + cc * 2;
    return st * 1024 + (ob ^ (((ob >> 9) & 1) << 5));
}
__device__ __forceinline__ void stage_rc(int b, int& R, int& C) {
    int st = b / 1024, sb = b % 1024, swz = sb ^ (((sb >> 9) & 1) << 5);
    R = (st >> 1) * 16 + swz / 64; C = (st & 1) * 32 + (swz % 64) / 2;
}
#define SA(b, h) (shm + ((b) * 2 + (h)) * HT)
#define SB(b, h) (shm + (4 + (b) * 2 + (h)) * HT)
#define G_STAGE_A(P_, h, kt) do { _Pragma("unroll") for (int _i = 0; _i < 2; ++_i) \
    __builtin_amdgcn_global_load_lds((const unsigned*)((const char*)A + (size_t)((kt) * 128 + (RowSrc::DENSE ? (h) * 256 * K : 0)) + aoff[RowSrc::DENSE ? 0 : (h)][_i]), (unsigned*)((char*)(P_) + tid * 16 + _i * 8192), 16, 0, 0); } while (0)
#define G_STAGE_B(P_, h, kt) do { _Pragma("unroll") for (int _i = 0; _i < 2; ++_i) \
    __builtin_amdgcn_global_load_lds((const unsigned*)((const char*)Bt + (size_t)((kt) * 128 + (h) * 256 * K) + boff[_i]), (unsigned*)((char*)(P_) + tid * 16 + _i * 8192), 16, 0, 0); } while (0)
#define G_LDA(dst, b, h) _Pragma("unroll") for (int m = 0; m < 4; ++m) _Pragma("unroll") for (int k = 0; k < 2; ++k) \
    dst[m][k] = *reinterpret_cast<const bf16x8*>((char*)SA(b, h) + lds_byte(wr * 64 + m * 16 + fr, k * 32 + fq * 8))
#define G_LDB(dst, b, h) _Pragma("unroll") for (int n = 0; n < 2; ++n) _Pragma("unroll") for (int k = 0; k < 2; ++k) \
    dst[n][k] = *reinterpret_cast<const bf16x8*>((char*)SB(b, h) + lds_byte(wc * 32 + n * 16 + fr, k * 32 + fq * 8))
#define G_MMA(ai, bj, At_, Bt_) do { __builtin_amdgcn_s_setprio(1); \
    _Pragma("unroll") for (int m = 0; m < 4; ++m) _Pragma("unroll") for (int n = 0; n < 2; ++n) _Pragma("unroll") for (int k = 0; k < 2; ++k) \
      acc[ai][bj][m][n] = __builtin_amdgcn_mfma_f32_16x16x32_bf16(Bt_[n][k], At_[m][k], acc[ai][bj][m][n], 0, 0, 0); \
    __builtin_amdgcn_s_setprio(0); } while (0)
#define WAIT_V(n) asm volatile("s_waitcnt vmcnt(" #n ")" ::: "memory")
#define WAIT_L(n) asm volatile("s_waitcnt lgkmcnt(" #n ")" ::: "memory")
#define BAR __builtin_amdgcn_s_barrier()
#define SCHED __builtin_amdgcn_sched_barrier(0)

typedef f32x4 AccT[2][2][4][2];

template <class RowSrc, class Epi>
__device__ __forceinline__ void gemm_tile(const bf16_t* __restrict__ A, const bf16_t* __restrict__ Bt, const int K,
                                          const int bcol, const RowSrc& rs, const Epi& epi, const int wv) {
    const int tid = hidden_tid(wv);
    int wid = tid >> 6, lane = tid & 63, wr = wid >> 2, wc = wid & 3, fr = lane & 15, fq = lane >> 4;
    unsigned aoff[2][2], boff[2];
#pragma unroll
    for (int i = 0; i < 2; ++i) {
        int R, C; stage_rc(tid * 16 + i * 8192, R, C);
        boff[i] = (unsigned)(((bcol + R) * K + C) * 2);
        if (RowSrc::DENSE) { aoff[0][i] = (unsigned)((R * K + C) * 2); aoff[1][i] = 0u; }
        else {
#pragma unroll
            for (int h = 0; h < 2; ++h) aoff[h][i] = (unsigned)((rs(h * 128 + R) * K + C) * 2);
        }
    }
    WAIT_V(0);
    AccT acc = {};
    bf16x8 At[4][2], B0[2][2], B1[2][2];
    const int nt = K / 64;
    G_STAGE_B(SB(0, 0), 0, 0); G_STAGE_A(SA(0, 0), 0, 0);
    G_STAGE_B(SB(0, 1), 1, 0); G_STAGE_A(SA(0, 1), 1, 0);
    if (wr == 1) BAR;
    WAIT_V(4); BAR;
    G_STAGE_B(SB(1, 0), 0, 1); G_STAGE_A(SA(1, 0), 0, 1); G_STAGE_B(SB(1, 1), 1, 1);
    WAIT_V(6); BAR;
    for (int t = 0; t < nt - 2; t += 2) {
        G_LDB(B0, 0, 0); SCHED; G_LDA(At, 0, 0); G_STAGE_A(SA(1, 1), 1, t + 1);
        WAIT_L(8); BAR; WAIT_L(0); G_MMA(0, 0, At, B0); BAR; SCHED;
        G_LDB(B1, 0, 1); G_STAGE_B(SB(0, 0), 0, t + 2);
        BAR; WAIT_L(0); G_MMA(0, 1, At, B1); BAR;
        G_LDA(At, 0, 1); G_STAGE_A(SA(0, 0), 0, t + 2);
        BAR; WAIT_L(0); G_MMA(1, 0, At, B0); BAR; SCHED;
        G_STAGE_B(SB(0, 1), 1, t + 2);
        WAIT_V(6); BAR; G_MMA(1, 1, At, B1); BAR;
        G_LDB(B0, 1, 0); SCHED; G_LDA(At, 1, 0); G_STAGE_A(SA(0, 1), 1, t + 2);
        WAIT_L(8); BAR; WAIT_L(0); G_MMA(0, 0, At, B0); BAR; SCHED;
        G_LDB(B1, 1, 1); G_STAGE_B(SB(1, 0), 0, t + 3);
        BAR; WAIT_L(0); G_MMA(0, 1, At, B1); BAR;
        G_LDA(At, 1, 1); G_STAGE_A(SA(1, 0), 0, t + 3);
        BAR; WAIT_L(0); G_MMA(1, 0, At, B0); BAR; SCHED;
        G_STAGE_B(SB(1, 1), 1, t + 3);
        WAIT_V(6); BAR; G_MMA(1, 1, At, B1); BAR;
    }
    { G_LDB(B0, 0, 0); WAIT_V(0); G_LDA(At, 0, 0); G_STAGE_A(SA(1, 1), 1, nt - 1);
      BAR; WAIT_L(0); G_MMA(0, 0, At, B0); BAR;
      G_LDB(B1, 0, 1); BAR; WAIT_L(0); G_MMA(0, 1, At, B1); BAR;
      G_LDA(At, 0, 1); WAIT_V(4); BAR; WAIT_L(0); G_MMA(1, 0, At, B0); G_MMA(1, 1, At, B1); BAR; }
    { G_LDB(B0, 1, 0); G_LDA(At, 1, 0); WAIT_V(2); BAR; WAIT_L(0); G_MMA(0, 0, At, B0); BAR;
      G_LDB(B1, 1, 1); WAIT_V(0); BAR; WAIT_L(0); G_MMA(0, 1, At, B1); BAR;
      G_LDA(At, 1, 1); BAR; WAIT_L(0); G_MMA(1, 0, At, B0); G_MMA(1, 1, At, B1); BAR; }
    if (wr == 0) BAR;
    int tz = hidden_tid(wv); wid = tz >> 6; lane = tz & 63; wr = wid >> 2; wc = wid & 3; fr = lane & 15; fq = lane >> 4;
    epi(acc, wr * 64 + fr, bcol + wc * 32 + fq * 4);
}

struct RowIdent { static constexpr bool DENSE = true; __device__ __forceinline__ int operator()(int r) const { return r; } };

__device__ __forceinline__ void st_bf16x4(bf16_t* p, const f32x4& v) { u32x2 w; w.x = cvt_pk_bf16(v[0], v[1]); w.y = cvt_pk_bf16(v[2], v[3]); *(u32x2*)p = w; }
__device__ __forceinline__ void st_chan4(bf16_t* q, size_t ld, const f32x4& v) {
    const unsigned a = cvt_pk_bf16(v[0], v[1]), b = cvt_pk_bf16(v[2], v[3]);
    q[0] = (bf16_t)(a & 0xffff); q[ld] = (bf16_t)(a >> 16); q[2 * ld] = (bf16_t)(b & 0xffff); q[3 * ld] = (bf16_t)(b >> 16);
}
#define EPI_LOOP_AM _Pragma("unroll") for (int ai = 0; ai < 2; ++ai) _Pragma("unroll") for (int m = 0; m < 4; ++m)
#define EPI_LOOP_BN _Pragma("unroll") for (int bj = 0; bj < 2; ++bj) _Pragma("unroll") for (int n = 0; n < 2; ++n)
struct EpiRes {
    float* X; int brow; float* Xo;
    __device__ __forceinline__ void operator()(AccT& acc, int r0, int c0) const {
        EPI_LOOP_AM {
            const size_t off = (size_t)(brow + r0 + ai * 128 + m * 16) * D + c0;
            float* q = X + off; float* qo = Xo + off;
            EPI_LOOP_BN { *(f32x4*)(qo + bj * 128 + n * 16) = *(const f32x4*)(q + bj * 128 + n * 16) + acc[ai][bj][m][n]; }
            asm volatile("" ::: "memory");
        }
    }
};
struct EpiSplit {
    bf16_t* Ca; bf16_t* T; bf16_t* Cb; int c0s, c1s, ldT; size_t ldC; int brow;
    __device__ __forceinline__ void chan(AccT& acc, bf16_t* base, int r0, int c) const {
        EPI_LOOP_AM { bf16_t* q = base + (size_t)c * ldC + (brow + r0 + ai * 128 + m * 16);
            EPI_LOOP_BN st_chan4(q + (size_t)(bj * 128 + n * 16) * ldC, ldC, acc[ai][bj][m][n]); }
    }
    __device__ __forceinline__ void operator()(AccT& acc, int r0, int c0) const {
        const int tilec = __builtin_amdgcn_readfirstlane(c0) & ~255;
        if (tilec < c0s) chan(acc, Ca, r0, c0);
        else if (tilec < c1s) {
            EPI_LOOP_AM { bf16_t* q = T + (size_t)(brow + r0 + ai * 128 + m * 16) * ldT + (c0 - c0s);
                EPI_LOOP_BN st_bf16x4(q + bj * 128 + n * 16, acc[ai][bj][m][n]); }
        } else chan(acc, Cb, r0, c0 - c1s);
    }
};
struct EpiGateUp {
    bf16_t* act; const int* list; int cnt, pos0; const float* rstd;
    __device__ __forceinline__ void operator()(AccT& acc, int r0, int c0) const {
        EPI_LOOP_AM {
            const int pos = pos0 + r0 + ai * 128 + m * 16;
            if (pos < cnt) {
                const int a = list[pos];
                const float rs = rstd[a >> 1];
#pragma unroll
                for (int bj = 0; bj < 2; ++bj) {
                    const f32x4 g = acc[ai][bj][m][0] * rs, u = acc[ai][bj][m][1] * rs; f32x4 o;
#pragma unroll
                    for (int j = 0; j < 4; ++j) o[j] = g[j] / (1.0f + __expf(-g[j])) * u[j];
                    const int col = c0 + bj * 128;
                    const unsigned long long wv8 = ((unsigned long long)cvt_pk_bf16(o[2], o[3]) << 32) | cvt_pk_bf16(o[0], o[1]);
                    __hip_atomic_store((unsigned long long*)(act + (size_t)a * EH + (col >> 5) * 16 + (col & 15)), wv8, __ATOMIC_RELAXED, __HIP_MEMORY_SCOPE_AGENT);
                }
            }
        }
    }
};
struct EpiDown {
    bf16_t* y; const int* list; int cnt, pos0;
    __device__ __forceinline__ void operator()(AccT& acc, int r0, int c0) const {
        EPI_LOOP_AM {
            const int pos = pos0 + r0 + ai * 128 + m * 16;
            if (pos < cnt) { bf16_t* q = y + (size_t)list[pos] * D + c0; EPI_LOOP_BN st_bf16x4(q + bj * 128 + n * 16, acc[ai][bj][m][n]); }
        }
    }
};
struct RowTok { static constexpr bool DENSE = false; const int* list; int cnt, pos0; __device__ __forceinline__ int operator()(int r) const { const int pos = pos0 + r; return pos < cnt ? (list[pos] >> 1) : NTOK; } };
struct RowAsg { static constexpr bool DENSE = false; const int* list; int cnt, pos0; __device__ __forceinline__ int operator()(int r) const { const int pos = pos0 + r; return pos < cnt ? list[pos] : 2 * NTOK; } };

constexpr int ATT_VOFF = 16384;
template <int MODE> struct ACfg;
template <> struct ACfg<0> { static constexpr int DQK = 64, DV = 128, NMAP = 2, KBLK = 2; };
template <> struct ACfg<1> { static constexpr int DQK = 64, DV = 64, NMAP = 1, KBLK = 1; };
template <> struct ACfg<2> { static constexpr int DQK = 128, DV = 128, NMAP = 1, KBLK = 2; };

template <int MODE, bool ALT = false>
__device__ __forceinline__ void attn_unit(const bf16_t* __restrict__ Qp, const int ldq,
                                          const bf16_t* __restrict__ Kp, const int ldk,
                                          const bf16_t* __restrict__ Vt, const size_t ldvt,
                                          const int q0, const int kbeg, const int kend,
                                          const float scale, const float slope, const float m_init, const float l_init,
                                          bf16_t* __restrict__ Op, const int ldo,
                                          const float lam, const float outscale, const float* __restrict__ subln, const int wv) {
    constexpr int DQK = ACfg<MODE>::DQK, DV = ACfg<MODE>::DV, NMAP = ACfg<MODE>::NMAP, KBLK = ACfg<MODE>::KBLK;
    const int tid = hidden_tid(wv), w = tid >> 6, lane = tid & 63, fr = lane & 15, fq = lane >> 4;
    const int qrow = q0 + w * 16 + fr;
    bf16x8 Qf[NMAP][DQK / 32];
#pragma unroll
    for (int m = 0; m < NMAP; ++m)
#pragma unroll
        for (int kk = 0; kk < DQK / 32; ++kk) Qf[m][kk] = *(const bf16x8*)(Qp + (size_t)qrow * ldq + m * DQK + kk * 32 + fq * 8);
    constexpr float LOG2E = 1.4426950408889634f;
    const float scale2 = scale * LOG2E, slope2 = slope * LOG2E, kappa = slope / scale;
    f32x4 Cpos[4], Cneg[4];
#pragma unroll
    for (int t = 0; t < 4; ++t)
#pragma unroll
        for (int r = 0; r < 4; ++r) { const float cl = (float)(16 * t + 4 * fq + r); Cpos[t][r] = kappa * cl; Cneg[t][r] = -kappa * cl; }
    f32x4 O[NMAP][DV / 16], Ol[NMAP];
    float mrun[NMAP];
#pragma unroll
    for (int m = 0; m < NMAP; ++m) {
        mrun[m] = m_init * LOG2E; Ol[m] = (f32x4){(fq == 0) ? l_init : 0.f, 0.f, 0.f, 0.f};
#pragma unroll
        for (int et = 0; et < DV / 16; ++et) O[m][et] = (f32x4){0.f, 0.f, 0.f, 0.f};
    }
    const unsigned onesw = (fr == 0) ? 0x3f803f80u : 0u;
    const bf16x8 onesf = __builtin_bit_cast(bf16x8, (u32x4){onesw, onesw, onesw, onesw});
    char* const lds = (char*)shm;
    constexpr int KN = KBLK, VN = DV / 64;
    u32x4 kreg[KN], vreg[VN];
#define ATT_LOAD(k0_) do { \
        _Pragma("unroll") for (int i_ = 0; i_ < KN; ++i_) { const int c_ = tid + i_ * NT; const int key_ = c_ / (KBLK * 8), col_ = (c_ % (KBLK * 8)) * 8; \
            kreg[i_] = *(const u32x4*)(Kp + (size_t)((k0_) + key_) * ldk + col_); } \
        _Pragma("unroll") for (int i_ = 0; i_ < VN; ++i_) { const int c_ = tid + i_ * NT; const int e_ = c_ >> 3, kc_ = c_ & 7; \
            vreg[i_] = *(const u32x4*)(Vt + (size_t)e_ * ldvt + (k0_) + kc_ * 8); } } while (0)
    ATT_LOAD(kbeg);
    const int qw0 = q0 + w * 16;
    const bool lag = (w >= 4);
    constexpr int VBYTES = DV * 160;
    bf16x8 Pf[NMAP][2];
    if (ALT) {
#pragma unroll
        for (int m = 0; m < NMAP; ++m) { Pf[m][0] = onesf; Pf[m][1] = onesf; }
    }
#define ATT_PV(voff_) do { \
        _Pragma("unroll") for (int c = 0; c < 2; ++c) { \
            bf16x8 vf[DV / 16]; \
            _Pragma("unroll") for (int et = 0; et < DV / 16; ++et) { \
                vf[et] = *(const bf16x8*)(lds + (voff_) + (et * 16 + fr) * 160 + c * 64 + fq * 16); } \
            _Pragma("unroll") for (int m = 0; m < NMAP; ++m) Ol[m] = __builtin_amdgcn_mfma_f32_16x16x32_bf16(onesf, Pf[m][c], Ol[m], 0, 0, 0); \
            _Pragma("unroll") for (int et = 0; et < DV / 16; ++et) \
                _Pragma("unroll") for (int m = 0; m < NMAP; ++m) O[m][et] = __builtin_amdgcn_mfma_f32_16x16x32_bf16(vf[et], Pf[m][c], O[m][et], 0, 0, 0); \
        } } while (0)
    int vcur = ATT_VOFF;
    for (int k0 = kbeg; k0 < kend; k0 += 64) {
        if (!(ALT && (DUPSEL == 11 || DUPSEL == 12))) __syncthreads();
#pragma unroll
        for (int i = 0; i < KN; ++i) { const int c = tid + i * NT; const int key = c / (KBLK * 8), col = (c % (KBLK * 8)) * 8;
            *(u32x4*)(lds + (col >> 6) * 8192 + lds_byte(key, col & 63)) = kreg[i]; }
#pragma unroll
        for (int i = 0; i < VN; ++i) { const int c = tid + i * NT; const int e = c >> 3, kc = c & 7;
            char* vd = lds + vcur + e * 160 + (kc >> 2) * 64 + (kc & 1) * 32 + ((kc >> 1) & 1) * 8;
            *(u32x2*)vd = (u32x2){vreg[i].x, vreg[i].y}; *(u32x2*)(vd + 16) = (u32x2){vreg[i].z, vreg[i].w}; }
        if (!(ALT && (DUPSEL == 11 || DUPSEL == 12))) __syncthreads();
        if (k0 + 64 < kend && !(ALT && (DUPSEL == 7 || DUPSEL == 11))) ATT_LOAD(k0 + 64);
        if (lag && k0 > kbeg && !(ALT && DUPSEL == 10)) ATT_PV(vcur ^ ATT_VOFF ^ (ATT_VOFF + VBYTES));
        const float dq = (float)(qrow - k0);
        bool gen;
        if (MODE == 2) gen = false;
        else if (MODE == 1) gen = !((k0 + 63 <= qw0 && qw0 + 15 - k0 <= 128) || (k0 >= qw0 + 15 && k0 + 63 - qw0 <= 128));
        else gen = !(k0 + 63 <= qw0 || k0 >= qw0 + 15);
        const bool pos = (MODE == 2) || (k0 + 63 <= qw0);
        f32x4 Cin[4]; float off;
        if (gen) {
#pragma unroll
            for (int t = 0; t < 4; ++t)
#pragma unroll
                for (int r = 0; r < 4; ++r) Cin[t][r] = -kappa * fabsf(dq - (float)(16 * t + 4 * fq + r));
            off = 0.f;
        } else if (pos) {
#pragma unroll
            for (int t = 0; t < 4; ++t) Cin[t] = Cpos[t];
            off = -slope2 * dq;
        } else {
#pragma unroll
            for (int t = 0; t < 4; ++t) Cin[t] = Cneg[t];
            off = slope2 * dq;
        }
        if (!(ALT && (DUPSEL == 9 || DUPSEL == 11)))
#pragma unroll
        for (int m = 0; m < NMAP; ++m) {
            f32x4 s[4];
            bf16x8 kf[4][DQK / 32];
#pragma unroll
            for (int t = 0; t < 4; ++t)
#pragma unroll
                for (int kk = 0; kk < DQK / 32; ++kk) {
                    const int blk = (MODE == 2) ? (kk >> 1) : m, kcol = (MODE == 2) ? (kk & 1) * 32 : kk * 32;
                    kf[t][kk] = *(const bf16x8*)(lds + blk * 8192 + lds_byte(t * 16 + fr, kcol + fq * 8));
                }
#pragma unroll
            for (int t = 0; t < 4; ++t) {
                s[t] = Cin[t];
#pragma unroll
                for (int kk = 0; kk < DQK / 32; ++kk) s[t] = __builtin_amdgcn_mfma_f32_16x16x32_bf16(kf[t][kk], Qf[m][kk], s[t], 0, 0, 0);
            }
            if (MODE == 1 && gen) {
#pragma unroll
                for (int t = 0; t < 4; ++t)
#pragma unroll
                    for (int r = 0; r < 4; ++r) s[t][r] = (fabsf(dq - (float)(16 * t + 4 * fq + r)) > 128.0f) ? -1e30f : s[t][r];
            }
            float mx = fmaxf(fmaxf(s[0][0], s[0][1]), fmaxf(s[0][2], s[0][3]));
#pragma unroll
            for (int t = 1; t < 4; ++t) mx = fmaxf(mx, fmaxf(fmaxf(s[t][0], s[t][1]), fmaxf(s[t][2], s[t][3])));
            mx = fmaxf(mx, shx(mx, 16, lane)); mx = fmaxf(mx, shx(mx, 32, lane));
            const float mtile = fmaxf(mx * scale2 + off, -1e30f);
            const float mnew = fmaxf(mrun[m], mtile), alpha = __builtin_amdgcn_exp2f(mrun[m] - mnew);
            mrun[m] = mnew;
            const float sub = off - mnew;
#pragma unroll
            for (int t = 0; t < 4; ++t)
#pragma unroll
                for (int r = 0; r < 4; ++r) s[t][r] = __builtin_amdgcn_exp2f(s[t][r] * scale2 + sub);
            if (__builtin_amdgcn_ballot_w64(alpha != 1.0f) != 0ull) {
                Ol[m] *= alpha;
#pragma unroll
                for (int et = 0; et < DV / 16; ++et) O[m][et] *= alpha;
            }
#pragma unroll
            for (int c = 0; c < 2; ++c) {
                u32x4 pk; pk.x = cvt_pk_bf16(s[2 * c][0], s[2 * c][1]); pk.y = cvt_pk_bf16(s[2 * c][2], s[2 * c][3]);
                pk.z = cvt_pk_bf16(s[2 * c + 1][0], s[2 * c + 1][1]); pk.w = cvt_pk_bf16(s[2 * c + 1][2], s[2 * c + 1][3]);
                Pf[m][c] = __builtin_bit_cast(bf16x8, pk);
            }
        }
        if (!lag && !(ALT && DUPSEL == 10)) ATT_PV(vcur);
        vcur ^= ATT_VOFF ^ (ATT_VOFF + VBYTES);
    }
    if (lag) ATT_PV(vcur ^ ATT_VOFF ^ (ATT_VOFF + VBYTES));
    float linv[NMAP];
#pragma unroll
    for (int m = 0; m < NMAP; ++m) linv[m] = 1.0f / shl(Ol[m][0], fr);
    const int tid2 = hidden_tid(wv); const int qrow_o = q0 + (tid2 >> 6) * 16 + (tid2 & 15);
    if (MODE == 0) {
        float ss = 0.f;
#pragma unroll
        for (int et = 0; et < DV / 16; ++et)
#pragma unroll
            for (int r = 0; r < 4; ++r) { const float v = O[0][et][r] * linv[0] - lam * (O[NMAP - 1][et][r] * linv[NMAP - 1]); O[0][et][r] = v; ss += v * v; }
        ss += shx(ss, 16, lane); ss += shx(ss, 32, lane);
        const float rs = rsqrtf(ss * (1.0f / 128.0f) + EPS) * outscale;
#pragma unroll
        for (int et = 0; et < DV / 16; ++et) {
            const f32x4 g = *(const f32x4*)(subln + et * 16 + fq * 4);
            st_bf16x4(Op + (size_t)qrow_o * ldo + et * 16 + fq * 4, O[0][et] * rs * g);
        }
    } else {
#pragma unroll
        for (int et = 0; et < DV / 16; ++et) st_bf16x4(Op + (size_t)qrow_o * ldo + et * 16 + fq * 4, O[0][et] * linv[0]);
    }
}

constexpr int HZ_RS = 4896;
constexpr int HZ_PAD = 192;
constexpr int H_CPS = 8256;
constexpr int H_ZOFF = 0, H_CPOFF = 8 * HZ_RS, H_RAWOFF = H_CPOFF + 8 * H_CPS;

template <bool ALT>
__device__ __forceinline__ void hyena_unit(const Params& p, const int lj  , const int c, const int wv) {
    const int tid = hidden_tid(wv), w = tid >> 6, lane = tid & 63, fr = lane & 15, fq = lane >> 4;
    char* const lds = (char*)shm;
    const bf16_t* hyT = (const bf16_t*)(p.ws + WS_PROJ + PR_HYT);
    const float* cw = p.in[4] + (size_t)lj * 3 * 1536; const float* cb = p.in[5] + (size_t)lj * 1536;
    const int nb = fr >> 1, tbp = fr & 1;
    __syncthreads();
    for (int i = tid; i < 8 * 2 * (HZ_PAD / 8); i += NT) {
        const int b = i / (2 * (HZ_PAD / 8)), r = i % (2 * (HZ_PAD / 8)), side = r / (HZ_PAD / 8), k = r % (HZ_PAD / 8);
        unsigned zz0 = 0u; asm volatile("" : "+v"(zz0));
        *(u32x4*)(lds + H_ZOFF + b * HZ_RS + (side ? (HZ_PAD + 2048) * 2 : 0) + k * 16) = (u32x4){zz0, zz0, zz0, zz0};
        if (i < 2) *(u32x4*)(lds + H_RAWOFF + 8192 + i * 16) = (u32x4){zz0, zz0, zz0, zz0};
    }
    {
        const float w0 = cw[c], w1 = cw[1536 + c], w2 = cw[2 * 1536 + c], bb = cb[c];
        const bf16_t* src = hyT + (size_t)c * NTOK;
        u32x4 v[4]; unsigned short um[4], up[4];
#pragma unroll
        for (int k = 0; k < 4; ++k) {
            const int i = tid + k * NT, b = i >> 8, s0 = (i & 255) * 8;
            const bf16_t* q = src + b * S + s0;
            v[k] = *(const u32x4*)q; um[k] = q[s0 > 0 ? -1 : 0]; up[k] = q[s0 + 8 < S ? 8 : 7];
        }
#pragma unroll
        for (int k = 0; k < 4; ++k) {
            const int i = tid + k * NT, b = i >> 8, s0 = (i & 255) * 8;
            float u[10];
            u[0] = (s0 > 0) ? bf2f(um[k]) : 0.f; u[9] = (s0 + 8 < S) ? bf2f(up[k]) : 0.f;
            u[1] = bflo(v[k].x); u[2] = bfhi(v[k].x); u[3] = bflo(v[k].y); u[4] = bfhi(v[k].y); u[5] = bflo(v[k].z); u[6] = bfhi(v[k].z); u[7] = bflo(v[k].w); u[8] = bfhi(v[k].w);
            float o[8];
#pragma unroll
            for (int j = 0; j < 8; ++j) o[j] = w0 * u[j] + w1 * u[j + 1] + w2 * u[j + 2] + bb;
            u32x4 ov; ov.x = cvt_pk_bf16(o[0], o[1]); ov.y = cvt_pk_bf16(o[2], o[3]); ov.z = cvt_pk_bf16(o[4], o[5]); ov.w = cvt_pk_bf16(o[6], o[7]);
            *(u32x4*)(lds + H_ZOFF + b * HZ_RS + (HZ_PAD + s0) * 2) = ov;
        }
    }
#pragma unroll 1
    for (int order = 0; order < 2; ++order) {
        const int gch = 512 * (order + 1) + c;
        const bf16_t* gsrc = hyT + (size_t)gch * NTOK;
        u32x2 gv[2][4]; unsigned short gm[2][4], gp[2][4];
        u32x4 rawv;
        {
            const bf16_t* f = (const bf16_t*)(p.ws + WS_FILT) + ((size_t)(lj * 2 + order) * 512 + c) * 4096;
            rawv = *(const u32x4*)(f + tid * 8);
#pragma unroll
            for (int ci = 0; ci < 2; ++ci)
#pragma unroll
                for (int mt = 0; mt < 4; ++mt) {
                    const int t = 64 * (4 * w + 2 * ci + tbp) + 16 * mt + 4 * fq;
                    const bf16_t* gq = gsrc + nb * S + t;
                    gv[ci][mt] = *(const u32x2*)gq; gm[ci][mt] = gq[t > 0 ? -1 : 0]; gp[ci][mt] = gq[t + 4 < S ? 4 : 3];
                }
        }
        *(u32x4*)(lds + H_RAWOFF + tid * 16) = rawv;
        __syncthreads();
        {
            const bf16_t* raw = (const bf16_t*)(lds + H_RAWOFF);
            const int o = w;
#pragma unroll
            for (int k = 0; k < 8; ++k) {
                const int a = lane + 64 * k;
                unsigned short e[8];
#pragma unroll
                for (int j = 0; j < 8; ++j) e[j] = raw[8 * a + o + j];
                u32x4 ov; ov.x = e[0] | ((unsigned)e[1] << 16); ov.y = e[2] | ((unsigned)e[3] << 16); ov.z = e[4] | ((unsigned)e[5] << 16); ov.w = e[6] | ((unsigned)e[7] << 16);
                *(u32x4*)(lds + H_CPOFF + o * H_CPS + a * 16) = ov;
            }
        }
        __syncthreads();
        f32x4 acc[2][4];
#pragma unroll
        for (int ci = 0; ci < 2; ++ci)
#pragma unroll
            for (int mt = 0; mt < 4; ++mt) acc[ci][mt] = (f32x4){0.f, 0.f, 0.f, 0.f};
        {
            const int acp = H_CPOFF + (7 - (fr & 7)) * H_CPS + (255 - (fr >> 3) + fq) * 16;
            const int zb = H_ZOFF + nb * HZ_RS + (HZ_PAD + 8 * fq) * 2;
            for (int dl = 4 * w - 31; dl <= ((ALT && DUPSEL >= 5) ? 4 * w - 31 : 4 * w + 3); ++dl) {
#pragma unroll
                for (int kh = 0; kh < 2; ++kh) {
                    bf16x8 Bf[2];
#pragma unroll
                    for (int ci = 0; ci < 2; ++ci) {
                        const int sblk = 4 * w + 2 * ci + tbp - dl;
                        Bf[ci] = *(const bf16x8*)(lds + zb + (64 * sblk + 32 * kh) * 2);
                    }
#pragma unroll
                    for (int mt = 0; mt < 4; ++mt) {
                        const int q = 4 * dl + mt - 2 * kh;
                        const bf16x8 Af = *(const bf16x8*)(lds + acp - 32 * q);
#pragma unroll
                        for (int ci = 0; ci < 2; ++ci) acc[ci][mt] = __builtin_amdgcn_mfma_f32_16x16x32_bf16(Af, Bf[ci], acc[ci][mt], 0, 0, 0);
                    }
                }
            }
        }
        const float hb = p.in[12][(size_t)(lj * 2 + order) * 512 + c];
        const float w0 = cw[gch], w1 = cw[1536 + gch], w2 = cw[2 * 1536 + gch], bb = cb[gch];
        u32x2 zout[2][4];
#pragma unroll
        for (int ci = 0; ci < 2; ++ci)
#pragma unroll
            for (int mt = 0; mt < 4; ++mt) {
                const int t = 64 * (4 * w + 2 * ci + tbp) + 16 * mt + 4 * fq;
                const u32x2 zz = *(const u32x2*)(lds + H_ZOFF + nb * HZ_RS + (HZ_PAD + t) * 2);
                float u[6];
                u[0] = (t > 0) ? bf2f(gm[ci][mt]) : 0.f; u[5] = (t + 4 < S) ? bf2f(gp[ci][mt]) : 0.f;
                u[1] = bflo(gv[ci][mt].x); u[2] = bfhi(gv[ci][mt].x); u[3] = bflo(gv[ci][mt].y); u[4] = bfhi(gv[ci][mt].y);
                const float z[4] = {bflo(zz.x), bfhi(zz.x), bflo(zz.y), bfhi(zz.y)};
                float o[4];
#pragma unroll
                for (int r = 0; r < 4; ++r) {
                    const float gate = w0 * u[r] + w1 * u[r + 1] + w2 * u[r + 2] + bb;
                    o[r] = gate * (acc[ci][mt][r] + hb * z[r]);
                }
                zout[ci][mt].x = cvt_pk_bf16(o[0], o[1]); zout[ci][mt].y = cvt_pk_bf16(o[2], o[3]);
            }
        __syncthreads();
        if (order == 0) {
#pragma unroll
            for (int ci = 0; ci < 2; ++ci)
#pragma unroll
                for (int mt = 0; mt < 4; ++mt) {
                    const int t = 64 * (4 * w + 2 * ci + tbp) + 16 * mt + 4 * fq;
                    *(u32x2*)(lds + H_ZOFF + nb * HZ_RS + (HZ_PAD + t) * 2) = zout[ci][mt];
                }
        } else if (!(ALT && DUPSEL >= 6)) {
            bf16_t* ym = (bf16_t*)(p.ws + (ALT ? WS_Y : WS_YMIX));
#pragma unroll
            for (int ci = 0; ci < 2; ++ci)
#pragma unroll
                for (int mt = 0; mt < 4; ++mt) {
                    const int t = 64 * (4 * w + 2 * ci + tbp) + 16 * mt + 4 * fq;
                    bf16_t* q = ym + (size_t)(nb * S + t) * D + c;
                    q[0] = (bf16_t)(zout[ci][mt].x & 0xffff); q[D] = (bf16_t)(zout[ci][mt].x >> 16);
                    q[2 * D] = (bf16_t)(zout[ci][mt].y & 0xffff); q[3 * D] = (bf16_t)(zout[ci][mt].y >> 16);
                }
        }
        __syncthreads();
    }
}

struct Row16 { f32x4 v[4]; };
__device__ __forceinline__ void ld_row(Row16& r, const float* src, int lane) {
#pragma unroll
    for (int i = 0; i < 4; ++i) r.v[i] = *(const f32x4*)(src + 256 * i + 4 * lane);
}
__device__ __forceinline__ float row_rstd(const Row16& r, int lane) {
    float ss = 0.f;
#pragma unroll
    for (int i = 0; i < 4; ++i) ss += r.v[i][0] * r.v[i][0] + r.v[i][1] * r.v[i][1] + r.v[i][2] * r.v[i][2] + r.v[i][3] * r.v[i][3];
    ss = wave_sum(ss, lane);
    return rsqrtf(ss * (1.0f / 1024.0f) + EPS);
}
template <int KIND  , bool ALT = false>
__device__ __forceinline__ void norm_phase(const Params& p, const int layer, const float* __restrict__ gain, const int bid, const int nb, const int wv) {
    const int tid_ = hidden_tid(wv), lane = tid_ & 63, w = tid_ >> 6;
    float* X = (float*)(p.ws + WS_X);
    float* Xo = ALT ? (float*)(p.ws + WS_PROJ) : X;
    bf16_t* H = (bf16_t*)(p.ws + (ALT ? WS_QX : WS_H));
    const bf16_t* Y = (const bf16_t*)(p.ws + WS_Y);
    const float* WT = (const float*)(p.ws + WS_WT);
    Row16 g; ld_row(g, gain, lane);
    for (int tok = bid * 8 + w; tok < NTOK; tok += nb * 8) {
        Row16 x;
        if (KIND == 0 && layer == 0) ld_row(x, p.in[0] + (size_t)tok * D, lane); else ld_row(x, X + (size_t)tok * D, lane);
        if ((KIND == 0 && layer > 0) || KIND == 2) {
            const float w0 = WT[2 * tok], w1 = WT[2 * tok + 1];
            const bf16_t* y0 = Y + (size_t)(2 * tok) * D; const bf16_t* y1 = y0 + D;
#pragma unroll
            for (int i = 0; i < 4; ++i) {
                const u32x2 a = *(const u32x2*)(y0 + 256 * i + 4 * lane), b = *(const u32x2*)(y1 + 256 * i + 4 * lane);
                x.v[i][0] += w0 * bflo(a.x) + w1 * bflo(b.x); x.v[i][1] += w0 * bfhi(a.x) + w1 * bfhi(b.x);
                x.v[i][2] += w0 * bflo(a.y) + w1 * bflo(b.y); x.v[i][3] += w0 * bfhi(a.y) + w1 * bfhi(b.y);
            }
        }
        const float rstd = row_rstd(x, lane);
        if (KIND == 2) {
#pragma unroll
            for (int i = 0; i < 4; ++i) *(f32x4*)(p.out + (size_t)tok * D + 256 * i + 4 * lane) = x.v[i] * rstd * g.v[i];
        } else {
            if (KIND == 0) {
#pragma unroll
                for (int i = 0; i < 4; ++i) *(f32x4*)(Xo + (size_t)tok * D + 256 * i + 4 * lane) = x.v[i];
            }
#pragma unroll
            for (int i = 0; i < 4; ++i) st_bf16x4(H + (size_t)tok * D + 256 * i + 4 * lane, x.v[i] * rstd * g.v[i]);
        }
    }
}

template <bool ALT>
__device__ __forceinline__ void route_phase(const Params& p, const int layer, const int bid, const int nb, const int wv) {
    const int tid = hidden_tid(wv), lane = tid & 63, w = tid >> 6, fr = lane & 15, fq = lane >> 4;
    float* part = (float*)shm;
    float* ssql = part + 2 * 64 * 48;
    int* cntl = (int*)((char*)shm + LDS_ROUTE);
    int* basel = cntl + 32;
    int* sel = basel + 32;
    int* posl = sel + 128;
    const float* X = (const float*)(p.ws + WS_X);
    bf16_t* H = (bf16_t*)(p.ws + WS_H);
    float* WT = (float*)(p.ws + (ALT ? WS_ACT + (size_t)4 * 1024 * 1024 : WS_WT));
    float* RSTD = (float*)(p.ws + (ALT ? WS_ACT + (size_t)5 * 1024 * 1024 : WS_RSTD));
    int* LIST = (int*)(p.ws + (ALT ? WS_ACT : WS_LIST));
    int* CNT = (int*)(p.ws + WS_CNT) + (layer + (ALT ? 4 : 0)) * NEXP * CNT_STRIDE;
    const float* bg = p.in[26] + layer * 4; const float* be = p.in[28] + layer * NEXP;
    const float* gain = p.in[24] + (size_t)layer * D;
    const bf16_t* Wh = (const bf16_t*)(p.ws + WS_WRT) + (size_t)layer * 2 * 48 * 1024; const bf16_t* Wl = Wh + 48 * 1024;
    const int mt = w & 3, kh = w >> 2;
    for (int chunk = bid; chunk < NTOK / 64; chunk += nb) {
        __syncthreads();
        if (tid < 32) cntl[tid] = 0;
        const int tok = chunk * 64 + mt * 16 + fr;
        const float* xr = X + (size_t)tok * D + kh * 512 + fq * 8;
        f32x4 acc[3];
#pragma unroll
        for (int nt = 0; nt < 3; ++nt) acc[nt] = (f32x4){0.f, 0.f, 0.f, 0.f};
        float ssq = 0.f;
#pragma unroll 2
        for (int ks = 0; ks < 16; ++ks) {
            const int kcol = kh * 512 + ks * 32 + fq * 8;
            const f32x4 x0 = *(const f32x4*)(xr + ks * 32), x1 = *(const f32x4*)(xr + ks * 32 + 4);
            const f32x4 g0 = *(const f32x4*)(gain + kcol), g1 = *(const f32x4*)(gain + kcol + 4);
            bf16x8 Bh[3], Bl[3];
#pragma unroll
            for (int nt = 0; nt < 3; ++nt) { Bh[nt] = *(const bf16x8*)(Wh + (size_t)(nt * 16 + fr) * 1024 + kcol); Bl[nt] = *(const bf16x8*)(Wl + (size_t)(nt * 16 + fr) * 1024 + kcol); }
            ssq += x0[0] * x0[0] + x0[1] * x0[1] + x0[2] * x0[2] + x0[3] * x0[3] + x1[0] * x1[0] + x1[1] * x1[1] + x1[2] * x1[2] + x1[3] * x1[3];
            u32x4 hi; hi.x = cvt_pk_bf16(x0[0], x0[1]); hi.y = cvt_pk_bf16(x0[2], x0[3]); hi.z = cvt_pk_bf16(x1[0], x1[1]); hi.w = cvt_pk_bf16(x1[2], x1[3]);
            u32x4 lo;
            lo.x = cvt_pk_bf16(x0[0] - bflo(hi.x), x0[1] - bfhi(hi.x)); lo.y = cvt_pk_bf16(x0[2] - bflo(hi.y), x0[3] - bfhi(hi.y));
            lo.z = cvt_pk_bf16(x1[0] - bflo(hi.z), x1[1] - bfhi(hi.z)); lo.w = cvt_pk_bf16(x1[2] - bflo(hi.w), x1[3] - bfhi(hi.w));
            u32x4 hg; hg.x = cvt_pk_bf16(x0[0] * g0[0], x0[1] * g0[1]); hg.y = cvt_pk_bf16(x0[2] * g0[2], x0[3] * g0[3]);
            hg.z = cvt_pk_bf16(x1[0] * g1[0], x1[1] * g1[1]); hg.w = cvt_pk_bf16(x1[2] * g1[2], x1[3] * g1[3]);
            *(u32x4*)(H + (size_t)tok * D + kcol) = hg;
            const bf16x8 Ah = __builtin_bit_cast(bf16x8, hi), Al = __builtin_bit_cast(bf16x8, lo);
#pragma unroll
            for (int nt = 0; nt < 3; ++nt) {
                acc[nt] = __builtin_amdgcn_mfma_f32_16x16x32_bf16(Ah, Bh[nt], acc[nt], 0, 0, 0);
                acc[nt] = __builtin_amdgcn_mfma_f32_16x16x32_bf16(Ah, Bl[nt], acc[nt], 0, 0, 0);
                acc[nt] = __builtin_amdgcn_mfma_f32_16x16x32_bf16(Al, Bh[nt], acc[nt], 0, 0, 0);
            }
        }
        ssq += shx(ssq, 16, lane); ssq += shx(ssq, 32, lane);
        if (fq == 0) ssql[kh * 64 + mt * 16 + fr] = ssq;
#pragma unroll
        for (int nt = 0; nt < 3; ++nt)
#pragma unroll
            for (int r = 0; r < 4; ++r) part[(kh * 64 + mt * 16 + fq * 4 + r) * 48 + nt * 16 + fr] = acc[nt][r];
        __syncthreads();
        if (tid < 64) {
            const int tl = tid, tk = chunk * 64 + tl;
            const float rstd = rsqrtf((ssql[tl] + ssql[64 + tl]) * (1.0f / 1024.0f) + EPS);
            const float* p0 = part + tl * 48; const float* p1 = part + (64 + tl) * 48;
            float lg[36];
#pragma unroll
            for (int j = 0; j < 36; ++j) lg[j] = (p0[j] + p1[j]) * rstd;
            float g0 = lg[0] + bg[0], g1 = lg[1] + bg[1], g2 = lg[2] + bg[2], g3 = lg[3] + bg[3];
            int gs = 0; float gm = g0;
            if (g1 > gm) { gm = g1; gs = 1; } if (g2 > gm) { gm = g2; gs = 2; } if (g3 > gm) { gm = g3; gs = 3; }
            const float gden = __expf(g0 - gm) + __expf(g1 - gm) + __expf(g2 - gm) + __expf(g3 - gm);
            const float ggate = 1.0f / gden;
            float ev[8];
#pragma unroll
            for (int j = 0; j < 8; ++j) {
                const float a0 = lg[4 + j] + be[j], a1 = lg[12 + j] + be[8 + j], a2 = lg[20 + j] + be[16 + j], a3 = lg[28 + j] + be[24 + j];
                ev[j] = gs == 0 ? a0 : gs == 1 ? a1 : gs == 2 ? a2 : a3;
            }
            int i0 = 0; float v0 = ev[0];
#pragma unroll
            for (int j = 1; j < 8; ++j) if (ev[j] > v0) { v0 = ev[j]; i0 = j; }
            int i1 = -1; float v1 = -3.0e38f;
#pragma unroll
            for (int j = 0; j < 8; ++j) if (j != i0 && ev[j] > v1) { v1 = ev[j]; i1 = j; }
            const float e1 = __expf(v1 - v0), sden = 1.0f / (1.0f + e1);
            const int ea = gs * 8 + i0, eb = gs * 8 + i1;
            sel[2 * tl] = ea; posl[2 * tl] = atomicAdd(&cntl[ea], 1);
            sel[2 * tl + 1] = eb; posl[2 * tl + 1] = atomicAdd(&cntl[eb], 1);
            WT[2 * tk] = ggate * sden; WT[2 * tk + 1] = ggate * e1 * sden;
            RSTD[tk] = rstd;
        }
        __syncthreads();
        if (tid < 32) { const int c = cntl[tid]; basel[tid] = c > 0 ? atomicAdd(&CNT[tid * CNT_STRIDE], c) : 0; }
        __syncthreads();
        if (tid < 128) { const int e = sel[tid]; LIST[(size_t)e * NTOK + basel[e] + posl[tid]] = 128 * chunk + tid; }
    }
}

template <int MODE>
__device__ __forceinline__ void cvt_job(const float* __restrict__ src, bf16_t* __restrict__ dst, const int K, const int N, const int nmat,
                                        const size_t dst_mat_stride, const int bid, const int nb, const int wv) {
    float* T = (float*)shm;
    const int tid = hidden_tid(wv);
    const int tk = K / 64, tn = N / 256, per = tk * tn, total = per * nmat;
    for (int t = bid; t < total; t += nb) {
        const int mat = t / per, r = t % per, k0 = (r / tn) * 64, n0 = (r % tn) * 256;
        const float* s = src + (size_t)mat * K * N + (size_t)k0 * N + n0;
        bf16_t* d = dst + (size_t)mat * dst_mat_stride;
        f32x4 v[8];
#pragma unroll
        for (int i = 0; i < 8; ++i) v[i] = *(const f32x4*)(s + (size_t)((tid >> 6) + 8 * i) * N + (tid & 63) * 4);
        __syncthreads();
#pragma unroll
        for (int i = 0; i < 8; ++i) {
            float* q = T + ((tid >> 6) + 8 * i) * 257 + (tid & 63) * 4;
            q[0] = v[i][0]; q[1] = v[i][1]; q[2] = v[i][2]; q[3] = v[i][3];
        }
        __syncthreads();
#pragma unroll
        for (int j = 0; j < 4; ++j) {
            const int n = (tid >> 3) + 64 * j, kc = (tid & 7) * 8;
            float e[8];
#pragma unroll
            for (int jj = 0; jj < 8; ++jj) e[jj] = T[(kc + jj) * 257 + n];
            u32x4 ov; ov.x = cvt_pk_bf16(e[0], e[1]); ov.y = cvt_pk_bf16(e[2], e[3]); ov.z = cvt_pk_bf16(e[4], e[5]); ov.w = cvt_pk_bf16(e[6], e[7]);
            const int ng = n0 + n;
            const int row = (MODE == 0) ? ng : ((ng >> 4) * 32 + (ng & 15) + (MODE == 2 ? 16 : 0));
            *(u32x4*)(d + (size_t)row * K + k0 + kc) = ov;
        }
    }
}

__device__ __forceinline__ void prologue0(const Params& p, const int bid, const int nb, const int wv) {
    unsigned char* ws = p.ws;
    cvt_job<0>(p.in[3], (bf16_t*)(ws + WS_W_EIN), 1024, 3072, 2, (size_t)3072 * 1024, bid, nb, wv);
    cvt_job<0>(p.in[15], (bf16_t*)(ws + WS_W_EOUT), 1024, 1024, 2, (size_t)1024 * 1024, bid, nb, wv);
    cvt_job<0>(p.in[17], (bf16_t*)(ws + WS_W_OIN), 1024, 1536, 2, (size_t)1536 * 1024, bid, nb, wv);
    cvt_job<0>(p.in[19], (bf16_t*)(ws + WS_W_OOUT), 1024, 1024, 2, (size_t)1024 * 1024, bid, nb, wv);
    cvt_job<0>(p.in[21], (bf16_t*)(ws + WS_W_CQ), 1024, 512, 4, (size_t)512 * 1024, bid, nb, wv);
    cvt_job<0>(p.in[22], (bf16_t*)(ws + WS_W_CKV), 1024, 1024, 4, (size_t)1024 * 1024, bid, nb, wv);
    cvt_job<0>(p.in[23], (bf16_t*)(ws + WS_W_CO), 512, 1024, 4, (size_t)1024 * 512, bid, nb, wv);
    cvt_job<1>(p.in[29], (bf16_t*)(ws + WS_W_GU), 1024, 512, 128, (size_t)1024 * 1024, bid, nb, wv);
    cvt_job<2>(p.in[30], (bf16_t*)(ws + WS_W_GU), 1024, 512, 128, (size_t)1024 * 1024, bid, nb, wv);
    cvt_job<0>(p.in[31], (bf16_t*)(ws + WS_W_DN), 512, 1024, 128, (size_t)1024 * 512, bid, nb, wv);
    const int tid = hidden_tid(wv), lane = tid & 63, w = tid >> 6;
    {
        Row16 g; ld_row(g, p.in[32], lane);
        bf16_t* MN = (bf16_t*)(ws + WS_MEMN);
        for (int r = bid * 8 + w; r < Bb * MEM; r += nb * 8) {
            Row16 x; ld_row(x, p.in[1] + (size_t)r * D, lane);
            const float rstd = row_rstd(x, lane);
#pragma unroll
            for (int i = 0; i < 4; ++i) st_bf16x4(MN + (size_t)r * D + 256 * i + 4 * lane, x.v[i] * rstd * g.v[i]);
        }
    }
    {
        float* A2 = (float*)(ws + WS_A2);
        for (int r = bid * 8 + w; r < 2 * S; r += nb * 8) {
            const int lj = r / S, pos = r % S;
            const float* w1 = p.in[6] + (size_t)lj * 33 * 64; const float* b1 = p.in[7] + lj * 64;
            const float* w2 = p.in[8] + (size_t)lj * 64 * 64; const float* b2 = p.in[9] + lj * 64;
            const float fr_ = p.in[11][lj * 64 + lane];
            float a = ((float)pos / 2047.0f) * w1[lane];
#pragma unroll 1
            for (int k = 0; k < 16; ++k) {
                const float band = 1e-4f + (float)k * ((15.0f - 1e-4f) / 15.0f);
                const float ang = band * (6.283185307179586f * (float)pos / 2048.0f);
                a += cosf(ang) * w1[(1 + k) * 64 + lane] - sinf(ang) * w1[(17 + k) * 64 + lane];
            }
            const float a1 = sinf(fr_ * (a + b1[lane]));
            float a2 = 0.f;
#pragma unroll 1
            for (int i = 0; i < 64; ++i) a2 += shl(a1, i) * w2[i * 64 + lane];
            A2[(size_t)r * 64 + lane] = sinf(fr_ * (a2 + b2[lane]));
        }
    }
    {
        bf16_t* WR = (bf16_t*)(ws + WS_WRT);
        for (int i = bid * NT + tid; i < 4 * 48 * 1024; i += nb * NT) {
            const int l = i / (48 * 1024), r = i % (48 * 1024), j = r >> 10, k = r & 1023;
            float v = 0.f;
            if (j < 4) v = p.in[25][((size_t)l * D + k) * 4 + j]; else if (j < 36) v = p.in[27][((size_t)l * D + k) * NEXP + (j - 4)];
            v *= p.in[24][(size_t)l * D + k];
            const unsigned h = cvt_pk_bf16(v, 0.f) & 0xffffu;
            const unsigned lo = cvt_pk_bf16(v - bflo(h), 0.f) & 0xffffu;
            WR[(size_t)l * 2 * 48 * 1024 + r] = (bf16_t)h; WR[(size_t)l * 2 * 48 * 1024 + 48 * 1024 + r] = (bf16_t)lo;
        }
    }
    if (bid == 0) {
        if (tid < 2) {
            const float* lm = p.in[13] + (size_t)tid * 4 * 64;
            float s01 = 0.f, s23 = 0.f;
            for (int i = 0; i < 64; ++i) { s01 += lm[i] * lm[64 + i]; s23 += lm[128 + i] * lm[192 + i]; }
            const float lam_init = 0.8f - 0.6f * expf(-0.3f * (float)(2 * tid));
            ((float*)(ws + WS_MISC))[tid] = expf(s01) - expf(s23) + lam_init;
            ((float*)(ws + WS_MISC))[2 + tid] = 1.0f - lam_init;
        }
        bf16_t* hz = (bf16_t*)(ws + WS_H) + (size_t)NTOK * D; bf16_t* az = (bf16_t*)(ws + WS_ACT) + (size_t)2 * NTOK * EH;
        for (int i = tid; i < D; i += NT) hz[i] = 0;
        for (int i = tid; i < EH; i += NT) az[i] = 0;
    }
}

__device__ __forceinline__ void filter_taps(const Params& p, const int bid, const int nb, const int wv) {
    float* sA = (float*)shm;
    float* sW = sA + 64 * 65;
    const int tid = hidden_tid(wv);
    const float* A2 = (const float*)(p.ws + WS_A2);
    bf16_t* FL = (bf16_t*)(p.ws + WS_FILT);
    for (int job = bid; job < 2 * 4 * 8 * 32; job += nb) {
        const int pt = job & 31, ct = (job >> 5) & 7, od = (job >> 8) & 3, lj = job >> 10;
        const int pos0 = pt * 64, ch0 = ct * 64, order = od >> 1, dir = od & 1;
        const float* w3 = p.in[10] + (size_t)lj * 64 * 2048 + od * 512 + ch0;
        __syncthreads();
        for (int i = tid; i < 4096; i += NT) { sA[(i >> 6) * 65 + (i & 63)] = A2[((size_t)lj * S + pos0 + (i >> 6)) * 64 + (i & 63)]; sW[i] = w3[(size_t)(i >> 6) * 2048 + (i & 63)]; }
        __syncthreads();
        const int pl = tid & 63, cg = tid >> 6, pos = pos0 + pl;
        float acc[8];
#pragma unroll
        for (int k = 0; k < 8; ++k) acc[k] = 0.f;
#pragma unroll 2
        for (int j = 0; j < 64; ++j) {
            const float a = sA[pl * 65 + j];
#pragma unroll
            for (int k = 0; k < 8; ++k) acc[k] += a * sW[j * 64 + cg * 8 + k];
        }
        const float tpos = (float)pos / 2047.0f;
        const float mind = logf(1e-2f) / 1.5f, maxd = logf(1e-2f) / 0.3f;
#pragma unroll
        for (int k = 0; k < 8; ++k) {
            const int ch = ch0 + cg * 8 + k;
            const float delta = mind + (float)ch * ((maxd - mind) / 511.0f);
            const float v = acc[k] * expf(-tpos * fabsf(delta));
            bf16_t* f = FL + ((size_t)(lj * 2 + order) * 512 + ch) * 4096;
            const unsigned short hv = (unsigned short)(cvt_pk_bf16(v, 0.f) & 0xffff);
            if (dir == 0) f[2047 - pos] = hv;
            else { if (pos >= 1) f[2047 + pos] = hv; if (pos == 2047) f[4095] = 0; }
        }
    }
}

enum { PH_P0 = 0, PH_P1, PH_N1, PH_GIN, PH_MIX, PH_GOUT, PH_N2, PH_GQ, PH_XATT, PH_GO, PH_ROUTE, PH_G1, PH_G2, PH_FINAL, PH_COUNT };

template <class Epi>
__device__ __forceinline__ void gemm_dense(const bf16_t* A, const bf16_t* Bt, const int K, const int nM, const int nN, Epi epi, const int bid, const int nb, const int wv) {
    for (int u = bid; u < nM * nN; u += nb) {
        const int pm = u / nN, pn = u % nN;
        epi.brow = pm * 256;
        gemm_tile(A + (size_t)pm * 256 * K, Bt, K, pn * 256, RowIdent{}, epi, wv);
    }
}

typedef const __attribute__((address_space(4))) Params* ParamsK;
#define PHASE_FN __forceinline__
template <int PH, bool ALT = false>
__device__ PHASE_FN void run_phase(ParamsK pk_, const int layer, const int bid_, const int nb_, const int wv_) {
    ParamsK pk = pk_; asm volatile("" : "+s"(pk));
    int bid = bid_, nb = nb_, wv = wv_; asm volatile("" : "+s"(bid), "+s"(nb), "+s"(wv));
    const Params& p = *(const Params*)pk;
    unsigned char* ws = p.ws;
    const int lj = layer >> 1; const bool even = (layer & 1) == 0;
    bf16_t* H = (bf16_t*)(ws + WS_H);
    float* X = (float*)(ws + WS_X);
    bf16_t* YMIX = (bf16_t*)(ws + WS_YMIX);
    bf16_t* QX = (bf16_t*)(ws + WS_QX);
    bf16_t* OX = (bf16_t*)(ws + WS_OX);
    if constexpr (PH == PH_P0) { prologue0(p, bid, nb, wv); }
    if constexpr (PH == PH_P1) {
        for (int u = bid; u < 4 * 8 * 4; u += nb) {
            const int l = u >> 5, pm = (u >> 2) & 7, pn = u & 3;
            EpiSplit e{nullptr, (bf16_t*)(ws + WS_XK) + (size_t)l * 2048 * 512, (bf16_t*)(ws + WS_XVT) + (size_t)l * 512 * 2048, 0, 512, 512, (size_t)2048, pm * 256};
            gemm_tile((const bf16_t*)(ws + WS_MEMN) + (size_t)pm * 256 * 1024, (const bf16_t*)(ws + WS_W_CKV) + (size_t)l * 1024 * 1024, 1024, pn * 256, RowIdent{}, e, wv);
        }
        filter_taps(p, bid, nb, wv);
    }
    if constexpr (PH == PH_N1) { norm_phase<0, ALT>(p, layer, (even ? p.in[2] : p.in[16]) + (size_t)lj * D, bid, nb, wv); }
    if constexpr (PH == PH_GIN) {
        if (even) {
            EpiSplit e{(bf16_t*)(ws + WS_PROJ + PR_HYT), (bf16_t*)(ws + WS_PROJ + PR_QK), (bf16_t*)(ws + WS_PROJ + PR_VT), 1536, 2560, 1024, (size_t)NTOK, 0};
            gemm_dense(H, (const bf16_t*)(ws + WS_W_EIN) + (size_t)lj * 3072 * 1024, 1024, 64, 12, e, bid, nb, wv);
        } else {
            EpiSplit e{nullptr, (bf16_t*)(ws + WS_PROJ), (bf16_t*)(ws + WS_PROJ + PR_OVT), 0, 1280, 1280, (size_t)NTOK, 0};
            gemm_dense(H, (const bf16_t*)(ws + WS_W_OIN) + (size_t)lj * 1536 * 1024, 1024, 64, 6, e, bid, nb, wv);
        }
    }
    if constexpr (PH == PH_MIX) {
        if (even) {
            const bf16_t* qk = (const bf16_t*)(ws + WS_PROJ + PR_QK);
            const bf16_t* vT = (const bf16_t*)(ws + WS_PROJ + PR_VT);
            const float lam = uni(((const float*)(ws + WS_MISC))[lj]);
            const float oscale = uni(((const float*)(ws + WS_MISC))[2 + lj]);
            for (int u = bid + ((ALT && (DUPSEL == 4 || DUPSEL >= 7)) ? 512 : 0); u < ((ALT && (DUPSEL == 3 || DUPSEL == 5 || DUPSEL == 6)) ? 512 : 1024); u += nb) {
                if (u < 512) hyena_unit<ALT>(p, lj, u, wv);
                else {
                    const int id = u - 512, b = id >> 6, h = (id >> 4) & 3, qb = id & 15;
                    attn_unit<0, ALT>(qk + (size_t)(b * S) * 1024 + 2 * h * 64, 1024, qk + (size_t)(b * S) * 1024 + 512 + 2 * h * 64, 1024,
                                 vT + (size_t)(h * 128) * NTOK + b * S, (size_t)NTOK, qb * 128, 0, S,
                                 0.125f, uni(exp2f(-2.0f * (float)(h + 1))), -1e30f, 0.f,
                                 (ALT ? (bf16_t*)(ws + WS_Y) : YMIX) + (size_t)(b * S) * D + 512 + h * 128, D, lam, oscale, p.in[14] + (size_t)lj * 128, wv);
                }
            }
        } else {
            const bf16_t* qk = (const bf16_t*)(ws + WS_PROJ);
            const bf16_t* vT = (const bf16_t*)(ws + WS_PROJ + PR_OVT);
            for (int u = bid; u < 2048; u += nb) {
                const int b = u >> 8, hq = (u >> 4) & 15, qb = u & 15, kv = hq >> 2, q0 = qb * 128;
                const int kbeg = q0 - 128 < 0 ? 0 : q0 - 128, kend = q0 + 256 > S ? S : q0 + 256;
                attn_unit<1>(qk + (size_t)(b * S) * 1280 + hq * 64, 1280, qk + (size_t)(b * S) * 1280 + 1024 + kv * 64, 1280,
                             vT + (size_t)(kv * 64) * NTOK + b * S, (size_t)NTOK, q0, kbeg, kend,
                             0.125f, uni(exp2f(-0.5f * (float)(hq + 1))), uni(p.in[18][lj * 16 + hq]), 1.0f,
                             YMIX + (size_t)(b * S) * D + hq * 64, D, 0.f, 1.f, nullptr, wv);
            }
        }
    }
    if constexpr (PH == PH_GOUT) {
        EpiRes e{X, 0, ALT ? (float*)(ws + WS_Y) : X};
        gemm_dense(YMIX, (const bf16_t*)(ws + (even ? WS_W_EOUT : WS_W_OOUT)) + (size_t)lj * 1024 * 1024, 1024, 64, 4, e, bid, nb, wv);
    }
    if constexpr (PH == PH_N2) { norm_phase<1>(p, layer, p.in[20] + (size_t)layer * D, bid, nb, wv); }
    if constexpr (PH == PH_GQ) {
        EpiSplit e{nullptr, QX, nullptr, 0, 512, 512, (size_t)NTOK, 0};
        gemm_dense(H, (const bf16_t*)(ws + WS_W_CQ) + (size_t)layer * 512 * 1024, 1024, 64, 2, e, bid, nb, wv);
    }
    if constexpr (PH == PH_XATT) {
        const bf16_t* xk = (const bf16_t*)(ws + WS_XK) + (size_t)layer * 2048 * 512;
        const bf16_t* xvt = (const bf16_t*)(ws + WS_XVT) + (size_t)layer * 512 * 2048;
        for (int u = bid; u < 512; u += nb) {
            const int b = u >> 6, h = (u >> 4) & 3, qb = u & 15;
            attn_unit<2>(QX + (size_t)(b * S) * 512 + h * 128, 512, xk + (size_t)(b * MEM) * 512 + h * 128, 512,
                         xvt + (size_t)(h * 128) * 2048 + b * MEM, (size_t)2048, qb * 128, 0, MEM,
                         0.08838834764831845f, 0.f, -1e30f, 0.f, OX + (size_t)(b * S) * 512 + h * 128, 512, 0.f, 1.f, nullptr, wv);
        }
    }
    if constexpr (PH == PH_GO) {
        EpiRes e{X, 0, ALT ? (float*)(ws + WS_Y) : X};
        gemm_dense(OX, (const bf16_t*)(ws + WS_W_CO) + (size_t)layer * 1024 * 512, 512, 64, 4, e, bid, nb, wv);
    }
    if constexpr (PH == PH_ROUTE) { route_phase<ALT>(p, layer, bid, nb, wv); }
    if constexpr (PH == PH_G1) {
        const int* CNT = (const int*)(ws + WS_CNT) + layer * NEXP * CNT_STRIDE;
        const int* LIST = (const int*)(ws + WS_LIST);
        unsigned* head = (unsigned*)(ws + WS_QHEAD) + layer * 64;
        unsigned* done = (unsigned*)(ws + WS_DONE) + layer * 32 * 64;
        int* uq = (int*)((char*)shm + LDS_ROUTE + 1024);
        const int tid = hidden_tid(wv);
        int total = 0;
        for (int e = 0; e < NEXP; ++e) total += (CNT[e * CNT_STRIDE] + 255) >> 8;
        total = __builtin_amdgcn_readfirstlane(total) * 4;
        for (;;) {
            __syncthreads();
            if (tid == 0) *uq = (int)__hip_atomic_fetch_add(head, 1u, __ATOMIC_RELAXED, __HIP_MEMORY_SCOPE_AGENT);
            __syncthreads();
            const int uall = __builtin_amdgcn_readfirstlane(*uq);
            if (uall >= 2 * total) break;
            const bool second = uall >= total;
            const int u = second ? uall - total : uall;
            int e = 0, base = 0, tl = 0, cnt = 0;
            for (; e < NEXP; ++e) { cnt = __builtin_amdgcn_readfirstlane(CNT[e * CNT_STRIDE]); tl = (cnt + 255) >> 8; if (u < base + tl * 4) break; base += tl * 4; }
            const int r = u - base, pn = r / tl, pm = r % tl;
            const int* list = LIST + (size_t)e * NTOK;
            if (!second) {
                EpiGateUp ep{(bf16_t*)(ws + WS_ACT), list, cnt, pm * 256, (const float*)(ws + WS_RSTD)};
                gemm_tile(H, (const bf16_t*)(ws + WS_W_GU) + ((size_t)layer * NEXP + e) * 1024 * 1024, 1024, pn * 256, RowTok{list, cnt, pm * 256}, ep, wv);
                asm volatile("s_waitcnt vmcnt(0)" ::: "memory");
                if ((hidden_tid(wv) & 63) == 0) (void)__hip_atomic_fetch_add(done + e * 64 + pm, 1u, __ATOMIC_RELAXED, __HIP_MEMORY_SCOPE_AGENT);
            } else {
                if (tid < 64) {
                    unsigned spins = 0;
                    while ((unsigned)__builtin_amdgcn_readfirstlane(__hip_atomic_load(done + e * 64 + pm, __ATOMIC_RELAXED, __HIP_MEMORY_SCOPE_AGENT)) < 32u) {
                        __builtin_amdgcn_s_sleep(2);
                        if (++spins > (1u << 24)) break;
                    }
                    __builtin_amdgcn_fence(__ATOMIC_ACQUIRE, "agent");
                    asm volatile("s_waitcnt vmcnt(0)" ::: "memory");
                }
                __syncthreads();
                EpiDown ep{(bf16_t*)(ws + WS_Y), list, cnt, pm * 256};
                gemm_tile((const bf16_t*)(ws + WS_ACT), (const bf16_t*)(ws + WS_W_DN) + ((size_t)layer * NEXP + e) * 1024 * 512, 512, pn * 256, RowAsg{list, cnt, pm * 256}, ep, wv);
            }
        }
    }
    if constexpr (PH == PH_FINAL) { norm_phase<2>(p, DEPTH, p.in[33], bid, nb, wv); }
}

#if ONE_LAUNCH
__global__ void __launch_bounds__(NT, 2) k_mega(Params p_) {
    ParamsK p = (ParamsK)__builtin_amdgcn_kernarg_segment_ptr();
    volatile LAS unsigned* st = (volatile LAS unsigned*)((char*)shm + LDS_XB);
    if (threadIdx.x < 4) st[threadIdx.x] = 0u;
    __syncthreads();
    const XcdBarrier bar = xcd_barrier_post((unsigned*)(p->ws + WS_BAR), st);
    const int bid = blockIdx.x, nb = gridDim.x, wv = __builtin_amdgcn_readfirstlane(threadIdx.x >> 6);
    run_phase<PH_P0>(p, 0, bid, nb, wv); xcd_barrier(bar); if (DUP == PH_P0) { run_phase<PH_P0, true>(p, 0, bid, nb, wv); xcd_barrier(bar); }
    run_phase<PH_P1>(p, 0, bid, nb, wv); xcd_barrier(bar); if (DUP == PH_P1) { run_phase<PH_P1, true>(p, 0, bid, nb, wv); xcd_barrier(bar); }
#pragma unroll 1
    for (int layer = 0; layer < DEPTH; ++layer) {
        run_phase<PH_N1>(p, layer, bid, nb, wv); xcd_barrier(bar); if (DUP == PH_N1) { run_phase<PH_N1, true>(p, layer, bid, nb, wv); xcd_barrier(bar); }
        run_phase<PH_GIN>(p, layer, bid, nb, wv); xcd_barrier(bar); if (DUP == PH_GIN) { run_phase<PH_GIN, true>(p, layer, bid, nb, wv); xcd_barrier(bar); }
        run_phase<PH_MIX>(p, layer, bid, nb, wv); xcd_barrier(bar); if (DUP == PH_MIX && (DUPSEL == 0 || (DUPSEL != 2 && (layer & 1) == 0) || (DUPSEL == 2 && (layer & 1) == 1))) { run_phase<PH_MIX, true>(p, layer, bid, nb, wv); xcd_barrier(bar); }
        run_phase<PH_GOUT>(p, layer, bid, nb, wv); xcd_barrier(bar); if (DUP == PH_GOUT) { run_phase<PH_GOUT, true>(p, layer, bid, nb, wv); xcd_barrier(bar); }
        run_phase<PH_N2>(p, layer, bid, nb, wv); xcd_barrier(bar); if (DUP == PH_N2) { run_phase<PH_N2, true>(p, layer, bid, nb, wv); xcd_barrier(bar); }
        run_phase<PH_GQ>(p, layer, bid, nb, wv); xcd_barrier(bar); if (DUP == PH_GQ) { run_phase<PH_GQ, true>(p, layer, bid, nb, wv); xcd_barrier(bar); }
        run_phase<PH_XATT>(p, layer, bid, nb, wv); xcd_barrier(bar); if (DUP == PH_XATT) { run_phase<PH_XATT, true>(p, layer, bid, nb, wv); xcd_barrier(bar); }
        run_phase<PH_GO>(p, layer, bid, nb, wv); xcd_barrier(bar); if (DUP == PH_GO) { run_phase<PH_GO, true>(p, layer, bid, nb, wv); xcd_barrier(bar); }
        run_phase<PH_ROUTE>(p, layer, bid, nb, wv); xcd_barrier(bar); if (DUP == PH_ROUTE) { run_phase<PH_ROUTE, true>(p, layer, bid, nb, wv); xcd_barrier(bar); }
        run_phase<PH_G1>(p, layer, bid, nb, wv); xcd_barrier(bar); if (DUP == PH_G1) { run_phase<PH_G1, true>(p, layer, bid, nb, wv); xcd_barrier(bar); }
    }
    run_phase<PH_FINAL>(p, DEPTH, bid, nb, wv);
}
#else
template <int PH>
__global__ void __launch_bounds__(NT, 2) k_phase(Params p_, int layer) {
    run_phase<PH>((ParamsK)__builtin_amdgcn_kernarg_segment_ptr(), layer, blockIdx.x, gridDim.x, __builtin_amdgcn_readfirstlane(threadIdx.x >> 6));
}
template <int PH> static void launch_phase(const Params& p, int layer, int grid, hipStream_t stream) {
    static bool init = false;
    if (!init) { (void)hipFuncSetAttribute((const void*)k_phase<PH>, hipFuncAttributeMaxDynamicSharedMemorySize, LDS_BYTES); init = true; }
    hipLaunchKernelGGL(k_phase<PH>, dim3(grid), dim3(NT), LDS_BYTES, stream, p, layer);
}
#endif

extern "C" void kernel_launch(void* const* d_in, const int* in_sizes, int n_in, void* d_out, int out_size, void* d_ws, size_t ws_size, hipStream_t stream) {
    if (n_in != 34 || ws_size < WS_END) { fprintf(stderr, "kernel_launch: unexpected n_in %d or ws_size %zu (need %zu)\n", n_in, ws_size, (size_t)WS_END); return; }
    Params p{};
    for (int i = 0; i < 34; ++i) p.in[i] = (const float*)d_in[i];
    p.out = (float*)d_out; p.ws = (unsigned char*)d_ws;
    (void)hipMemsetAsync(d_ws, 0, WS_ZERO_BYTES, stream);
#if ONE_LAUNCH
    static int grid = 0;
    if (grid == 0) {
        int dev = 0, cus = 0, per_cu = 0;
        (void)hipGetDevice(&dev); (void)hipDeviceGetAttribute(&cus, hipDeviceAttributeMultiprocessorCount, dev);
        (void)hipFuncSetAttribute((const void*)k_mega, hipFuncAttributeMaxDynamicSharedMemorySize, LDS_BYTES);
        (void)hipOccupancyMaxActiveBlocksPerMultiprocessor(&per_cu, (const void*)k_mega, NT, LDS_BYTES);
        (void)hipGetLastError();
        grid = cus > 0 ? cus : 256;
    }
    hipLaunchKernelGGL(k_mega, dim3(grid), dim3(NT), LDS_BYTES, stream, p);
#else
    const int grid = 256;
    launch_phase<PH_P0>(p, 0, grid, stream);
    launch_phase<PH_P1>(p, 0, grid, stream);
    for (int layer = 0; layer < DEPTH; ++layer) {
        launch_phase<PH_N1>(p, layer, grid, stream);
        launch_phase<PH_GIN>(p, layer, grid, stream);
        launch_phase<PH_MIX>(p, layer, grid, stream);
        launch_phase<PH_GOUT>(p, layer, grid, stream);
        launch_phase<PH_N2>(p, layer, grid, stream);
        launch_phase<PH_GQ>(p, layer, grid, stream);
        launch_phase<PH_XATT>(p, layer, grid, stream);
        launch_phase<PH_GO>(p, layer, grid, stream);
        launch_phase<PH_ROUTE>(p, layer, grid, stream);
        launch_phase<PH_G1>(p, layer, grid, stream);
    }
    launch_phase<PH_FINAL>(p, DEPTH, grid, stream);
#endif
}
```

```cpp
#include <hip/hip_runtime.h>
#include <stdint.h>
#include <stdio.h>

#ifndef RD_N
#define RD_N 1
#endif
#ifndef RD_E
#define RD_E 1
#endif
#ifndef RD_R
#define RD_R 1
#endif
#ifndef DUP
#define DUP -1
#endif
#ifndef DUPSEL
#define DUPSEL 0
#endif
#ifndef ONE_LAUNCH
#define ONE_LAUNCH 1
#endif

typedef unsigned short bf16_t;
typedef short bf16x8 __attribute__((ext_vector_type(8)));
typedef float f32x4 __attribute__((ext_vector_type(4)));
typedef unsigned u32x4 __attribute__((ext_vector_type(4)));
typedef unsigned u32x2 __attribute__((ext_vector_type(2)));

constexpr int Bb = 8, S = 2048, D = 1024, NTOK = Bb * S, DEPTH = 4, MEM = 256;
constexpr int NEXP = 32, EH = 512;
constexpr int NT = 512;
constexpr float EPS = 1e-6f;

constexpr size_t al256(size_t x) { return (x + 255) & ~(size_t)255; }
constexpr size_t WS_BAR   = 0;
constexpr size_t WS_CNT   = 16384;
constexpr int    CNT_STRIDE = 64;
constexpr size_t WS_QHEAD = 16384 + 65536;
constexpr size_t WS_DONE  = WS_QHEAD + 4096;
constexpr size_t WS_ZERO_BYTES = WS_DONE + (size_t)4 * 32 * 64 * 4;
constexpr size_t WS_MISC  = WS_ZERO_BYTES;
constexpr size_t WS_W_EIN = 131072;
constexpr size_t WS_W_EOUT = WS_W_EIN + (size_t)2 * 3072 * 1024 * 2;
constexpr size_t WS_W_OIN = WS_W_EOUT + (size_t)2 * 1024 * 1024 * 2;
constexpr size_t WS_W_OOUT = WS_W_OIN + (size_t)2 * 1536 * 1024 * 2;
constexpr size_t WS_W_CQ  = WS_W_OOUT + (size_t)2 * 1024 * 1024 * 2;
constexpr size_t WS_W_CKV = WS_W_CQ + (size_t)4 * 512 * 1024 * 2;
constexpr size_t WS_W_CO  = WS_W_CKV + (size_t)4 * 1024 * 1024 * 2;
constexpr size_t WS_W_GU  = WS_W_CO + (size_t)4 * 1024 * 512 * 2;
constexpr size_t WS_W_DN  = WS_W_GU + (size_t)4 * 32 * 1024 * 1024 * 2;
constexpr size_t WS_MEMN  = WS_W_DN + (size_t)4 * 32 * 1024 * 512 * 2;
constexpr size_t WS_XK    = WS_MEMN + (size_t)2048 * 1024 * 2;
constexpr size_t WS_XVT   = WS_XK + (size_t)4 * 2048 * 512 * 2;
constexpr size_t WS_A2    = WS_XVT + (size_t)4 * 2048 * 512 * 2;
constexpr size_t WS_FILT  = WS_A2 + (size_t)2 * 2048 * 64 * 4;
constexpr size_t WS_X     = WS_FILT + (size_t)2 * 2 * 512 * 4096 * 2;
constexpr size_t WS_H     = WS_X + (size_t)NTOK * D * 4;
constexpr size_t WS_PROJ  = WS_H + al256((size_t)(NTOK + 1) * D * 2);
constexpr size_t WS_YMIX  = WS_PROJ + (size_t)NTOK * 3072 * 2;
constexpr size_t WS_QX    = WS_YMIX + (size_t)NTOK * D * 2;
constexpr size_t WS_OX    = WS_QX + (size_t)NTOK * 512 * 2;
constexpr size_t WS_ACT   = WS_OX + (size_t)NTOK * 512 * 2;
constexpr size_t WS_Y     = WS_ACT + al256((size_t)(2 * NTOK + 1) * EH * 2);
constexpr size_t WS_LIST  = WS_Y + (size_t)2 * NTOK * D * 2;
constexpr size_t WS_WT    = WS_LIST + (size_t)NEXP * NTOK * 4;
constexpr size_t WS_RSTD  = WS_WT + (size_t)2 * NTOK * 4;
constexpr size_t WS_WRT   = WS_RSTD + (size_t)NTOK * 4;
constexpr size_t WS_XB    = WS_WRT + (size_t)4 * 2 * 48 * 1024 * 2;
constexpr size_t WS_END   = WS_XB + (size_t)NTOK * D * 2;
constexpr size_t PR_HYT   = 0;
constexpr size_t PR_QK    = (size_t)1536 * NTOK * 2;
constexpr size_t PR_VT    = PR_QK + (size_t)NTOK * 1024 * 2;
constexpr size_t PR_OVT   = (size_t)NTOK * 1280 * 2;

constexpr int LDS_XB = 147456;
constexpr int LDS_ROUTE = LDS_XB + 64;
constexpr int LDS_BYTES = LDS_ROUTE + 2048;

struct Params {
    const float* in[34];
    float* out;
    unsigned char* ws;
};

extern __shared__ __attribute__((aligned(16))) bf16_t shm[];

typedef float f32x2 __attribute__((ext_vector_type(2)));
typedef __bf16 bf16x2v __attribute__((ext_vector_type(2)));
__device__ __forceinline__ unsigned cvt_pk_bf16(float lo, float hi) { const f32x2 v = {lo, hi}; return __builtin_bit_cast(unsigned, __builtin_convertvector(v, bf16x2v)); }
__device__ __forceinline__ float bf2f(unsigned short b) { return __uint_as_float((unsigned)b << 16); }
__device__ __forceinline__ float bflo(unsigned w) { return __uint_as_float(w << 16); }
__device__ __forceinline__ float bfhi(unsigned w) { return __uint_as_float(w & 0xffff0000u); }
__device__ __forceinline__ float shx(float v, int m, int lane) { return __int_as_float(__builtin_amdgcn_ds_bpermute((lane ^ m) << 2, __float_as_int(v))); }
__device__ __forceinline__ float shl(float v, int src) { return __int_as_float(__builtin_amdgcn_ds_bpermute(src << 2, __float_as_int(v))); }
__device__ __forceinline__ float wave_sum(float v, int lane) {
    v += shx(v, 1, lane); v += shx(v, 2, lane); v += shx(v, 4, lane); v += shx(v, 8, lane); v += shx(v, 16, lane); v += shx(v, 32, lane); return v;
}

__device__ __forceinline__ float uni(float x) { return __builtin_bit_cast(float, __builtin_amdgcn_readfirstlane(__builtin_bit_cast(int, x))); }
__device__ __forceinline__ int hidden_tid(int wv) { int l; asm volatile("v_mbcnt_lo_u32_b32 %0, -1, 0\n\tv_mbcnt_hi_u32_b32 %0, -1, %0" : "=&v"(l)); return (wv << 6) | l; }

#define XB_TMO      128
#define XB_XCNT(j)  (256  + 64 * (j))
#define XB_XSUB(j)  (1280 + 64 * (j))
#define XB_XGEN(j)  (2304 + 64 * (j))
#define XB_TOP      3328
#define XB_TOPGEN   3392
#define XCD_BAR_WORDS 3456
#define XB_SPIN_CAP (1u << 22)
#define LAS __attribute__((address_space(3)))

__device__ __forceinline__ unsigned xb_ld(unsigned* p)              { return __hip_atomic_load(p, __ATOMIC_RELAXED, __HIP_MEMORY_SCOPE_AGENT); }
__device__ __forceinline__ unsigned xb_add(unsigned* p, unsigned v) { return __hip_atomic_fetch_add(p, v, __ATOMIC_RELAXED, __HIP_MEMORY_SCOPE_AGENT); }
__device__ __forceinline__ unsigned xb_xcc_id() { return (unsigned)__builtin_amdgcn_s_getreg((3 << 11) | 20) & 0xFu; }
#define XB_SPIN(cond, bar) do { unsigned _sp = 0; while (cond) { __builtin_amdgcn_s_sleep(1); \
    if ((++_sp & 255u) == 0u) { if (xb_ld(&(bar)[XB_TMO])) break; if (_sp > XB_SPIN_CAP) { atomicAdd(&(bar)[XB_TMO], 1u); break; } } } } while (0)

struct XcdBarrier { unsigned* bar; unsigned x; volatile LAS unsigned* st; };

__device__ __forceinline__ XcdBarrier xcd_barrier_post(unsigned* bar, volatile LAS unsigned* st) {
    XcdBarrier b; b.bar = bar; b.x = xb_xcc_id(); b.st = st;
    if (threadIdx.x == 0) (void)xb_add(&bar[XB_XCNT(b.x)], 1u);
    return b;
}
__device__ __forceinline__ void xcd_barrier_complete(unsigned* bar, unsigned x, unsigned& nloc, unsigned& nx) {
    const unsigned G = gridDim.x * gridDim.y * gridDim.z;
    unsigned sum, cnt, mine, sp = 0u;
    for (;;) {
        sum = 0u; cnt = 0u; mine = 0u;
#pragma unroll
        for (unsigned j = 0; j < 16; ++j) { const unsigned c = xb_ld(&bar[XB_XCNT(j)]); sum += c; cnt += (c > 0u) ? 1u : 0u; mine = (j == x) ? c : mine; }
        if (sum == G) break;
        __builtin_amdgcn_s_sleep(1);
        if ((++sp & 255u) == 0u) { if (xb_ld(&bar[XB_TMO])) break; if (sp > XB_SPIN_CAP) { atomicAdd(&bar[XB_TMO], 1u); break; } }
    }
    nloc = mine > 0u ? mine : 1u; nx = cnt > 0u ? cnt : 1u;
}
__device__ __forceinline__ void xcd_barrier(const XcdBarrier& b) {
    asm volatile("s_waitcnt vmcnt(0)" ::: "memory");
    __syncthreads();
    if (threadIdx.x == 0) {
        unsigned* bar = b.bar; unsigned bx = b.x;
        asm volatile("" : "+s"(bar), "+s"(bx));
        __builtin_amdgcn_s_waitcnt(0);
        unsigned nloc = b.st[0], nx = b.st[1];
        if (nloc == 0u) { xcd_barrier_complete(bar, bx, nloc, nx); b.st[0] = nloc; b.st[1] = nx; }
        const unsigned old = xb_add(&bar[XB_XSUB(bx)], 1u);
        const unsigned gen = old / nloc;
        if (old + 1u == (gen + 1u) * nloc) {
            __builtin_amdgcn_fence(__ATOMIC_RELEASE, "agent");
            asm volatile("s_waitcnt vmcnt(0)" ::: "memory");
            const unsigned og = xb_add(&bar[XB_TOP], 1u);
            const unsigned tg = og / nx;
            if (og + 1u == (tg + 1u) * nx) xb_add(&bar[XB_TOPGEN], 1u);
            else XB_SPIN(xb_ld(&bar[XB_TOPGEN]) == tg, bar);
            __builtin_amdgcn_fence(__ATOMIC_ACQUIRE, "agent");
            xb_add(&bar[XB_XGEN(bx)], 1u);
            asm volatile("s_waitcnt vmcnt(0)" ::: "memory");
        } else {
            XB_SPIN(xb_ld(&bar[XB_XGEN(bx)]) == gen, bar);
            __builtin_amdgcn_fence(__ATOMIC_ACQUIRE, "agent");
            asm volatile("s_waitcnt vmcnt(0)" ::: "memory");
        }
    }
    __syncthreads();
}

constexpr int HT = 128 * 64;
__device__ __forceinline__ int lds_byte(int r, int c) {
    int st = (r >> 4) * 2 + (c >> 5), rr = r & 15, cc = c & 31, ob = rr * 64 + cc * 2;
    return st * 1024 + (ob ^ (((ob >> 9) & 1) << 5));
}
__device__ __forceinline__ void stage_rc(int b, int& R, int& C) {
    int st = b / 1024, sb = b % 1024, swz = sb ^ (((sb >> 9) & 1) << 5);
    R = (st >> 1) * 16 + swz / 64; C = (st & 1) * 32 + (swz % 64) / 2;
}
#define SA(b, h) (shm + ((b) * 2 + (h)) * HT)
#define SB(b, h) (shm + (4 + (b) * 2 + (h)) * HT)
#define G_STAGE_A(P_, h, kt) do { _Pragma("unroll") for (int _i = 0; _i < 2; ++_i) \
    __builtin_amdgcn_global_load_lds((const unsigned*)((const char*)A + (size_t)((kt) * 128 + (RowSrc::DENSE ? (h) * 256 * K : 0)) + aoff[RowSrc::DENSE ? 0 : (h)][_i]), (unsigned*)((char*)(P_) + tid * 16 + _i * 8192), 16, 0, 0); } while (0)
#define G_STAGE_B(P_, h, kt) do { _Pragma("unroll") for (int _i = 0; _i < 2; ++_i) \
    __builtin_amdgcn_global_load_lds((const unsigned*)((const char*)Bt + (size_t)((kt) * 128 + (h) * 64 * K) + boff[_i]), (unsigned*)((char*)(P_) + tid * 16 + _i * 8192), 16, 0, 0); } while (0)
#define G_LDA(dst, b, h) _Pragma("unroll") for (int m = 0; m < 4; ++m) _Pragma("unroll") for (int k = 0; k < 2; ++k) \
    dst[m][k] = *reinterpret_cast<const bf16x8*>((char*)SA(b, h) + lds_byte(wr * 64 + m * 16 + fr, k * 32 + fq * 8))
#define G_LDB(dst, b, h) _Pragma("unroll") for (int n = 0; n < 2; ++n) _Pragma("unroll") for (int k = 0; k < 2; ++k) \
    dst[n][k] = *reinterpret_cast<const bf16x8*>((char*)SB(b, h) + lds_byte(wc * 32 + n * 16 + fr, k * 32 + fq * 8))
#define G_MMA(ai, bj, At_, Bt_) do { __builtin_amdgcn_s_setprio(1); \
    _Pragma("unroll") for (int m = 0; m < 4; ++m) _Pragma("unroll") for (int n = 0; n < 2; ++n) _Pragma("unroll") for (int k = 0; k < 2; ++k) \
      acc[ai][bj][m][n] = __builtin_amdgcn_mfma_f32_16x16x32_bf16(Bt_[n][k], At_[m][k], acc[ai][bj][m][n], 0, 0, 0); \
    __builtin_amdgcn_s_setprio(0); } while (0)
#define WAIT_V(n) asm volatile("s_waitcnt vmcnt(" #n ")" ::: "memory")
#define WAIT_L(n) asm volatile("s_waitcnt lgkmcnt(" #n ")" ::: "memory")
#define BAR __builtin_amdgcn_s_barrier()
#define SCHED __builtin_amdgcn_sched_barrier(0)

typedef f32x4 AccT[2][2][4][2];

template <class RowSrc, class Epi>
__device__ __forceinline__ void gemm_tile(const bf16_t* __restrict__ A, const bf16_t* __restrict__ Bt, const int K,
                                          const int bcol, const RowSrc& rs, const Epi& epi, const int wv) {
    const int tid = hidden_tid(wv);
    int wid = tid >> 6, lane = tid & 63, wr = wid >> 2, wc = wid & 3, fr = lane & 15, fq = lane >> 4;
    unsigned aoff[2][2], boff[2];
#pragma unroll
    for (int i = 0; i < 2; ++i) {
        int R, C; stage_rc(tid * 16 + i * 8192, R, C);
        boff[i] = (unsigned)(((bcol + (R >> 5) * 64 + (R & 31)) * K + C) * 2);
        if (RowSrc::DENSE) { aoff[0][i] = (unsigned)((R * K + C) * 2); aoff[1][i] = 0u; }
        else {
#pragma unroll
            for (int h = 0; h < 2; ++h) aoff[h][i] = (unsigned)((rs(h * 128 + R) * K + C) * 2);
        }
    }
    WAIT_V(0);
    AccT acc = {};
    bf16x8 At[4][2], B0[2][2], B1[2][2];
    const int nt = K / 64;
    G_STAGE_B(SB(0, 0), 0, 0); G_STAGE_A(SA(0, 0), 0, 0);
    G_STAGE_B(SB(0, 1), 1, 0); G_STAGE_A(SA(0, 1), 1, 0);
    if (wr == 1) BAR;
    WAIT_V(4); BAR;
    G_STAGE_B(SB(1, 0), 0, 1); G_STAGE_A(SA(1, 0), 0, 1); G_STAGE_B(SB(1, 1), 1, 1);
    WAIT_V(6); BAR;
    for (int t = 0; t < nt - 2; t += 2) {
        G_LDB(B0, 0, 0); SCHED; G_LDA(At, 0, 0); G_STAGE_A(SA(1, 1), 1, t + 1);
        WAIT_L(8); BAR; WAIT_L(0); G_MMA(0, 0, At, B0); BAR; SCHED;
        G_LDB(B1, 0, 1); G_STAGE_B(SB(0, 0), 0, t + 2);
        BAR; WAIT_L(0); G_MMA(0, 1, At, B1); BAR;
        G_LDA(At, 0, 1); G_STAGE_A(SA(0, 0), 0, t + 2);
        BAR; WAIT_L(0); G_MMA(1, 0, At, B0); BAR; SCHED;
        G_STAGE_B(SB(0, 1), 1, t + 2);
        WAIT_V(6); BAR; G_MMA(1, 1, At, B1); BAR;
        G_LDB(B0, 1, 0); SCHED; G_LDA(At, 1, 0); G_STAGE_A(SA(0, 1), 1, t + 2);
        WAIT_L(8); BAR; WAIT_L(0); G_MMA(0, 0, At, B0); BAR; SCHED;
        G_LDB(B1, 1, 1); G_STAGE_B(SB(1, 0), 0, t + 3);
        BAR; WAIT_L(0); G_MMA(0, 1, At, B1); BAR;
        G_LDA(At, 1, 1); G_STAGE_A(SA(1, 0), 0, t + 3);
        BAR; WAIT_L(0); G_MMA(1, 0, At, B0); BAR; SCHED;
        G_STAGE_B(SB(1, 1), 1, t + 3);
        WAIT_V(6); BAR; G_MMA(1, 1, At, B1); BAR;
    }
    { G_LDB(B0, 0, 0); WAIT_V(0); G_LDA(At, 0, 0); G_STAGE_A(SA(1, 1), 1, nt - 1);
      BAR; WAIT_L(0); G_MMA(0, 0, At, B0); BAR;
      G_LDB(B1, 0, 1); BAR; WAIT_L(0); G_MMA(0, 1, At, B1); BAR;
      G_LDA(At, 0, 1); WAIT_V(4); BAR; WAIT_L(0); G_MMA(1, 0, At, B0); G_MMA(1, 1, At, B1); BAR; }
    { G_LDB(B0, 1, 0); G_LDA(At, 1, 0); WAIT_V(2); BAR; WAIT_L(0); G_MMA(0, 0, At, B0); BAR;
      G_LDB(B1, 1, 1); WAIT_V(0); BAR; WAIT_L(0); G_MMA(0, 1, At, B1); BAR;
      G_LDA(At, 1, 1); BAR; WAIT_L(0); G_MMA(1, 0, At, B0); G_MMA(1, 1, At, B1); BAR; }
    if (wr == 0) BAR;
    int tz = hidden_tid(wv); wid = tz >> 6; lane = tz & 63; wr = wid >> 2; wc = wid & 3; fr = lane & 15; fq = lane >> 4;
    epi(acc, wr * 64 + fr, bcol + wc * 64 + fq * 4);
}

struct RowIdent { static constexpr bool DENSE = true; __device__ __forceinline__ int operator()(int r) const { return r; } };

__device__ __forceinline__ void st_bf16x4(bf16_t* p, const f32x4& v) { u32x2 w; w.x = cvt_pk_bf16(v[0], v[1]); w.y = cvt_pk_bf16(v[2], v[3]); *(u32x2*)p = w; }
__device__ __forceinline__ void st_chan4(bf16_t* q, size_t ld, const f32x4& v) {
    const unsigned a = cvt_pk_bf16(v[0], v[1]), b = cvt_pk_bf16(v[2], v[3]);
    q[0] = (bf16_t)(a & 0xffff); q[ld] = (bf16_t)(a >> 16); q[2 * ld] = (bf16_t)(b & 0xffff); q[3 * ld] = (bf16_t)(b >> 16);
}
constexpr int BJS = 32;
#define EPI_LOOP_AM _Pragma("unroll") for (int ai = 0; ai < 2; ++ai) _Pragma("unroll") for (int m = 0; m < 4; ++m)
#define EPI_LOOP_BN _Pragma("unroll") for (int bj = 0; bj < 2; ++bj) _Pragma("unroll") for (int n = 0; n < 2; ++n)
struct EpiRes {
    float* X; int brow; float* Xo; bf16_t* XB;
    __device__ __forceinline__ void operator()(AccT& acc, int r0, int c0) const {
        EPI_LOOP_AM {
            const size_t off = (size_t)(brow + r0 + ai * 128 + m * 16) * D + c0;
            float* q = X + off; float* qo = Xo + off; bf16_t* qb = XB + off;
            EPI_LOOP_BN {
                f32x4 xin;
                if (RD_E) { const u32x2 xv = *(const u32x2*)(qb + bj * BJS + n * 16); xin = (f32x4){bflo(xv.x), bfhi(xv.x), bflo(xv.y), bfhi(xv.y)}; }
                else xin = *(const f32x4*)(q + bj * BJS + n * 16);
                const f32x4 t = xin + acc[ai][bj][m][n];
                const unsigned a0 = cvt_pk_bf16(t[0], t[1]), a1 = cvt_pk_bf16(t[2], t[3]);
                *(u32x2*)(qb + bj * BJS + n * 16) = (u32x2){a0, a1};
            }
            asm volatile("" ::: "memory");
        }
    }
};
struct EpiSplit {
    bf16_t* Ca; bf16_t* T; bf16_t* Cb; int c0s, c1s, ldT; size_t ldC; int brow;
    __device__ __forceinline__ void chan(AccT& acc, bf16_t* base, int r0, int c) const {
        EPI_LOOP_AM { bf16_t* q = base + (size_t)c * ldC + (brow + r0 + ai * 128 + m * 16);
            EPI_LOOP_BN st_chan4(q + (size_t)(bj * BJS + n * 16) * ldC, ldC, acc[ai][bj][m][n]); }
    }
    __device__ __forceinline__ void operator()(AccT& acc, int r0, int c0) const {
        const int tilec = __builtin_amdgcn_readfirstlane(c0) & ~255;
        if (tilec < c0s) chan(acc, Ca, r0, c0);
        else if (tilec < c1s) {
            EPI_LOOP_AM { bf16_t* q = T + (size_t)(brow + r0 + ai * 128 + m * 16) * ldT + (c0 - c0s);
                EPI_LOOP_BN st_bf16x4(q + bj * BJS + n * 16, acc[ai][bj][m][n]); }
        } else chan(acc, Cb, r0, c0 - c1s);
    }
};
struct EpiGateUp {
    bf16_t* act; const int* list; int cnt, pos0; const float* rstd;
    __device__ __forceinline__ void operator()(AccT& acc, int r0, int c0) const {
        EPI_LOOP_AM {
            const int pos = pos0 + r0 + ai * 128 + m * 16;
            if (pos < cnt) {
                const int a = list[pos];
                const float rs = rstd[a >> 1];
#pragma unroll
                for (int bj = 0; bj < 2; ++bj) {
                    const f32x4 g = acc[ai][bj][m][0] * rs, u = acc[ai][bj][m][1] * rs; f32x4 o;
#pragma unroll
                    for (int j = 0; j < 4; ++j) o[j] = g[j] / (1.0f + __expf(-g[j])) * u[j];
                    const int col = c0 + bj * BJS;
                    const unsigned long long wv8 = ((unsigned long long)cvt_pk_bf16(o[2], o[3]) << 32) | cvt_pk_bf16(o[0], o[1]);
                    __hip_atomic_store((unsigned long long*)(act + (size_t)a * EH + (col >> 5) * 16 + (col & 15)), wv8, __ATOMIC_RELAXED, __HIP_MEMORY_SCOPE_AGENT);
                }
            }
        }
    }
};
struct EpiDown {
    bf16_t* y; const int* list; int cnt, pos0;
    __device__ __forceinline__ void operator()(AccT& acc, int r0, int c0) const {
        EPI_LOOP_AM {
            const int pos = pos0 + r0 + ai * 128 + m * 16;
            if (pos < cnt) { bf16_t* q = y + (size_t)list[pos] * D + c0; EPI_LOOP_BN st_bf16x4(q + bj * BJS + n * 16, acc[ai][bj][m][n]); }
        }
    }
};
struct RowTok { static constexpr bool DENSE = false; const int* list; int cnt, pos0; __device__ __forceinline__ int operator()(int r) const { const int pos = pos0 + r; return pos < cnt ? (list[pos] >> 1) : NTOK; } };
struct RowAsg { static constexpr bool DENSE = false; const int* list; int cnt, pos0; __device__ __forceinline__ int operator()(int r) const { const int pos = pos0 + r; return pos < cnt ? list[pos] : 2 * NTOK; } };

constexpr int ATT_VOFF = 16384;
template <int MODE> struct ACfg;
template <> struct ACfg<0> { static constexpr int DQK = 64, DV = 128, NMAP = 2, KBLK = 2; };
template <> struct ACfg<1> { static constexpr int DQK = 64, DV = 64, NMAP = 1, KBLK = 1; };
template <> struct ACfg<2> { static constexpr int DQK = 128, DV = 128, NMAP = 1, KBLK = 2; };

template <int MODE, bool ALT = false>
__device__ __forceinline__ void attn_unit(const bf16_t* __restrict__ Qp, const int ldq,
                                          const bf16_t* __restrict__ Kp, const int ldk,
                                          const bf16_t* __restrict__ Vt, const size_t ldvt,
                                          const int q0, const int kbeg, const int kend,
                                          const float scale, const float slope, const float m_init, const float l_init,
                                          bf16_t* __restrict__ Op, const int ldo,
                                          const float lam, const float outscale, const float* __restrict__ subln, const int wv) {
    constexpr int DQK = ACfg<MODE>::DQK, DV = ACfg<MODE>::DV, NMAP = ACfg<MODE>::NMAP, KBLK = ACfg<MODE>::KBLK;
    const int tid = hidden_tid(wv), w = tid >> 6, lane = tid & 63, fr = lane & 15, fq = lane >> 4;
    const int qrow = q0 + w * 16 + fr;
    bf16x8 Qf[NMAP][DQK / 32];
#pragma unroll
    for (int m = 0; m < NMAP; ++m)
#pragma unroll
        for (int kk = 0; kk < DQK / 32; ++kk) Qf[m][kk] = *(const bf16x8*)(Qp + (size_t)qrow * ldq + m * DQK + kk * 32 + fq * 8);
    constexpr float LOG2E = 1.4426950408889634f;
    const float scale2 = scale * LOG2E, slope2 = slope * LOG2E, kappa = slope / scale;
    f32x4 O[NMAP][DV / 16], Ol[NMAP];
    float mrun[NMAP];
#pragma unroll
    for (int m = 0; m < NMAP; ++m) {
        mrun[m] = m_init * LOG2E; Ol[m] = (f32x4){(fq == 0) ? l_init : 0.f, 0.f, 0.f, 0.f};
#pragma unroll
        for (int et = 0; et < DV / 16; ++et) O[m][et] = (f32x4){0.f, 0.f, 0.f, 0.f};
    }
    const unsigned onesw = (fr == 0) ? 0x3f803f80u : 0u;
    const bf16x8 onesf = __builtin_bit_cast(bf16x8, (u32x4){onesw, onesw, onesw, onesw});
    char* const lds = (char*)shm;
    constexpr int KN = KBLK, VN = DV / 64;
    u32x4 kreg[KN], vreg[VN];
#define ATT_LOAD(k0_) do { \
        _Pragma("unroll") for (int i_ = 0; i_ < KN; ++i_) { const int c_ = tid + i_ * NT; const int key_ = c_ / (KBLK * 8), col_ = (c_ % (KBLK * 8)) * 8; \
            kreg[i_] = *(const u32x4*)(Kp + (size_t)((k0_) + key_) * ldk + col_); } \
        _Pragma("unroll") for (int i_ = 0; i_ < VN; ++i_) { const int c_ = tid + i_ * NT; const int e_ = c_ >> 3, kc_ = c_ & 7; \
            vreg[i_] = *(const u32x4*)(Vt + (size_t)e_ * ldvt + (k0_) + kc_ * 8); } } while (0)
    ATT_LOAD(kbeg);
    const int qw0 = q0 + w * 16;
    constexpr int VBYTES = DV * 160;
    bf16x8 Pf[NMAP][2];
#define ATT_PV_C(voff_, c) do { \
            bf16x8 vf[DV / 16]; \
            _Pragma("unroll") for (int et = 0; et < DV / 16; ++et) vf[et] = *(const bf16x8*)(lds + (voff_) + (et * 16 + fr) * 160 + (c) * 64 + fq * 16); \
            _Pragma("unroll") for (int m = 0; m < NMAP; ++m) Ol[m] = __builtin_amdgcn_mfma_f32_16x16x32_bf16(onesf, Pf[m][c], Ol[m], 0, 0, 0); \
            _Pragma("unroll") for (int et = 0; et < DV / 16; ++et) \
                _Pragma("unroll") for (int m = 0; m < NMAP; ++m) O[m][et] = __builtin_amdgcn_mfma_f32_16x16x32_bf16(vf[et], Pf[m][c], O[m][et], 0, 0, 0); \
        } while (0)
    int vcur = ATT_VOFF;
    for (int k0 = kbeg; k0 < kend; k0 += 64) {
        __syncthreads();
#pragma unroll
        for (int i = 0; i < KN; ++i) { const int c = tid + i * NT; const int key = c / (KBLK * 8), col = (c % (KBLK * 8)) * 8;
            *(u32x4*)(lds + (col >> 6) * 8192 + lds_byte(key, col & 63)) = kreg[i]; }
#pragma unroll
        for (int i = 0; i < VN; ++i) { const int c = tid + i * NT; const int e = c >> 3, kc = c & 7;
            char* vd = lds + vcur + e * 160 + (kc >> 2) * 64 + (kc & 1) * 32 + ((kc >> 1) & 1) * 8;
            *(u32x2*)vd = (u32x2){vreg[i].x, vreg[i].y}; *(u32x2*)(vd + 16) = (u32x2){vreg[i].z, vreg[i].w}; }
        __syncthreads();
        if (k0 + 64 < kend) ATT_LOAD(k0 + 64);
        const int vprev = vcur ^ ATT_VOFF ^ (ATT_VOFF + VBYTES);
        const float dq = (float)(qrow - k0);
        bool gen;
        if (MODE == 2) gen = false;
        else if (MODE == 1) gen = !((k0 + 63 <= qw0 && qw0 + 15 - k0 <= 128) || (k0 >= qw0 + 15 && k0 + 63 - qw0 <= 128));
        else gen = !(k0 + 63 <= qw0 || k0 >= qw0 + 15);
        const bool pos = (MODE == 2) || (k0 + 63 <= qw0);
        f32x4 Cin[4]; float off;
        if (MODE == 2) {
#pragma unroll
            for (int t = 0; t < 4; ++t) Cin[t] = (f32x4){0.f, 0.f, 0.f, 0.f};
            off = 0.f;
        } else if (gen) {
#pragma unroll
            for (int t = 0; t < 4; ++t)
#pragma unroll
                for (int r = 0; r < 4; ++r) Cin[t][r] = -kappa * fabsf(dq - (float)(16 * t + 4 * fq + r));
            off = 0.f;
        } else {
            const float sk = pos ? kappa : -kappa, cb = sk * (float)(4 * fq);
#pragma unroll
            for (int t = 0; t < 4; ++t)
#pragma unroll
                for (int r = 0; r < 4; ++r) Cin[t][r] = sk * (float)(16 * t + r) + cb;
            off = pos ? -slope2 * dq : slope2 * dq;
        }
        f32x4 s[NMAP][4];
#pragma unroll
        for (int m = 0; m < NMAP; ++m) {
            bf16x8 kf[4][DQK / 32];
#pragma unroll
            for (int t = 0; t < 4; ++t)
#pragma unroll
                for (int kk = 0; kk < DQK / 32; ++kk) {
                    const int blk = (MODE == 2) ? (kk >> 1) : m, kcol = (MODE == 2) ? (kk & 1) * 32 : kk * 32;
                    kf[t][kk] = *(const bf16x8*)(lds + blk * 8192 + lds_byte(t * 16 + fr, kcol + fq * 8));
                }
#pragma unroll
            for (int t = 0; t < 4; ++t) {
                s[m][t] = Cin[t];
#pragma unroll
                for (int kk = 0; kk < DQK / 32; ++kk) s[m][t] = __builtin_amdgcn_mfma_f32_16x16x32_bf16(kf[t][kk], Qf[m][kk], s[m][t], 0, 0, 0);
            }
        }
        float mx[NMAP], mx1[NMAP];
#pragma unroll
        for (int m = 0; m < NMAP; ++m) {
            if (MODE == 1 && gen) {
#pragma unroll
                for (int t = 0; t < 4; ++t)
#pragma unroll
                    for (int r = 0; r < 4; ++r) s[m][t][r] = (fabsf(dq - (float)(16 * t + 4 * fq + r)) > 128.0f) ? -1e30f : s[m][t][r];
            }
            float v = fmaxf(fmaxf(s[m][0][0], s[m][0][1]), fmaxf(s[m][0][2], s[m][0][3]));
#pragma unroll
            for (int t = 1; t < 4; ++t) v = fmaxf(v, fmaxf(fmaxf(s[m][t][0], s[m][t][1]), fmaxf(s[m][t][2], s[m][t][3])));
            mx[m] = v; mx1[m] = shx(v, 16, lane);
        }
        __builtin_amdgcn_sched_barrier(0);
        if (k0 > kbeg) ATT_PV_C(vprev, 0);
        __builtin_amdgcn_sched_barrier(0);
#pragma unroll
        for (int m = 0; m < NMAP; ++m) { mx[m] = fmaxf(mx[m], mx1[m]); mx1[m] = shx(mx[m], 32, lane); }
        __builtin_amdgcn_sched_barrier(0);
        if (k0 > kbeg) ATT_PV_C(vprev, 1);
        __builtin_amdgcn_sched_barrier(0);
#pragma unroll
        for (int m = 0; m < NMAP; ++m) {
            const float mxx = fmaxf(mx[m], mx1[m]);
            const float mtile = fmaxf(mxx * scale2 + off, -1e30f);
            const float mnew = fmaxf(mrun[m], mtile), alpha = __builtin_amdgcn_exp2f(mrun[m] - mnew);
            mrun[m] = mnew;
            const float sub = off - mnew;
#pragma unroll
            for (int t = 0; t < 4; ++t)
#pragma unroll
                for (int r = 0; r < 4; ++r) s[m][t][r] = __builtin_amdgcn_exp2f(s[m][t][r] * scale2 + sub);
            if (__builtin_amdgcn_ballot_w64(alpha != 1.0f) != 0ull) {
                Ol[m] *= alpha;
#pragma unroll
                for (int et = 0; et < DV / 16; ++et) O[m][et] *= alpha;
            }
#pragma unroll
            for (int c = 0; c < 2; ++c) {
                u32x4 pk; pk.x = cvt_pk_bf16(s[m][2 * c][0], s[m][2 * c][1]); pk.y = cvt_pk_bf16(s[m][2 * c][2], s[m][2 * c][3]);
                pk.z = cvt_pk_bf16(s[m][2 * c + 1][0], s[m][2 * c + 1][1]); pk.w = cvt_pk_bf16(s[m][2 * c + 1][2], s[m][2 * c + 1][3]);
                Pf[m][c] = __builtin_bit_cast(bf16x8, pk);
            }
        }
        vcur = vprev;
    }
    { const int vlast = vcur ^ ATT_VOFF ^ (ATT_VOFF + VBYTES); ATT_PV_C(vlast, 0); ATT_PV_C(vlast, 1); }
    float linv[NMAP];
#pragma unroll
    for (int m = 0; m < NMAP; ++m) linv[m] = 1.0f / shl(Ol[m][0], fr);
    const int tid2 = hidden_tid(wv); const int qrow_o = q0 + (tid2 >> 6) * 16 + (tid2 & 15);
    if (MODE == 0) {
        float ss = 0.f;
#pragma unroll
        for (int et = 0; et < DV / 16; ++et)
#pragma unroll
            for (int r = 0; r < 4; ++r) { const float v = O[0][et][r] * linv[0] - lam * (O[NMAP - 1][et][r] * linv[NMAP - 1]); O[0][et][r] = v; ss += v * v; }
        ss += shx(ss, 16, lane); ss += shx(ss, 32, lane);
        const float rs = rsqrtf(ss * (1.0f / 128.0f) + EPS) * outscale;
#pragma unroll
        for (int et = 0; et < DV / 16; ++et) {
            const f32x4 g = *(const f32x4*)(subln + et * 16 + fq * 4);
            st_bf16x4(Op + (size_t)qrow_o * ldo + et * 16 + fq * 4, O[0][et] * rs * g);
        }
    } else {
#pragma unroll
        for (int et = 0; et < DV / 16; ++et) st_bf16x4(Op + (size_t)qrow_o * ldo + et * 16 + fq * 4, O[0][et] * linv[0]);
    }
}

constexpr int HZ_RS = 4896;
constexpr int HZ_PAD = 192;
constexpr int H_CPS = 8256;
constexpr int H_ZOFF = 0, H_CPOFF = 8 * HZ_RS, H_RAWOFF = H_CPOFF + 8 * H_CPS;

template <bool ALT>
__device__ __forceinline__ void hyena_unit(const Params& p, const int lj  , const int c, const int wv) {
    const int tid = hidden_tid(wv), w = tid >> 6, lane = tid & 63, fr = lane & 15, fq = lane >> 4;
    char* const lds = (char*)shm;
    const bf16_t* hyT = (const bf16_t*)(p.ws + WS_PROJ + PR_HYT);
    const float* cw = p.in[4] + (size_t)lj * 3 * 1536; const float* cb = p.in[5] + (size_t)lj * 1536;
    const int nb = fr >> 1, tbp = fr & 1;
    __syncthreads();
    for (int i = tid; i < 8 * 2 * (HZ_PAD / 8); i += NT) {
        const int b = i / (2 * (HZ_PAD / 8)), r = i % (2 * (HZ_PAD / 8)), side = r / (HZ_PAD / 8), k = r % (HZ_PAD / 8);
        unsigned zz0 = 0u; asm volatile("" : "+v"(zz0));
        *(u32x4*)(lds + H_ZOFF + b * HZ_RS + (side ? (HZ_PAD + 2048) * 2 : 0) + k * 16) = (u32x4){zz0, zz0, zz0, zz0};
        if (i < 2) *(u32x4*)(lds + H_RAWOFF + 8192 + i * 16) = (u32x4){zz0, zz0, zz0, zz0};
    }
    {
        const float w0 = cw[c], w1 = cw[1536 + c], w2 = cw[2 * 1536 + c], bb = cb[c];
        const bf16_t* src = hyT + (size_t)c * NTOK;
        u32x4 v[4]; unsigned short um[4], up[4];
#pragma unroll
        for (int k = 0; k < 4; ++k) {
            const int i = tid + k * NT, b = i >> 8, s0 = (i & 255) * 8;
            const bf16_t* q = src + b * S + s0;
            v[k] = *(const u32x4*)q; um[k] = q[s0 > 0 ? -1 : 0]; up[k] = q[s0 + 8 < S ? 8 : 7];
        }
#pragma unroll
        for (int k = 0; k < 4; ++k) {
            const int i = tid + k * NT, b = i >> 8, s0 = (i & 255) * 8;
            float u[10];
            u[0] = (s0 > 0) ? bf2f(um[k]) : 0.f; u[9] = (s0 + 8 < S) ? bf2f(up[k]) : 0.f;
            u[1] = bflo(v[k].x); u[2] = bfhi(v[k].x); u[3] = bflo(v[k].y); u[4] = bfhi(v[k].y); u[5] = bflo(v[k].z); u[6] = bfhi(v[k].z); u[7] = bflo(v[k].w); u[8] = bfhi(v[k].w);
            float o[8];
#pragma unroll
            for (int j = 0; j < 8; ++j) o[j] = w0 * u[j] + w1 * u[j + 1] + w2 * u[j + 2] + bb;
            u32x4 ov; ov.x = cvt_pk_bf16(o[0], o[1]); ov.y = cvt_pk_bf16(o[2], o[3]); ov.z = cvt_pk_bf16(o[4], o[5]); ov.w = cvt_pk_bf16(o[6], o[7]);
            *(u32x4*)(lds + H_ZOFF + b * HZ_RS + (HZ_PAD + s0) * 2) = ov;
        }
    }
#pragma unroll 1
    for (int order = 0; order < 2; ++order) {
        const int gch = 512 * (order + 1) + c;
        const bf16_t* gsrc = hyT + (size_t)gch * NTOK;
        u32x2 gv[2][4]; unsigned short gm[2][4], gp[2][4];
        u32x4 rawv;
        {
            const bf16_t* f = (const bf16_t*)(p.ws + WS_FILT) + ((size_t)(lj * 2 + order) * 512 + c) * 4096;
            rawv = *(const u32x4*)(f + tid * 8);
#pragma unroll
            for (int ci = 0; ci < 2; ++ci)
#pragma unroll
                for (int mt = 0; mt < 4; ++mt) {
                    const int t = 64 * (4 * w + 2 * ci + tbp) + 16 * mt + 4 * fq;
                    const bf16_t* gq = gsrc + nb * S + t;
                    gv[ci][mt] = *(const u32x2*)gq; gm[ci][mt] = gq[t > 0 ? -1 : 0]; gp[ci][mt] = gq[t + 4 < S ? 4 : 3];
                }
        }
        *(u32x4*)(lds + H_RAWOFF + tid * 16) = rawv;
        __syncthreads();
        {
            const bf16_t* raw = (const bf16_t*)(lds + H_RAWOFF);
            const int o = w;
#pragma unroll
            for (int k = 0; k < 8; ++k) {
                const int a = lane + 64 * k;
                unsigned short e[8];
#pragma unroll
                for (int j = 0; j < 8; ++j) e[j] = raw[8 * a + o + j];
                u32x4 ov; ov.x = e[0] | ((unsigned)e[1] << 16); ov.y = e[2] | ((unsigned)e[3] << 16); ov.z = e[4] | ((unsigned)e[5] << 16); ov.w = e[6] | ((unsigned)e[7] << 16);
                *(u32x4*)(lds + H_CPOFF + o * H_CPS + a * 16) = ov;
            }
        }
        __syncthreads();
        f32x4 acc[2][4];
#pragma unroll
        for (int ci = 0; ci < 2; ++ci)
#pragma unroll
            for (int mt = 0; mt < 4; ++mt) acc[ci][mt] = (f32x4){0.f, 0.f, 0.f, 0.f};
        {
            const int acp = H_CPOFF + (7 - (fr & 7)) * H_CPS + (255 - (fr >> 3) + fq) * 16;
            const int zb = H_ZOFF + nb * HZ_RS + (HZ_PAD + 8 * fq) * 2;
            for (int dl = 4 * w - 31; dl <= ((ALT && DUPSEL >= 5) ? 4 * w - 31 : 4 * w + 3); ++dl) {
#pragma unroll
                for (int kh = 0; kh < 2; ++kh) {
                    bf16x8 Bf[2];
#pragma unroll
                    for (int ci = 0; ci < 2; ++ci) {
                        const int sblk = 4 * w + 2 * ci + tbp - dl;
                        Bf[ci] = *(const bf16x8*)(lds + zb + (64 * sblk + 32 * kh) * 2);
                    }
#pragma unroll
                    for (int mt = 0; mt < 4; ++mt) {
                        const int q = 4 * dl + mt - 2 * kh;
                        const bf16x8 Af = *(const bf16x8*)(lds + acp - 32 * q);
#pragma unroll
                        for (int ci = 0; ci < 2; ++ci) acc[ci][mt] = __builtin_amdgcn_mfma_f32_16x16x32_bf16(Af, Bf[ci], acc[ci][mt], 0, 0, 0);
                    }
                }
            }
        }
        const float hb = p.in[12][(size_t)(lj * 2 + order) * 512 + c];
        const float w0 = cw[gch], w1 = cw[1536 + gch], w2 = cw[2 * 1536 + gch], bb = cb[gch];
        u32x2 zout[2][4];
#pragma unroll
        for (int ci = 0; ci < 2; ++ci)
#pragma unroll
            for (int mt = 0; mt < 4; ++mt) {
                const int t = 64 * (4 * w + 2 * ci + tbp) + 16 * mt + 4 * fq;
                const u32x2 zz = *(const u32x2*)(lds + H_ZOFF + nb * HZ_RS + (HZ_PAD + t) * 2);
                float u[6];
                u[0] = (t > 0) ? bf2f(gm[ci][mt]) : 0.f; u[5] = (t + 4 < S) ? bf2f(gp[ci][mt]) : 0.f;
                u[1] = bflo(gv[ci][mt].x); u[2] = bfhi(gv[ci][mt].x); u[3] = bflo(gv[ci][mt].y); u[4] = bfhi(gv[ci][mt].y);
                const float z[4] = {bflo(zz.x), bfhi(zz.x), bflo(zz.y), bfhi(zz.y)};
                float o[4];
#pragma unroll
                for (int r = 0; r < 4; ++r) {
                    const float gate = w0 * u[r] + w1 * u[r + 1] + w2 * u[r + 2] + bb;
                    o[r] = gate * (acc[ci][mt][r] + hb * z[r]);
                }
                zout[ci][mt].x = cvt_pk_bf16(o[0], o[1]); zout[ci][mt].y = cvt_pk_bf16(o[2], o[3]);
            }
        __syncthreads();
        if (order == 0) {
#pragma unroll
            for (int ci = 0; ci < 2; ++ci)
#pragma unroll
                for (int mt = 0; mt < 4; ++mt) {
                    const int t = 64 * (4 * w + 2 * ci + tbp) + 16 * mt + 4 * fq;
                    *(u32x2*)(lds + H_ZOFF + nb * HZ_RS + (HZ_PAD + t) * 2) = zout[ci][mt];
                }
        } else {
            bf16_t* yt = (bf16_t*)(p.ws + WS_QX) + (size_t)c * NTOK;
#pragma unroll
            for (int ci = 0; ci < 2; ++ci)
#pragma unroll
                for (int mt = 0; mt < 4; ++mt) {
                    const int t = 64 * (4 * w + 2 * ci + tbp) + 16 * mt + 4 * fq;
                    *(u32x2*)(yt + nb * S + t) = zout[ci][mt];
                }
        }
        __syncthreads();
    }
}

struct Row16 { f32x4 v[4]; };
__device__ __forceinline__ void ld_row(Row16& r, const float* src, int lane) {
#pragma unroll
    for (int i = 0; i < 4; ++i) r.v[i] = *(const f32x4*)(src + 256 * i + 4 * lane);
}
__device__ __forceinline__ void ld_row_bf(Row16& r, const bf16_t* src, int lane) {
#pragma unroll
    for (int i = 0; i < 4; ++i) { const u32x2 v = *(const u32x2*)(src + 256 * i + 4 * lane); r.v[i] = (f32x4){bflo(v.x), bfhi(v.x), bflo(v.y), bfhi(v.y)}; }
}
__device__ __forceinline__ float row_rstd(const Row16& r, int lane) {
    float ss = 0.f;
#pragma unroll
    for (int i = 0; i < 4; ++i) ss += r.v[i][0] * r.v[i][0] + r.v[i][1] * r.v[i][1] + r.v[i][2] * r.v[i][2] + r.v[i][3] * r.v[i][3];
    ss = wave_sum(ss, lane);
    return rsqrtf(ss * (1.0f / 1024.0f) + EPS);
}
template <int KIND  , bool ALT = false>
__device__ __forceinline__ void norm_phase(const Params& p, const int layer, const float* __restrict__ gain, const int bid, const int nb, const int wv) {
    const int tid_ = hidden_tid(wv), lane = tid_ & 63, w = tid_ >> 6;
    float* X = (float*)(p.ws + WS_X);
    float* Xo = ALT ? (float*)(p.ws + WS_PROJ) : X;
    bf16_t* H = (bf16_t*)(p.ws + (ALT ? WS_QX : WS_H));
    const bf16_t* Y = (const bf16_t*)(p.ws + WS_Y);
    const float* WT = (const float*)(p.ws + WS_WT);
    Row16 g; ld_row(g, gain, lane);
    for (int tok = bid * 8 + w; tok < NTOK; tok += nb * 8) {
        Row16 x;
        if (KIND == 0 && layer == 0) ld_row(x, p.in[0] + (size_t)tok * D, lane); else if (RD_N) ld_row_bf(x, (const bf16_t*)(p.ws + WS_XB) + (size_t)tok * D, lane); else ld_row(x, X + (size_t)tok * D, lane);
        if ((KIND == 0 && layer > 0) || KIND == 2) {
            const float w0 = WT[2 * tok], w1 = WT[2 * tok + 1];
            const bf16_t* y0 = Y + (size_t)(2 * tok) * D; const bf16_t* y1 = y0 + D;
#pragma unroll
            for (int i = 0; i < 4; ++i) {
                const u32x2 a = *(const u32x2*)(y0 + 256 * i + 4 * lane), b = *(const u32x2*)(y1 + 256 * i + 4 * lane);
                x.v[i][0] += w0 * bflo(a.x) + w1 * bflo(b.x); x.v[i][1] += w0 * bfhi(a.x) + w1 * bfhi(b.x);
                x.v[i][2] += w0 * bflo(a.y) + w1 * bflo(b.y); x.v[i][3] += w0 * bfhi(a.y) + w1 * bfhi(b.y);
            }
        }
        const float rstd = row_rstd(x, lane);
        if (KIND == 2) {
#pragma unroll
            for (int i = 0; i < 4; ++i) *(f32x4*)(p.out + (size_t)tok * D + 256 * i + 4 * lane) = x.v[i] * rstd * g.v[i];
        } else {
            if (KIND == 0) {
#pragma unroll
                for (int i = 0; i < 4; ++i) { const unsigned a0 = cvt_pk_bf16(x.v[i][0], x.v[i][1]), a1 = cvt_pk_bf16(x.v[i][2], x.v[i][3]); *(u32x2*)((bf16_t*)(p.ws + WS_XB) + (size_t)tok * D + 256 * i + 4 * lane) = (u32x2){a0, a1}; }
            }
#pragma unroll
            for (int i = 0; i < 4; ++i) st_bf16x4(H + (size_t)tok * D + 256 * i + 4 * lane, x.v[i] * rstd * g.v[i]);
        }
    }
}

template <bool ALT>
__device__ __forceinline__ void route_phase(const Params& p, const int layer, const int bid, const int nb, const int wv) {
    const int tid = hidden_tid(wv), lane = tid & 63, w = tid >> 6, fr = lane & 15, fq = lane >> 4;
    float* part = (float*)shm;
    float* ssql = part + 2 * 64 * 48;
    int* cntl = (int*)((char*)shm + LDS_ROUTE);
    int* basel = cntl + 32;
    int* sel = basel + 32;
    int* posl = sel + 128;
    const float* X = (const float*)(p.ws + WS_X);
    bf16_t* H = (bf16_t*)(p.ws + WS_H);
    float* WT = (float*)(p.ws + (ALT ? WS_ACT + (size_t)4 * 1024 * 1024 : WS_WT));
    float* RSTD = (float*)(p.ws + (ALT ? WS_ACT + (size_t)5 * 1024 * 1024 : WS_RSTD));
    int* LIST = (int*)(p.ws + (ALT ? WS_ACT : WS_LIST));
    int* CNT = (int*)(p.ws + WS_CNT) + (layer + (ALT ? 4 : 0)) * NEXP * CNT_STRIDE;
    const float* bg = p.in[26] + layer * 4; const float* be = p.in[28] + layer * NEXP;
    const float* gain = p.in[24] + (size_t)layer * D;
    const bf16_t* Wh = (const bf16_t*)(p.ws + WS_WRT) + (size_t)layer * 2 * 48 * 1024; const bf16_t* Wl = Wh + 48 * 1024;
    const int mt = w & 3, kh = w >> 2;
    for (int chunk = bid; chunk < NTOK / 64; chunk += nb) {
        __syncthreads();
        if (tid < 32) cntl[tid] = 0;
        const int tok = chunk * 64 + mt * 16 + fr;
        const unsigned xoff = (unsigned)((tok * D + kh * 512 + fq * 8) * 4), woff = (unsigned)((fr * 1024 + kh * 512 + fq * 8) * 2), hoff = (unsigned)((tok * D + kh * 512 + fq * 8) * 2);
        const char* const Xc = (const char*)X; const char* const Whc = (const char*)Wh; const char* const Wlc = (const char*)Wl; char* const Hc = (char*)H;
        f32x4 acc[3];
#pragma unroll
        for (int nt = 0; nt < 3; ++nt) acc[nt] = (f32x4){0.f, 0.f, 0.f, 0.f};
        float ssq = 0.f;
        constexpr int PF = 2;
        f32x4 xa[PF][2]; bf16x8 Bh[PF][3], Bl[PF][3];
#define ROUTE_LOAD(slot, ko_) do { if (RD_R) { const u32x4 xb_ = *(const u32x4*)((const char*)(p.ws + WS_XB) + ((xoff >> 1) + (unsigned)(ko_) * 2u)); xa[slot][0] = (f32x4){bflo(xb_.x), bfhi(xb_.x), bflo(xb_.y), bfhi(xb_.y)}; xa[slot][1] = (f32x4){bflo(xb_.z), bfhi(xb_.z), bflo(xb_.w), bfhi(xb_.w)}; } else { xa[slot][0] = *(const f32x4*)(Xc + (xoff + (unsigned)(ko_) * 4u)); xa[slot][1] = *(const f32x4*)(Xc + (xoff + (unsigned)(ko_) * 4u + 16u)); } \
        _Pragma("unroll") for (int nt = 0; nt < 3; ++nt) { Bh[slot][nt] = *(const bf16x8*)(Whc + (woff + (unsigned)(nt * 16 * 2048) + (unsigned)(ko_) * 2u)); Bl[slot][nt] = *(const bf16x8*)(Wlc + (woff + (unsigned)(nt * 16 * 2048) + (unsigned)(ko_) * 2u)); } } while (0)
#pragma unroll
        for (int i = 0; i < PF; ++i) ROUTE_LOAD(i, i * 32);
#pragma unroll 1
        for (int kb = 0; kb < 512; kb += PF * 32) {
#pragma unroll
            for (int i = 0; i < PF; ++i) {
                const f32x4 x0 = xa[i][0], x1 = xa[i][1];
                ssq += x0[0] * x0[0] + x0[1] * x0[1] + x0[2] * x0[2] + x0[3] * x0[3] + x1[0] * x1[0] + x1[1] * x1[1] + x1[2] * x1[2] + x1[3] * x1[3];
                u32x4 hi; hi.x = cvt_pk_bf16(x0[0], x0[1]); hi.y = cvt_pk_bf16(x0[2], x0[3]); hi.z = cvt_pk_bf16(x1[0], x1[1]); hi.w = cvt_pk_bf16(x1[2], x1[3]);
                u32x4 lo;
                lo.x = cvt_pk_bf16(x0[0] - bflo(hi.x), x0[1] - bfhi(hi.x)); lo.y = cvt_pk_bf16(x0[2] - bflo(hi.y), x0[3] - bfhi(hi.y));
                lo.z = cvt_pk_bf16(x1[0] - bflo(hi.z), x1[1] - bfhi(hi.z)); lo.w = cvt_pk_bf16(x1[2] - bflo(hi.w), x1[3] - bfhi(hi.w));
                *(u32x4*)(Hc + (hoff + (unsigned)(kb + i * 32) * 2u)) = hi;
                const bf16x8 Ah = __builtin_bit_cast(bf16x8, hi), Al = __builtin_bit_cast(bf16x8, lo);
#pragma unroll
                for (int nt = 0; nt < 3; ++nt) {
                    acc[nt] = __builtin_amdgcn_mfma_f32_16x16x32_bf16(Ah, Bh[i][nt], acc[nt], 0, 0, 0);
                    acc[nt] = __builtin_amdgcn_mfma_f32_16x16x32_bf16(Ah, Bl[i][nt], acc[nt], 0, 0, 0);
                    acc[nt] = __builtin_amdgcn_mfma_f32_16x16x32_bf16(Al, Bh[i][nt], acc[nt], 0, 0, 0);
                }
                if (kb + PF * 32 < 512) ROUTE_LOAD(i, kb + (PF + i) * 32);
            }
        }
        ssq += shx(ssq, 16, lane); ssq += shx(ssq, 32, lane);
        if (fq == 0) ssql[kh * 64 + mt * 16 + fr] = ssq;
#pragma unroll
        for (int nt = 0; nt < 3; ++nt)
#pragma unroll
            for (int r = 0; r < 4; ++r) part[(kh * 64 + mt * 16 + fq * 4 + r) * 48 + nt * 16 + fr] = acc[nt][r];
        __syncthreads();
        if (tid < 64) {
            const int tl = tid, tk = chunk * 64 + tl;
            const float rstd = rsqrtf((ssql[tl] + ssql[64 + tl]) * (1.0f / 1024.0f) + EPS);
            const float* p0 = part + tl * 48; const float* p1 = part + (64 + tl) * 48;
            float lg[36];
#pragma unroll
            for (int j = 0; j < 36; ++j) lg[j] = (p0[j] + p1[j]) * rstd;
            float g0 = lg[0] + bg[0], g1 = lg[1] + bg[1], g2 = lg[2] + bg[2], g3 = lg[3] + bg[3];
            int gs = 0; float gm = g0;
            if (g1 > gm) { gm = g1; gs = 1; } if (g2 > gm) { gm = g2; gs = 2; } if (g3 > gm) { gm = g3; gs = 3; }
            const float gden = __expf(g0 - gm) + __expf(g1 - gm) + __expf(g2 - gm) + __expf(g3 - gm);
            const float ggate = 1.0f / gden;
            float ev[8];
#pragma unroll
            for (int j = 0; j < 8; ++j) {
                const float a0 = lg[4 + j] + be[j], a1 = lg[12 + j] + be[8 + j], a2 = lg[20 + j] + be[16 + j], a3 = lg[28 + j] + be[24 + j];
                ev[j] = gs == 0 ? a0 : gs == 1 ? a1 : gs == 2 ? a2 : a3;
            }
            int i0 = 0; float v0 = ev[0];
#pragma unroll
            for (int j = 1; j < 8; ++j) if (ev[j] > v0) { v0 = ev[j]; i0 = j; }
            int i1 = -1; float v1 = -3.0e38f;
#pragma unroll
            for (int j = 0; j < 8; ++j) if (j != i0 && ev[j] > v1) { v1 = ev[j]; i1 = j; }
            const float e1 = __expf(v1 - v0), sden = 1.0f / (1.0f + e1);
            const int ea = gs * 8 + i0, eb = gs * 8 + i1;
            sel[2 * tl] = ea; posl[2 * tl] = atomicAdd(&cntl[ea], 1);
            sel[2 * tl + 1] = eb; posl[2 * tl + 1] = atomicAdd(&cntl[eb], 1);
            WT[2 * tk] = ggate * sden; WT[2 * tk + 1] = ggate * e1 * sden;
            RSTD[tk] = rstd;
        }
        __syncthreads();
        if (tid < 32) { const int c = cntl[tid]; basel[tid] = c > 0 ? atomicAdd(&CNT[tid * CNT_STRIDE], c) : 0; }
        __syncthreads();
        if (tid < 128) { const int e = sel[tid]; LIST[(size_t)e * NTOK + basel[e] + posl[tid]] = 128 * chunk + tid; }
    }
}

template <int MODE>
__device__ __forceinline__ void cvt_job(const float* __restrict__ src, bf16_t* __restrict__ dst, const int K, const int N, const int nmat,
                                        const size_t dst_mat_stride, const int bid, const int nb, const int wv, const float* __restrict__ kgain = nullptr) {
    float* T = (float*)shm;
    const int tid = hidden_tid(wv);
    const int tk = K / 64, tn = N / 256, per = tk * tn, total = per * nmat;
    for (int t = bid; t < total; t += nb) {
        const int mat = t / per, r = t % per, k0 = (r / tn) * 64, n0 = (r % tn) * 256;
        const float* s = src + (size_t)mat * K * N + (size_t)k0 * N + n0;
        bf16_t* d = dst + (size_t)mat * dst_mat_stride;
        f32x4 v[8];
#pragma unroll
        for (int i = 0; i < 8; ++i) v[i] = *(const f32x4*)(s + (size_t)((tid >> 6) + 8 * i) * N + (tid & 63) * 4);
        if (MODE != 0) {
#pragma unroll
            for (int i = 0; i < 8; ++i) v[i] *= kgain[(size_t)(mat >> 5) * D + k0 + (tid >> 6) + 8 * i];
        }
        __syncthreads();
#pragma unroll
        for (int i = 0; i < 8; ++i) {
            float* q = T + ((tid >> 6) + 8 * i) * 257 + (tid & 63) * 4;
            q[0] = v[i][0]; q[1] = v[i][1]; q[2] = v[i][2]; q[3] = v[i][3];
        }
        __syncthreads();
#pragma unroll
        for (int j = 0; j < 4; ++j) {
            const int n = (tid >> 3) + 64 * j, kc = (tid & 7) * 8;
            float e[8];
#pragma unroll
            for (int jj = 0; jj < 8; ++jj) e[jj] = T[(kc + jj) * 257 + n];
            u32x4 ov; ov.x = cvt_pk_bf16(e[0], e[1]); ov.y = cvt_pk_bf16(e[2], e[3]); ov.z = cvt_pk_bf16(e[4], e[5]); ov.w = cvt_pk_bf16(e[6], e[7]);
            const int ng = n0 + n;
            const int row = (MODE == 0) ? ng : ((ng >> 4) * 32 + (ng & 15) + (MODE == 2 ? 16 : 0));
            *(u32x4*)(d + (size_t)row * K + k0 + kc) = ov;
        }
    }
}

__device__ __forceinline__ void prologue0(const Params& p, const int bid, const int nb, const int wv) {
    unsigned char* ws = p.ws;
    cvt_job<0>(p.in[3], (bf16_t*)(ws + WS_W_EIN), 1024, 3072, 2, (size_t)3072 * 1024, bid, nb, wv);
    cvt_job<0>(p.in[15], (bf16_t*)(ws + WS_W_EOUT), 1024, 1024, 2, (size_t)1024 * 1024, bid, nb, wv);
    cvt_job<0>(p.in[17], (bf16_t*)(ws + WS_W_OIN), 1024, 1536, 2, (size_t)1536 * 1024, bid, nb, wv);
    cvt_job<0>(p.in[19], (bf16_t*)(ws + WS_W_OOUT), 1024, 1024, 2, (size_t)1024 * 1024, bid, nb, wv);
    cvt_job<0>(p.in[21], (bf16_t*)(ws + WS_W_CQ), 1024, 512, 4, (size_t)512 * 1024, bid, nb, wv);
    cvt_job<0>(p.in[22], (bf16_t*)(ws + WS_W_CKV), 1024, 1024, 4, (size_t)1024 * 1024, bid, nb, wv);
    cvt_job<0>(p.in[23], (bf16_t*)(ws + WS_W_CO), 512, 1024, 4, (size_t)1024 * 512, bid, nb, wv);
    cvt_job<1>(p.in[29], (bf16_t*)(ws + WS_W_GU), 1024, 512, 128, (size_t)1024 * 1024, bid, nb, wv, p.in[24]);
    cvt_job<2>(p.in[30], (bf16_t*)(ws + WS_W_GU), 1024, 512, 128, (size_t)1024 * 1024, bid, nb, wv, p.in[24]);
    cvt_job<0>(p.in[31], (bf16_t*)(ws + WS_W_DN), 512, 1024, 128, (size_t)1024 * 512, bid, nb, wv);
    const int tid = hidden_tid(wv), lane = tid & 63, w = tid >> 6;
    {
        Row16 g; ld_row(g, p.in[32], lane);
        bf16_t* MN = (bf16_t*)(ws + WS_MEMN);
        for (int r = bid * 8 + w; r < Bb * MEM; r += nb * 8) {
            Row16 x; ld_row(x, p.in[1] + (size_t)r * D, lane);
            const float rstd = row_rstd(x, lane);
#pragma unroll
            for (int i = 0; i < 4; ++i) st_bf16x4(MN + (size_t)r * D + 256 * i + 4 * lane, x.v[i] * rstd * g.v[i]);
        }
    }
    {
        float* A2 = (float*)(ws + WS_A2);
        for (int r = bid * 8 + w; r < 2 * S; r += nb * 8) {
            const int lj = r / S, pos = r % S;
            const float* w1 = p.in[6] + (size_t)lj * 33 * 64; const float* b1 = p.in[7] + lj * 64;
            const float* w2 = p.in[8] + (size_t)lj * 64 * 64; const float* b2 = p.in[9] + lj * 64;
            const float fr_ = p.in[11][lj * 64 + lane];
            float a = ((float)pos / 2047.0f) * w1[lane];
#pragma unroll 1
            for (int k = 0; k < 16; ++k) {
                const float band = 1e-4f + (float)k * ((15.0f - 1e-4f) / 15.0f);
                const float ang = band * (6.283185307179586f * (float)pos / 2048.0f);
                a += cosf(ang) * w1[(1 + k) * 64 + lane] - sinf(ang) * w1[(17 + k) * 64 + lane];
            }
            const float a1 = sinf(fr_ * (a + b1[lane]));
            float a2 = 0.f;
#pragma unroll 1
            for (int i = 0; i < 64; ++i) a2 += shl(a1, i) * w2[i * 64 + lane];
            A2[(size_t)r * 64 + lane] = sinf(fr_ * (a2 + b2[lane]));
        }
    }
    {
        bf16_t* WR = (bf16_t*)(ws + WS_WRT);
        for (int i = bid * NT + tid; i < 4 * 48 * 1024; i += nb * NT) {
            const int l = i / (48 * 1024), r = i % (48 * 1024), j = r >> 10, k = r & 1023;
            float v = 0.f;
            if (j < 4) v = p.in[25][((size_t)l * D + k) * 4 + j]; else if (j < 36) v = p.in[27][((size_t)l * D + k) * NEXP + (j - 4)];
            v *= p.in[24][(size_t)l * D + k];
            const unsigned h = cvt_pk_bf16(v, 0.f) & 0xffffu;
            const unsigned lo = cvt_pk_bf16(v - bflo(h), 0.f) & 0xffffu;
            WR[(size_t)l * 2 * 48 * 1024 + r] = (bf16_t)h; WR[(size_t)l * 2 * 48 * 1024 + 48 * 1024 + r] = (bf16_t)lo;
        }
    }
    if (bid == 0) {
        if (tid < 2) {
            const float* lm = p.in[13] + (size_t)tid * 4 * 64;
            float s01 = 0.f, s23 = 0.f;
            for (int i = 0; i < 64; ++i) { s01 += lm[i] * lm[64 + i]; s23 += lm[128 + i] * lm[192 + i]; }
            const float lam_init = 0.8f - 0.6f * expf(-0.3f * (float)(2 * tid));
            ((float*)(ws + WS_MISC))[tid] = expf(s01) - expf(s23) + lam_init;
            ((float*)(ws + WS_MISC))[2 + tid] = 1.0f - lam_init;
        }
        bf16_t* hz = (bf16_t*)(ws + WS_H) + (size_t)NTOK * D; bf16_t* az = (bf16_t*)(ws + WS_ACT) + (size_t)2 * NTOK * EH;
        for (int i = tid; i < D; i += NT) hz[i] = 0;
        for (int i = tid; i < EH; i += NT) az[i] = 0;
    }
}

__device__ __forceinline__ void filter_taps(const Params& p, const int bid, const int nb, const int wv) {
    float* sA = (float*)shm;
    float* sW = sA + 64 * 65;
    const int tid = hidden_tid(wv);
    const float* A2 = (const float*)(p.ws + WS_A2);
    bf16_t* FL = (bf16_t*)(p.ws + WS_FILT);
    for (int job = bid; job < 2 * 4 * 8 * 32; job += nb) {
        const int pt = job & 31, ct = (job >> 5) & 7, od = (job >> 8) & 3, lj = job >> 10;
        const int pos0 = pt * 64, ch0 = ct * 64, order = od >> 1, dir = od & 1;
        const float* w3 = p.in[10] + (size_t)lj * 64 * 2048 + od * 512 + ch0;
        __syncthreads();
        for (int i = tid; i < 4096; i += NT) { sA[(i >> 6) * 65 + (i & 63)] = A2[((size_t)lj * S + pos0 + (i >> 6)) * 64 + (i & 63)]; sW[i] = w3[(size_t)(i >> 6) * 2048 + (i & 63)]; }
        __syncthreads();
        const int pl = tid & 63, cg = tid >> 6, pos = pos0 + pl;
        float acc[8];
#pragma unroll
        for (int k = 0; k < 8; ++k) acc[k] = 0.f;
#pragma unroll 2
        for (int j = 0; j < 64; ++j) {
            const float a = sA[pl * 65 + j];
#pragma unroll
            for (int k = 0; k < 8; ++k) acc[k] += a * sW[j * 64 + cg * 8 + k];
        }
        const float tpos = (float)pos / 2047.0f;
        const float mind = logf(1e-2f) / 1.5f, maxd = logf(1e-2f) / 0.3f;
#pragma unroll
        for (int k = 0; k < 8; ++k) {
            const int ch = ch0 + cg * 8 + k;
            const float delta = mind + (float)ch * ((maxd - mind) / 511.0f);
            const float v = acc[k] * expf(-tpos * fabsf(delta));
            bf16_t* f = FL + ((size_t)(lj * 2 + order) * 512 + ch) * 4096;
            const unsigned short hv = (unsigned short)(cvt_pk_bf16(v, 0.f) & 0xffff);
            if (dir == 0) f[2047 - pos] = hv;
            else { if (pos >= 1) f[2047 + pos] = hv; if (pos == 2047) f[4095] = 0; }
        }
    }
}

enum { PH_P0 = 0, PH_P1, PH_N1, PH_GIN, PH_MIX, PH_GOUT, PH_N2, PH_GQ, PH_XATT, PH_GO, PH_ROUTE, PH_G1, PH_G2, PH_FINAL, PH_TR, PH_COUNT };

template <class Epi>
__device__ __forceinline__ void gemm_dense(const bf16_t* A, const bf16_t* Bt, const int K, const int nM, const int nN, Epi epi, const int bid, const int nb, const int wv) {
    for (int u = bid; u < nM * nN; u += nb) {
        const int pm = u / nN, pn = u % nN;
        epi.brow = pm * 256;
        gemm_tile(A + (size_t)pm * 256 * K, Bt, K, pn * 256, RowIdent{}, epi, wv);
    }
}

typedef const __attribute__((address_space(4))) Params* ParamsK;
#define PHASE_FN __forceinline__
template <int PH, bool ALT = false>
__device__ PHASE_FN void run_phase(ParamsK pk_, const int layer, const int bid_, const int nb_, const int wv_) {
    ParamsK pk = pk_; asm volatile("" : "+s"(pk));
    int bid = bid_, nb = nb_, wv = wv_; asm volatile("" : "+s"(bid), "+s"(nb), "+s"(wv));
    const Params& p = *(const Params*)pk;
    unsigned char* ws = p.ws;
    const int lj = layer >> 1; const bool even = (layer & 1) == 0;
    bf16_t* H = (bf16_t*)(ws + WS_H);
    float* X = (float*)(ws + WS_X);
    bf16_t* YMIX = (bf16_t*)(ws + WS_YMIX);
    bf16_t* QX = (bf16_t*)(ws + WS_QX);
    bf16_t* OX = (bf16_t*)(ws + WS_OX);
    if constexpr (PH == PH_P0) { prologue0(p, bid, nb, wv); }
    if constexpr (PH == PH_N1) {
        norm_phase<0, ALT>(p, layer, (even ? p.in[2] : p.in[16]) + (size_t)lj * D, bid, nb, wv);
        if (layer == 0 && !ALT) filter_taps(p, bid, nb, wv);
    }
    if constexpr (PH == PH_GIN) {
        if (even) {
            EpiSplit e{(bf16_t*)(ws + WS_PROJ + PR_HYT), (bf16_t*)(ws + WS_PROJ + PR_QK), (bf16_t*)(ws + WS_PROJ + PR_VT), 1536, 2560, 1024, (size_t)NTOK, 0};
            gemm_dense(H, (const bf16_t*)(ws + WS_W_EIN) + (size_t)lj * 3072 * 1024, 1024, 64, 12, e, bid, nb, wv);
        } else {
            EpiSplit e{nullptr, (bf16_t*)(ws + WS_PROJ), (bf16_t*)(ws + WS_PROJ + PR_OVT), 0, 1280, 1280, (size_t)NTOK, 0};
            gemm_dense(H, (const bf16_t*)(ws + WS_W_OIN) + (size_t)lj * 1536 * 1024, 1024, 64, 6, e, bid, nb, wv);
        }
    }
    if constexpr (PH == PH_MIX) {
        if (even) {
            const bf16_t* qk = (const bf16_t*)(ws + WS_PROJ + PR_QK);
            const bf16_t* vT = (const bf16_t*)(ws + WS_PROJ + PR_VT);
            const float lam = uni(((const float*)(ws + WS_MISC))[lj]);
            const float oscale = uni(((const float*)(ws + WS_MISC))[2 + lj]);
            for (int u = bid + ((ALT && (DUPSEL == 4 || DUPSEL >= 7)) ? 512 : 0); u < ((ALT && (DUPSEL == 3 || DUPSEL == 5 || DUPSEL == 6)) ? 512 : 1024); u += nb) {
                if (u < 512) hyena_unit<ALT>(p, lj, u, wv);
                else {
                    const int id = u - 512, b = id >> 6, h = (id >> 4) & 3, qb = id & 15;
                    attn_unit<0, ALT>(qk + (size_t)(b * S) * 1024 + 2 * h * 64, 1024, qk + (size_t)(b * S) * 1024 + 512 + 2 * h * 64, 1024,
                                 vT + (size_t)(h * 128) * NTOK + b * S, (size_t)NTOK, qb * 128, 0, S,
                                 0.125f, uni(exp2f(-2.0f * (float)(h + 1))), -1e30f, 0.f,
                                 (ALT ? (bf16_t*)(ws + WS_Y) : YMIX) + (size_t)(b * S) * D + 512 + h * 128, D, lam, oscale, p.in[14] + (size_t)lj * 128, wv);
                }
            }
        } else {
            const bf16_t* qk = (const bf16_t*)(ws + WS_PROJ);
            const bf16_t* vT = (const bf16_t*)(ws + WS_PROJ + PR_OVT);
            for (int u = bid; u < 2048; u += nb) {
                const int b = u >> 8, hq = (u >> 4) & 15, qb = u & 15, kv = hq >> 2, q0 = qb * 128;
                const int kbeg = q0 - 128 < 0 ? 0 : q0 - 128, kend = q0 + 256 > S ? S : q0 + 256;
                attn_unit<1>(qk + (size_t)(b * S) * 1280 + hq * 64, 1280, qk + (size_t)(b * S) * 1280 + 1024 + kv * 64, 1280,
                             vT + (size_t)(kv * 64) * NTOK + b * S, (size_t)NTOK, q0, kbeg, kend,
                             0.125f, uni(exp2f(-0.5f * (float)(hq + 1))), uni(p.in[18][lj * 16 + hq]), 1.0f,
                             YMIX + (size_t)(b * S) * D + hq * 64, D, 0.f, 1.f, nullptr, wv);
            }
        }
    }
    if constexpr (PH == PH_TR) {
        const int tid = hidden_tid(wv);
        const bf16_t* yt = (const bf16_t*)(ws + WS_QX);
        bf16_t* T = shm;
        for (int t = bid; t < 8 * 256; t += nb) {
            const int c0 = (t & 7) * 64, tk0 = (t >> 3) * 64;
            const u32x4 v = *(const u32x4*)(yt + (size_t)(c0 + (tid >> 3)) * NTOK + tk0 + (tid & 7) * 8);
            __syncthreads();
            *(u32x4*)((char*)T + (tid >> 3) * 144 + (tid & 7) * 16) = v;
            __syncthreads();
            const int tok = tid >> 3, cg = (tid & 7) * 8;
            unsigned short e[8];
#pragma unroll
            for (int j = 0; j < 8; ++j) e[j] = T[(cg + j) * 72 + tok];
            u32x4 ov; ov.x = e[0] | ((unsigned)e[1] << 16); ov.y = e[2] | ((unsigned)e[3] << 16); ov.z = e[4] | ((unsigned)e[5] << 16); ov.w = e[6] | ((unsigned)e[7] << 16);
            *(u32x4*)(YMIX + (size_t)(tk0 + tok) * D + c0 + cg) = ov;
        }
    }
    if constexpr (PH == PH_GOUT) {
        EpiRes e{X, 0, ALT ? (float*)(ws + WS_Y) : X, (bf16_t*)(ws + WS_XB)};
        gemm_dense(YMIX, (const bf16_t*)(ws + (even ? WS_W_EOUT : WS_W_OOUT)) + (size_t)lj * 1024 * 1024, 1024, 64, 4, e, bid, nb, wv);
    }
    if constexpr (PH == PH_N2) { norm_phase<1>(p, layer, p.in[20] + (size_t)layer * D, bid, nb, wv); }
    if constexpr (PH == PH_GQ) {
        for (int u = bid; u < 128 + 32; u += nb) {
            if (u < 128) {
                const int pm = u >> 1, pn = u & 1;
                EpiSplit e{nullptr, QX, nullptr, 0, 512, 512, (size_t)NTOK, pm * 256};
                gemm_tile(H + (size_t)pm * 256 * 1024, (const bf16_t*)(ws + WS_W_CQ) + (size_t)layer * 512 * 1024, 1024, pn * 256, RowIdent{}, e, wv);
            } else {
                const int v = u - 128, pm = v >> 2, pn = v & 3;
                EpiSplit e{nullptr, (bf16_t*)(ws + WS_XK) + (size_t)layer * 2048 * 512, (bf16_t*)(ws + WS_XVT) + (size_t)layer * 512 * 2048, 0, 512, 512, (size_t)2048, pm * 256};
                gemm_tile((const bf16_t*)(ws + WS_MEMN) + (size_t)pm * 256 * 1024, (const bf16_t*)(ws + WS_W_CKV) + (size_t)layer * 1024 * 1024, 1024, pn * 256, RowIdent{}, e, wv);
            }
        }
    }
    if constexpr (PH == PH_XATT) {
        const bf16_t* xk = (const bf16_t*)(ws + WS_XK) + (size_t)layer * 2048 * 512;
        const bf16_t* xvt = (const bf16_t*)(ws + WS_XVT) + (size_t)layer * 512 * 2048;
        for (int u = bid; u < 512; u += nb) {
            const int b = u >> 6, h = (u >> 4) & 3, qb = u & 15;
            attn_unit<2>(QX + (size_t)(b * S) * 512 + h * 128, 512, xk + (size_t)(b * MEM) * 512 + h * 128, 512,
                         xvt + (size_t)(h * 128) * 2048 + b * MEM, (size_t)2048, qb * 128, 0, MEM,
                         0.08838834764831845f, 0.f, -1e30f, 0.f, OX + (size_t)(b * S) * 512 + h * 128, 512, 0.f, 1.f, nullptr, wv);
        }
    }
    if constexpr (PH == PH_GO) {
        EpiRes e{X, 0, ALT ? (float*)(ws + WS_Y) : X, (bf16_t*)(ws + WS_XB)};
        gemm_dense(OX, (const bf16_t*)(ws + WS_W_CO) + (size_t)layer * 1024 * 512, 512, 64, 4, e, bid, nb, wv);
    }
    if constexpr (PH == PH_ROUTE) { route_phase<ALT>(p, layer, bid, nb, wv); }
    if constexpr (PH == PH_G1) {
        const int* CNT = (const int*)(ws + WS_CNT) + layer * NEXP * CNT_STRIDE;
        const int* LIST = (const int*)(ws + WS_LIST);
        unsigned* head = (unsigned*)(ws + WS_QHEAD) + layer * 64;
        unsigned* done = (unsigned*)(ws + WS_DONE) + layer * 32 * 64;
        int* uq = (int*)((char*)shm + LDS_ROUTE + 1024);
        const int tid = hidden_tid(wv);
        int total = 0;
        for (int e = 0; e < NEXP; ++e) total += (CNT[e * CNT_STRIDE] + 255) >> 8;
        total = __builtin_amdgcn_readfirstlane(total) * 4;
        for (;;) {
            __syncthreads();
            if (tid == 0) *uq = (int)__hip_atomic_fetch_add(head, 1u, __ATOMIC_RELAXED, __HIP_MEMORY_SCOPE_AGENT);
            __syncthreads();
            const int uall = __builtin_amdgcn_readfirstlane(*uq);
            if (uall >= 2 * total) break;
            const bool second = uall >= total;
            const int u = second ? uall - total : uall;
            int e = 0, base = 0, tl = 0, cnt = 0;
            for (; e < NEXP; ++e) { cnt = __builtin_amdgcn_readfirstlane(CNT[e * CNT_STRIDE]); tl = (cnt + 255) >> 8; if (u < base + tl * 4) break; base += tl * 4; }
            const int r = u - base, pn = r / tl, pm = r % tl;
            const int* list = LIST + (size_t)e * NTOK;
            if (!second) {
                EpiGateUp ep{(bf16_t*)(ws + WS_ACT), list, cnt, pm * 256, (const float*)(ws + WS_RSTD)};
                gemm_tile(H, (const bf16_t*)(ws + WS_W_GU) + ((size_t)layer * NEXP + e) * 1024 * 1024, 1024, pn * 256, RowTok{list, cnt, pm * 256}, ep, wv);
                asm volatile("s_waitcnt vmcnt(0)" ::: "memory");
                if ((hidden_tid(wv) & 63) == 0) (void)__hip_atomic_fetch_add(done + e * 64 + pm, 1u, __ATOMIC_RELAXED, __HIP_MEMORY_SCOPE_AGENT);
            } else {
                if (tid < 64) {
                    unsigned spins = 0;
                    while ((unsigned)__builtin_amdgcn_readfirstlane(__hip_atomic_load(done + e * 64 + pm, __ATOMIC_RELAXED, __HIP_MEMORY_SCOPE_AGENT)) < 32u) {
                        __builtin_amdgcn_s_sleep(2);
                        if (++spins > (1u << 24)) break;
                    }
                    __builtin_amdgcn_fence(__ATOMIC_ACQUIRE, "agent");
                    asm volatile("s_waitcnt vmcnt(0)" ::: "memory");
                }
                __syncthreads();
                EpiDown ep{(bf16_t*)(ws + WS_Y), list, cnt, pm * 256};
                gemm_tile((const bf16_t*)(ws + WS_ACT), (const bf16_t*)(ws + WS_W_DN) + ((size_t)layer * NEXP + e) * 1024 * 512, 512, pn * 256, RowAsg{list, cnt, pm * 256}, ep, wv);
            }
        }
    }
    if constexpr (PH == PH_FINAL) { norm_phase<2>(p, DEPTH, p.in[33], bid, nb, wv); }
}

#if ONE_LAUNCH
__global__ void __launch_bounds__(NT, 2) k_mega(Params p_) {
    ParamsK p = (ParamsK)__builtin_amdgcn_kernarg_segment_ptr();
    volatile LAS unsigned* st = (volatile LAS unsigned*)((char*)shm + LDS_XB);
    if (threadIdx.x < 4) st[threadIdx.x] = 0u;
    __syncthreads();
    const XcdBarrier bar = xcd_barrier_post((unsigned*)(p->ws + WS_BAR), st);
    const int bid = blockIdx.x, nb = gridDim.x, wv = __builtin_amdgcn_readfirstlane(threadIdx.x >> 6);
    run_phase<PH_P0>(p, 0, bid, nb, wv); xcd_barrier(bar); if (DUP == PH_P0) { run_phase<PH_P0, true>(p, 0, bid, nb, wv); xcd_barrier(bar); }
#pragma unroll 1
    for (int layer = 0; layer < DEPTH; ++layer) {
        run_phase<PH_N1>(p, layer, bid, nb, wv); xcd_barrier(bar); if (DUP == PH_N1) { run_phase<PH_N1, true>(p, layer, bid, nb, wv); xcd_barrier(bar); }
        run_phase<PH_GIN>(p, layer, bid, nb, wv); xcd_barrier(bar); if (DUP == PH_GIN) { run_phase<PH_GIN, true>(p, layer, bid, nb, wv); xcd_barrier(bar); }
        run_phase<PH_MIX>(p, layer, bid, nb, wv); xcd_barrier(bar); if (DUP == PH_MIX && (DUPSEL == 0 || (DUPSEL != 2 && (layer & 1) == 0) || (DUPSEL == 2 && (layer & 1) == 1))) { run_phase<PH_MIX, true>(p, layer, bid, nb, wv); xcd_barrier(bar); }
        if ((layer & 1) == 0) { run_phase<PH_TR>(p, layer, bid, nb, wv); xcd_barrier(bar); }
        run_phase<PH_GOUT>(p, layer, bid, nb, wv); xcd_barrier(bar); if (DUP == PH_GOUT) { run_phase<PH_GOUT, true>(p, layer, bid, nb, wv); xcd_barrier(bar); }
        run_phase<PH_N2>(p, layer, bid, nb, wv); xcd_barrier(bar); if (DUP == PH_N2) { run_phase<PH_N2, true>(p, layer, bid, nb, wv); xcd_barrier(bar); }
        run_phase<PH_GQ>(p, layer, bid, nb, wv); xcd_barrier(bar); if (DUP == PH_GQ) { run_phase<PH_GQ, true>(p, layer, bid, nb, wv); xcd_barrier(bar); }
        run_phase<PH_XATT>(p, layer, bid, nb, wv); xcd_barrier(bar); if (DUP == PH_XATT) { run_phase<PH_XATT, true>(p, layer, bid, nb, wv); xcd_barrier(bar); }
        run_phase<PH_GO>(p, layer, bid, nb, wv); xcd_barrier(bar); if (DUP == PH_GO) { run_phase<PH_GO, true>(p, layer, bid, nb, wv); xcd_barrier(bar); }
        run_phase<PH_ROUTE>(p, layer, bid, nb, wv); xcd_barrier(bar); if (DUP == PH_ROUTE) { run_phase<PH_ROUTE, true>(p, layer, bid, nb, wv); xcd_barrier(bar); }
        run_phase<PH_G1>(p, layer, bid, nb, wv); xcd_barrier(bar); if (DUP == PH_G1) { run_phase<PH_G1, true>(p, layer, bid, nb, wv); xcd_barrier(bar); }
    }
    run_phase<PH_FINAL>(p, DEPTH, bid, nb, wv);
}
#else
template <int PH>
__global__ void __launch_bounds__(NT, 2) k_phase(Params p_, int layer) {
    run_phase<PH>((ParamsK)__builtin_amdgcn_kernarg_segment_ptr(), layer, blockIdx.x, gridDim.x, __builtin_amdgcn_readfirstlane(threadIdx.x >> 6));
}
template <int PH> static void launch_phase(const Params& p, int layer, int grid, hipStream_t stream) {
    static bool init = false;
    if (!init) { (void)hipFuncSetAttribute((const void*)k_phase<PH>, hipFuncAttributeMaxDynamicSharedMemorySize, LDS_BYTES); init = true; }
    hipLaunchKernelGGL(k_phase<PH>, dim3(grid), dim3(NT), LDS_BYTES, stream, p, layer);
}
#endif

extern "C" void kernel_launch(void* const* d_in, const int* in_sizes, int n_in, void* d_out, int out_size, void* d_ws, size_t ws_size, hipStream_t stream) {
    if (n_in != 34 || ws_size < WS_END) { fprintf(stderr, "kernel_launch: unexpected n_in %d or ws_size %zu (need %zu)\n", n_in, ws_size, (size_t)WS_END); return; }
    Params p{};
    for (int i = 0; i < 34; ++i) p.in[i] = (const float*)d_in[i];
    p.out = (float*)d_out; p.ws = (unsigned char*)d_ws;
    (void)hipMemsetAsync(d_ws, 0, WS_ZERO_BYTES, stream);
#if ONE_LAUNCH
    static int grid = 0;
    if (grid == 0) {
        int dev = 0, cus = 0, per_cu = 0;
        (void)hipGetDevice(&dev); (void)hipDeviceGetAttribute(&cus, hipDeviceAttributeMultiprocessorCount, dev);
        (void)hipFuncSetAttribute((const void*)k_mega, hipFuncAttributeMaxDynamicSharedMemorySize, LDS_BYTES);
        (void)hipOccupancyMaxActiveBlocksPerMultiprocessor(&per_cu, (const void*)k_mega, NT, LDS_BYTES);
        (void)hipGetLastError();
        grid = cus > 0 ? cus : 256;
    }
    hipLaunchKernelGGL(k_mega, dim3(grid), dim3(NT), LDS_BYTES, stream, p);
#else
    const int grid = 256;
    launch_phase<PH_P0>(p, 0, grid, stream);
    for (int layer = 0; layer < DEPTH; ++layer) {
        launch_phase<PH_N1>(p, layer, grid, stream);
        launch_phase<PH_GIN>(p, layer, grid, stream);
        launch_phase<PH_MIX>(p, layer, grid, stream);
        if ((layer & 1) == 0) launch_phase<PH_TR>(p, layer, grid, stream);
        launch_phase<PH_GOUT>(p, layer, grid, stream);
        launch_phase<PH_N2>(p, layer, grid, stream);
        launch_phase<PH_GQ>(p, layer, grid, stream);
        launch_phase<PH_XATT>(p, layer, grid, stream);
        launch_phase<PH_GO>(p, layer, grid, stream);
        launch_phase<PH_ROUTE>(p, layer, grid, stream);
        launch_phase<PH_G1>(p, layer, grid, stream);
    }
    launch_phase<PH_FINAL>(p, DEPTH, grid, stream);
#endif
}
```

```cpp
#include <hip/hip_runtime.h>
#include <stdint.h>
#include <stdio.h>

#ifndef RD_N
#define RD_N 1
#endif
#ifndef RD_E
#define RD_E 1
#endif
#ifndef RD_R
#define RD_R 1
#endif
#ifndef DUP
#define DUP -1
#endif
#ifndef DUPSEL
#define DUPSEL 0
#endif
#ifndef ONE_LAUNCH
#define ONE_LAUNCH 1
#endif

typedef unsigned short bf16_t;
typedef short bf16x8 __attribute__((ext_vector_type(8)));
typedef float f32x4 __attribute__((ext_vector_type(4)));
typedef unsigned u32x4 __attribute__((ext_vector_type(4)));
typedef unsigned u32x2 __attribute__((ext_vector_type(2)));

constexpr int Bb = 8, S = 2048, D = 1024, NTOK = Bb * S, DEPTH = 4, MEM = 256;
constexpr int NEXP = 32, EH = 512;
constexpr int NT = 512;
constexpr float EPS = 1e-6f;

constexpr size_t al256(size_t x) { return (x + 255) & ~(size_t)255; }
constexpr size_t WS_BAR   = 0;
constexpr size_t WS_CNT   = 16384;
constexpr int    CNT_STRIDE = 64;
constexpr size_t WS_QHEAD = 16384 + 65536;
constexpr size_t WS_DONE  = WS_QHEAD + 4096;
constexpr size_t WS_ZERO_BYTES = WS_DONE + (size_t)4 * 32 * 64 * 4;
constexpr size_t WS_MISC  = WS_ZERO_BYTES;
constexpr size_t WS_W_EIN = 131072;
constexpr size_t WS_W_EOUT = WS_W_EIN + (size_t)2 * 3072 * 1024 * 2;
constexpr size_t WS_W_OIN = WS_W_EOUT + (size_t)2 * 1024 * 1024 * 2;
constexpr size_t WS_W_OOUT = WS_W_OIN + (size_t)2 * 1536 * 1024 * 2;
constexpr size_t WS_W_CQ  = WS_W_OOUT + (size_t)2 * 1024 * 1024 * 2;
constexpr size_t WS_W_CKV = WS_W_CQ + (size_t)4 * 512 * 1024 * 2;
constexpr size_t WS_W_CO  = WS_W_CKV + (size_t)4 * 1024 * 1024 * 2;
constexpr size_t WS_W_GU  = WS_W_CO + (size_t)4 * 1024 * 512 * 2;
constexpr size_t WS_W_DN  = WS_W_GU + (size_t)4 * 32 * 1024 * 1024 * 2;
constexpr size_t WS_MEMN  = WS_W_DN + (size_t)4 * 32 * 1024 * 512 * 2;
constexpr size_t WS_XK    = WS_MEMN + (size_t)2048 * 1024 * 2;
constexpr size_t WS_XVT   = WS_XK + (size_t)4 * 2048 * 512 * 2;
constexpr size_t WS_A2    = WS_XVT + (size_t)4 * 2048 * 512 * 2;
constexpr size_t WS_FILT  = WS_A2 + (size_t)2 * 2048 * 64 * 4;
constexpr size_t WS_X     = WS_FILT + (size_t)2 * 2 * 512 * 4096 * 2;
constexpr size_t WS_H     = WS_X + (size_t)NTOK * D * 4;
constexpr size_t WS_PROJ  = WS_H + al256((size_t)(NTOK + 1) * D * 2);
constexpr size_t WS_YMIX  = WS_PROJ + (size_t)NTOK * 3072 * 2;
constexpr size_t WS_QX    = WS_YMIX + (size_t)NTOK * D * 2;
constexpr size_t WS_OX    = WS_QX + (size_t)NTOK * 512 * 2;
constexpr size_t WS_ACT   = WS_OX + (size_t)NTOK * 512 * 2;
constexpr size_t WS_Y     = WS_ACT + al256((size_t)(2 * NTOK + 1) * EH * 2);
constexpr size_t WS_LIST  = WS_Y + (size_t)2 * NTOK * D * 2;
constexpr size_t WS_WT    = WS_LIST + (size_t)NEXP * NTOK * 4;
constexpr size_t WS_RSTD  = WS_WT + (size_t)2 * NTOK * 4;
constexpr size_t WS_WRT   = WS_RSTD + (size_t)NTOK * 4;
constexpr size_t WS_XB    = WS_WRT + (size_t)4 * 2 * 48 * 1024 * 2;
constexpr size_t WS_SSP   = WS_XB + al256((size_t)(NTOK + 1) * D * 2);
constexpr size_t WS_RS1   = WS_SSP + (size_t)NTOK * 16 * 4;
constexpr size_t WS_END   = WS_RS1 + (size_t)NTOK * 4;
constexpr size_t PR_HYT   = 0;
constexpr size_t PR_QK    = (size_t)1536 * NTOK * 2;
constexpr size_t PR_VT    = PR_QK + (size_t)NTOK * 1024 * 2;
constexpr size_t PR_OVT   = (size_t)NTOK * 1280 * 2;

constexpr int LDS_XB = 147456;
constexpr int LDS_ROUTE = LDS_XB + 64;
constexpr int LDS_BYTES = LDS_ROUTE + 2048;

struct Params {
    const float* in[34];
    float* out;
    unsigned char* ws;
};

extern __shared__ __attribute__((aligned(16))) bf16_t shm[];

typedef float f32x2 __attribute__((ext_vector_type(2)));
typedef __bf16 bf16x2v __attribute__((ext_vector_type(2)));
__device__ __forceinline__ unsigned cvt_pk_bf16(float lo, float hi) { const f32x2 v = {lo, hi}; return __builtin_bit_cast(unsigned, __builtin_convertvector(v, bf16x2v)); }
__device__ __forceinline__ float bf2f(unsigned short b) { return __uint_as_float((unsigned)b << 16); }
__device__ __forceinline__ float bflo(unsigned w) { return __uint_as_float(w << 16); }
__device__ __forceinline__ float bfhi(unsigned w) { return __uint_as_float(w & 0xffff0000u); }
__device__ __forceinline__ float shx(float v, int m, int lane) { return __int_as_float(__builtin_amdgcn_ds_bpermute((lane ^ m) << 2, __float_as_int(v))); }
__device__ __forceinline__ float shl(float v, int src) { return __int_as_float(__builtin_amdgcn_ds_bpermute(src << 2, __float_as_int(v))); }
__device__ __forceinline__ float wave_sum(float v, int lane) {
    v += shx(v, 1, lane); v += shx(v, 2, lane); v += shx(v, 4, lane); v += shx(v, 8, lane); v += shx(v, 16, lane); v += shx(v, 32, lane); return v;
}

__device__ __forceinline__ float uni(float x) { return __builtin_bit_cast(float, __builtin_amdgcn_readfirstlane(__builtin_bit_cast(int, x))); }
__device__ __forceinline__ int hidden_tid(int wv) { int l; asm volatile("v_mbcnt_lo_u32_b32 %0, -1, 0\n\tv_mbcnt_hi_u32_b32 %0, -1, %0" : "=&v"(l)); return (wv << 6) | l; }

#define XB_TMO      128
#define XB_XCNT(j)  (256  + 64 * (j))
#define XB_XSUB(j)  (1280 + 64 * (j))
#define XB_XGEN(j)  (2304 + 64 * (j))
#define XB_TOP      3328
#define XB_TOPGEN   3392
#define XCD_BAR_WORDS 3456
#define XB_SPIN_CAP (1u << 22)
#define LAS __attribute__((address_space(3)))

__device__ __forceinline__ unsigned xb_ld(unsigned* p)              { return __hip_atomic_load(p, __ATOMIC_RELAXED, __HIP_MEMORY_SCOPE_AGENT); }
__device__ __forceinline__ unsigned xb_add(unsigned* p, unsigned v) { return __hip_atomic_fetch_add(p, v, __ATOMIC_RELAXED, __HIP_MEMORY_SCOPE_AGENT); }
__device__ __forceinline__ unsigned xb_xcc_id() { return (unsigned)__builtin_amdgcn_s_getreg((3 << 11) | 20) & 0xFu; }
#define XB_SPIN(cond, bar) do { unsigned _sp = 0; while (cond) { __builtin_amdgcn_s_sleep(1); \
    if ((++_sp & 255u) == 0u) { if (xb_ld(&(bar)[XB_TMO])) break; if (_sp > XB_SPIN_CAP) { atomicAdd(&(bar)[XB_TMO], 1u); break; } } } } while (0)

struct XcdBarrier { unsigned* bar; unsigned x; volatile LAS unsigned* st; };

__device__ __forceinline__ XcdBarrier xcd_barrier_post(unsigned* bar, volatile LAS unsigned* st) {
    XcdBarrier b; b.bar = bar; b.x = xb_xcc_id(); b.st = st;
    if (threadIdx.x == 0) (void)xb_add(&bar[XB_XCNT(b.x)], 1u);
    return b;
}
__device__ __forceinline__ void xcd_barrier_complete(unsigned* bar, unsigned x, unsigned& nloc, unsigned& nx) {
    const unsigned G = gridDim.x * gridDim.y * gridDim.z;
    unsigned sum, cnt, mine, sp = 0u;
    for (;;) {
        sum = 0u; cnt = 0u; mine = 0u;
#pragma unroll
        for (unsigned j = 0; j < 16; ++j) { const unsigned c = xb_ld(&bar[XB_XCNT(j)]); sum += c; cnt += (c > 0u) ? 1u : 0u; mine = (j == x) ? c : mine; }
        if (sum == G) break;
        __builtin_amdgcn_s_sleep(1);
        if ((++sp & 255u) == 0u) { if (xb_ld(&bar[XB_TMO])) break; if (sp > XB_SPIN_CAP) { atomicAdd(&bar[XB_TMO], 1u); break; } }
    }
    nloc = mine > 0u ? mine : 1u; nx = cnt > 0u ? cnt : 1u;
}
__device__ __forceinline__ void xcd_barrier(const XcdBarrier& b) {
    asm volatile("s_waitcnt vmcnt(0)" ::: "memory");
    __syncthreads();
    if (threadIdx.x == 0) {
        unsigned* bar = b.bar; unsigned bx = b.x;
        asm volatile("" : "+s"(bar), "+s"(bx));
        __builtin_amdgcn_s_waitcnt(0);
        unsigned nloc = b.st[0], nx = b.st[1];
        if (nloc == 0u) { xcd_barrier_complete(bar, bx, nloc, nx); b.st[0] = nloc; b.st[1] = nx; }
        const unsigned old = xb_add(&bar[XB_XSUB(bx)], 1u);
        const unsigned gen = old / nloc;
        if (old + 1u == (gen + 1u) * nloc) {
            __builtin_amdgcn_fence(__ATOMIC_RELEASE, "agent");
            asm volatile("s_waitcnt vmcnt(0)" ::: "memory");
            const unsigned og = xb_add(&bar[XB_TOP], 1u);
            const unsigned tg = og / nx;
            if (og + 1u == (tg + 1u) * nx) xb_add(&bar[XB_TOPGEN], 1u);
            else XB_SPIN(xb_ld(&bar[XB_TOPGEN]) == tg, bar);
            __builtin_amdgcn_fence(__ATOMIC_ACQUIRE, "agent");
            xb_add(&bar[XB_XGEN(bx)], 1u);
            asm volatile("s_waitcnt vmcnt(0)" ::: "memory");
        } else {
            XB_SPIN(xb_ld(&bar[XB_XGEN(bx)]) == gen, bar);
            __builtin_amdgcn_fence(__ATOMIC_ACQUIRE, "agent");
            asm volatile("s_waitcnt vmcnt(0)" ::: "memory");
        }
    }
    __syncthreads();
}

constexpr int HT = 128 * 64;
__device__ __forceinline__ int lds_byte(int r, int c) {
    int st = (r >> 4) * 2 + (c >> 5), rr = r & 15, cc = c & 31, ob = rr * 64 + cc * 2;
    return st * 1024 + (ob ^ (((ob >> 9) & 1) << 5));
}
__device__ __forceinline__ void stage_rc(int b, int& R, int& C) {
    int st = b / 1024, sb = b % 1024, swz = sb ^ (((sb >> 9) & 1) << 5);
    R = (st >> 1) * 16 + swz / 64; C = (st & 1) * 32 + (swz % 64) / 2;
}
#define SA(b, h) (shm + ((b) * 2 + (h)) * HT)
#define SB(b, h) (shm + (4 + (b) * 2 + (h)) * HT)
#define G_STAGE_A(P_, h, kt) do { _Pragma("unroll") for (int _i = 0; _i < 2; ++_i) \
    __builtin_amdgcn_global_load_lds((const unsigned*)((const char*)A + (size_t)((kt) * 128 + (RowSrc::DENSE ? (h) * 256 * K : 0)) + aoff[RowSrc::DENSE ? 0 : (h)][_i]), (unsigned*)((char*)(P_) + tid * 16 + _i * 8192), 16, 0, 0); } while (0)
#define G_STAGE_B(P_, h, kt) do { _Pragma("unroll") for (int _i = 0; _i < 2; ++_i) \
    __builtin_amdgcn_global_load_lds((const unsigned*)((const char*)Bt + (size_t)((kt) * 128 + (h) * 64 * K) + boff[_i]), (unsigned*)((char*)(P_) + tid * 16 + _i * 8192), 16, 0, 0); } while (0)
#define G_LDA(dst, b, h) _Pragma("unroll") for (int m = 0; m < 4; ++m) _Pragma("unroll") for (int k = 0; k < 2; ++k) \
    dst[m][k] = *reinterpret_cast<const bf16x8*>((char*)SA(b, h) + lds_byte(wr * 64 + m * 16 + fr, k * 32 + fq * 8))
#define G_LDB(dst, b, h) _Pragma("unroll") for (int n = 0; n < 2; ++n) _Pragma("unroll") for (int k = 0; k < 2; ++k) \
    dst[n][k] = *reinterpret_cast<const bf16x8*>((char*)SB(b, h) + lds_byte(wc * 32 + n * 16 + fr, k * 32 + fq * 8))
#define G_MMA(ai, bj, At_, Bt_) do { __builtin_amdgcn_s_setprio(1); \
    _Pragma("unroll") for (int m = 0; m < 4; ++m) _Pragma("unroll") for (int n = 0; n < 2; ++n) _Pragma("unroll") for (int k = 0; k < 2; ++k) \
      acc[ai][bj][m][n] = __builtin_amdgcn_mfma_f32_16x16x32_bf16(Bt_[n][k], At_[m][k], acc[ai][bj][m][n], 0, 0, 0); \
    __builtin_amdgcn_s_setprio(0); } while (0)
#define WAIT_V(n) asm volatile("s_waitcnt vmcnt(" #n ")" ::: "memory")
#define WAIT_L(n) asm volatile("s_waitcnt lgkmcnt(" #n ")" ::: "memory")
#define BAR __builtin_amdgcn_s_barrier()
#define SCHED __builtin_amdgcn_sched_barrier(0)

typedef f32x4 AccT[2][2][4][2];

template <class RowSrc, class Epi>
__device__ __forceinline__ void gemm_tile(const bf16_t* __restrict__ A, const bf16_t* __restrict__ Bt, const int K,
                                          const int bcol, const RowSrc& rs, const Epi& epi, const int wv) {
    const int tid = hidden_tid(wv);
    int wid = tid >> 6, lane = tid & 63, wr = wid >> 2, wc = wid & 3, fr = lane & 15, fq = lane >> 4;
    unsigned aoff[2][2], boff[2];
#pragma unroll
    for (int i = 0; i < 2; ++i) {
        int R, C; stage_rc(tid * 16 + i * 8192, R, C);
        boff[i] = (unsigned)(((bcol + (R >> 5) * 64 + (R & 31)) * K + C) * 2);
        if (RowSrc::DENSE) { aoff[0][i] = (unsigned)((R * K + C) * 2); aoff[1][i] = 0u; }
        else {
#pragma unroll
            for (int h = 0; h < 2; ++h) aoff[h][i] = (unsigned)((rs(h * 128 + R) * K + C) * 2);
        }
    }
    WAIT_V(0);
    AccT acc = {};
    bf16x8 At[4][2], B0[2][2], B1[2][2];
    const int nt = K / 64;
    G_STAGE_B(SB(0, 0), 0, 0); G_STAGE_A(SA(0, 0), 0, 0);
    G_STAGE_B(SB(0, 1), 1, 0); G_STAGE_A(SA(0, 1), 1, 0);
    if (wr == 1) BAR;
    WAIT_V(4); BAR;
    G_STAGE_B(SB(1, 0), 0, 1); G_STAGE_A(SA(1, 0), 0, 1); G_STAGE_B(SB(1, 1), 1, 1);
    WAIT_V(6); BAR;
    for (int t = 0; t < nt - 2; t += 2) {
        G_LDB(B0, 0, 0); SCHED; G_LDA(At, 0, 0); G_STAGE_A(SA(1, 1), 1, t + 1);
        WAIT_L(8); BAR; WAIT_L(0); G_MMA(0, 0, At, B0); BAR; SCHED;
        G_LDB(B1, 0, 1); G_STAGE_B(SB(0, 0), 0, t + 2);
        BAR; WAIT_L(0); G_MMA(0, 1, At, B1); BAR;
        G_LDA(At, 0, 1); G_STAGE_A(SA(0, 0), 0, t + 2);
        BAR; WAIT_L(0); G_MMA(1, 0, At, B0); BAR; SCHED;
        G_STAGE_B(SB(0, 1), 1, t + 2);
        WAIT_V(6); BAR; G_MMA(1, 1, At, B1); BAR;
        G_LDB(B0, 1, 0); SCHED; G_LDA(At, 1, 0); G_STAGE_A(SA(0, 1), 1, t + 2);
        WAIT_L(8); BAR; WAIT_L(0); G_MMA(0, 0, At, B0); BAR; SCHED;
        G_LDB(B1, 1, 1); G_STAGE_B(SB(1, 0), 0, t + 3);
        BAR; WAIT_L(0); G_MMA(0, 1, At, B1); BAR;
        G_LDA(At, 1, 1); G_STAGE_A(SA(1, 0), 0, t + 3);
        BAR; WAIT_L(0); G_MMA(1, 0, At, B0); BAR; SCHED;
        G_STAGE_B(SB(1, 1), 1, t + 3);
        WAIT_V(6); BAR; G_MMA(1, 1, At, B1); BAR;
    }
    { G_LDB(B0, 0, 0); WAIT_V(0); G_LDA(At, 0, 0); G_STAGE_A(SA(1, 1), 1, nt - 1);
      BAR; WAIT_L(0); G_MMA(0, 0, At, B0); BAR;
      G_LDB(B1, 0, 1); BAR; WAIT_L(0); G_MMA(0, 1, At, B1); BAR;
      G_LDA(At, 0, 1); WAIT_V(4); BAR; WAIT_L(0); G_MMA(1, 0, At, B0); G_MMA(1, 1, At, B1); BAR; }
    { G_LDB(B0, 1, 0); G_LDA(At, 1, 0); WAIT_V(2); BAR; WAIT_L(0); G_MMA(0, 0, At, B0); BAR;
      G_LDB(B1, 1, 1); WAIT_V(0); BAR; WAIT_L(0); G_MMA(0, 1, At, B1); BAR;
      G_LDA(At, 1, 1); BAR; WAIT_L(0); G_MMA(1, 0, At, B0); G_MMA(1, 1, At, B1); BAR; }
    if (wr == 0) BAR;
    int tz = hidden_tid(wv); wid = tz >> 6; lane = tz & 63; wr = wid >> 2; wc = wid & 3; fr = lane & 15; fq = lane >> 4;
    epi(acc, wr * 64 + fr, bcol + wc * 64 + fq * 4);
}

struct RowIdent { static constexpr bool DENSE = true; __device__ __forceinline__ int operator()(int r) const { return r; } };

__device__ __forceinline__ void st_bf16x4(bf16_t* p, const f32x4& v) { u32x2 w; w.x = cvt_pk_bf16(v[0], v[1]); w.y = cvt_pk_bf16(v[2], v[3]); *(u32x2*)p = w; }
__device__ __forceinline__ void st_chan4(bf16_t* q, size_t ld, const f32x4& v) {
    const unsigned a = cvt_pk_bf16(v[0], v[1]), b = cvt_pk_bf16(v[2], v[3]);
    q[0] = (bf16_t)(a & 0xffff); q[ld] = (bf16_t)(a >> 16); q[2 * ld] = (bf16_t)(b & 0xffff); q[3 * ld] = (bf16_t)(b >> 16);
}
constexpr int BJS = 32;
#define EPI_LOOP_AM _Pragma("unroll") for (int ai = 0; ai < 2; ++ai) _Pragma("unroll") for (int m = 0; m < 4; ++m)
#define EPI_LOOP_BN _Pragma("unroll") for (int bj = 0; bj < 2; ++bj) _Pragma("unroll") for (int n = 0; n < 2; ++n)
struct EpiRes {
    bf16_t* XB; int brow; float* ssp; int lane;
    __device__ __forceinline__ void operator()(AccT& acc, int r0, int c0) const {
        EPI_LOOP_AM {
            const int row = brow + r0 + ai * 128 + m * 16;
            bf16_t* qb = XB + (size_t)row * D + c0;
            float ss = 0.f;
            EPI_LOOP_BN {
                const u32x2 xv = *(const u32x2*)(qb + bj * BJS + n * 16);
                const f32x4 t = (f32x4){bflo(xv.x), bfhi(xv.x), bflo(xv.y), bfhi(xv.y)} + acc[ai][bj][m][n];
                const unsigned a0 = cvt_pk_bf16(t[0], t[1]), a1 = cvt_pk_bf16(t[2], t[3]);
                *(u32x2*)(qb + bj * BJS + n * 16) = (u32x2){a0, a1};
                const float r0f = bflo(a0), r1f = bfhi(a0), r2f = bflo(a1), r3f = bfhi(a1);
                ss += (r0f * r0f + r1f * r1f) + (r2f * r2f + r3f * r3f);
            }
            if (ssp) { ss += shx(ss, 16, lane); ss += shx(ss, 32, lane); if ((lane >> 4) == 0) ssp[(size_t)row * 16 + (c0 >> 6)] = ss; }
            asm volatile("" ::: "memory");
        }
    }
};
struct EpiSplit {
    bf16_t* Ca; bf16_t* T; bf16_t* Cb; int c0s, c1s, ldT; size_t ldC; int brow; const float* rs;
    __device__ __forceinline__ void chan(AccT& acc, bf16_t* base, int r0, int c) const {
        EPI_LOOP_AM { const int row = brow + r0 + ai * 128 + m * 16; const float sc = rs ? rs[row] : 1.0f;
            bf16_t* q = base + (size_t)c * ldC + row;
            EPI_LOOP_BN st_chan4(q + (size_t)(bj * BJS + n * 16) * ldC, ldC, acc[ai][bj][m][n] * sc); }
    }
    __device__ __forceinline__ void operator()(AccT& acc, int r0, int c0) const {
        const int tilec = __builtin_amdgcn_readfirstlane(c0) & ~255;
        if (tilec < c0s) chan(acc, Ca, r0, c0);
        else if (tilec < c1s) {
            EPI_LOOP_AM { const int row = brow + r0 + ai * 128 + m * 16; const float sc = rs ? rs[row] : 1.0f;
                bf16_t* q = T + (size_t)row * ldT + (c0 - c0s);
                EPI_LOOP_BN st_bf16x4(q + bj * BJS + n * 16, acc[ai][bj][m][n] * sc); }
        } else chan(acc, Cb, r0, c0 - c1s);
    }
};
struct EpiTokRstd {
    bf16_t* T; int ldT, brow; const float* ssp;
    __device__ __forceinline__ void operator()(AccT& acc, int r0, int c0) const {
        EPI_LOOP_AM {
            const int row = brow + r0 + ai * 128 + m * 16;
            const f32x4 p0 = *(const f32x4*)(ssp + (size_t)row * 16), p1 = *(const f32x4*)(ssp + (size_t)row * 16 + 4), p2 = *(const f32x4*)(ssp + (size_t)row * 16 + 8), p3 = *(const f32x4*)(ssp + (size_t)row * 16 + 12);
            const float ssq = ((p0[0] + p0[1]) + (p0[2] + p0[3])) + ((p1[0] + p1[1]) + (p1[2] + p1[3])) + ((p2[0] + p2[1]) + (p2[2] + p2[3])) + ((p3[0] + p3[1]) + (p3[2] + p3[3]));
            const float rs = rsqrtf(ssq * (1.0f / 1024.0f) + EPS);
            bf16_t* q = T + (size_t)row * ldT + c0;
            EPI_LOOP_BN st_bf16x4(q + bj * BJS + n * 16, acc[ai][bj][m][n] * rs);
        }
    }
};
struct EpiGateUp {
    bf16_t* act; const int* list; int cnt, pos0; const float* rstd;
    __device__ __forceinline__ void operator()(AccT& acc, int r0, int c0) const {
        EPI_LOOP_AM {
            const int pos = pos0 + r0 + ai * 128 + m * 16;
            if (pos < cnt) {
                const int a = list[pos];
                const float rs = rstd[a >> 1];
#pragma unroll
                for (int bj = 0; bj < 2; ++bj) {
                    const f32x4 g = acc[ai][bj][m][0] * rs, u = acc[ai][bj][m][1] * rs; f32x4 o;
#pragma unroll
                    for (int j = 0; j < 4; ++j) o[j] = g[j] / (1.0f + __expf(-g[j])) * u[j];
                    const int col = c0 + bj * BJS;
                    const unsigned long long wv8 = ((unsigned long long)cvt_pk_bf16(o[2], o[3]) << 32) | cvt_pk_bf16(o[0], o[1]);
                    __hip_atomic_store((unsigned long long*)(act + (size_t)a * EH + (col >> 5) * 16 + (col & 15)), wv8, __ATOMIC_RELAXED, __HIP_MEMORY_SCOPE_AGENT);
                }
            }
        }
    }
};
struct EpiDown {
    bf16_t* y; const int* list; int cnt, pos0;
    __device__ __forceinline__ void operator()(AccT& acc, int r0, int c0) const {
        EPI_LOOP_AM {
            const int pos = pos0 + r0 + ai * 128 + m * 16;
            if (pos < cnt) { bf16_t* q = y + (size_t)list[pos] * D + c0; EPI_LOOP_BN st_bf16x4(q + bj * BJS + n * 16, acc[ai][bj][m][n]); }
        }
    }
};
struct RowTok { static constexpr bool DENSE = false; const int* list; int cnt, pos0; __device__ __forceinline__ int operator()(int r) const { const int pos = pos0 + r; return pos < cnt ? (list[pos] >> 1) : NTOK; } };
struct RowAsg { static constexpr bool DENSE = false; const int* list; int cnt, pos0; __device__ __forceinline__ int operator()(int r) const { const int pos = pos0 + r; return pos < cnt ? list[pos] : 2 * NTOK; } };

constexpr int ATT_VOFF = 16384;
template <int MODE> struct ACfg;
template <> struct ACfg<0> { static constexpr int DQK = 64, DV = 128, NMAP = 2, KBLK = 2; };
template <> struct ACfg<1> { static constexpr int DQK = 64, DV = 64, NMAP = 1, KBLK = 1; };
template <> struct ACfg<2> { static constexpr int DQK = 128, DV = 128, NMAP = 1, KBLK = 2; };

template <int MODE, bool ALT = false>
__device__ __forceinline__ void attn_unit(const bf16_t* __restrict__ Qp, const int ldq,
                                          const bf16_t* __restrict__ Kp, const int ldk,
                                          const bf16_t* __restrict__ Vt, const size_t ldvt,
                                          const int q0, const int kbeg, const int kend,
                                          const float scale, const float slope, const float m_init, const float l_init,
                                          bf16_t* __restrict__ Op, const int ldo,
                                          const float lam, const float outscale, const float* __restrict__ subln, const int wv) {
    constexpr int DQK = ACfg<MODE>::DQK, DV = ACfg<MODE>::DV, NMAP = ACfg<MODE>::NMAP, KBLK = ACfg<MODE>::KBLK;
    const int tid = hidden_tid(wv), w = tid >> 6, lane = tid & 63, fr = lane & 15, fq = lane >> 4;
    const int qrow = q0 + w * 16 + fr;
    bf16x8 Qf[NMAP][DQK / 32];
#pragma unroll
    for (int m = 0; m < NMAP; ++m)
#pragma unroll
        for (int kk = 0; kk < DQK / 32; ++kk) Qf[m][kk] = *(const bf16x8*)(Qp + (size_t)qrow * ldq + m * DQK + kk * 32 + fq * 8);
    constexpr float LOG2E = 1.4426950408889634f;
    const float scale2 = scale * LOG2E, slope2 = slope * LOG2E, kappa = slope / scale;
    f32x4 O[NMAP][DV / 16], Ol[NMAP];
    float mrun[NMAP];
#pragma unroll
    for (int m = 0; m < NMAP; ++m) {
        mrun[m] = m_init * LOG2E; Ol[m] = (f32x4){(fq == 0) ? l_init : 0.f, 0.f, 0.f, 0.f};
#pragma unroll
        for (int et = 0; et < DV / 16; ++et) O[m][et] = (f32x4){0.f, 0.f, 0.f, 0.f};
    }
    const unsigned onesw = (fr == 0) ? 0x3f803f80u : 0u;
    const bf16x8 onesf = __builtin_bit_cast(bf16x8, (u32x4){onesw, onesw, onesw, onesw});
    char* const lds = (char*)shm;
    constexpr int KN = KBLK, VN = DV / 64;
    u32x4 kreg[KN], vreg[VN];
#define ATT_LOAD(k0_) do { \
        _Pragma("unroll") for (int i_ = 0; i_ < KN; ++i_) { const int c_ = tid + i_ * NT; const int key_ = c_ / (KBLK * 8), col_ = (c_ % (KBLK * 8)) * 8; \
            kreg[i_] = *(const u32x4*)(Kp + (size_t)((k0_) + key_) * ldk + col_); } \
        _Pragma("unroll") for (int i_ = 0; i_ < VN; ++i_) { const int c_ = tid + i_ * NT; const int e_ = c_ >> 3, kc_ = c_ & 7; \
            vreg[i_] = *(const u32x4*)(Vt + (size_t)e_ * ldvt + (k0_) + kc_ * 8); } } while (0)
    ATT_LOAD(kbeg);
    const int qw0 = q0 + w * 16;
    constexpr int VBYTES = DV * 160;
    bf16x8 Pf[NMAP][2];
#define ATT_PV_C(voff_, c) do { \
            bf16x8 vf[DV / 16]; \
            _Pragma("unroll") for (int et = 0; et < DV / 16; ++et) vf[et] = *(const bf16x8*)(lds + (voff_) + (et * 16 + fr) * 160 + (c) * 64 + fq * 16); \
            _Pragma("unroll") for (int m = 0; m < NMAP; ++m) Ol[m] = __builtin_amdgcn_mfma_f32_16x16x32_bf16(onesf, Pf[m][c], Ol[m], 0, 0, 0); \
            _Pragma("unroll") for (int et = 0; et < DV / 16; ++et) \
                _Pragma("unroll") for (int m = 0; m < NMAP; ++m) O[m][et] = __builtin_amdgcn_mfma_f32_16x16x32_bf16(vf[et], Pf[m][c], O[m][et], 0, 0, 0); \
        } while (0)
    int vcur = ATT_VOFF;
    for (int k0 = kbeg; k0 < kend; k0 += 64) {
        __syncthreads();
#pragma unroll
        for (int i = 0; i < KN; ++i) { const int c = tid + i * NT; const int key = c / (KBLK * 8), col = (c % (KBLK * 8)) * 8;
            *(u32x4*)(lds + (col >> 6) * 8192 + lds_byte(key, col & 63)) = kreg[i]; }
#pragma unroll
        for (int i = 0; i < VN; ++i) { const int c = tid + i * NT; const int e = c >> 3, kc = c & 7;
            char* vd = lds + vcur + e * 160 + (kc >> 2) * 64 + (kc & 1) * 32 + ((kc >> 1) & 1) * 8;
            *(u32x2*)vd = (u32x2){vreg[i].x, vreg[i].y}; *(u32x2*)(vd + 16) = (u32x2){vreg[i].z, vreg[i].w}; }
        __syncthreads();
        if (k0 + 64 < kend) ATT_LOAD(k0 + 64);
        const int vprev = vcur ^ ATT_VOFF ^ (ATT_VOFF + VBYTES);
        const float dq = (float)(qrow - k0);
        bool gen;
        if (MODE == 2) gen = false;
        else if (MODE == 1) gen = !((k0 + 63 <= qw0 && qw0 + 15 - k0 <= 128) || (k0 >= qw0 + 15 && k0 + 63 - qw0 <= 128));
        else gen = !(k0 + 63 <= qw0 || k0 >= qw0 + 15);
        const bool pos = (MODE == 2) || (k0 + 63 <= qw0);
        f32x4 Cin[4]; float off;
        if (MODE == 2) {
#pragma unroll
            for (int t = 0; t < 4; ++t) Cin[t] = (f32x4){0.f, 0.f, 0.f, 0.f};
            off = 0.f;
        } else if (gen) {
#pragma unroll
            for (int t = 0; t < 4; ++t)
#pragma unroll
                for (int r = 0; r < 4; ++r) Cin[t][r] = -kappa * fabsf(dq - (float)(16 * t + 4 * fq + r));
            off = 0.f;
        } else {
            const float sk = pos ? kappa : -kappa, cb = sk * (float)(4 * fq);
#pragma unroll
            for (int t = 0; t < 4; ++t)
#pragma unroll
                for (int r = 0; r < 4; ++r) Cin[t][r] = sk * (float)(16 * t + r) + cb;
            off = pos ? -slope2 * dq : slope2 * dq;
        }
        f32x4 s[NMAP][4];
#pragma unroll
        for (int m = 0; m < NMAP; ++m) {
            bf16x8 kf[4][DQK / 32];
#pragma unroll
            for (int t = 0; t < 4; ++t)
#pragma unroll
                for (int kk = 0; kk < DQK / 32; ++kk) {
                    const int blk = (MODE == 2) ? (kk >> 1) : m, kcol = (MODE == 2) ? (kk & 1) * 32 : kk * 32;
                    kf[t][kk] = *(const bf16x8*)(lds + blk * 8192 + lds_byte(t * 16 + fr, kcol + fq * 8));
                }
#pragma unroll
            for (int t = 0; t < 4; ++t) {
                s[m][t] = Cin[t];
#pragma unroll
                for (int kk = 0; kk < DQK / 32; ++kk) s[m][t] = __builtin_amdgcn_mfma_f32_16x16x32_bf16(kf[t][kk], Qf[m][kk], s[m][t], 0, 0, 0);
            }
        }
        float mx[NMAP], mx1[NMAP];
#pragma unroll
        for (int m = 0; m < NMAP; ++m) {
            if (MODE == 1 && gen) {
#pragma unroll
                for (int t = 0; t < 4; ++t)
#pragma unroll
                    for (int r = 0; r < 4; ++r) s[m][t][r] = (fabsf(dq - (float)(16 * t + 4 * fq + r)) > 128.0f) ? -1e30f : s[m][t][r];
            }
            float v = fmaxf(fmaxf(s[m][0][0], s[m][0][1]), fmaxf(s[m][0][2], s[m][0][3]));
#pragma unroll
            for (int t = 1; t < 4; ++t) v = fmaxf(v, fmaxf(fmaxf(s[m][t][0], s[m][t][1]), fmaxf(s[m][t][2], s[m][t][3])));
            mx[m] = v; mx1[m] = shx(v, 16, lane);
        }
        __builtin_amdgcn_sched_barrier(0);
        if (k0 > kbeg) ATT_PV_C(vprev, 0);
        __builtin_amdgcn_sched_barrier(0);
#pragma unroll
        for (int m = 0; m < NMAP; ++m) { mx[m] = fmaxf(mx[m], mx1[m]); mx1[m] = shx(mx[m], 32, lane); }
        __builtin_amdgcn_sched_barrier(0);
        if (k0 > kbeg) ATT_PV_C(vprev, 1);
        __builtin_amdgcn_sched_barrier(0);
#pragma unroll
        for (int m = 0; m < NMAP; ++m) {
            const float mxx = fmaxf(mx[m], mx1[m]);
            const float mtile = fmaxf(mxx * scale2 + off, -1e30f);
            const float mnew = fmaxf(mrun[m], mtile), alpha = __builtin_amdgcn_exp2f(mrun[m] - mnew);
            mrun[m] = mnew;
            const float sub = off - mnew;
#pragma unroll
            for (int t = 0; t < 4; ++t)
#pragma unroll
                for (int r = 0; r < 4; ++r) s[m][t][r] = __builtin_amdgcn_exp2f(s[m][t][r] * scale2 + sub);
            if (__builtin_amdgcn_ballot_w64(alpha != 1.0f) != 0ull) {
                Ol[m] *= alpha;
#pragma unroll
                for (int et = 0; et < DV / 16; ++et) O[m][et] *= alpha;
            }
#pragma unroll
            for (int c = 0; c < 2; ++c) {
                u32x4 pk; pk.x = cvt_pk_bf16(s[m][2 * c][0], s[m][2 * c][1]); pk.y = cvt_pk_bf16(s[m][2 * c][2], s[m][2 * c][3]);
                pk.z = cvt_pk_bf16(s[m][2 * c + 1][0], s[m][2 * c + 1][1]); pk.w = cvt_pk_bf16(s[m][2 * c + 1][2], s[m][2 * c + 1][3]);
                Pf[m][c] = __builtin_bit_cast(bf16x8, pk);
            }
        }
        vcur = vprev;
    }
    { const int vlast = vcur ^ ATT_VOFF ^ (ATT_VOFF + VBYTES); ATT_PV_C(vlast, 0); ATT_PV_C(vlast, 1); }
    float linv[NMAP];
#pragma unroll
    for (int m = 0; m < NMAP; ++m) linv[m] = 1.0f / shl(Ol[m][0], fr);
    const int tid2 = hidden_tid(wv); const int qrow_o = q0 + (tid2 >> 6) * 16 + (tid2 & 15);
    if (MODE == 0) {
        float ss = 0.f;
#pragma unroll
        for (int et = 0; et < DV / 16; ++et)
#pragma unroll
            for (int r = 0; r < 4; ++r) { const float v = O[0][et][r] * linv[0] - lam * (O[NMAP - 1][et][r] * linv[NMAP - 1]); O[0][et][r] = v; ss += v * v; }
        ss += shx(ss, 16, lane); ss += shx(ss, 32, lane);
        const float rs = rsqrtf(ss * (1.0f / 128.0f) + EPS) * outscale;
#pragma unroll
        for (int et = 0; et < DV / 16; ++et) {
            const f32x4 g = *(const f32x4*)(subln + et * 16 + fq * 4);
            st_bf16x4(Op + (size_t)qrow_o * ldo + et * 16 + fq * 4, O[0][et] * rs * g);
        }
    } else {
#pragma unroll
        for (int et = 0; et < DV / 16; ++et) st_bf16x4(Op + (size_t)qrow_o * ldo + et * 16 + fq * 4, O[0][et] * linv[0]);
    }
}

constexpr int HZ_RS = 4896;
constexpr int HZ_PAD = 192;
constexpr int H_CPS = 8256;
constexpr int H_ZOFF = 0, H_CPOFF = 8 * HZ_RS, H_RAWOFF = H_CPOFF + 8 * H_CPS;

template <bool ALT>
__device__ __forceinline__ void hyena_unit(const Params& p, const int lj  , const int c, const int wv) {
    const int tid = hidden_tid(wv), w = tid >> 6, lane = tid & 63, fr = lane & 15, fq = lane >> 4;
    char* const lds = (char*)shm;
    const bf16_t* hyT = (const bf16_t*)(p.ws + WS_PROJ + PR_HYT);
    const float* cw = p.in[4] + (size_t)lj * 3 * 1536; const float* cb = p.in[5] + (size_t)lj * 1536;
    const int nb = fr >> 1, tbp = fr & 1;
    __syncthreads();
    for (int i = tid; i < 8 * 2 * (HZ_PAD / 8); i += NT) {
        const int b = i / (2 * (HZ_PAD / 8)), r = i % (2 * (HZ_PAD / 8)), side = r / (HZ_PAD / 8), k = r % (HZ_PAD / 8);
        unsigned zz0 = 0u; asm volatile("" : "+v"(zz0));
        *(u32x4*)(lds + H_ZOFF + b * HZ_RS + (side ? (HZ_PAD + 2048) * 2 : 0) + k * 16) = (u32x4){zz0, zz0, zz0, zz0};
        if (i < 2) *(u32x4*)(lds + H_RAWOFF + 8192 + i * 16) = (u32x4){zz0, zz0, zz0, zz0};
    }
    {
        const float w0 = cw[c], w1 = cw[1536 + c], w2 = cw[2 * 1536 + c], bb = cb[c];
        const bf16_t* src = hyT + (size_t)c * NTOK;
        u32x4 v[4]; unsigned short um[4], up[4];
#pragma unroll
        for (int k = 0; k < 4; ++k) {
            const int i = tid + k * NT, b = i >> 8, s0 = (i & 255) * 8;
            const bf16_t* q = src + b * S + s0;
            v[k] = *(const u32x4*)q; um[k] = q[s0 > 0 ? -1 : 0]; up[k] = q[s0 + 8 < S ? 8 : 7];
        }
#pragma unroll
        for (int k = 0; k < 4; ++k) {
            const int i = tid + k * NT, b = i >> 8, s0 = (i & 255) * 8;
            float u[10];
            u[0] = (s0 > 0) ? bf2f(um[k]) : 0.f; u[9] = (s0 + 8 < S) ? bf2f(up[k]) : 0.f;
            u[1] = bflo(v[k].x); u[2] = bfhi(v[k].x); u[3] = bflo(v[k].y); u[4] = bfhi(v[k].y); u[5] = bflo(v[k].z); u[6] = bfhi(v[k].z); u[7] = bflo(v[k].w); u[8] = bfhi(v[k].w);
            float o[8];
#pragma unroll
            for (int j = 0; j < 8; ++j) o[j] = w0 * u[j] + w1 * u[j + 1] + w2 * u[j + 2] + bb;
            u32x4 ov; ov.x = cvt_pk_bf16(o[0], o[1]); ov.y = cvt_pk_bf16(o[2], o[3]); ov.z = cvt_pk_bf16(o[4], o[5]); ov.w = cvt_pk_bf16(o[6], o[7]);
            *(u32x4*)(lds + H_ZOFF + b * HZ_RS + (HZ_PAD + s0) * 2) = ov;
        }
    }
#pragma unroll 1
    for (int order = 0; order < 2; ++order) {
        const int gch = 512 * (order + 1) + c;
        const bf16_t* gsrc = hyT + (size_t)gch * NTOK;
        u32x2 gv[2][4]; unsigned short gm[2][4], gp[2][4];
        u32x4 rawv;
        {
            const bf16_t* f = (const bf16_t*)(p.ws + WS_FILT) + ((size_t)(lj * 2 + order) * 512 + c) * 4096;
            rawv = *(const u32x4*)(f + tid * 8);
#pragma unroll
            for (int ci = 0; ci < 2; ++ci)
#pragma unroll
                for (int mt = 0; mt < 4; ++mt) {
                    const int t = 64 * (4 * w + 2 * ci + tbp) + 16 * mt + 4 * fq;
                    const bf16_t* gq = gsrc + nb * S + t;
                    gv[ci][mt] = *(const u32x2*)gq; gm[ci][mt] = gq[t > 0 ? -1 : 0]; gp[ci][mt] = gq[t + 4 < S ? 4 : 3];
                }
        }
        *(u32x4*)(lds + H_RAWOFF + tid * 16) = rawv;
        __syncthreads();
        {
            const bf16_t* raw = (const bf16_t*)(lds + H_RAWOFF);
            const int o = w;
#pragma unroll
            for (int k = 0; k < 8; ++k) {
                const int a = lane + 64 * k;
                unsigned short e[8];
#pragma unroll
                for (int j = 0; j < 8; ++j) e[j] = raw[8 * a + o + j];
                u32x4 ov; ov.x = e[0] | ((unsigned)e[1] << 16); ov.y = e[2] | ((unsigned)e[3] << 16); ov.z = e[4] | ((unsigned)e[5] << 16); ov.w = e[6] | ((unsigned)e[7] << 16);
                *(u32x4*)(lds + H_CPOFF + o * H_CPS + a * 16) = ov;
            }
        }
        __syncthreads();
        f32x4 acc[2][4];
#pragma unroll
        for (int ci = 0; ci < 2; ++ci)
#pragma unroll
            for (int mt = 0; mt < 4; ++mt) acc[ci][mt] = (f32x4){0.f, 0.f, 0.f, 0.f};
        {
            const int acp = H_CPOFF + (7 - (fr & 7)) * H_CPS + (255 - (fr >> 3) + fq) * 16;
            const int zb = H_ZOFF + nb * HZ_RS + (HZ_PAD + 8 * fq) * 2;
            for (int dl = 4 * w - 31; dl <= ((ALT && DUPSEL >= 5) ? 4 * w - 31 : 4 * w + 3); ++dl) {
#pragma unroll
                for (int kh = 0; kh < 2; ++kh) {
                    bf16x8 Bf[2];
#pragma unroll
                    for (int ci = 0; ci < 2; ++ci) {
                        const int sblk = 4 * w + 2 * ci + tbp - dl;
                        Bf[ci] = *(const bf16x8*)(lds + zb + (64 * sblk + 32 * kh) * 2);
                    }
#pragma unroll
                    for (int mt = 0; mt < 4; ++mt) {
                        const int q = 4 * dl + mt - 2 * kh;
                        const bf16x8 Af = *(const bf16x8*)(lds + acp - 32 * q);
#pragma unroll
                        for (int ci = 0; ci < 2; ++ci) acc[ci][mt] = __builtin_amdgcn_mfma_f32_16x16x32_bf16(Af, Bf[ci], acc[ci][mt], 0, 0, 0);
                    }
                }
            }
        }
        const float hb = p.in[12][(size_t)(lj * 2 + order) * 512 + c];
        const float w0 = cw[gch], w1 = cw[1536 + gch], w2 = cw[2 * 1536 + gch], bb = cb[gch];
        u32x2 zout[2][4];
#pragma unroll
        for (int ci = 0; ci < 2; ++ci)
#pragma unroll
            for (int mt = 0; mt < 4; ++mt) {
                const int t = 64 * (4 * w + 2 * ci + tbp) + 16 * mt + 4 * fq;
                const u32x2 zz = *(const u32x2*)(lds + H_ZOFF + nb * HZ_RS + (HZ_PAD + t) * 2);
                float u[6];
                u[0] = (t > 0) ? bf2f(gm[ci][mt]) : 0.f; u[5] = (t + 4 < S) ? bf2f(gp[ci][mt]) : 0.f;
                u[1] = bflo(gv[ci][mt].x); u[2] = bfhi(gv[ci][mt].x); u[3] = bflo(gv[ci][mt].y); u[4] = bfhi(gv[ci][mt].y);
                const float z[4] = {bflo(zz.x), bfhi(zz.x), bflo(zz.y), bfhi(zz.y)};
                float o[4];
#pragma unroll
                for (int r = 0; r < 4; ++r) {
                    const float gate = w0 * u[r] + w1 * u[r + 1] + w2 * u[r + 2] + bb;
                    o[r] = gate * (acc[ci][mt][r] + hb * z[r]);
                }
                zout[ci][mt].x = cvt_pk_bf16(o[0], o[1]); zout[ci][mt].y = cvt_pk_bf16(o[2], o[3]);
            }
        __syncthreads();
        if (order == 0) {
#pragma unroll
            for (int ci = 0; ci < 2; ++ci)
#pragma unroll
                for (int mt = 0; mt < 4; ++mt) {
                    const int t = 64 * (4 * w + 2 * ci + tbp) + 16 * mt + 4 * fq;
                    *(u32x2*)(lds + H_ZOFF + nb * HZ_RS + (HZ_PAD + t) * 2) = zout[ci][mt];
                }
        } else {
            bf16_t* yt = (bf16_t*)(p.ws + WS_QX) + (size_t)c * NTOK;
#pragma unroll
            for (int ci = 0; ci < 2; ++ci)
#pragma unroll
                for (int mt = 0; mt < 4; ++mt) {
                    const int t = 64 * (4 * w + 2 * ci + tbp) + 16 * mt + 4 * fq;
                    *(u32x2*)(yt + nb * S + t) = zout[ci][mt];
                }
        }
        __syncthreads();
    }
}

struct Row16 { f32x4 v[4]; };
__device__ __forceinline__ void ld_row(Row16& r, const float* src, int lane) {
#pragma unroll
    for (int i = 0; i < 4; ++i) r.v[i] = *(const f32x4*)(src + 256 * i + 4 * lane);
}
__device__ __forceinline__ void ld_row_bf(Row16& r, const bf16_t* src, int lane) {
#pragma unroll
    for (int i = 0; i < 4; ++i) { const u32x2 v = *(const u32x2*)(src + 256 * i + 4 * lane); r.v[i] = (f32x4){bflo(v.x), bfhi(v.x), bflo(v.y), bfhi(v.y)}; }
}
__device__ __forceinline__ float row_rstd(const Row16& r, int lane) {
    float ss = 0.f;
#pragma unroll
    for (int i = 0; i < 4; ++i) ss += r.v[i][0] * r.v[i][0] + r.v[i][1] * r.v[i][1] + r.v[i][2] * r.v[i][2] + r.v[i][3] * r.v[i][3];
    ss = wave_sum(ss, lane);
    return rsqrtf(ss * (1.0f / 1024.0f) + EPS);
}
template <int KIND  , bool ALT = false>
__device__ __forceinline__ void norm_phase(const Params& p, const int layer, const float* __restrict__ gain, const int bid, const int nb, const int wv) {
    const int tid_ = hidden_tid(wv), lane = tid_ & 63, w = tid_ >> 6;
    bf16_t* XB = (bf16_t*)(p.ws + WS_XB);
    bf16_t* XBo = ALT ? (bf16_t*)(p.ws + WS_PROJ) : XB;
    float* RS1 = (float*)(p.ws + (ALT ? WS_QX : WS_RS1));
    const bf16_t* Y = (const bf16_t*)(p.ws + WS_Y);
    const float* WT = (const float*)(p.ws + WS_WT);
    Row16 g;
    if (KIND == 2) ld_row(g, gain, lane);
    for (int tok = bid * 8 + w; tok < NTOK; tok += nb * 8) {
        Row16 x;
        if (KIND == 0 && layer == 0) ld_row(x, p.in[0] + (size_t)tok * D, lane); else ld_row_bf(x, XB + (size_t)tok * D, lane);
        if ((KIND == 0 && layer > 0) || KIND == 2) {
            const float w0 = WT[2 * tok], w1 = WT[2 * tok + 1];
            const bf16_t* y0 = Y + (size_t)(2 * tok) * D; const bf16_t* y1 = y0 + D;
#pragma unroll
            for (int i = 0; i < 4; ++i) {
                const u32x2 a = *(const u32x2*)(y0 + 256 * i + 4 * lane), b = *(const u32x2*)(y1 + 256 * i + 4 * lane);
                x.v[i][0] += w0 * bflo(a.x) + w1 * bflo(b.x); x.v[i][1] += w0 * bfhi(a.x) + w1 * bfhi(b.x);
                x.v[i][2] += w0 * bflo(a.y) + w1 * bflo(b.y); x.v[i][3] += w0 * bfhi(a.y) + w1 * bfhi(b.y);
            }
        }
        if (KIND == 2) {
            const float rstd = row_rstd(x, lane);
#pragma unroll
            for (int i = 0; i < 4; ++i) *(f32x4*)(p.out + (size_t)tok * D + 256 * i + 4 * lane) = x.v[i] * rstd * g.v[i];
        } else {
#pragma unroll
            for (int i = 0; i < 4; ++i) {
                const unsigned a0 = cvt_pk_bf16(x.v[i][0], x.v[i][1]), a1 = cvt_pk_bf16(x.v[i][2], x.v[i][3]);
                *(u32x2*)(XBo + (size_t)tok * D + 256 * i + 4 * lane) = (u32x2){a0, a1};
                x.v[i] = (f32x4){bflo(a0), bfhi(a0), bflo(a1), bfhi(a1)};
            }
            const float rstd = row_rstd(x, lane);
            if (lane == 0) RS1[tok] = rstd;
        }
    }
}

template <bool ALT>
__device__ __forceinline__ void route_phase(const Params& p, const int layer, const int bid, const int nb, const int wv) {
    const int tid = hidden_tid(wv), lane = tid & 63, w = tid >> 6, fr = lane & 15, fq = lane >> 4;
    float* part = (float*)shm;
    float* ssql = part + 2 * 64 * 48;
    int* cntl = (int*)((char*)shm + LDS_ROUTE);
    int* basel = cntl + 32;
    int* sel = basel + 32;
    int* posl = sel + 128;
    const float* X = (const float*)(p.ws + WS_X);
    bf16_t* H = (bf16_t*)(p.ws + WS_H);
    float* WT = (float*)(p.ws + (ALT ? WS_ACT + (size_t)4 * 1024 * 1024 : WS_WT));
    float* RSTD = (float*)(p.ws + (ALT ? WS_ACT + (size_t)5 * 1024 * 1024 : WS_RSTD));
    int* LIST = (int*)(p.ws + (ALT ? WS_ACT : WS_LIST));
    int* CNT = (int*)(p.ws + WS_CNT) + (layer + (ALT ? 4 : 0)) * NEXP * CNT_STRIDE;
    const float* bg = p.in[26] + layer * 4; const float* be = p.in[28] + layer * NEXP;
    const float* gain = p.in[24] + (size_t)layer * D;
    const bf16_t* Wh = (const bf16_t*)(p.ws + WS_WRT) + (size_t)layer * 2 * 48 * 1024; const bf16_t* Wl = Wh + 48 * 1024;
    const int mt = w & 3, kh = w >> 2;
    for (int chunk = bid; chunk < NTOK / 64; chunk += nb) {
        __syncthreads();
        if (tid < 32) cntl[tid] = 0;
        const int tok = chunk * 64 + mt * 16 + fr;
        const unsigned xoff = (unsigned)((tok * D + kh * 512 + fq * 8) * 4), woff = (unsigned)((fr * 1024 + kh * 512 + fq * 8) * 2), hoff = (unsigned)((tok * D + kh * 512 + fq * 8) * 2);
        const char* const Xc = (const char*)X; const char* const Whc = (const char*)Wh; const char* const Wlc = (const char*)Wl; char* const Hc = (char*)H;
        f32x4 acc[3];
#pragma unroll
        for (int nt = 0; nt < 3; ++nt) acc[nt] = (f32x4){0.f, 0.f, 0.f, 0.f};
        float ssq = 0.f;
        constexpr int PF = 2;
        f32x4 xa[PF][2]; bf16x8 Bh[PF][3], Bl[PF][3];
#define ROUTE_LOAD(slot, ko_) do { { const u32x4 xb_ = *(const u32x4*)((const char*)(p.ws + WS_XB) + ((xoff >> 1) + (unsigned)(ko_) * 2u)); xa[slot][0] = (f32x4){bflo(xb_.x), bfhi(xb_.x), bflo(xb_.y), bfhi(xb_.y)}; xa[slot][1] = (f32x4){bflo(xb_.z), bfhi(xb_.z), bflo(xb_.w), bfhi(xb_.w)}; } \
        _Pragma("unroll") for (int nt = 0; nt < 3; ++nt) { Bh[slot][nt] = *(const bf16x8*)(Whc + (woff + (unsigned)(nt * 16 * 2048) + (unsigned)(ko_) * 2u)); Bl[slot][nt] = *(const bf16x8*)(Wlc + (woff + (unsigned)(nt * 16 * 2048) + (unsigned)(ko_) * 2u)); } } while (0)
#pragma unroll
        for (int i = 0; i < PF; ++i) ROUTE_LOAD(i, i * 32);
#pragma unroll 1
        for (int kb = 0; kb < 512; kb += PF * 32) {
#pragma unroll
            for (int i = 0; i < PF; ++i) {
                const f32x4 x0 = xa[i][0], x1 = xa[i][1];
                ssq += x0[0] * x0[0] + x0[1] * x0[1] + x0[2] * x0[2] + x0[3] * x0[3] + x1[0] * x1[0] + x1[1] * x1[1] + x1[2] * x1[2] + x1[3] * x1[3];
                u32x4 hi; hi.x = cvt_pk_bf16(x0[0], x0[1]); hi.y = cvt_pk_bf16(x0[2], x0[3]); hi.z = cvt_pk_bf16(x1[0], x1[1]); hi.w = cvt_pk_bf16(x1[2], x1[3]);
                u32x4 lo;
                lo.x = cvt_pk_bf16(x0[0] - bflo(hi.x), x0[1] - bfhi(hi.x)); lo.y = cvt_pk_bf16(x0[2] - bflo(hi.y), x0[3] - bfhi(hi.y));
                lo.z = cvt_pk_bf16(x1[0] - bflo(hi.z), x1[1] - bfhi(hi.z)); lo.w = cvt_pk_bf16(x1[2] - bflo(hi.w), x1[3] - bfhi(hi.w));
                const bf16x8 Ah = __builtin_bit_cast(bf16x8, hi), Al = __builtin_bit_cast(bf16x8, lo);
#pragma unroll
                for (int nt = 0; nt < 3; ++nt) {
                    acc[nt] = __builtin_amdgcn_mfma_f32_16x16x32_bf16(Ah, Bh[i][nt], acc[nt], 0, 0, 0);
                    acc[nt] = __builtin_amdgcn_mfma_f32_16x16x32_bf16(Ah, Bl[i][nt], acc[nt], 0, 0, 0);
                    acc[nt] = __builtin_amdgcn_mfma_f32_16x16x32_bf16(Al, Bh[i][nt], acc[nt], 0, 0, 0);
                }
                if (kb + PF * 32 < 512) ROUTE_LOAD(i, kb + (PF + i) * 32);
            }
        }
        ssq += shx(ssq, 16, lane); ssq += shx(ssq, 32, lane);
        if (fq == 0) ssql[kh * 64 + mt * 16 + fr] = ssq;
#pragma unroll
        for (int nt = 0; nt < 3; ++nt)
#pragma unroll
            for (int r = 0; r < 4; ++r) part[(kh * 64 + mt * 16 + fq * 4 + r) * 48 + nt * 16 + fr] = acc[nt][r];
        __syncthreads();
        if (tid < 64) {
            const int tl = tid, tk = chunk * 64 + tl;
            const float rstd = rsqrtf((ssql[tl] + ssql[64 + tl]) * (1.0f / 1024.0f) + EPS);
            const float* p0 = part + tl * 48; const float* p1 = part + (64 + tl) * 48;
            float lg[36];
#pragma unroll
            for (int j = 0; j < 36; ++j) lg[j] = (p0[j] + p1[j]) * rstd;
            float g0 = lg[0] + bg[0], g1 = lg[1] + bg[1], g2 = lg[2] + bg[2], g3 = lg[3] + bg[3];
            int gs = 0; float gm = g0;
            if (g1 > gm) { gm = g1; gs = 1; } if (g2 > gm) { gm = g2; gs = 2; } if (g3 > gm) { gm = g3; gs = 3; }
            const float gden = __expf(g0 - gm) + __expf(g1 - gm) + __expf(g2 - gm) + __expf(g3 - gm);
            const float ggate = 1.0f / gden;
            float ev[8];
#pragma unroll
            for (int j = 0; j < 8; ++j) {
                const float a0 = lg[4 + j] + be[j], a1 = lg[12 + j] + be[8 + j], a2 = lg[20 + j] + be[16 + j], a3 = lg[28 + j] + be[24 + j];
                ev[j] = gs == 0 ? a0 : gs == 1 ? a1 : gs == 2 ? a2 : a3;
            }
            int i0 = 0; float v0 = ev[0];
#pragma unroll
            for (int j = 1; j < 8; ++j) if (ev[j] > v0) { v0 = ev[j]; i0 = j; }
            int i1 = -1; float v1 = -3.0e38f;
#pragma unroll
            for (int j = 0; j < 8; ++j) if (j != i0 && ev[j] > v1) { v1 = ev[j]; i1 = j; }
            const float e1 = __expf(v1 - v0), sden = 1.0f / (1.0f + e1);
            const int ea = gs * 8 + i0, eb = gs * 8 + i1;
            sel[2 * tl] = ea; posl[2 * tl] = atomicAdd(&cntl[ea], 1);
            sel[2 * tl + 1] = eb; posl[2 * tl + 1] = atomicAdd(&cntl[eb], 1);
            WT[2 * tk] = ggate * sden; WT[2 * tk + 1] = ggate * e1 * sden;
            RSTD[tk] = rstd;
        }
        __syncthreads();
        if (tid < 32) { const int c = cntl[tid]; basel[tid] = c > 0 ? atomicAdd(&CNT[tid * CNT_STRIDE], c) : 0; }
        __syncthreads();
        if (tid < 128) { const int e = sel[tid]; LIST[(size_t)e * NTOK + basel[e] + posl[tid]] = 128 * chunk + tid; }
    }
}

template <int MODE>
__device__ __forceinline__ void cvt_job(const float* __restrict__ src, bf16_t* __restrict__ dst, const int K, const int N, const int nmat,
                                        const size_t dst_mat_stride, const int bid, const int nb, const int wv, const float* __restrict__ kgain = nullptr, const int gshift = 0) {
    float* T = (float*)shm;
    const int tid = hidden_tid(wv);
    const int tk = K / 64, tn = N / 256, per = tk * tn, total = per * nmat;
    for (int t = bid; t < total; t += nb) {
        const int mat = t / per, r = t % per, k0 = (r / tn) * 64, n0 = (r % tn) * 256;
        const float* s = src + (size_t)mat * K * N + (size_t)k0 * N + n0;
        bf16_t* d = dst + (size_t)mat * dst_mat_stride;
        f32x4 v[8];
#pragma unroll
        for (int i = 0; i < 8; ++i) v[i] = *(const f32x4*)(s + (size_t)((tid >> 6) + 8 * i) * N + (tid & 63) * 4);
        if (kgain) {
#pragma unroll
            for (int i = 0; i < 8; ++i) v[i] *= kgain[(size_t)(mat >> gshift) * D + k0 + (tid >> 6) + 8 * i];
        }
        __syncthreads();
#pragma unroll
        for (int i = 0; i < 8; ++i) {
            float* q = T + ((tid >> 6) + 8 * i) * 257 + (tid & 63) * 4;
            q[0] = v[i][0]; q[1] = v[i][1]; q[2] = v[i][2]; q[3] = v[i][3];
        }
        __syncthreads();
#pragma unroll
        for (int j = 0; j < 4; ++j) {
            const int n = (tid >> 3) + 64 * j, kc = (tid & 7) * 8;
            float e[8];
#pragma unroll
            for (int jj = 0; jj < 8; ++jj) e[jj] = T[(kc + jj) * 257 + n];
            u32x4 ov; ov.x = cvt_pk_bf16(e[0], e[1]); ov.y = cvt_pk_bf16(e[2], e[3]); ov.z = cvt_pk_bf16(e[4], e[5]); ov.w = cvt_pk_bf16(e[6], e[7]);
            const int ng = n0 + n;
            const int row = (MODE == 0) ? ng : ((ng >> 4) * 32 + (ng & 15) + (MODE == 2 ? 16 : 0));
            *(u32x4*)(d + (size_t)row * K + k0 + kc) = ov;
        }
    }
}

__device__ __forceinline__ void prologue0(const Params& p, const int bid, const int nb, const int wv) {
    unsigned char* ws = p.ws;
    cvt_job<0>(p.in[3], (bf16_t*)(ws + WS_W_EIN), 1024, 3072, 2, (size_t)3072 * 1024, bid, nb, wv, p.in[2]);
    cvt_job<0>(p.in[15], (bf16_t*)(ws + WS_W_EOUT), 1024, 1024, 2, (size_t)1024 * 1024, bid, nb, wv);
    cvt_job<0>(p.in[17], (bf16_t*)(ws + WS_W_OIN), 1024, 1536, 2, (size_t)1536 * 1024, bid, nb, wv, p.in[16]);
    cvt_job<0>(p.in[19], (bf16_t*)(ws + WS_W_OOUT), 1024, 1024, 2, (size_t)1024 * 1024, bid, nb, wv);
    cvt_job<0>(p.in[21], (bf16_t*)(ws + WS_W_CQ), 1024, 512, 4, (size_t)512 * 1024, bid, nb, wv, p.in[20]);
    cvt_job<0>(p.in[22], (bf16_t*)(ws + WS_W_CKV), 1024, 1024, 4, (size_t)1024 * 1024, bid, nb, wv);
    cvt_job<0>(p.in[23], (bf16_t*)(ws + WS_W_CO), 512, 1024, 4, (size_t)1024 * 512, bid, nb, wv);
    cvt_job<1>(p.in[29], (bf16_t*)(ws + WS_W_GU), 1024, 512, 128, (size_t)1024 * 1024, bid, nb, wv, p.in[24], 5);
    cvt_job<2>(p.in[30], (bf16_t*)(ws + WS_W_GU), 1024, 512, 128, (size_t)1024 * 1024, bid, nb, wv, p.in[24], 5);
    cvt_job<0>(p.in[31], (bf16_t*)(ws + WS_W_DN), 512, 1024, 128, (size_t)1024 * 512, bid, nb, wv);
    const int tid = hidden_tid(wv), lane = tid & 63, w = tid >> 6;
    {
        Row16 g; ld_row(g, p.in[32], lane);
        bf16_t* MN = (bf16_t*)(ws + WS_MEMN);
        for (int r = bid * 8 + w; r < Bb * MEM; r += nb * 8) {
            Row16 x; ld_row(x, p.in[1] + (size_t)r * D, lane);
            const float rstd = row_rstd(x, lane);
#pragma unroll
            for (int i = 0; i < 4; ++i) st_bf16x4(MN + (size_t)r * D + 256 * i + 4 * lane, x.v[i] * rstd * g.v[i]);
        }
    }
    {
        float* A2 = (float*)(ws + WS_A2);
        for (int r = bid * 8 + w; r < 2 * S; r += nb * 8) {
            const int lj = r / S, pos = r % S;
            const float* w1 = p.in[6] + (size_t)lj * 33 * 64; const float* b1 = p.in[7] + lj * 64;
            const float* w2 = p.in[8] + (size_t)lj * 64 * 64; const float* b2 = p.in[9] + lj * 64;
            const float fr_ = p.in[11][lj * 64 + lane];
            float a = ((float)pos / 2047.0f) * w1[lane];
#pragma unroll 1
            for (int k = 0; k < 16; ++k) {
                const float band = 1e-4f + (float)k * ((15.0f - 1e-4f) / 15.0f);
                const float ang = band * (6.283185307179586f * (float)pos / 2048.0f);
                a += cosf(ang) * w1[(1 + k) * 64 + lane] - sinf(ang) * w1[(17 + k) * 64 + lane];
            }
            const float a1 = sinf(fr_ * (a + b1[lane]));
            float a2 = 0.f;
#pragma unroll 1
            for (int i = 0; i < 64; ++i) a2 += shl(a1, i) * w2[i * 64 + lane];
            A2[(size_t)r * 64 + lane] = sinf(fr_ * (a2 + b2[lane]));
        }
    }
    {
        bf16_t* WR = (bf16_t*)(ws + WS_WRT);
        for (int i = bid * NT + tid; i < 4 * 48 * 1024; i += nb * NT) {
            const int l = i / (48 * 1024), r = i % (48 * 1024), j = r >> 10, k = r & 1023;
            float v = 0.f;
            if (j < 4) v = p.in[25][((size_t)l * D + k) * 4 + j]; else if (j < 36) v = p.in[27][((size_t)l * D + k) * NEXP + (j - 4)];
            v *= p.in[24][(size_t)l * D + k];
            const unsigned h = cvt_pk_bf16(v, 0.f) & 0xffffu;
            const unsigned lo = cvt_pk_bf16(v - bflo(h), 0.f) & 0xffffu;
            WR[(size_t)l * 2 * 48 * 1024 + r] = (bf16_t)h; WR[(size_t)l * 2 * 48 * 1024 + 48 * 1024 + r] = (bf16_t)lo;
        }
    }
    if (bid == 0) {
        if (tid < 2) {
            const float* lm = p.in[13] + (size_t)tid * 4 * 64;
            float s01 = 0.f, s23 = 0.f;
            for (int i = 0; i < 64; ++i) { s01 += lm[i] * lm[64 + i]; s23 += lm[128 + i] * lm[192 + i]; }
            const float lam_init = 0.8f - 0.6f * expf(-0.3f * (float)(2 * tid));
            ((float*)(ws + WS_MISC))[tid] = expf(s01) - expf(s23) + lam_init;
            ((float*)(ws + WS_MISC))[2 + tid] = 1.0f - lam_init;
        }
        bf16_t* hz = (bf16_t*)(ws + WS_XB) + (size_t)NTOK * D; bf16_t* az = (bf16_t*)(ws + WS_ACT) + (size_t)2 * NTOK * EH;
        for (int i = tid; i < D; i += NT) hz[i] = 0;
        for (int i = tid; i < EH; i += NT) az[i] = 0;
    }
}

__device__ __forceinline__ void filter_taps(const Params& p, const int bid, const int nb, const int wv) {
    const int tid = hidden_tid(wv), w = tid >> 6, lane = tid & 63, fr = lane & 15, fq = lane >> 4;
    const float* A2 = (const float*)(p.ws + WS_A2);
    bf16_t* FL = (bf16_t*)(p.ws + WS_FILT);
    const float mind = logf(1e-2f) / 1.5f, maxd = logf(1e-2f) / 0.3f;
    for (int job = bid; job < 2 * 4 * 8 * 32; job += nb) {
        const int pt = job & 31, ct = (job >> 5) & 7, od = (job >> 8) & 3, lj = job >> 10;
        const int pos0 = pt * 64 + (w >> 2) * 32, ch0 = ct * 64 + (w & 3) * 16, order = od >> 1, dir = od & 1;
        const float* w3 = p.in[10] + (size_t)lj * 64 * 2048 + od * 512 + ch0 + fr;
        bf16x8 Af[2], Bf[2][2];
#pragma unroll
        for (int ks = 0; ks < 2; ++ks) {
            float e[8];
#pragma unroll
            for (int jj = 0; jj < 8; ++jj) e[jj] = w3[(size_t)(ks * 32 + fq * 8 + jj) * 2048];
            u32x4 pk; pk.x = cvt_pk_bf16(e[0], e[1]); pk.y = cvt_pk_bf16(e[2], e[3]); pk.z = cvt_pk_bf16(e[4], e[5]); pk.w = cvt_pk_bf16(e[6], e[7]);
            Af[ks] = __builtin_bit_cast(bf16x8, pk);
#pragma unroll
            for (int nt = 0; nt < 2; ++nt) {
                const float* ap = A2 + ((size_t)lj * S + pos0 + nt * 16 + fr) * 64 + ks * 32 + fq * 8;
                const f32x4 v0 = *(const f32x4*)ap, v1 = *(const f32x4*)(ap + 4);
                u32x4 pb; pb.x = cvt_pk_bf16(v0[0], v0[1]); pb.y = cvt_pk_bf16(v0[2], v0[3]); pb.z = cvt_pk_bf16(v1[0], v1[1]); pb.w = cvt_pk_bf16(v1[2], v1[3]);
                Bf[nt][ks] = __builtin_bit_cast(bf16x8, pb);
            }
        }
#pragma unroll
        for (int nt = 0; nt < 2; ++nt) {
            f32x4 acc = {0.f, 0.f, 0.f, 0.f};
            acc = __builtin_amdgcn_mfma_f32_16x16x32_bf16(Af[0], Bf[nt][0], acc, 0, 0, 0);
            acc = __builtin_amdgcn_mfma_f32_16x16x32_bf16(Af[1], Bf[nt][1], acc, 0, 0, 0);
            const int pos = pos0 + nt * 16 + fr;
            const float tpos = (float)pos / 2047.0f;
#pragma unroll
            for (int r = 0; r < 4; ++r) {
                const int ch = ch0 + fq * 4 + r;
                const float delta = mind + (float)ch * ((maxd - mind) / 511.0f);
                const float v = acc[r] * __builtin_amdgcn_exp2f(-tpos * fabsf(delta) * 1.4426950408889634f);
                bf16_t* f = FL + ((size_t)(lj * 2 + order) * 512 + ch) * 4096;
                const unsigned short hv = (unsigned short)(cvt_pk_bf16(v, 0.f) & 0xffff);
                if (dir == 0) f[2047 - pos] = hv;
                else { if (pos >= 1) f[2047 + pos] = hv; if (pos == 2047) f[4095] = 0; }
            }
        }
    }
}

enum { PH_P0 = 0, PH_P1, PH_N1, PH_GIN, PH_MIX, PH_GOUT, PH_N2, PH_GQ, PH_XATT, PH_GO, PH_ROUTE, PH_G1, PH_G2, PH_FINAL, PH_TR, PH_COUNT };

template <class Epi>
__device__ __forceinline__ void gemm_dense(const bf16_t* A, const bf16_t* Bt, const int K, const int nM, const int nN, Epi epi, const int bid, const int nb, const int wv) {
    for (int u = bid; u < nM * nN; u += nb) {
        const int pm = u / nN, pn = u % nN;
        epi.brow = pm * 256;
        gemm_tile(A + (size_t)pm * 256 * K, Bt, K, pn * 256, RowIdent{}, epi, wv);
    }
}

typedef const __attribute__((address_space(4))) Params* ParamsK;
#define PHASE_FN __forceinline__
template <int PH, bool ALT = false>
__device__ PHASE_FN void run_phase(ParamsK pk_, const int layer, const int bid_, const int nb_, const int wv_) {
    ParamsK pk = pk_; asm volatile("" : "+s"(pk));
    int bid = bid_, nb = nb_, wv = wv_; asm volatile("" : "+s"(bid), "+s"(nb), "+s"(wv));
    const Params& p = *(const Params*)pk;
    unsigned char* ws = p.ws;
    const int lj = layer >> 1; const bool even = (layer & 1) == 0;
    bf16_t* H = (bf16_t*)(ws + WS_H);
    float* X = (float*)(ws + WS_X);
    bf16_t* YMIX = (bf16_t*)(ws + WS_YMIX);
    bf16_t* QX = (bf16_t*)(ws + WS_QX);
    bf16_t* OX = (bf16_t*)(ws + WS_OX);
    if constexpr (PH == PH_P0) { prologue0(p, bid, nb, wv); }
    if constexpr (PH == PH_N1) {
        norm_phase<0, ALT>(p, layer, nullptr, bid, nb, wv);
        if (layer == 0 && !ALT) filter_taps(p, bid, nb, wv);
    }
    if constexpr (PH == PH_GIN) {
        const bf16_t* XBc = (const bf16_t*)(ws + WS_XB); const float* RS1 = (const float*)(ws + WS_RS1);
        if (even) {
            EpiSplit e{(bf16_t*)(ws + WS_PROJ + PR_HYT), (bf16_t*)(ws + WS_PROJ + PR_QK), (bf16_t*)(ws + WS_PROJ + PR_VT), 1536, 2560, 1024, (size_t)NTOK, 0, RS1};
            gemm_dense(XBc, (const bf16_t*)(ws + WS_W_EIN) + (size_t)lj * 3072 * 1024, 1024, 64, 12, e, bid, nb, wv);
        } else {
            EpiSplit e{nullptr, (bf16_t*)(ws + WS_PROJ), (bf16_t*)(ws + WS_PROJ + PR_OVT), 0, 1280, 1280, (size_t)NTOK, 0, RS1};
            gemm_dense(XBc, (const bf16_t*)(ws + WS_W_OIN) + (size_t)lj * 1536 * 1024, 1024, 64, 6, e, bid, nb, wv);
        }
    }
    if constexpr (PH == PH_MIX) {
        if (even) {
            const bf16_t* qk = (const bf16_t*)(ws + WS_PROJ + PR_QK);
            const bf16_t* vT = (const bf16_t*)(ws + WS_PROJ + PR_VT);
            const float lam = uni(((const float*)(ws + WS_MISC))[lj]);
            const float oscale = uni(((const float*)(ws + WS_MISC))[2 + lj]);
            for (int u = bid + ((ALT && (DUPSEL == 4 || DUPSEL >= 7)) ? 512 : 0); u < ((ALT && (DUPSEL == 3 || DUPSEL == 5 || DUPSEL == 6)) ? 512 : 1024); u += nb) {
                if (u < 512) hyena_unit<ALT>(p, lj, u, wv);
                else {
                    const int id = u - 512, b = id >> 6, h = (id >> 4) & 3, qb = id & 15;
                    attn_unit<0, ALT>(qk + (size_t)(b * S) * 1024 + 2 * h * 64, 1024, qk + (size_t)(b * S) * 1024 + 512 + 2 * h * 64, 1024,
                                 vT + (size_t)(h * 128) * NTOK + b * S, (size_t)NTOK, qb * 128, 0, S,
                                 0.125f, uni(exp2f(-2.0f * (float)(h + 1))), -1e30f, 0.f,
                                 (ALT ? (bf16_t*)(ws + WS_Y) : YMIX) + (size_t)(b * S) * D + 512 + h * 128, D, lam, oscale, p.in[14] + (size_t)lj * 128, wv);
                }
            }
        } else {
            const bf16_t* qk = (const bf16_t*)(ws + WS_PROJ);
            const bf16_t* vT = (const bf16_t*)(ws + WS_PROJ + PR_OVT);
            for (int u = bid; u < 2048; u += nb) {
                const int b = u >> 8, hq = (u >> 4) & 15, qb = u & 15, kv = hq >> 2, q0 = qb * 128;
                const int kbeg = q0 - 128 < 0 ? 0 : q0 - 128, kend = q0 + 256 > S ? S : q0 + 256;
                attn_unit<1>(qk + (size_t)(b * S) * 1280 + hq * 64, 1280, qk + (size_t)(b * S) * 1280 + 1024 + kv * 64, 1280,
                             vT + (size_t)(kv * 64) * NTOK + b * S, (size_t)NTOK, q0, kbeg, kend,
                             0.125f, uni(exp2f(-0.5f * (float)(hq + 1))), uni(p.in[18][lj * 16 + hq]), 1.0f,
                             YMIX + (size_t)(b * S) * D + hq * 64, D, 0.f, 1.f, nullptr, wv);
            }
        }
    }
    if constexpr (PH == PH_TR) {
        const int tid = hidden_tid(wv);
        const bf16_t* yt = (const bf16_t*)(ws + WS_QX);
        bf16_t* T = shm;
        for (int t = bid; t < 8 * 256; t += nb) {
            const int c0 = (t & 7) * 64, tk0 = (t >> 3) * 64;
            const u32x4 v = *(const u32x4*)(yt + (size_t)(c0 + (tid >> 3)) * NTOK + tk0 + (tid & 7) * 8);
            __syncthreads();
            *(u32x4*)((char*)T + (tid >> 3) * 144 + (tid & 7) * 16) = v;
            __syncthreads();
            const int tok = tid >> 3, cg = (tid & 7) * 8;
            unsigned short e[8];
#pragma unroll
            for (int j = 0; j < 8; ++j) e[j] = T[(cg + j) * 72 + tok];
            u32x4 ov; ov.x = e[0] | ((unsigned)e[1] << 16); ov.y = e[2] | ((unsigned)e[3] << 16); ov.z = e[4] | ((unsigned)e[5] << 16); ov.w = e[6] | ((unsigned)e[7] << 16);
            *(u32x4*)(YMIX + (size_t)(tk0 + tok) * D + c0 + cg) = ov;
        }
    }
    if constexpr (PH == PH_GOUT) {
        EpiRes e{(bf16_t*)(ws + (ALT ? WS_Y : WS_XB)), 0, (float*)(ws + WS_SSP), hidden_tid(wv) & 63};
        gemm_dense(YMIX, (const bf16_t*)(ws + (even ? WS_W_EOUT : WS_W_OOUT)) + (size_t)lj * 1024 * 1024, 1024, 64, 4, e, bid, nb, wv);
    }
    if constexpr (PH == PH_GQ) {
        for (int u = bid; u < 128 + 32; u += nb) {
            if (u < 128) {
                const int pm = u >> 1, pn = u & 1;
                EpiTokRstd e{QX, 512, pm * 256, (const float*)(ws + WS_SSP)};
                gemm_tile((const bf16_t*)(ws + WS_XB) + (size_t)pm * 256 * 1024, (const bf16_t*)(ws + WS_W_CQ) + (size_t)layer * 512 * 1024, 1024, pn * 256, RowIdent{}, e, wv);
            } else {
                const int v = u - 128, pm = v >> 2, pn = v & 3;
                EpiSplit e{nullptr, (bf16_t*)(ws + WS_XK) + (size_t)layer * 2048 * 512, (bf16_t*)(ws + WS_XVT) + (size_t)layer * 512 * 2048, 0, 512, 512, (size_t)2048, pm * 256, nullptr};
                gemm_tile((const bf16_t*)(ws + WS_MEMN) + (size_t)pm * 256 * 1024, (const bf16_t*)(ws + WS_W_CKV) + (size_t)layer * 1024 * 1024, 1024, pn * 256, RowIdent{}, e, wv);
            }
        }
    }
    if constexpr (PH == PH_XATT) {
        const bf16_t* xk = (const bf16_t*)(ws + WS_XK) + (size_t)layer * 2048 * 512;
        const bf16_t* xvt = (const bf16_t*)(ws + WS_XVT) + (size_t)layer * 512 * 2048;
        for (int u = bid; u < 512; u += nb) {
            const int b = u >> 6, h = (u >> 4) & 3, qb = u & 15;
            attn_unit<2>(QX + (size_t)(b * S) * 512 + h * 128, 512, xk + (size_t)(b * MEM) * 512 + h * 128, 512,
                         xvt + (size_t)(h * 128) * 2048 + b * MEM, (size_t)2048, qb * 128, 0, MEM,
                         0.08838834764831845f, 0.f, -1e30f, 0.f, OX + (size_t)(b * S) * 512 + h * 128, 512, 0.f, 1.f, nullptr, wv);
        }
    }
    if constexpr (PH == PH_GO) {
        EpiRes e{(bf16_t*)(ws + (ALT ? WS_Y : WS_XB)), 0, nullptr, hidden_tid(wv) & 63};
        gemm_dense(OX, (const bf16_t*)(ws + WS_W_CO) + (size_t)layer * 1024 * 512, 512, 64, 4, e, bid, nb, wv);
    }
    if constexpr (PH == PH_ROUTE) { route_phase<ALT>(p, layer, bid, nb, wv); }
    if constexpr (PH == PH_G1) {
        const int* CNT = (const int*)(ws + WS_CNT) + layer * NEXP * CNT_STRIDE;
        const int* LIST = (const int*)(ws + WS_LIST);
        unsigned* head = (unsigned*)(ws + WS_QHEAD) + layer * 64;
        unsigned* done = (unsigned*)(ws + WS_DONE) + layer * 32 * 64;
        int* uq = (int*)((char*)shm + LDS_ROUTE + 1024);
        const int tid = hidden_tid(wv);
        int total = 0;
        for (int e = 0; e < NEXP; ++e) total += (CNT[e * CNT_STRIDE] + 255) >> 8;
        total = __builtin_amdgcn_readfirstlane(total) * 4;
        for (;;) {
            __syncthreads();
            if (tid == 0) *uq = (int)__hip_atomic_fetch_add(head, 1u, __ATOMIC_RELAXED, __HIP_MEMORY_SCOPE_AGENT);
            __syncthreads();
            const int uall = __builtin_amdgcn_readfirstlane(*uq);
            if (uall >= 2 * total) break;
            const bool second = uall >= total;
            const int u = second ? uall - total : uall;
            int e = 0, base = 0, tl = 0, cnt = 0;
            for (; e < NEXP; ++e) { cnt = __builtin_amdgcn_readfirstlane(CNT[e * CNT_STRIDE]); tl = (cnt + 255) >> 8; if (u < base + tl * 4) break; base += tl * 4; }
            const int r = u - base, pn = r / tl, pm = r % tl;
            const int* list = LIST + (size_t)e * NTOK;
            if (!second) {
                EpiGateUp ep{(bf16_t*)(ws + WS_ACT), list, cnt, pm * 256, (const float*)(ws + WS_RSTD)};
                gemm_tile((const bf16_t*)(ws + WS_XB), (const bf16_t*)(ws + WS_W_GU) + ((size_t)layer * NEXP + e) * 1024 * 1024, 1024, pn * 256, RowTok{list, cnt, pm * 256}, ep, wv);
                asm volatile("s_waitcnt vmcnt(0)" ::: "memory");
                if ((hidden_tid(wv) & 63) == 0) (void)__hip_atomic_fetch_add(done + e * 64 + pm, 1u, __ATOMIC_RELAXED, __HIP_MEMORY_SCOPE_AGENT);
            } else {
                if (tid < 64) {
                    unsigned spins = 0;
                    while ((unsigned)__builtin_amdgcn_readfirstlane(__hip_atomic_load(done + e * 64 + pm, __ATOMIC_RELAXED, __HIP_MEMORY_SCOPE_AGENT)) < 32u) {
                        __builtin_amdgcn_s_sleep(2);
                        if (++spins > (1u << 24)) break;
                    }
                    __builtin_amdgcn_fence(__ATOMIC_ACQUIRE, "agent");
                    asm volatile("s_waitcnt vmcnt(0)" ::: "memory");
                }
                __syncthreads();
                EpiDown ep{(bf16_t*)(ws + WS_Y), list, cnt, pm * 256};
                gemm_tile((const bf16_t*)(ws + WS_ACT), (const bf16_t*)(ws + WS_W_DN) + ((size_t)layer * NEXP + e) * 1024 * 512, 512, pn * 256, RowAsg{list, cnt, pm * 256}, ep, wv);
            }
        }
    }
    if constexpr (PH == PH_FINAL) { norm_phase<2>(p, DEPTH, p.in[33], bid, nb, wv); }
}

#if ONE_LAUNCH
__global__ void __launch_bounds__(NT, 2) k_mega(Params p_) {
    ParamsK p = (ParamsK)__builtin_amdgcn_kernarg_segment_ptr();
    volatile LAS unsigned* st = (volatile LAS unsigned*)((char*)shm + LDS_XB);
    if (threadIdx.x < 4) st[threadIdx.x] = 0u;
    __syncthreads();
    const XcdBarrier bar = xcd_barrier_post((unsigned*)(p->ws + WS_BAR), st);
    const int bid = blockIdx.x, nb = gridDim.x, wv = __builtin_amdgcn_readfirstlane(threadIdx.x >> 6);
    run_phase<PH_P0>(p, 0, bid, nb, wv); xcd_barrier(bar); if (DUP == PH_P0) { run_phase<PH_P0, true>(p, 0, bid, nb, wv); xcd_barrier(bar); }
#pragma unroll 1
    for (int layer = 0; layer < DEPTH; ++layer) {
        run_phase<PH_N1>(p, layer, bid, nb, wv); xcd_barrier(bar); if (DUP == PH_N1) { run_phase<PH_N1, true>(p, layer, bid, nb, wv); xcd_barrier(bar); }
        run_phase<PH_GIN>(p, layer, bid, nb, wv); xcd_barrier(bar); if (DUP == PH_GIN) { run_phase<PH_GIN, true>(p, layer, bid, nb, wv); xcd_barrier(bar); }
        run_phase<PH_MIX>(p, layer, bid, nb, wv); xcd_barrier(bar); if (DUP == PH_MIX && (DUPSEL == 0 || (DUPSEL != 2 && (layer & 1) == 0) || (DUPSEL == 2 && (layer & 1) == 1))) { run_phase<PH_MIX, true>(p, layer, bid, nb, wv); xcd_barrier(bar); }
        if ((layer & 1) == 0) { run_phase<PH_TR>(p, layer, bid, nb, wv); xcd_barrier(bar); }
        run_phase<PH_GOUT>(p, layer, bid, nb, wv); xcd_barrier(bar); if (DUP == PH_GOUT) { run_phase<PH_GOUT, true>(p, layer, bid, nb, wv); xcd_barrier(bar); }
        run_phase<PH_GQ>(p, layer, bid, nb, wv); xcd_barrier(bar); if (DUP == PH_GQ) { run_phase<PH_GQ, true>(p, layer, bid, nb, wv); xcd_barrier(bar); }
        run_phase<PH_XATT>(p, layer, bid, nb, wv); xcd_barrier(bar); if (DUP == PH_XATT) { run_phase<PH_XATT, true>(p, layer, bid, nb, wv); xcd_barrier(bar); }
        run_phase<PH_GO>(p, layer, bid, nb, wv); xcd_barrier(bar); if (DUP == PH_GO) { run_phase<PH_GO, true>(p, layer, bid, nb, wv); xcd_barrier(bar); }
        run_phase<PH_ROUTE>(p, layer, bid, nb, wv); xcd_barrier(bar); if (DUP == PH_ROUTE) { run_phase<PH_ROUTE, true>(p, layer, bid, nb, wv); xcd_barrier(bar); }
        run_phase<PH_G1>(p, layer, bid, nb, wv); xcd_barrier(bar); if (DUP == PH_G1) { run_phase<PH_G1, true>(p, layer, bid, nb, wv); xcd_barrier(bar); }
    }
    run_phase<PH_FINAL>(p, DEPTH, bid, nb, wv);
}
#else
template <int PH>
__global__ void __launch_bounds__(NT, 2) k_phase(Params p_, int layer) {
    run_phase<PH>((ParamsK)__builtin_amdgcn_kernarg_segment_ptr(), layer, blockIdx.x, gridDim.x, __builtin_amdgcn_readfirstlane(threadIdx.x >> 6));
}
template <int PH> static void launch_phase(const Params& p, int layer, int grid, hipStream_t stream) {
    static bool init = false;
    if (!init) { (void)hipFuncSetAttribute((const void*)k_phase<PH>, hipFuncAttributeMaxDynamicSharedMemorySize, LDS_BYTES); init = true; }
    hipLaunchKernelGGL(k_phase<PH>, dim3(grid), dim3(NT), LDS_BYTES, stream, p, layer);
}
#endif

extern "C" void kernel_launch(void* const* d_in, const int* in_sizes, int n_in, void* d_out, int out_size, void* d_ws, size_t ws_size, hipStream_t stream) {
    if (n_in != 34 || ws_size < WS_END) { fprintf(stderr, "kernel_launch: unexpected n_in %d or ws_size %zu (need %zu)\n", n_in, ws_size, (size_t)WS_END); return; }
    Params p{};
    for (int i = 0; i < 34; ++i) p.in[i] = (const float*)d_in[i];
    p.out = (float*)d_out; p.ws = (unsigned char*)d_ws;
    (void)hipMemsetAsync(d_ws, 0, WS_ZERO_BYTES, stream);
#if ONE_LAUNCH
    static int grid = 0;
    if (grid == 0) {
        int dev = 0, cus = 0, per_cu = 0;
        (void)hipGetDevice(&dev); (void)hipDeviceGetAttribute(&cus, hipDeviceAttributeMultiprocessorCount, dev);
        (void)hipFuncSetAttribute((const void*)k_mega, hipFuncAttributeMaxDynamicSharedMemorySize, LDS_BYTES);
        (void)hipOccupancyMaxActiveBlocksPerMultiprocessor(&per_cu, (const void*)k_mega, NT, LDS_BYTES);
        (void)hipGetLastError();
        grid = cus > 0 ? cus : 256;
    }
    hipLaunchKernelGGL(k_mega, dim3(grid), dim3(NT), LDS_BYTES, stream, p);
#else
    const int grid = 256;
    launch_phase<PH_P0>(p, 0, grid, stream);
    for (int layer = 0; layer < DEPTH; ++layer) {
        launch_phase<PH_N1>(p, layer, grid, stream);
        launch_phase<PH_GIN>(p, layer, grid, stream);
        launch_phase<PH_MIX>(p, layer, grid, stream);
        if ((layer & 1) == 0) launch_phase<PH_TR>(p, layer, grid, stream);
        launch_phase<PH_GOUT>(p, layer, grid, stream);
        launch_phase<PH_GQ>(p, layer, grid, stream);
        launch_phase<PH_XATT>(p, layer, grid, stream);
        launch_phase<PH_GO>(p, layer, grid, stream);
        launch_phase<PH_ROUTE>(p, layer, grid, stream);
        launch_phase<PH_G1>(p, layer, grid, stream);
    }
    launch_phase<PH_FINAL>(p, DEPTH, grid, stream);
#endif
}
```

```cpp
#include <hip/hip_runtime.h>
#include <stdint.h>
#include <stdio.h>

#ifndef RD_N
#define RD_N 1
#endif
#ifndef RD_E
#define RD_E 1
#endif
#ifndef RD_R
#define RD_R 1
#endif
#ifndef DUP
#define DUP -1
#endif
#ifndef DUPSEL
#define DUPSEL 0
#endif
#ifndef ONE_LAUNCH
#define ONE_LAUNCH 1
#endif

typedef unsigned short bf16_t;
typedef short bf16x8 __attribute__((ext_vector_type(8)));
typedef float f32x4 __attribute__((ext_vector_type(4)));
typedef unsigned u32x4 __attribute__((ext_vector_type(4)));
typedef unsigned u32x2 __attribute__((ext_vector_type(2)));

constexpr int Bb = 8, S = 2048, D = 1024, NTOK = Bb * S, DEPTH = 4, MEM = 256;
constexpr int NEXP = 32, EH = 512;
constexpr int NT = 512;
constexpr float EPS = 1e-6f;

constexpr size_t al256(size_t x) { return (x + 255) & ~(size_t)255; }
constexpr size_t WS_BAR   = 0;
constexpr size_t WS_CNT   = 16384;
constexpr int    CNT_STRIDE = 64;
constexpr size_t WS_QHEAD = 16384 + 65536;
constexpr size_t WS_DONE  = WS_QHEAD + 4096;
constexpr size_t WS_ZERO_BYTES = WS_DONE + (size_t)4 * 32 * 64 * 4;
constexpr size_t WS_MISC  = WS_ZERO_BYTES;
constexpr size_t WS_W_EIN = 131072;
constexpr size_t WS_W_EOUT = WS_W_EIN + (size_t)2 * 3072 * 1024 * 2;
constexpr size_t WS_W_OIN = WS_W_EOUT + (size_t)2 * 1024 * 1024 * 2;
constexpr size_t WS_W_OOUT = WS_W_OIN + (size_t)2 * 1536 * 1024 * 2;
constexpr size_t WS_W_CQ  = WS_W_OOUT + (size_t)2 * 1024 * 1024 * 2;
constexpr size_t WS_W_CKV = WS_W_CQ + (size_t)4 * 512 * 1024 * 2;
constexpr size_t WS_W_CO  = WS_W_CKV + (size_t)4 * 1024 * 1024 * 2;
constexpr size_t WS_W_GU  = WS_W_CO + (size_t)4 * 1024 * 512 * 2;
constexpr size_t WS_W_DN  = WS_W_GU + (size_t)4 * 32 * 1024 * 1024 * 2;
constexpr size_t WS_MEMN  = WS_W_DN + (size_t)4 * 32 * 1024 * 512 * 2;
constexpr size_t WS_XK    = WS_MEMN + (size_t)2048 * 1024 * 2;
constexpr size_t WS_XVT   = WS_XK + (size_t)4 * 2048 * 512 * 2;
constexpr size_t WS_A2    = WS_XVT + (size_t)4 * 2048 * 512 * 2;
constexpr size_t WS_FILT  = WS_A2 + (size_t)2 * 2048 * 64 * 4;
constexpr size_t WS_X     = WS_FILT + (size_t)2 * 2 * 512 * 4096 * 2;
constexpr size_t WS_H     = WS_X + (size_t)NTOK * D * 4;
constexpr size_t WS_PROJ  = WS_H + al256((size_t)(NTOK + 1) * D * 2);
constexpr size_t WS_YMIX  = WS_PROJ + (size_t)NTOK * 3072 * 2;
constexpr size_t WS_QX    = WS_YMIX + (size_t)NTOK * D * 2;
constexpr size_t WS_OX    = WS_QX + (size_t)NTOK * 512 * 2;
constexpr size_t WS_ACT   = WS_OX + (size_t)NTOK * 512 * 2;
constexpr size_t WS_Y     = WS_ACT + al256((size_t)(2 * NTOK + 1) * EH * 2);
constexpr size_t WS_LIST  = WS_Y + (size_t)2 * NTOK * D * 2;
constexpr size_t WS_WT    = WS_LIST + (size_t)NEXP * NTOK * 4;
constexpr size_t WS_RSTD  = WS_WT + (size_t)2 * NTOK * 4;
constexpr size_t WS_WRT   = WS_RSTD + (size_t)NTOK * 4;
constexpr size_t WS_XB    = WS_WRT + (size_t)4 * 2 * 48 * 1024 * 2;
constexpr size_t WS_SSP   = WS_XB + al256((size_t)(NTOK + 1) * D * 2);
constexpr size_t WS_RS1   = WS_SSP + (size_t)NTOK * 16 * 4;
constexpr size_t WS_END   = WS_RS1 + (size_t)NTOK * 4;
constexpr size_t PR_HYT   = 0;
constexpr size_t PR_QK    = (size_t)1536 * NTOK * 2;
constexpr size_t PR_VT    = PR_QK + (size_t)NTOK * 1024 * 2;
constexpr size_t PR_OVT   = (size_t)NTOK * 1280 * 2;

constexpr int LDS_XB = 147456;
constexpr int LDS_ROUTE = LDS_XB + 64;
constexpr int LDS_BYTES = LDS_ROUTE + 2048;

struct Params {
    const float* in[34];
    float* out;
    unsigned char* ws;
};

extern __shared__ __attribute__((aligned(16))) bf16_t shm[];

typedef float f32x2 __attribute__((ext_vector_type(2)));
typedef __bf16 bf16x2v __attribute__((ext_vector_type(2)));
__device__ __forceinline__ unsigned cvt_pk_bf16(float lo, float hi) { const f32x2 v = {lo, hi}; return __builtin_bit_cast(unsigned, __builtin_convertvector(v, bf16x2v)); }
__device__ __forceinline__ float bf2f(unsigned short b) { return __uint_as_float((unsigned)b << 16); }
__device__ __forceinline__ float bflo(unsigned w) { return __uint_as_float(w << 16); }
__device__ __forceinline__ float bfhi(unsigned w) { return __uint_as_float(w & 0xffff0000u); }
__device__ __forceinline__ float shx(float v, int m, int lane) { return __int_as_float(__builtin_amdgcn_ds_bpermute((lane ^ m) << 2, __float_as_int(v))); }
__device__ __forceinline__ float shl(float v, int src) { return __int_as_float(__builtin_amdgcn_ds_bpermute(src << 2, __float_as_int(v))); }
__device__ __forceinline__ float wave_sum(float v, int lane) {
    v += shx(v, 1, lane); v += shx(v, 2, lane); v += shx(v, 4, lane); v += shx(v, 8, lane); v += shx(v, 16, lane); v += shx(v, 32, lane); return v;
}

__device__ __forceinline__ float uni(float x) { return __builtin_bit_cast(float, __builtin_amdgcn_readfirstlane(__builtin_bit_cast(int, x))); }
__device__ __forceinline__ int hidden_tid(int wv) { int l; asm volatile("v_mbcnt_lo_u32_b32 %0, -1, 0\n\tv_mbcnt_hi_u32_b32 %0, -1, %0" : "=&v"(l)); return (wv << 6) | l; }

#define XB_TMO      128
#define XB_XCNT(j)  (256  + 64 * (j))
#define XB_XSUB(j)  (1280 + 64 * (j))
#define XB_XGEN(j)  (2304 + 64 * (j))
#define XB_TOP      3328
#define XB_TOPGEN   3392
#define XCD_BAR_WORDS 3456
#define XB_SPIN_CAP (1u << 22)
#define LAS __attribute__((address_space(3)))

__device__ __forceinline__ unsigned xb_ld(unsigned* p)              { return __hip_atomic_load(p, __ATOMIC_RELAXED, __HIP_MEMORY_SCOPE_AGENT); }
__device__ __forceinline__ unsigned xb_add(unsigned* p, unsigned v) { return __hip_atomic_fetch_add(p, v, __ATOMIC_RELAXED, __HIP_MEMORY_SCOPE_AGENT); }
__device__ __forceinline__ unsigned xb_xcc_id() { return (unsigned)__builtin_amdgcn_s_getreg((3 << 11) | 20) & 0xFu; }
#define XB_SPIN(cond, bar) do { unsigned _sp = 0; while (cond) { __builtin_amdgcn_s_sleep(1); \
    if ((++_sp & 255u) == 0u) { if (xb_ld(&(bar)[XB_TMO])) break; if (_sp > XB_SPIN_CAP) { atomicAdd(&(bar)[XB_TMO], 1u); break; } } } } while (0)

struct XcdBarrier { unsigned* bar; unsigned x; volatile LAS unsigned* st; };

__device__ __forceinline__ XcdBarrier xcd_barrier_post(unsigned* bar, volatile LAS unsigned* st) {
    XcdBarrier b; b.bar = bar; b.x = xb_xcc_id(); b.st = st;
    if (threadIdx.x == 0) (void)xb_add(&bar[XB_XCNT(b.x)], 1u);
    return b;
}
__device__ __forceinline__ void xcd_barrier_complete(unsigned* bar, unsigned x, unsigned& nloc, unsigned& nx) {
    const unsigned G = gridDim.x * gridDim.y * gridDim.z;
    unsigned sum, cnt, mine, sp = 0u;
    for (;;) {
        sum = 0u; cnt = 0u; mine = 0u;
#pragma unroll
        for (unsigned j = 0; j < 16; ++j) { const unsigned c = xb_ld(&bar[XB_XCNT(j)]); sum += c; cnt += (c > 0u) ? 1u : 0u; mine = (j == x) ? c : mine; }
        if (sum == G) break;
        __builtin_amdgcn_s_sleep(1);
        if ((++sp & 255u) == 0u) { if (xb_ld(&bar[XB_TMO])) break; if (sp > XB_SPIN_CAP) { atomicAdd(&bar[XB_TMO], 1u); break; } }
    }
    nloc = mine > 0u ? mine : 1u; nx = cnt > 0u ? cnt : 1u;
}
__device__ __forceinline__ void xcd_barrier(const XcdBarrier& b) {
    asm volatile("s_waitcnt vmcnt(0)" ::: "memory");
    __syncthreads();
    if (threadIdx.x == 0) {
        unsigned* bar = b.bar; unsigned bx = b.x;
        asm volatile("" : "+s"(bar), "+s"(bx));
        __builtin_amdgcn_s_waitcnt(0);
        unsigned nloc = b.st[0], nx = b.st[1];
        if (nloc == 0u) { xcd_barrier_complete(bar, bx, nloc, nx); b.st[0] = nloc; b.st[1] = nx; }
        const unsigned old = xb_add(&bar[XB_XSUB(bx)], 1u);
        const unsigned gen = old / nloc;
        if (old + 1u == (gen + 1u) * nloc) {
            __builtin_amdgcn_fence(__ATOMIC_RELEASE, "agent");
            asm volatile("s_waitcnt vmcnt(0)" ::: "memory");
            const unsigned og = xb_add(&bar[XB_TOP], 1u);
            const unsigned tg = og / nx;
            if (og + 1u == (tg + 1u) * nx) xb_add(&bar[XB_TOPGEN], 1u);
            else XB_SPIN(xb_ld(&bar[XB_TOPGEN]) == tg, bar);
            __builtin_amdgcn_fence(__ATOMIC_ACQUIRE, "agent");
            xb_add(&bar[XB_XGEN(bx)], 1u);
            asm volatile("s_waitcnt vmcnt(0)" ::: "memory");
        } else {
            XB_SPIN(xb_ld(&bar[XB_XGEN(bx)]) == gen, bar);
            __builtin_amdgcn_fence(__ATOMIC_ACQUIRE, "agent");
            asm volatile("s_waitcnt vmcnt(0)" ::: "memory");
        }
    }
    __syncthreads();
}

constexpr int HT = 128 * 64;
__device__ __forceinline__ int lds_byte(int r, int c) {
    int st = (r >> 4) * 2 + (c >> 5), rr = r & 15, cc = c & 31, ob = rr * 64 + cc * 2;
    return st * 1024 + (ob ^ (((ob >> 9) & 1) << 5));
}
__device__ __forceinline__ void stage_rc(int b, int& R, int& C) {
    int st = b / 1024, sb = b % 1024, swz = sb ^ (((sb >> 9) & 1) << 5);
    R = (st >> 1) * 16 + swz / 64; C = (st & 1) * 32 + (swz % 64) / 2;
}
#define SA(b, h) (shm + ((b) * 2 + (h)) * HT)
#define SB(b, h) (shm + (4 + (b) * 2 + (h)) * HT)
#define G_STAGE_A(P_, h, kt) do { _Pragma("unroll") for (int _i = 0; _i < 2; ++_i) \
    __builtin_amdgcn_global_load_lds((const unsigned*)((const char*)A + (size_t)((kt) * 128 + (RowSrc::DENSE ? (h) * 256 * K : 0)) + aoff[RowSrc::DENSE ? 0 : (h)][_i]), (unsigned*)((char*)(P_) + tid * 16 + _i * 8192), 16, 0, 0); } while (0)
#define G_STAGE_B(P_, h, kt) do { _Pragma("unroll") for (int _i = 0; _i < 2; ++_i) \
    __builtin_amdgcn_global_load_lds((const unsigned*)((const char*)Bt + (size_t)((kt) * 128 + (h) * 64 * K) + boff[_i]), (unsigned*)((char*)(P_) + tid * 16 + _i * 8192), 16, 0, 0); } while (0)
#define G_LDA(dst, b, h) _Pragma("unroll") for (int m = 0; m < 4; ++m) _Pragma("unroll") for (int k = 0; k < 2; ++k) \
    dst[m][k] = *reinterpret_cast<const bf16x8*>((char*)SA(b, h) + lds_byte(wr * 64 + m * 16 + fr, k * 32 + fq * 8))
#define G_LDB(dst, b, h) _Pragma("unroll") for (int n = 0; n < 2; ++n) _Pragma("unroll") for (int k = 0; k < 2; ++k) \
    dst[n][k] = *reinterpret_cast<const bf16x8*>((char*)SB(b, h) + lds_byte(wc * 32 + n * 16 + fr, k * 32 + fq * 8))
#define G_MMA(ai, bj, At_, Bt_) do { __builtin_amdgcn_s_setprio(1); \
    _Pragma("unroll") for (int m = 0; m < 4; ++m) _Pragma("unroll") for (int n = 0; n < 2; ++n) _Pragma("unroll") for (int k = 0; k < 2; ++k) \
      acc[ai][bj][m][n] = __builtin_amdgcn_mfma_f32_16x16x32_bf16(Bt_[n][k], At_[m][k], acc[ai][bj][m][n], 0, 0, 0); \
    __builtin_amdgcn_s_setprio(0); } while (0)
#define WAIT_V(n) asm volatile("s_waitcnt vmcnt(" #n ")" ::: "memory")
#define WAIT_L(n) asm volatile("s_waitcnt lgkmcnt(" #n ")" ::: "memory")
#define BAR __builtin_amdgcn_s_barrier()
#define SCHED __builtin_amdgcn_sched_barrier(0)

typedef f32x4 AccT[2][2][4][2];

template <class RowSrc, class Epi>
__device__ __forceinline__ void gemm_tile(const bf16_t* __restrict__ A, const bf16_t* __restrict__ Bt, const int K,
                                          const int bcol, const RowSrc& rs, const Epi& epi, const int wv) {
    const int tid = hidden_tid(wv);
    int wid = tid >> 6, lane = tid & 63, wr = wid >> 2, wc = wid & 3, fr = lane & 15, fq = lane >> 4;
    unsigned aoff[2][2], boff[2];
#pragma unroll
    for (int i = 0; i < 2; ++i) {
        int R, C; stage_rc(tid * 16 + i * 8192, R, C);
        boff[i] = (unsigned)(((bcol + (R >> 5) * 64 + (R & 31)) * K + C) * 2);
        if (RowSrc::DENSE) { aoff[0][i] = (unsigned)((R * K + C) * 2); aoff[1][i] = 0u; }
        else {
#pragma unroll
            for (int h = 0; h < 2; ++h) aoff[h][i] = (unsigned)((rs(h * 128 + R) * K + C) * 2);
        }
    }
    WAIT_V(0);
    AccT acc = {};
    bf16x8 At[4][2], B0[2][2], B1[2][2];
    const int nt = K / 64;
    G_STAGE_B(SB(0, 0), 0, 0); G_STAGE_A(SA(0, 0), 0, 0);
    G_STAGE_B(SB(0, 1), 1, 0); G_STAGE_A(SA(0, 1), 1, 0);
    if (wr == 1) BAR;
    WAIT_V(4); BAR;
    G_STAGE_B(SB(1, 0), 0, 1); G_STAGE_A(SA(1, 0), 0, 1); G_STAGE_B(SB(1, 1), 1, 1);
    WAIT_V(6); BAR;
    for (int t = 0; t < nt - 2; t += 2) {
        G_LDB(B0, 0, 0); SCHED; G_LDA(At, 0, 0); G_STAGE_A(SA(1, 1), 1, t + 1);
        WAIT_L(8); BAR; WAIT_L(0); G_MMA(0, 0, At, B0); BAR; SCHED;
        G_LDB(B1, 0, 1); G_STAGE_B(SB(0, 0), 0, t + 2);
        BAR; WAIT_L(0); G_MMA(0, 1, At, B1); BAR;
        G_LDA(At, 0, 1); G_STAGE_A(SA(0, 0), 0, t + 2);
        BAR; WAIT_L(0); G_MMA(1, 0, At, B0); BAR; SCHED;
        G_STAGE_B(SB(0, 1), 1, t + 2);
        WAIT_V(6); BAR; G_MMA(1, 1, At, B1); BAR;
        G_LDB(B0, 1, 0); SCHED; G_LDA(At, 1, 0); G_STAGE_A(SA(0, 1), 1, t + 2);
        WAIT_L(8); BAR; WAIT_L(0); G_MMA(0, 0, At, B0); BAR; SCHED;
        G_LDB(B1, 1, 1); G_STAGE_B(SB(1, 0), 0, t + 3);
        BAR; WAIT_L(0); G_MMA(0, 1, At, B1); BAR;
        G_LDA(At, 1, 1); G_STAGE_A(SA(1, 0), 0, t + 3);
        BAR; WAIT_L(0); G_MMA(1, 0, At, B0); BAR; SCHED;
        G_STAGE_B(SB(1, 1), 1, t + 3);
        WAIT_V(6); BAR; G_MMA(1, 1, At, B1); BAR;
    }
    { G_LDB(B0, 0, 0); WAIT_V(0); G_LDA(At, 0, 0); G_STAGE_A(SA(1, 1), 1, nt - 1);
      BAR; WAIT_L(0); G_MMA(0, 0, At, B0); BAR;
      G_LDB(B1, 0, 1); BAR; WAIT_L(0); G_MMA(0, 1, At, B1); BAR;
      G_LDA(At, 0, 1); WAIT_V(4); BAR; WAIT_L(0); G_MMA(1, 0, At, B0); G_MMA(1, 1, At, B1); BAR; }
    { G_LDB(B0, 1, 0); G_LDA(At, 1, 0); WAIT_V(2); BAR; WAIT_L(0); G_MMA(0, 0, At, B0); BAR;
      G_LDB(B1, 1, 1); WAIT_V(0); BAR; WAIT_L(0); G_MMA(0, 1, At, B1); BAR;
      G_LDA(At, 1, 1); BAR; WAIT_L(0); G_MMA(1, 0, At, B0); G_MMA(1, 1, At, B1); BAR; }
    if (wr == 0) BAR;
    int tz = hidden_tid(wv); wid = tz >> 6; lane = tz & 63; wr = wid >> 2; wc = wid & 3; fr = lane & 15; fq = lane >> 4;
    epi(acc, wr * 64 + fr, bcol + wc * 64 + fq * 4);
}

struct RowIdent { static constexpr bool DENSE = true; __device__ __forceinline__ int operator()(int r) const { return r; } };

__device__ __forceinline__ void st_bf16x4(bf16_t* p, const f32x4& v) { u32x2 w; w.x = cvt_pk_bf16(v[0], v[1]); w.y = cvt_pk_bf16(v[2], v[3]); *(u32x2*)p = w; }
__device__ __forceinline__ void st_chan4(bf16_t* q, size_t ld, const f32x4& v) {
    const unsigned a = cvt_pk_bf16(v[0], v[1]), b = cvt_pk_bf16(v[2], v[3]);
    q[0] = (bf16_t)(a & 0xffff); q[ld] = (bf16_t)(a >> 16); q[2 * ld] = (bf16_t)(b & 0xffff); q[3 * ld] = (bf16_t)(b >> 16);
}
constexpr int BJS = 32;
#define EPI_LOOP_AM _Pragma("unroll") for (int ai = 0; ai < 2; ++ai) _Pragma("unroll") for (int m = 0; m < 4; ++m)
#define EPI_LOOP_BN _Pragma("unroll") for (int bj = 0; bj < 2; ++bj) _Pragma("unroll") for (int n = 0; n < 2; ++n)
struct EpiRes {
    bf16_t* XB; int brow; float* ssp; int lane;
    __device__ __forceinline__ void operator()(AccT& acc, int r0, int c0) const {
        EPI_LOOP_AM {
            const int row = brow + r0 + ai * 128 + m * 16;
            bf16_t* qb = XB + (size_t)row * D + c0;
            float ss = 0.f;
            EPI_LOOP_BN {
                const u32x2 xv = *(const u32x2*)(qb + bj * BJS + n * 16);
                const f32x4 t = (f32x4){bflo(xv.x), bfhi(xv.x), bflo(xv.y), bfhi(xv.y)} + acc[ai][bj][m][n];
                const unsigned a0 = cvt_pk_bf16(t[0], t[1]), a1 = cvt_pk_bf16(t[2], t[3]);
                *(u32x2*)(qb + bj * BJS + n * 16) = (u32x2){a0, a1};
                const float r0f = bflo(a0), r1f = bfhi(a0), r2f = bflo(a1), r3f = bfhi(a1);
                ss += (r0f * r0f + r1f * r1f) + (r2f * r2f + r3f * r3f);
            }
            if (ssp) { ss += shx(ss, 16, lane); ss += shx(ss, 32, lane); if ((lane >> 4) == 0) ssp[(size_t)row * 16 + (c0 >> 6)] = ss; }
            asm volatile("" ::: "memory");
        }
    }
};
struct EpiSplit {
    bf16_t* Ca; bf16_t* T; bf16_t* Cb; int c0s, c1s, ldT; size_t ldC; int brow; const float* rs;
    __device__ __forceinline__ void chan(AccT& acc, bf16_t* base, int r0, int c) const {
        EPI_LOOP_AM { const int row = brow + r0 + ai * 128 + m * 16; const float sc = rs ? rs[row] : 1.0f;
            bf16_t* q = base + (size_t)c * ldC + row;
            EPI_LOOP_BN st_chan4(q + (size_t)(bj * BJS + n * 16) * ldC, ldC, acc[ai][bj][m][n] * sc); }
    }
    __device__ __forceinline__ void operator()(AccT& acc, int r0, int c0) const {
        const int tilec = __builtin_amdgcn_readfirstlane(c0) & ~255;
        if (tilec < c0s) chan(acc, Ca, r0, c0);
        else if (tilec < c1s) {
            EPI_LOOP_AM { const int row = brow + r0 + ai * 128 + m * 16; const float sc = rs ? rs[row] : 1.0f;
                bf16_t* q = T + (size_t)row * ldT + (c0 - c0s);
                EPI_LOOP_BN st_bf16x4(q + bj * BJS + n * 16, acc[ai][bj][m][n] * sc); }
        } else chan(acc, Cb, r0, c0 - c1s);
    }
};
struct EpiTokRstd {
    bf16_t* T; int ldT, brow; const float* ssp;
    __device__ __forceinline__ void operator()(AccT& acc, int r0, int c0) const {
        EPI_LOOP_AM {
            const int row = brow + r0 + ai * 128 + m * 16;
            const f32x4 p0 = *(const f32x4*)(ssp + (size_t)row * 16), p1 = *(const f32x4*)(ssp + (size_t)row * 16 + 4), p2 = *(const f32x4*)(ssp + (size_t)row * 16 + 8), p3 = *(const f32x4*)(ssp + (size_t)row * 16 + 12);
            const float ssq = ((p0[0] + p0[1]) + (p0[2] + p0[3])) + ((p1[0] + p1[1]) + (p1[2] + p1[3])) + ((p2[0] + p2[1]) + (p2[2] + p2[3])) + ((p3[0] + p3[1]) + (p3[2] + p3[3]));
            const float rs = rsqrtf(ssq * (1.0f / 1024.0f) + EPS);
            bf16_t* q = T + (size_t)row * ldT + c0;
            EPI_LOOP_BN st_bf16x4(q + bj * BJS + n * 16, acc[ai][bj][m][n] * rs);
        }
    }
};
struct EpiGateUp {
    bf16_t* act; const int* list; int cnt, pos0; const float* rstd;
    __device__ __forceinline__ void operator()(AccT& acc, int r0, int c0) const {
        EPI_LOOP_AM {
            const int pos = pos0 + r0 + ai * 128 + m * 16;
            if (pos < cnt) {
                const int a = list[pos];
                const float rs = rstd[a >> 1];
#pragma unroll
                for (int bj = 0; bj < 2; ++bj) {
                    const f32x4 g = acc[ai][bj][m][0] * rs, u = acc[ai][bj][m][1] * rs; f32x4 o;
#pragma unroll
                    for (int j = 0; j < 4; ++j) o[j] = g[j] / (1.0f + __expf(-g[j])) * u[j];
                    const int col = c0 + bj * BJS;
                    const unsigned long long wv8 = ((unsigned long long)cvt_pk_bf16(o[2], o[3]) << 32) | cvt_pk_bf16(o[0], o[1]);
                    __hip_atomic_store((unsigned long long*)(act + (size_t)a * EH + (col >> 5) * 16 + (col & 15)), wv8, __ATOMIC_RELAXED, __HIP_MEMORY_SCOPE_AGENT);
                }
            }
        }
    }
};
struct EpiDown {
    bf16_t* y; const int* list; int cnt, pos0;
    __device__ __forceinline__ void operator()(AccT& acc, int r0, int c0) const {
        EPI_LOOP_AM {
            const int pos = pos0 + r0 + ai * 128 + m * 16;
            if (pos < cnt) { bf16_t* q = y + (size_t)list[pos] * D + c0; EPI_LOOP_BN st_bf16x4(q + bj * BJS + n * 16, acc[ai][bj][m][n]); }
        }
    }
};
struct RowTok { static constexpr bool DENSE = false; const int* list; int cnt, pos0; __device__ __forceinline__ int operator()(int r) const { const int pos = pos0 + r; return pos < cnt ? (list[pos] >> 1) : NTOK; } };
struct RowAsg { static constexpr bool DENSE = false; const int* list; int cnt, pos0; __device__ __forceinline__ int operator()(int r) const { const int pos = pos0 + r; return pos < cnt ? list[pos] : 2 * NTOK; } };

constexpr int ATT_VOFF = 16384;
template <int MODE> struct ACfg;
template <> struct ACfg<0> { static constexpr int DQK = 64, DV = 128, NMAP = 2, KBLK = 2; };
template <> struct ACfg<1> { static constexpr int DQK = 64, DV = 64, NMAP = 1, KBLK = 1; };
template <> struct ACfg<2> { static constexpr int DQK = 128, DV = 128, NMAP = 1, KBLK = 2; };

template <int MODE, bool ALT = false>
__device__ __forceinline__ void attn_unit(const bf16_t* __restrict__ Qp, const int ldq,
                                          const bf16_t* __restrict__ Kp, const int ldk,
                                          const bf16_t* __restrict__ Vt, const size_t ldvt,
                                          const int q0, const int kbeg, const int kend,
                                          const float scale, const float slope, const float m_init, const float l_init,
                                          bf16_t* __restrict__ Op, const int ldo,
                                          const float lam, const float outscale, const float* __restrict__ subln, const int wv) {
    constexpr int DQK = ACfg<MODE>::DQK, DV = ACfg<MODE>::DV, NMAP = ACfg<MODE>::NMAP, KBLK = ACfg<MODE>::KBLK;
    const int tid = hidden_tid(wv), w = tid >> 6, lane = tid & 63, fr = lane & 15, fq = lane >> 4;
    const int qrow = q0 + w * 16 + fr;
    bf16x8 Qf[NMAP][DQK / 32];
#pragma unroll
    for (int m = 0; m < NMAP; ++m)
#pragma unroll
        for (int kk = 0; kk < DQK / 32; ++kk) Qf[m][kk] = *(const bf16x8*)(Qp + (size_t)qrow * ldq + m * DQK + kk * 32 + fq * 8);
    constexpr float LOG2E = 1.4426950408889634f;
    const float scale2 = scale * LOG2E, slope2 = slope * LOG2E, kappa = slope / scale;
    f32x4 O[NMAP][DV / 16], Ol[NMAP];
    float mrun[NMAP];
#pragma unroll
    for (int m = 0; m < NMAP; ++m) {
        mrun[m] = m_init * LOG2E; Ol[m] = (f32x4){(fq == 0) ? l_init : 0.f, 0.f, 0.f, 0.f};
#pragma unroll
        for (int et = 0; et < DV / 16; ++et) O[m][et] = (f32x4){0.f, 0.f, 0.f, 0.f};
    }
    const unsigned onesw = (fr == 0) ? 0x3f803f80u : 0u;
    const bf16x8 onesf = __builtin_bit_cast(bf16x8, (u32x4){onesw, onesw, onesw, onesw});
    char* const lds = (char*)shm;
    constexpr int KN = KBLK, VN = DV / 64;
    u32x4 kreg[KN], vreg[VN];
#define ATT_LOAD(k0_) do { \
        _Pragma("unroll") for (int i_ = 0; i_ < KN; ++i_) { const int c_ = tid + i_ * NT; const int key_ = c_ / (KBLK * 8), col_ = (c_ % (KBLK * 8)) * 8; \
            kreg[i_] = *(const u32x4*)(Kp + (size_t)((k0_) + key_) * ldk + col_); } \
        _Pragma("unroll") for (int i_ = 0; i_ < VN; ++i_) { const int c_ = tid + i_ * NT; const int e_ = c_ >> 3, kc_ = c_ & 7; \
            vreg[i_] = *(const u32x4*)(Vt + (size_t)e_ * ldvt + (k0_) + kc_ * 8); } } while (0)
    ATT_LOAD(kbeg);
    const int qw0 = q0 + w * 16;
    constexpr int VBYTES = DV * 160;
    bf16x8 Pf[NMAP][2];
#define ATT_PV_C(voff_, c) do { \
            bf16x8 vf[DV / 16]; \
            _Pragma("unroll") for (int et = 0; et < DV / 16; ++et) vf[et] = *(const bf16x8*)(lds + (voff_) + (et * 16 + fr) * 160 + (c) * 64 + fq * 16); \
            _Pragma("unroll") for (int m = 0; m < NMAP; ++m) Ol[m] = __builtin_amdgcn_mfma_f32_16x16x32_bf16(onesf, Pf[m][c], Ol[m], 0, 0, 0); \
            _Pragma("unroll") for (int et = 0; et < DV / 16; ++et) \
                _Pragma("unroll") for (int m = 0; m < NMAP; ++m) O[m][et] = __builtin_amdgcn_mfma_f32_16x16x32_bf16(vf[et], Pf[m][c], O[m][et], 0, 0, 0); \
        } while (0)
    int vcur = ATT_VOFF;
    for (int k0 = kbeg; k0 < kend; k0 += 64) {
        __syncthreads();
#pragma unroll
        for (int i = 0; i < KN; ++i) { const int c = tid + i * NT; const int key = c / (KBLK * 8), col = (c % (KBLK * 8)) * 8;
            *(u32x4*)(lds + (col >> 6) * 8192 + lds_byte(key, col & 63)) = kreg[i]; }
#pragma unroll
        for (int i = 0; i < VN; ++i) { const int c = tid + i * NT; const int e = c >> 3, kc = c & 7;
            char* vd = lds + vcur + e * 160 + (kc >> 2) * 64 + (kc & 1) * 32 + ((kc >> 1) & 1) * 8;
            *(u32x2*)vd = (u32x2){vreg[i].x, vreg[i].y}; *(u32x2*)(vd + 16) = (u32x2){vreg[i].z, vreg[i].w}; }
        __syncthreads();
        if (k0 + 64 < kend) ATT_LOAD(k0 + 64);
        const int vprev = vcur ^ ATT_VOFF ^ (ATT_VOFF + VBYTES);
        const float dq = (float)(qrow - k0);
        bool gen;
        if (MODE == 2) gen = false;
        else if (MODE == 1) gen = !((k0 + 63 <= qw0 && qw0 + 15 - k0 <= 128) || (k0 >= qw0 + 15 && k0 + 63 - qw0 <= 128));
        else gen = !(k0 + 63 <= qw0 || k0 >= qw0 + 15);
        const bool pos = (MODE == 2) || (k0 + 63 <= qw0);
        f32x4 Cin[4]; float off;
        if (MODE == 2) {
#pragma unroll
            for (int t = 0; t < 4; ++t) Cin[t] = (f32x4){0.f, 0.f, 0.f, 0.f};
            off = 0.f;
        } else if (gen) {
#pragma unroll
            for (int t = 0; t < 4; ++t)
#pragma unroll
                for (int r = 0; r < 4; ++r) Cin[t][r] = -kappa * fabsf(dq - (float)(16 * t + 4 * fq + r));
            off = 0.f;
        } else {
            const float sk = pos ? kappa : -kappa, cb = sk * (float)(4 * fq);
#pragma unroll
            for (int t = 0; t < 4; ++t)
#pragma unroll
                for (int r = 0; r < 4; ++r) Cin[t][r] = sk * (float)(16 * t + r) + cb;
            off = pos ? -slope2 * dq : slope2 * dq;
        }
        f32x4 s[NMAP][4];
#pragma unroll
        for (int m = 0; m < NMAP; ++m) {
            bf16x8 kf[4][DQK / 32];
#pragma unroll
            for (int t = 0; t < 4; ++t)
#pragma unroll
                for (int kk = 0; kk < DQK / 32; ++kk) {
                    const int blk = (MODE == 2) ? (kk >> 1) : m, kcol = (MODE == 2) ? (kk & 1) * 32 : kk * 32;
                    kf[t][kk] = *(const bf16x8*)(lds + blk * 8192 + lds_byte(t * 16 + fr, kcol + fq * 8));
                }
#pragma unroll
            for (int t = 0; t < 4; ++t) {
                s[m][t] = Cin[t];
#pragma unroll
                for (int kk = 0; kk < DQK / 32; ++kk) s[m][t] = __builtin_amdgcn_mfma_f32_16x16x32_bf16(kf[t][kk], Qf[m][kk], s[m][t], 0, 0, 0);
            }
        }
        float mx[NMAP], mx1[NMAP];
#pragma unroll
        for (int m = 0; m < NMAP; ++m) {
            if (MODE == 1 && gen) {
#pragma unroll
                for (int t = 0; t < 4; ++t)
#pragma unroll
                    for (int r = 0; r < 4; ++r) s[m][t][r] = (fabsf(dq - (float)(16 * t + 4 * fq + r)) > 128.0f) ? -1e30f : s[m][t][r];
            }
            float v = fmaxf(fmaxf(s[m][0][0], s[m][0][1]), fmaxf(s[m][0][2], s[m][0][3]));
#pragma unroll
            for (int t = 1; t < 4; ++t) v = fmaxf(v, fmaxf(fmaxf(s[m][t][0], s[m][t][1]), fmaxf(s[m][t][2], s[m][t][3])));
            mx[m] = v; mx1[m] = shx(v, 16, lane);
        }
        __builtin_amdgcn_sched_barrier(0);
        if (k0 > kbeg) ATT_PV_C(vprev, 0);
        __builtin_amdgcn_sched_barrier(0);
#pragma unroll
        for (int m = 0; m < NMAP; ++m) { mx[m] = fmaxf(mx[m], mx1[m]); mx1[m] = shx(mx[m], 32, lane); }
        __builtin_amdgcn_sched_barrier(0);
        if (k0 > kbeg) ATT_PV_C(vprev, 1);
        __builtin_amdgcn_sched_barrier(0);
#pragma unroll
        for (int m = 0; m < NMAP; ++m) {
            const float mxx = fmaxf(mx[m], mx1[m]);
            const float mtile = fmaxf(mxx * scale2 + off, -1e30f);
            const float mnew = fmaxf(mrun[m], mtile), alpha = __builtin_amdgcn_exp2f(mrun[m] - mnew);
            mrun[m] = mnew;
            const float sub = off - mnew;
#pragma unroll
            for (int t = 0; t < 4; ++t)
#pragma unroll
                for (int r = 0; r < 4; ++r) s[m][t][r] = __builtin_amdgcn_exp2f(s[m][t][r] * scale2 + sub);
            if (__builtin_amdgcn_ballot_w64(alpha != 1.0f) != 0ull) {
                Ol[m] *= alpha;
#pragma unroll
                for (int et = 0; et < DV / 16; ++et) O[m][et] *= alpha;
            }
#pragma unroll
            for (int c = 0; c < 2; ++c) {
                u32x4 pk; pk.x = cvt_pk_bf16(s[m][2 * c][0], s[m][2 * c][1]); pk.y = cvt_pk_bf16(s[m][2 * c][2], s[m][2 * c][3]);
                pk.z = cvt_pk_bf16(s[m][2 * c + 1][0], s[m][2 * c + 1][1]); pk.w = cvt_pk_bf16(s[m][2 * c + 1][2], s[m][2 * c + 1][3]);
                Pf[m][c] = __builtin_bit_cast(bf16x8, pk);
            }
        }
        vcur = vprev;
    }
    { const int vlast = vcur ^ ATT_VOFF ^ (ATT_VOFF + VBYTES); ATT_PV_C(vlast, 0); ATT_PV_C(vlast, 1); }
    float linv[NMAP];
#pragma unroll
    for (int m = 0; m < NMAP; ++m) linv[m] = 1.0f / shl(Ol[m][0], fr);
    const int tid2 = hidden_tid(wv); const int qrow_o = q0 + (tid2 >> 6) * 16 + (tid2 & 15);
    if (MODE == 0) {
        float ss = 0.f;
#pragma unroll
        for (int et = 0; et < DV / 16; ++et)
#pragma unroll
            for (int r = 0; r < 4; ++r) { const float v = O[0][et][r] * linv[0] - lam * (O[NMAP - 1][et][r] * linv[NMAP - 1]); O[0][et][r] = v; ss += v * v; }
        ss += shx(ss, 16, lane); ss += shx(ss, 32, lane);
        const float rs = rsqrtf(ss * (1.0f / 128.0f) + EPS) * outscale;
#pragma unroll
        for (int et = 0; et < DV / 16; ++et) {
            const f32x4 g = *(const f32x4*)(subln + et * 16 + fq * 4);
            st_bf16x4(Op + (size_t)qrow_o * ldo + et * 16 + fq * 4, O[0][et] * rs * g);
        }
    } else {
#pragma unroll
        for (int et = 0; et < DV / 16; ++et) st_bf16x4(Op + (size_t)qrow_o * ldo + et * 16 + fq * 4, O[0][et] * linv[0]);
    }
}

constexpr int HZ_RS = 4896;
constexpr int HZ_PAD = 192;
constexpr int H_CPS = 8256;
constexpr int H_ZOFF = 0, H_CPOFF = 8 * HZ_RS, H_RAWOFF = H_CPOFF + 8 * H_CPS;

template <bool ALT>
__device__ __forceinline__ void hyena_unit(const Params& p, const int lj  , const int c, const int wv) {
    const int tid = hidden_tid(wv), w = tid >> 6, lane = tid & 63, fr = lane & 15, fq = lane >> 4;
    char* const lds = (char*)shm;
    const bf16_t* hyT = (const bf16_t*)(p.ws + WS_PROJ + PR_HYT);
    const float* cw = p.in[4] + (size_t)lj * 3 * 1536; const float* cb = p.in[5] + (size_t)lj * 1536;
    const int nb = fr >> 1, tbp = fr & 1;
    __syncthreads();
    for (int i = tid; i < 8 * 2 * (HZ_PAD / 8); i += NT) {
        const int b = i / (2 * (HZ_PAD / 8)), r = i % (2 * (HZ_PAD / 8)), side = r / (HZ_PAD / 8), k = r % (HZ_PAD / 8);
        unsigned zz0 = 0u; asm volatile("" : "+v"(zz0));
        *(u32x4*)(lds + H_ZOFF + b * HZ_RS + (side ? (HZ_PAD + 2048) * 2 : 0) + k * 16) = (u32x4){zz0, zz0, zz0, zz0};
        if (i < 2) *(u32x4*)(lds + H_RAWOFF + 8192 + i * 16) = (u32x4){zz0, zz0, zz0, zz0};
    }
    {
        const float w0 = cw[c], w1 = cw[1536 + c], w2 = cw[2 * 1536 + c], bb = cb[c];
        const bf16_t* src = hyT + (size_t)c * NTOK;
        u32x4 v[4]; unsigned short um[4], up[4];
#pragma unroll
        for (int k = 0; k < 4; ++k) {
            const int i = tid + k * NT, b = i >> 8, s0 = (i & 255) * 8;
            const bf16_t* q = src + b * S + s0;
            v[k] = *(const u32x4*)q; um[k] = q[s0 > 0 ? -1 : 0]; up[k] = q[s0 + 8 < S ? 8 : 7];
        }
#pragma unroll
        for (int k = 0; k < 4; ++k) {
            const int i = tid + k * NT, b = i >> 8, s0 = (i & 255) * 8;
            float u[10];
            u[0] = (s0 > 0) ? bf2f(um[k]) : 0.f; u[9] = (s0 + 8 < S) ? bf2f(up[k]) : 0.f;
            u[1] = bflo(v[k].x); u[2] = bfhi(v[k].x); u[3] = bflo(v[k].y); u[4] = bfhi(v[k].y); u[5] = bflo(v[k].z); u[6] = bfhi(v[k].z); u[7] = bflo(v[k].w); u[8] = bfhi(v[k].w);
            float o[8];
#pragma unroll
            for (int j = 0; j < 8; ++j) o[j] = w0 * u[j] + w1 * u[j + 1] + w2 * u[j + 2] + bb;
            u32x4 ov; ov.x = cvt_pk_bf16(o[0], o[1]); ov.y = cvt_pk_bf16(o[2], o[3]); ov.z = cvt_pk_bf16(o[4], o[5]); ov.w = cvt_pk_bf16(o[6], o[7]);
            *(u32x4*)(lds + H_ZOFF + b * HZ_RS + (HZ_PAD + s0) * 2) = ov;
        }
    }
#pragma unroll 1
    for (int order = 0; order < 2; ++order) {
        const int gch = 512 * (order + 1) + c;
        const bf16_t* gsrc = hyT + (size_t)gch * NTOK;
        u32x2 gv[2][4]; unsigned short gm[2][4], gp[2][4];
        u32x4 rawv;
        {
            const bf16_t* f = (const bf16_t*)(p.ws + WS_FILT) + ((size_t)(lj * 2 + order) * 512 + c) * 4096;
            rawv = *(const u32x4*)(f + tid * 8);
#pragma unroll
            for (int ci = 0; ci < 2; ++ci)
#pragma unroll
                for (int mt = 0; mt < 4; ++mt) {
                    const int t = 64 * (4 * w + 2 * ci + tbp) + 16 * mt + 4 * fq;
                    const bf16_t* gq = gsrc + nb * S + t;
                    gv[ci][mt] = *(const u32x2*)gq; gm[ci][mt] = gq[t > 0 ? -1 : 0]; gp[ci][mt] = gq[t + 4 < S ? 4 : 3];
                }
        }
        *(u32x4*)(lds + H_RAWOFF + tid * 16) = rawv;
        __syncthreads();
        {
            const bf16_t* raw = (const bf16_t*)(lds + H_RAWOFF);
            const int o = w;
#pragma unroll
            for (int k = 0; k < 8; ++k) {
                const int a = lane + 64 * k;
                unsigned short e[8];
#pragma unroll
                for (int j = 0; j < 8; ++j) e[j] = raw[8 * a + o + j];
                u32x4 ov; ov.x = e[0] | ((unsigned)e[1] << 16); ov.y = e[2] | ((unsigned)e[3] << 16); ov.z = e[4] | ((unsigned)e[5] << 16); ov.w = e[6] | ((unsigned)e[7] << 16);
                *(u32x4*)(lds + H_CPOFF + o * H_CPS + a * 16) = ov;
            }
        }
        __syncthreads();
        f32x4 acc[2][4];
#pragma unroll
        for (int ci = 0; ci < 2; ++ci)
#pragma unroll
            for (int mt = 0; mt < 4; ++mt) acc[ci][mt] = (f32x4){0.f, 0.f, 0.f, 0.f};
        {
            const int acp = H_CPOFF + (7 - (fr & 7)) * H_CPS + (255 - (fr >> 3) + fq) * 16;
            const int zb = H_ZOFF + nb * HZ_RS + (HZ_PAD + 8 * fq) * 2;
            for (int dl = 4 * w - 31; dl <= ((ALT && DUPSEL >= 5) ? 4 * w - 31 : 4 * w + 3); ++dl) {
#pragma unroll
                for (int kh = 0; kh < 2; ++kh) {
                    bf16x8 Bf[2];
#pragma unroll
                    for (int ci = 0; ci < 2; ++ci) {
                        const int sblk = 4 * w + 2 * ci + tbp - dl;
                        Bf[ci] = *(const bf16x8*)(lds + zb + (64 * sblk + 32 * kh) * 2);
                    }
#pragma unroll
                    for (int mt = 0; mt < 4; ++mt) {
                        const int q = 4 * dl + mt - 2 * kh;
                        const bf16x8 Af = *(const bf16x8*)(lds + acp - 32 * q);
#pragma unroll
                        for (int ci = 0; ci < 2; ++ci) acc[ci][mt] = __builtin_amdgcn_mfma_f32_16x16x32_bf16(Af, Bf[ci], acc[ci][mt], 0, 0, 0);
                    }
                }
            }
        }
        const float hb = p.in[12][(size_t)(lj * 2 + order) * 512 + c];
        const float w0 = cw[gch], w1 = cw[1536 + gch], w2 = cw[2 * 1536 + gch], bb = cb[gch];
        u32x2 zout[2][4];
#pragma unroll
        for (int ci = 0; ci < 2; ++ci)
#pragma unroll
            for (int mt = 0; mt < 4; ++mt) {
                const int t = 64 * (4 * w + 2 * ci + tbp) + 16 * mt + 4 * fq;
                const u32x2 zz = *(const u32x2*)(lds + H_ZOFF + nb * HZ_RS + (HZ_PAD + t) * 2);
                float u[6];
                u[0] = (t > 0) ? bf2f(gm[ci][mt]) : 0.f; u[5] = (t + 4 < S) ? bf2f(gp[ci][mt]) : 0.f;
                u[1] = bflo(gv[ci][mt].x); u[2] = bfhi(gv[ci][mt].x); u[3] = bflo(gv[ci][mt].y); u[4] = bfhi(gv[ci][mt].y);
                const float z[4] = {bflo(zz.x), bfhi(zz.x), bflo(zz.y), bfhi(zz.y)};
                float o[4];
#pragma unroll
                for (int r = 0; r < 4; ++r) {
                    const float gate = w0 * u[r] + w1 * u[r + 1] + w2 * u[r + 2] + bb;
                    o[r] = gate * (acc[ci][mt][r] + hb * z[r]);
                }
                zout[ci][mt].x = cvt_pk_bf16(o[0], o[1]); zout[ci][mt].y = cvt_pk_bf16(o[2], o[3]);
            }
        __syncthreads();
        if (order == 0) {
#pragma unroll
            for (int ci = 0; ci < 2; ++ci)
#pragma unroll
                for (int mt = 0; mt < 4; ++mt) {
                    const int t = 64 * (4 * w + 2 * ci + tbp) + 16 * mt + 4 * fq;
                    *(u32x2*)(lds + H_ZOFF + nb * HZ_RS + (HZ_PAD + t) * 2) = zout[ci][mt];
                }
        } else {
            bf16_t* yt = (bf16_t*)(p.ws + WS_QX) + (size_t)c * NTOK;
#pragma unroll
            for (int ci = 0; ci < 2; ++ci)
#pragma unroll
                for (int mt = 0; mt < 4; ++mt) {
                    const int t = 64 * (4 * w + 2 * ci + tbp) + 16 * mt + 4 * fq;
                    *(u32x2*)(yt + nb * S + t) = zout[ci][mt];
                }
        }
        __syncthreads();
    }
}

struct Row16 { f32x4 v[4]; };
__device__ __forceinline__ void ld_row(Row16& r, const float* src, int lane) {
#pragma unroll
    for (int i = 0; i < 4; ++i) r.v[i] = *(const f32x4*)(src + 256 * i + 4 * lane);
}
__device__ __forceinline__ void ld_row_bf(Row16& r, const bf16_t* src, int lane) {
#pragma unroll
    for (int i = 0; i < 4; ++i) { const u32x2 v = *(const u32x2*)(src + 256 * i + 4 * lane); r.v[i] = (f32x4){bflo(v.x), bfhi(v.x), bflo(v.y), bfhi(v.y)}; }
}
__device__ __forceinline__ float row_rstd(const Row16& r, int lane) {
    float ss = 0.f;
#pragma unroll
    for (int i = 0; i < 4; ++i) ss += r.v[i][0] * r.v[i][0] + r.v[i][1] * r.v[i][1] + r.v[i][2] * r.v[i][2] + r.v[i][3] * r.v[i][3];
    ss = wave_sum(ss, lane);
    return rsqrtf(ss * (1.0f / 1024.0f) + EPS);
}
template <int KIND  , bool ALT = false>
__device__ __forceinline__ void norm_phase(const Params& p, const int layer, const float* __restrict__ gain, const int bid, const int nb, const int wv) {
    const int tid_ = hidden_tid(wv), lane = tid_ & 63, w = tid_ >> 6;
    bf16_t* XB = (bf16_t*)(p.ws + WS_XB);
    bf16_t* XBo = ALT ? (bf16_t*)(p.ws + WS_PROJ) : XB;
    float* RS1 = (float*)(p.ws + (ALT ? WS_QX : WS_RS1));
    const bf16_t* Y = (const bf16_t*)(p.ws + WS_Y);
    const float* WT = (const float*)(p.ws + WS_WT);
    Row16 g;
    if (KIND == 2) ld_row(g, gain, lane);
    for (int tok = bid * 8 + w; tok < NTOK; tok += nb * 8) {
        Row16 x;
        if (KIND == 0 && layer == 0) ld_row(x, p.in[0] + (size_t)tok * D, lane); else ld_row_bf(x, XB + (size_t)tok * D, lane);
        if ((KIND == 0 && layer > 0) || KIND == 2) {
            const float w0 = WT[2 * tok], w1 = WT[2 * tok + 1];
            const bf16_t* y0 = Y + (size_t)(2 * tok) * D; const bf16_t* y1 = y0 + D;
#pragma unroll
            for (int i = 0; i < 4; ++i) {
                const u32x2 a = *(const u32x2*)(y0 + 256 * i + 4 * lane), b = *(const u32x2*)(y1 + 256 * i + 4 * lane);
                x.v[i][0] += w0 * bflo(a.x) + w1 * bflo(b.x); x.v[i][1] += w0 * bfhi(a.x) + w1 * bfhi(b.x);
                x.v[i][2] += w0 * bflo(a.y) + w1 * bflo(b.y); x.v[i][3] += w0 * bfhi(a.y) + w1 * bfhi(b.y);
            }
        }
        if (KIND == 2) {
            const float rstd = row_rstd(x, lane);
#pragma unroll
            for (int i = 0; i < 4; ++i) *(f32x4*)(p.out + (size_t)tok * D + 256 * i + 4 * lane) = x.v[i] * rstd * g.v[i];
        } else {
#pragma unroll
            for (int i = 0; i < 4; ++i) {
                const unsigned a0 = cvt_pk_bf16(x.v[i][0], x.v[i][1]), a1 = cvt_pk_bf16(x.v[i][2], x.v[i][3]);
                *(u32x2*)(XBo + (size_t)tok * D + 256 * i + 4 * lane) = (u32x2){a0, a1};
                x.v[i] = (f32x4){bflo(a0), bfhi(a0), bflo(a1), bfhi(a1)};
            }
            const float rstd = row_rstd(x, lane);
            if (lane == 0) RS1[tok] = rstd;
        }
    }
}

template <bool ALT>
__device__ __forceinline__ void route_phase(const Params& p, const int layer, const int bid, const int nb, const int wv) {
    const int tid = hidden_tid(wv), lane = tid & 63, w = tid >> 6, fr = lane & 15, fq = lane >> 4;
    float* part = (float*)shm;
    float* ssql = part + 8 * 64 * 49;
    float* lgl = ssql + 8 * 64;
    int* cntl = (int*)((char*)shm + LDS_ROUTE);
    int* basel = cntl + 32;
    int* sel = basel + 32;
    int* posl = sel + 128;
    float* WT = (float*)(p.ws + (ALT ? WS_ACT + (size_t)4 * 1024 * 1024 : WS_WT));
    float* RSTD = (float*)(p.ws + (ALT ? WS_ACT + (size_t)5 * 1024 * 1024 : WS_RSTD));
    int* LIST = (int*)(p.ws + (ALT ? WS_ACT : WS_LIST));
    int* CNT = (int*)(p.ws + WS_CNT) + (layer + (ALT ? 4 : 0)) * NEXP * CNT_STRIDE;
    const float* bg = p.in[26] + layer * 4; const float* be = p.in[28] + layer * NEXP;
    const char* const Xc = (const char*)(p.ws + WS_XB);
    const char* const Whc = (const char*)(p.ws + WS_WRT) + (size_t)layer * 2 * 48 * 1024 * 2; const char* const Wlc = Whc + 48 * 1024 * 2;
    for (int chunk = bid; chunk < NTOK / 64; chunk += nb) {
        __syncthreads();
        if (tid < 32) cntl[tid] = 0;
        const unsigned xoff = (unsigned)(((chunk * 64 + fr) * D + w * 128 + fq * 8) * 2), woff = (unsigned)((fr * 1024 + w * 128 + fq * 8) * 2);
        f32x4 acc[4][3];
#pragma unroll
        for (int mt = 0; mt < 4; ++mt)
#pragma unroll
            for (int nt = 0; nt < 3; ++nt) acc[mt][nt] = (f32x4){0.f, 0.f, 0.f, 0.f};
        float ssq[4] = {0.f, 0.f, 0.f, 0.f};
#pragma unroll 1
        for (int st = 0; st < 4; ++st) {
            u32x4 xa[4]; bf16x8 Bh[3], Bl[3];
#pragma unroll
            for (int mt = 0; mt < 4; ++mt) xa[mt] = *(const u32x4*)(Xc + (xoff + (unsigned)(mt * 16 * D * 2 + st * 64)));
#pragma unroll
            for (int nt = 0; nt < 3; ++nt) { Bh[nt] = *(const bf16x8*)(Whc + (woff + (unsigned)(nt * 16 * 2048 + st * 64))); Bl[nt] = *(const bf16x8*)(Wlc + (woff + (unsigned)(nt * 16 * 2048 + st * 64))); }
#pragma unroll
            for (int mt = 0; mt < 4; ++mt) {
                const u32x4 xb = xa[mt];
                const f32x4 x0 = {bflo(xb.x), bfhi(xb.x), bflo(xb.y), bfhi(xb.y)}, x1 = {bflo(xb.z), bfhi(xb.z), bflo(xb.w), bfhi(xb.w)};
                ssq[mt] += x0[0] * x0[0] + x0[1] * x0[1] + x0[2] * x0[2] + x0[3] * x0[3] + x1[0] * x1[0] + x1[1] * x1[1] + x1[2] * x1[2] + x1[3] * x1[3];
                u32x4 hi; hi.x = cvt_pk_bf16(x0[0], x0[1]); hi.y = cvt_pk_bf16(x0[2], x0[3]); hi.z = cvt_pk_bf16(x1[0], x1[1]); hi.w = cvt_pk_bf16(x1[2], x1[3]);
                u32x4 lo;
                lo.x = cvt_pk_bf16(x0[0] - bflo(hi.x), x0[1] - bfhi(hi.x)); lo.y = cvt_pk_bf16(x0[2] - bflo(hi.y), x0[3] - bfhi(hi.y));
                lo.z = cvt_pk_bf16(x1[0] - bflo(hi.z), x1[1] - bfhi(hi.z)); lo.w = cvt_pk_bf16(x1[2] - bflo(hi.w), x1[3] - bfhi(hi.w));
                const bf16x8 Ah = __builtin_bit_cast(bf16x8, hi), Al = __builtin_bit_cast(bf16x8, lo);
#pragma unroll
                for (int nt = 0; nt < 3; ++nt) {
                    acc[mt][nt] = __builtin_amdgcn_mfma_f32_16x16x32_bf16(Ah, Bh[nt], acc[mt][nt], 0, 0, 0);
                    acc[mt][nt] = __builtin_amdgcn_mfma_f32_16x16x32_bf16(Ah, Bl[nt], acc[mt][nt], 0, 0, 0);
                    acc[mt][nt] = __builtin_amdgcn_mfma_f32_16x16x32_bf16(Al, Bh[nt], acc[mt][nt], 0, 0, 0);
                }
            }
            __builtin_amdgcn_sched_barrier(0);
        }
#pragma unroll
        for (int mt = 0; mt < 4; ++mt) {
            float sq = ssq[mt]; sq += shx(sq, 16, lane); sq += shx(sq, 32, lane);
            if (fq == 0) ssql[w * 64 + mt * 16 + fr] = sq;
#pragma unroll
            for (int nt = 0; nt < 3; ++nt)
#pragma unroll
                for (int r = 0; r < 4; ++r) part[(w * 64 + mt * 16 + fq * 4 + r) * 49 + nt * 16 + fr] = acc[mt][nt][r];
        }
        __syncthreads();
        {
            const int tl = tid & 63;
            for (int j = tid >> 6; j < 36; j += 8) {
                float s = 0.f;
#pragma unroll
                for (int ww = 0; ww < 8; ++ww) s += part[(ww * 64 + tl) * 49 + j];
                lgl[tl * 37 + j] = s;
            }
        }
        __syncthreads();
        if (tid < 64) {
            const int tl = tid, tk = chunk * 64 + tl;
            float sq = 0.f;
#pragma unroll
            for (int ww = 0; ww < 8; ++ww) sq += ssql[ww * 64 + tl];
            const float rstd = rsqrtf(sq * (1.0f / 1024.0f) + EPS);
            float lg[36];
#pragma unroll
            for (int j = 0; j < 36; ++j) lg[j] = lgl[tl * 37 + j] * rstd;
            float g0 = lg[0] + bg[0], g1 = lg[1] + bg[1], g2 = lg[2] + bg[2], g3 = lg[3] + bg[3];
            int gs = 0; float gm = g0;
            if (g1 > gm) { gm = g1; gs = 1; } if (g2 > gm) { gm = g2; gs = 2; } if (g3 > gm) { gm = g3; gs = 3; }
            const float gden = __expf(g0 - gm) + __expf(g1 - gm) + __expf(g2 - gm) + __expf(g3 - gm);
            const float ggate = 1.0f / gden;
            float ev[8];
#pragma unroll
            for (int j = 0; j < 8; ++j) {
                const float a0 = lg[4 + j] + be[j], a1 = lg[12 + j] + be[8 + j], a2 = lg[20 + j] + be[16 + j], a3 = lg[28 + j] + be[24 + j];
                ev[j] = gs == 0 ? a0 : gs == 1 ? a1 : gs == 2 ? a2 : a3;
            }
            int i0 = 0; float v0 = ev[0];
#pragma unroll
            for (int j = 1; j < 8; ++j) if (ev[j] > v0) { v0 = ev[j]; i0 = j; }
            int i1 = -1; float v1 = -3.0e38f;
#pragma unroll
            for (int j = 0; j < 8; ++j) if (j != i0 && ev[j] > v1) { v1 = ev[j]; i1 = j; }
            const float e1 = __expf(v1 - v0), sden = 1.0f / (1.0f + e1);
            const int ea = gs * 8 + i0, eb = gs * 8 + i1;
            sel[2 * tl] = ea; posl[2 * tl] = atomicAdd(&cntl[ea], 1);
            sel[2 * tl + 1] = eb; posl[2 * tl + 1] = atomicAdd(&cntl[eb], 1);
            WT[2 * tk] = ggate * sden; WT[2 * tk + 1] = ggate * e1 * sden;
            RSTD[tk] = rstd;
        }
        __syncthreads();
        if (tid < 32) { const int c = cntl[tid]; basel[tid] = c > 0 ? atomicAdd(&CNT[tid * CNT_STRIDE], c) : 0; }
        __syncthreads();
        if (tid < 128) { const int e = sel[tid]; LIST[(size_t)e * NTOK + basel[e] + posl[tid]] = 128 * chunk + tid; }
    }
}

template <int MODE>
__device__ __forceinline__ void cvt_job(const float* __restrict__ src, bf16_t* __restrict__ dst, const int K, const int N, const int nmat,
                                        const size_t dst_mat_stride, const int bid, const int nb, const int wv, const float* __restrict__ kgain = nullptr, const int gshift = 0) {
    float* T = (float*)shm;
    const int tid = hidden_tid(wv);
    const int tk = K / 64, tn = N / 256, per = tk * tn, total = per * nmat;
    f32x4 v[8];
#define CVT_LOAD(t_) do { const int mat_ = (t_) / per, r_ = (t_) % per, k0_ = (r_ / tn) * 64, n0_ = (r_ % tn) * 256; \
        const float* s_ = src + (size_t)mat_ * K * N + (size_t)k0_ * N + n0_; \
        _Pragma("unroll") for (int i = 0; i < 8; ++i) v[i] = *(const f32x4*)(s_ + (size_t)((tid >> 6) + 8 * i) * N + (tid & 63) * 4); } while (0)
    if (bid < total) CVT_LOAD(bid);
    for (int t = bid; t < total; t += nb) {
        const int mat = t / per, r = t % per, k0 = (r / tn) * 64, n0 = (r % tn) * 256;
        bf16_t* d = dst + (size_t)mat * dst_mat_stride;
        if (kgain) {
#pragma unroll
            for (int i = 0; i < 8; ++i) v[i] *= kgain[(size_t)(mat >> gshift) * D + k0 + (tid >> 6) + 8 * i];
        }
        __syncthreads();
#pragma unroll
        for (int i = 0; i < 8; ++i) {
            float* q = T + ((tid >> 6) + 8 * i) * 257 + (tid & 63) * 4;
            q[0] = v[i][0]; q[1] = v[i][1]; q[2] = v[i][2]; q[3] = v[i][3];
        }
        __syncthreads();
        if (t + nb < total) CVT_LOAD(t + nb);
#pragma unroll
        for (int j = 0; j < 4; ++j) {
            const int n = (tid >> 3) + 64 * j, kc = (tid & 7) * 8;
            float e[8];
#pragma unroll
            for (int jj = 0; jj < 8; ++jj) e[jj] = T[(kc + jj) * 257 + n];
            u32x4 ov; ov.x = cvt_pk_bf16(e[0], e[1]); ov.y = cvt_pk_bf16(e[2], e[3]); ov.z = cvt_pk_bf16(e[4], e[5]); ov.w = cvt_pk_bf16(e[6], e[7]);
            const int ng = n0 + n;
            const int row = (MODE == 0) ? ng : ((ng >> 4) * 32 + (ng & 15) + (MODE == 2 ? 16 : 0));
            *(u32x4*)(d + (size_t)row * K + k0 + kc) = ov;
        }
    }
#undef CVT_LOAD
}

__device__ __forceinline__ void prologue0(const Params& p, const int bid, const int nb, const int wv) {
    unsigned char* ws = p.ws;
    cvt_job<0>(p.in[3], (bf16_t*)(ws + WS_W_EIN), 1024, 3072, 2, (size_t)3072 * 1024, bid, nb, wv, p.in[2]);
    cvt_job<0>(p.in[15], (bf16_t*)(ws + WS_W_EOUT), 1024, 1024, 2, (size_t)1024 * 1024, bid, nb, wv);
    cvt_job<0>(p.in[17], (bf16_t*)(ws + WS_W_OIN), 1024, 1536, 2, (size_t)1536 * 1024, bid, nb, wv, p.in[16]);
    cvt_job<0>(p.in[19], (bf16_t*)(ws + WS_W_OOUT), 1024, 1024, 2, (size_t)1024 * 1024, bid, nb, wv);
    cvt_job<0>(p.in[21], (bf16_t*)(ws + WS_W_CQ), 1024, 512, 4, (size_t)512 * 1024, bid, nb, wv, p.in[20]);
    cvt_job<0>(p.in[22], (bf16_t*)(ws + WS_W_CKV), 1024, 1024, 4, (size_t)1024 * 1024, bid, nb, wv);
    cvt_job<0>(p.in[23], (bf16_t*)(ws + WS_W_CO), 512, 1024, 4, (size_t)1024 * 512, bid, nb, wv);
    cvt_job<1>(p.in[29], (bf16_t*)(ws + WS_W_GU), 1024, 512, 128, (size_t)1024 * 1024, bid, nb, wv, p.in[24], 5);
    cvt_job<2>(p.in[30], (bf16_t*)(ws + WS_W_GU), 1024, 512, 128, (size_t)1024 * 1024, bid, nb, wv, p.in[24], 5);
    cvt_job<0>(p.in[31], (bf16_t*)(ws + WS_W_DN), 512, 1024, 128, (size_t)1024 * 512, bid, nb, wv);
    const int tid = hidden_tid(wv), lane = tid & 63, w = tid >> 6;
    {
        Row16 g; ld_row(g, p.in[32], lane);
        bf16_t* MN = (bf16_t*)(ws + WS_MEMN);
        for (int r = bid * 8 + w; r < Bb * MEM; r += nb * 8) {
            Row16 x; ld_row(x, p.in[1] + (size_t)r * D, lane);
            const float rstd = row_rstd(x, lane);
#pragma unroll
            for (int i = 0; i < 4; ++i) st_bf16x4(MN + (size_t)r * D + 256 * i + 4 * lane, x.v[i] * rstd * g.v[i]);
        }
    }
    {
        float* A2 = (float*)(ws + WS_A2);
        for (int r = bid * 8 + w; r < 2 * S; r += nb * 8) {
            const int lj = r / S, pos = r % S;
            const float* w1 = p.in[6] + (size_t)lj * 33 * 64; const float* b1 = p.in[7] + lj * 64;
            const float* w2 = p.in[8] + (size_t)lj * 64 * 64; const float* b2 = p.in[9] + lj * 64;
            const float fr_ = p.in[11][lj * 64 + lane];
            float a = ((float)pos / 2047.0f) * w1[lane];
#pragma unroll 1
            for (int k = 0; k < 16; ++k) {
                const float band = 1e-4f + (float)k * ((15.0f - 1e-4f) / 15.0f);
                const float ang = band * (6.283185307179586f * (float)pos / 2048.0f);
                a += cosf(ang) * w1[(1 + k) * 64 + lane] - sinf(ang) * w1[(17 + k) * 64 + lane];
            }
            const float a1 = sinf(fr_ * (a + b1[lane]));
            float a2 = 0.f;
#pragma unroll 1
            for (int i = 0; i < 64; ++i) a2 += shl(a1, i) * w2[i * 64 + lane];
            A2[(size_t)r * 64 + lane] = sinf(fr_ * (a2 + b2[lane]));
        }
    }
    {
        bf16_t* WR = (bf16_t*)(ws + WS_WRT);
        for (int i = bid * NT + tid; i < 4 * 48 * 1024; i += nb * NT) {
            const int l = i / (48 * 1024), r = i % (48 * 1024), j = r >> 10, k = r & 1023;
            float v = 0.f;
            if (j < 4) v = p.in[25][((size_t)l * D + k) * 4 + j]; else if (j < 36) v = p.in[27][((size_t)l * D + k) * NEXP + (j - 4)];
            v *= p.in[24][(size_t)l * D + k];
            const unsigned h = cvt_pk_bf16(v, 0.f) & 0xffffu;
            const unsigned lo = cvt_pk_bf16(v - bflo(h), 0.f) & 0xffffu;
            WR[(size_t)l * 2 * 48 * 1024 + r] = (bf16_t)h; WR[(size_t)l * 2 * 48 * 1024 + 48 * 1024 + r] = (bf16_t)lo;
        }
    }
    if (bid == 0) {
        if (tid < 2) {
            const float* lm = p.in[13] + (size_t)tid * 4 * 64;
            float s01 = 0.f, s23 = 0.f;
            for (int i = 0; i < 64; ++i) { s01 += lm[i] * lm[64 + i]; s23 += lm[128 + i] * lm[192 + i]; }
            const float lam_init = 0.8f - 0.6f * expf(-0.3f * (float)(2 * tid));
            ((float*)(ws + WS_MISC))[tid] = expf(s01) - expf(s23) + lam_init;
            ((float*)(ws + WS_MISC))[2 + tid] = 1.0f - lam_init;
        }
        bf16_t* hz = (bf16_t*)(ws + WS_XB) + (size_t)NTOK * D; bf16_t* az = (bf16_t*)(ws + WS_ACT) + (size_t)2 * NTOK * EH;
        for (int i = tid; i < D; i += NT) hz[i] = 0;
        for (int i = tid; i < EH; i += NT) az[i] = 0;
    }
}

__device__ __forceinline__ void filter_taps(const Params& p, const int bid, const int nb, const int wv) {
    const int tid = hidden_tid(wv), w = tid >> 6, lane = tid & 63, fr = lane & 15, fq = lane >> 4;
    const float* A2 = (const float*)(p.ws + WS_A2);
    bf16_t* FL = (bf16_t*)(p.ws + WS_FILT);
    const float mind = logf(1e-2f) / 1.5f, maxd = logf(1e-2f) / 0.3f;
    for (int job = bid; job < 2 * 4 * 8 * 32; job += nb) {
        const int pt = job & 31, ct = (job >> 5) & 7, od = (job >> 8) & 3, lj = job >> 10;
        const int pos0 = pt * 64 + (w >> 2) * 32, ch0 = ct * 64 + (w & 3) * 16, order = od >> 1, dir = od & 1;
        const float* w3 = p.in[10] + (size_t)lj * 64 * 2048 + od * 512 + ch0 + fr;
        bf16x8 Af[2], Bf[2][2];
#pragma unroll
        for (int ks = 0; ks < 2; ++ks) {
            float e[8];
#pragma unroll
            for (int jj = 0; jj < 8; ++jj) e[jj] = w3[(size_t)(ks * 32 + fq * 8 + jj) * 2048];
            u32x4 pk; pk.x = cvt_pk_bf16(e[0], e[1]); pk.y = cvt_pk_bf16(e[2], e[3]); pk.z = cvt_pk_bf16(e[4], e[5]); pk.w = cvt_pk_bf16(e[6], e[7]);
            Af[ks] = __builtin_bit_cast(bf16x8, pk);
#pragma unroll
            for (int nt = 0; nt < 2; ++nt) {
                const float* ap = A2 + ((size_t)lj * S + pos0 + nt * 16 + fr) * 64 + ks * 32 + fq * 8;
                const f32x4 v0 = *(const f32x4*)ap, v1 = *(const f32x4*)(ap + 4);
                u32x4 pb; pb.x = cvt_pk_bf16(v0[0], v0[1]); pb.y = cvt_pk_bf16(v0[2], v0[3]); pb.z = cvt_pk_bf16(v1[0], v1[1]); pb.w = cvt_pk_bf16(v1[2], v1[3]);
                Bf[nt][ks] = __builtin_bit_cast(bf16x8, pb);
            }
        }
#pragma unroll
        for (int nt = 0; nt < 2; ++nt) {
            f32x4 acc = {0.f, 0.f, 0.f, 0.f};
            acc = __builtin_amdgcn_mfma_f32_16x16x32_bf16(Af[0], Bf[nt][0], acc, 0, 0, 0);
            acc = __builtin_amdgcn_mfma_f32_16x16x32_bf16(Af[1], Bf[nt][1], acc, 0, 0, 0);
            const int pos = pos0 + nt * 16 + fr;
            const float tpos = (float)pos / 2047.0f;
#pragma unroll
            for (int r = 0; r < 4; ++r) {
                const int ch = ch0 + fq * 4 + r;
                const float delta = mind + (float)ch * ((maxd - mind) / 511.0f);
                const float v = acc[r] * __builtin_amdgcn_exp2f(-tpos * fabsf(delta) * 1.4426950408889634f);
                bf16_t* f = FL + ((size_t)(lj * 2 + order) * 512 + ch) * 4096;
                const unsigned short hv = (unsigned short)(cvt_pk_bf16(v, 0.f) & 0xffff);
                if (dir == 0) f[2047 - pos] = hv;
                else { if (pos >= 1) f[2047 + pos] = hv; if (pos == 2047) f[4095] = 0; }
            }
        }
    }
}

enum { PH_P0 = 0, PH_P1, PH_N1, PH_GIN, PH_MIX, PH_GOUT, PH_N2, PH_GQ, PH_XATT, PH_GO, PH_ROUTE, PH_G1, PH_G2, PH_FINAL, PH_TR, PH_COUNT };

template <class Epi>
__device__ __forceinline__ void gemm_dense(const bf16_t* A, const bf16_t* Bt, const int K, const int nM, const int nN, Epi epi, const int bid, const int nb, const int wv) {
    for (int u = bid; u < nM * nN; u += nb) {
        const int pm = u / nN, pn = u % nN;
        epi.brow = pm * 256;
        gemm_tile(A + (size_t)pm * 256 * K, Bt, K, pn * 256, RowIdent{}, epi, wv);
    }
}

typedef const __attribute__((address_space(4))) Params* ParamsK;
#define PHASE_FN __forceinline__
template <int PH, bool ALT = false>
__device__ PHASE_FN void run_phase(ParamsK pk_, const int layer, const int bid_, const int nb_, const int wv_) {
    ParamsK pk = pk_; asm volatile("" : "+s"(pk));
    int bid = bid_, nb = nb_, wv = wv_; asm volatile("" : "+s"(bid), "+s"(nb), "+s"(wv));
    const Params& p = *(const Params*)pk;
    unsigned char* ws = p.ws;
    const int lj = layer >> 1; const bool even = (layer & 1) == 0;
    bf16_t* H = (bf16_t*)(ws + WS_H);
    float* X = (float*)(ws + WS_X);
    bf16_t* YMIX = (bf16_t*)(ws + WS_YMIX);
    bf16_t* QX = (bf16_t*)(ws + WS_QX);
    bf16_t* OX = (bf16_t*)(ws + WS_OX);
    if constexpr (PH == PH_P0) { prologue0(p, bid, nb, wv); }
    if constexpr (PH == PH_N1) {
        norm_phase<0, ALT>(p, layer, nullptr, bid, nb, wv);
        if (layer == 0 && !ALT) filter_taps(p, bid, nb, wv);
    }
    if constexpr (PH == PH_GIN) {
        const bf16_t* XBc = (const bf16_t*)(ws + WS_XB); const float* RS1 = (const float*)(ws + WS_RS1);
        if (even) {
            EpiSplit e{(bf16_t*)(ws + WS_PROJ + PR_HYT), (bf16_t*)(ws + WS_PROJ + PR_QK), (bf16_t*)(ws + WS_PROJ + PR_VT), 1536, 2560, 1024, (size_t)NTOK, 0, RS1};
            gemm_dense(XBc, (const bf16_t*)(ws + WS_W_EIN) + (size_t)lj * 3072 * 1024, 1024, 64, 12, e, bid, nb, wv);
        } else {
            EpiSplit e{nullptr, (bf16_t*)(ws + WS_PROJ), (bf16_t*)(ws + WS_PROJ + PR_OVT), 0, 1280, 1280, (size_t)NTOK, 0, RS1};
            gemm_dense(XBc, (const bf16_t*)(ws + WS_W_OIN) + (size_t)lj * 1536 * 1024, 1024, 64, 6, e, bid, nb, wv);
        }
    }
    if constexpr (PH == PH_MIX) {
        if (even) {
            const bf16_t* qk = (const bf16_t*)(ws + WS_PROJ + PR_QK);
            const bf16_t* vT = (const bf16_t*)(ws + WS_PROJ + PR_VT);
            const float lam = uni(((const float*)(ws + WS_MISC))[lj]);
            const float oscale = uni(((const float*)(ws + WS_MISC))[2 + lj]);
            for (int u = bid + ((ALT && (DUPSEL == 4 || DUPSEL >= 7)) ? 512 : 0); u < ((ALT && (DUPSEL == 3 || DUPSEL == 5 || DUPSEL == 6)) ? 512 : 1024); u += nb) {
                if (u < 512) hyena_unit<ALT>(p, lj, u, wv);
                else {
                    const int id = u - 512, b = id >> 6, h = (id >> 4) & 3, qb = id & 15;
                    attn_unit<0, ALT>(qk + (size_t)(b * S) * 1024 + 2 * h * 64, 1024, qk + (size_t)(b * S) * 1024 + 512 + 2 * h * 64, 1024,
                                 vT + (size_t)(h * 128) * NTOK + b * S, (size_t)NTOK, qb * 128, 0, S,
                                 0.125f, uni(exp2f(-2.0f * (float)(h + 1))), -1e30f, 0.f,
                                 (ALT ? (bf16_t*)(ws + WS_Y) : YMIX) + (size_t)(b * S) * D + 512 + h * 128, D, lam, oscale, p.in[14] + (size_t)lj * 128, wv);
                }
            }
        } else {
            const bf16_t* qk = (const bf16_t*)(ws + WS_PROJ);
            const bf16_t* vT = (const bf16_t*)(ws + WS_PROJ + PR_OVT);
            for (int u = bid; u < 2048; u += nb) {
                const int b = u >> 8, hq = (u >> 4) & 15, qb = u & 15, kv = hq >> 2, q0 = qb * 128;
                const int kbeg = q0 - 128 < 0 ? 0 : q0 - 128, kend = q0 + 256 > S ? S : q0 + 256;
                attn_unit<1>(qk + (size_t)(b * S) * 1280 + hq * 64, 1280, qk + (size_t)(b * S) * 1280 + 1024 + kv * 64, 1280,
                             vT + (size_t)(kv * 64) * NTOK + b * S, (size_t)NTOK, q0, kbeg, kend,
                             0.125f, uni(exp2f(-0.5f * (float)(hq + 1))), uni(p.in[18][lj * 16 + hq]), 1.0f,
                             YMIX + (size_t)(b * S) * D + hq * 64, D, 0.f, 1.f, nullptr, wv);
            }
        }
    }
    if constexpr (PH == PH_TR) {
        const int tid = hidden_tid(wv);
        const bf16_t* yt = (const bf16_t*)(ws + WS_QX);
        bf16_t* T = shm;
        for (int t = bid; t < 8 * 256; t += nb) {
            const int c0 = (t & 7) * 64, tk0 = (t >> 3) * 64;
            const u32x4 v = *(const u32x4*)(yt + (size_t)(c0 + (tid >> 3)) * NTOK + tk0 + (tid & 7) * 8);
            __syncthreads();
            *(u32x4*)((char*)T + (tid >> 3) * 144 + (tid & 7) * 16) = v;
            __syncthreads();
            const int tok = tid >> 3, cg = (tid & 7) * 8;
            unsigned short e[8];
#pragma unroll
            for (int j = 0; j < 8; ++j) e[j] = T[(cg + j) * 72 + tok];
            u32x4 ov; ov.x = e[0] | ((unsigned)e[1] << 16); ov.y = e[2] | ((unsigned)e[3] << 16); ov.z = e[4] | ((unsigned)e[5] << 16); ov.w = e[6] | ((unsigned)e[7] << 16);
            *(u32x4*)(YMIX + (size_t)(tk0 + tok) * D + c0 + cg) = ov;
        }
    }
    if constexpr (PH == PH_GOUT) {
        EpiRes e{(bf16_t*)(ws + (ALT ? WS_Y : WS_XB)), 0, (float*)(ws + WS_SSP), hidden_tid(wv) & 63};
        gemm_dense(YMIX, (const bf16_t*)(ws + (even ? WS_W_EOUT : WS_W_OOUT)) + (size_t)lj * 1024 * 1024, 1024, 64, 4, e, bid, nb, wv);
    }
    if constexpr (PH == PH_GQ) {
        for (int u = bid; u < 128 + 32; u += nb) {
            if (u < 128) {
                const int pm = u >> 1, pn = u & 1;
                EpiTokRstd e{QX, 512, pm * 256, (const float*)(ws + WS_SSP)};
                gemm_tile((const bf16_t*)(ws + WS_XB) + (size_t)pm * 256 * 1024, (const bf16_t*)(ws + WS_W_CQ) + (size_t)layer * 512 * 1024, 1024, pn * 256, RowIdent{}, e, wv);
            } else {
                const int v = u - 128, pm = v >> 2, pn = v & 3;
                EpiSplit e{nullptr, (bf16_t*)(ws + WS_XK) + (size_t)layer * 2048 * 512, (bf16_t*)(ws + WS_XVT) + (size_t)layer * 512 * 2048, 0, 512, 512, (size_t)2048, pm * 256, nullptr};
                gemm_tile((const bf16_t*)(ws + WS_MEMN) + (size_t)pm * 256 * 1024, (const bf16_t*)(ws + WS_W_CKV) + (size_t)layer * 1024 * 1024, 1024, pn * 256, RowIdent{}, e, wv);
            }
        }
    }
    if constexpr (PH == PH_XATT) {
        const bf16_t* xk = (const bf16_t*)(ws + WS_XK) + (size_t)layer * 2048 * 512;
        const bf16_t* xvt = (const bf16_t*)(ws + WS_XVT) + (size_t)layer * 512 * 2048;
        for (int u = bid; u < 512; u += nb) {
            const int b = u >> 6, h = (u >> 4) & 3, qb = u & 15;
            attn_unit<2>(QX + (size_t)(b * S) * 512 + h * 128, 512, xk + (size_t)(b * MEM) * 512 + h * 128, 512,
                         xvt + (size_t)(h * 128) * 2048 + b * MEM, (size_t)2048, qb * 128, 0, MEM,
                         0.08838834764831845f, 0.f, -1e30f, 0.f, OX + (size_t)(b * S) * 512 + h * 128, 512, 0.f, 1.f, nullptr, wv);
        }
    }
    if constexpr (PH == PH_GO) {
        EpiRes e{(bf16_t*)(ws + (ALT ? WS_Y : WS_XB)), 0, nullptr, hidden_tid(wv) & 63};
        gemm_dense(OX, (const bf16_t*)(ws + WS_W_CO) + (size_t)layer * 1024 * 512, 512, 64, 4, e, bid, nb, wv);
    }
    if constexpr (PH == PH_ROUTE) { route_phase<ALT>(p, layer, bid, nb, wv); }
    if constexpr (PH == PH_G1) {
        const int* CNT = (const int*)(ws + WS_CNT) + layer * NEXP * CNT_STRIDE;
        const int* LIST = (const int*)(ws + WS_LIST);
        unsigned* head = (unsigned*)(ws + WS_QHEAD) + layer * 64;
        unsigned* done = (unsigned*)(ws + WS_DONE) + layer * 32 * 64;
        int* uq = (int*)((char*)shm + LDS_ROUTE + 1024);
        const int tid = hidden_tid(wv);
        int total = 0;
        for (int e = 0; e < NEXP; ++e) total += (CNT[e * CNT_STRIDE] + 255) >> 8;
        total = __builtin_amdgcn_readfirstlane(total) * 4;
        for (;;) {
            __syncthreads();
            if (tid == 0) *uq = (int)__hip_atomic_fetch_add(head, 1u, __ATOMIC_RELAXED, __HIP_MEMORY_SCOPE_AGENT);
            __syncthreads();
            const int uall = __builtin_amdgcn_readfirstlane(*uq);
            if (uall >= 2 * total) break;
            const bool second = uall >= total;
            const int u = second ? uall - total : uall;
            int e = 0, base = 0, tl = 0, cnt = 0;
            for (; e < NEXP; ++e) { cnt = __builtin_amdgcn_readfirstlane(CNT[e * CNT_STRIDE]); tl = (cnt + 255) >> 8; if (u < base + tl * 4) break; base += tl * 4; }
            const int r = u - base, pn = r / tl, pm = r % tl;
            const int* list = LIST + (size_t)e * NTOK;
            if (!second) {
                EpiGateUp ep{(bf16_t*)(ws + WS_ACT), list, cnt, pm * 256, (const float*)(ws + WS_RSTD)};
                gemm_tile((const bf16_t*)(ws + WS_XB), (const bf16_t*)(ws + WS_W_GU) + ((size_t)layer * NEXP + e) * 1024 * 1024, 1024, pn * 256, RowTok{list, cnt, pm * 256}, ep, wv);
                asm volatile("s_waitcnt vmcnt(0)" ::: "memory");
                if ((hidden_tid(wv) & 63) == 0) (void)__hip_atomic_fetch_add(done + e * 64 + pm, 1u, __ATOMIC_RELAXED, __HIP_MEMORY_SCOPE_AGENT);
            } else {
                if (tid < 64) {
                    unsigned spins = 0;
                    while ((unsigned)__builtin_amdgcn_readfirstlane(__hip_atomic_load(done + e * 64 + pm, __ATOMIC_RELAXED, __HIP_MEMORY_SCOPE_AGENT)) < 32u) {
                        __builtin_amdgcn_s_sleep(2);
                        if (++spins > (1u << 24)) break;
                    }
                    __builtin_amdgcn_fence(__ATOMIC_ACQUIRE, "agent");
                    asm volatile("s_waitcnt vmcnt(0)" ::: "memory");
                }
                __syncthreads();
                EpiDown ep{(bf16_t*)(ws + WS_Y), list, cnt, pm * 256};
                gemm_tile((const bf16_t*)(ws + WS_ACT), (const bf16_t*)(ws + WS_W_DN) + ((size_t)layer * NEXP + e) * 1024 * 512, 512, pn * 256, RowAsg{list, cnt, pm * 256}, ep, wv);
            }
        }
    }
    if constexpr (PH == PH_FINAL) { norm_phase<2>(p, DEPTH, p.in[33], bid, nb, wv); }
}

#if ONE_LAUNCH
__global__ void __launch_bounds__(NT, 2) k_mega(Params p_) {
    ParamsK p = (ParamsK)__builtin_amdgcn_kernarg_segment_ptr();
    volatile LAS unsigned* st = (volatile LAS unsigned*)((char*)shm + LDS_XB);
    if (threadIdx.x < 4) st[threadIdx.x] = 0u;
    __syncthreads();
    const XcdBarrier bar = xcd_barrier_post((unsigned*)(p->ws + WS_BAR), st);
    const int bid = blockIdx.x, nb = gridDim.x, wv = __builtin_amdgcn_readfirstlane(threadIdx.x >> 6);
    run_phase<PH_P0>(p, 0, bid, nb, wv); xcd_barrier(bar); if (DUP == PH_P0) { run_phase<PH_P0, true>(p, 0, bid, nb, wv); xcd_barrier(bar); }
#pragma unroll 1
    for (int layer = 0; layer < DEPTH; ++layer) {
        run_phase<PH_N1>(p, layer, bid, nb, wv); xcd_barrier(bar); if (DUP == PH_N1) { run_phase<PH_N1, true>(p, layer, bid, nb, wv); xcd_barrier(bar); }
        run_phase<PH_GIN>(p, layer, bid, nb, wv); xcd_barrier(bar); if (DUP == PH_GIN) { run_phase<PH_GIN, true>(p, layer, bid, nb, wv); xcd_barrier(bar); }
        run_phase<PH_MIX>(p, layer, bid, nb, wv); xcd_barrier(bar); if (DUP == PH_MIX && (DUPSEL == 0 || (DUPSEL != 2 && (layer & 1) == 0) || (DUPSEL == 2 && (layer & 1) == 1))) { run_phase<PH_MIX, true>(p, layer, bid, nb, wv); xcd_barrier(bar); }
        if ((layer & 1) == 0) { run_phase<PH_TR>(p, layer, bid, nb, wv); xcd_barrier(bar); }
        run_phase<PH_GOUT>(p, layer, bid, nb, wv); xcd_barrier(bar); if (DUP == PH_GOUT) { run_phase<PH_GOUT, true>(p, layer, bid, nb, wv); xcd_barrier(bar); }
        run_phase<PH_GQ>(p, layer, bid, nb, wv); xcd_barrier(bar); if (DUP == PH_GQ) { run_phase<PH_GQ, true>(p, layer, bid, nb, wv); xcd_barrier(bar); }
        run_phase<PH_XATT>(p, layer, bid, nb, wv); xcd_barrier(bar); if (DUP == PH_XATT) { run_phase<PH_XATT, true>(p, layer, bid, nb, wv); xcd_barrier(bar); }
        run_phase<PH_GO>(p, layer, bid, nb, wv); xcd_barrier(bar); if (DUP == PH_GO) { run_phase<PH_GO, true>(p, layer, bid, nb, wv); xcd_barrier(bar); }
        run_phase<PH_ROUTE>(p, layer, bid, nb, wv); xcd_barrier(bar); if (DUP == PH_ROUTE) { run_phase<PH_ROUTE, true>(p, layer, bid, nb, wv); xcd_barrier(bar); }
        run_phase<PH_G1>(p, layer, bid, nb, wv); xcd_barrier(bar); if (DUP == PH_G1) { run_phase<PH_G1, true>(p, layer, bid, nb, wv); xcd_barrier(bar); }
    }
    run_phase<PH_FINAL>(p, DEPTH, bid, nb, wv);
}
#else
template <int PH>
__global__ void __launch_bounds__(NT, 2) k_phase(Params p_, int layer) {
    run_phase<PH>((ParamsK)__builtin_amdgcn_kernarg_segment_ptr(), layer, blockIdx.x, gridDim.x, __builtin_amdgcn_readfirstlane(threadIdx.x >> 6));
}
template <int PH> static void launch_phase(const Params& p, int layer, int grid, hipStream_t stream) {
    static bool init = false;
    if (!init) { (void)hipFuncSetAttribute((const void*)k_phase<PH>, hipFuncAttributeMaxDynamicSharedMemorySize, LDS_BYTES); init = true; }
    hipLaunchKernelGGL(k_phase<PH>, dim3(grid), dim3(NT), LDS_BYTES, stream, p, layer);
}
#endif

extern "C" void kernel_launch(void* const* d_in, const int* in_sizes, int n_in, void* d_out, int out_size, void* d_ws, size_t ws_size, hipStream_t stream) {
    if (n_in != 34 || ws_size < WS_END) { fprintf(stderr, "kernel_launch: unexpected n_in %d or ws_size %zu (need %zu)\n", n_in, ws_size, (size_t)WS_END); return; }
    Params p{};
    for (int i = 0; i < 34; ++i) p.in[i] = (const float*)d_in[i];
    p.out = (float*)d_out; p.ws = (unsigned char*)d_ws;
    (void)hipMemsetAsync(d_ws, 0, WS_ZERO_BYTES, stream);
#if ONE_LAUNCH
    static int grid = 0;
    if (grid == 0) {
        int dev = 0, cus = 0, per_cu = 0;
        (void)hipGetDevice(&dev); (void)hipDeviceGetAttribute(&cus, hipDeviceAttributeMultiprocessorCount, dev);
        (void)hipFuncSetAttribute((const void*)k_mega, hipFuncAttributeMaxDynamicSharedMemorySize, LDS_BYTES);
        (void)hipOccupancyMaxActiveBlocksPerMultiprocessor(&per_cu, (const void*)k_mega, NT, LDS_BYTES);
        (void)hipGetLastError();
        grid = cus > 0 ? cus : 256;
    }
    hipLaunchKernelGGL(k_mega, dim3(grid), dim3(NT), LDS_BYTES, stream, p);
#else
    const int grid = 256;
    launch_phase<PH_P0>(p, 0, grid, stream);
    for (int layer = 0; layer < DEPTH; ++layer) {
        launch_phase<PH_N1>(p, layer, grid, stream);
        launch_phase<PH_GIN>(p, layer, grid, stream);
        launch_phase<PH_MIX>(p, layer, grid, stream);
        if ((layer & 1) == 0) launch_phase<PH_TR>(p, layer, grid, stream);
        launch_phase<PH_GOUT>(p, layer, grid, stream);
        launch_phase<PH_GQ>(p, layer, grid, stream);
        launch_phase<PH_XATT>(p, layer, grid, stream);
        launch_phase<PH_GO>(p, layer, grid, stream);
        launch_phase<PH_ROUTE>(p, layer, grid, stream);
        launch_phase<PH_G1>(p, layer, grid, stream);
    }
    launch_phase<PH_FINAL>(p, DEPTH, grid, stream);
#endif
}
```

```cpp
#include <hip/hip_runtime.h>
#include <stdint.h>
#include <stdio.h>

#ifndef RD_N
#define RD_N 1
#endif
#ifndef RD_E
#define RD_E 1
#endif
#ifndef RD_R
#define RD_R 1
#endif
#ifndef DUP
#define DUP -1
#endif
#ifndef DUPSEL
#define DUPSEL 0
#endif
#ifndef ONE_LAUNCH
#define ONE_LAUNCH 1
#endif

typedef unsigned short bf16_t;
typedef short bf16x8 __attribute__((ext_vector_type(8)));
typedef float f32x4 __attribute__((ext_vector_type(4)));
typedef unsigned u32x4 __attribute__((ext_vector_type(4)));
typedef unsigned u32x2 __attribute__((ext_vector_type(2)));

constexpr int Bb = 8, S = 2048, D = 1024, NTOK = Bb * S, DEPTH = 4, MEM = 256;
constexpr int NEXP = 32, EH = 512;
constexpr int NT = 512;
constexpr float EPS = 1e-6f;

constexpr size_t al256(size_t x) { return (x + 255) & ~(size_t)255; }
constexpr size_t WS_BAR   = 0;
constexpr size_t WS_CNT   = 16384;
constexpr int    CNT_STRIDE = 64;
constexpr size_t WS_QHEAD = 16384 + 65536;
constexpr size_t WS_DONE  = WS_QHEAD + 4096;
constexpr size_t WS_ZERO_BYTES = WS_DONE + (size_t)4 * 32 * 64 * 4;
constexpr size_t WS_MISC  = WS_ZERO_BYTES;
constexpr size_t WS_W_EIN = 131072;
constexpr size_t WS_W_EOUT = WS_W_EIN + (size_t)2 * 3072 * 1024 * 2;
constexpr size_t WS_W_OIN = WS_W_EOUT + (size_t)2 * 1024 * 1024 * 2;
constexpr size_t WS_W_OOUT = WS_W_OIN + (size_t)2 * 1536 * 1024 * 2;
constexpr size_t WS_W_CQ  = WS_W_OOUT + (size_t)2 * 1024 * 1024 * 2;
constexpr size_t WS_W_CKV = WS_W_CQ + (size_t)4 * 512 * 1024 * 2;
constexpr size_t WS_W_CO  = WS_W_CKV + (size_t)4 * 1024 * 1024 * 2;
constexpr size_t WS_W_GU  = WS_W_CO + (size_t)4 * 1024 * 512 * 2;
constexpr size_t WS_W_DN  = WS_W_GU + (size_t)4 * 32 * 1024 * 1024 * 2;
constexpr size_t WS_MEMN  = WS_W_DN + (size_t)4 * 32 * 1024 * 512 * 2;
constexpr size_t WS_XK    = WS_MEMN + (size_t)2048 * 1024 * 2;
constexpr size_t WS_XVT   = WS_XK + (size_t)4 * 2048 * 512 * 2;
constexpr size_t WS_A2    = WS_XVT + (size_t)4 * 2048 * 512 * 2;
constexpr size_t WS_FILT  = WS_A2 + (size_t)2 * 2048 * 64 * 4;
constexpr size_t WS_X     = WS_FILT + (size_t)2 * 2 * 512 * 4096 * 2;
constexpr size_t WS_H     = WS_X + (size_t)NTOK * D * 4;
constexpr size_t WS_PROJ  = WS_H + al256((size_t)(NTOK + 1) * D * 2);
constexpr size_t WS_YMIX  = WS_PROJ + (size_t)NTOK * 3072 * 2;
constexpr size_t WS_QX    = WS_YMIX + (size_t)NTOK * D * 2;
constexpr size_t WS_OX    = WS_QX + (size_t)NTOK * 512 * 2;
constexpr size_t WS_ACT   = WS_OX + (size_t)NTOK * 512 * 2;
constexpr size_t WS_Y     = WS_ACT + al256((size_t)(2 * NTOK + 1) * EH * 2);
constexpr size_t WS_LIST  = WS_Y + (size_t)2 * NTOK * D * 2;
constexpr size_t WS_WT    = WS_LIST + (size_t)NEXP * NTOK * 4;
constexpr size_t WS_RSTD  = WS_WT + (size_t)2 * NTOK * 4;
constexpr size_t WS_WRT   = WS_RSTD + (size_t)NTOK * 4;
constexpr size_t WS_XB    = WS_WRT + (size_t)4 * 2 * 48 * 1024 * 2;
constexpr size_t WS_SSP   = WS_XB + al256((size_t)(NTOK + 1) * D * 2);
constexpr size_t WS_RS1   = WS_SSP + (size_t)NTOK * 16 * 4;
constexpr size_t WS_RP    = WS_RS1 + (size_t)NTOK * 4;
constexpr size_t WS_END   = WS_RP + (size_t)NEXP * NTOK * 4;
constexpr size_t PR_HYT   = 0;
constexpr size_t PR_QK    = (size_t)1536 * NTOK * 2;
constexpr size_t PR_VT    = PR_QK + (size_t)NTOK * 1024 * 2;
constexpr size_t PR_OVT   = (size_t)NTOK * 1280 * 2;

constexpr int LDS_XB = 147456;
constexpr int LDS_ROUTE = LDS_XB + 64;
constexpr int LDS_BYTES = LDS_ROUTE + 2048;

struct Params {
    const float* in[34];
    float* out;
    unsigned char* ws;
};

extern __shared__ __attribute__((aligned(16))) bf16_t shm[];

typedef float f32x2 __attribute__((ext_vector_type(2)));
typedef __bf16 bf16x2v __attribute__((ext_vector_type(2)));
__device__ __forceinline__ unsigned cvt_pk_bf16(float lo, float hi) { const f32x2 v = {lo, hi}; return __builtin_bit_cast(unsigned, __builtin_convertvector(v, bf16x2v)); }
__device__ __forceinline__ float bf2f(unsigned short b) { return __uint_as_float((unsigned)b << 16); }
__device__ __forceinline__ float bflo(unsigned w) { return __uint_as_float(w << 16); }
__device__ __forceinline__ float bfhi(unsigned w) { return __uint_as_float(w & 0xffff0000u); }
__device__ __forceinline__ float shx(float v, int m, int lane) { return __int_as_float(__builtin_amdgcn_ds_bpermute((lane ^ m) << 2, __float_as_int(v))); }
__device__ __forceinline__ float shl(float v, int src) { return __int_as_float(__builtin_amdgcn_ds_bpermute(src << 2, __float_as_int(v))); }
__device__ __forceinline__ float wave_sum(float v, int lane) {
    v += shx(v, 1, lane); v += shx(v, 2, lane); v += shx(v, 4, lane); v += shx(v, 8, lane); v += shx(v, 16, lane); v += shx(v, 32, lane); return v;
}

__device__ __forceinline__ float uni(float x) { return __builtin_bit_cast(float, __builtin_amdgcn_readfirstlane(__builtin_bit_cast(int, x))); }
__device__ __forceinline__ int hidden_tid(int wv) { int l; asm volatile("v_mbcnt_lo_u32_b32 %0, -1, 0\n\tv_mbcnt_hi_u32_b32 %0, -1, %0" : "=&v"(l)); return (wv << 6) | l; }

#define XB_TMO      128
#define XB_XCNT(j)  (256  + 64 * (j))
#define XB_XSUB(j)  (1280 + 64 * (j))
#define XB_XGEN(j)  (2304 + 64 * (j))
#define XB_TOP      3328
#define XB_TOPGEN   3392
#define XCD_BAR_WORDS 3456
#define XB_SPIN_CAP (1u << 22)
#define LAS __attribute__((address_space(3)))

__device__ __forceinline__ unsigned xb_ld(unsigned* p)              { return __hip_atomic_load(p, __ATOMIC_RELAXED, __HIP_MEMORY_SCOPE_AGENT); }
__device__ __forceinline__ unsigned xb_add(unsigned* p, unsigned v) { return __hip_atomic_fetch_add(p, v, __ATOMIC_RELAXED, __HIP_MEMORY_SCOPE_AGENT); }
__device__ __forceinline__ unsigned xb_xcc_id() { return (unsigned)__builtin_amdgcn_s_getreg((3 << 11) | 20) & 0xFu; }
#define XB_SPIN(cond, bar) do { unsigned _sp = 0; while (cond) { __builtin_amdgcn_s_sleep(1); \
    if ((++_sp & 255u) == 0u) { if (xb_ld(&(bar)[XB_TMO])) break; if (_sp > XB_SPIN_CAP) { atomicAdd(&(bar)[XB_TMO], 1u); break; } } } } while (0)

struct XcdBarrier { unsigned* bar; unsigned x; volatile LAS unsigned* st; };

__device__ __forceinline__ XcdBarrier xcd_barrier_post(unsigned* bar, volatile LAS unsigned* st) {
    XcdBarrier b; b.bar = bar; b.x = xb_xcc_id(); b.st = st;
    if (threadIdx.x == 0) (void)xb_add(&bar[XB_XCNT(b.x)], 1u);
    return b;
}
__device__ __forceinline__ void xcd_barrier_complete(unsigned* bar, unsigned x, unsigned& nloc, unsigned& nx) {
    const unsigned G = gridDim.x * gridDim.y * gridDim.z;
    unsigned sum, cnt, mine, sp = 0u;
    for (;;) {
        sum = 0u; cnt = 0u; mine = 0u;
#pragma unroll
        for (unsigned j = 0; j < 16; ++j) { const unsigned c = xb_ld(&bar[XB_XCNT(j)]); sum += c; cnt += (c > 0u) ? 1u : 0u; mine = (j == x) ? c : mine; }
        if (sum == G) break;
        __builtin_amdgcn_s_sleep(1);
        if ((++sp & 255u) == 0u) { if (xb_ld(&bar[XB_TMO])) break; if (sp > XB_SPIN_CAP) { atomicAdd(&bar[XB_TMO], 1u); break; } }
    }
    nloc = mine > 0u ? mine : 1u; nx = cnt > 0u ? cnt : 1u;
}
__device__ __forceinline__ void xcd_barrier(const XcdBarrier& b) {
    asm volatile("s_waitcnt vmcnt(0)" ::: "memory");
    __syncthreads();
    if (threadIdx.x == 0) {
        unsigned* bar = b.bar; unsigned bx = b.x;
        asm volatile("" : "+s"(bar), "+s"(bx));
        __builtin_amdgcn_s_waitcnt(0);
        unsigned nloc = b.st[0], nx = b.st[1];
        if (nloc == 0u) { xcd_barrier_complete(bar, bx, nloc, nx); b.st[0] = nloc; b.st[1] = nx; }
        const unsigned old = xb_add(&bar[XB_XSUB(bx)], 1u);
        const unsigned gen = old / nloc;
        if (old + 1u == (gen + 1u) * nloc) {
            __builtin_amdgcn_fence(__ATOMIC_RELEASE, "agent");
            asm volatile("s_waitcnt vmcnt(0)" ::: "memory");
            const unsigned og = xb_add(&bar[XB_TOP], 1u);
            const unsigned tg = og / nx;
            if (og + 1u == (tg + 1u) * nx) xb_add(&bar[XB_TOPGEN], 1u);
            else XB_SPIN(xb_ld(&bar[XB_TOPGEN]) == tg, bar);
            __builtin_amdgcn_fence(__ATOMIC_ACQUIRE, "agent");
            xb_add(&bar[XB_XGEN(bx)], 1u);
            asm volatile("s_waitcnt vmcnt(0)" ::: "memory");
        } else {
            XB_SPIN(xb_ld(&bar[XB_XGEN(bx)]) == gen, bar);
            __builtin_amdgcn_fence(__ATOMIC_ACQUIRE, "agent");
            asm volatile("s_waitcnt vmcnt(0)" ::: "memory");
        }
    }
    __syncthreads();
}

constexpr int HT = 128 * 64;
__device__ __forceinline__ int lds_byte(int r, int c) {
    int st = (r >> 4) * 2 + (c >> 5), rr = r & 15, cc = c & 31, ob = rr * 64 + cc * 2;
    return st * 1024 + (ob ^ (((ob >> 9) & 1) << 5));
}
__device__ __forceinline__ void stage_rc(int b, int& R, int& C) {
    int st = b / 1024, sb = b % 1024, swz = sb ^ (((sb >> 9) & 1) << 5);
    R = (st >> 1) * 16 + swz / 64; C = (st & 1) * 32 + (swz % 64) / 2;
}
#define SA(b, h) (shm + ((b) * 2 + (h)) * HT)
#define SB(b, h) (shm + (4 + (b) * 2 + (h)) * HT)
#define G_STAGE_A(P_, h, kt) do { _Pragma("unroll") for (int _i = 0; _i < 2; ++_i) \
    __builtin_amdgcn_global_load_lds((const unsigned*)((const char*)A + (size_t)((kt) * 128 + (RowSrc::DENSE ? (h) * 256 * K : 0)) + aoff[RowSrc::DENSE ? 0 : (h)][_i]), (unsigned*)((char*)(P_) + tid * 16 + _i * 8192), 16, 0, 0); } while (0)
#define G_STAGE_B(P_, h, kt) do { _Pragma("unroll") for (int _i = 0; _i < 2; ++_i) \
    __builtin_amdgcn_global_load_lds((const unsigned*)((const char*)Bt + (size_t)((kt) * 128 + (h) * 64 * K) + boff[_i]), (unsigned*)((char*)(P_) + tid * 16 + _i * 8192), 16, 0, 0); } while (0)
#define G_LDA(dst, b, h) _Pragma("unroll") for (int m = 0; m < 4; ++m) _Pragma("unroll") for (int k = 0; k < 2; ++k) \
    dst[m][k] = *reinterpret_cast<const bf16x8*>((char*)SA(b, h) + lds_byte(wr * 64 + m * 16 + fr, k * 32 + fq * 8))
#define G_LDB(dst, b, h) _Pragma("unroll") for (int n = 0; n < 2; ++n) _Pragma("unroll") for (int k = 0; k < 2; ++k) \
    dst[n][k] = *reinterpret_cast<const bf16x8*>((char*)SB(b, h) + lds_byte(wc * 32 + n * 16 + fr, k * 32 + fq * 8))
#define G_MMA(ai, bj, At_, Bt_) do { __builtin_amdgcn_s_setprio(1); \
    _Pragma("unroll") for (int m = 0; m < 4; ++m) _Pragma("unroll") for (int n = 0; n < 2; ++n) _Pragma("unroll") for (int k = 0; k < 2; ++k) \
      acc[ai][bj][m][n] = __builtin_amdgcn_mfma_f32_16x16x32_bf16(Bt_[n][k], At_[m][k], acc[ai][bj][m][n], 0, 0, 0); \
    __builtin_amdgcn_s_setprio(0); } while (0)
#define WAIT_V(n) asm volatile("s_waitcnt vmcnt(" #n ")" ::: "memory")
#define WAIT_L(n) asm volatile("s_waitcnt lgkmcnt(" #n ")" ::: "memory")
#define BAR __builtin_amdgcn_s_barrier()
#define SCHED __builtin_amdgcn_sched_barrier(0)

typedef f32x4 AccT[2][2][4][2];

template <class RowSrc, class Epi>
__device__ __forceinline__ void gemm_tile(const bf16_t* __restrict__ A, const bf16_t* __restrict__ Bt, const int K,
                                          const int bcol, const RowSrc& rs, const Epi& epi, const int wv) {
    const int tid = hidden_tid(wv);
    int wid = tid >> 6, lane = tid & 63, wr = wid >> 2, wc = wid & 3, fr = lane & 15, fq = lane >> 4;
    unsigned aoff[2][2], boff[2];
#pragma unroll
    for (int i = 0; i < 2; ++i) {
        int R, C; stage_rc(tid * 16 + i * 8192, R, C);
        boff[i] = (unsigned)(((bcol + (R >> 5) * 64 + (R & 31)) * K + C) * 2);
        if (RowSrc::DENSE) { aoff[0][i] = (unsigned)((R * K + C) * 2); aoff[1][i] = 0u; }
        else {
#pragma unroll
            for (int h = 0; h < 2; ++h) aoff[h][i] = (unsigned)((rs(h * 128 + R) * K + C) * 2);
        }
    }
    WAIT_V(0);
    AccT acc = {};
    bf16x8 At[4][2], B0[2][2], B1[2][2];
    const int nt = K / 64;
    G_STAGE_B(SB(0, 0), 0, 0); G_STAGE_A(SA(0, 0), 0, 0);
    G_STAGE_B(SB(0, 1), 1, 0); G_STAGE_A(SA(0, 1), 1, 0);
    if (wr == 1) BAR;
    WAIT_V(4); BAR;
    G_STAGE_B(SB(1, 0), 0, 1); G_STAGE_A(SA(1, 0), 0, 1); G_STAGE_B(SB(1, 1), 1, 1);
    WAIT_V(6); BAR;
    for (int t = 0; t < nt - 2; t += 2) {
        G_LDB(B0, 0, 0); SCHED; G_LDA(At, 0, 0); G_STAGE_A(SA(1, 1), 1, t + 1);
        WAIT_L(8); BAR; WAIT_L(0); G_MMA(0, 0, At, B0); BAR; SCHED;
        G_LDB(B1, 0, 1); G_STAGE_B(SB(0, 0), 0, t + 2);
        BAR; WAIT_L(0); G_MMA(0, 1, At, B1); BAR;
        G_LDA(At, 0, 1); G_STAGE_A(SA(0, 0), 0, t + 2);
        BAR; WAIT_L(0); G_MMA(1, 0, At, B0); BAR; SCHED;
        G_STAGE_B(SB(0, 1), 1, t + 2);
        WAIT_V(6); BAR; G_MMA(1, 1, At, B1); BAR;
        G_LDB(B0, 1, 0); SCHED; G_LDA(At, 1, 0); G_STAGE_A(SA(0, 1), 1, t + 2);
        WAIT_L(8); BAR; WAIT_L(0); G_MMA(0, 0, At, B0); BAR; SCHED;
        G_LDB(B1, 1, 1); G_STAGE_B(SB(1, 0), 0, t + 3);
        BAR; WAIT_L(0); G_MMA(0, 1, At, B1); BAR;
        G_LDA(At, 1, 1); G_STAGE_A(SA(1, 0), 0, t + 3);
        BAR; WAIT_L(0); G_MMA(1, 0, At, B0); BAR; SCHED;
        G_STAGE_B(SB(1, 1), 1, t + 3);
        WAIT_V(6); BAR; G_MMA(1, 1, At, B1); BAR;
    }
    { G_LDB(B0, 0, 0); WAIT_V(0); G_LDA(At, 0, 0); G_STAGE_A(SA(1, 1), 1, nt - 1);
      BAR; WAIT_L(0); G_MMA(0, 0, At, B0); BAR;
      G_LDB(B1, 0, 1); BAR; WAIT_L(0); G_MMA(0, 1, At, B1); BAR;
      G_LDA(At, 0, 1); WAIT_V(4); BAR; WAIT_L(0); G_MMA(1, 0, At, B0); G_MMA(1, 1, At, B1); BAR; }
    { G_LDB(B0, 1, 0); G_LDA(At, 1, 0); WAIT_V(2); BAR; WAIT_L(0); G_MMA(0, 0, At, B0); BAR;
      G_LDB(B1, 1, 1); WAIT_V(0); BAR; WAIT_L(0); G_MMA(0, 1, At, B1); BAR;
      G_LDA(At, 1, 1); BAR; WAIT_L(0); G_MMA(1, 0, At, B0); G_MMA(1, 1, At, B1); BAR; }
    if (wr == 0) BAR;
    int tz = hidden_tid(wv); wid = tz >> 6; lane = tz & 63; wr = wid >> 2; wc = wid & 3; fr = lane & 15; fq = lane >> 4;
    epi(acc, wr * 64 + fr, bcol + wc * 64 + fq * 4);
}

struct RowIdent { static constexpr bool DENSE = true; __device__ __forceinline__ int operator()(int r) const { return r; } };

__device__ __forceinline__ void st_bf16x4(bf16_t* p, const f32x4& v) { u32x2 w; w.x = cvt_pk_bf16(v[0], v[1]); w.y = cvt_pk_bf16(v[2], v[3]); *(u32x2*)p = w; }
__device__ __forceinline__ void st_chan4(bf16_t* q, size_t ld, const f32x4& v) {
    const unsigned a = cvt_pk_bf16(v[0], v[1]), b = cvt_pk_bf16(v[2], v[3]);
    q[0] = (bf16_t)(a & 0xffff); q[ld] = (bf16_t)(a >> 16); q[2 * ld] = (bf16_t)(b & 0xffff); q[3 * ld] = (bf16_t)(b >> 16);
}
constexpr int BJS = 32;
#define EPI_LOOP_AM _Pragma("unroll") for (int ai = 0; ai < 2; ++ai) _Pragma("unroll") for (int m = 0; m < 4; ++m)
#define EPI_LOOP_BN _Pragma("unroll") for (int bj = 0; bj < 2; ++bj) _Pragma("unroll") for (int n = 0; n < 2; ++n)
struct EpiRes {
    bf16_t* XB; int brow; float* ssp; int lane;
    __device__ __forceinline__ void operator()(AccT& acc, int r0, int c0) const {
        u32x2 xv[2][4][4];
        EPI_LOOP_AM {
            const bf16_t* qb = XB + (size_t)(brow + r0 + ai * 128 + m * 16) * D + c0;
            EPI_LOOP_BN xv[ai][m][bj * 2 + n] = *(const u32x2*)(qb + bj * BJS + n * 16);
        }
        EPI_LOOP_AM {
            const int row = brow + r0 + ai * 128 + m * 16;
            bf16_t* qb = XB + (size_t)row * D + c0;
            float ss = 0.f;
            EPI_LOOP_BN {
                const u32x2 x = xv[ai][m][bj * 2 + n];
                const f32x4 t = (f32x4){bflo(x.x), bfhi(x.x), bflo(x.y), bfhi(x.y)} + acc[ai][bj][m][n];
                const unsigned a0 = cvt_pk_bf16(t[0], t[1]), a1 = cvt_pk_bf16(t[2], t[3]);
                *(u32x2*)(qb + bj * BJS + n * 16) = (u32x2){a0, a1};
                const float r0f = bflo(a0), r1f = bfhi(a0), r2f = bflo(a1), r3f = bfhi(a1);
                ss += (r0f * r0f + r1f * r1f) + (r2f * r2f + r3f * r3f);
            }
            if (ssp) { ss += shx(ss, 16, lane); ss += shx(ss, 32, lane); if ((lane >> 4) == 0) ssp[(size_t)row * 16 + (c0 >> 6)] = ss; }
        }
    }
};
struct EpiSplit {
    bf16_t* Ca; bf16_t* T; bf16_t* Cb; int c0s, c1s, ldT; size_t ldC; int brow; const float* rs;
    __device__ __forceinline__ void chan(AccT& acc, bf16_t* base, int r0, int c, const float (&scv)[2][4]) const {
        EPI_LOOP_AM { const int row = brow + r0 + ai * 128 + m * 16; const float sc = scv[ai][m];
            bf16_t* q = base + (size_t)c * ldC + row;
            EPI_LOOP_BN st_chan4(q + (size_t)(bj * BJS + n * 16) * ldC, ldC, acc[ai][bj][m][n] * sc); }
    }
    __device__ __forceinline__ void operator()(AccT& acc, int r0, int c0) const {
        const int tilec = __builtin_amdgcn_readfirstlane(c0) & ~255;
        float scv[2][4];
        EPI_LOOP_AM scv[ai][m] = rs ? rs[brow + r0 + ai * 128 + m * 16] : 1.0f;
        if (tilec < c0s) chan(acc, Ca, r0, c0, scv);
        else if (tilec < c1s) {
            EPI_LOOP_AM { const int row = brow + r0 + ai * 128 + m * 16; const float sc = scv[ai][m];
                bf16_t* q = T + (size_t)row * ldT + (c0 - c0s);
                EPI_LOOP_BN st_bf16x4(q + bj * BJS + n * 16, acc[ai][bj][m][n] * sc); }
        } else chan(acc, Cb, r0, c0 - c1s, scv);
    }
};
struct EpiTokRstd {
    bf16_t* T; int ldT, brow; const float* ssp; int lane;
    __device__ __forceinline__ void operator()(AccT& acc, int r0, int c0) const {
        f32x4 pv[2][4];
        EPI_LOOP_AM pv[ai][m] = *(const f32x4*)(ssp + (size_t)(brow + r0 + ai * 128 + m * 16) * 16 + (lane >> 4) * 4);
        EPI_LOOP_AM {
            const int row = brow + r0 + ai * 128 + m * 16;
            float ssq = (pv[ai][m][0] + pv[ai][m][1]) + (pv[ai][m][2] + pv[ai][m][3]);
            ssq += shx(ssq, 16, lane); ssq += shx(ssq, 32, lane);
            const float rs = rsqrtf(ssq * (1.0f / 1024.0f) + EPS);
            bf16_t* q = T + (size_t)row * ldT + c0;
            EPI_LOOP_BN st_bf16x4(q + bj * BJS + n * 16, acc[ai][bj][m][n] * rs);
        }
    }
};
struct EpiGateUp {
    bf16_t* act; const int* list; int cnt, pos0; const float* rp;
    __device__ __forceinline__ void operator()(AccT& acc, int r0, int c0) const {
        int av[2][4]; float rv[2][4];
        EPI_LOOP_AM { const int pos = pos0 + r0 + ai * 128 + m * 16, pc = pos < cnt ? pos : cnt - 1; av[ai][m] = list[pc]; rv[ai][m] = rp[pc]; }
        EPI_LOOP_AM {
            const int pos = pos0 + r0 + ai * 128 + m * 16;
            if (pos < cnt) {
                const int a = av[ai][m];
                const float rs = rv[ai][m];
#pragma unroll
                for (int bj = 0; bj < 2; ++bj) {
                    const f32x4 g = acc[ai][bj][m][0] * rs, u = acc[ai][bj][m][1] * rs; f32x4 o;
#pragma unroll
                    for (int j = 0; j < 4; ++j) o[j] = g[j] / (1.0f + __expf(-g[j])) * u[j];
                    const int col = c0 + bj * BJS;
                    const unsigned long long wv8 = ((unsigned long long)cvt_pk_bf16(o[2], o[3]) << 32) | cvt_pk_bf16(o[0], o[1]);
                    __hip_atomic_store((unsigned long long*)(act + (size_t)a * EH + (col >> 5) * 16 + (col & 15)), wv8, __ATOMIC_RELAXED, __HIP_MEMORY_SCOPE_AGENT);
                }
            }
        }
    }
};
struct EpiDown {
    bf16_t* y; const int* list; int cnt, pos0;
    __device__ __forceinline__ void operator()(AccT& acc, int r0, int c0) const {
        int av[2][4];
        EPI_LOOP_AM { const int pos = pos0 + r0 + ai * 128 + m * 16, pc = pos < cnt ? pos : cnt - 1; av[ai][m] = list[pc]; }
        EPI_LOOP_AM {
            const int pos = pos0 + r0 + ai * 128 + m * 16;
            if (pos < cnt) { bf16_t* q = y + (size_t)av[ai][m] * D + c0; EPI_LOOP_BN st_bf16x4(q + bj * BJS + n * 16, acc[ai][bj][m][n]); }
        }
    }
};
struct RowTok { static constexpr bool DENSE = false; const int* list; int cnt, pos0; __device__ __forceinline__ int operator()(int r) const { const int pos = pos0 + r; return pos < cnt ? (list[pos] >> 1) : NTOK; } };
struct RowAsg { static constexpr bool DENSE = false; const int* list; int cnt, pos0; __device__ __forceinline__ int operator()(int r) const { const int pos = pos0 + r; return pos < cnt ? list[pos] : 2 * NTOK; } };

constexpr int ATT_VOFF = 16384;
template <int MODE> struct ACfg;
template <> struct ACfg<0> { static constexpr int DQK = 64, DV = 128, NMAP = 2, KBLK = 2; };
template <> struct ACfg<1> { static constexpr int DQK = 64, DV = 64, NMAP = 1, KBLK = 1; };
template <> struct ACfg<2> { static constexpr int DQK = 128, DV = 128, NMAP = 1, KBLK = 2; };

template <int MODE, bool ALT = false>
__device__ __forceinline__ void attn_unit(const bf16_t* __restrict__ Qp, const int ldq,
                                          const bf16_t* __restrict__ Kp, const int ldk,
                                          const bf16_t* __restrict__ Vt, const size_t ldvt,
                                          const int q0, const int kbeg, const int kend,
                                          const float scale, const float slope, const float m_init, const float l_init,
                                          bf16_t* __restrict__ Op, const int ldo,
                                          const float lam, const float outscale, const float* __restrict__ subln, const int wv) {
    constexpr int DQK = ACfg<MODE>::DQK, DV = ACfg<MODE>::DV, NMAP = ACfg<MODE>::NMAP, KBLK = ACfg<MODE>::KBLK;
    const int tid = hidden_tid(wv), w = tid >> 6, lane = tid & 63, fr = lane & 15, fq = lane >> 4;
    const int qrow = q0 + w * 16 + fr;
    bf16x8 Qf[NMAP][DQK / 32];
#pragma unroll
    for (int m = 0; m < NMAP; ++m)
#pragma unroll
        for (int kk = 0; kk < DQK / 32; ++kk) Qf[m][kk] = *(const bf16x8*)(Qp + (size_t)qrow * ldq + m * DQK + kk * 32 + fq * 8);
    constexpr float LOG2E = 1.4426950408889634f;
    const float scale2 = scale * LOG2E, slope2 = slope * LOG2E, kappa = slope / scale;
    f32x4 O[NMAP][DV / 16], Ol[NMAP];
    float mrun[NMAP];
#pragma unroll
    for (int m = 0; m < NMAP; ++m) {
        mrun[m] = m_init * LOG2E; Ol[m] = (f32x4){(fq == 0) ? l_init : 0.f, 0.f, 0.f, 0.f};
#pragma unroll
        for (int et = 0; et < DV / 16; ++et) O[m][et] = (f32x4){0.f, 0.f, 0.f, 0.f};
    }
    const unsigned onesw = (fr == 0) ? 0x3f803f80u : 0u;
    const bf16x8 onesf = __builtin_bit_cast(bf16x8, (u32x4){onesw, onesw, onesw, onesw});
    char* const lds = (char*)shm;
    constexpr int KN = KBLK, VN = DV / 64;
    u32x4 kreg[KN], vreg[VN];
#define ATT_LOAD(k0_) do { \
        _Pragma("unroll") for (int i_ = 0; i_ < KN; ++i_) { const int c_ = tid + i_ * NT; const int key_ = c_ / (KBLK * 8), col_ = (c_ % (KBLK * 8)) * 8; \
            kreg[i_] = *(const u32x4*)(Kp + (size_t)((k0_) + key_) * ldk + col_); } \
        _Pragma("unroll") for (int i_ = 0; i_ < VN; ++i_) { const int c_ = tid + i_ * NT; const int e_ = c_ >> 3, kc_ = c_ & 7; \
            vreg[i_] = *(const u32x4*)(Vt + (size_t)e_ * ldvt + (k0_) + kc_ * 8); } } while (0)
    ATT_LOAD(kbeg);
    const int qw0 = q0 + w * 16;
    constexpr int VBYTES = DV * 160;
    bf16x8 Pf[NMAP][2];
#define ATT_PV_C(voff_, c) do { \
            bf16x8 vf[DV / 16]; \
            _Pragma("unroll") for (int et = 0; et < DV / 16; ++et) vf[et] = *(const bf16x8*)(lds + (voff_) + (et * 16 + fr) * 160 + (c) * 64 + fq * 16); \
            _Pragma("unroll") for (int m = 0; m < NMAP; ++m) Ol[m] = __builtin_amdgcn_mfma_f32_16x16x32_bf16(onesf, Pf[m][c], Ol[m], 0, 0, 0); \
            _Pragma("unroll") for (int et = 0; et < DV / 16; ++et) \
                _Pragma("unroll") for (int m = 0; m < NMAP; ++m) O[m][et] = __builtin_amdgcn_mfma_f32_16x16x32_bf16(vf[et], Pf[m][c], O[m][et], 0, 0, 0); \
        } while (0)
    int vcur = ATT_VOFF;
    for (int k0 = kbeg; k0 < kend; k0 += 64) {
        __syncthreads();
#pragma unroll
        for (int i = 0; i < KN; ++i) { const int c = tid + i * NT; const int key = c / (KBLK * 8), col = (c % (KBLK * 8)) * 8;
            *(u32x4*)(lds + (col >> 6) * 8192 + lds_byte(key, col & 63)) = kreg[i]; }
#pragma unroll
        for (int i = 0; i < VN; ++i) { const int c = tid + i * NT; const int e = c >> 3, kc = c & 7;
            char* vd = lds + vcur + e * 160 + (kc >> 2) * 64 + (kc & 1) * 32 + ((kc >> 1) & 1) * 8;
            *(u32x2*)vd = (u32x2){vreg[i].x, vreg[i].y}; *(u32x2*)(vd + 16) = (u32x2){vreg[i].z, vreg[i].w}; }
        __syncthreads();
        if (k0 + 64 < kend) ATT_LOAD(k0 + 64);
        const int vprev = vcur ^ ATT_VOFF ^ (ATT_VOFF + VBYTES);
        const float dq = (float)(qrow - k0);
        bool gen;
        if (MODE == 2) gen = false;
        else if (MODE == 1) gen = !((k0 + 63 <= qw0 && qw0 + 15 - k0 <= 128) || (k0 >= qw0 + 15 && k0 + 63 - qw0 <= 128));
        else gen = !(k0 + 63 <= qw0 || k0 >= qw0 + 15);
        const bool pos = (MODE == 2) || (k0 + 63 <= qw0);
        f32x4 Cin[4]; float off;
        if (MODE == 2) {
#pragma unroll
            for (int t = 0; t < 4; ++t) Cin[t] = (f32x4){0.f, 0.f, 0.f, 0.f};
            off = 0.f;
        } else if (gen) {
#pragma unroll
            for (int t = 0; t < 4; ++t)
#pragma unroll
                for (int r = 0; r < 4; ++r) Cin[t][r] = -kappa * fabsf(dq - (float)(16 * t + 4 * fq + r));
            off = 0.f;
        } else {
            const float sk = pos ? kappa : -kappa, cb = sk * (float)(4 * fq);
#pragma unroll
            for (int t = 0; t < 4; ++t)
#pragma unroll
                for (int r = 0; r < 4; ++r) Cin[t][r] = sk * (float)(16 * t + r) + cb;
            off = pos ? -slope2 * dq : slope2 * dq;
        }
        f32x4 s[NMAP][4];
#pragma unroll
        for (int m = 0; m < NMAP; ++m) {
            bf16x8 kf[4][DQK / 32];
#pragma unroll
            for (int t = 0; t < 4; ++t)
#pragma unroll
                for (int kk = 0; kk < DQK / 32; ++kk) {
                    const int blk = (MODE == 2) ? (kk >> 1) : m, kcol = (MODE == 2) ? (kk & 1) * 32 : kk * 32;
                    kf[t][kk] = *(const bf16x8*)(lds + blk * 8192 + lds_byte(t * 16 + fr, kcol + fq * 8));
                }
#pragma unroll
            for (int t = 0; t < 4; ++t) {
                s[m][t] = Cin[t];
#pragma unroll
                for (int kk = 0; kk < DQK / 32; ++kk) s[m][t] = __builtin_amdgcn_mfma_f32_16x16x32_bf16(kf[t][kk], Qf[m][kk], s[m][t], 0, 0, 0);
            }
        }
        float mx[NMAP], mx1[NMAP];
#pragma unroll
        for (int m = 0; m < NMAP; ++m) {
            if (MODE == 1 && gen) {
#pragma unroll
                for (int t = 0; t < 4; ++t)
#pragma unroll
                    for (int r = 0; r < 4; ++r) s[m][t][r] = (fabsf(dq - (float)(16 * t + 4 * fq + r)) > 128.0f) ? -1e30f : s[m][t][r];
            }
            float v = fmaxf(fmaxf(s[m][0][0], s[m][0][1]), fmaxf(s[m][0][2], s[m][0][3]));
#pragma unroll
            for (int t = 1; t < 4; ++t) v = fmaxf(v, fmaxf(fmaxf(s[m][t][0], s[m][t][1]), fmaxf(s[m][t][2], s[m][t][3])));
            mx[m] = v; mx1[m] = shx(v, 16, lane);
        }
        __builtin_amdgcn_sched_barrier(0);
        if (k0 > kbeg) ATT_PV_C(vprev, 0);
        __builtin_amdgcn_sched_barrier(0);
#pragma unroll
        for (int m = 0; m < NMAP; ++m) { mx[m] = fmaxf(mx[m], mx1[m]); mx1[m] = shx(mx[m], 32, lane); }
        __builtin_amdgcn_sched_barrier(0);
        if (k0 > kbeg) ATT_PV_C(vprev, 1);
        __builtin_amdgcn_sched_barrier(0);
#pragma unroll
        for (int m = 0; m < NMAP; ++m) {
            const float mxx = fmaxf(mx[m], mx1[m]);
            const float mtile = fmaxf(mxx * scale2 + off, -1e30f);
            const float mnew = fmaxf(mrun[m], mtile), alpha = __builtin_amdgcn_exp2f(mrun[m] - mnew);
            mrun[m] = mnew;
            const float sub = off - mnew;
#pragma unroll
            for (int t = 0; t < 4; ++t)
#pragma unroll
                for (int r = 0; r < 4; ++r) s[m][t][r] = __builtin_amdgcn_exp2f(s[m][t][r] * scale2 + sub);
            if (__builtin_amdgcn_ballot_w64(alpha != 1.0f) != 0ull) {
                Ol[m] *= alpha;
#pragma unroll
                for (int et = 0; et < DV / 16; ++et) O[m][et] *= alpha;
            }
#pragma unroll
            for (int c = 0; c < 2; ++c) {
                u32x4 pk; pk.x = cvt_pk_bf16(s[m][2 * c][0], s[m][2 * c][1]); pk.y = cvt_pk_bf16(s[m][2 * c][2], s[m][2 * c][3]);
                pk.z = cvt_pk_bf16(s[m][2 * c + 1][0], s[m][2 * c + 1][1]); pk.w = cvt_pk_bf16(s[m][2 * c + 1][2], s[m][2 * c + 1][3]);
                Pf[m][c] = __builtin_bit_cast(bf16x8, pk);
            }
        }
        vcur = vprev;
    }
    { const int vlast = vcur ^ ATT_VOFF ^ (ATT_VOFF + VBYTES); ATT_PV_C(vlast, 0); ATT_PV_C(vlast, 1); }
    float linv[NMAP];
#pragma unroll
    for (int m = 0; m < NMAP; ++m) linv[m] = 1.0f / shl(Ol[m][0], fr);
    const int tid2 = hidden_tid(wv); const int qrow_o = q0 + (tid2 >> 6) * 16 + (tid2 & 15);
    if (MODE == 0) {
        float ss = 0.f;
#pragma unroll
        for (int et = 0; et < DV / 16; ++et)
#pragma unroll
            for (int r = 0; r < 4; ++r) { const float v = O[0][et][r] * linv[0] - lam * (O[NMAP - 1][et][r] * linv[NMAP - 1]); O[0][et][r] = v; ss += v * v; }
        ss += shx(ss, 16, lane); ss += shx(ss, 32, lane);
        const float rs = rsqrtf(ss * (1.0f / 128.0f) + EPS) * outscale;
#pragma unroll
        for (int et = 0; et < DV / 16; ++et) {
            const f32x4 g = *(const f32x4*)(subln + et * 16 + fq * 4);
            st_bf16x4(Op + (size_t)qrow_o * ldo + et * 16 + fq * 4, O[0][et] * rs * g);
        }
    } else {
#pragma unroll
        for (int et = 0; et < DV / 16; ++et) st_bf16x4(Op + (size_t)qrow_o * ldo + et * 16 + fq * 4, O[0][et] * linv[0]);
    }
}

constexpr int HZ_RS = 4896;
constexpr int HZ_PAD = 192;
constexpr int H_CPS = 8256;
constexpr int H_ZOFF = 0, H_CPOFF = 8 * HZ_RS, H_RAWOFF = H_CPOFF + 8 * H_CPS;

template <bool ALT>
__device__ __forceinline__ void hyena_unit(const Params& p, const int lj  , const int c, const int wv) {
    const int tid = hidden_tid(wv), w = tid >> 6, lane = tid & 63, fr = lane & 15, fq = lane >> 4;
    char* const lds = (char*)shm;
    const bf16_t* hyT = (const bf16_t*)(p.ws + WS_PROJ + PR_HYT);
    const float* cw = p.in[4] + (size_t)lj * 3 * 1536; const float* cb = p.in[5] + (size_t)lj * 1536;
    const int nb = fr >> 1, tbp = fr & 1;
    __syncthreads();
    for (int i = tid; i < 8 * 2 * (HZ_PAD / 8); i += NT) {
        const int b = i / (2 * (HZ_PAD / 8)), r = i % (2 * (HZ_PAD / 8)), side = r / (HZ_PAD / 8), k = r % (HZ_PAD / 8);
        unsigned zz0 = 0u; asm volatile("" : "+v"(zz0));
        *(u32x4*)(lds + H_ZOFF + b * HZ_RS + (side ? (HZ_PAD + 2048) * 2 : 0) + k * 16) = (u32x4){zz0, zz0, zz0, zz0};
        if (i < 2) *(u32x4*)(lds + H_RAWOFF + 8192 + i * 16) = (u32x4){zz0, zz0, zz0, zz0};
    }
    {
        const float w0 = cw[c], w1 = cw[1536 + c], w2 = cw[2 * 1536 + c], bb = cb[c];
        const bf16_t* src = hyT + (size_t)c * NTOK;
        u32x4 v[4]; unsigned short um[4], up[4];
#pragma unroll
        for (int k = 0; k < 4; ++k) {
            const int i = tid + k * NT, b = i >> 8, s0 = (i & 255) * 8;
            const bf16_t* q = src + b * S + s0;
            v[k] = *(const u32x4*)q; um[k] = q[s0 > 0 ? -1 : 0]; up[k] = q[s0 + 8 < S ? 8 : 7];
        }
#pragma unroll
        for (int k = 0; k < 4; ++k) {
            const int i = tid + k * NT, b = i >> 8, s0 = (i & 255) * 8;
            float u[10];
            u[0] = (s0 > 0) ? bf2f(um[k]) : 0.f; u[9] = (s0 + 8 < S) ? bf2f(up[k]) : 0.f;
            u[1] = bflo(v[k].x); u[2] = bfhi(v[k].x); u[3] = bflo(v[k].y); u[4] = bfhi(v[k].y); u[5] = bflo(v[k].z); u[6] = bfhi(v[k].z); u[7] = bflo(v[k].w); u[8] = bfhi(v[k].w);
            float o[8];
#pragma unroll
            for (int j = 0; j < 8; ++j) o[j] = w0 * u[j] + w1 * u[j + 1] + w2 * u[j + 2] + bb;
            u32x4 ov; ov.x = cvt_pk_bf16(o[0], o[1]); ov.y = cvt_pk_bf16(o[2], o[3]); ov.z = cvt_pk_bf16(o[4], o[5]); ov.w = cvt_pk_bf16(o[6], o[7]);
            *(u32x4*)(lds + H_ZOFF + b * HZ_RS + (HZ_PAD + s0) * 2) = ov;
        }
    }
#pragma unroll 1
    for (int order = 0; order < 2; ++order) {
        const int gch = 512 * (order + 1) + c;
        const bf16_t* gsrc = hyT + (size_t)gch * NTOK;
        u32x2 gv[2][4]; unsigned short gm[2][4], gp[2][4];
        u32x4 rawv;
        {
            const bf16_t* f = (const bf16_t*)(p.ws + WS_FILT) + ((size_t)(lj * 2 + order) * 512 + c) * 4096;
            rawv = *(const u32x4*)(f + tid * 8);
#pragma unroll
            for (int ci = 0; ci < 2; ++ci)
#pragma unroll
                for (int mt = 0; mt < 4; ++mt) {
                    const int t = 64 * (4 * w + 2 * ci + tbp) + 16 * mt + 4 * fq;
                    const bf16_t* gq = gsrc + nb * S + t;
                    gv[ci][mt] = *(const u32x2*)gq; gm[ci][mt] = gq[t > 0 ? -1 : 0]; gp[ci][mt] = gq[t + 4 < S ? 4 : 3];
                }
        }
        *(u32x4*)(lds + H_RAWOFF + tid * 16) = rawv;
        __syncthreads();
        {
            const bf16_t* raw = (const bf16_t*)(lds + H_RAWOFF);
            const int o = w;
#pragma unroll
            for (int k = 0; k < 8; ++k) {
                const int a = lane + 64 * k;
                unsigned short e[8];
#pragma unroll
                for (int j = 0; j < 8; ++j) e[j] = raw[8 * a + o + j];
                u32x4 ov; ov.x = e[0] | ((unsigned)e[1] << 16); ov.y = e[2] | ((unsigned)e[3] << 16); ov.z = e[4] | ((unsigned)e[5] << 16); ov.w = e[6] | ((unsigned)e[7] << 16);
                *(u32x4*)(lds + H_CPOFF + o * H_CPS + a * 16) = ov;
            }
        }
        __syncthreads();
        f32x4 acc[2][4];
#pragma unroll
        for (int ci = 0; ci < 2; ++ci)
#pragma unroll
            for (int mt = 0; mt < 4; ++mt) acc[ci][mt] = (f32x4){0.f, 0.f, 0.f, 0.f};
        {
            const int acp = H_CPOFF + (7 - (fr & 7)) * H_CPS + (255 - (fr >> 3) + fq) * 16;
            const int zb = H_ZOFF + nb * HZ_RS + (HZ_PAD + 8 * fq) * 2;
            for (int dl = 4 * w - 31; dl <= ((ALT && DUPSEL >= 5) ? 4 * w - 31 : 4 * w + 3); ++dl) {
#pragma unroll
                for (int kh = 0; kh < 2; ++kh) {
                    bf16x8 Bf[2];
#pragma unroll
                    for (int ci = 0; ci < 2; ++ci) {
                        const int sblk = 4 * w + 2 * ci + tbp - dl;
                        Bf[ci] = *(const bf16x8*)(lds + zb + (64 * sblk + 32 * kh) * 2);
                    }
#pragma unroll
                    for (int mt = 0; mt < 4; ++mt) {
                        const int q = 4 * dl + mt - 2 * kh;
                        const bf16x8 Af = *(const bf16x8*)(lds + acp - 32 * q);
#pragma unroll
                        for (int ci = 0; ci < 2; ++ci) acc[ci][mt] = __builtin_amdgcn_mfma_f32_16x16x32_bf16(Af, Bf[ci], acc[ci][mt], 0, 0, 0);
                    }
                }
            }
        }
        const float hb = p.in[12][(size_t)(lj * 2 + order) * 512 + c];
        const float w0 = cw[gch], w1 = cw[1536 + gch], w2 = cw[2 * 1536 + gch], bb = cb[gch];
        u32x2 zout[2][4];
#pragma unroll
        for (int ci = 0; ci < 2; ++ci)
#pragma unroll
            for (int mt = 0; mt < 4; ++mt) {
                const int t = 64 * (4 * w + 2 * ci + tbp) + 16 * mt + 4 * fq;
                const u32x2 zz = *(const u32x2*)(lds + H_ZOFF + nb * HZ_RS + (HZ_PAD + t) * 2);
                float u[6];
                u[0] = (t > 0) ? bf2f(gm[ci][mt]) : 0.f; u[5] = (t + 4 < S) ? bf2f(gp[ci][mt]) : 0.f;
                u[1] = bflo(gv[ci][mt].x); u[2] = bfhi(gv[ci][mt].x); u[3] = bflo(gv[ci][mt].y); u[4] = bfhi(gv[ci][mt].y);
                const float z[4] = {bflo(zz.x), bfhi(zz.x), bflo(zz.y), bfhi(zz.y)};
                float o[4];
#pragma unroll
                for (int r = 0; r < 4; ++r) {
                    const float gate = w0 * u[r] + w1 * u[r + 1] + w2 * u[r + 2] + bb;
                    o[r] = gate * (acc[ci][mt][r] + hb * z[r]);
                }
                zout[ci][mt].x = cvt_pk_bf16(o[0], o[1]); zout[ci][mt].y = cvt_pk_bf16(o[2], o[3]);
            }
        __syncthreads();
        if (order == 0) {
#pragma unroll
            for (int ci = 0; ci < 2; ++ci)
#pragma unroll
                for (int mt = 0; mt < 4; ++mt) {
                    const int t = 64 * (4 * w + 2 * ci + tbp) + 16 * mt + 4 * fq;
                    *(u32x2*)(lds + H_ZOFF + nb * HZ_RS + (HZ_PAD + t) * 2) = zout[ci][mt];
                }
        } else {
            bf16_t* yt = (bf16_t*)(p.ws + WS_QX) + (size_t)c * NTOK;
#pragma unroll
            for (int ci = 0; ci < 2; ++ci)
#pragma unroll
                for (int mt = 0; mt < 4; ++mt) {
                    const int t = 64 * (4 * w + 2 * ci + tbp) + 16 * mt + 4 * fq;
                    *(u32x2*)(yt + nb * S + t) = zout[ci][mt];
                }
        }
        __syncthreads();
    }
}

struct Row16 { f32x4 v[4]; };
__device__ __forceinline__ void ld_row(Row16& r, const float* src, int lane) {
#pragma unroll
    for (int i = 0; i < 4; ++i) r.v[i] = *(const f32x4*)(src + 256 * i + 4 * lane);
}
__device__ __forceinline__ void ld_row_bf(Row16& r, const bf16_t* src, int lane) {
#pragma unroll
    for (int i = 0; i < 4; ++i) { const u32x2 v = *(const u32x2*)(src + 256 * i + 4 * lane); r.v[i] = (f32x4){bflo(v.x), bfhi(v.x), bflo(v.y), bfhi(v.y)}; }
}
__device__ __forceinline__ float row_rstd(const Row16& r, int lane) {
    float ss = 0.f;
#pragma unroll
    for (int i = 0; i < 4; ++i) ss += r.v[i][0] * r.v[i][0] + r.v[i][1] * r.v[i][1] + r.v[i][2] * r.v[i][2] + r.v[i][3] * r.v[i][3];
    ss = wave_sum(ss, lane);
    return rsqrtf(ss * (1.0f / 1024.0f) + EPS);
}
template <int KIND  , bool ALT = false>
__device__ __forceinline__ void norm_phase(const Params& p, const int layer, const float* __restrict__ gain, const int bid, const int nb, const int wv) {
    const int tid_ = hidden_tid(wv), lane = tid_ & 63, w = tid_ >> 6;
    bf16_t* XB = (bf16_t*)(p.ws + WS_XB);
    bf16_t* XBo = ALT ? (bf16_t*)(p.ws + WS_PROJ) : XB;
    float* RS1 = (float*)(p.ws + (ALT ? WS_QX : WS_RS1));
    const bf16_t* Y = (const bf16_t*)(p.ws + WS_Y);
    const float* WT = (const float*)(p.ws + WS_WT);
    Row16 g;
    if (KIND == 2) ld_row(g, gain, lane);
    for (int tok = bid * 8 + w; tok < NTOK; tok += nb * 8) {
        Row16 x;
        if (KIND == 0 && layer == 0) ld_row(x, p.in[0] + (size_t)tok * D, lane); else ld_row_bf(x, XB + (size_t)tok * D, lane);
        if ((KIND == 0 && layer > 0) || KIND == 2) {
            const float w0 = WT[2 * tok], w1 = WT[2 * tok + 1];
            const bf16_t* y0 = Y + (size_t)(2 * tok) * D; const bf16_t* y1 = y0 + D;
#pragma unroll
            for (int i = 0; i < 4; ++i) {
                const u32x2 a = *(const u32x2*)(y0 + 256 * i + 4 * lane), b = *(const u32x2*)(y1 + 256 * i + 4 * lane);
                x.v[i][0] += w0 * bflo(a.x) + w1 * bflo(b.x); x.v[i][1] += w0 * bfhi(a.x) + w1 * bfhi(b.x);
                x.v[i][2] += w0 * bflo(a.y) + w1 * bflo(b.y); x.v[i][3] += w0 * bfhi(a.y) + w1 * bfhi(b.y);
            }
        }
        if (KIND == 2) {
            const float rstd = row_rstd(x, lane);
#pragma unroll
            for (int i = 0; i < 4; ++i) *(f32x4*)(p.out + (size_t)tok * D + 256 * i + 4 * lane) = x.v[i] * rstd * g.v[i];
        } else {
#pragma unroll
            for (int i = 0; i < 4; ++i) {
                const unsigned a0 = cvt_pk_bf16(x.v[i][0], x.v[i][1]), a1 = cvt_pk_bf16(x.v[i][2], x.v[i][3]);
                *(u32x2*)(XBo + (size_t)tok * D + 256 * i + 4 * lane) = (u32x2){a0, a1};
                x.v[i] = (f32x4){bflo(a0), bfhi(a0), bflo(a1), bfhi(a1)};
            }
            const float rstd = row_rstd(x, lane);
            if (lane == 0) RS1[tok] = rstd;
        }
    }
}

template <bool ALT>
__device__ __forceinline__ void route_phase(const Params& p, const int layer, const int bid, const int nb, const int wv) {
    const int tid = hidden_tid(wv), lane = tid & 63, w = tid >> 6, fr = lane & 15, fq = lane >> 4;
    float* part = (float*)shm;
    float* ssql = part + 8 * 64 * 49;
    float* lgl = ssql + 8 * 64;
    int* cntl = (int*)((char*)shm + LDS_ROUTE);
    int* basel = cntl + 32;
    int* sel = basel + 32;
    int* posl = sel + 128;
    float* rsl = (float*)(posl + 128);
    float* WT = (float*)(p.ws + (ALT ? WS_ACT + (size_t)4 * 1024 * 1024 : WS_WT));
    float* RSTD = (float*)(p.ws + (ALT ? WS_ACT + (size_t)5 * 1024 * 1024 : WS_RSTD));
    int* LIST = (int*)(p.ws + (ALT ? WS_ACT : WS_LIST));
    float* RP = (float*)(p.ws + (ALT ? WS_ACT + (size_t)2 * 1024 * 1024 : WS_RP));
    int* CNT = (int*)(p.ws + WS_CNT) + (layer + (ALT ? 4 : 0)) * NEXP * CNT_STRIDE;
    const float* bg = p.in[26] + layer * 4; const float* be = p.in[28] + layer * NEXP;
    const char* const Xc = (const char*)(p.ws + WS_XB);
    const char* const Whc = (const char*)(p.ws + WS_WRT) + (size_t)layer * 2 * 48 * 1024 * 2; const char* const Wlc = Whc + 48 * 1024 * 2;
    for (int chunk = bid; chunk < NTOK / 64; chunk += nb) {
        __syncthreads();
        if (tid < 32) cntl[tid] = 0;
        const unsigned xoff = (unsigned)(((chunk * 64 + fr) * D + w * 128 + fq * 8) * 2), woff = (unsigned)((fr * 1024 + w * 128 + fq * 8) * 2);
        f32x4 acc[4][3];
#pragma unroll
        for (int mt = 0; mt < 4; ++mt)
#pragma unroll
            for (int nt = 0; nt < 3; ++nt) acc[mt][nt] = (f32x4){0.f, 0.f, 0.f, 0.f};
        float ssq[4] = {0.f, 0.f, 0.f, 0.f};
#pragma unroll 1
        for (int st = 0; st < 4; ++st) {
            u32x4 xa[4]; bf16x8 Bh[3], Bl[3];
#pragma unroll
            for (int mt = 0; mt < 4; ++mt) xa[mt] = *(const u32x4*)(Xc + (xoff + (unsigned)(mt * 16 * D * 2 + st * 64)));
#pragma unroll
            for (int nt = 0; nt < 3; ++nt) { Bh[nt] = *(const bf16x8*)(Whc + (woff + (unsigned)(nt * 16 * 2048 + st * 64))); Bl[nt] = *(const bf16x8*)(Wlc + (woff + (unsigned)(nt * 16 * 2048 + st * 64))); }
#pragma unroll
            for (int mt = 0; mt < 4; ++mt) {
                const u32x4 xb = xa[mt];
                const f32x4 x0 = {bflo(xb.x), bfhi(xb.x), bflo(xb.y), bfhi(xb.y)}, x1 = {bflo(xb.z), bfhi(xb.z), bflo(xb.w), bfhi(xb.w)};
                ssq[mt] += x0[0] * x0[0] + x0[1] * x0[1] + x0[2] * x0[2] + x0[3] * x0[3] + x1[0] * x1[0] + x1[1] * x1[1] + x1[2] * x1[2] + x1[3] * x1[3];
                u32x4 hi; hi.x = cvt_pk_bf16(x0[0], x0[1]); hi.y = cvt_pk_bf16(x0[2], x0[3]); hi.z = cvt_pk_bf16(x1[0], x1[1]); hi.w = cvt_pk_bf16(x1[2], x1[3]);
                u32x4 lo;
                lo.x = cvt_pk_bf16(x0[0] - bflo(hi.x), x0[1] - bfhi(hi.x)); lo.y = cvt_pk_bf16(x0[2] - bflo(hi.y), x0[3] - bfhi(hi.y));
                lo.z = cvt_pk_bf16(x1[0] - bflo(hi.z), x1[1] - bfhi(hi.z)); lo.w = cvt_pk_bf16(x1[2] - bflo(hi.w), x1[3] - bfhi(hi.w));
                const bf16x8 Ah = __builtin_bit_cast(bf16x8, hi), Al = __builtin_bit_cast(bf16x8, lo);
#pragma unroll
                for (int nt = 0; nt < 3; ++nt) {
                    acc[mt][nt] = __builtin_amdgcn_mfma_f32_16x16x32_bf16(Ah, Bh[nt], acc[mt][nt], 0, 0, 0);
                    acc[mt][nt] = __builtin_amdgcn_mfma_f32_16x16x32_bf16(Ah, Bl[nt], acc[mt][nt], 0, 0, 0);
                    acc[mt][nt] = __builtin_amdgcn_mfma_f32_16x16x32_bf16(Al, Bh[nt], acc[mt][nt], 0, 0, 0);
                }
            }
            __builtin_amdgcn_sched_barrier(0);
        }
#pragma unroll
        for (int mt = 0; mt < 4; ++mt) {
            float sq = ssq[mt]; sq += shx(sq, 16, lane); sq += shx(sq, 32, lane);
            if (fq == 0) ssql[w * 64 + mt * 16 + fr] = sq;
#pragma unroll
            for (int nt = 0; nt < 3; ++nt)
#pragma unroll
                for (int r = 0; r < 4; ++r) part[(w * 64 + mt * 16 + fq * 4 + r) * 49 + nt * 16 + fr] = acc[mt][nt][r];
        }
        __syncthreads();
        {
            const int tl = tid & 63;
            for (int j = tid >> 6; j < 36; j += 8) {
                float s = 0.f;
#pragma unroll
                for (int ww = 0; ww < 8; ++ww) s += part[(ww * 64 + tl) * 49 + j];
                lgl[tl * 37 + j] = s;
            }
        }
        __syncthreads();
        if (tid < 64) {
            const int tl = tid, tk = chunk * 64 + tl;
            float sq = 0.f;
#pragma unroll
            for (int ww = 0; ww < 8; ++ww) sq += ssql[ww * 64 + tl];
            const float rstd = rsqrtf(sq * (1.0f / 1024.0f) + EPS);
            float lg[36];
#pragma unroll
            for (int j = 0; j < 36; ++j) lg[j] = lgl[tl * 37 + j] * rstd;
            float g0 = lg[0] + bg[0], g1 = lg[1] + bg[1], g2 = lg[2] + bg[2], g3 = lg[3] + bg[3];
            int gs = 0; float gm = g0;
            if (g1 > gm) { gm = g1; gs = 1; } if (g2 > gm) { gm = g2; gs = 2; } if (g3 > gm) { gm = g3; gs = 3; }
            const float gden = __expf(g0 - gm) + __expf(g1 - gm) + __expf(g2 - gm) + __expf(g3 - gm);
            const float ggate = 1.0f / gden;
            float ev[8];
#pragma unroll
            for (int j = 0; j < 8; ++j) {
                const float a0 = lg[4 + j] + be[j], a1 = lg[12 + j] + be[8 + j], a2 = lg[20 + j] + be[16 + j], a3 = lg[28 + j] + be[24 + j];
                ev[j] = gs == 0 ? a0 : gs == 1 ? a1 : gs == 2 ? a2 : a3;
            }
            int i0 = 0; float v0 = ev[0];
#pragma unroll
            for (int j = 1; j < 8; ++j) if (ev[j] > v0) { v0 = ev[j]; i0 = j; }
            int i1 = -1; float v1 = -3.0e38f;
#pragma unroll
            for (int j = 0; j < 8; ++j) if (j != i0 && ev[j] > v1) { v1 = ev[j]; i1 = j; }
            const float e1 = __expf(v1 - v0), sden = 1.0f / (1.0f + e1);
            const int ea = gs * 8 + i0, eb = gs * 8 + i1;
            sel[2 * tl] = ea; posl[2 * tl] = atomicAdd(&cntl[ea], 1);
            sel[2 * tl + 1] = eb; posl[2 * tl + 1] = atomicAdd(&cntl[eb], 1);
            WT[2 * tk] = ggate * sden; WT[2 * tk + 1] = ggate * e1 * sden;
            RSTD[tk] = rstd; rsl[tl] = rstd;
        }
        __syncthreads();
        if (tid < 32) { const int c = cntl[tid]; basel[tid] = c > 0 ? atomicAdd(&CNT[tid * CNT_STRIDE], c) : 0; }
        __syncthreads();
        if (tid < 128) { const int e = sel[tid]; const size_t li = (size_t)e * NTOK + basel[e] + posl[tid]; LIST[li] = 128 * chunk + tid; RP[li] = rsl[tid >> 1]; }
    }
}

template <int MODE>
__device__ __forceinline__ void cvt_job(const float* __restrict__ src, bf16_t* __restrict__ dst, const int K, const int N, const int nmat,
                                        const size_t dst_mat_stride, const int bid, const int nb, const int wv, const float* __restrict__ kgain = nullptr, const int gshift = 0) {
    float* T = (float*)shm;
    const int tid = hidden_tid(wv);
    const int tk = K / 64, tn = N / 256, per = tk * tn, total = per * nmat;
    f32x4 v[8];
#define CVT_LOAD(t_) do { const int mat_ = (t_) / per, r_ = (t_) % per, k0_ = (r_ / tn) * 64, n0_ = (r_ % tn) * 256; \
        const float* s_ = src + (size_t)mat_ * K * N + (size_t)k0_ * N + n0_; \
        _Pragma("unroll") for (int i = 0; i < 8; ++i) v[i] = *(const f32x4*)(s_ + (size_t)((tid >> 6) + 8 * i) * N + (tid & 63) * 4); } while (0)
    if (bid < total) CVT_LOAD(bid);
    for (int t = bid; t < total; t += nb) {
        const int mat = t / per, r = t % per, k0 = (r / tn) * 64, n0 = (r % tn) * 256;
        bf16_t* d = dst + (size_t)mat * dst_mat_stride;
        if (kgain) {
#pragma unroll
            for (int i = 0; i < 8; ++i) v[i] *= kgain[(size_t)(mat >> gshift) * D + k0 + (tid >> 6) + 8 * i];
        }
        __syncthreads();
#pragma unroll
        for (int i = 0; i < 8; ++i) {
            float* q = T + ((tid >> 6) + 8 * i) * 257 + (tid & 63) * 4;
            q[0] = v[i][0]; q[1] = v[i][1]; q[2] = v[i][2]; q[3] = v[i][3];
        }
        __syncthreads();
        if (t + nb < total) CVT_LOAD(t + nb);
#pragma unroll
        for (int j = 0; j < 4; ++j) {
            const int n = (tid >> 3) + 64 * j, kc = (tid & 7) * 8;
            float e[8];
#pragma unroll
            for (int jj = 0; jj < 8; ++jj) e[jj] = T[(kc + jj) * 257 + n];
            u32x4 ov; ov.x = cvt_pk_bf16(e[0], e[1]); ov.y = cvt_pk_bf16(e[2], e[3]); ov.z = cvt_pk_bf16(e[4], e[5]); ov.w = cvt_pk_bf16(e[6], e[7]);
            const int ng = n0 + n;
            const int row = (MODE == 0) ? ng : ((ng >> 4) * 32 + (ng & 15) + (MODE == 2 ? 16 : 0));
            *(u32x4*)(d + (size_t)row * K + k0 + kc) = ov;
        }
    }
#undef CVT_LOAD
}

__device__ __forceinline__ void prologue0(const Params& p, const int bid, const int nb, const int wv) {
    unsigned char* ws = p.ws;
    cvt_job<0>(p.in[3], (bf16_t*)(ws + WS_W_EIN), 1024, 3072, 2, (size_t)3072 * 1024, bid, nb, wv, p.in[2]);
    cvt_job<0>(p.in[15], (bf16_t*)(ws + WS_W_EOUT), 1024, 1024, 2, (size_t)1024 * 1024, bid, nb, wv);
    cvt_job<0>(p.in[17], (bf16_t*)(ws + WS_W_OIN), 1024, 1536, 2, (size_t)1536 * 1024, bid, nb, wv, p.in[16]);
    cvt_job<0>(p.in[19], (bf16_t*)(ws + WS_W_OOUT), 1024, 1024, 2, (size_t)1024 * 1024, bid, nb, wv);
    cvt_job<0>(p.in[21], (bf16_t*)(ws + WS_W_CQ), 1024, 512, 4, (size_t)512 * 1024, bid, nb, wv, p.in[20]);
    cvt_job<0>(p.in[22], (bf16_t*)(ws + WS_W_CKV), 1024, 1024, 4, (size_t)1024 * 1024, bid, nb, wv);
    cvt_job<0>(p.in[23], (bf16_t*)(ws + WS_W_CO), 512, 1024, 4, (size_t)1024 * 512, bid, nb, wv);
    cvt_job<1>(p.in[29], (bf16_t*)(ws + WS_W_GU), 1024, 512, 128, (size_t)1024 * 1024, bid, nb, wv, p.in[24], 5);
    cvt_job<2>(p.in[30], (bf16_t*)(ws + WS_W_GU), 1024, 512, 128, (size_t)1024 * 1024, bid, nb, wv, p.in[24], 5);
    cvt_job<0>(p.in[31], (bf16_t*)(ws + WS_W_DN), 512, 1024, 128, (size_t)1024 * 512, bid, nb, wv);
    const int tid = hidden_tid(wv), lane = tid & 63, w = tid >> 6;
    {
        Row16 g; ld_row(g, p.in[32], lane);
        bf16_t* MN = (bf16_t*)(ws + WS_MEMN);
        for (int r = bid * 8 + w; r < Bb * MEM; r += nb * 8) {
            Row16 x; ld_row(x, p.in[1] + (size_t)r * D, lane);
            const float rstd = row_rstd(x, lane);
#pragma unroll
            for (int i = 0; i < 4; ++i) st_bf16x4(MN + (size_t)r * D + 256 * i + 4 * lane, x.v[i] * rstd * g.v[i]);
        }
    }
    {
        float* A2 = (float*)(ws + WS_A2);
        for (int r = bid * 8 + w; r < 2 * S; r += nb * 8) {
            const int lj = r / S, pos = r % S;
            const float* w1 = p.in[6] + (size_t)lj * 33 * 64; const float* b1 = p.in[7] + lj * 64;
            const float* w2 = p.in[8] + (size_t)lj * 64 * 64; const float* b2 = p.in[9] + lj * 64;
            const float fr_ = p.in[11][lj * 64 + lane];
            float a = ((float)pos / 2047.0f) * w1[lane];
#pragma unroll 1
            for (int k = 0; k < 16; ++k) {
                const float band = 1e-4f + (float)k * ((15.0f - 1e-4f) / 15.0f);
                const float ang = band * (6.283185307179586f * (float)pos / 2048.0f);
                a += cosf(ang) * w1[(1 + k) * 64 + lane] - sinf(ang) * w1[(17 + k) * 64 + lane];
            }
            const float a1 = sinf(fr_ * (a + b1[lane]));
            float a2 = 0.f;
#pragma unroll 1
            for (int i = 0; i < 64; ++i) a2 += shl(a1, i) * w2[i * 64 + lane];
            A2[(size_t)r * 64 + lane] = sinf(fr_ * (a2 + b2[lane]));
        }
    }
    {
        bf16_t* WR = (bf16_t*)(ws + WS_WRT);
        for (int i = bid * NT + tid; i < 4 * 48 * 1024; i += nb * NT) {
            const int l = i / (48 * 1024), r = i % (48 * 1024), j = r >> 10, k = r & 1023;
            float v = 0.f;
            if (j < 4) v = p.in[25][((size_t)l * D + k) * 4 + j]; else if (j < 36) v = p.in[27][((size_t)l * D + k) * NEXP + (j - 4)];
            v *= p.in[24][(size_t)l * D + k];
            const unsigned h = cvt_pk_bf16(v, 0.f) & 0xffffu;
            const unsigned lo = cvt_pk_bf16(v - bflo(h), 0.f) & 0xffffu;
            WR[(size_t)l * 2 * 48 * 1024 + r] = (bf16_t)h; WR[(size_t)l * 2 * 48 * 1024 + 48 * 1024 + r] = (bf16_t)lo;
        }
    }
    if (bid == 0) {
        if (tid < 2) {
            const float* lm = p.in[13] + (size_t)tid * 4 * 64;
            float s01 = 0.f, s23 = 0.f;
            for (int i = 0; i < 64; ++i) { s01 += lm[i] * lm[64 + i]; s23 += lm[128 + i] * lm[192 + i]; }
            const float lam_init = 0.8f - 0.6f * expf(-0.3f * (float)(2 * tid));
            ((float*)(ws + WS_MISC))[tid] = expf(s01) - expf(s23) + lam_init;
            ((float*)(ws + WS_MISC))[2 + tid] = 1.0f - lam_init;
        }
        bf16_t* hz = (bf16_t*)(ws + WS_XB) + (size_t)NTOK * D; bf16_t* az = (bf16_t*)(ws + WS_ACT) + (size_t)2 * NTOK * EH;
        for (int i = tid; i < D; i += NT) hz[i] = 0;
        for (int i = tid; i < EH; i += NT) az[i] = 0;
    }
}

__device__ __forceinline__ void filter_taps(const Params& p, const int bid, const int nb, const int wv) {
    const int tid = hidden_tid(wv), w = tid >> 6, lane = tid & 63, fr = lane & 15, fq = lane >> 4;
    const float* A2 = (const float*)(p.ws + WS_A2);
    bf16_t* FL = (bf16_t*)(p.ws + WS_FILT);
    const float mind = logf(1e-2f) / 1.5f, maxd = logf(1e-2f) / 0.3f;
    for (int job = bid; job < 2 * 4 * 8 * 32; job += nb) {
        const int pt = job & 31, ct = (job >> 5) & 7, od = (job >> 8) & 3, lj = job >> 10;
        const int pos0 = pt * 64 + (w >> 2) * 32, ch0 = ct * 64 + (w & 3) * 16, order = od >> 1, dir = od & 1;
        const float* w3 = p.in[10] + (size_t)lj * 64 * 2048 + od * 512 + ch0 + fr;
        bf16x8 Af[2], Bf[2][2];
#pragma unroll
        for (int ks = 0; ks < 2; ++ks) {
            float e[8];
#pragma unroll
            for (int jj = 0; jj < 8; ++jj) e[jj] = w3[(size_t)(ks * 32 + fq * 8 + jj) * 2048];
            u32x4 pk; pk.x = cvt_pk_bf16(e[0], e[1]); pk.y = cvt_pk_bf16(e[2], e[3]); pk.z = cvt_pk_bf16(e[4], e[5]); pk.w = cvt_pk_bf16(e[6], e[7]);
            Af[ks] = __builtin_bit_cast(bf16x8, pk);
#pragma unroll
            for (int nt = 0; nt < 2; ++nt) {
                const float* ap = A2 + ((size_t)lj * S + pos0 + nt * 16 + fr) * 64 + ks * 32 + fq * 8;
                const f32x4 v0 = *(const f32x4*)ap, v1 = *(const f32x4*)(ap + 4);
                u32x4 pb; pb.x = cvt_pk_bf16(v0[0], v0[1]); pb.y = cvt_pk_bf16(v0[2], v0[3]); pb.z = cvt_pk_bf16(v1[0], v1[1]); pb.w = cvt_pk_bf16(v1[2], v1[3]);
                Bf[nt][ks] = __builtin_bit_cast(bf16x8, pb);
            }
        }
#pragma unroll
        for (int nt = 0; nt < 2; ++nt) {
            f32x4 acc = {0.f, 0.f, 0.f, 0.f};
            acc = __builtin_amdgcn_mfma_f32_16x16x32_bf16(Af[0], Bf[nt][0], acc, 0, 0, 0);
            acc = __builtin_amdgcn_mfma_f32_16x16x32_bf16(Af[1], Bf[nt][1], acc, 0, 0, 0);
            const int pos = pos0 + nt * 16 + fr;
            const float tpos = (float)pos / 2047.0f;
#pragma unroll
            for (int r = 0; r < 4; ++r) {
                const int ch = ch0 + fq * 4 + r;
                const float delta = mind + (float)ch * ((maxd - mind) / 511.0f);
                const float v = acc[r] * __builtin_amdgcn_exp2f(-tpos * fabsf(delta) * 1.4426950408889634f);
                bf16_t* f = FL + ((size_t)(lj * 2 + order) * 512 + ch) * 4096;
                const unsigned short hv = (unsigned short)(cvt_pk_bf16(v, 0.f) & 0xffff);
                if (dir == 0) f[2047 - pos] = hv;
                else { if (pos >= 1) f[2047 + pos] = hv; if (pos == 2047) f[4095] = 0; }
            }
        }
    }
}

enum { PH_P0 = 0, PH_P1, PH_N1, PH_GIN, PH_MIX, PH_GOUT, PH_N2, PH_GQ, PH_XATT, PH_GO, PH_ROUTE, PH_G1, PH_G2, PH_FINAL, PH_TR, PH_COUNT };

template <class Epi>
__device__ __forceinline__ void gemm_dense(const bf16_t* A, const bf16_t* Bt, const int K, const int nM, const int nN, Epi epi, const int bid, const int nb, const int wv) {
    for (int u = bid; u < nM * nN; u += nb) {
        const int pm = u / nN, pn = u % nN;
        epi.brow = pm * 256;
        gemm_tile(A + (size_t)pm * 256 * K, Bt, K, pn * 256, RowIdent{}, epi, wv);
    }
}

typedef const __attribute__((address_space(4))) Params* ParamsK;
#define PHASE_FN __forceinline__
template <int PH, bool ALT = false>
__device__ PHASE_FN void run_phase(ParamsK pk_, const int layer, const int bid_, const int nb_, const int wv_) {
    ParamsK pk = pk_; asm volatile("" : "+s"(pk));
    int bid = bid_, nb = nb_, wv = wv_; asm volatile("" : "+s"(bid), "+s"(nb), "+s"(wv));
    const Params& p = *(const Params*)pk;
    unsigned char* ws = p.ws;
    const int lj = layer >> 1; const bool even = (layer & 1) == 0;
    bf16_t* H = (bf16_t*)(ws + WS_H);
    float* X = (float*)(ws + WS_X);
    bf16_t* YMIX = (bf16_t*)(ws + WS_YMIX);
    bf16_t* QX = (bf16_t*)(ws + WS_QX);
    bf16_t* OX = (bf16_t*)(ws + WS_OX);
    if constexpr (PH == PH_P0) { prologue0(p, bid, nb, wv); }
    if constexpr (PH == PH_N1) {
        norm_phase<0, ALT>(p, layer, nullptr, bid, nb, wv);
        if (layer == 0 && !ALT) filter_taps(p, bid, nb, wv);
    }
    if constexpr (PH == PH_GIN) {
        const bf16_t* XBc = (const bf16_t*)(ws + WS_XB); const float* RS1 = (const float*)(ws + WS_RS1);
        if (even) {
            EpiSplit e{(bf16_t*)(ws + WS_PROJ + PR_HYT), (bf16_t*)(ws + WS_PROJ + PR_QK), (bf16_t*)(ws + WS_PROJ + PR_VT), 1536, 2560, 1024, (size_t)NTOK, 0, RS1};
            gemm_dense(XBc, (const bf16_t*)(ws + WS_W_EIN) + (size_t)lj * 3072 * 1024, 1024, 64, 12, e, bid, nb, wv);
        } else {
            EpiSplit e{nullptr, (bf16_t*)(ws + WS_PROJ), (bf16_t*)(ws + WS_PROJ + PR_OVT), 0, 1280, 1280, (size_t)NTOK, 0, RS1};
            gemm_dense(XBc, (const bf16_t*)(ws + WS_W_OIN) + (size_t)lj * 1536 * 1024, 1024, 64, 6, e, bid, nb, wv);
        }
    }
    if constexpr (PH == PH_MIX) {
        if (even) {
            const bf16_t* qk = (const bf16_t*)(ws + WS_PROJ + PR_QK);
            const bf16_t* vT = (const bf16_t*)(ws + WS_PROJ + PR_VT);
            const float lam = uni(((const float*)(ws + WS_MISC))[lj]);
            const float oscale = uni(((const float*)(ws + WS_MISC))[2 + lj]);
            for (int u = bid + ((ALT && (DUPSEL == 4 || DUPSEL >= 7)) ? 512 : 0); u < ((ALT && (DUPSEL == 3 || DUPSEL == 5 || DUPSEL == 6)) ? 512 : 1024); u += nb) {
                if (u < 512) hyena_unit<ALT>(p, lj, u, wv);
                else {
                    const int id = u - 512, b = id >> 6, h = (id >> 4) & 3, qb = id & 15;
                    attn_unit<0, ALT>(qk + (size_t)(b * S) * 1024 + 2 * h * 64, 1024, qk + (size_t)(b * S) * 1024 + 512 + 2 * h * 64, 1024,
                                 vT + (size_t)(h * 128) * NTOK + b * S, (size_t)NTOK, qb * 128, 0, S,
                                 0.125f, uni(exp2f(-2.0f * (float)(h + 1))), -1e30f, 0.f,
                                 (ALT ? (bf16_t*)(ws + WS_Y) : YMIX) + (size_t)(b * S) * D + 512 + h * 128, D, lam, oscale, p.in[14] + (size_t)lj * 128, wv);
                }
            }
        } else {
            const bf16_t* qk = (const bf16_t*)(ws + WS_PROJ);
            const bf16_t* vT = (const bf16_t*)(ws + WS_PROJ + PR_OVT);
            for (int u = bid; u < 2048; u += nb) {
                const int b = u >> 8, hq = (u >> 4) & 15, qb = u & 15, kv = hq >> 2, q0 = qb * 128;
                const int kbeg = q0 - 128 < 0 ? 0 : q0 - 128, kend = q0 + 256 > S ? S : q0 + 256;
                attn_unit<1>(qk + (size_t)(b * S) * 1280 + hq * 64, 1280, qk + (size_t)(b * S) * 1280 + 1024 + kv * 64, 1280,
                             vT + (size_t)(kv * 64) * NTOK + b * S, (size_t)NTOK, q0, kbeg, kend,
                             0.125f, uni(exp2f(-0.5f * (float)(hq + 1))), uni(p.in[18][lj * 16 + hq]), 1.0f,
                             YMIX + (size_t)(b * S) * D + hq * 64, D, 0.f, 1.f, nullptr, wv);
            }
        }
    }
    if constexpr (PH == PH_TR) {
        const int tid = hidden_tid(wv);
        const bf16_t* yt = (const bf16_t*)(ws + WS_QX);
        bf16_t* T = shm;
        for (int t = bid; t < 8 * 256; t += nb) {
            const int c0 = (t & 7) * 64, tk0 = (t >> 3) * 64;
            const u32x4 v = *(const u32x4*)(yt + (size_t)(c0 + (tid >> 3)) * NTOK + tk0 + (tid & 7) * 8);
            __syncthreads();
            *(u32x4*)((char*)T + (tid >> 3) * 144 + (tid & 7) * 16) = v;
            __syncthreads();
            const int tok = tid >> 3, cg = (tid & 7) * 8;
            unsigned short e[8];
#pragma unroll
            for (int j = 0; j < 8; ++j) e[j] = T[(cg + j) * 72 + tok];
            u32x4 ov; ov.x = e[0] | ((unsigned)e[1] << 16); ov.y = e[2] | ((unsigned)e[3] << 16); ov.z = e[4] | ((unsigned)e[5] << 16); ov.w = e[6] | ((unsigned)e[7] << 16);
            *(u32x4*)(YMIX + (size_t)(tk0 + tok) * D + c0 + cg) = ov;
        }
    }
    if constexpr (PH == PH_GOUT) {
        EpiRes e{(bf16_t*)(ws + (ALT ? WS_Y : WS_XB)), 0, (float*)(ws + WS_SSP), hidden_tid(wv) & 63};
        gemm_dense(YMIX, (const bf16_t*)(ws + (even ? WS_W_EOUT : WS_W_OOUT)) + (size_t)lj * 1024 * 1024, 1024, 64, 4, e, bid, nb, wv);
    }
    if constexpr (PH == PH_GQ) {
        for (int u = bid; u < 128 + 32; u += nb) {
            if (u < 128) {
                const int pm = u >> 1, pn = u & 1;
                EpiTokRstd e{QX, 512, pm * 256, (const float*)(ws + WS_SSP), hidden_tid(wv) & 63};
                gemm_tile((const bf16_t*)(ws + WS_XB) + (size_t)pm * 256 * 1024, (const bf16_t*)(ws + WS_W_CQ) + (size_t)layer * 512 * 1024, 1024, pn * 256, RowIdent{}, e, wv);
            } else {
                const int v = u - 128, pm = v >> 2, pn = v & 3;
                EpiSplit e{nullptr, (bf16_t*)(ws + WS_XK) + (size_t)layer * 2048 * 512, (bf16_t*)(ws + WS_XVT) + (size_t)layer * 512 * 2048, 0, 512, 512, (size_t)2048, pm * 256, nullptr};
                gemm_tile((const bf16_t*)(ws + WS_MEMN) + (size_t)pm * 256 * 1024, (const bf16_t*)(ws + WS_W_CKV) + (size_t)layer * 1024 * 1024, 1024, pn * 256, RowIdent{}, e, wv);
            }
        }
    }
    if constexpr (PH == PH_XATT) {
        const bf16_t* xk = (const bf16_t*)(ws + WS_XK) + (size_t)layer * 2048 * 512;
        const bf16_t* xvt = (const bf16_t*)(ws + WS_XVT) + (size_t)layer * 512 * 2048;
        for (int u = bid; u < 512; u += nb) {
            const int b = u >> 6, h = (u >> 4) & 3, qb = u & 15;
            attn_unit<2>(QX + (size_t)(b * S) * 512 + h * 128, 512, xk + (size_t)(b * MEM) * 512 + h * 128, 512,
                         xvt + (size_t)(h * 128) * 2048 + b * MEM, (size_t)2048, qb * 128, 0, MEM,
                         0.08838834764831845f, 0.f, -1e30f, 0.f, OX + (size_t)(b * S) * 512 + h * 128, 512, 0.f, 1.f, nullptr, wv);
        }
    }
    if constexpr (PH == PH_GO) {
        EpiRes e{(bf16_t*)(ws + (ALT ? WS_Y : WS_XB)), 0, nullptr, hidden_tid(wv) & 63};
        gemm_dense(OX, (const bf16_t*)(ws + WS_W_CO) + (size_t)layer * 1024 * 512, 512, 64, 4, e, bid, nb, wv);
    }
    if constexpr (PH == PH_ROUTE) { route_phase<ALT>(p, layer, bid, nb, wv); }
    if constexpr (PH == PH_G1) {
        const int* CNT = (const int*)(ws + WS_CNT) + layer * NEXP * CNT_STRIDE;
        const int* LIST = (const int*)(ws + WS_LIST);
        unsigned* head = (unsigned*)(ws + WS_QHEAD) + layer * 64;
        unsigned* done = (unsigned*)(ws + WS_DONE) + layer * 32 * 64;
        int* uq = (int*)((char*)shm + LDS_ROUTE + 1024);
        const int tid = hidden_tid(wv);
        int total = 0;
        for (int e = 0; e < NEXP; ++e) total += (CNT[e * CNT_STRIDE] + 255) >> 8;
        total = __builtin_amdgcn_readfirstlane(total) * 4;
        for (;;) {
            __syncthreads();
            if (tid == 0) *uq = (int)__hip_atomic_fetch_add(head, 1u, __ATOMIC_RELAXED, __HIP_MEMORY_SCOPE_AGENT);
            __syncthreads();
            const int uall = __builtin_amdgcn_readfirstlane(*uq);
            if (uall >= 2 * total) break;
            const bool second = uall >= total;
            const int u = second ? uall - total : uall;
            int e = 0, base = 0, tl = 0, cnt = 0;
            for (; e < NEXP; ++e) { cnt = __builtin_amdgcn_readfirstlane(CNT[e * CNT_STRIDE]); tl = (cnt + 255) >> 8; if (u < base + tl * 4) break; base += tl * 4; }
            const int r = u - base, pn = r / tl, pm = r % tl;
            const int* list = LIST + (size_t)e * NTOK;
            if (!second) {
                EpiGateUp ep{(bf16_t*)(ws + WS_ACT), list, cnt, pm * 256, (const float*)(ws + WS_RP) + (size_t)e * NTOK};
                gemm_tile((const bf16_t*)(ws + WS_XB), (const bf16_t*)(ws + WS_W_GU) + ((size_t)layer * NEXP + e) * 1024 * 1024, 1024, pn * 256, RowTok{list, cnt, pm * 256}, ep, wv);
                asm volatile("s_waitcnt vmcnt(0)" ::: "memory");
                if ((hidden_tid(wv) & 63) == 0) (void)__hip_atomic_fetch_add(done + e * 64 + pm, 1u, __ATOMIC_RELAXED, __HIP_MEMORY_SCOPE_AGENT);
            } else {
                if (tid < 64) {
                    unsigned spins = 0;
                    while ((unsigned)__builtin_amdgcn_readfirstlane(__hip_atomic_load(done + e * 64 + pm, __ATOMIC_RELAXED, __HIP_MEMORY_SCOPE_AGENT)) < 32u) {
                        __builtin_amdgcn_s_sleep(2);
                        if (++spins > (1u << 24)) break;
                    }
                    __builtin_amdgcn_fence(__ATOMIC_ACQUIRE, "agent");
                    asm volatile("s_waitcnt vmcnt(0)" ::: "memory");
                }
                __syncthreads();
                EpiDown ep{(bf16_t*)(ws + WS_Y), list, cnt, pm * 256};
                gemm_tile((const bf16_t*)(ws + WS_ACT), (const bf16_t*)(ws + WS_W_DN) + ((size_t)layer * NEXP + e) * 1024 * 512, 512, pn * 256, RowAsg{list, cnt, pm * 256}, ep, wv);
            }
        }
    }
    if constexpr (PH == PH_FINAL) { norm_phase<2>(p, DEPTH, p.in[33], bid, nb, wv); }
}

#if ONE_LAUNCH
__global__ void __launch_bounds__(NT, 2) k_mega(Params p_) {
    ParamsK p = (ParamsK)__builtin_amdgcn_kernarg_segment_ptr();
    volatile LAS unsigned* st = (volatile LAS unsigned*)((char*)shm + LDS_XB);
    if (threadIdx.x < 4) st[threadIdx.x] = 0u;
    __syncthreads();
    const XcdBarrier bar = xcd_barrier_post((unsigned*)(p->ws + WS_BAR), st);
    const int bid = blockIdx.x, nb = gridDim.x, wv = __builtin_amdgcn_readfirstlane(threadIdx.x >> 6);
    run_phase<PH_P0>(p, 0, bid, nb, wv); xcd_barrier(bar); if (DUP == PH_P0) { run_phase<PH_P0, true>(p, 0, bid, nb, wv); xcd_barrier(bar); }
#pragma unroll 1
    for (int layer = 0; layer < DEPTH; ++layer) {
        run_phase<PH_N1>(p, layer, bid, nb, wv); xcd_barrier(bar); if (DUP == PH_N1) { run_phase<PH_N1, true>(p, layer, bid, nb, wv); xcd_barrier(bar); }
        run_phase<PH_GIN>(p, layer, bid, nb, wv); xcd_barrier(bar); if (DUP == PH_GIN) { run_phase<PH_GIN, true>(p, layer, bid, nb, wv); xcd_barrier(bar); }
        run_phase<PH_MIX>(p, layer, bid, nb, wv); xcd_barrier(bar); if (DUP == PH_MIX && (DUPSEL == 0 || (DUPSEL != 2 && (layer & 1) == 0) || (DUPSEL == 2 && (layer & 1) == 1))) { run_phase<PH_MIX, true>(p, layer, bid, nb, wv); xcd_barrier(bar); }
        if ((layer & 1) == 0) { run_phase<PH_TR>(p, layer, bid, nb, wv); xcd_barrier(bar); }
        run_phase<PH_GOUT>(p, layer, bid, nb, wv); xcd_barrier(bar); if (DUP == PH_GOUT) { run_phase<PH_GOUT, true>(p, layer, bid, nb, wv); xcd_barrier(bar); }
        run_phase<PH_GQ>(p, layer, bid, nb, wv); xcd_barrier(bar); if (DUP == PH_GQ) { run_phase<PH_GQ, true>(p, layer, bid, nb, wv); xcd_barrier(bar); }
        run_phase<PH_XATT>(p, layer, bid, nb, wv); xcd_barrier(bar); if (DUP == PH_XATT) { run_phase<PH_XATT, true>(p, layer, bid, nb, wv); xcd_barrier(bar); }
        run_phase<PH_GO>(p, layer, bid, nb, wv); xcd_barrier(bar); if (DUP == PH_GO) { run_phase<PH_GO, true>(p, layer, bid, nb, wv); xcd_barrier(bar); }
        run_phase<PH_ROUTE>(p, layer, bid, nb, wv); xcd_barrier(bar); if (DUP == PH_ROUTE) { run_phase<PH_ROUTE, true>(p, layer, bid, nb, wv); xcd_barrier(bar); }
        run_phase<PH_G1>(p, layer, bid, nb, wv); xcd_barrier(bar); if (DUP == PH_G1) { run_phase<PH_G1, true>(p, layer, bid, nb, wv); xcd_barrier(bar); }
    }
    run_phase<PH_FINAL>(p, DEPTH, bid, nb, wv);
}
#else
template <int PH>
__global__ void __launch_bounds__(NT, 2) k_phase(Params p_, int layer) {
    run_phase<PH>((ParamsK)__builtin_amdgcn_kernarg_segment_ptr(), layer, blockIdx.x, gridDim.x, __builtin_amdgcn_readfirstlane(threadIdx.x >> 6));
}
template <int PH> static void launch_phase(const Params& p, int layer, int grid, hipStream_t stream) {
    static bool init = false;
    if (!init) { (void)hipFuncSetAttribute((const void*)k_phase<PH>, hipFuncAttributeMaxDynamicSharedMemorySize, LDS_BYTES); init = true; }
    hipLaunchKernelGGL(k_phase<PH>, dim3(grid), dim3(NT), LDS_BYTES, stream, p, layer);
}
#endif

extern "C" void kernel_launch(void* const* d_in, const int* in_sizes, int n_in, void* d_out, int out_size, void* d_ws, size_t ws_size, hipStream_t stream) {
    if (n_in != 34 || ws_size < WS_END) { fprintf(stderr, "kernel_launch: unexpected n_in %d or ws_size %zu (need %zu)\n", n_in, ws_size, (size_t)WS_END); return; }
    Params p{};
    for (int i = 0; i < 34; ++i) p.in[i] = (const float*)d_in[i];
    p.out = (float*)d_out; p.ws = (unsigned char*)d_ws;
    (void)hipMemsetAsync(d_ws, 0, WS_ZERO_BYTES, stream);
#if ONE_LAUNCH
    static int grid = 0;
    if (grid == 0) {
        int dev = 0, cus = 0, per_cu = 0;
        (void)hipGetDevice(&dev); (void)hipDeviceGetAttribute(&cus, hipDeviceAttributeMultiprocessorCount, dev);
        (void)hipFuncSetAttribute((const void*)k_mega, hipFuncAttributeMaxDynamicSharedMemorySize, LDS_BYTES);
        (void)hipOccupancyMaxActiveBlocksPerMultiprocessor(&per_cu, (const void*)k_mega, NT, LDS_BYTES);
        (void)hipGetLastError();
        grid = cus > 0 ? cus : 256;
    }
    hipLaunchKernelGGL(k_mega, dim3(grid), dim3(NT), LDS_BYTES, stream, p);
#else
    const int grid = 256;
    launch_phase<PH_P0>(p, 0, grid, stream);
    for (int layer = 0; layer < DEPTH; ++layer) {
        launch_phase<PH_N1>(p, layer, grid, stream);
        launch_phase<PH_GIN>(p, layer, grid, stream);
        launch_phase<PH_MIX>(p, layer, grid, stream);
        if ((layer & 1) == 0) launch_phase<PH_TR>(p, layer, grid, stream);
        launch_phase<PH_GOUT>(p, layer, grid, stream);
        launch_phase<PH_GQ>(p, layer, grid, stream);
        launch_phase<PH_XATT>(p, layer, grid, stream);
        launch_phase<PH_GO>(p, layer, grid, stream);
        launch_phase<PH_ROUTE>(p, layer, grid, stream);
        launch_phase<PH_G1>(p, layer, grid, stream);
    }
    launch_phase<PH_FINAL>(p, DEPTH, grid, stream);
#endif
}
```

```cpp
#include <hip/hip_runtime.h>
#include <stdint.h>
#include <stdio.h>

#ifndef RD_N
#define RD_N 1
#endif
#ifndef RD_E
#define RD_E 1
#endif
#ifndef RD_R
#define RD_R 1
#endif
#ifndef DUP
#define DUP -1
#endif
#ifndef DUPSEL
#define DUPSEL 0
#endif
#ifndef ONE_LAUNCH
#define ONE_LAUNCH 1
#endif

typedef unsigned short bf16_t;
typedef short bf16x8 __attribute__((ext_vector_type(8)));
typedef float f32x4 __attribute__((ext_vector_type(4)));
typedef unsigned u32x4 __attribute__((ext_vector_type(4)));
typedef unsigned u32x2 __attribute__((ext_vector_type(2)));

constexpr int Bb = 8, S = 2048, D = 1024, NTOK = Bb * S, DEPTH = 4, MEM = 256;
constexpr int NEXP = 32, EH = 512;
constexpr int NT = 512;
constexpr float EPS = 1e-6f;

constexpr size_t al256(size_t x) { return (x + 255) & ~(size_t)255; }
constexpr size_t WS_BAR   = 0;
constexpr size_t WS_CNT   = 16384;
constexpr int    CNT_STRIDE = 64;
constexpr size_t WS_QHEAD = 16384 + 65536;
constexpr size_t WS_DONE  = WS_QHEAD + 4096;
constexpr size_t WS_ZERO_BYTES = WS_DONE + (size_t)4 * 32 * 64 * 4;
constexpr size_t WS_MISC  = WS_ZERO_BYTES;
constexpr size_t WS_W_EIN = 131072;
constexpr size_t WS_W_EOUT = WS_W_EIN + (size_t)2 * 3072 * 1024 * 2;
constexpr size_t WS_W_OIN = WS_W_EOUT + (size_t)2 * 1024 * 1024 * 2;
constexpr size_t WS_W_OOUT = WS_W_OIN + (size_t)2 * 1536 * 1024 * 2;
constexpr size_t WS_W_CQ  = WS_W_OOUT + (size_t)2 * 1024 * 1024 * 2;
constexpr size_t WS_W_CKV = WS_W_CQ + (size_t)4 * 512 * 1024 * 2;
constexpr size_t WS_W_CO  = WS_W_CKV + (size_t)4 * 1024 * 1024 * 2;
constexpr size_t WS_W_GU  = WS_W_CO + (size_t)4 * 1024 * 512 * 2;
constexpr size_t WS_W_DN  = WS_W_GU + (size_t)4 * 32 * 1024 * 1024 * 2;
constexpr size_t WS_MEMN  = WS_W_DN + (size_t)4 * 32 * 1024 * 512 * 2;
constexpr size_t WS_XK    = WS_MEMN + (size_t)2048 * 1024 * 2;
constexpr size_t WS_XVT   = WS_XK + (size_t)4 * 2048 * 512 * 2;
constexpr size_t WS_A2    = WS_XVT + (size_t)4 * 2048 * 512 * 2;
constexpr size_t WS_FILT  = WS_A2 + (size_t)2 * 2048 * 64 * 4;
constexpr size_t WS_X     = WS_FILT + (size_t)2 * 2 * 512 * 4096 * 2;
constexpr size_t WS_H     = WS_X + (size_t)NTOK * D * 4;
constexpr size_t WS_PROJ  = WS_H + al256((size_t)(NTOK + 1) * D * 2);
constexpr size_t WS_YMIX  = WS_PROJ + (size_t)NTOK * 3072 * 2;
constexpr size_t WS_QX    = WS_YMIX + (size_t)NTOK * D * 2;
constexpr size_t WS_OX    = WS_QX + (size_t)NTOK * 512 * 2;
constexpr size_t WS_ACT   = WS_OX + (size_t)NTOK * 512 * 2;
constexpr size_t WS_Y     = WS_ACT + al256((size_t)(2 * NTOK + 1) * EH * 2);
constexpr size_t WS_LIST  = WS_Y + (size_t)2 * NTOK * D * 2;
constexpr size_t WS_WT    = WS_LIST + (size_t)NEXP * NTOK * 4;
constexpr size_t WS_RSTD  = WS_WT + (size_t)2 * NTOK * 4;
constexpr size_t WS_WRT   = WS_RSTD + (size_t)NTOK * 4;
constexpr size_t WS_XB    = WS_WRT + (size_t)4 * 2 * 48 * 1024 * 2;
constexpr size_t WS_SSP   = WS_XB + al256((size_t)(NTOK + 1) * D * 2);
constexpr size_t WS_RS1   = WS_SSP + (size_t)NTOK * 16 * 4;
constexpr size_t WS_RP    = WS_RS1 + (size_t)NTOK * 4;
constexpr size_t WS_END   = WS_RP + (size_t)NEXP * NTOK * 4;
constexpr size_t PR_HYT   = 0;
constexpr size_t PR_QK    = (size_t)1536 * NTOK * 2;
constexpr size_t PR_VT    = PR_QK + (size_t)NTOK * 1024 * 2;
constexpr size_t PR_OVT   = (size_t)NTOK * 1280 * 2;

constexpr int LDS_XB = 147456;
constexpr int LDS_ROUTE = LDS_XB + 64;
constexpr int LDS_BYTES = LDS_ROUTE + 2048;

struct Params {
    const float* in[34];
    float* out;
    unsigned char* ws;
};

extern __shared__ __attribute__((aligned(16))) bf16_t shm[];

typedef float f32x2 __attribute__((ext_vector_type(2)));
typedef __bf16 bf16x2v __attribute__((ext_vector_type(2)));
__device__ __forceinline__ unsigned cvt_pk_bf16(float lo, float hi) { const f32x2 v = {lo, hi}; return __builtin_bit_cast(unsigned, __builtin_convertvector(v, bf16x2v)); }
__device__ __forceinline__ float bf2f(unsigned short b) { return __uint_as_float((unsigned)b << 16); }
__device__ __forceinline__ float bflo(unsigned w) { return __uint_as_float(w << 16); }
__device__ __forceinline__ float bfhi(unsigned w) { return __uint_as_float(w & 0xffff0000u); }
__device__ __forceinline__ float shx(float v, int m, int lane) { return __int_as_float(__builtin_amdgcn_ds_bpermute((lane ^ m) << 2, __float_as_int(v))); }
__device__ __forceinline__ float shl(float v, int src) { return __int_as_float(__builtin_amdgcn_ds_bpermute(src << 2, __float_as_int(v))); }
__device__ __forceinline__ float wave_sum(float v, int lane) {
    v += shx(v, 1, lane); v += shx(v, 2, lane); v += shx(v, 4, lane); v += shx(v, 8, lane); v += shx(v, 16, lane); v += shx(v, 32, lane); return v;
}

__device__ __forceinline__ float uni(float x) { return __builtin_bit_cast(float, __builtin_amdgcn_readfirstlane(__builtin_bit_cast(int, x))); }
__device__ __forceinline__ int hidden_tid(int wv) { int l; asm volatile("v_mbcnt_lo_u32_b32 %0, -1, 0\n\tv_mbcnt_hi_u32_b32 %0, -1, %0" : "=&v"(l)); return (wv << 6) | l; }

#define XB_TMO      128
#define XB_XCNT(j)  (256  + 64 * (j))
#define XB_XSUB(j)  (1280 + 64 * (j))
#define XB_XGEN(j)  (2304 + 64 * (j))
#define XB_TOP      3328
#define XB_TOPGEN   3392
#define XCD_BAR_WORDS 3456
#define XB_SPIN_CAP (1u << 22)
#define LAS __attribute__((address_space(3)))

__device__ __forceinline__ unsigned xb_ld(unsigned* p)              { return __hip_atomic_load(p, __ATOMIC_RELAXED, __HIP_MEMORY_SCOPE_AGENT); }
__device__ __forceinline__ unsigned xb_add(unsigned* p, unsigned v) { return __hip_atomic_fetch_add(p, v, __ATOMIC_RELAXED, __HIP_MEMORY_SCOPE_AGENT); }
__device__ __forceinline__ unsigned xb_xcc_id() { return (unsigned)__builtin_amdgcn_s_getreg((3 << 11) | 20) & 0xFu; }
#define XB_SPIN(cond, bar) do { unsigned _sp = 0; while (cond) { __builtin_amdgcn_s_sleep(1); \
    if ((++_sp & 255u) == 0u) { if (xb_ld(&(bar)[XB_TMO])) break; if (_sp > XB_SPIN_CAP) { atomicAdd(&(bar)[XB_TMO], 1u); break; } } } } while (0)

struct XcdBarrier { unsigned* bar; unsigned x; volatile LAS unsigned* st; };

__device__ __forceinline__ XcdBarrier xcd_barrier_post(unsigned* bar, volatile LAS unsigned* st) {
    XcdBarrier b; b.bar = bar; b.x = xb_xcc_id(); b.st = st;
    if (threadIdx.x == 0) (void)xb_add(&bar[XB_XCNT(b.x)], 1u);
    return b;
}
__device__ __forceinline__ void xcd_barrier_complete(unsigned* bar, unsigned x, unsigned& nloc, unsigned& nx) {
    const unsigned G = gridDim.x * gridDim.y * gridDim.z;
    unsigned sum, cnt, mine, sp = 0u;
    for (;;) {
        sum = 0u; cnt = 0u; mine = 0u;
#pragma unroll
        for (unsigned j = 0; j < 16; ++j) { const unsigned c = xb_ld(&bar[XB_XCNT(j)]); sum += c; cnt += (c > 0u) ? 1u : 0u; mine = (j == x) ? c : mine; }
        if (sum == G) break;
        __builtin_amdgcn_s_sleep(1);
        if ((++sp & 255u) == 0u) { if (xb_ld(&bar[XB_TMO])) break; if (sp > XB_SPIN_CAP) { atomicAdd(&bar[XB_TMO], 1u); break; } }
    }
    nloc = mine > 0u ? mine : 1u; nx = cnt > 0u ? cnt : 1u;
}
__device__ __forceinline__ void xcd_barrier(const XcdBarrier& b) {
    asm volatile("s_waitcnt vmcnt(0)" ::: "memory");
    __syncthreads();
    if (threadIdx.x == 0) {
        unsigned* bar = b.bar; unsigned bx = b.x;
        asm volatile("" : "+s"(bar), "+s"(bx));
        __builtin_amdgcn_s_waitcnt(0);
        unsigned nloc = b.st[0], nx = b.st[1];
        if (nloc == 0u) { xcd_barrier_complete(bar, bx, nloc, nx); b.st[0] = nloc; b.st[1] = nx; }
        const unsigned old = xb_add(&bar[XB_XSUB(bx)], 1u);
        const unsigned gen = old / nloc;
        if (old + 1u == (gen + 1u) * nloc) {
            __builtin_amdgcn_fence(__ATOMIC_RELEASE, "agent");
            asm volatile("s_waitcnt vmcnt(0)" ::: "memory");
            const unsigned og = xb_add(&bar[XB_TOP], 1u);
            const unsigned tg = og / nx;
            if (og + 1u == (tg + 1u) * nx) xb_add(&bar[XB_TOPGEN], 1u);
            else XB_SPIN(xb_ld(&bar[XB_TOPGEN]) == tg, bar);
            __builtin_amdgcn_fence(__ATOMIC_ACQUIRE, "agent");
            xb_add(&bar[XB_XGEN(bx)], 1u);
            asm volatile("s_waitcnt vmcnt(0)" ::: "memory");
        } else {
            XB_SPIN(xb_ld(&bar[XB_XGEN(bx)]) == gen, bar);
            __builtin_amdgcn_fence(__ATOMIC_ACQUIRE, "agent");
            asm volatile("s_waitcnt vmcnt(0)" ::: "memory");
        }
    }
    __syncthreads();
}

constexpr int HT = 128 * 64;
__device__ __forceinline__ int lds_byte(int r, int c) {
    int st = (r >> 4) * 2 + (c >> 5), rr = r & 15, cc = c & 31, ob = rr * 64 + cc * 2;
    return st * 1024 + (ob ^ (((ob >> 9) & 1) << 5));
}
__device__ __forceinline__ void stage_rc(int b, int& R, int& C) {
    int st = b / 1024, sb = b % 1024, swz = sb ^ (((sb >> 9) & 1) << 5);
    R = (st >> 1) * 16 + swz / 64; C = (st & 1) * 32 + (swz % 64) / 2;
}
#define SA(b, h) (shm + ((b) * 2 + (h)) * HT)
#define SB(b, h) (shm + (4 + (b) * 2 + (h)) * HT)
#define G_STAGE_A(P_, h, kt) do { _Pragma("unroll") for (int _i = 0; _i < 2; ++_i) \
    __builtin_amdgcn_global_load_lds((const unsigned*)((const char*)A + (size_t)((kt) * 128 + (RowSrc::DENSE ? (h) * 256 * K : 0)) + aoff[RowSrc::DENSE ? 0 : (h)][_i]), (unsigned*)((char*)(P_) + tid * 16 + _i * 8192), 16, 0, 0); } while (0)
#define G_STAGE_B(P_, h, kt) do { _Pragma("unroll") for (int _i = 0; _i < 2; ++_i) \
    __builtin_amdgcn_global_load_lds((const unsigned*)((const char*)Bt + (size_t)((kt) * 128 + (h) * 64 * K) + boff[_i]), (unsigned*)((char*)(P_) + tid * 16 + _i * 8192), 16, 0, 0); } while (0)
#define G_LDA(dst, b, h) _Pragma("unroll") for (int m = 0; m < 4; ++m) _Pragma("unroll") for (int k = 0; k < 2; ++k) \
    dst[m][k] = *reinterpret_cast<const bf16x8*>((char*)SA(b, h) + lds_byte(wr * 64 + m * 16 + fr, k * 32 + fq * 8))
#define G_LDB(dst, b, h) _Pragma("unroll") for (int n = 0; n < 2; ++n) _Pragma("unroll") for (int k = 0; k < 2; ++k) \
    dst[n][k] = *reinterpret_cast<const bf16x8*>((char*)SB(b, h) + lds_byte(wc * 32 + n * 16 + fr, k * 32 + fq * 8))
#define G_MMA(ai, bj, At_, Bt_) do { __builtin_amdgcn_s_setprio(1); \
    _Pragma("unroll") for (int m = 0; m < 4; ++m) _Pragma("unroll") for (int n = 0; n < 2; ++n) _Pragma("unroll") for (int k = 0; k < 2; ++k) \
      acc[ai][bj][m][n] = __builtin_amdgcn_mfma_f32_16x16x32_bf16(Bt_[n][k], At_[m][k], acc[ai][bj][m][n], 0, 0, 0); \
    __builtin_amdgcn_s_setprio(0); } while (0)
#define WAIT_V(n) asm volatile("s_waitcnt vmcnt(" #n ")" ::: "memory")
#define WAIT_L(n) asm volatile("s_waitcnt lgkmcnt(" #n ")" ::: "memory")
#define BAR __builtin_amdgcn_s_barrier()
#define SCHED __builtin_amdgcn_sched_barrier(0)

typedef f32x4 AccT[2][2][4][2];

template <class RowSrc, class Epi>
__device__ __forceinline__ void gemm_tile(const bf16_t* __restrict__ A, const bf16_t* __restrict__ Bt, const int K,
                                          const int bcol, const RowSrc& rs, const Epi& epi, const int wv) {
    const int tid = hidden_tid(wv);
    int wid = tid >> 6, lane = tid & 63, wr = wid >> 2, wc = wid & 3, fr = lane & 15, fq = lane >> 4;
    unsigned aoff[2][2], boff[2];
#pragma unroll
    for (int i = 0; i < 2; ++i) {
        int R, C; stage_rc(tid * 16 + i * 8192, R, C);
        boff[i] = (unsigned)(((bcol + (R >> 5) * 64 + (R & 31)) * K + C) * 2);
        if (RowSrc::DENSE) { aoff[0][i] = (unsigned)((R * K + C) * 2); aoff[1][i] = 0u; }
        else {
#pragma unroll
            for (int h = 0; h < 2; ++h) aoff[h][i] = (unsigned)((rs(h * 128 + R) * K + C) * 2);
        }
    }
    WAIT_V(0);
    AccT acc = {};
    bf16x8 At[4][2], B0[2][2], B1[2][2];
    const int nt = K / 64;
    G_STAGE_B(SB(0, 0), 0, 0); G_STAGE_A(SA(0, 0), 0, 0);
    G_STAGE_B(SB(0, 1), 1, 0); G_STAGE_A(SA(0, 1), 1, 0);
    if (wr == 1) BAR;
    WAIT_V(4); BAR;
    G_STAGE_B(SB(1, 0), 0, 1); G_STAGE_A(SA(1, 0), 0, 1); G_STAGE_B(SB(1, 1), 1, 1);
    WAIT_V(6); BAR;
    for (int t = 0; t < nt - 2; t += 2) {
        G_LDB(B0, 0, 0); SCHED; G_LDA(At, 0, 0); G_STAGE_A(SA(1, 1), 1, t + 1);
        WAIT_L(8); BAR; WAIT_L(0); G_MMA(0, 0, At, B0); BAR; SCHED;
        G_LDB(B1, 0, 1); G_STAGE_B(SB(0, 0), 0, t + 2);
        BAR; WAIT_L(0); G_MMA(0, 1, At, B1); BAR;
        G_LDA(At, 0, 1); G_STAGE_A(SA(0, 0), 0, t + 2);
        BAR; WAIT_L(0); G_MMA(1, 0, At, B0); BAR; SCHED;
        G_STAGE_B(SB(0, 1), 1, t + 2);
        WAIT_V(6); BAR; G_MMA(1, 1, At, B1); BAR;
        G_LDB(B0, 1, 0); SCHED; G_LDA(At, 1, 0); G_STAGE_A(SA(0, 1), 1, t + 2);
        WAIT_L(8); BAR; WAIT_L(0); G_MMA(0, 0, At, B0); BAR; SCHED;
        G_LDB(B1, 1, 1); G_STAGE_B(SB(1, 0), 0, t + 3);
        BAR; WAIT_L(0); G_MMA(0, 1, At, B1); BAR;
        G_LDA(At, 1, 1); G_STAGE_A(SA(1, 0), 0, t + 3);
        BAR; WAIT_L(0); G_MMA(1, 0, At, B0); BAR; SCHED;
        G_STAGE_B(SB(1, 1), 1, t + 3);
        WAIT_V(6); BAR; G_MMA(1, 1, At, B1); BAR;
    }
    { G_LDB(B0, 0, 0); WAIT_V(0); G_LDA(At, 0, 0); G_STAGE_A(SA(1, 1), 1, nt - 1);
      BAR; WAIT_L(0); G_MMA(0, 0, At, B0); BAR;
      G_LDB(B1, 0, 1); BAR; WAIT_L(0); G_MMA(0, 1, At, B1); BAR;
      G_LDA(At, 0, 1); WAIT_V(4); BAR; WAIT_L(0); G_MMA(1, 0, At, B0); G_MMA(1, 1, At, B1); BAR; }
    { G_LDB(B0, 1, 0); G_LDA(At, 1, 0); WAIT_V(2); BAR; WAIT_L(0); G_MMA(0, 0, At, B0); BAR;
      G_LDB(B1, 1, 1); WAIT_V(0); BAR; WAIT_L(0); G_MMA(0, 1, At, B1); BAR;
      G_LDA(At, 1, 1); BAR; WAIT_L(0); G_MMA(1, 0, At, B0); G_MMA(1, 1, At, B1); BAR; }
    if (wr == 0) BAR;
    int tz = hidden_tid(wv); wid = tz >> 6; lane = tz & 63; wr = wid >> 2; wc = wid & 3; fr = lane & 15; fq = lane >> 4;
    epi(acc, wr * 64 + fr, bcol + wc * 64 + fq * 4);
}

struct RowIdent { static constexpr bool DENSE = true; __device__ __forceinline__ int operator()(int r) const { return r; } };

__device__ __forceinline__ void st_bf16x4(bf16_t* p, const f32x4& v) { u32x2 w; w.x = cvt_pk_bf16(v[0], v[1]); w.y = cvt_pk_bf16(v[2], v[3]); *(u32x2*)p = w; }
__device__ __forceinline__ void st_chan4(bf16_t* q, size_t ld, const f32x4& v) {
    const unsigned a = cvt_pk_bf16(v[0], v[1]), b = cvt_pk_bf16(v[2], v[3]);
    q[0] = (bf16_t)(a & 0xffff); q[ld] = (bf16_t)(a >> 16); q[2 * ld] = (bf16_t)(b & 0xffff); q[3 * ld] = (bf16_t)(b >> 16);
}
constexpr int BJS = 32;
#define EPI_LOOP_AM _Pragma("unroll") for (int ai = 0; ai < 2; ++ai) _Pragma("unroll") for (int m = 0; m < 4; ++m)
#define EPI_LOOP_BN _Pragma("unroll") for (int bj = 0; bj < 2; ++bj) _Pragma("unroll") for (int n = 0; n < 2; ++n)
struct EpiRes {
    bf16_t* XB; int brow; float* ssp; int lane;
    __device__ __forceinline__ void operator()(AccT& acc, int r0, int c0) const {
        u32x2 xv[2][4][4];
        EPI_LOOP_AM {
            const bf16_t* qb = XB + (size_t)(brow + r0 + ai * 128 + m * 16) * D + c0;
            EPI_LOOP_BN xv[ai][m][bj * 2 + n] = *(const u32x2*)(qb + bj * BJS + n * 16);
        }
        EPI_LOOP_AM {
            const int row = brow + r0 + ai * 128 + m * 16;
            bf16_t* qb = XB + (size_t)row * D + c0;
            float ss = 0.f;
            EPI_LOOP_BN {
                const u32x2 x = xv[ai][m][bj * 2 + n];
                const f32x4 t = (f32x4){bflo(x.x), bfhi(x.x), bflo(x.y), bfhi(x.y)} + acc[ai][bj][m][n];
                const unsigned a0 = cvt_pk_bf16(t[0], t[1]), a1 = cvt_pk_bf16(t[2], t[3]);
                *(u32x2*)(qb + bj * BJS + n * 16) = (u32x2){a0, a1};
                const float r0f = bflo(a0), r1f = bfhi(a0), r2f = bflo(a1), r3f = bfhi(a1);
                ss += (r0f * r0f + r1f * r1f) + (r2f * r2f + r3f * r3f);
            }
            if (ssp) { ss += shx(ss, 16, lane); ss += shx(ss, 32, lane); if ((lane >> 4) == 0) ssp[(size_t)row * 16 + (c0 >> 6)] = ss; }
        }
    }
};
struct EpiSplit {
    bf16_t* Ca; bf16_t* T; bf16_t* Cb; int c0s, c1s, ldT; size_t ldC; int brow; const float* rs;
    __device__ __forceinline__ void chan(AccT& acc, bf16_t* base, int r0, int c, const float (&scv)[2][4]) const {
        EPI_LOOP_AM { const int row = brow + r0 + ai * 128 + m * 16; const float sc = scv[ai][m];
            bf16_t* q = base + (size_t)c * ldC + row;
            EPI_LOOP_BN st_chan4(q + (size_t)(bj * BJS + n * 16) * ldC, ldC, acc[ai][bj][m][n] * sc); }
    }
    __device__ __forceinline__ void operator()(AccT& acc, int r0, int c0) const {
        const int tilec = __builtin_amdgcn_readfirstlane(c0) & ~255;
        float scv[2][4];
        EPI_LOOP_AM scv[ai][m] = rs ? rs[brow + r0 + ai * 128 + m * 16] : 1.0f;
        if (tilec < c0s) chan(acc, Ca, r0, c0, scv);
        else if (tilec < c1s) {
            EPI_LOOP_AM { const int row = brow + r0 + ai * 128 + m * 16; const float sc = scv[ai][m];
                bf16_t* q = T + (size_t)row * ldT + (c0 - c0s);
                EPI_LOOP_BN st_bf16x4(q + bj * BJS + n * 16, acc[ai][bj][m][n] * sc); }
        } else chan(acc, Cb, r0, c0 - c1s, scv);
    }
};
struct EpiTokRstd {
    bf16_t* T; int ldT, brow; const float* ssp; int lane;
    __device__ __forceinline__ void operator()(AccT& acc, int r0, int c0) const {
        f32x4 pv[2][4];
        EPI_LOOP_AM pv[ai][m] = *(const f32x4*)(ssp + (size_t)(brow + r0 + ai * 128 + m * 16) * 16 + (lane >> 4) * 4);
        EPI_LOOP_AM {
            const int row = brow + r0 + ai * 128 + m * 16;
            float ssq = (pv[ai][m][0] + pv[ai][m][1]) + (pv[ai][m][2] + pv[ai][m][3]);
            ssq += shx(ssq, 16, lane); ssq += shx(ssq, 32, lane);
            const float rs = rsqrtf(ssq * (1.0f / 1024.0f) + EPS);
            bf16_t* q = T + (size_t)row * ldT + c0;
            EPI_LOOP_BN st_bf16x4(q + bj * BJS + n * 16, acc[ai][bj][m][n] * rs);
        }
    }
};
struct EpiGateUp {
    bf16_t* act; const int* list; int cnt, pos0; const float* rp;
    __device__ __forceinline__ void operator()(AccT& acc, int r0, int c0) const {
        int av[2][4]; float rv[2][4];
        EPI_LOOP_AM { const int pos = pos0 + r0 + ai * 128 + m * 16, pc = pos < cnt ? pos : cnt - 1; av[ai][m] = list[pc]; rv[ai][m] = rp[pc]; }
        EPI_LOOP_AM {
            const int pos = pos0 + r0 + ai * 128 + m * 16;
            if (pos < cnt) {
                const int a = av[ai][m];
                const float rs = rv[ai][m];
#pragma unroll
                for (int bj = 0; bj < 2; ++bj) {
                    const f32x4 g = acc[ai][bj][m][0] * rs, u = acc[ai][bj][m][1] * rs; f32x4 o;
#pragma unroll
                    for (int j = 0; j < 4; ++j) o[j] = g[j] / (1.0f + __expf(-g[j])) * u[j];
                    const int col = c0 + bj * BJS;
                    const unsigned long long wv8 = ((unsigned long long)cvt_pk_bf16(o[2], o[3]) << 32) | cvt_pk_bf16(o[0], o[1]);
                    __hip_atomic_store((unsigned long long*)(act + (size_t)a * EH + (col >> 5) * 16 + (col & 15)), wv8, __ATOMIC_RELAXED, __HIP_MEMORY_SCOPE_AGENT);
                }
            }
        }
    }
};
struct EpiDown {
    bf16_t* y; const int* list; int cnt, pos0;
    __device__ __forceinline__ void operator()(AccT& acc, int r0, int c0) const {
        int av[2][4];
        EPI_LOOP_AM { const int pos = pos0 + r0 + ai * 128 + m * 16, pc = pos < cnt ? pos : cnt - 1; av[ai][m] = list[pc]; }
        EPI_LOOP_AM {
            const int pos = pos0 + r0 + ai * 128 + m * 16;
            if (pos < cnt) { bf16_t* q = y + (size_t)av[ai][m] * D + c0; EPI_LOOP_BN st_bf16x4(q + bj * BJS + n * 16, acc[ai][bj][m][n]); }
        }
    }
};
struct RowTok { static constexpr bool DENSE = false; const int* list; int cnt, pos0; __device__ __forceinline__ int operator()(int r) const { const int pos = pos0 + r; return pos < cnt ? (list[pos] >> 1) : NTOK; } };
struct RowAsg { static constexpr bool DENSE = false; const int* list; int cnt, pos0; __device__ __forceinline__ int operator()(int r) const { const int pos = pos0 + r; return pos < cnt ? list[pos] : 2 * NTOK; } };

constexpr int ATT_VOFF = 16384;
template <int MODE> struct ACfg;
template <> struct ACfg<0> { static constexpr int DQK = 64, DV = 128, NMAP = 2, KBLK = 2; };
template <> struct ACfg<1> { static constexpr int DQK = 64, DV = 64, NMAP = 1, KBLK = 1; };
template <> struct ACfg<2> { static constexpr int DQK = 128, DV = 128, NMAP = 1, KBLK = 2; };

template <int MODE, bool ALT = false>
__device__ __forceinline__ void attn_unit(const bf16_t* __restrict__ Qp, const int ldq,
                                          const bf16_t* __restrict__ Kp, const int ldk,
                                          const bf16_t* __restrict__ Vt, const size_t ldvt,
                                          const int q0, const int kbeg, const int kend,
                                          const float scale, const float slope, const float m_init, const float l_init,
                                          bf16_t* __restrict__ Op, const int ldo,
                                          const float lam, const float outscale, const float* __restrict__ subln, const int wv) {
    constexpr int DQK = ACfg<MODE>::DQK, DV = ACfg<MODE>::DV, NMAP = ACfg<MODE>::NMAP, KBLK = ACfg<MODE>::KBLK;
    const int tid = hidden_tid(wv), w = tid >> 6, lane = tid & 63, fr = lane & 15, fq = lane >> 4;
    const int qrow = q0 + w * 16 + fr;
    bf16x8 Qf[NMAP][DQK / 32];
#pragma unroll
    for (int m = 0; m < NMAP; ++m)
#pragma unroll
        for (int kk = 0; kk < DQK / 32; ++kk) Qf[m][kk] = *(const bf16x8*)(Qp + (size_t)qrow * ldq + m * DQK + kk * 32 + fq * 8);
    constexpr float LOG2E = 1.4426950408889634f;
    const float scale2 = scale * LOG2E, slope2 = slope * LOG2E, kappa = slope / scale;
    f32x4 O[NMAP][DV / 16], Ol[NMAP];
    float mrun[NMAP];
#pragma unroll
    for (int m = 0; m < NMAP; ++m) {
        mrun[m] = m_init * LOG2E; Ol[m] = (f32x4){(fq == 0) ? l_init : 0.f, 0.f, 0.f, 0.f};
#pragma unroll
        for (int et = 0; et < DV / 16; ++et) O[m][et] = (f32x4){0.f, 0.f, 0.f, 0.f};
    }
    const unsigned onesw = (fr == 0) ? 0x3f803f80u : 0u;
    const bf16x8 onesf = __builtin_bit_cast(bf16x8, (u32x4){onesw, onesw, onesw, onesw});
    char* const lds = (char*)shm;
    constexpr int KN = KBLK, VN = DV / 64;
    u32x4 kreg[KN], vreg[VN];
#define ATT_LOAD(k0_) do { \
        _Pragma("unroll") for (int i_ = 0; i_ < KN; ++i_) { const int c_ = tid + i_ * NT; const int key_ = c_ / (KBLK * 8), col_ = (c_ % (KBLK * 8)) * 8; \
            kreg[i_] = *(const u32x4*)(Kp + (size_t)((k0_) + key_) * ldk + col_); } \
        _Pragma("unroll") for (int i_ = 0; i_ < VN; ++i_) { const int c_ = tid + i_ * NT; const int e_ = c_ >> 3, kc_ = c_ & 7; \
            vreg[i_] = *(const u32x4*)(Vt + (size_t)e_ * ldvt + (k0_) + kc_ * 8); } } while (0)
    ATT_LOAD(kbeg);
    const int qw0 = q0 + w * 16;
    constexpr int VBYTES = DV * 160;
    bf16x8 Pf[NMAP][2];
#define ATT_PV_C(voff_, c) do { \
            bf16x8 vf[DV / 16]; \
            _Pragma("unroll") for (int et = 0; et < DV / 16; ++et) vf[et] = *(const bf16x8*)(lds + (voff_) + (et * 16 + fr) * 160 + (c) * 64 + fq * 16); \
            _Pragma("unroll") for (int m = 0; m < NMAP; ++m) Ol[m] = __builtin_amdgcn_mfma_f32_16x16x32_bf16(onesf, Pf[m][c], Ol[m], 0, 0, 0); \
            _Pragma("unroll") for (int et = 0; et < DV / 16; ++et) \
                _Pragma("unroll") for (int m = 0; m < NMAP; ++m) O[m][et] = __builtin_amdgcn_mfma_f32_16x16x32_bf16(vf[et], Pf[m][c], O[m][et], 0, 0, 0); \
        } while (0)
    int vcur = ATT_VOFF;
    for (int k0 = kbeg; k0 < kend; k0 += 64) {
        __syncthreads();
#pragma unroll
        for (int i = 0; i < KN; ++i) { const int c = tid + i * NT; const int key = c / (KBLK * 8), col = (c % (KBLK * 8)) * 8;
            *(u32x4*)(lds + (col >> 6) * 8192 + lds_byte(key, col & 63)) = kreg[i]; }
#pragma unroll
        for (int i = 0; i < VN; ++i) { const int c = tid + i * NT; const int e = c >> 3, kc = c & 7;
            char* vd = lds + vcur + e * 160 + (kc >> 2) * 64 + (kc & 1) * 32 + ((kc >> 1) & 1) * 8;
            *(u32x2*)vd = (u32x2){vreg[i].x, vreg[i].y}; *(u32x2*)(vd + 16) = (u32x2){vreg[i].z, vreg[i].w}; }
        __syncthreads();
        if (k0 + 64 < kend) ATT_LOAD(k0 + 64);
        const int vprev = vcur ^ ATT_VOFF ^ (ATT_VOFF + VBYTES);
        const float dq = (float)(qrow - k0);
        bool gen;
        if (MODE == 2) gen = false;
        else if (MODE == 1) gen = !((k0 + 63 <= qw0 && qw0 + 15 - k0 <= 128) || (k0 >= qw0 + 15 && k0 + 63 - qw0 <= 128));
        else gen = !(k0 + 63 <= qw0 || k0 >= qw0 + 15);
        const bool pos = (MODE == 2) || (k0 + 63 <= qw0);
        f32x4 Cin[4]; float off;
        if (MODE == 2) {
#pragma unroll
            for (int t = 0; t < 4; ++t) Cin[t] = (f32x4){0.f, 0.f, 0.f, 0.f};
            off = 0.f;
        } else if (gen) {
#pragma unroll
            for (int t = 0; t < 4; ++t)
#pragma unroll
                for (int r = 0; r < 4; ++r) Cin[t][r] = -kappa * fabsf(dq - (float)(16 * t + 4 * fq + r));
            off = 0.f;
        } else {
            const float sk = pos ? kappa : -kappa, cb = sk * (float)(4 * fq);
#pragma unroll
            for (int t = 0; t < 4; ++t)
#pragma unroll
                for (int r = 0; r < 4; ++r) Cin[t][r] = sk * (float)(16 * t + r) + cb;
            off = pos ? -slope2 * dq : slope2 * dq;
        }
        f32x4 s[NMAP][4];
#pragma unroll
        for (int m = 0; m < NMAP; ++m) {
            bf16x8 kf[4][DQK / 32];
#pragma unroll
            for (int t = 0; t < 4; ++t)
#pragma unroll
                for (int kk = 0; kk < DQK / 32; ++kk) {
                    const int blk = (MODE == 2) ? (kk >> 1) : m, kcol = (MODE == 2) ? (kk & 1) * 32 : kk * 32;
                    kf[t][kk] = *(const bf16x8*)(lds + blk * 8192 + lds_byte(t * 16 + fr, kcol + fq * 8));
                }
#pragma unroll
            for (int t = 0; t < 4; ++t) {
                s[m][t] = Cin[t];
#pragma unroll
                for (int kk = 0; kk < DQK / 32; ++kk) s[m][t] = __builtin_amdgcn_mfma_f32_16x16x32_bf16(kf[t][kk], Qf[m][kk], s[m][t], 0, 0, 0);
            }
        }
        float mx[NMAP], mx1[NMAP];
#pragma unroll
        for (int m = 0; m < NMAP; ++m) {
            if (MODE == 1 && gen) {
#pragma unroll
                for (int t = 0; t < 4; ++t)
#pragma unroll
                    for (int r = 0; r < 4; ++r) s[m][t][r] = (fabsf(dq - (float)(16 * t + 4 * fq + r)) > 128.0f) ? -1e30f : s[m][t][r];
            }
            float v = fmaxf(fmaxf(s[m][0][0], s[m][0][1]), fmaxf(s[m][0][2], s[m][0][3]));
#pragma unroll
            for (int t = 1; t < 4; ++t) v = fmaxf(v, fmaxf(fmaxf(s[m][t][0], s[m][t][1]), fmaxf(s[m][t][2], s[m][t][3])));
            mx[m] = v; mx1[m] = shx(v, 16, lane);
        }
        __builtin_amdgcn_sched_barrier(0);
        if (k0 > kbeg) ATT_PV_C(vprev, 0);
        __builtin_amdgcn_sched_barrier(0);
#pragma unroll
        for (int m = 0; m < NMAP; ++m) { mx[m] = fmaxf(mx[m], mx1[m]); mx1[m] = shx(mx[m], 32, lane); }
        __builtin_amdgcn_sched_barrier(0);
        if (k0 > kbeg) ATT_PV_C(vprev, 1);
        __builtin_amdgcn_sched_barrier(0);
#pragma unroll
        for (int m = 0; m < NMAP; ++m) {
            const float mxx = fmaxf(mx[m], mx1[m]);
            const float mtile = fmaxf(mxx * scale2 + off, -1e30f);
            const float mnew = fmaxf(mrun[m], mtile), alpha = __builtin_amdgcn_exp2f(mrun[m] - mnew);
            mrun[m] = mnew;
            const float sub = off - mnew;
#pragma unroll
            for (int t = 0; t < 4; ++t)
#pragma unroll
                for (int r = 0; r < 4; ++r) s[m][t][r] = __builtin_amdgcn_exp2f(s[m][t][r] * scale2 + sub);
            if (__builtin_amdgcn_ballot_w64(alpha != 1.0f) != 0ull) {
                Ol[m] *= alpha;
#pragma unroll
                for (int et = 0; et < DV / 16; ++et) O[m][et] *= alpha;
            }
#pragma unroll
            for (int c = 0; c < 2; ++c) {
                u32x4 pk; pk.x = cvt_pk_bf16(s[m][2 * c][0], s[m][2 * c][1]); pk.y = cvt_pk_bf16(s[m][2 * c][2], s[m][2 * c][3]);
                pk.z = cvt_pk_bf16(s[m][2 * c + 1][0], s[m][2 * c + 1][1]); pk.w = cvt_pk_bf16(s[m][2 * c + 1][2], s[m][2 * c + 1][3]);
                Pf[m][c] = __builtin_bit_cast(bf16x8, pk);
            }
        }
        vcur = vprev;
    }
    { const int vlast = vcur ^ ATT_VOFF ^ (ATT_VOFF + VBYTES); ATT_PV_C(vlast, 0); ATT_PV_C(vlast, 1); }
    float linv[NMAP];
#pragma unroll
    for (int m = 0; m < NMAP; ++m) linv[m] = 1.0f / shl(Ol[m][0], fr);
    const int tid2 = hidden_tid(wv); const int qrow_o = q0 + (tid2 >> 6) * 16 + (tid2 & 15);
    if (MODE == 0) {
        float ss = 0.f;
#pragma unroll
        for (int et = 0; et < DV / 16; ++et)
#pragma unroll
            for (int r = 0; r < 4; ++r) { const float v = O[0][et][r] * linv[0] - lam * (O[NMAP - 1][et][r] * linv[NMAP - 1]); O[0][et][r] = v; ss += v * v; }
        ss += shx(ss, 16, lane); ss += shx(ss, 32, lane);
        const float rs = rsqrtf(ss * (1.0f / 128.0f) + EPS) * outscale;
#pragma unroll
        for (int et = 0; et < DV / 16; ++et) {
            const f32x4 g = *(const f32x4*)(subln + et * 16 + fq * 4);
            st_bf16x4(Op + (size_t)qrow_o * ldo + et * 16 + fq * 4, O[0][et] * rs * g);
        }
    } else {
#pragma unroll
        for (int et = 0; et < DV / 16; ++et) st_bf16x4(Op + (size_t)qrow_o * ldo + et * 16 + fq * 4, O[0][et] * linv[0]);
    }
}

template <int MODE>
__device__ __forceinline__ void attn2_unit(const bf16_t* __restrict__ Qp, const int ldq, const bf16_t* __restrict__ Kp, const int ldk,
                                           const bf16_t* __restrict__ Vt, const size_t ldvt, const int q0, const int kbeg, const int kend,
                                           const float scale, const float* __restrict__ sinkp, const int hq0, bf16_t* __restrict__ Op, const int ldo, const int wv) {
    constexpr int DQK = ACfg<MODE>::DQK, DV = ACfg<MODE>::DV, KBLK = ACfg<MODE>::KBLK, RT = 2;
    const int tid = hidden_tid(wv), w = tid >> 6, lane = tid & 63, fr = lane & 15, fq = lane >> 4;
    const int hl = (MODE == 1) ? (w >> 1) : 0, qsub = (MODE == 1) ? (w & 1) * 32 : w * 32;
    const float slope = (MODE == 1) ? exp2f(-0.5f * (float)(hq0 + hl + 1)) : 0.f;
    const float m_init = (MODE == 1) ? sinkp[hl] : -1e30f, l_init = (MODE == 1) ? 1.0f : 0.f;
    constexpr float LOG2E = 1.4426950408889634f;
    const float scale2 = scale * LOG2E, slope2 = slope * LOG2E, kappa = slope / scale;
    bf16x8 Qf[RT][DQK / 32];
#pragma unroll
    for (int rt = 0; rt < RT; ++rt)
#pragma unroll
        for (int kk = 0; kk < DQK / 32; ++kk) Qf[rt][kk] = *(const bf16x8*)(Qp + (size_t)(q0 + qsub + 16 * rt + fr) * ldq + hl * 64 + kk * 32 + fq * 8);
    f32x4 O[RT][DV / 16], Ol[RT];
    float mrun[RT];
#pragma unroll
    for (int rt = 0; rt < RT; ++rt) {
        mrun[rt] = m_init * LOG2E; Ol[rt] = (f32x4){(fq == 0) ? l_init : 0.f, 0.f, 0.f, 0.f};
#pragma unroll
        for (int et = 0; et < DV / 16; ++et) O[rt][et] = (f32x4){0.f, 0.f, 0.f, 0.f};
    }
    const unsigned onesw = (fr == 0) ? 0x3f803f80u : 0u;
    const bf16x8 onesf = __builtin_bit_cast(bf16x8, (u32x4){onesw, onesw, onesw, onesw});
    char* const lds = (char*)shm;
    constexpr int KN = KBLK, VN = DV / 64;
    u32x4 kreg[KN], vreg[VN];
#define ATT2_LOAD(k0_) do { \
        _Pragma("unroll") for (int i_ = 0; i_ < KN; ++i_) { const int c_ = tid + i_ * NT; const int key_ = c_ / (KBLK * 8), col_ = (c_ % (KBLK * 8)) * 8; \
            kreg[i_] = *(const u32x4*)(Kp + (size_t)((k0_) + key_) * ldk + col_); } \
        _Pragma("unroll") for (int i_ = 0; i_ < VN; ++i_) { const int c_ = tid + i_ * NT; const int e_ = c_ >> 3, kc_ = c_ & 7; \
            vreg[i_] = *(const u32x4*)(Vt + (size_t)e_ * ldvt + (k0_) + kc_ * 8); } } while (0)
    ATT2_LOAD(kbeg);
    constexpr int VBYTES = DV * 160;
    bf16x8 Pf[RT][2];
#define ATT2_PV_C(voff_, c) do { \
            bf16x8 vf[DV / 16]; \
            _Pragma("unroll") for (int et = 0; et < DV / 16; ++et) vf[et] = *(const bf16x8*)(lds + (voff_) + (et * 16 + fr) * 160 + (c) * 64 + fq * 16); \
            _Pragma("unroll") for (int rt = 0; rt < RT; ++rt) Ol[rt] = __builtin_amdgcn_mfma_f32_16x16x32_bf16(onesf, Pf[rt][c], Ol[rt], 0, 0, 0); \
            _Pragma("unroll") for (int et = 0; et < DV / 16; ++et) \
                _Pragma("unroll") for (int rt = 0; rt < RT; ++rt) O[rt][et] = __builtin_amdgcn_mfma_f32_16x16x32_bf16(vf[et], Pf[rt][c], O[rt][et], 0, 0, 0); \
        } while (0)
    int vcur = ATT_VOFF;
    for (int k0 = kbeg; k0 < kend; k0 += 64) {
        __syncthreads();
#pragma unroll
        for (int i = 0; i < KN; ++i) { const int c = tid + i * NT; const int key = c / (KBLK * 8), col = (c % (KBLK * 8)) * 8;
            *(u32x4*)(lds + (col >> 6) * 8192 + lds_byte(key, col & 63)) = kreg[i]; }
#pragma unroll
        for (int i = 0; i < VN; ++i) { const int c = tid + i * NT; const int e = c >> 3, kc = c & 7;
            char* vd = lds + vcur + e * 160 + (kc >> 2) * 64 + (kc & 1) * 32 + ((kc >> 1) & 1) * 8;
            *(u32x2*)vd = (u32x2){vreg[i].x, vreg[i].y}; *(u32x2*)(vd + 16) = (u32x2){vreg[i].z, vreg[i].w}; }
        __syncthreads();
        if (k0 + 64 < kend) ATT2_LOAD(k0 + 64);
        const int vprev = vcur ^ ATT_VOFF ^ (ATT_VOFF + VBYTES);
        f32x4 s[RT][4]; float off[RT], dqv[RT]; bool genv[RT];
#pragma unroll
        for (int rt = 0; rt < RT; ++rt) {
            const int qw0 = q0 + qsub + 16 * rt;
            const float dq = (float)(qw0 + fr - k0); dqv[rt] = dq;
            const bool gen = (MODE == 1) && !((k0 + 63 <= qw0 && qw0 + 15 - k0 <= 128) || (k0 >= qw0 + 15 && k0 + 63 - qw0 <= 128));
            const bool pos = (MODE == 2) || (k0 + 63 <= qw0);
            genv[rt] = gen;
            if (MODE == 2) {
#pragma unroll
                for (int t = 0; t < 4; ++t) s[rt][t] = (f32x4){0.f, 0.f, 0.f, 0.f};
                off[rt] = 0.f;
            } else if (gen) {
#pragma unroll
                for (int t = 0; t < 4; ++t)
#pragma unroll
                    for (int r = 0; r < 4; ++r) s[rt][t][r] = -kappa * fabsf(dq - (float)(16 * t + 4 * fq + r));
                off[rt] = 0.f;
            } else {
                const float sk = pos ? kappa : -kappa; float cb = sk * (float)(4 * fq);
                asm volatile("" : "+v"(cb));
#pragma unroll
                for (int t = 0; t < 4; ++t)
#pragma unroll
                    for (int r = 0; r < 4; ++r) s[rt][t][r] = sk * (float)(16 * t + r) + cb;
                off[rt] = pos ? -slope2 * dq : slope2 * dq;
            }
        }
#pragma unroll
        for (int t = 0; t < 4; ++t) {
            bf16x8 kf[DQK / 32];
#pragma unroll
            for (int kk = 0; kk < DQK / 32; ++kk) {
                const int blk = (MODE == 2) ? (kk >> 1) : 0, kcol = (MODE == 2) ? (kk & 1) * 32 : kk * 32;
                kf[kk] = *(const bf16x8*)(lds + blk * 8192 + lds_byte(t * 16 + fr, kcol + fq * 8));
            }
#pragma unroll
            for (int rt = 0; rt < RT; ++rt)
#pragma unroll
                for (int kk = 0; kk < DQK / 32; ++kk) s[rt][t] = __builtin_amdgcn_mfma_f32_16x16x32_bf16(kf[kk], Qf[rt][kk], s[rt][t], 0, 0, 0);
        }
        float mx[RT], mx1[RT];
#pragma unroll
        for (int rt = 0; rt < RT; ++rt) {
            if (MODE == 1 && genv[rt]) {
#pragma unroll
                for (int t = 0; t < 4; ++t)
#pragma unroll
                    for (int r = 0; r < 4; ++r) s[rt][t][r] = (fabsf(dqv[rt] - (float)(16 * t + 4 * fq + r)) > 128.0f) ? -1e30f : s[rt][t][r];
            }
            float v = fmaxf(fmaxf(s[rt][0][0], s[rt][0][1]), fmaxf(s[rt][0][2], s[rt][0][3]));
#pragma unroll
            for (int t = 1; t < 4; ++t) v = fmaxf(v, fmaxf(fmaxf(s[rt][t][0], s[rt][t][1]), fmaxf(s[rt][t][2], s[rt][t][3])));
            mx[rt] = v; mx1[rt] = shx(v, 16, lane);
        }
        __builtin_amdgcn_sched_barrier(0);
        if (k0 > kbeg) ATT2_PV_C(vprev, 0);
        __builtin_amdgcn_sched_barrier(0);
#pragma unroll
        for (int rt = 0; rt < RT; ++rt) { mx[rt] = fmaxf(mx[rt], mx1[rt]); mx1[rt] = shx(mx[rt], 32, lane); }
        __builtin_amdgcn_sched_barrier(0);
        if (k0 > kbeg) ATT2_PV_C(vprev, 1);
        __builtin_amdgcn_sched_barrier(0);
#pragma unroll
        for (int rt = 0; rt < RT; ++rt) {
            const float mxx = fmaxf(mx[rt], mx1[rt]);
            const float mtile = fmaxf(mxx * scale2 + off[rt], -1e30f);
            const float mnew = fmaxf(mrun[rt], mtile), alpha = __builtin_amdgcn_exp2f(mrun[rt] - mnew);
            mrun[rt] = mnew;
            const float sub = off[rt] - mnew;
#pragma unroll
            for (int t = 0; t < 4; ++t)
#pragma unroll
                for (int r = 0; r < 4; ++r) s[rt][t][r] = __builtin_amdgcn_exp2f(s[rt][t][r] * scale2 + sub);
            if (__builtin_amdgcn_ballot_w64(alpha != 1.0f) != 0ull) {
                Ol[rt] *= alpha;
#pragma unroll
                for (int et = 0; et < DV / 16; ++et) O[rt][et] *= alpha;
            }
#pragma unroll
            for (int c = 0; c < 2; ++c) {
                u32x4 pk; pk.x = cvt_pk_bf16(s[rt][2 * c][0], s[rt][2 * c][1]); pk.y = cvt_pk_bf16(s[rt][2 * c][2], s[rt][2 * c][3]);
                pk.z = cvt_pk_bf16(s[rt][2 * c + 1][0], s[rt][2 * c + 1][1]); pk.w = cvt_pk_bf16(s[rt][2 * c + 1][2], s[rt][2 * c + 1][3]);
                Pf[rt][c] = __builtin_bit_cast(bf16x8, pk);
            }
        }
        vcur = vprev;
    }
    { const int vlast = vcur ^ ATT_VOFF ^ (ATT_VOFF + VBYTES); ATT2_PV_C(vlast, 0); ATT2_PV_C(vlast, 1); }
    const int tid2 = hidden_tid(wv), w2 = tid2 >> 6, fr2 = tid2 & 15;
    const int hl2 = (MODE == 1) ? (w2 >> 1) : 0, qsub2 = (MODE == 1) ? (w2 & 1) * 32 : w2 * 32;
#pragma unroll
    for (int rt = 0; rt < RT; ++rt) {
        const float linv = 1.0f / shl(Ol[rt][0], fr);
        bf16_t* orow = Op + (size_t)(q0 + qsub2 + 16 * rt + fr2) * ldo + hl2 * 64;
#pragma unroll
        for (int et = 0; et < DV / 16; ++et) st_bf16x4(orow + et * 16 + fq * 4, O[rt][et] * linv);
    }
#undef ATT2_LOAD
#undef ATT2_PV_C
}

constexpr int HZ_RS = 4896;
constexpr int HZ_PAD = 192;
constexpr int H_CPS = 8256;
constexpr int H_ZOFF = 0, H_CPOFF = 8 * HZ_RS, H_RAWOFF = H_CPOFF + 8 * H_CPS;

template <bool ALT>
__device__ __forceinline__ void hyena_unit(const Params& p, const int lj  , const int c, const int wv) {
    const int tid = hidden_tid(wv), w = tid >> 6, lane = tid & 63, fr = lane & 15, fq = lane >> 4;
    char* const lds = (char*)shm;
    const bf16_t* hyT = (const bf16_t*)(p.ws + WS_PROJ + PR_HYT);
    const float* cw = p.in[4] + (size_t)lj * 3 * 1536; const float* cb = p.in[5] + (size_t)lj * 1536;
    const int nb = fr >> 1, tbp = fr & 1;
    __syncthreads();
    for (int i = tid; i < 8 * 2 * (HZ_PAD / 8); i += NT) {
        const int b = i / (2 * (HZ_PAD / 8)), r = i % (2 * (HZ_PAD / 8)), side = r / (HZ_PAD / 8), k = r % (HZ_PAD / 8);
        unsigned zz0 = 0u; asm volatile("" : "+v"(zz0));
        *(u32x4*)(lds + H_ZOFF + b * HZ_RS + (side ? (HZ_PAD + 2048) * 2 : 0) + k * 16) = (u32x4){zz0, zz0, zz0, zz0};
        if (i < 2) *(u32x4*)(lds + H_RAWOFF + 8192 + i * 16) = (u32x4){zz0, zz0, zz0, zz0};
    }
    {
        const float w0 = cw[c], w1 = cw[1536 + c], w2 = cw[2 * 1536 + c], bb = cb[c];
        const bf16_t* src = hyT + (size_t)c * NTOK;
        u32x4 v[4]; unsigned short um[4], up[4];
#pragma unroll
        for (int k = 0; k < 4; ++k) {
            const int i = tid + k * NT, b = i >> 8, s0 = (i & 255) * 8;
            const bf16_t* q = src + b * S + s0;
            v[k] = *(const u32x4*)q; um[k] = q[s0 > 0 ? -1 : 0]; up[k] = q[s0 + 8 < S ? 8 : 7];
        }
#pragma unroll
        for (int k = 0; k < 4; ++k) {
            const int i = tid + k * NT, b = i >> 8, s0 = (i & 255) * 8;
            float u[10];
            u[0] = (s0 > 0) ? bf2f(um[k]) : 0.f; u[9] = (s0 + 8 < S) ? bf2f(up[k]) : 0.f;
            u[1] = bflo(v[k].x); u[2] = bfhi(v[k].x); u[3] = bflo(v[k].y); u[4] = bfhi(v[k].y); u[5] = bflo(v[k].z); u[6] = bfhi(v[k].z); u[7] = bflo(v[k].w); u[8] = bfhi(v[k].w);
            float o[8];
#pragma unroll
            for (int j = 0; j < 8; ++j) o[j] = w0 * u[j] + w1 * u[j + 1] + w2 * u[j + 2] + bb;
            u32x4 ov; ov.x = cvt_pk_bf16(o[0], o[1]); ov.y = cvt_pk_bf16(o[2], o[3]); ov.z = cvt_pk_bf16(o[4], o[5]); ov.w = cvt_pk_bf16(o[6], o[7]);
            *(u32x4*)(lds + H_ZOFF + b * HZ_RS + (HZ_PAD + s0) * 2) = ov;
        }
    }
#pragma unroll 1
    for (int order = 0; order < 2; ++order) {
        const int gch = 512 * (order + 1) + c;
        const bf16_t* gsrc = hyT + (size_t)gch * NTOK;
        u32x2 gv[2][4]; unsigned short gm[2][4], gp[2][4];
        u32x4 rawv;
        {
            const bf16_t* f = (const bf16_t*)(p.ws + WS_FILT) + ((size_t)(lj * 2 + order) * 512 + c) * 4096;
            rawv = *(const u32x4*)(f + tid * 8);
#pragma unroll
            for (int ci = 0; ci < 2; ++ci)
#pragma unroll
                for (int mt = 0; mt < 4; ++mt) {
                    const int t = 64 * (4 * w + 2 * ci + tbp) + 16 * mt + 4 * fq;
                    const bf16_t* gq = gsrc + nb * S + t;
                    gv[ci][mt] = *(const u32x2*)gq; gm[ci][mt] = gq[t > 0 ? -1 : 0]; gp[ci][mt] = gq[t + 4 < S ? 4 : 3];
                }
        }
        *(u32x4*)(lds + H_RAWOFF + tid * 16) = rawv;
        __syncthreads();
        {
            const bf16_t* raw = (const bf16_t*)(lds + H_RAWOFF);
            const int o = w;
#pragma unroll
            for (int k = 0; k < 8; ++k) {
                const int a = lane + 64 * k;
                unsigned short e[8];
#pragma unroll
                for (int j = 0; j < 8; ++j) e[j] = raw[8 * a + o + j];
                u32x4 ov; ov.x = e[0] | ((unsigned)e[1] << 16); ov.y = e[2] | ((unsigned)e[3] << 16); ov.z = e[4] | ((unsigned)e[5] << 16); ov.w = e[6] | ((unsigned)e[7] << 16);
                *(u32x4*)(lds + H_CPOFF + o * H_CPS + a * 16) = ov;
            }
        }
        __syncthreads();
        f32x4 acc[2][4];
#pragma unroll
        for (int ci = 0; ci < 2; ++ci)
#pragma unroll
            for (int mt = 0; mt < 4; ++mt) acc[ci][mt] = (f32x4){0.f, 0.f, 0.f, 0.f};
        {
            const int acp = H_CPOFF + (7 - (fr & 7)) * H_CPS + (255 - (fr >> 3) + fq) * 16;
            const int zb = H_ZOFF + nb * HZ_RS + (HZ_PAD + 8 * fq) * 2;
            for (int dl = 4 * w - 31; dl <= ((ALT && DUPSEL >= 5) ? 4 * w - 31 : 4 * w + 3); ++dl) {
#pragma unroll
                for (int kh = 0; kh < 2; ++kh) {
                    bf16x8 Bf[2];
#pragma unroll
                    for (int ci = 0; ci < 2; ++ci) {
                        const int sblk = 4 * w + 2 * ci + tbp - dl;
                        Bf[ci] = *(const bf16x8*)(lds + zb + (64 * sblk + 32 * kh) * 2);
                    }
#pragma unroll
                    for (int mt = 0; mt < 4; ++mt) {
                        const int q = 4 * dl + mt - 2 * kh;
                        const bf16x8 Af = *(const bf16x8*)(lds + acp - 32 * q);
#pragma unroll
                        for (int ci = 0; ci < 2; ++ci) acc[ci][mt] = __builtin_amdgcn_mfma_f32_16x16x32_bf16(Af, Bf[ci], acc[ci][mt], 0, 0, 0);
                    }
                }
            }
        }
        const float hb = p.in[12][(size_t)(lj * 2 + order) * 512 + c];
        const float w0 = cw[gch], w1 = cw[1536 + gch], w2 = cw[2 * 1536 + gch], bb = cb[gch];
        u32x2 zout[2][4];
#pragma unroll
        for (int ci = 0; ci < 2; ++ci)
#pragma unroll
            for (int mt = 0; mt < 4; ++mt) {
                const int t = 64 * (4 * w + 2 * ci + tbp) + 16 * mt + 4 * fq;
                const u32x2 zz = *(const u32x2*)(lds + H_ZOFF + nb * HZ_RS + (HZ_PAD + t) * 2);
                float u[6];
                u[0] = (t > 0) ? bf2f(gm[ci][mt]) : 0.f; u[5] = (t + 4 < S) ? bf2f(gp[ci][mt]) : 0.f;
                u[1] = bflo(gv[ci][mt].x); u[2] = bfhi(gv[ci][mt].x); u[3] = bflo(gv[ci][mt].y); u[4] = bfhi(gv[ci][mt].y);
                const float z[4] = {bflo(zz.x), bfhi(zz.x), bflo(zz.y), bfhi(zz.y)};
                float o[4];
#pragma unroll
                for (int r = 0; r < 4; ++r) {
                    const float gate = w0 * u[r] + w1 * u[r + 1] + w2 * u[r + 2] + bb;
                    o[r] = gate * (acc[ci][mt][r] + hb * z[r]);
                }
                zout[ci][mt].x = cvt_pk_bf16(o[0], o[1]); zout[ci][mt].y = cvt_pk_bf16(o[2], o[3]);
            }
        __syncthreads();
        if (order == 0) {
#pragma unroll
            for (int ci = 0; ci < 2; ++ci)
#pragma unroll
                for (int mt = 0; mt < 4; ++mt) {
                    const int t = 64 * (4 * w + 2 * ci + tbp) + 16 * mt + 4 * fq;
                    *(u32x2*)(lds + H_ZOFF + nb * HZ_RS + (HZ_PAD + t) * 2) = zout[ci][mt];
                }
        } else {
            bf16_t* yt = (bf16_t*)(p.ws + WS_QX) + (size_t)c * NTOK;
#pragma unroll
            for (int ci = 0; ci < 2; ++ci)
#pragma unroll
                for (int mt = 0; mt < 4; ++mt) {
                    const int t = 64 * (4 * w + 2 * ci + tbp) + 16 * mt + 4 * fq;
                    *(u32x2*)(yt + nb * S + t) = zout[ci][mt];
                }
        }
        __syncthreads();
    }
}

struct Row16 { f32x4 v[4]; };
__device__ __forceinline__ void ld_row(Row16& r, const float* src, int lane) {
#pragma unroll
    for (int i = 0; i < 4; ++i) r.v[i] = *(const f32x4*)(src + 256 * i + 4 * lane);
}
__device__ __forceinline__ void ld_row_bf(Row16& r, const bf16_t* src, int lane) {
#pragma unroll
    for (int i = 0; i < 4; ++i) { const u32x2 v = *(const u32x2*)(src + 256 * i + 4 * lane); r.v[i] = (f32x4){bflo(v.x), bfhi(v.x), bflo(v.y), bfhi(v.y)}; }
}
__device__ __forceinline__ float row_rstd(const Row16& r, int lane) {
    float ss = 0.f;
#pragma unroll
    for (int i = 0; i < 4; ++i) ss += r.v[i][0] * r.v[i][0] + r.v[i][1] * r.v[i][1] + r.v[i][2] * r.v[i][2] + r.v[i][3] * r.v[i][3];
    ss = wave_sum(ss, lane);
    return rsqrtf(ss * (1.0f / 1024.0f) + EPS);
}
template <int KIND  , bool ALT = false>
__device__ __forceinline__ void norm_phase(const Params& p, const int layer, const float* __restrict__ gain, const int bid, const int nb, const int wv) {
    const int tid_ = hidden_tid(wv), lane = tid_ & 63, w = tid_ >> 6;
    bf16_t* XB = (bf16_t*)(p.ws + WS_XB);
    bf16_t* XBo = ALT ? (bf16_t*)(p.ws + WS_PROJ) : XB;
    float* RS1 = (float*)(p.ws + (ALT ? WS_QX : WS_RS1));
    const bf16_t* Y = (const bf16_t*)(p.ws + WS_Y);
    const float* WT = (const float*)(p.ws + WS_WT);
    Row16 g;
    if (KIND == 2) ld_row(g, gain, lane);
    for (int tok = bid * 8 + w; tok < NTOK; tok += nb * 8) {
        Row16 x;
        if (KIND == 0 && layer == 0) ld_row(x, p.in[0] + (size_t)tok * D, lane); else ld_row_bf(x, XB + (size_t)tok * D, lane);
        if ((KIND == 0 && layer > 0) || KIND == 2) {
            const float w0 = WT[2 * tok], w1 = WT[2 * tok + 1];
            const bf16_t* y0 = Y + (size_t)(2 * tok) * D; const bf16_t* y1 = y0 + D;
#pragma unroll
            for (int i = 0; i < 4; ++i) {
                const u32x2 a = *(const u32x2*)(y0 + 256 * i + 4 * lane), b = *(const u32x2*)(y1 + 256 * i + 4 * lane);
                x.v[i][0] += w0 * bflo(a.x) + w1 * bflo(b.x); x.v[i][1] += w0 * bfhi(a.x) + w1 * bfhi(b.x);
                x.v[i][2] += w0 * bflo(a.y) + w1 * bflo(b.y); x.v[i][3] += w0 * bfhi(a.y) + w1 * bfhi(b.y);
            }
        }
        if (KIND == 2) {
            const float rstd = row_rstd(x, lane);
#pragma unroll
            for (int i = 0; i < 4; ++i) *(f32x4*)(p.out + (size_t)tok * D + 256 * i + 4 * lane) = x.v[i] * rstd * g.v[i];
        } else {
#pragma unroll
            for (int i = 0; i < 4; ++i) {
                const unsigned a0 = cvt_pk_bf16(x.v[i][0], x.v[i][1]), a1 = cvt_pk_bf16(x.v[i][2], x.v[i][3]);
                *(u32x2*)(XBo + (size_t)tok * D + 256 * i + 4 * lane) = (u32x2){a0, a1};
                x.v[i] = (f32x4){bflo(a0), bfhi(a0), bflo(a1), bfhi(a1)};
            }
            const float rstd = row_rstd(x, lane);
            if (lane == 0) RS1[tok] = rstd;
        }
    }
}

template <bool ALT>
__device__ __forceinline__ void route_phase(const Params& p, const int layer, const int bid, const int nb, const int wv) {
    const int tid = hidden_tid(wv), lane = tid & 63, w = tid >> 6, fr = lane & 15, fq = lane >> 4;
    float* part = (float*)shm;
    float* ssql = part + 8 * 64 * 49;
    float* lgl = ssql + 8 * 64;
    int* cntl = (int*)((char*)shm + LDS_ROUTE);
    int* basel = cntl + 32;
    int* sel = basel + 32;
    int* posl = sel + 128;
    float* rsl = (float*)(posl + 128);
    float* WT = (float*)(p.ws + (ALT ? WS_ACT + (size_t)4 * 1024 * 1024 : WS_WT));
    float* RSTD = (float*)(p.ws + (ALT ? WS_ACT + (size_t)5 * 1024 * 1024 : WS_RSTD));
    int* LIST = (int*)(p.ws + (ALT ? WS_ACT : WS_LIST));
    float* RP = (float*)(p.ws + (ALT ? WS_ACT + (size_t)2 * 1024 * 1024 : WS_RP));
    int* CNT = (int*)(p.ws + WS_CNT) + (layer + (ALT ? 4 : 0)) * NEXP * CNT_STRIDE;
    const float* bg = p.in[26] + layer * 4; const float* be = p.in[28] + layer * NEXP;
    const char* const Xc = (const char*)(p.ws + WS_XB);
    const char* const Whc = (const char*)(p.ws + WS_WRT) + (size_t)layer * 2 * 48 * 1024 * 2; const char* const Wlc = Whc + 48 * 1024 * 2;
    for (int chunk = bid; chunk < NTOK / 64; chunk += nb) {
        __syncthreads();
        if (tid < 32) cntl[tid] = 0;
        const unsigned xoff = (unsigned)(((chunk * 64 + fr) * D + w * 128 + fq * 8) * 2), woff = (unsigned)((fr * 1024 + w * 128 + fq * 8) * 2);
        f32x4 acc[4][3];
#pragma unroll
        for (int mt = 0; mt < 4; ++mt)
#pragma unroll
            for (int nt = 0; nt < 3; ++nt) acc[mt][nt] = (f32x4){0.f, 0.f, 0.f, 0.f};
        float ssq[4] = {0.f, 0.f, 0.f, 0.f};
#pragma unroll 1
        for (int st = 0; st < 4; ++st) {
            u32x4 xa[4]; bf16x8 Bh[3], Bl[3];
#pragma unroll
            for (int mt = 0; mt < 4; ++mt) xa[mt] = *(const u32x4*)(Xc + (xoff + (unsigned)(mt * 16 * D * 2 + st * 64)));
#pragma unroll
            for (int nt = 0; nt < 3; ++nt) { Bh[nt] = *(const bf16x8*)(Whc + (woff + (unsigned)(nt * 16 * 2048 + st * 64))); Bl[nt] = *(const bf16x8*)(Wlc + (woff + (unsigned)(nt * 16 * 2048 + st * 64))); }
#pragma unroll
            for (int mt = 0; mt < 4; ++mt) {
                const u32x4 xb = xa[mt];
                const f32x4 x0 = {bflo(xb.x), bfhi(xb.x), bflo(xb.y), bfhi(xb.y)}, x1 = {bflo(xb.z), bfhi(xb.z), bflo(xb.w), bfhi(xb.w)};
                ssq[mt] += x0[0] * x0[0] + x0[1] * x0[1] + x0[2] * x0[2] + x0[3] * x0[3] + x1[0] * x1[0] + x1[1] * x1[1] + x1[2] * x1[2] + x1[3] * x1[3];
                u32x4 hi; hi.x = cvt_pk_bf16(x0[0], x0[1]); hi.y = cvt_pk_bf16(x0[2], x0[3]); hi.z = cvt_pk_bf16(x1[0], x1[1]); hi.w = cvt_pk_bf16(x1[2], x1[3]);
                u32x4 lo;
                lo.x = cvt_pk_bf16(x0[0] - bflo(hi.x), x0[1] - bfhi(hi.x)); lo.y = cvt_pk_bf16(x0[2] - bflo(hi.y), x0[3] - bfhi(hi.y));
                lo.z = cvt_pk_bf16(x1[0] - bflo(hi.z), x1[1] - bfhi(hi.z)); lo.w = cvt_pk_bf16(x1[2] - bflo(hi.w), x1[3] - bfhi(hi.w));
                const bf16x8 Ah = __builtin_bit_cast(bf16x8, hi), Al = __builtin_bit_cast(bf16x8, lo);
#pragma unroll
                for (int nt = 0; nt < 3; ++nt) {
                    acc[mt][nt] = __builtin_amdgcn_mfma_f32_16x16x32_bf16(Ah, Bh[nt], acc[mt][nt], 0, 0, 0);
                    acc[mt][nt] = __builtin_amdgcn_mfma_f32_16x16x32_bf16(Ah, Bl[nt], acc[mt][nt], 0, 0, 0);
                    acc[mt][nt] = __builtin_amdgcn_mfma_f32_16x16x32_bf16(Al, Bh[nt], acc[mt][nt], 0, 0, 0);
                }
            }
            __builtin_amdgcn_sched_barrier(0);
        }
#pragma unroll
        for (int mt = 0; mt < 4; ++mt) {
            float sq = ssq[mt]; sq += shx(sq, 16, lane); sq += shx(sq, 32, lane);
            if (fq == 0) ssql[w * 64 + mt * 16 + fr] = sq;
#pragma unroll
            for (int nt = 0; nt < 3; ++nt)
#pragma unroll
                for (int r = 0; r < 4; ++r) part[(w * 64 + mt * 16 + fq * 4 + r) * 49 + nt * 16 + fr] = acc[mt][nt][r];
        }
        __syncthreads();
        {
            const int tl = tid & 63;
            for (int j = tid >> 6; j < 36; j += 8) {
                float s = 0.f;
#pragma unroll
                for (int ww = 0; ww < 8; ++ww) s += part[(ww * 64 + tl) * 49 + j];
                lgl[tl * 37 + j] = s;
            }
        }
        __syncthreads();
        if (tid < 64) {
            const int tl = tid, tk = chunk * 64 + tl;
            float sq = 0.f;
#pragma unroll
            for (int ww = 0; ww < 8; ++ww) sq += ssql[ww * 64 + tl];
            const float rstd = rsqrtf(sq * (1.0f / 1024.0f) + EPS);
            float lg[36];
#pragma unroll
            for (int j = 0; j < 36; ++j) lg[j] = lgl[tl * 37 + j] * rstd;
            float g0 = lg[0] + bg[0], g1 = lg[1] + bg[1], g2 = lg[2] + bg[2], g3 = lg[3] + bg[3];
            int gs = 0; float gm = g0;
            if (g1 > gm) { gm = g1; gs = 1; } if (g2 > gm) { gm = g2; gs = 2; } if (g3 > gm) { gm = g3; gs = 3; }
            const float gden = __expf(g0 - gm) + __expf(g1 - gm) + __expf(g2 - gm) + __expf(g3 - gm);
            const float ggate = 1.0f / gden;
            float ev[8];
#pragma unroll
            for (int j = 0; j < 8; ++j) {
                const float a0 = lg[4 + j] + be[j], a1 = lg[12 + j] + be[8 + j], a2 = lg[20 + j] + be[16 + j], a3 = lg[28 + j] + be[24 + j];
                ev[j] = gs == 0 ? a0 : gs == 1 ? a1 : gs == 2 ? a2 : a3;
            }
            int i0 = 0; float v0 = ev[0];
#pragma unroll
            for (int j = 1; j < 8; ++j) if (ev[j] > v0) { v0 = ev[j]; i0 = j; }
            int i1 = -1; float v1 = -3.0e38f;
#pragma unroll
            for (int j = 0; j < 8; ++j) if (j != i0 && ev[j] > v1) { v1 = ev[j]; i1 = j; }
            const float e1 = __expf(v1 - v0), sden = 1.0f / (1.0f + e1);
            const int ea = gs * 8 + i0, eb = gs * 8 + i1;
            sel[2 * tl] = ea; posl[2 * tl] = atomicAdd(&cntl[ea], 1);
            sel[2 * tl + 1] = eb; posl[2 * tl + 1] = atomicAdd(&cntl[eb], 1);
            WT[2 * tk] = ggate * sden; WT[2 * tk + 1] = ggate * e1 * sden;
            RSTD[tk] = rstd; rsl[tl] = rstd;
        }
        __syncthreads();
        if (tid < 32) { const int c = cntl[tid]; basel[tid] = c > 0 ? atomicAdd(&CNT[tid * CNT_STRIDE], c) : 0; }
        __syncthreads();
        if (tid < 128) { const int e = sel[tid]; const size_t li = (size_t)e * NTOK + basel[e] + posl[tid]; LIST[li] = 128 * chunk + tid; RP[li] = rsl[tid >> 1]; }
    }
}

template <int MODE>
__device__ __forceinline__ void cvt_job(const float* __restrict__ src, bf16_t* __restrict__ dst, const int K, const int N, const int nmat,
                                        const size_t dst_mat_stride, const int bid, const int nb, const int wv, const float* __restrict__ kgain = nullptr, const int gshift = 0) {
    float* T = (float*)shm;
    const int tid = hidden_tid(wv);
    const int tk = K / 64, tn = N / 256, per = tk * tn, total = per * nmat;
    f32x4 v[8];
#define CVT_LOAD(t_) do { const int mat_ = (t_) / per, r_ = (t_) % per, k0_ = (r_ / tn) * 64, n0_ = (r_ % tn) * 256; \
        const float* s_ = src + (size_t)mat_ * K * N + (size_t)k0_ * N + n0_; \
        _Pragma("unroll") for (int i = 0; i < 8; ++i) v[i] = *(const f32x4*)(s_ + (size_t)((tid >> 6) + 8 * i) * N + (tid & 63) * 4); } while (0)
    if (bid < total) CVT_LOAD(bid);
    for (int t = bid; t < total; t += nb) {
        const int mat = t / per, r = t % per, k0 = (r / tn) * 64, n0 = (r % tn) * 256;
        bf16_t* d = dst + (size_t)mat * dst_mat_stride;
        if (kgain) {
#pragma unroll
            for (int i = 0; i < 8; ++i) v[i] *= kgain[(size_t)(mat >> gshift) * D + k0 + (tid >> 6) + 8 * i];
        }
        __syncthreads();
#pragma unroll
        for (int i = 0; i < 8; ++i) {
            float* q = T + ((tid >> 6) + 8 * i) * 257 + (tid & 63) * 4;
            q[0] = v[i][0]; q[1] = v[i][1]; q[2] = v[i][2]; q[3] = v[i][3];
        }
        __syncthreads();
        if (t + nb < total) CVT_LOAD(t + nb);
#pragma unroll
        for (int j = 0; j < 4; ++j) {
            const int n = (tid >> 3) + 64 * j, kc = (tid & 7) * 8;
            float e[8];
#pragma unroll
            for (int jj = 0; jj < 8; ++jj) e[jj] = T[(kc + jj) * 257 + n];
            u32x4 ov; ov.x = cvt_pk_bf16(e[0], e[1]); ov.y = cvt_pk_bf16(e[2], e[3]); ov.z = cvt_pk_bf16(e[4], e[5]); ov.w = cvt_pk_bf16(e[6], e[7]);
            const int ng = n0 + n;
            const int row = (MODE == 0) ? ng : ((ng >> 4) * 32 + (ng & 15) + (MODE == 2 ? 16 : 0));
            *(u32x4*)(d + (size_t)row * K + k0 + kc) = ov;
        }
    }
#undef CVT_LOAD
}

__device__ __forceinline__ void prologue0(const Params& p, const int bid, const int nb, const int wv) {
    unsigned char* ws = p.ws;
    cvt_job<0>(p.in[3], (bf16_t*)(ws + WS_W_EIN), 1024, 3072, 2, (size_t)3072 * 1024, bid, nb, wv, p.in[2]);
    cvt_job<0>(p.in[15], (bf16_t*)(ws + WS_W_EOUT), 1024, 1024, 2, (size_t)1024 * 1024, bid, nb, wv);
    cvt_job<0>(p.in[17], (bf16_t*)(ws + WS_W_OIN), 1024, 1536, 2, (size_t)1536 * 1024, bid, nb, wv, p.in[16]);
    cvt_job<0>(p.in[19], (bf16_t*)(ws + WS_W_OOUT), 1024, 1024, 2, (size_t)1024 * 1024, bid, nb, wv);
    cvt_job<0>(p.in[21], (bf16_t*)(ws + WS_W_CQ), 1024, 512, 4, (size_t)512 * 1024, bid, nb, wv, p.in[20]);
    cvt_job<0>(p.in[22], (bf16_t*)(ws + WS_W_CKV), 1024, 1024, 4, (size_t)1024 * 1024, bid, nb, wv);
    cvt_job<0>(p.in[23], (bf16_t*)(ws + WS_W_CO), 512, 1024, 4, (size_t)1024 * 512, bid, nb, wv);
    cvt_job<1>(p.in[29], (bf16_t*)(ws + WS_W_GU), 1024, 512, 128, (size_t)1024 * 1024, bid, nb, wv, p.in[24], 5);
    cvt_job<2>(p.in[30], (bf16_t*)(ws + WS_W_GU), 1024, 512, 128, (size_t)1024 * 1024, bid, nb, wv, p.in[24], 5);
    cvt_job<0>(p.in[31], (bf16_t*)(ws + WS_W_DN), 512, 1024, 128, (size_t)1024 * 512, bid, nb, wv);
    const int tid = hidden_tid(wv), lane = tid & 63, w = tid >> 6;
    {
        Row16 g; ld_row(g, p.in[32], lane);
        bf16_t* MN = (bf16_t*)(ws + WS_MEMN);
        for (int r = bid * 8 + w; r < Bb * MEM; r += nb * 8) {
            Row16 x; ld_row(x, p.in[1] + (size_t)r * D, lane);
            const float rstd = row_rstd(x, lane);
#pragma unroll
            for (int i = 0; i < 4; ++i) st_bf16x4(MN + (size_t)r * D + 256 * i + 4 * lane, x.v[i] * rstd * g.v[i]);
        }
    }
    {
        float* A2 = (float*)(ws + WS_A2);
        for (int r = bid * 8 + w; r < 2 * S; r += nb * 8) {
            const int lj = r / S, pos = r % S;
            const float* w1 = p.in[6] + (size_t)lj * 33 * 64; const float* b1 = p.in[7] + lj * 64;
            const float* w2 = p.in[8] + (size_t)lj * 64 * 64; const float* b2 = p.in[9] + lj * 64;
            const float fr_ = p.in[11][lj * 64 + lane];
            float a = ((float)pos / 2047.0f) * w1[lane];
#pragma unroll 1
            for (int k = 0; k < 16; ++k) {
                const float band = 1e-4f + (float)k * ((15.0f - 1e-4f) / 15.0f);
                const float ang = band * (6.283185307179586f * (float)pos / 2048.0f);
                a += cosf(ang) * w1[(1 + k) * 64 + lane] - sinf(ang) * w1[(17 + k) * 64 + lane];
            }
            const float a1 = sinf(fr_ * (a + b1[lane]));
            float a2 = 0.f;
#pragma unroll 1
            for (int i = 0; i < 64; ++i) a2 += shl(a1, i) * w2[i * 64 + lane];
            A2[(size_t)r * 64 + lane] = sinf(fr_ * (a2 + b2[lane]));
        }
    }
    {
        bf16_t* WR = (bf16_t*)(ws + WS_WRT);
        for (int i = bid * NT + tid; i < 4 * 48 * 1024; i += nb * NT) {
            const int l = i / (48 * 1024), r = i % (48 * 1024), j = r >> 10, k = r & 1023;
            float v = 0.f;
            if (j < 4) v = p.in[25][((size_t)l * D + k) * 4 + j]; else if (j < 36) v = p.in[27][((size_t)l * D + k) * NEXP + (j - 4)];
            v *= p.in[24][(size_t)l * D + k];
            const unsigned h = cvt_pk_bf16(v, 0.f) & 0xffffu;
            const unsigned lo = cvt_pk_bf16(v - bflo(h), 0.f) & 0xffffu;
            WR[(size_t)l * 2 * 48 * 1024 + r] = (bf16_t)h; WR[(size_t)l * 2 * 48 * 1024 + 48 * 1024 + r] = (bf16_t)lo;
        }
    }
    if (bid == 0) {
        if (tid < 2) {
            const float* lm = p.in[13] + (size_t)tid * 4 * 64;
            float s01 = 0.f, s23 = 0.f;
            for (int i = 0; i < 64; ++i) { s01 += lm[i] * lm[64 + i]; s23 += lm[128 + i] * lm[192 + i]; }
            const float lam_init = 0.8f - 0.6f * expf(-0.3f * (float)(2 * tid));
            ((float*)(ws + WS_MISC))[tid] = expf(s01) - expf(s23) + lam_init;
            ((float*)(ws + WS_MISC))[2 + tid] = 1.0f - lam_init;
        }
        bf16_t* hz = (bf16_t*)(ws + WS_XB) + (size_t)NTOK * D; bf16_t* az = (bf16_t*)(ws + WS_ACT) + (size_t)2 * NTOK * EH;
        for (int i = tid; i < D; i += NT) hz[i] = 0;
        for (int i = tid; i < EH; i += NT) az[i] = 0;
    }
}

__device__ __forceinline__ void filter_taps(const Params& p, const int bid, const int nb, const int wv) {
    const int tid = hidden_tid(wv), w = tid >> 6, lane = tid & 63, fr = lane & 15, fq = lane >> 4;
    const float* A2 = (const float*)(p.ws + WS_A2);
    bf16_t* FL = (bf16_t*)(p.ws + WS_FILT);
    const float mind = logf(1e-2f) / 1.5f, maxd = logf(1e-2f) / 0.3f;
    for (int job = bid; job < 2 * 4 * 8 * 32; job += nb) {
        const int pt = job & 31, ct = (job >> 5) & 7, od = (job >> 8) & 3, lj = job >> 10;
        const int pos0 = pt * 64 + (w >> 2) * 32, ch0 = ct * 64 + (w & 3) * 16, order = od >> 1, dir = od & 1;
        const float* w3 = p.in[10] + (size_t)lj * 64 * 2048 + od * 512 + ch0 + fr;
        bf16x8 Af[2], Bf[2][2];
#pragma unroll
        for (int ks = 0; ks < 2; ++ks) {
            float e[8];
#pragma unroll
            for (int jj = 0; jj < 8; ++jj) e[jj] = w3[(size_t)(ks * 32 + fq * 8 + jj) * 2048];
            u32x4 pk; pk.x = cvt_pk_bf16(e[0], e[1]); pk.y = cvt_pk_bf16(e[2], e[3]); pk.z = cvt_pk_bf16(e[4], e[5]); pk.w = cvt_pk_bf16(e[6], e[7]);
            Af[ks] = __builtin_bit_cast(bf16x8, pk);
#pragma unroll
            for (int nt = 0; nt < 2; ++nt) {
                const float* ap = A2 + ((size_t)lj * S + pos0 + nt * 16 + fr) * 64 + ks * 32 + fq * 8;
                const f32x4 v0 = *(const f32x4*)ap, v1 = *(const f32x4*)(ap + 4);
                u32x4 pb; pb.x = cvt_pk_bf16(v0[0], v0[1]); pb.y = cvt_pk_bf16(v0[2], v0[3]); pb.z = cvt_pk_bf16(v1[0], v1[1]); pb.w = cvt_pk_bf16(v1[2], v1[3]);
                Bf[nt][ks] = __builtin_bit_cast(bf16x8, pb);
            }
        }
#pragma unroll
        for (int nt = 0; nt < 2; ++nt) {
            f32x4 acc = {0.f, 0.f, 0.f, 0.f};
            acc = __builtin_amdgcn_mfma_f32_16x16x32_bf16(Af[0], Bf[nt][0], acc, 0, 0, 0);
            acc = __builtin_amdgcn_mfma_f32_16x16x32_bf16(Af[1], Bf[nt][1], acc, 0, 0, 0);
            const int pos = pos0 + nt * 16 + fr;
            const float tpos = (float)pos / 2047.0f;
#pragma unroll
            for (int r = 0; r < 4; ++r) {
                const int ch = ch0 + fq * 4 + r;
                const float delta = mind + (float)ch * ((maxd - mind) / 511.0f);
                const float v = acc[r] * __builtin_amdgcn_exp2f(-tpos * fabsf(delta) * 1.4426950408889634f);
                bf16_t* f = FL + ((size_t)(lj * 2 + order) * 512 + ch) * 4096;
                const unsigned short hv = (unsigned short)(cvt_pk_bf16(v, 0.f) & 0xffff);
                if (dir == 0) f[2047 - pos] = hv;
                else { if (pos >= 1) f[2047 + pos] = hv; if (pos == 2047) f[4095] = 0; }
            }
        }
    }
}

enum { PH_P0 = 0, PH_P1, PH_N1, PH_GIN, PH_MIX, PH_GOUT, PH_N2, PH_GQ, PH_XATT, PH_GO, PH_ROUTE, PH_G1, PH_G2, PH_FINAL, PH_TR, PH_COUNT };

template <class Epi>
__device__ __forceinline__ void gemm_dense(const bf16_t* A, const bf16_t* Bt, const int K, const int nM, const int nN, Epi epi, const int bid, const int nb, const int wv) {
    for (int u = bid; u < nM * nN; u += nb) {
        const int pm = u / nN, pn = u % nN;
        epi.brow = pm * 256;
        gemm_tile(A + (size_t)pm * 256 * K, Bt, K, pn * 256, RowIdent{}, epi, wv);
    }
}

typedef const __attribute__((address_space(4))) Params* ParamsK;
#define PHASE_FN __forceinline__
template <int PH, bool ALT = false>
__device__ PHASE_FN void run_phase(ParamsK pk_, const int layer, const int bid_, const int nb_, const int wv_) {
    ParamsK pk = pk_; asm volatile("" : "+s"(pk));
    int bid = bid_, nb = nb_, wv = wv_; asm volatile("" : "+s"(bid), "+s"(nb), "+s"(wv));
    const Params& p = *(const Params*)pk;
    unsigned char* ws = p.ws;
    const int lj = layer >> 1; const bool even = (layer & 1) == 0;
    bf16_t* H = (bf16_t*)(ws + WS_H);
    float* X = (float*)(ws + WS_X);
    bf16_t* YMIX = (bf16_t*)(ws + WS_YMIX);
    bf16_t* QX = (bf16_t*)(ws + WS_QX);
    bf16_t* OX = (bf16_t*)(ws + WS_OX);
    if constexpr (PH == PH_P0) { prologue0(p, bid, nb, wv); }
    if constexpr (PH == PH_N1) {
        norm_phase<0, ALT>(p, layer, nullptr, bid, nb, wv);
        if (layer == 0 && !ALT) filter_taps(p, bid, nb, wv);
    }
    if constexpr (PH == PH_GIN) {
        const bf16_t* XBc = (const bf16_t*)(ws + WS_XB); const float* RS1 = (const float*)(ws + WS_RS1);
        if (even) {
            EpiSplit e{(bf16_t*)(ws + WS_PROJ + PR_HYT), (bf16_t*)(ws + WS_PROJ + PR_QK), (bf16_t*)(ws + WS_PROJ + PR_VT), 1536, 2560, 1024, (size_t)NTOK, 0, RS1};
            gemm_dense(XBc, (const bf16_t*)(ws + WS_W_EIN) + (size_t)lj * 3072 * 1024, 1024, 64, 12, e, bid, nb, wv);
        } else {
            EpiSplit e{nullptr, (bf16_t*)(ws + WS_PROJ), (bf16_t*)(ws + WS_PROJ + PR_OVT), 0, 1280, 1280, (size_t)NTOK, 0, RS1};
            gemm_dense(XBc, (const bf16_t*)(ws + WS_W_OIN) + (size_t)lj * 1536 * 1024, 1024, 64, 6, e, bid, nb, wv);
        }
    }
    if constexpr (PH == PH_MIX) {
        if (even) {
            const bf16_t* qk = (const bf16_t*)(ws + WS_PROJ + PR_QK);
            const bf16_t* vT = (const bf16_t*)(ws + WS_PROJ + PR_VT);
            const float lam = uni(((const float*)(ws + WS_MISC))[lj]);
            const float oscale = uni(((const float*)(ws + WS_MISC))[2 + lj]);
            for (int u = bid + ((ALT && (DUPSEL == 4 || DUPSEL >= 7)) ? 512 : 0); u < ((ALT && (DUPSEL == 3 || DUPSEL == 5 || DUPSEL == 6)) ? 512 : 1024); u += nb) {
                if (u < 512) hyena_unit<ALT>(p, lj, u, wv);
                else {
                    const int id = u - 512, b = id >> 6, h = (id >> 4) & 3, qb = id & 15;
                    attn_unit<0, ALT>(qk + (size_t)(b * S) * 1024 + 2 * h * 64, 1024, qk + (size_t)(b * S) * 1024 + 512 + 2 * h * 64, 1024,
                                 vT + (size_t)(h * 128) * NTOK + b * S, (size_t)NTOK, qb * 128, 0, S,
                                 0.125f, uni(exp2f(-2.0f * (float)(h + 1))), -1e30f, 0.f,
                                 (ALT ? (bf16_t*)(ws + WS_Y) : YMIX) + (size_t)(b * S) * D + 512 + h * 128, D, lam, oscale, p.in[14] + (size_t)lj * 128, wv);
                }
            }
        } else {
            const bf16_t* qk = (const bf16_t*)(ws + WS_PROJ);
            const bf16_t* vT = (const bf16_t*)(ws + WS_PROJ + PR_OVT);
            for (int u = bid; u < 1024; u += nb) {
                const int b = u >> 7, kv = (u >> 5) & 3, qb = u & 31, q0 = qb * 64;
                const int kbeg = q0 - 128 < 0 ? 0 : q0 - 128, kend = q0 + 192 > S ? S : q0 + 192;
                attn2_unit<1>(qk + (size_t)(b * S) * 1280 + kv * 256, 1280, qk + (size_t)(b * S) * 1280 + 1024 + kv * 64, 1280,
                              vT + (size_t)(kv * 64) * NTOK + b * S, (size_t)NTOK, q0, kbeg, kend,
                              0.125f, p.in[18] + lj * 16 + kv * 4, kv * 4, YMIX + (size_t)(b * S) * D + kv * 256, D, wv);
            }
        }
    }
    if constexpr (PH == PH_TR) {
        const int tid = hidden_tid(wv);
        const bf16_t* yt = (const bf16_t*)(ws + WS_QX);
        bf16_t* T = shm;
        for (int t = bid; t < 8 * 256; t += nb) {
            const int c0 = (t & 7) * 64, tk0 = (t >> 3) * 64;
            const u32x4 v = *(const u32x4*)(yt + (size_t)(c0 + (tid >> 3)) * NTOK + tk0 + (tid & 7) * 8);
            __syncthreads();
            *(u32x4*)((char*)T + (tid >> 3) * 144 + (tid & 7) * 16) = v;
            __syncthreads();
            const int tok = tid >> 3, cg = (tid & 7) * 8;
            unsigned short e[8];
#pragma unroll
            for (int j = 0; j < 8; ++j) e[j] = T[(cg + j) * 72 + tok];
            u32x4 ov; ov.x = e[0] | ((unsigned)e[1] << 16); ov.y = e[2] | ((unsigned)e[3] << 16); ov.z = e[4] | ((unsigned)e[5] << 16); ov.w = e[6] | ((unsigned)e[7] << 16);
            *(u32x4*)(YMIX + (size_t)(tk0 + tok) * D + c0 + cg) = ov;
        }
    }
    if constexpr (PH == PH_GOUT) {
        EpiRes e{(bf16_t*)(ws + (ALT ? WS_Y : WS_XB)), 0, (float*)(ws + WS_SSP), hidden_tid(wv) & 63};
        gemm_dense(YMIX, (const bf16_t*)(ws + (even ? WS_W_EOUT : WS_W_OOUT)) + (size_t)lj * 1024 * 1024, 1024, 64, 4, e, bid, nb, wv);
    }
    if constexpr (PH == PH_GQ) {
        for (int u = bid; u < 128 + 32; u += nb) {
            if (u < 128) {
                const int pm = u >> 1, pn = u & 1;
                EpiTokRstd e{QX, 512, pm * 256, (const float*)(ws + WS_SSP), hidden_tid(wv) & 63};
                gemm_tile((const bf16_t*)(ws + WS_XB) + (size_t)pm * 256 * 1024, (const bf16_t*)(ws + WS_W_CQ) + (size_t)layer * 512 * 1024, 1024, pn * 256, RowIdent{}, e, wv);
            } else {
                const int v = u - 128, pm = v >> 2, pn = v & 3;
                EpiSplit e{nullptr, (bf16_t*)(ws + WS_XK) + (size_t)layer * 2048 * 512, (bf16_t*)(ws + WS_XVT) + (size_t)layer * 512 * 2048, 0, 512, 512, (size_t)2048, pm * 256, nullptr};
                gemm_tile((const bf16_t*)(ws + WS_MEMN) + (size_t)pm * 256 * 1024, (const bf16_t*)(ws + WS_W_CKV) + (size_t)layer * 1024 * 1024, 1024, pn * 256, RowIdent{}, e, wv);
            }
        }
    }
    if constexpr (PH == PH_XATT) {
        const bf16_t* xk = (const bf16_t*)(ws + WS_XK) + (size_t)layer * 2048 * 512;
        const bf16_t* xvt = (const bf16_t*)(ws + WS_XVT) + (size_t)layer * 512 * 2048;
        for (int u = bid; u < 256; u += nb) {
            const int b = u >> 5, h = (u >> 3) & 3, qb = u & 7;
            attn2_unit<2>(QX + (size_t)(b * S) * 512 + h * 128, 512, xk + (size_t)(b * MEM) * 512 + h * 128, 512,
                          xvt + (size_t)(h * 128) * 2048 + b * MEM, (size_t)2048, qb * 256, 0, MEM,
                          0.08838834764831845f, nullptr, 0, OX + (size_t)(b * S) * 512 + h * 128, 512, wv);
        }
    }
    if constexpr (PH == PH_GO) {
        EpiRes e{(bf16_t*)(ws + (ALT ? WS_Y : WS_XB)), 0, nullptr, hidden_tid(wv) & 63};
        gemm_dense(OX, (const bf16_t*)(ws + WS_W_CO) + (size_t)layer * 1024 * 512, 512, 64, 4, e, bid, nb, wv);
    }
    if constexpr (PH == PH_ROUTE) { route_phase<ALT>(p, layer, bid, nb, wv); }
    if constexpr (PH == PH_G1) {
        const int* CNT = (const int*)(ws + WS_CNT) + layer * NEXP * CNT_STRIDE;
        const int* LIST = (const int*)(ws + WS_LIST);
        unsigned* head = (unsigned*)(ws + WS_QHEAD) + layer * 64;
        unsigned* done = (unsigned*)(ws + WS_DONE) + layer * 32 * 64;
        int* uq = (int*)((char*)shm + LDS_ROUTE + 1024);
        const int tid = hidden_tid(wv);
        int total = 0;
        for (int e = 0; e < NEXP; ++e) total += (CNT[e * CNT_STRIDE] + 255) >> 8;
        total = __builtin_amdgcn_readfirstlane(total) * 4;
        for (;;) {
            __syncthreads();
            if (tid == 0) *uq = (int)__hip_atomic_fetch_add(head, 1u, __ATOMIC_RELAXED, __HIP_MEMORY_SCOPE_AGENT);
            __syncthreads();
            const int uall = __builtin_amdgcn_readfirstlane(*uq);
            if (uall >= 2 * total) break;
            const bool second = uall >= total;
            const int u = second ? uall - total : uall;
            int e = 0, base = 0, tl = 0, cnt = 0;
            for (; e < NEXP; ++e) { cnt = __builtin_amdgcn_readfirstlane(CNT[e * CNT_STRIDE]); tl = (cnt + 255) >> 8; if (u < base + tl * 4) break; base += tl * 4; }
            const int r = u - base, pn = r / tl, pm = r % tl;
            const int* list = LIST + (size_t)e * NTOK;
            if (!second) {
                EpiGateUp ep{(bf16_t*)(ws + WS_ACT), list, cnt, pm * 256, (const float*)(ws + WS_RP) + (size_t)e * NTOK};
                gemm_tile((const bf16_t*)(ws + WS_XB), (const bf16_t*)(ws + WS_W_GU) + ((size_t)layer * NEXP + e) * 1024 * 1024, 1024, pn * 256, RowTok{list, cnt, pm * 256}, ep, wv);
                asm volatile("s_waitcnt vmcnt(0)" ::: "memory");
                if ((hidden_tid(wv) & 63) == 0) (void)__hip_atomic_fetch_add(done + e * 64 + pm, 1u, __ATOMIC_RELAXED, __HIP_MEMORY_SCOPE_AGENT);
            } else {
                if (tid < 64) {
                    unsigned spins = 0;
                    while ((unsigned)__builtin_amdgcn_readfirstlane(__hip_atomic_load(done + e * 64 + pm, __ATOMIC_RELAXED, __HIP_MEMORY_SCOPE_AGENT)) < 32u) {
                        __builtin_amdgcn_s_sleep(2);
                        if (++spins > (1u << 24)) break;
                    }
                    __builtin_amdgcn_fence(__ATOMIC_ACQUIRE, "agent");
                    asm volatile("s_waitcnt vmcnt(0)" ::: "memory");
                }
                __syncthreads();
                EpiDown ep{(bf16_t*)(ws + WS_Y), list, cnt, pm * 256};
                gemm_tile((const bf16_t*)(ws + WS_ACT), (const bf16_t*)(ws + WS_W_DN) + ((size_t)layer * NEXP + e) * 1024 * 512, 512, pn * 256, RowAsg{list, cnt, pm * 256}, ep, wv);
            }
        }
    }
    if constexpr (PH == PH_FINAL) { norm_phase<2>(p, DEPTH, p.in[33], bid, nb, wv); }
}

#if ONE_LAUNCH
__global__ void __launch_bounds__(NT, 2) k_mega(Params p_) {
    ParamsK p = (ParamsK)__builtin_amdgcn_kernarg_segment_ptr();
    volatile LAS unsigned* st = (volatile LAS unsigned*)((char*)shm + LDS_XB);
    if (threadIdx.x < 4) st[threadIdx.x] = 0u;
    __syncthreads();
    const XcdBarrier bar = xcd_barrier_post((unsigned*)(p->ws + WS_BAR), st);
    const int bid = blockIdx.x, nb = gridDim.x, wv = __builtin_amdgcn_readfirstlane(threadIdx.x >> 6);
    run_phase<PH_P0>(p, 0, bid, nb, wv); xcd_barrier(bar); if (DUP == PH_P0) { run_phase<PH_P0, true>(p, 0, bid, nb, wv); xcd_barrier(bar); }
#pragma unroll 1
    for (int layer = 0; layer < DEPTH; ++layer) {
        run_phase<PH_N1>(p, layer, bid, nb, wv); xcd_barrier(bar); if (DUP == PH_N1) { run_phase<PH_N1, true>(p, layer, bid, nb, wv); xcd_barrier(bar); }
        run_phase<PH_GIN>(p, layer, bid, nb, wv); xcd_barrier(bar); if (DUP == PH_GIN) { run_phase<PH_GIN, true>(p, layer, bid, nb, wv); xcd_barrier(bar); }
        run_phase<PH_MIX>(p, layer, bid, nb, wv); xcd_barrier(bar); if (DUP == PH_MIX && (DUPSEL == 0 || (DUPSEL != 2 && (layer & 1) == 0) || (DUPSEL == 2 && (layer & 1) == 1))) { run_phase<PH_MIX, true>(p, layer, bid, nb, wv); xcd_barrier(bar); }
        if ((layer & 1) == 0) { run_phase<PH_TR>(p, layer, bid, nb, wv); xcd_barrier(bar); }
        run_phase<PH_GOUT>(p, layer, bid, nb, wv); xcd_barrier(bar); if (DUP == PH_GOUT) { run_phase<PH_GOUT, true>(p, layer, bid, nb, wv); xcd_barrier(bar); }
        run_phase<PH_GQ>(p, layer, bid, nb, wv); xcd_barrier(bar); if (DUP == PH_GQ) { run_phase<PH_GQ, true>(p, layer, bid, nb, wv); xcd_barrier(bar); }
        run_phase<PH_XATT>(p, layer, bid, nb, wv); xcd_barrier(bar); if (DUP == PH_XATT) { run_phase<PH_XATT, true>(p, layer, bid, nb, wv); xcd_barrier(bar); }
        run_phase<PH_GO>(p, layer, bid, nb, wv); xcd_barrier(bar); if (DUP == PH_GO) { run_phase<PH_GO, true>(p, layer, bid, nb, wv); xcd_barrier(bar); }
        run_phase<PH_ROUTE>(p, layer, bid, nb, wv); xcd_barrier(bar); if (DUP == PH_ROUTE) { run_phase<PH_ROUTE, true>(p, layer, bid, nb, wv); xcd_barrier(bar); }
        run_phase<PH_G1>(p, layer, bid, nb, wv); xcd_barrier(bar); if (DUP == PH_G1) { run_phase<PH_G1, true>(p, layer, bid, nb, wv); xcd_barrier(bar); }
    }
    run_phase<PH_FINAL>(p, DEPTH, bid, nb, wv);
}
#else
template <int PH>
__global__ void __launch_bounds__(NT, 2) k_phase(Params p_, int layer) {
    run_phase<PH>((ParamsK)__builtin_amdgcn_kernarg_segment_ptr(), layer, blockIdx.x, gridDim.x, __builtin_amdgcn_readfirstlane(threadIdx.x >> 6));
}
template <int PH> static void launch_phase(const Params& p, int layer, int grid, hipStream_t stream) {
    static bool init = false;
    if (!init) { (void)hipFuncSetAttribute((const void*)k_phase<PH>, hipFuncAttributeMaxDynamicSharedMemorySize, LDS_BYTES); init = true; }
    hipLaunchKernelGGL(k_phase<PH>, dim3(grid), dim3(NT), LDS_BYTES, stream, p, layer);
}
#endif

extern "C" void kernel_launch(void* const* d_in, const int* in_sizes, int n_in, void* d_out, int out_size, void* d_ws, size_t ws_size, hipStream_t stream) {
    if (n_in != 34 || ws_size < WS_END) { fprintf(stderr, "kernel_launch: unexpected n_in %d or ws_size %zu (need %zu)\n", n_in, ws_size, (size_t)WS_END); return; }
    Params p{};
    for (int i = 0; i < 34; ++i) p.in[i] = (const float*)d_in[i];
    p.out = (float*)d_out; p.ws = (unsigned char*)d_ws;
    (void)hipMemsetAsync(d_ws, 0, WS_ZERO_BYTES, stream);
#if ONE_LAUNCH
    static int grid = 0;
    if (grid == 0) {
        int dev = 0, cus = 0, per_cu = 0;
        (void)hipGetDevice(&dev); (void)hipDeviceGetAttribute(&cus, hipDeviceAttributeMultiprocessorCount, dev);
        (void)hipFuncSetAttribute((const void*)k_mega, hipFuncAttributeMaxDynamicSharedMemorySize, LDS_BYTES);
        (void)hipOccupancyMaxActiveBlocksPerMultiprocessor(&per_cu, (const void*)k_mega, NT, LDS_BYTES);
        (void)hipGetLastError();
        grid = cus > 0 ? cus : 256;
    }
    hipLaunchKernelGGL(k_mega, dim3(grid), dim3(NT), LDS_BYTES, stream, p);
#else
    const int grid = 256;
    launch_phase<PH_P0>(p, 0, grid, stream);
    for (int layer = 0; layer < DEPTH; ++layer) {
        launch_phase<PH_N1>(p, layer, grid, stream);
        launch_phase<PH_GIN>(p, layer, grid, stream);
        launch_phase<PH_MIX>(p, layer, grid, stream);
        if ((layer & 1) == 0) launch_phase<PH_TR>(p, layer, grid, stream);
        launch_phase<PH_GOUT>(p, layer, grid, stream);
        launch_phase<PH_GQ>(p, layer, grid, stream);
        launch_phase<PH_XATT>(p, layer, grid, stream);
        launch_phase<PH_GO>(p, layer, grid, stream);
        launch_phase<PH_ROUTE>(p, layer, grid, stream);
        launch_phase<PH_G1>(p, layer, grid, stream);
    }
    launch_phase<PH_FINAL>(p, DEPTH, grid, stream);
#endif
}
```

```cpp
#include <hip/hip_runtime.h>
#include <stdint.h>
#include <stdio.h>

#ifndef RD_N
#define RD_N 1
#endif
#ifndef RD_E
#define RD_E 1
#endif
#ifndef RD_R
#define RD_R 1
#endif
#ifndef DUP
#define DUP -1
#endif
#ifndef DUPSEL
#define DUPSEL 0
#endif
#ifndef ONE_LAUNCH
#define ONE_LAUNCH 1
#endif

typedef unsigned short bf16_t;
typedef short bf16x8 __attribute__((ext_vector_type(8)));
typedef float f32x4 __attribute__((ext_vector_type(4)));
typedef unsigned u32x4 __attribute__((ext_vector_type(4)));
typedef unsigned u32x2 __attribute__((ext_vector_type(2)));

constexpr int Bb = 8, S = 2048, D = 1024, NTOK = Bb * S, DEPTH = 4, MEM = 256;
constexpr int NEXP = 32, EH = 512;
constexpr int NT = 512;
constexpr float EPS = 1e-6f;

constexpr size_t al256(size_t x) { return (x + 255) & ~(size_t)255; }
constexpr size_t WS_BAR   = 0;
constexpr size_t WS_CNT   = 16384;
constexpr int    CNT_STRIDE = 64;
constexpr size_t WS_QHEAD = 16384 + 65536;
constexpr size_t WS_DONE  = WS_QHEAD + 4096;
constexpr size_t WS_ZERO_BYTES = WS_DONE + (size_t)4 * 32 * 64 * 4;
constexpr size_t WS_MISC  = WS_ZERO_BYTES;
constexpr size_t WS_W_EIN = 131072;
constexpr size_t WS_W_EOUT = WS_W_EIN + (size_t)2 * 3072 * 1024 * 2;
constexpr size_t WS_W_OIN = WS_W_EOUT + (size_t)2 * 1024 * 1024 * 2;
constexpr size_t WS_W_OOUT = WS_W_OIN + (size_t)2 * 1536 * 1024 * 2;
constexpr size_t WS_W_CQ  = WS_W_OOUT + (size_t)2 * 1024 * 1024 * 2;
constexpr size_t WS_W_CKV = WS_W_CQ + (size_t)4 * 512 * 1024 * 2;
constexpr size_t WS_W_CO  = WS_W_CKV + (size_t)4 * 1024 * 1024 * 2;
constexpr size_t WS_W_GU  = WS_W_CO + (size_t)4 * 1024 * 512 * 2;
constexpr size_t WS_W_DN  = WS_W_GU + (size_t)4 * 32 * 1024 * 1024 * 2;
constexpr size_t WS_MEMN  = WS_W_DN + (size_t)4 * 32 * 1024 * 512 * 2;
constexpr size_t WS_XK    = WS_MEMN + (size_t)2048 * 1024 * 2;
constexpr size_t WS_XVT   = WS_XK + (size_t)4 * 2048 * 512 * 2;
constexpr size_t WS_A2    = WS_XVT + (size_t)4 * 2048 * 512 * 2;
constexpr size_t WS_FILT  = WS_A2 + (size_t)2 * 2048 * 64 * 4;
constexpr size_t WS_X     = WS_FILT + (size_t)2 * 2 * 512 * 4096 * 2;
constexpr size_t WS_H     = WS_X + (size_t)NTOK * D * 4;
constexpr size_t WS_PROJ  = WS_H + al256((size_t)(NTOK + 1) * D * 2);
constexpr size_t WS_YMIX  = WS_PROJ + (size_t)NTOK * 3072 * 2;
constexpr size_t WS_QX    = WS_YMIX + (size_t)NTOK * D * 2;
constexpr size_t WS_OX    = WS_QX + (size_t)NTOK * 512 * 2;
constexpr size_t WS_ACT   = WS_OX + (size_t)NTOK * 512 * 2;
constexpr size_t WS_Y     = WS_ACT + al256((size_t)(2 * NTOK + 1) * EH * 2);
constexpr size_t WS_LIST  = WS_Y + (size_t)2 * NTOK * D * 2;
constexpr size_t WS_WT    = WS_LIST + (size_t)NEXP * NTOK * 4;
constexpr size_t WS_RSTD  = WS_WT + (size_t)2 * NTOK * 4;
constexpr size_t WS_WRT   = WS_RSTD + (size_t)NTOK * 4;
constexpr size_t WS_XB    = WS_WRT + (size_t)4 * 2 * 48 * 1024 * 2;
constexpr size_t WS_SSP   = WS_XB + al256((size_t)(NTOK + 1) * D * 2);
constexpr size_t WS_RS1   = WS_SSP + (size_t)NTOK * 16 * 4;
constexpr size_t WS_RP    = WS_RS1 + (size_t)NTOK * 4;
constexpr size_t WS_END   = WS_RP + (size_t)NEXP * NTOK * 4;
constexpr size_t PR_HYT   = 0;
constexpr size_t PR_QK    = (size_t)1536 * NTOK * 2;
constexpr size_t PR_VT    = PR_QK + (size_t)NTOK * 1024 * 2;
constexpr size_t PR_OVT   = (size_t)NTOK * 1280 * 2;

constexpr int LDS_XB = 147456;
constexpr int LDS_ROUTE = LDS_XB + 64;
constexpr int LDS_BYTES = LDS_ROUTE + 2048;

struct Params {
    const float* in[34];
    float* out;
    unsigned char* ws;
};

extern __shared__ __attribute__((aligned(16))) bf16_t shm[];

typedef float f32x2 __attribute__((ext_vector_type(2)));
typedef __bf16 bf16x2v __attribute__((ext_vector_type(2)));
__device__ __forceinline__ unsigned cvt_pk_bf16(float lo, float hi) { const f32x2 v = {lo, hi}; return __builtin_bit_cast(unsigned, __builtin_convertvector(v, bf16x2v)); }
__device__ __forceinline__ float bf2f(unsigned short b) { return __uint_as_float((unsigned)b << 16); }
__device__ __forceinline__ float bflo(unsigned w) { return __uint_as_float(w << 16); }
__device__ __forceinline__ float bfhi(unsigned w) { return __uint_as_float(w & 0xffff0000u); }
__device__ __forceinline__ float shx(float v, int m, int lane) { return __int_as_float(__builtin_amdgcn_ds_bpermute((lane ^ m) << 2, __float_as_int(v))); }
__device__ __forceinline__ float shl(float v, int src) { return __int_as_float(__builtin_amdgcn_ds_bpermute(src << 2, __float_as_int(v))); }
__device__ __forceinline__ float wave_sum(float v, int lane) {
    v += shx(v, 1, lane); v += shx(v, 2, lane); v += shx(v, 4, lane); v += shx(v, 8, lane); v += shx(v, 16, lane); v += shx(v, 32, lane); return v;
}

__device__ __forceinline__ float uni(float x) { return __builtin_bit_cast(float, __builtin_amdgcn_readfirstlane(__builtin_bit_cast(int, x))); }
__device__ __forceinline__ int hidden_tid(int wv) { int l; asm volatile("v_mbcnt_lo_u32_b32 %0, -1, 0\n\tv_mbcnt_hi_u32_b32 %0, -1, %0" : "=&v"(l)); return (wv << 6) | l; }

#define XB_TMO      128
#define XB_XCNT(j)  (256  + 64 * (j))
#define XB_XSUB(j)  (1280 + 64 * (j))
#define XB_XGEN(j)  (2304 + 64 * (j))
#define XB_TOP      3328
#define XB_TOPGEN   3392
#define XCD_BAR_WORDS 3456
#define XB_SPIN_CAP (1u << 22)
#define LAS __attribute__((address_space(3)))

__device__ __forceinline__ unsigned xb_ld(unsigned* p)              { return __hip_atomic_load(p, __ATOMIC_RELAXED, __HIP_MEMORY_SCOPE_AGENT); }
__device__ __forceinline__ unsigned xb_add(unsigned* p, unsigned v) { return __hip_atomic_fetch_add(p, v, __ATOMIC_RELAXED, __HIP_MEMORY_SCOPE_AGENT); }
__device__ __forceinline__ unsigned xb_xcc_id() { return (unsigned)__builtin_amdgcn_s_getreg((3 << 11) | 20) & 0xFu; }
#define XB_SPIN(cond, bar) do { unsigned _sp = 0; while (cond) { __builtin_amdgcn_s_sleep(1); \
    if ((++_sp & 255u) == 0u) { if (xb_ld(&(bar)[XB_TMO])) break; if (_sp > XB_SPIN_CAP) { atomicAdd(&(bar)[XB_TMO], 1u); break; } } } } while (0)

struct XcdBarrier { unsigned* bar; unsigned x; volatile LAS unsigned* st; };

__device__ __forceinline__ XcdBarrier xcd_barrier_post(unsigned* bar, volatile LAS unsigned* st) {
    XcdBarrier b; b.bar = bar; b.x = xb_xcc_id(); b.st = st;
    if (threadIdx.x == 0) (void)xb_add(&bar[XB_XCNT(b.x)], 1u);
    return b;
}
__device__ __forceinline__ void xcd_barrier_complete(unsigned* bar, unsigned x, unsigned& nloc, unsigned& nx) {
    const unsigned G = gridDim.x * gridDim.y * gridDim.z;
    unsigned sum, cnt, mine, sp = 0u;
    for (;;) {
        sum = 0u; cnt = 0u; mine = 0u;
#pragma unroll
        for (unsigned j = 0; j < 16; ++j) { const unsigned c = xb_ld(&bar[XB_XCNT(j)]); sum += c; cnt += (c > 0u) ? 1u : 0u; mine = (j == x) ? c : mine; }
        if (sum == G) break;
        __builtin_amdgcn_s_sleep(1);
        if ((++sp & 255u) == 0u) { if (xb_ld(&bar[XB_TMO])) break; if (sp > XB_SPIN_CAP) { atomicAdd(&bar[XB_TMO], 1u); break; } }
    }
    nloc = mine > 0u ? mine : 1u; nx = cnt > 0u ? cnt : 1u;
}
__device__ __forceinline__ void xcd_barrier(const XcdBarrier& b) {
    asm volatile("s_waitcnt vmcnt(0)" ::: "memory");
    __syncthreads();
    if (threadIdx.x == 0) {
        unsigned* bar = b.bar; unsigned bx = b.x;
        asm volatile("" : "+s"(bar), "+s"(bx));
        __builtin_amdgcn_s_waitcnt(0);
        unsigned nloc = b.st[0], nx = b.st[1];
        if (nloc == 0u) { xcd_barrier_complete(bar, bx, nloc, nx); b.st[0] = nloc; b.st[1] = nx; }
        const unsigned old = xb_add(&bar[XB_XSUB(bx)], 1u);
        const unsigned gen = old / nloc;
        if (old + 1u == (gen + 1u) * nloc) {
            __builtin_amdgcn_fence(__ATOMIC_RELEASE, "agent");
            asm volatile("s_waitcnt vmcnt(0)" ::: "memory");
            const unsigned og = xb_add(&bar[XB_TOP], 1u);
            const unsigned tg = og / nx;
            if (og + 1u == (tg + 1u) * nx) xb_add(&bar[XB_TOPGEN], 1u);
            else XB_SPIN(xb_ld(&bar[XB_TOPGEN]) == tg, bar);
            __builtin_amdgcn_fence(__ATOMIC_ACQUIRE, "agent");
            xb_add(&bar[XB_XGEN(bx)], 1u);
            asm volatile("s_waitcnt vmcnt(0)" ::: "memory");
        } else {
            XB_SPIN(xb_ld(&bar[XB_XGEN(bx)]) == gen, bar);
            __builtin_amdgcn_fence(__ATOMIC_ACQUIRE, "agent");
            asm volatile("s_waitcnt vmcnt(0)" ::: "memory");
        }
    }
    __syncthreads();
}

constexpr int HT = 128 * 64;
__device__ __forceinline__ int lds_byte(int r, int c) {
    int st = (r >> 4) * 2 + (c >> 5), rr = r & 15, cc = c & 31, ob = rr * 64 + cc * 2;
    return st * 1024 + (ob ^ (((ob >> 9) & 1) << 5));
}
__device__ __forceinline__ void stage_rc(int b, int& R, int& C) {
    int st = b / 1024, sb = b % 1024, swz = sb ^ (((sb >> 9) & 1) << 5);
    R = (st >> 1) * 16 + swz / 64; C = (st & 1) * 32 + (swz % 64) / 2;
}
#define SA(b, h) (shm + ((b) * 2 + (h)) * HT)
#define SB(b, h) (shm + (4 + (b) * 2 + (h)) * HT)
#define G_STAGE_A(P_, h, kt) do { _Pragma("unroll") for (int _i = 0; _i < 2; ++_i) \
    __builtin_amdgcn_global_load_lds((const unsigned*)((const char*)A + (size_t)((kt) * 128 + (RowSrc::DENSE ? (h) * 256 * K : 0)) + aoff[RowSrc::DENSE ? 0 : (h)][_i]), (unsigned*)((char*)(P_) + tid * 16 + _i * 8192), 16, 0, 0); } while (0)
#define G_STAGE_B(P_, h, kt) do { _Pragma("unroll") for (int _i = 0; _i < 2; ++_i) \
    __builtin_amdgcn_global_load_lds((const unsigned*)((const char*)Bt + (size_t)((kt) * 128 + (h) * 64 * K) + boff[_i]), (unsigned*)((char*)(P_) + tid * 16 + _i * 8192), 16, 0, 0); } while (0)
#define G_LDA(dst, b, h) _Pragma("unroll") for (int m = 0; m < 4; ++m) _Pragma("unroll") for (int k = 0; k < 2; ++k) \
    dst[m][k] = *reinterpret_cast<const bf16x8*>((char*)SA(b, h) + lds_byte(wr * 64 + m * 16 + fr, k * 32 + fq * 8))
#define G_LDB(dst, b, h) _Pragma("unroll") for (int n = 0; n < 2; ++n) _Pragma("unroll") for (int k = 0; k < 2; ++k) \
    dst[n][k] = *reinterpret_cast<const bf16x8*>((char*)SB(b, h) + lds_byte(wc * 32 + n * 16 + fr, k * 32 + fq * 8))
#define G_MMA(ai, bj, At_, Bt_) do { __builtin_amdgcn_s_setprio(1); \
    _Pragma("unroll") for (int m = 0; m < 4; ++m) _Pragma("unroll") for (int n = 0; n < 2; ++n) _Pragma("unroll") for (int k = 0; k < 2; ++k) \
      acc[ai][bj][m][n] = __builtin_amdgcn_mfma_f32_16x16x32_bf16(Bt_[n][k], At_[m][k], acc[ai][bj][m][n], 0, 0, 0); \
    __builtin_amdgcn_s_setprio(0); } while (0)
#define WAIT_V(n) asm volatile("s_waitcnt vmcnt(" #n ")" ::: "memory")
#define WAIT_L(n) asm volatile("s_waitcnt lgkmcnt(" #n ")" ::: "memory")
#define BAR __builtin_amdgcn_s_barrier()
#define SCHED __builtin_amdgcn_sched_barrier(0)

typedef f32x4 AccT[2][2][4][2];

template <class RowSrc, class Epi>
__device__ __forceinline__ void gemm_tile(const bf16_t* __restrict__ A, const bf16_t* __restrict__ Bt, const int K,
                                          const int bcol, const RowSrc& rs, const Epi& epi, const int wv, const int ntl = 0) {
    const int tid = hidden_tid(wv);
    int wid = tid >> 6, lane = tid & 63, wr = wid >> 2, wc = wid & 3, fr = lane & 15, fq = lane >> 4;
    unsigned aoff[2][2], boff[2];
#pragma unroll
    for (int i = 0; i < 2; ++i) {
        int R, C; stage_rc(tid * 16 + i * 8192, R, C);
        boff[i] = (unsigned)(((bcol + (R >> 5) * 64 + (R & 31)) * K + C) * 2);
        if (RowSrc::DENSE) { aoff[0][i] = (unsigned)((R * K + C) * 2); aoff[1][i] = 0u; }
        else {
#pragma unroll
            for (int h = 0; h < 2; ++h) aoff[h][i] = (unsigned)((rs(h * 128 + R) * K + C) * 2);
        }
    }
    AccT acc = {};
    bf16x8 At[4][2], B0[2][2], B1[2][2];
    const int nt = ntl ? ntl : K / 64;
    G_STAGE_B(SB(0, 0), 0, 0); G_STAGE_A(SA(0, 0), 0, 0);
    G_STAGE_B(SB(0, 1), 1, 0); G_STAGE_A(SA(0, 1), 1, 0);
    if (wr == 1) BAR;
    WAIT_V(4); BAR;
    G_STAGE_B(SB(1, 0), 0, 1); G_STAGE_A(SA(1, 0), 0, 1); G_STAGE_B(SB(1, 1), 1, 1);
    WAIT_V(6); BAR;
    for (int t = 0; t < nt - 2; t += 2) {
        G_LDB(B0, 0, 0); SCHED; G_LDA(At, 0, 0); G_STAGE_A(SA(1, 1), 1, t + 1);
        WAIT_L(8); BAR; WAIT_L(0); G_MMA(0, 0, At, B0); BAR; SCHED;
        G_LDB(B1, 0, 1); G_STAGE_B(SB(0, 0), 0, t + 2);
        BAR; WAIT_L(0); G_MMA(0, 1, At, B1); BAR;
        G_LDA(At, 0, 1); G_STAGE_A(SA(0, 0), 0, t + 2);
        BAR; WAIT_L(0); G_MMA(1, 0, At, B0); BAR; SCHED;
        G_STAGE_B(SB(0, 1), 1, t + 2);
        WAIT_V(6); BAR; G_MMA(1, 1, At, B1); BAR;
        G_LDB(B0, 1, 0); SCHED; G_LDA(At, 1, 0); G_STAGE_A(SA(0, 1), 1, t + 2);
        WAIT_L(8); BAR; WAIT_L(0); G_MMA(0, 0, At, B0); BAR; SCHED;
        G_LDB(B1, 1, 1); G_STAGE_B(SB(1, 0), 0, t + 3);
        BAR; WAIT_L(0); G_MMA(0, 1, At, B1); BAR;
        G_LDA(At, 1, 1); G_STAGE_A(SA(1, 0), 0, t + 3);
        BAR; WAIT_L(0); G_MMA(1, 0, At, B0); BAR; SCHED;
        G_STAGE_B(SB(1, 1), 1, t + 3);
        WAIT_V(6); BAR; G_MMA(1, 1, At, B1); BAR;
    }
    { G_LDB(B0, 0, 0); WAIT_V(0); G_LDA(At, 0, 0); G_STAGE_A(SA(1, 1), 1, nt - 1);
      BAR; WAIT_L(0); G_MMA(0, 0, At, B0); BAR;
      G_LDB(B1, 0, 1); BAR; WAIT_L(0); G_MMA(0, 1, At, B1); BAR;
      G_LDA(At, 0, 1); WAIT_V(4); BAR; WAIT_L(0); G_MMA(1, 0, At, B0); G_MMA(1, 1, At, B1); BAR; }
    { G_LDB(B0, 1, 0); G_LDA(At, 1, 0); WAIT_V(2); BAR; WAIT_L(0); G_MMA(0, 0, At, B0); BAR;
      G_LDB(B1, 1, 1); WAIT_V(0); BAR; WAIT_L(0); G_MMA(0, 1, At, B1); BAR;
      G_LDA(At, 1, 1); BAR; WAIT_L(0); G_MMA(1, 0, At, B0); G_MMA(1, 1, At, B1); BAR; }
    if (wr == 0) BAR;
    int tz = hidden_tid(wv); wid = tz >> 6; lane = tz & 63; wr = wid >> 2; wc = wid & 3; fr = lane & 15; fq = lane >> 4;
    epi(acc, wr * 64 + fr, bcol + wc * 64 + fq * 4);
}

struct RowIdent { static constexpr bool DENSE = true; __device__ __forceinline__ int operator()(int r) const { return r; } };

__device__ __forceinline__ void st_bf16x4(bf16_t* p, const f32x4& v) { u32x2 w; w.x = cvt_pk_bf16(v[0], v[1]); w.y = cvt_pk_bf16(v[2], v[3]); *(u32x2*)p = w; }
__device__ __forceinline__ void st_chan4(bf16_t* q, size_t ld, const f32x4& v) {
    const unsigned a = cvt_pk_bf16(v[0], v[1]), b = cvt_pk_bf16(v[2], v[3]);
    q[0] = (bf16_t)(a & 0xffff); q[ld] = (bf16_t)(a >> 16); q[2 * ld] = (bf16_t)(b & 0xffff); q[3 * ld] = (bf16_t)(b >> 16);
}
constexpr int BJS = 32;
#define EPI_LOOP_AM _Pragma("unroll") for (int ai = 0; ai < 2; ++ai) _Pragma("unroll") for (int m = 0; m < 4; ++m)
#define EPI_LOOP_BN _Pragma("unroll") for (int bj = 0; bj < 2; ++bj) _Pragma("unroll") for (int n = 0; n < 2; ++n)
struct EpiRes {
    bf16_t* XB; int brow; float* ssp; int lane;
    __device__ __forceinline__ void operator()(AccT& acc, int r0, int c0) const {
        u32x2 xv[2][4][4];
        EPI_LOOP_AM {
            const bf16_t* qb = XB + (size_t)(brow + r0 + ai * 128 + m * 16) * D + c0;
            EPI_LOOP_BN xv[ai][m][bj * 2 + n] = *(const u32x2*)(qb + bj * BJS + n * 16);
        }
        EPI_LOOP_AM {
            const int row = brow + r0 + ai * 128 + m * 16;
            bf16_t* qb = XB + (size_t)row * D + c0;
            float ss = 0.f;
            EPI_LOOP_BN {
                const u32x2 x = xv[ai][m][bj * 2 + n];
                const f32x4 t = (f32x4){bflo(x.x), bfhi(x.x), bflo(x.y), bfhi(x.y)} + acc[ai][bj][m][n];
                const unsigned a0 = cvt_pk_bf16(t[0], t[1]), a1 = cvt_pk_bf16(t[2], t[3]);
                *(u32x2*)(qb + bj * BJS + n * 16) = (u32x2){a0, a1};
                const float r0f = bflo(a0), r1f = bfhi(a0), r2f = bflo(a1), r3f = bfhi(a1);
                ss += (r0f * r0f + r1f * r1f) + (r2f * r2f + r3f * r3f);
            }
            if (ssp) { ss += shx(ss, 16, lane); ss += shx(ss, 32, lane); if ((lane >> 4) == 0) ssp[(size_t)row * 16 + (c0 >> 6)] = ss; }
        }
    }
};
struct EpiSplit {
    bf16_t* Ca; bf16_t* T; bf16_t* Cb; int c0s, c1s, ldT; size_t ldC; int brow; const float* rs;
    __device__ __forceinline__ void chan(AccT& acc, bf16_t* base, int r0, int c, const float (&scv)[2][4]) const {
        EPI_LOOP_AM { const int row = brow + r0 + ai * 128 + m * 16; const float sc = scv[ai][m];
            bf16_t* q = base + (size_t)c * ldC + row;
            EPI_LOOP_BN st_chan4(q + (size_t)(bj * BJS + n * 16) * ldC, ldC, acc[ai][bj][m][n] * sc); }
    }
    __device__ __forceinline__ void operator()(AccT& acc, int r0, int c0) const {
        const int tilec = __builtin_amdgcn_readfirstlane(c0) & ~255;
        float scv[2][4];
        EPI_LOOP_AM scv[ai][m] = rs ? rs[brow + r0 + ai * 128 + m * 16] : 1.0f;
        if (tilec < c0s) chan(acc, Ca, r0, c0, scv);
        else if (tilec < c1s) {
            EPI_LOOP_AM { const int row = brow + r0 + ai * 128 + m * 16; const float sc = scv[ai][m];
                bf16_t* q = T + (size_t)row * ldT + (c0 - c0s);
                EPI_LOOP_BN st_bf16x4(q + bj * BJS + n * 16, acc[ai][bj][m][n] * sc); }
        } else chan(acc, Cb, r0, c0 - c1s, scv);
    }
};
struct EpiTokRstd {
    bf16_t* T; int ldT, brow; const float* ssp; int lane;
    __device__ __forceinline__ void operator()(AccT& acc, int r0, int c0) const {
        f32x4 pv[2][4];
        EPI_LOOP_AM pv[ai][m] = *(const f32x4*)(ssp + (size_t)(brow + r0 + ai * 128 + m * 16) * 16 + (lane >> 4) * 4);
        EPI_LOOP_AM {
            const int row = brow + r0 + ai * 128 + m * 16;
            float ssq = (pv[ai][m][0] + pv[ai][m][1]) + (pv[ai][m][2] + pv[ai][m][3]);
            ssq += shx(ssq, 16, lane); ssq += shx(ssq, 32, lane);
            const float rs = rsqrtf(ssq * (1.0f / 1024.0f) + EPS);
            bf16_t* q = T + (size_t)row * ldT + c0;
            EPI_LOOP_BN st_bf16x4(q + bj * BJS + n * 16, acc[ai][bj][m][n] * rs);
        }
    }
};
struct EpiGateUp {
    bf16_t* act; const int* list; int cnt, pos0; const float* rp;
    __device__ __forceinline__ void operator()(AccT& acc, int r0, int c0) const {
        int av[2][4]; float rv[2][4];
        EPI_LOOP_AM { const int pos = pos0 + r0 + ai * 128 + m * 16, pc = pos < cnt ? pos : cnt - 1; av[ai][m] = list[pc]; rv[ai][m] = rp[pc]; }
        EPI_LOOP_AM {
            const int pos = pos0 + r0 + ai * 128 + m * 16;
            if (pos < cnt) {
                const int a = av[ai][m];
                const float rs = rv[ai][m];
#pragma unroll
                for (int bj = 0; bj < 2; ++bj) {
                    const f32x4 g = acc[ai][bj][m][0] * rs, u = acc[ai][bj][m][1] * rs; f32x4 o;
#pragma unroll
                    for (int j = 0; j < 4; ++j) o[j] = g[j] * __builtin_amdgcn_rcpf(1.0f + __builtin_amdgcn_exp2f(g[j] * -1.4426950408889634f)) * u[j];
                    const int col = c0 + bj * BJS;
                    const unsigned long long wv8 = ((unsigned long long)cvt_pk_bf16(o[2], o[3]) << 32) | cvt_pk_bf16(o[0], o[1]);
                    __hip_atomic_store((unsigned long long*)(act + (size_t)a * EH + (col >> 5) * 16 + (col & 15)), wv8, __ATOMIC_RELAXED, __HIP_MEMORY_SCOPE_AGENT);
                }
            }
        }
    }
};
struct EpiDown {
    bf16_t* y; const int* list; int cnt, pos0;
    __device__ __forceinline__ void operator()(AccT& acc, int r0, int c0) const {
        int av[2][4];
        EPI_LOOP_AM { const int pos = pos0 + r0 + ai * 128 + m * 16, pc = pos < cnt ? pos : cnt - 1; av[ai][m] = list[pc]; }
        EPI_LOOP_AM {
            const int pos = pos0 + r0 + ai * 128 + m * 16;
            if (pos < cnt) { bf16_t* q = y + (size_t)av[ai][m] * D + c0; EPI_LOOP_BN st_bf16x4(q + bj * BJS + n * 16, acc[ai][bj][m][n]); }
        }
    }
};
struct EpiNull {
    float* sink; int flag; int brow;
    __device__ __forceinline__ void operator()(AccT& acc, int r0, int c0) const {
        if (flag) { f32x4 t = {0.f, 0.f, 0.f, 0.f}; EPI_LOOP_AM EPI_LOOP_BN t += acc[ai][bj][m][n]; *(f32x4*)(sink + (size_t)(brow + r0) * 4 + c0) = t; }
    }
};
struct RowTok { static constexpr bool DENSE = false; const int* list; int cnt, pos0; __device__ __forceinline__ int operator()(int r) const { const int pos = pos0 + r; return pos < cnt ? (list[pos] >> 1) : NTOK; } };
struct RowAsg { static constexpr bool DENSE = false; const int* list; int cnt, pos0; __device__ __forceinline__ int operator()(int r) const { const int pos = pos0 + r; return pos < cnt ? list[pos] : 2 * NTOK; } };

constexpr int ATT_VOFF = 16384;
template <int MODE> struct ACfg;
template <> struct ACfg<0> { static constexpr int DQK = 64, DV = 128, NMAP = 2, KBLK = 2; };
template <> struct ACfg<1> { static constexpr int DQK = 64, DV = 64, NMAP = 1, KBLK = 1; };
template <> struct ACfg<2> { static constexpr int DQK = 128, DV = 128, NMAP = 1, KBLK = 2; };

template <int MODE, bool ALT = false>
__device__ __forceinline__ void attn_unit(const bf16_t* __restrict__ Qp, const int ldq,
                                          const bf16_t* __restrict__ Kp, const int ldk,
                                          const bf16_t* __restrict__ Vt, const size_t ldvt,
                                          const int q0, const int kbeg, const int kend,
                                          const float scale, const float slope, const float m_init, const float l_init,
                                          bf16_t* __restrict__ Op, const int ldo,
                                          const float lam, const float outscale, const float* __restrict__ subln, const int wv) {
    constexpr int DQK = ACfg<MODE>::DQK, DV = ACfg<MODE>::DV, NMAP = ACfg<MODE>::NMAP, KBLK = ACfg<MODE>::KBLK;
    const int tid = hidden_tid(wv), w = tid >> 6, lane = tid & 63, fr = lane & 15, fq = lane >> 4;
    const int qrow = q0 + w * 16 + fr;
    bf16x8 Qf[NMAP][DQK / 32];
#pragma unroll
    for (int m = 0; m < NMAP; ++m)
#pragma unroll
        for (int kk = 0; kk < DQK / 32; ++kk) Qf[m][kk] = *(const bf16x8*)(Qp + (size_t)qrow * ldq + m * DQK + kk * 32 + fq * 8);
    constexpr float LOG2E = 1.4426950408889634f;
    const float scale2 = scale * LOG2E, slope2 = slope * LOG2E, kappa = slope / scale;
    f32x4 O[NMAP][DV / 16], Ol[NMAP];
    float mrun[NMAP];
#pragma unroll
    for (int m = 0; m < NMAP; ++m) {
        mrun[m] = m_init * LOG2E; Ol[m] = (f32x4){(fq == 0) ? l_init : 0.f, 0.f, 0.f, 0.f};
#pragma unroll
        for (int et = 0; et < DV / 16; ++et) O[m][et] = (f32x4){0.f, 0.f, 0.f, 0.f};
    }
    const unsigned onesw = (fr == 0) ? 0x3f803f80u : 0u;
    const bf16x8 onesf = __builtin_bit_cast(bf16x8, (u32x4){onesw, onesw, onesw, onesw});
    char* const lds = (char*)shm;
    constexpr int KN = KBLK, VN = DV / 64;
    u32x4 kreg[KN], vreg[VN];
#define ATT_LOAD(k0_) do { \
        _Pragma("unroll") for (int i_ = 0; i_ < KN; ++i_) { const int c_ = tid + i_ * NT; const int key_ = c_ / (KBLK * 8), col_ = (c_ % (KBLK * 8)) * 8; \
            kreg[i_] = *(const u32x4*)(Kp + (size_t)((k0_) + key_) * ldk + col_); } \
        _Pragma("unroll") for (int i_ = 0; i_ < VN; ++i_) { const int c_ = tid + i_ * NT; const int e_ = c_ >> 3, kc_ = c_ & 7; \
            vreg[i_] = *(const u32x4*)(Vt + (size_t)e_ * ldvt + (k0_) + kc_ * 8); } } while (0)
    ATT_LOAD(kbeg);
    const int qw0 = q0 + w * 16;
    constexpr int VBYTES = DV * 160;
    bf16x8 Pf[NMAP][2];
#define ATT_PV_C(voff_, c) do { \
            bf16x8 vf[DV / 16]; \
            _Pragma("unroll") for (int et = 0; et < DV / 16; ++et) vf[et] = *(const bf16x8*)(lds + (voff_) + (et * 16 + fr) * 160 + (c) * 64 + fq * 16); \
            _Pragma("unroll") for (int m = 0; m < NMAP; ++m) Ol[m] = __builtin_amdgcn_mfma_f32_16x16x32_bf16(onesf, Pf[m][c], Ol[m], 0, 0, 0); \
            _Pragma("unroll") for (int et = 0; et < DV / 16; ++et) \
                _Pragma("unroll") for (int m = 0; m < NMAP; ++m) O[m][et] = __builtin_amdgcn_mfma_f32_16x16x32_bf16(vf[et], Pf[m][c], O[m][et], 0, 0, 0); \
        } while (0)
    int vcur = ATT_VOFF;
    for (int k0 = kbeg; k0 < kend; k0 += 64) {
        __syncthreads();
#pragma unroll
        for (int i = 0; i < KN; ++i) { const int c = tid + i * NT; const int key = c / (KBLK * 8), col = (c % (KBLK * 8)) * 8;
            *(u32x4*)(lds + (col >> 6) * 8192 + lds_byte(key, col & 63)) = kreg[i]; }
#pragma unroll
        for (int i = 0; i < VN; ++i) { const int c = tid + i * NT; const int e = c >> 3, kc = c & 7;
            char* vd = lds + vcur + e * 160 + (kc >> 2) * 64 + (kc & 1) * 32 + ((kc >> 1) & 1) * 8;
            *(u32x2*)vd = (u32x2){vreg[i].x, vreg[i].y}; *(u32x2*)(vd + 16) = (u32x2){vreg[i].z, vreg[i].w}; }
        __syncthreads();
        if (k0 + 64 < kend) ATT_LOAD(k0 + 64);
        const int vprev = vcur ^ ATT_VOFF ^ (ATT_VOFF + VBYTES);
        const float dq = (float)(qrow - k0);
        bool gen;
        if (MODE == 2) gen = false;
        else if (MODE == 1) gen = !((k0 + 63 <= qw0 && qw0 + 15 - k0 <= 128) || (k0 >= qw0 + 15 && k0 + 63 - qw0 <= 128));
        else gen = !(k0 + 63 <= qw0 || k0 >= qw0 + 15);
        const bool pos = (MODE == 2) || (k0 + 63 <= qw0);
        f32x4 Cin[4]; float off;
        if (MODE == 2) {
#pragma unroll
            for (int t = 0; t < 4; ++t) Cin[t] = (f32x4){0.f, 0.f, 0.f, 0.f};
            off = 0.f;
        } else if (gen) {
#pragma unroll
            for (int t = 0; t < 4; ++t)
#pragma unroll
                for (int r = 0; r < 4; ++r) Cin[t][r] = -kappa * fabsf(dq - (float)(16 * t + 4 * fq + r));
            off = 0.f;
        } else {
            const float sk = pos ? kappa : -kappa, cb = sk * (float)(4 * fq);
#pragma unroll
            for (int t = 0; t < 4; ++t)
#pragma unroll
                for (int r = 0; r < 4; ++r) Cin[t][r] = sk * (float)(16 * t + r) + cb;
            off = pos ? -slope2 * dq : slope2 * dq;
        }
        f32x4 s[NMAP][4];
#pragma unroll
        for (int m = 0; m < NMAP; ++m) {
            bf16x8 kf[4][DQK / 32];
#pragma unroll
            for (int t = 0; t < 4; ++t)
#pragma unroll
                for (int kk = 0; kk < DQK / 32; ++kk) {
                    const int blk = (MODE == 2) ? (kk >> 1) : m, kcol = (MODE == 2) ? (kk & 1) * 32 : kk * 32;
                    kf[t][kk] = *(const bf16x8*)(lds + blk * 8192 + lds_byte(t * 16 + fr, kcol + fq * 8));
                }
#pragma unroll
            for (int t = 0; t < 4; ++t) {
                s[m][t] = Cin[t];
#pragma unroll
                for (int kk = 0; kk < DQK / 32; ++kk) s[m][t] = __builtin_amdgcn_mfma_f32_16x16x32_bf16(kf[t][kk], Qf[m][kk], s[m][t], 0, 0, 0);
            }
        }
        float mx[NMAP], mx1[NMAP];
#pragma unroll
        for (int m = 0; m < NMAP; ++m) {
            if (MODE == 1 && gen) {
#pragma unroll
                for (int t = 0; t < 4; ++t)
#pragma unroll
                    for (int r = 0; r < 4; ++r) s[m][t][r] = (fabsf(dq - (float)(16 * t + 4 * fq + r)) > 128.0f) ? -1e30f : s[m][t][r];
            }
            float v = fmaxf(fmaxf(s[m][0][0], s[m][0][1]), fmaxf(s[m][0][2], s[m][0][3]));
#pragma unroll
            for (int t = 1; t < 4; ++t) v = fmaxf(v, fmaxf(fmaxf(s[m][t][0], s[m][t][1]), fmaxf(s[m][t][2], s[m][t][3])));
            mx[m] = v; mx1[m] = shx(v, 16, lane);
        }
        __builtin_amdgcn_sched_barrier(0);
        if (k0 > kbeg) ATT_PV_C(vprev, 0);
        __builtin_amdgcn_sched_barrier(0);
#pragma unroll
        for (int m = 0; m < NMAP; ++m) { mx[m] = fmaxf(mx[m], mx1[m]); mx1[m] = shx(mx[m], 32, lane); }
        __builtin_amdgcn_sched_barrier(0);
        if (k0 > kbeg) ATT_PV_C(vprev, 1);
        __builtin_amdgcn_sched_barrier(0);
#pragma unroll
        for (int m = 0; m < NMAP; ++m) {
            const float mxx = fmaxf(mx[m], mx1[m]);
            const float mtile = fmaxf(mxx * scale2 + off, -1e30f);
            const float mnew = fmaxf(mrun[m], mtile), alpha = __builtin_amdgcn_exp2f(mrun[m] - mnew);
            mrun[m] = mnew;
            const float sub = off - mnew;
#pragma unroll
            for (int t = 0; t < 4; ++t)
#pragma unroll
                for (int r = 0; r < 4; ++r) s[m][t][r] = __builtin_amdgcn_exp2f(s[m][t][r] * scale2 + sub);
            if (__builtin_amdgcn_ballot_w64(alpha != 1.0f) != 0ull) {
                Ol[m] *= alpha;
#pragma unroll
                for (int et = 0; et < DV / 16; ++et) O[m][et] *= alpha;
            }
#pragma unroll
            for (int c = 0; c < 2; ++c) {
                u32x4 pk; pk.x = cvt_pk_bf16(s[m][2 * c][0], s[m][2 * c][1]); pk.y = cvt_pk_bf16(s[m][2 * c][2], s[m][2 * c][3]);
                pk.z = cvt_pk_bf16(s[m][2 * c + 1][0], s[m][2 * c + 1][1]); pk.w = cvt_pk_bf16(s[m][2 * c + 1][2], s[m][2 * c + 1][3]);
                Pf[m][c] = __builtin_bit_cast(bf16x8, pk);
            }
        }
        vcur = vprev;
    }
    { const int vlast = vcur ^ ATT_VOFF ^ (ATT_VOFF + VBYTES); ATT_PV_C(vlast, 0); ATT_PV_C(vlast, 1); }
    float linv[NMAP];
#pragma unroll
    for (int m = 0; m < NMAP; ++m) linv[m] = 1.0f / shl(Ol[m][0], fr);
    const int tid2 = hidden_tid(wv); const int qrow_o = q0 + (tid2 >> 6) * 16 + (tid2 & 15);
    if (MODE == 0) {
        float ss = 0.f;
#pragma unroll
        for (int et = 0; et < DV / 16; ++et)
#pragma unroll
            for (int r = 0; r < 4; ++r) { const float v = O[0][et][r] * linv[0] - lam * (O[NMAP - 1][et][r] * linv[NMAP - 1]); O[0][et][r] = v; ss += v * v; }
        ss += shx(ss, 16, lane); ss += shx(ss, 32, lane);
        const float rs = rsqrtf(ss * (1.0f / 128.0f) + EPS) * outscale;
#pragma unroll
        for (int et = 0; et < DV / 16; ++et) {
            const f32x4 g = *(const f32x4*)(subln + et * 16 + fq * 4);
            st_bf16x4(Op + (size_t)qrow_o * ldo + et * 16 + fq * 4, O[0][et] * rs * g);
        }
    } else {
#pragma unroll
        for (int et = 0; et < DV / 16; ++et) st_bf16x4(Op + (size_t)qrow_o * ldo + et * 16 + fq * 4, O[0][et] * linv[0]);
    }
}

template <int MODE>
__device__ __forceinline__ void attn2_unit(const bf16_t* __restrict__ Qp, const int ldq, const bf16_t* __restrict__ Kp, const int ldk,
                                           const bf16_t* __restrict__ Vt, const size_t ldvt, const int q0, const int kbeg, const int kend,
                                           const float scale, const float* __restrict__ sinkp, const int hq0, bf16_t* __restrict__ Op, const int ldo, const int wv) {
    constexpr int DQK = ACfg<MODE>::DQK, DV = ACfg<MODE>::DV, KBLK = ACfg<MODE>::KBLK, RT = 2;
    const int tid = hidden_tid(wv), w = tid >> 6, lane = tid & 63, fr = lane & 15, fq = lane >> 4;
    const int hl = (MODE == 1) ? (w >> 1) : 0, qsub = (MODE == 1) ? (w & 1) * 32 : w * 32;
    const float slope = (MODE == 1) ? exp2f(-0.5f * (float)(hq0 + hl + 1)) : 0.f;
    const float m_init = (MODE == 1) ? sinkp[hl] : -1e30f, l_init = (MODE == 1) ? 1.0f : 0.f;
    constexpr float LOG2E = 1.4426950408889634f;
    const float scale2 = scale * LOG2E, slope2 = slope * LOG2E, kappa = slope / scale;
    bf16x8 Qf[RT][DQK / 32];
#pragma unroll
    for (int rt = 0; rt < RT; ++rt)
#pragma unroll
        for (int kk = 0; kk < DQK / 32; ++kk) Qf[rt][kk] = *(const bf16x8*)(Qp + (size_t)(q0 + qsub + 16 * rt + fr) * ldq + hl * 64 + kk * 32 + fq * 8);
    f32x4 O[RT][DV / 16], Ol[RT];
    float mrun[RT];
#pragma unroll
    for (int rt = 0; rt < RT; ++rt) {
        mrun[rt] = m_init * LOG2E; Ol[rt] = (f32x4){(fq == 0) ? l_init : 0.f, 0.f, 0.f, 0.f};
#pragma unroll
        for (int et = 0; et < DV / 16; ++et) O[rt][et] = (f32x4){0.f, 0.f, 0.f, 0.f};
    }
    const unsigned onesw = (fr == 0) ? 0x3f803f80u : 0u;
    const bf16x8 onesf = __builtin_bit_cast(bf16x8, (u32x4){onesw, onesw, onesw, onesw});
    char* const lds = (char*)shm;
    constexpr int KN = KBLK, VN = DV / 64;
    u32x4 kreg[KN], vreg[VN];
#define ATT2_LOAD(k0_) do { \
        _Pragma("unroll") for (int i_ = 0; i_ < KN; ++i_) { const int c_ = tid + i_ * NT; const int key_ = c_ / (KBLK * 8), col_ = (c_ % (KBLK * 8)) * 8; \
            kreg[i_] = *(const u32x4*)(Kp + (size_t)((k0_) + key_) * ldk + col_); } \
        _Pragma("unroll") for (int i_ = 0; i_ < VN; ++i_) { const int c_ = tid + i_ * NT; const int e_ = c_ >> 3, kc_ = c_ & 7; \
            vreg[i_] = *(const u32x4*)(Vt + (size_t)e_ * ldvt + (k0_) + kc_ * 8); } } while (0)
    ATT2_LOAD(kbeg);
    constexpr int VBYTES = DV * 160;
    bf16x8 Pf[RT][2];
#define ATT2_PV_C(voff_, c) do { \
            bf16x8 vf[DV / 16]; \
            _Pragma("unroll") for (int et = 0; et < DV / 16; ++et) vf[et] = *(const bf16x8*)(lds + (voff_) + (et * 16 + fr) * 160 + (c) * 64 + fq * 16); \
            _Pragma("unroll") for (int rt = 0; rt < RT; ++rt) Ol[rt] = __builtin_amdgcn_mfma_f32_16x16x32_bf16(onesf, Pf[rt][c], Ol[rt], 0, 0, 0); \
            _Pragma("unroll") for (int et = 0; et < DV / 16; ++et) \
                _Pragma("unroll") for (int rt = 0; rt < RT; ++rt) O[rt][et] = __builtin_amdgcn_mfma_f32_16x16x32_bf16(vf[et], Pf[rt][c], O[rt][et], 0, 0, 0); \
        } while (0)
    int vcur = ATT_VOFF;
    for (int k0 = kbeg; k0 < kend; k0 += 64) {
        __syncthreads();
#pragma unroll
        for (int i = 0; i < KN; ++i) { const int c = tid + i * NT; const int key = c / (KBLK * 8), col = (c % (KBLK * 8)) * 8;
            *(u32x4*)(lds + (col >> 6) * 8192 + lds_byte(key, col & 63)) = kreg[i]; }
#pragma unroll
        for (int i = 0; i < VN; ++i) { const int c = tid + i * NT; const int e = c >> 3, kc = c & 7;
            char* vd = lds + vcur + e * 160 + (kc >> 2) * 64 + (kc & 1) * 32 + ((kc >> 1) & 1) * 8;
            *(u32x2*)vd = (u32x2){vreg[i].x, vreg[i].y}; *(u32x2*)(vd + 16) = (u32x2){vreg[i].z, vreg[i].w}; }
        __syncthreads();
        if (k0 + 64 < kend) ATT2_LOAD(k0 + 64);
        const int vprev = vcur ^ ATT_VOFF ^ (ATT_VOFF + VBYTES);
        f32x4 s[RT][4]; float off[RT], dqv[RT]; bool genv[RT];
#pragma unroll
        for (int rt = 0; rt < RT; ++rt) {
            const int qw0 = q0 + qsub + 16 * rt;
            const float dq = (float)(qw0 + fr - k0); dqv[rt] = dq;
            const bool gen = (MODE == 1) && !((k0 + 63 <= qw0 && qw0 + 15 - k0 <= 128) || (k0 >= qw0 + 15 && k0 + 63 - qw0 <= 128));
            const bool pos = (MODE == 2) || (k0 + 63 <= qw0);
            genv[rt] = gen;
            if (MODE == 2) {
#pragma unroll
                for (int t = 0; t < 4; ++t) s[rt][t] = (f32x4){0.f, 0.f, 0.f, 0.f};
                off[rt] = 0.f;
            } else if (gen) {
#pragma unroll
                for (int t = 0; t < 4; ++t)
#pragma unroll
                    for (int r = 0; r < 4; ++r) s[rt][t][r] = -kappa * fabsf(dq - (float)(16 * t + 4 * fq + r));
                off[rt] = 0.f;
            } else {
                const float sk = pos ? kappa : -kappa; float cb = sk * (float)(4 * fq);
                asm volatile("" : "+v"(cb));
#pragma unroll
                for (int t = 0; t < 4; ++t)
#pragma unroll
                    for (int r = 0; r < 4; ++r) s[rt][t][r] = sk * (float)(16 * t + r) + cb;
                off[rt] = pos ? -slope2 * dq : slope2 * dq;
            }
        }
#pragma unroll
        for (int t = 0; t < 4; ++t) {
            bf16x8 kf[DQK / 32];
#pragma unroll
            for (int kk = 0; kk < DQK / 32; ++kk) {
                const int blk = (MODE == 2) ? (kk >> 1) : 0, kcol = (MODE == 2) ? (kk & 1) * 32 : kk * 32;
                kf[kk] = *(const bf16x8*)(lds + blk * 8192 + lds_byte(t * 16 + fr, kcol + fq * 8));
            }
#pragma unroll
            for (int rt = 0; rt < RT; ++rt)
#pragma unroll
                for (int kk = 0; kk < DQK / 32; ++kk) s[rt][t] = __builtin_amdgcn_mfma_f32_16x16x32_bf16(kf[kk], Qf[rt][kk], s[rt][t], 0, 0, 0);
        }
        float mx[RT], mx1[RT];
#pragma unroll
        for (int rt = 0; rt < RT; ++rt) {
            if (MODE == 1 && genv[rt]) {
#pragma unroll
                for (int t = 0; t < 4; ++t)
#pragma unroll
                    for (int r = 0; r < 4; ++r) s[rt][t][r] = (fabsf(dqv[rt] - (float)(16 * t + 4 * fq + r)) > 128.0f) ? -1e30f : s[rt][t][r];
            }
            float v = fmaxf(fmaxf(s[rt][0][0], s[rt][0][1]), fmaxf(s[rt][0][2], s[rt][0][3]));
#pragma unroll
            for (int t = 1; t < 4; ++t) v = fmaxf(v, fmaxf(fmaxf(s[rt][t][0], s[rt][t][1]), fmaxf(s[rt][t][2], s[rt][t][3])));
            mx[rt] = v; mx1[rt] = shx(v, 16, lane);
        }
        __builtin_amdgcn_sched_barrier(0);
        if (k0 > kbeg) ATT2_PV_C(vprev, 0);
        __builtin_amdgcn_sched_barrier(0);
#pragma unroll
        for (int rt = 0; rt < RT; ++rt) { mx[rt] = fmaxf(mx[rt], mx1[rt]); mx1[rt] = shx(mx[rt], 32, lane); }
        __builtin_amdgcn_sched_barrier(0);
        if (k0 > kbeg) ATT2_PV_C(vprev, 1);
        __builtin_amdgcn_sched_barrier(0);
#pragma unroll
        for (int rt = 0; rt < RT; ++rt) {
            const float mxx = fmaxf(mx[rt], mx1[rt]);
            const float mtile = fmaxf(mxx * scale2 + off[rt], -1e30f);
            const float mnew = fmaxf(mrun[rt], mtile), alpha = __builtin_amdgcn_exp2f(mrun[rt] - mnew);
            mrun[rt] = mnew;
            const float sub = off[rt] - mnew;
#pragma unroll
            for (int t = 0; t < 4; ++t)
#pragma unroll
                for (int r = 0; r < 4; ++r) s[rt][t][r] = __builtin_amdgcn_exp2f(s[rt][t][r] * scale2 + sub);
            if (__builtin_amdgcn_ballot_w64(alpha != 1.0f) != 0ull) {
                Ol[rt] *= alpha;
#pragma unroll
                for (int et = 0; et < DV / 16; ++et) O[rt][et] *= alpha;
            }
#pragma unroll
            for (int c = 0; c < 2; ++c) {
                u32x4 pk; pk.x = cvt_pk_bf16(s[rt][2 * c][0], s[rt][2 * c][1]); pk.y = cvt_pk_bf16(s[rt][2 * c][2], s[rt][2 * c][3]);
                pk.z = cvt_pk_bf16(s[rt][2 * c + 1][0], s[rt][2 * c + 1][1]); pk.w = cvt_pk_bf16(s[rt][2 * c + 1][2], s[rt][2 * c + 1][3]);
                Pf[rt][c] = __builtin_bit_cast(bf16x8, pk);
            }
        }
        vcur = vprev;
    }
    { const int vlast = vcur ^ ATT_VOFF ^ (ATT_VOFF + VBYTES); ATT2_PV_C(vlast, 0); ATT2_PV_C(vlast, 1); }
    const int tid2 = hidden_tid(wv), w2 = tid2 >> 6, fr2 = tid2 & 15;
    const int hl2 = (MODE == 1) ? (w2 >> 1) : 0, qsub2 = (MODE == 1) ? (w2 & 1) * 32 : w2 * 32;
#pragma unroll
    for (int rt = 0; rt < RT; ++rt) {
        const float linv = 1.0f / shl(Ol[rt][0], fr);
        bf16_t* orow = Op + (size_t)(q0 + qsub2 + 16 * rt + fr2) * ldo + hl2 * 64;
#pragma unroll
        for (int et = 0; et < DV / 16; ++et) st_bf16x4(orow + et * 16 + fq * 4, O[rt][et] * linv);
    }
#undef ATT2_LOAD
#undef ATT2_PV_C
}

constexpr int HZ_RS = 4896;
constexpr int HZ_PAD = 192;
constexpr int H_CPS = 8256;
constexpr int H_ZOFF = 0, H_CPOFF = 8 * HZ_RS, H_RAWOFF = H_CPOFF + 8 * H_CPS;

template <bool ALT>
__device__ __forceinline__ void hyena_unit(const Params& p, const int lj  , const int c, const int wv) {
    const int tid = hidden_tid(wv), w = tid >> 6, lane = tid & 63, fr = lane & 15, fq = lane >> 4;
    char* const lds = (char*)shm;
    const bf16_t* hyT = (const bf16_t*)(p.ws + WS_PROJ + PR_HYT);
    const float* cw = p.in[4] + (size_t)lj * 3 * 1536; const float* cb = p.in[5] + (size_t)lj * 1536;
    const int nb = fr >> 1, tbp = fr & 1;
    __syncthreads();
    for (int i = tid; i < 8 * 2 * (HZ_PAD / 8); i += NT) {
        const int b = i / (2 * (HZ_PAD / 8)), r = i % (2 * (HZ_PAD / 8)), side = r / (HZ_PAD / 8), k = r % (HZ_PAD / 8);
        unsigned zz0 = 0u; asm volatile("" : "+v"(zz0));
        *(u32x4*)(lds + H_ZOFF + b * HZ_RS + (side ? (HZ_PAD + 2048) * 2 : 0) + k * 16) = (u32x4){zz0, zz0, zz0, zz0};
        if (i < 2) *(u32x4*)(lds + H_RAWOFF + 8192 + i * 16) = (u32x4){zz0, zz0, zz0, zz0};
    }
    {
        const float w0 = cw[c], w1 = cw[1536 + c], w2 = cw[2 * 1536 + c], bb = cb[c];
        const bf16_t* src = hyT + (size_t)c * NTOK;
        u32x4 v[4]; unsigned short um[4], up[4];
#pragma unroll
        for (int k = 0; k < 4; ++k) {
            const int i = tid + k * NT, b = i >> 8, s0 = (i & 255) * 8;
            const bf16_t* q = src + b * S + s0;
            v[k] = *(const u32x4*)q; um[k] = q[s0 > 0 ? -1 : 0]; up[k] = q[s0 + 8 < S ? 8 : 7];
        }
#pragma unroll
        for (int k = 0; k < 4; ++k) {
            const int i = tid + k * NT, b = i >> 8, s0 = (i & 255) * 8;
            float u[10];
            u[0] = (s0 > 0) ? bf2f(um[k]) : 0.f; u[9] = (s0 + 8 < S) ? bf2f(up[k]) : 0.f;
            u[1] = bflo(v[k].x); u[2] = bfhi(v[k].x); u[3] = bflo(v[k].y); u[4] = bfhi(v[k].y); u[5] = bflo(v[k].z); u[6] = bfhi(v[k].z); u[7] = bflo(v[k].w); u[8] = bfhi(v[k].w);
            float o[8];
#pragma unroll
            for (int j = 0; j < 8; ++j) o[j] = w0 * u[j] + w1 * u[j + 1] + w2 * u[j + 2] + bb;
            u32x4 ov; ov.x = cvt_pk_bf16(o[0], o[1]); ov.y = cvt_pk_bf16(o[2], o[3]); ov.z = cvt_pk_bf16(o[4], o[5]); ov.w = cvt_pk_bf16(o[6], o[7]);
            *(u32x4*)(lds + H_ZOFF + b * HZ_RS + (HZ_PAD + s0) * 2) = ov;
        }
    }
#pragma unroll 1
    for (int order = 0; order < 2; ++order) {
        const int gch = 512 * (order + 1) + c;
        const bf16_t* gsrc = hyT + (size_t)gch * NTOK;
        u32x2 gv[2][4]; unsigned short gm[2][4], gp[2][4];
        u32x4 rawv;
        {
            const bf16_t* f = (const bf16_t*)(p.ws + WS_FILT) + ((size_t)(lj * 2 + order) * 512 + c) * 4096;
            rawv = *(const u32x4*)(f + tid * 8);
#pragma unroll
            for (int ci = 0; ci < 2; ++ci)
#pragma unroll
                for (int mt = 0; mt < 4; ++mt) {
                    const int t = 64 * (4 * w + 2 * ci + tbp) + 16 * mt + 4 * fq;
                    const bf16_t* gq = gsrc + nb * S + t;
                    gv[ci][mt] = *(const u32x2*)gq; gm[ci][mt] = gq[t > 0 ? -1 : 0]; gp[ci][mt] = gq[t + 4 < S ? 4 : 3];
                }
        }
        *(u32x4*)(lds + H_RAWOFF + tid * 16) = rawv;
        __syncthreads();
        {
            const bf16_t* raw = (const bf16_t*)(lds + H_RAWOFF);
            const int o = w;
#pragma unroll
            for (int k = 0; k < 8; ++k) {
                const int a = lane + 64 * k;
                unsigned short e[8];
#pragma unroll
                for (int j = 0; j < 8; ++j) e[j] = raw[8 * a + o + j];
                u32x4 ov; ov.x = e[0] | ((unsigned)e[1] << 16); ov.y = e[2] | ((unsigned)e[3] << 16); ov.z = e[4] | ((unsigned)e[5] << 16); ov.w = e[6] | ((unsigned)e[7] << 16);
                *(u32x4*)(lds + H_CPOFF + o * H_CPS + a * 16) = ov;
            }
        }
        __syncthreads();
        f32x4 acc[2][4];
#pragma unroll
        for (int ci = 0; ci < 2; ++ci)
#pragma unroll
            for (int mt = 0; mt < 4; ++mt) acc[ci][mt] = (f32x4){0.f, 0.f, 0.f, 0.f};
        {
            const int acp = H_CPOFF + (7 - (fr & 7)) * H_CPS + (255 - (fr >> 3) + fq) * 16;
            const int zb = H_ZOFF + nb * HZ_RS + (HZ_PAD + 8 * fq) * 2;
            for (int dl = 4 * w - 31; dl <= ((ALT && DUPSEL >= 5) ? 4 * w - 31 : 4 * w + 3); ++dl) {
#pragma unroll
                for (int kh = 0; kh < 2; ++kh) {
                    bf16x8 Bf[2];
#pragma unroll
                    for (int ci = 0; ci < 2; ++ci) {
                        const int sblk = 4 * w + 2 * ci + tbp - dl;
                        Bf[ci] = *(const bf16x8*)(lds + zb + (64 * sblk + 32 * kh) * 2);
                    }
#pragma unroll
                    for (int mt = 0; mt < 4; ++mt) {
                        const int q = 4 * dl + mt - 2 * kh;
                        const bf16x8 Af = *(const bf16x8*)(lds + acp - 32 * q);
#pragma unroll
                        for (int ci = 0; ci < 2; ++ci) acc[ci][mt] = __builtin_amdgcn_mfma_f32_16x16x32_bf16(Af, Bf[ci], acc[ci][mt], 0, 0, 0);
                    }
                }
            }
        }
        const float hb = p.in[12][(size_t)(lj * 2 + order) * 512 + c];
        const float w0 = cw[gch], w1 = cw[1536 + gch], w2 = cw[2 * 1536 + gch], bb = cb[gch];
        u32x2 zout[2][4];
#pragma unroll
        for (int ci = 0; ci < 2; ++ci)
#pragma unroll
            for (int mt = 0; mt < 4; ++mt) {
                const int t = 64 * (4 * w + 2 * ci + tbp) + 16 * mt + 4 * fq;
                const u32x2 zz = *(const u32x2*)(lds + H_ZOFF + nb * HZ_RS + (HZ_PAD + t) * 2);
                float u[6];
                u[0] = (t > 0) ? bf2f(gm[ci][mt]) : 0.f; u[5] = (t + 4 < S) ? bf2f(gp[ci][mt]) : 0.f;
                u[1] = bflo(gv[ci][mt].x); u[2] = bfhi(gv[ci][mt].x); u[3] = bflo(gv[ci][mt].y); u[4] = bfhi(gv[ci][mt].y);
                const float z[4] = {bflo(zz.x), bfhi(zz.x), bflo(zz.y), bfhi(zz.y)};
                float o[4];
#pragma unroll
                for (int r = 0; r < 4; ++r) {
                    const float gate = w0 * u[r] + w1 * u[r + 1] + w2 * u[r + 2] + bb;
                    o[r] = gate * (acc[ci][mt][r] + hb * z[r]);
                }
                zout[ci][mt].x = cvt_pk_bf16(o[0], o[1]); zout[ci][mt].y = cvt_pk_bf16(o[2], o[3]);
            }
        __syncthreads();
        if (order == 0) {
#pragma unroll
            for (int ci = 0; ci < 2; ++ci)
#pragma unroll
                for (int mt = 0; mt < 4; ++mt) {
                    const int t = 64 * (4 * w + 2 * ci + tbp) + 16 * mt + 4 * fq;
                    *(u32x2*)(lds + H_ZOFF + nb * HZ_RS + (HZ_PAD + t) * 2) = zout[ci][mt];
                }
        } else {
            bf16_t* yt = (bf16_t*)(p.ws + WS_QX) + (size_t)c * NTOK;
#pragma unroll
            for (int ci = 0; ci < 2; ++ci)
#pragma unroll
                for (int mt = 0; mt < 4; ++mt) {
                    const int t = 64 * (4 * w + 2 * ci + tbp) + 16 * mt + 4 * fq;
                    *(u32x2*)(yt + nb * S + t) = zout[ci][mt];
                }
        }
        __syncthreads();
    }
}

struct Row16 { f32x4 v[4]; };
__device__ __forceinline__ void ld_row(Row16& r, const float* src, int lane) {
#pragma unroll
    for (int i = 0; i < 4; ++i) r.v[i] = *(const f32x4*)(src + 256 * i + 4 * lane);
}
__device__ __forceinline__ void ld_row_bf(Row16& r, const bf16_t* src, int lane) {
#pragma unroll
    for (int i = 0; i < 4; ++i) { const u32x2 v = *(const u32x2*)(src + 256 * i + 4 * lane); r.v[i] = (f32x4){bflo(v.x), bfhi(v.x), bflo(v.y), bfhi(v.y)}; }
}
__device__ __forceinline__ float row_rstd(const Row16& r, int lane) {
    float ss = 0.f;
#pragma unroll
    for (int i = 0; i < 4; ++i) ss += r.v[i][0] * r.v[i][0] + r.v[i][1] * r.v[i][1] + r.v[i][2] * r.v[i][2] + r.v[i][3] * r.v[i][3];
    ss = wave_sum(ss, lane);
    return rsqrtf(ss * (1.0f / 1024.0f) + EPS);
}
template <int KIND  , bool ALT = false>
__device__ __forceinline__ void norm_phase(const Params& p, const int layer, const float* __restrict__ gain, const int bid, const int nb, const int wv) {
    const int tid_ = hidden_tid(wv), lane = tid_ & 63, w = tid_ >> 6;
    bf16_t* XB = (bf16_t*)(p.ws + WS_XB);
    bf16_t* XBo = ALT ? (bf16_t*)(p.ws + WS_PROJ) : XB;
    float* RS1 = (float*)(p.ws + (ALT ? WS_QX : WS_RS1));
    const bf16_t* Y = (const bf16_t*)(p.ws + WS_Y);
    const float* WT = (const float*)(p.ws + WS_WT);
    Row16 g;
    if (KIND == 2) ld_row(g, gain, lane);
    for (int tok = bid * 8 + w; tok < NTOK; tok += nb * 8) {
        Row16 x;
        if (KIND == 0 && layer == 0) ld_row(x, p.in[0] + (size_t)tok * D, lane); else ld_row_bf(x, XB + (size_t)tok * D, lane);
        if ((KIND == 0 && layer > 0) || KIND == 2) {
            const float w0 = WT[2 * tok], w1 = WT[2 * tok + 1];
            const bf16_t* y0 = Y + (size_t)(2 * tok) * D; const bf16_t* y1 = y0 + D;
#pragma unroll
            for (int i = 0; i < 4; ++i) {
                const u32x2 a = *(const u32x2*)(y0 + 256 * i + 4 * lane), b = *(const u32x2*)(y1 + 256 * i + 4 * lane);
                x.v[i][0] += w0 * bflo(a.x) + w1 * bflo(b.x); x.v[i][1] += w0 * bfhi(a.x) + w1 * bfhi(b.x);
                x.v[i][2] += w0 * bflo(a.y) + w1 * bflo(b.y); x.v[i][3] += w0 * bfhi(a.y) + w1 * bfhi(b.y);
            }
        }
        if (KIND == 2) {
            const float rstd = row_rstd(x, lane);
#pragma unroll
            for (int i = 0; i < 4; ++i) *(f32x4*)(p.out + (size_t)tok * D + 256 * i + 4 * lane) = x.v[i] * rstd * g.v[i];
        } else {
#pragma unroll
            for (int i = 0; i < 4; ++i) {
                const unsigned a0 = cvt_pk_bf16(x.v[i][0], x.v[i][1]), a1 = cvt_pk_bf16(x.v[i][2], x.v[i][3]);
                *(u32x2*)(XBo + (size_t)tok * D + 256 * i + 4 * lane) = (u32x2){a0, a1};
                x.v[i] = (f32x4){bflo(a0), bfhi(a0), bflo(a1), bfhi(a1)};
            }
            const float rstd = row_rstd(x, lane);
            if (lane == 0) RS1[tok] = rstd;
        }
    }
}

template <bool ALT>
__device__ __forceinline__ void route_phase(const Params& p, const int layer, const int bid, const int nb, const int wv) {
    const int tid = hidden_tid(wv), lane = tid & 63, w = tid >> 6, fr = lane & 15, fq = lane >> 4;
    float* part = (float*)shm;
    float* ssql = part + 8 * 64 * 49;
    float* lgl = ssql + 8 * 64;
    int* cntl = (int*)((char*)shm + LDS_ROUTE);
    int* basel = cntl + 32;
    int* sel = basel + 32;
    int* posl = sel + 128;
    float* rsl = (float*)(posl + 128);
    float* WT = (float*)(p.ws + (ALT ? WS_ACT + (size_t)4 * 1024 * 1024 : WS_WT));
    float* RSTD = (float*)(p.ws + (ALT ? WS_ACT + (size_t)5 * 1024 * 1024 : WS_RSTD));
    int* LIST = (int*)(p.ws + (ALT ? WS_ACT : WS_LIST));
    float* RP = (float*)(p.ws + (ALT ? WS_ACT + (size_t)2 * 1024 * 1024 : WS_RP));
    int* CNT = (int*)(p.ws + WS_CNT) + (layer + (ALT ? 4 : 0)) * NEXP * CNT_STRIDE;
    const float* bg = p.in[26] + layer * 4; const float* be = p.in[28] + layer * NEXP;
    const char* const Xc = (const char*)(p.ws + WS_XB);
    const char* const Whc = (const char*)(p.ws + WS_WRT) + (size_t)layer * 2 * 48 * 1024 * 2; const char* const Wlc = Whc + 48 * 1024 * 2;
    for (int chunk = bid; chunk < NTOK / 64; chunk += nb) {
        __syncthreads();
        if (tid < 32) cntl[tid] = 0;
        const unsigned xoff = (unsigned)(((chunk * 64 + fr) * D + w * 128 + fq * 8) * 2), woff = (unsigned)((fr * 1024 + w * 128 + fq * 8) * 2);
        f32x4 acc[4][3];
#pragma unroll
        for (int mt = 0; mt < 4; ++mt)
#pragma unroll
            for (int nt = 0; nt < 3; ++nt) acc[mt][nt] = (f32x4){0.f, 0.f, 0.f, 0.f};
        float ssq[4] = {0.f, 0.f, 0.f, 0.f};
        u32x4 xa[4][4]; bf16x8 Bh[2][3], Bl[2][3];
#pragma unroll
        for (int st = 0; st < 4; ++st)
#pragma unroll
            for (int mt = 0; mt < 4; ++mt) xa[st][mt] = *(const u32x4*)(Xc + (xoff + (unsigned)(mt * 16 * D * 2 + st * 64)));
#pragma unroll
        for (int nt = 0; nt < 3; ++nt) { Bh[0][nt] = *(const bf16x8*)(Whc + (woff + (unsigned)(nt * 16 * 2048))); Bl[0][nt] = *(const bf16x8*)(Wlc + (woff + (unsigned)(nt * 16 * 2048))); }
#pragma unroll
        for (int st = 0; st < 4; ++st) {
            if (st < 3) {
#pragma unroll
                for (int nt = 0; nt < 3; ++nt) { Bh[(st + 1) & 1][nt] = *(const bf16x8*)(Whc + (woff + (unsigned)(nt * 16 * 2048 + (st + 1) * 64))); Bl[(st + 1) & 1][nt] = *(const bf16x8*)(Wlc + (woff + (unsigned)(nt * 16 * 2048 + (st + 1) * 64))); }
            }
#pragma unroll
            for (int mt = 0; mt < 4; ++mt) {
                const u32x4 xb = xa[st][mt];
                const f32x4 x0 = {bflo(xb.x), bfhi(xb.x), bflo(xb.y), bfhi(xb.y)}, x1 = {bflo(xb.z), bfhi(xb.z), bflo(xb.w), bfhi(xb.w)};
                ssq[mt] += x0[0] * x0[0] + x0[1] * x0[1] + x0[2] * x0[2] + x0[3] * x0[3] + x1[0] * x1[0] + x1[1] * x1[1] + x1[2] * x1[2] + x1[3] * x1[3];
                const bf16x8 Ah = __builtin_bit_cast(bf16x8, xb);
#pragma unroll
                for (int nt = 0; nt < 3; ++nt) {
                    acc[mt][nt] = __builtin_amdgcn_mfma_f32_16x16x32_bf16(Ah, Bh[st & 1][nt], acc[mt][nt], 0, 0, 0);
                    acc[mt][nt] = __builtin_amdgcn_mfma_f32_16x16x32_bf16(Ah, Bl[st & 1][nt], acc[mt][nt], 0, 0, 0);
                }
            }
            __builtin_amdgcn_sched_barrier(0);
        }
#pragma unroll
        for (int mt = 0; mt < 4; ++mt) {
            float sq = ssq[mt]; sq += shx(sq, 16, lane); sq += shx(sq, 32, lane);
            if (fq == 0) ssql[w * 64 + mt * 16 + fr] = sq;
#pragma unroll
            for (int nt = 0; nt < 3; ++nt)
#pragma unroll
                for (int r = 0; r < 4; ++r) part[(w * 64 + mt * 16 + fq * 4 + r) * 49 + nt * 16 + fr] = acc[mt][nt][r];
        }
        __syncthreads();
        {
            const int tl = tid & 63;
            for (int j = tid >> 6; j < 36; j += 8) {
                float s = 0.f;
#pragma unroll
                for (int ww = 0; ww < 8; ++ww) s += part[(ww * 64 + tl) * 49 + j];
                lgl[tl * 37 + j] = s;
            }
        }
        __syncthreads();
        if (tid < 64) {
            const int tl = tid, tk = chunk * 64 + tl;
            float sq = 0.f;
#pragma unroll
            for (int ww = 0; ww < 8; ++ww) sq += ssql[ww * 64 + tl];
            const float rstd = rsqrtf(sq * (1.0f / 1024.0f) + EPS);
            float lg[36];
#pragma unroll
            for (int j = 0; j < 36; ++j) lg[j] = lgl[tl * 37 + j] * rstd;
            float g0 = lg[0] + bg[0], g1 = lg[1] + bg[1], g2 = lg[2] + bg[2], g3 = lg[3] + bg[3];
            int gs = 0; float gm = g0;
            if (g1 > gm) { gm = g1; gs = 1; } if (g2 > gm) { gm = g2; gs = 2; } if (g3 > gm) { gm = g3; gs = 3; }
            const float gden = __expf(g0 - gm) + __expf(g1 - gm) + __expf(g2 - gm) + __expf(g3 - gm);
            const float ggate = 1.0f / gden;
            float ev[8];
#pragma unroll
            for (int j = 0; j < 8; ++j) {
                const float a0 = lg[4 + j] + be[j], a1 = lg[12 + j] + be[8 + j], a2 = lg[20 + j] + be[16 + j], a3 = lg[28 + j] + be[24 + j];
                ev[j] = gs == 0 ? a0 : gs == 1 ? a1 : gs == 2 ? a2 : a3;
            }
            int i0 = 0; float v0 = ev[0];
#pragma unroll
            for (int j = 1; j < 8; ++j) if (ev[j] > v0) { v0 = ev[j]; i0 = j; }
            int i1 = -1; float v1 = -3.0e38f;
#pragma unroll
            for (int j = 0; j < 8; ++j) if (j != i0 && ev[j] > v1) { v1 = ev[j]; i1 = j; }
            const float e1 = __expf(v1 - v0), sden = 1.0f / (1.0f + e1);
            const int ea = gs * 8 + i0, eb = gs * 8 + i1;
            sel[2 * tl] = ea; posl[2 * tl] = atomicAdd(&cntl[ea], 1);
            sel[2 * tl + 1] = eb; posl[2 * tl + 1] = atomicAdd(&cntl[eb], 1);
            WT[2 * tk] = ggate * sden; WT[2 * tk + 1] = ggate * e1 * sden;
            RSTD[tk] = rstd; rsl[tl] = rstd;
        }
        __syncthreads();
        if (tid < 32) { const int c = cntl[tid]; basel[tid] = (ALT && DUPSEL == 1) ? chunk * 4 : (c > 0 ? atomicAdd(&CNT[tid * CNT_STRIDE], c) : 0); }
        __syncthreads();
        if (tid < 128) { const int e = sel[tid]; const size_t li = (size_t)e * NTOK + basel[e] + posl[tid]; LIST[li] = 128 * chunk + tid; RP[li] = rsl[tid >> 1]; }
    }
}

template <int MODE>
__device__ __forceinline__ void cvt_job(const float* __restrict__ src, bf16_t* __restrict__ dst, const int K, const int N, const int nmat,
                                        const size_t dst_mat_stride, const int bid, const int nb, const int wv, const float* __restrict__ kgain = nullptr, const int gshift = 0) {
    float* T = (float*)shm;
    const int tid = hidden_tid(wv);
    const int tk = K / 64, tn = N / 256, per = tk * tn, total = per * nmat;
    f32x4 v[8];
#define CVT_LOAD(t_) do { const int mat_ = (t_) / per, r_ = (t_) % per, k0_ = (r_ / tn) * 64, n0_ = (r_ % tn) * 256; \
        const float* s_ = src + (size_t)mat_ * K * N + (size_t)k0_ * N + n0_; \
        _Pragma("unroll") for (int i = 0; i < 8; ++i) v[i] = *(const f32x4*)(s_ + (size_t)((tid >> 6) + 8 * i) * N + (tid & 63) * 4); } while (0)
    if (bid < total) CVT_LOAD(bid);
    for (int t = bid; t < total; t += nb) {
        const int mat = t / per, r = t % per, k0 = (r / tn) * 64, n0 = (r % tn) * 256;
        bf16_t* d = dst + (size_t)mat * dst_mat_stride;
        if (kgain) {
#pragma unroll
            for (int i = 0; i < 8; ++i) v[i] *= kgain[(size_t)(mat >> gshift) * D + k0 + (tid >> 6) + 8 * i];
        }
        __syncthreads();
#pragma unroll
        for (int i = 0; i < 8; ++i) {
            float* q = T + ((tid >> 6) + 8 * i) * 257 + (tid & 63) * 4;
            q[0] = v[i][0]; q[1] = v[i][1]; q[2] = v[i][2]; q[3] = v[i][3];
        }
        __syncthreads();
        if (t + nb < total) CVT_LOAD(t + nb);
#pragma unroll
        for (int j = 0; j < 4; ++j) {
            const int n = (tid >> 3) + 64 * j, kc = (tid & 7) * 8;
            float e[8];
#pragma unroll
            for (int jj = 0; jj < 8; ++jj) e[jj] = T[(kc + jj) * 257 + n];
            u32x4 ov; ov.x = cvt_pk_bf16(e[0], e[1]); ov.y = cvt_pk_bf16(e[2], e[3]); ov.z = cvt_pk_bf16(e[4], e[5]); ov.w = cvt_pk_bf16(e[6], e[7]);
            const int ng = n0 + n;
            const int row = (MODE == 0) ? ng : ((ng >> 4) * 32 + (ng & 15) + (MODE == 2 ? 16 : 0));
            *(u32x4*)(d + (size_t)row * K + k0 + kc) = ov;
        }
    }
#undef CVT_LOAD
}

__device__ __forceinline__ void prologue0(const Params& p, const int bid, const int nb, const int wv) {
    unsigned char* ws = p.ws;
    cvt_job<0>(p.in[3], (bf16_t*)(ws + WS_W_EIN), 1024, 3072, 2, (size_t)3072 * 1024, bid, nb, wv, p.in[2]);
    cvt_job<0>(p.in[15], (bf16_t*)(ws + WS_W_EOUT), 1024, 1024, 2, (size_t)1024 * 1024, bid, nb, wv);
    cvt_job<0>(p.in[17], (bf16_t*)(ws + WS_W_OIN), 1024, 1536, 2, (size_t)1536 * 1024, bid, nb, wv, p.in[16]);
    cvt_job<0>(p.in[19], (bf16_t*)(ws + WS_W_OOUT), 1024, 1024, 2, (size_t)1024 * 1024, bid, nb, wv);
    cvt_job<0>(p.in[21], (bf16_t*)(ws + WS_W_CQ), 1024, 512, 4, (size_t)512 * 1024, bid, nb, wv, p.in[20]);
    cvt_job<0>(p.in[22], (bf16_t*)(ws + WS_W_CKV), 1024, 1024, 4, (size_t)1024 * 1024, bid, nb, wv);
    cvt_job<0>(p.in[23], (bf16_t*)(ws + WS_W_CO), 512, 1024, 4, (size_t)1024 * 512, bid, nb, wv);
    cvt_job<1>(p.in[29], (bf16_t*)(ws + WS_W_GU), 1024, 512, 128, (size_t)1024 * 1024, bid, nb, wv, p.in[24], 5);
    cvt_job<2>(p.in[30], (bf16_t*)(ws + WS_W_GU), 1024, 512, 128, (size_t)1024 * 1024, bid, nb, wv, p.in[24], 5);
    cvt_job<0>(p.in[31], (bf16_t*)(ws + WS_W_DN), 512, 1024, 128, (size_t)1024 * 512, bid, nb, wv);
    const int tid = hidden_tid(wv), lane = tid & 63, w = tid >> 6;
    {
        Row16 g; ld_row(g, p.in[32], lane);
        bf16_t* MN = (bf16_t*)(ws + WS_MEMN);
        for (int r = bid * 8 + w; r < Bb * MEM; r += nb * 8) {
            Row16 x; ld_row(x, p.in[1] + (size_t)r * D, lane);
            const float rstd = row_rstd(x, lane);
#pragma unroll
            for (int i = 0; i < 4; ++i) st_bf16x4(MN + (size_t)r * D + 256 * i + 4 * lane, x.v[i] * rstd * g.v[i]);
        }
    }
    {
        float* A2 = (float*)(ws + WS_A2);
        for (int r = bid * 8 + w; r < 2 * S; r += nb * 8) {
            const int lj = r / S, pos = r % S;
            const float* w1 = p.in[6] + (size_t)lj * 33 * 64; const float* b1 = p.in[7] + lj * 64;
            const float* w2 = p.in[8] + (size_t)lj * 64 * 64; const float* b2 = p.in[9] + lj * 64;
            const float fr_ = p.in[11][lj * 64 + lane];
            float a = ((float)pos / 2047.0f) * w1[lane];
#pragma unroll 1
            for (int k = 0; k < 16; ++k) {
                const float band = 1e-4f + (float)k * ((15.0f - 1e-4f) / 15.0f);
                const float ang = band * (6.283185307179586f * (float)pos / 2048.0f);
                a += cosf(ang) * w1[(1 + k) * 64 + lane] - sinf(ang) * w1[(17 + k) * 64 + lane];
            }
            const float a1 = sinf(fr_ * (a + b1[lane]));
            float a2 = 0.f;
#pragma unroll 1
            for (int i = 0; i < 64; ++i) a2 += shl(a1, i) * w2[i * 64 + lane];
            A2[(size_t)r * 64 + lane] = sinf(fr_ * (a2 + b2[lane]));
        }
    }
    {
        bf16_t* WR = (bf16_t*)(ws + WS_WRT);
        for (int i = bid * NT + tid; i < 4 * 48 * 1024; i += nb * NT) {
            const int l = i / (48 * 1024), r = i % (48 * 1024), j = r >> 10, k = r & 1023;
            float v = 0.f;
            if (j < 4) v = p.in[25][((size_t)l * D + k) * 4 + j]; else if (j < 36) v = p.in[27][((size_t)l * D + k) * NEXP + (j - 4)];
            v *= p.in[24][(size_t)l * D + k];
            const unsigned h = cvt_pk_bf16(v, 0.f) & 0xffffu;
            const unsigned lo = cvt_pk_bf16(v - bflo(h), 0.f) & 0xffffu;
            WR[(size_t)l * 2 * 48 * 1024 + r] = (bf16_t)h; WR[(size_t)l * 2 * 48 * 1024 + 48 * 1024 + r] = (bf16_t)lo;
        }
    }
    if (bid == 0) {
        if (tid < 2) {
            const float* lm = p.in[13] + (size_t)tid * 4 * 64;
            float s01 = 0.f, s23 = 0.f;
            for (int i = 0; i < 64; ++i) { s01 += lm[i] * lm[64 + i]; s23 += lm[128 + i] * lm[192 + i]; }
            const float lam_init = 0.8f - 0.6f * expf(-0.3f * (float)(2 * tid));
            ((float*)(ws + WS_MISC))[tid] = expf(s01) - expf(s23) + lam_init;
            ((float*)(ws + WS_MISC))[2 + tid] = 1.0f - lam_init;
        }
        bf16_t* hz = (bf16_t*)(ws + WS_XB) + (size_t)NTOK * D; bf16_t* az = (bf16_t*)(ws + WS_ACT) + (size_t)2 * NTOK * EH;
        for (int i = tid; i < D; i += NT) hz[i] = 0;
        for (int i = tid; i < EH; i += NT) az[i] = 0;
    }
}

__device__ __forceinline__ void filter_taps(const Params& p, const int bid, const int nb, const int wv) {
    const int tid = hidden_tid(wv), w = tid >> 6, lane = tid & 63, fr = lane & 15, fq = lane >> 4;
    const float* A2 = (const float*)(p.ws + WS_A2);
    bf16_t* FL = (bf16_t*)(p.ws + WS_FILT);
    const float mind = logf(1e-2f) / 1.5f, maxd = logf(1e-2f) / 0.3f;
    for (int job = bid; job < 2 * 4 * 8 * 32; job += nb) {
        const int pt = job & 31, ct = (job >> 5) & 7, od = (job >> 8) & 3, lj = job >> 10;
        const int pos0 = pt * 64 + (w >> 2) * 32, ch0 = ct * 64 + (w & 3) * 16, order = od >> 1, dir = od & 1;
        const float* w3 = p.in[10] + (size_t)lj * 64 * 2048 + od * 512 + ch0 + fr;
        bf16x8 Af[2], Bf[2][2];
#pragma unroll
        for (int ks = 0; ks < 2; ++ks) {
            float e[8];
#pragma unroll
            for (int jj = 0; jj < 8; ++jj) e[jj] = w3[(size_t)(ks * 32 + fq * 8 + jj) * 2048];
            u32x4 pk; pk.x = cvt_pk_bf16(e[0], e[1]); pk.y = cvt_pk_bf16(e[2], e[3]); pk.z = cvt_pk_bf16(e[4], e[5]); pk.w = cvt_pk_bf16(e[6], e[7]);
            Af[ks] = __builtin_bit_cast(bf16x8, pk);
#pragma unroll
            for (int nt = 0; nt < 2; ++nt) {
                const float* ap = A2 + ((size_t)lj * S + pos0 + nt * 16 + fr) * 64 + ks * 32 + fq * 8;
                const f32x4 v0 = *(const f32x4*)ap, v1 = *(const f32x4*)(ap + 4);
                u32x4 pb; pb.x = cvt_pk_bf16(v0[0], v0[1]); pb.y = cvt_pk_bf16(v0[2], v0[3]); pb.z = cvt_pk_bf16(v1[0], v1[1]); pb.w = cvt_pk_bf16(v1[2], v1[3]);
                Bf[nt][ks] = __builtin_bit_cast(bf16x8, pb);
            }
        }
#pragma unroll
        for (int nt = 0; nt < 2; ++nt) {
            f32x4 acc = {0.f, 0.f, 0.f, 0.f};
            acc = __builtin_amdgcn_mfma_f32_16x16x32_bf16(Af[0], Bf[nt][0], acc, 0, 0, 0);
            acc = __builtin_amdgcn_mfma_f32_16x16x32_bf16(Af[1], Bf[nt][1], acc, 0, 0, 0);
            const int pos = pos0 + nt * 16 + fr;
            const float tpos = (float)pos / 2047.0f;
#pragma unroll
            for (int r = 0; r < 4; ++r) {
                const int ch = ch0 + fq * 4 + r;
                const float delta = mind + (float)ch * ((maxd - mind) / 511.0f);
                const float v = acc[r] * __builtin_amdgcn_exp2f(-tpos * fabsf(delta) * 1.4426950408889634f);
                bf16_t* f = FL + ((size_t)(lj * 2 + order) * 512 + ch) * 4096;
                const unsigned short hv = (unsigned short)(cvt_pk_bf16(v, 0.f) & 0xffff);
                if (dir == 0) f[2047 - pos] = hv;
                else { if (pos >= 1) f[2047 + pos] = hv; if (pos == 2047) f[4095] = 0; }
            }
        }
    }
}

enum { PH_P0 = 0, PH_P1, PH_N1, PH_GIN, PH_MIX, PH_GOUT, PH_N2, PH_GQ, PH_XATT, PH_GO, PH_ROUTE, PH_G1, PH_G2, PH_FINAL, PH_TR, PH_COUNT };

template <class Epi>
__device__ __forceinline__ void gemm_dense(const bf16_t* A, const bf16_t* Bt, const int K, const int nM, const int nN, Epi epi, const int bid, const int nb, const int wv, const int ntl = 0) {
    for (int u = bid; u < nM * nN; u += nb) {
        const int pm = u / nN, pn = u % nN;
        epi.brow = pm * 256;
        gemm_tile(A + (size_t)pm * 256 * K, Bt, K, pn * 256, RowIdent{}, epi, wv, ntl);
    }
}

typedef const __attribute__((address_space(4))) Params* ParamsK;
#define PHASE_FN __forceinline__
template <int PH, bool ALT = false>
__device__ PHASE_FN void run_phase(ParamsK pk_, const int layer, const int bid_, const int nb_, const int wv_) {
    ParamsK pk = pk_; asm volatile("" : "+s"(pk));
    int bid = bid_, nb = nb_, wv = wv_; asm volatile("" : "+s"(bid), "+s"(nb), "+s"(wv));
    const Params& p = *(const Params*)pk;
    unsigned char* ws = p.ws;
    const int lj = layer >> 1; const bool even = (layer & 1) == 0;
    bf16_t* H = (bf16_t*)(ws + WS_H);
    float* X = (float*)(ws + WS_X);
    bf16_t* YMIX = (bf16_t*)(ws + WS_YMIX);
    bf16_t* QX = (bf16_t*)(ws + WS_QX);
    bf16_t* OX = (bf16_t*)(ws + WS_OX);
    if constexpr (PH == PH_P0) { prologue0(p, bid, nb, wv); }
    if constexpr (PH == PH_N1) {
        norm_phase<0, ALT>(p, layer, nullptr, bid, nb, wv);
        if (layer == 0 && !ALT) filter_taps(p, bid, nb, wv);
    }
    if constexpr (PH == PH_GIN) {
        const bf16_t* XBc = (const bf16_t*)(ws + WS_XB); const float* RS1 = (const float*)(ws + WS_RS1);
        if (ALT && DUPSEL >= 1) {
            int fl = bid; asm volatile("" : "+s"(fl));
            EpiNull e{(float*)(ws + WS_X), fl == 0x7fffffff, 0};
            gemm_dense(XBc, (const bf16_t*)(ws + (even ? WS_W_EIN : WS_W_OIN)) + (size_t)lj * (even ? 3072 : 1536) * 1024, 1024, 64, even ? 12 : 6, e, bid, nb, wv, DUPSEL == 2 ? 8 : 0);
        } else if (even) {
            EpiSplit e{(bf16_t*)(ws + WS_PROJ + PR_HYT), (bf16_t*)(ws + WS_PROJ + PR_QK), (bf16_t*)(ws + WS_PROJ + PR_VT), 1536, 2560, 1024, (size_t)NTOK, 0, RS1};
            gemm_dense(XBc, (const bf16_t*)(ws + WS_W_EIN) + (size_t)lj * 3072 * 1024, 1024, 64, 12, e, bid, nb, wv);
        } else {
            EpiSplit e{nullptr, (bf16_t*)(ws + WS_PROJ), (bf16_t*)(ws + WS_PROJ + PR_OVT), 0, 1280, 1280, (size_t)NTOK, 0, RS1};
            gemm_dense(XBc, (const bf16_t*)(ws + WS_W_OIN) + (size_t)lj * 1536 * 1024, 1024, 64, 6, e, bid, nb, wv);
        }
    }
    if constexpr (PH == PH_MIX) {
        if (even) {
            const bf16_t* qk = (const bf16_t*)(ws + WS_PROJ + PR_QK);
            const bf16_t* vT = (const bf16_t*)(ws + WS_PROJ + PR_VT);
            const float lam = uni(((const float*)(ws + WS_MISC))[lj]);
            const float oscale = uni(((const float*)(ws + WS_MISC))[2 + lj]);
            for (int u = bid + ((ALT && (DUPSEL == 4 || DUPSEL >= 7)) ? 512 : 0); u < ((ALT && (DUPSEL == 3 || DUPSEL == 5 || DUPSEL == 6)) ? 512 : 1024); u += nb) {
                if (u < 512) hyena_unit<ALT>(p, lj, u, wv);
                else {
                    const int id = u - 512, b = id >> 6, h = (id >> 4) & 3, qb = id & 15;
                    attn_unit<0, ALT>(qk + (size_t)(b * S) * 1024 + 2 * h * 64, 1024, qk + (size_t)(b * S) * 1024 + 512 + 2 * h * 64, 1024,
                                 vT + (size_t)(h * 128) * NTOK + b * S, (size_t)NTOK, qb * 128, 0, S,
                                 0.125f, uni(exp2f(-2.0f * (float)(h + 1))), -1e30f, 0.f,
                                 (ALT ? (bf16_t*)(ws + WS_Y) : YMIX) + (size_t)(b * S) * D + 512 + h * 128, D, lam, oscale, p.in[14] + (size_t)lj * 128, wv);
                }
            }
        } else {
            const bf16_t* qk = (const bf16_t*)(ws + WS_PROJ);
            const bf16_t* vT = (const bf16_t*)(ws + WS_PROJ + PR_OVT);
            for (int u = bid; u < 1024; u += nb) {
                const int b = u >> 7, kv = (u >> 5) & 3, qb = u & 31, q0 = qb * 64;
                const int kbeg = q0 - 128 < 0 ? 0 : q0 - 128, kend = q0 + 192 > S ? S : q0 + 192;
                attn2_unit<1>(qk + (size_t)(b * S) * 1280 + kv * 256, 1280, qk + (size_t)(b * S) * 1280 + 1024 + kv * 64, 1280,
                              vT + (size_t)(kv * 64) * NTOK + b * S, (size_t)NTOK, q0, kbeg, kend,
                              0.125f, p.in[18] + lj * 16 + kv * 4, kv * 4, YMIX + (size_t)(b * S) * D + kv * 256, D, wv);
            }
        }
    }
    if constexpr (PH == PH_TR) {
        const int tid = hidden_tid(wv);
        const bf16_t* yt = (const bf16_t*)(ws + WS_QX);
        bf16_t* T = shm;
        for (int t = bid; t < 8 * 256; t += nb) {
            const int c0 = (t & 7) * 64, tk0 = (t >> 3) * 64;
            const u32x4 v = *(const u32x4*)(yt + (size_t)(c0 + (tid >> 3)) * NTOK + tk0 + (tid & 7) * 8);
            __syncthreads();
            *(u32x4*)((char*)T + (tid >> 3) * 144 + (tid & 7) * 16) = v;
            __syncthreads();
            const int tok = tid >> 3, cg = (tid & 7) * 8;
            unsigned short e[8];
#pragma unroll
            for (int j = 0; j < 8; ++j) e[j] = T[(cg + j) * 72 + tok];
            u32x4 ov; ov.x = e[0] | ((unsigned)e[1] << 16); ov.y = e[2] | ((unsigned)e[3] << 16); ov.z = e[4] | ((unsigned)e[5] << 16); ov.w = e[6] | ((unsigned)e[7] << 16);
            *(u32x4*)(YMIX + (size_t)(tk0 + tok) * D + c0 + cg) = ov;
        }
    }
    if constexpr (PH == PH_GOUT) {
        EpiRes e{(bf16_t*)(ws + (ALT ? WS_Y : WS_XB)), 0, (float*)(ws + WS_SSP), hidden_tid(wv) & 63};
        gemm_dense(YMIX, (const bf16_t*)(ws + (even ? WS_W_EOUT : WS_W_OOUT)) + (size_t)lj * 1024 * 1024, 1024, 64, 4, e, bid, nb, wv);
    }
    if constexpr (PH == PH_GQ) {
        for (int u = bid; u < 128 + 32; u += nb) {
            if (u < 128) {
                const int pm = u >> 1, pn = u & 1;
                EpiTokRstd e{QX, 512, pm * 256, (const float*)(ws + WS_SSP), hidden_tid(wv) & 63};
                gemm_tile((const bf16_t*)(ws + WS_XB) + (size_t)pm * 256 * 1024, (const bf16_t*)(ws + WS_W_CQ) + (size_t)layer * 512 * 1024, 1024, pn * 256, RowIdent{}, e, wv);
            } else {
                const int v = u - 128, pm = v >> 2, pn = v & 3;
                EpiSplit e{nullptr, (bf16_t*)(ws + WS_XK) + (size_t)layer * 2048 * 512, (bf16_t*)(ws + WS_XVT) + (size_t)layer * 512 * 2048, 0, 512, 512, (size_t)2048, pm * 256, nullptr};
                gemm_tile((const bf16_t*)(ws + WS_MEMN) + (size_t)pm * 256 * 1024, (const bf16_t*)(ws + WS_W_CKV) + (size_t)layer * 1024 * 1024, 1024, pn * 256, RowIdent{}, e, wv);
            }
        }
    }
    if constexpr (PH == PH_XATT) {
        const bf16_t* xk = (const bf16_t*)(ws + WS_XK) + (size_t)layer * 2048 * 512;
        const bf16_t* xvt = (const bf16_t*)(ws + WS_XVT) + (size_t)layer * 512 * 2048;
        for (int u = bid; u < 256; u += nb) {
            const int b = u >> 5, h = (u >> 3) & 3, qb = u & 7;
            attn2_unit<2>(QX + (size_t)(b * S) * 512 + h * 128, 512, xk + (size_t)(b * MEM) * 512 + h * 128, 512,
                          xvt + (size_t)(h * 128) * 2048 + b * MEM, (size_t)2048, qb * 256, 0, MEM,
                          0.08838834764831845f, nullptr, 0, OX + (size_t)(b * S) * 512 + h * 128, 512, wv);
        }
    }
    if constexpr (PH == PH_GO) {
        EpiRes e{(bf16_t*)(ws + (ALT ? WS_Y : WS_XB)), 0, nullptr, hidden_tid(wv) & 63};
        gemm_dense(OX, (const bf16_t*)(ws + WS_W_CO) + (size_t)layer * 1024 * 512, 512, 64, 4, e, bid, nb, wv);
    }
    if constexpr (PH == PH_ROUTE) { route_phase<ALT>(p, layer, bid, nb, wv); }
    if constexpr (PH == PH_G1) {
        const int* CNT = (const int*)(ws + WS_CNT) + layer * NEXP * CNT_STRIDE;
        const int* LIST = (const int*)(ws + WS_LIST);
        unsigned* head = (unsigned*)(ws + WS_QHEAD) + layer * 64;
        unsigned* done = (unsigned*)(ws + WS_DONE) + layer * 32 * 64;
        int* uq = (int*)((char*)shm + LDS_ROUTE + 1024);
        int* pre = uq + 16;
        int* cn = pre + 40;
        const int tid = hidden_tid(wv);
        __syncthreads();
        if (tid < 64) {
            const int lane = tid;
            const int c = lane < 32 ? CNT[lane * CNT_STRIDE] : 0;
            int incl = ((c + 255) >> 8) * 4;
#pragma unroll
            for (int d = 1; d < 32; d <<= 1) { const int v = __builtin_amdgcn_ds_bpermute(((lane - d) & 63) << 2, incl); if (lane >= d) incl += v; }
            if (lane < 32) { pre[lane + 1] = incl; cn[lane] = c; }
            if (lane == 0) pre[0] = 0;
        }
        typedef __attribute__((address_space(1))) unsigned gu32_t;
        unsigned nxt_v = 0u;
        if (tid == 0) nxt_v = __hip_atomic_fetch_add((gu32_t*)head, 1u, __ATOMIC_RELAXED, __HIP_MEMORY_SCOPE_AGENT);
        __syncthreads();
        const int total = __builtin_amdgcn_readfirstlane(pre[32]);
        for (;;) {
            if (tid == 0) *uq = (int)nxt_v;
            __syncthreads();
            const int uall = __builtin_amdgcn_readfirstlane(*uq);
            if (uall >= 2 * total) break;
            if (tid == 0) nxt_v = __hip_atomic_fetch_add((gu32_t*)head, 1u, __ATOMIC_RELAXED, __HIP_MEMORY_SCOPE_AGENT);
            const bool second = uall >= total;
            const int u = second ? uall - total : uall;
            int e, base, tl, cnt;
            {
                const int l5 = hidden_tid(wv) & 31;
                const int lo = pre[l5], hi = pre[l5 + 1];
                const unsigned long long bal = __builtin_amdgcn_ballot_w64(u >= lo && u < hi);
                e = __builtin_amdgcn_readfirstlane((int)__builtin_ctzll(bal));
                base = __builtin_amdgcn_readfirstlane(pre[e]); cnt = __builtin_amdgcn_readfirstlane(cn[e]); tl = (cnt + 255) >> 8;
            }
            const int r = u - base, pn = r / tl, pm = r % tl;
            const int* list = LIST + (size_t)e * NTOK;
            if (!second) {
                EpiGateUp ep{(bf16_t*)(ws + WS_ACT), list, cnt, pm * 256, (const float*)(ws + WS_RP) + (size_t)e * NTOK};
                gemm_tile((const bf16_t*)(ws + WS_XB), (const bf16_t*)(ws + WS_W_GU) + ((size_t)layer * NEXP + e) * 1024 * 1024, 1024, pn * 256, RowTok{list, cnt, pm * 256}, ep, wv);
                asm volatile("s_waitcnt vmcnt(0)" ::: "memory");
                if ((hidden_tid(wv) & 63) == 0) (void)__hip_atomic_fetch_add(done + e * 64 + pm, 1u, __ATOMIC_RELAXED, __HIP_MEMORY_SCOPE_AGENT);
            } else {
                if (tid < 64) {
                    unsigned spins = 0;
                    while ((unsigned)__builtin_amdgcn_readfirstlane(__hip_atomic_load(done + e * 64 + pm, __ATOMIC_RELAXED, __HIP_MEMORY_SCOPE_AGENT)) < 32u) {
                        __builtin_amdgcn_s_sleep(2);
                        if (++spins > (1u << 24)) break;
                    }
                    __builtin_amdgcn_fence(__ATOMIC_ACQUIRE, "agent");
                    asm volatile("s_waitcnt vmcnt(0)" ::: "memory");
                }
                __syncthreads();
                EpiDown ep{(bf16_t*)(ws + WS_Y), list, cnt, pm * 256};
                gemm_tile((const bf16_t*)(ws + WS_ACT), (const bf16_t*)(ws + WS_W_DN) + ((size_t)layer * NEXP + e) * 1024 * 512, 512, pn * 256, RowAsg{list, cnt, pm * 256}, ep, wv);
            }
        }
    }
    if constexpr (PH == PH_FINAL) { norm_phase<2>(p, DEPTH, p.in[33], bid, nb, wv); }
}

#if ONE_LAUNCH
__global__ void __launch_bounds__(NT, 2) k_mega(Params p_) {
    ParamsK p = (ParamsK)__builtin_amdgcn_kernarg_segment_ptr();
    volatile LAS unsigned* st = (volatile LAS unsigned*)((char*)shm + LDS_XB);
    if (threadIdx.x < 4) st[threadIdx.x] = 0u;
    __syncthreads();
    const XcdBarrier bar = xcd_barrier_post((unsigned*)(p->ws + WS_BAR), st);
    const int bid = blockIdx.x, nb = gridDim.x, wv = __builtin_amdgcn_readfirstlane(threadIdx.x >> 6);
    run_phase<PH_P0>(p, 0, bid, nb, wv); xcd_barrier(bar); if (DUP == PH_P0) { run_phase<PH_P0, true>(p, 0, bid, nb, wv); xcd_barrier(bar); }
#pragma unroll 1
    for (int layer = 0; layer < DEPTH; ++layer) {
        run_phase<PH_N1>(p, layer, bid, nb, wv); xcd_barrier(bar); if (DUP == PH_N1) { run_phase<PH_N1, true>(p, layer, bid, nb, wv); xcd_barrier(bar); }
        run_phase<PH_GIN>(p, layer, bid, nb, wv); xcd_barrier(bar); if (DUP == PH_GIN) { run_phase<PH_GIN, true>(p, layer, bid, nb, wv); xcd_barrier(bar); }
        run_phase<PH_MIX>(p, layer, bid, nb, wv); xcd_barrier(bar); if (DUP == PH_MIX && (DUPSEL == 0 || (DUPSEL != 2 && (layer & 1) == 0) || (DUPSEL == 2 && (layer & 1) == 1))) { run_phase<PH_MIX, true>(p, layer, bid, nb, wv); xcd_barrier(bar); }
        if ((layer & 1) == 0) { run_phase<PH_TR>(p, layer, bid, nb, wv); xcd_barrier(bar); }
        run_phase<PH_GOUT>(p, layer, bid, nb, wv); xcd_barrier(bar); if (DUP == PH_GOUT) { run_phase<PH_GOUT, true>(p, layer, bid, nb, wv); xcd_barrier(bar); }
        run_phase<PH_GQ>(p, layer, bid, nb, wv); xcd_barrier(bar); if (DUP == PH_GQ) { run_phase<PH_GQ, true>(p, layer, bid, nb, wv); xcd_barrier(bar); }
        run_phase<PH_XATT>(p, layer, bid, nb, wv); xcd_barrier(bar); if (DUP == PH_XATT) { run_phase<PH_XATT, true>(p, layer, bid, nb, wv); xcd_barrier(bar); }
        run_phase<PH_GO>(p, layer, bid, nb, wv); xcd_barrier(bar); if (DUP == PH_GO) { run_phase<PH_GO, true>(p, layer, bid, nb, wv); xcd_barrier(bar); }
        run_phase<PH_ROUTE>(p, layer, bid, nb, wv); xcd_barrier(bar); if (DUP == PH_ROUTE) { run_phase<PH_ROUTE, true>(p, layer, bid, nb, wv); xcd_barrier(bar); }
        run_phase<PH_G1>(p, layer, bid, nb, wv); xcd_barrier(bar); if (DUP == PH_G1) { run_phase<PH_G1, true>(p, layer, bid, nb, wv); xcd_barrier(bar); }
    }
    run_phase<PH_FINAL>(p, DEPTH, bid, nb, wv);
}
#else
template <int PH>
__global__ void __launch_bounds__(NT, 2) k_phase(Params p_, int layer) {
    run_phase<PH>((ParamsK)__builtin_amdgcn_kernarg_segment_ptr(), layer, blockIdx.x, gridDim.x, __builtin_amdgcn_readfirstlane(threadIdx.x >> 6));
}
template <int PH> static void launch_phase(const Params& p, int layer, int grid, hipStream_t stream) {
    static bool init = false;
    if (!init) { (void)hipFuncSetAttribute((const void*)k_phase<PH>, hipFuncAttributeMaxDynamicSharedMemorySize, LDS_BYTES); init = true; }
    hipLaunchKernelGGL(k_phase<PH>, dim3(grid), dim3(NT), LDS_BYTES, stream, p, layer);
}
#endif

extern "C" void kernel_launch(void* const* d_in, const int* in_sizes, int n_in, void* d_out, int out_size, void* d_ws, size_t ws_size, hipStream_t stream) {
    if (n_in != 34 || ws_size < WS_END) { fprintf(stderr, "kernel_launch: unexpected n_in %d or ws_size %zu (need %zu)\n", n_in, ws_size, (size_t)WS_END); return; }
    Params p{};
    for (int i = 0; i < 34; ++i) p.in[i] = (const float*)d_in[i];
    p.out = (float*)d_out; p.ws = (unsigned char*)d_ws;
    (void)hipMemsetAsync(d_ws, 0, WS_ZERO_BYTES, stream);
#if ONE_LAUNCH
    static int grid = 0;
    if (grid == 0) {
        int dev = 0, cus = 0, per_cu = 0;
        (void)hipGetDevice(&dev); (void)hipDeviceGetAttribute(&cus, hipDeviceAttributeMultiprocessorCount, dev);
        (void)hipFuncSetAttribute((const void*)k_mega, hipFuncAttributeMaxDynamicSharedMemorySize, LDS_BYTES);
        (void)hipOccupancyMaxActiveBlocksPerMultiprocessor(&per_cu, (const void*)k_mega, NT, LDS_BYTES);
        (void)hipGetLastError();
        grid = cus > 0 ? cus : 256;
    }
    hipLaunchKernelGGL(k_mega, dim3(grid), dim3(NT), LDS_BYTES, stream, p);
#else
    const int grid = 256;
    launch_phase<PH_P0>(p, 0, grid, stream);
    for (int layer = 0; layer < DEPTH; ++layer) {
        launch_phase<PH_N1>(p, layer, grid, stream);
        launch_phase<PH_GIN>(p, layer, grid, stream);
        launch_phase<PH_MIX>(p, layer, grid, stream);
        if ((layer & 1) == 0) launch_phase<PH_TR>(p, layer, grid, stream);
        launch_phase<PH_GOUT>(p, layer, grid, stream);
        launch_phase<PH_GQ>(p, layer, grid, stream);
        launch_phase<PH_XATT>(p, layer, grid, stream);
        launch_phase<PH_GO>(p, layer, grid, stream);
        launch_phase<PH_ROUTE>(p, layer, grid, stream);
        launch_phase<PH_G1>(p, layer, grid, stream);
    }
    launch_phase<PH_FINAL>(p, DEPTH, grid, stream);
#endif
}
```

```cpp
#include <hip/hip_runtime.h>
#include <stdint.h>
#include <stdio.h>

#ifndef RD_N
#define RD_N 1
#endif
#ifndef RD_E
#define RD_E 1
#endif
#ifndef RD_R
#define RD_R 1
#endif
#ifndef DUP
#define DUP -1
#endif
#ifndef DUPSEL
#define DUPSEL 0
#endif
#ifndef ONE_LAUNCH
#define ONE_LAUNCH 1
#endif

typedef unsigned short bf16_t;
typedef short bf16x8 __attribute__((ext_vector_type(8)));
typedef float f32x4 __attribute__((ext_vector_type(4)));
typedef unsigned u32x4 __attribute__((ext_vector_type(4)));
typedef unsigned u32x2 __attribute__((ext_vector_type(2)));

constexpr int Bb = 8, S = 2048, D = 1024, NTOK = Bb * S, DEPTH = 4, MEM = 256;
constexpr int NEXP = 32, EH = 512;
constexpr int NT = 512;
constexpr float EPS = 1e-6f;

constexpr size_t al256(size_t x) { return (x + 255) & ~(size_t)255; }
constexpr size_t WS_BAR   = 0;
constexpr size_t WS_CNT   = 16384;
constexpr int    CNT_STRIDE = 64;
constexpr size_t WS_QHEAD = 16384 + 65536;
constexpr size_t WS_DONE  = WS_QHEAD + 4096;
constexpr size_t WS_ZERO_BYTES = WS_DONE + (size_t)4 * 32 * 64 * 4;
constexpr size_t WS_MISC  = WS_ZERO_BYTES;
constexpr size_t WS_W_EIN = 131072;
constexpr size_t WS_W_EOUT = WS_W_EIN + (size_t)2 * 3072 * 1024 * 2;
constexpr size_t WS_W_OIN = WS_W_EOUT + (size_t)2 * 1024 * 1024 * 2;
constexpr size_t WS_W_OOUT = WS_W_OIN + (size_t)2 * 1536 * 1024 * 2;
constexpr size_t WS_W_CQ  = WS_W_OOUT + (size_t)2 * 1024 * 1024 * 2;
constexpr size_t WS_W_CKV = WS_W_CQ + (size_t)4 * 512 * 1024 * 2;
constexpr size_t WS_W_CO  = WS_W_CKV + (size_t)4 * 1024 * 1024 * 2;
constexpr size_t WS_W_GU  = WS_W_CO + (size_t)4 * 1024 * 512 * 2;
constexpr size_t WS_W_DN  = WS_W_GU + (size_t)4 * 32 * 1024 * 1024 * 2;
constexpr size_t WS_MEMN  = WS_W_DN + (size_t)4 * 32 * 1024 * 512 * 2;
constexpr size_t WS_XK    = WS_MEMN + (size_t)2048 * 1024 * 2;
constexpr size_t WS_XVT   = WS_XK + (size_t)4 * 2048 * 512 * 2;
constexpr size_t WS_A2    = WS_XVT + (size_t)4 * 2048 * 512 * 2;
constexpr size_t WS_FILT  = WS_A2 + (size_t)2 * 2048 * 64 * 4;
constexpr size_t WS_X     = WS_FILT + (size_t)2 * 2 * 512 * 4096 * 2;
constexpr size_t WS_H     = WS_X + (size_t)NTOK * D * 4;
constexpr size_t WS_PROJ  = WS_H + al256((size_t)(NTOK + 1) * D * 2);
constexpr size_t WS_YMIX  = WS_PROJ + (size_t)NTOK * 3072 * 2;
constexpr size_t WS_QX    = WS_YMIX + (size_t)NTOK * D * 2;
constexpr size_t WS_OX    = WS_QX + (size_t)NTOK * 512 * 2;
constexpr size_t WS_ACT   = WS_OX + (size_t)NTOK * 512 * 2;
constexpr size_t WS_Y     = WS_ACT + al256((size_t)(2 * NTOK + 1) * EH * 2);
constexpr size_t WS_LIST  = WS_Y + (size_t)2 * NTOK * D * 2;
constexpr size_t WS_WT    = WS_LIST + (size_t)NEXP * NTOK * 4;
constexpr size_t WS_RSTD  = WS_WT + (size_t)2 * NTOK * 4;
constexpr size_t WS_WRT   = WS_RSTD + (size_t)NTOK * 4;
constexpr size_t WS_XB    = WS_WRT + (size_t)4 * 2 * 48 * 1024 * 2;
constexpr size_t WS_SSP   = WS_XB + al256((size_t)(NTOK + 1) * D * 2);
constexpr size_t WS_RS1   = WS_SSP + (size_t)NTOK * 16 * 4;
constexpr size_t WS_RP    = WS_RS1 + (size_t)NTOK * 4;
constexpr size_t WS_END   = WS_RP + (size_t)NEXP * NTOK * 4;
constexpr size_t PR_HYT   = 0;
constexpr size_t PR_QK    = (size_t)1536 * NTOK * 2;
constexpr size_t PR_VT    = PR_QK + (size_t)NTOK * 1024 * 2;
constexpr size_t PR_OVT   = (size_t)NTOK * 1280 * 2;

constexpr int LDS_XB = 147456;
constexpr int LDS_ROUTE = LDS_XB + 64;
constexpr int LDS_BYTES = LDS_ROUTE + 2048;

struct Params {
    const float* in[34];
    float* out;
    unsigned char* ws;
};

extern __shared__ __attribute__((aligned(16))) bf16_t shm[];

typedef float f32x2 __attribute__((ext_vector_type(2)));
typedef __bf16 bf16x2v __attribute__((ext_vector_type(2)));
__device__ __forceinline__ unsigned cvt_pk_bf16(float lo, float hi) { const f32x2 v = {lo, hi}; return __builtin_bit_cast(unsigned, __builtin_convertvector(v, bf16x2v)); }
__device__ __forceinline__ float bf2f(unsigned short b) { return __uint_as_float((unsigned)b << 16); }
__device__ __forceinline__ float bflo(unsigned w) { return __uint_as_float(w << 16); }
__device__ __forceinline__ float bfhi(unsigned w) { return __uint_as_float(w & 0xffff0000u); }
__device__ __forceinline__ float shx(float v, int m, int lane) { return __int_as_float(__builtin_amdgcn_ds_bpermute((lane ^ m) << 2, __float_as_int(v))); }
__device__ __forceinline__ float shl(float v, int src) { return __int_as_float(__builtin_amdgcn_ds_bpermute(src << 2, __float_as_int(v))); }
__device__ __forceinline__ float wave_sum(float v, int lane) {
    v += shx(v, 1, lane); v += shx(v, 2, lane); v += shx(v, 4, lane); v += shx(v, 8, lane); v += shx(v, 16, lane); v += shx(v, 32, lane); return v;
}

__device__ __forceinline__ float uni(float x) { return __builtin_bit_cast(float, __builtin_amdgcn_readfirstlane(__builtin_bit_cast(int, x))); }
__device__ __forceinline__ int hidden_tid(int wv) { int l; asm volatile("v_mbcnt_lo_u32_b32 %0, -1, 0\n\tv_mbcnt_hi_u32_b32 %0, -1, %0" : "=&v"(l)); return (wv << 6) | l; }

#define XB_TMO      128
#define XB_XCNT(j)  (256  + 64 * (j))
#define XB_XSUB(j)  (1280 + 64 * (j))
#define XB_XGEN(j)  (2304 + 64 * (j))
#define XB_TOP      3328
#define XB_TOPGEN   3392
#define XCD_BAR_WORDS 3456
#define XB_SPIN_CAP (1u << 22)
#define LAS __attribute__((address_space(3)))

__device__ __forceinline__ unsigned xb_ld(unsigned* p)              { return __hip_atomic_load(p, __ATOMIC_RELAXED, __HIP_MEMORY_SCOPE_AGENT); }
__device__ __forceinline__ unsigned xb_add(unsigned* p, unsigned v) { return __hip_atomic_fetch_add(p, v, __ATOMIC_RELAXED, __HIP_MEMORY_SCOPE_AGENT); }
__device__ __forceinline__ unsigned xb_xcc_id() { return (unsigned)__builtin_amdgcn_s_getreg((3 << 11) | 20) & 0xFu; }
#define XB_SPIN(cond, bar) do { unsigned _sp = 0; while (cond) { __builtin_amdgcn_s_sleep(1); \
    if ((++_sp & 255u) == 0u) { if (xb_ld(&(bar)[XB_TMO])) break; if (_sp > XB_SPIN_CAP) { atomicAdd(&(bar)[XB_TMO], 1u); break; } } } } while (0)

struct XcdBarrier { unsigned* bar; unsigned x; volatile LAS unsigned* st; };

__device__ __forceinline__ XcdBarrier xcd_barrier_post(unsigned* bar, volatile LAS unsigned* st) {
    XcdBarrier b; b.bar = bar; b.x = xb_xcc_id(); b.st = st;
    if (threadIdx.x == 0) (void)xb_add(&bar[XB_XCNT(b.x)], 1u);
    return b;
}
__device__ __forceinline__ void xcd_barrier_complete(unsigned* bar, unsigned x, unsigned& nloc, unsigned& nx) {
    const unsigned G = gridDim.x * gridDim.y * gridDim.z;
    unsigned sum, cnt, mine, sp = 0u;
    for (;;) {
        sum = 0u; cnt = 0u; mine = 0u;
#pragma unroll
        for (unsigned j = 0; j < 16; ++j) { const unsigned c = xb_ld(&bar[XB_XCNT(j)]); sum += c; cnt += (c > 0u) ? 1u : 0u; mine = (j == x) ? c : mine; }
        if (sum == G) break;
        __builtin_amdgcn_s_sleep(1);
        if ((++sp & 255u) == 0u) { if (xb_ld(&bar[XB_TMO])) break; if (sp > XB_SPIN_CAP) { atomicAdd(&bar[XB_TMO], 1u); break; } }
    }
    nloc = mine > 0u ? mine : 1u; nx = cnt > 0u ? cnt : 1u;
}
__device__ __forceinline__ void xcd_barrier(const XcdBarrier& b) {
    asm volatile("s_waitcnt vmcnt(0)" ::: "memory");
    __syncthreads();
    if (threadIdx.x == 0) {
        unsigned* bar = b.bar; unsigned bx = b.x;
        asm volatile("" : "+s"(bar), "+s"(bx));
        __builtin_amdgcn_s_waitcnt(0);
        unsigned nloc = b.st[0], nx = b.st[1];
        if (nloc == 0u) { xcd_barrier_complete(bar, bx, nloc, nx); b.st[0] = nloc; b.st[1] = nx; }
        const unsigned old = xb_add(&bar[XB_XSUB(bx)], 1u);
        const unsigned gen = old / nloc;
        if (old + 1u == (gen + 1u) * nloc) {
            __builtin_amdgcn_fence(__ATOMIC_RELEASE, "agent");
            asm volatile("s_waitcnt vmcnt(0)" ::: "memory");
            const unsigned og = xb_add(&bar[XB_TOP], 1u);
            const unsigned tg = og / nx;
            if (og + 1u == (tg + 1u) * nx) xb_add(&bar[XB_TOPGEN], 1u);
            else XB_SPIN(xb_ld(&bar[XB_TOPGEN]) == tg, bar);
            __builtin_amdgcn_fence(__ATOMIC_ACQUIRE, "agent");
            xb_add(&bar[XB_XGEN(bx)], 1u);
            asm volatile("s_waitcnt vmcnt(0)" ::: "memory");
        } else {
            XB_SPIN(xb_ld(&bar[XB_XGEN(bx)]) == gen, bar);
            __builtin_amdgcn_fence(__ATOMIC_ACQUIRE, "agent");
            asm volatile("s_waitcnt vmcnt(0)" ::: "memory");
        }
    }
    __syncthreads();
}

constexpr int HT = 128 * 64;
__device__ __forceinline__ int lds_byte(int r, int c) {
    int st = (r >> 4) * 2 + (c >> 5), rr = r & 15, cc = c & 31, ob = rr * 64 + cc * 2;
    return st * 1024 + (ob ^ (((ob >> 9) & 1) << 5));
}
__device__ __forceinline__ void stage_rc(int b, int& R, int& C) {
    int st = b / 1024, sb = b % 1024, swz = sb ^ (((sb >> 9) & 1) << 5);
    R = (st >> 1) * 16 + swz / 64; C = (st & 1) * 32 + (swz % 64) / 2;
}
#define SA(b, h) (shm + ((b) * 2 + (h)) * HT)
#define SB(b, h) (shm + (4 + (b) * 2 + (h)) * HT)
#define G_STAGE_A(P_, h, kt) do { _Pragma("unroll") for (int _i = 0; _i < 2; ++_i) \
    __builtin_amdgcn_global_load_lds((const unsigned*)((const char*)A + (size_t)((kt) * 128 + (RowSrc::DENSE ? (h) * 256 * K : 0)) + aoff[RowSrc::DENSE ? 0 : (h)][_i]), (unsigned*)((char*)(P_) + tid * 16 + _i * 8192), 16, 0, 0); } while (0)
#define G_STAGE_B(P_, h, kt) do { _Pragma("unroll") for (int _i = 0; _i < 2; ++_i) \
    __builtin_amdgcn_global_load_lds((const unsigned*)((const char*)Bt + (size_t)((kt) * 128 + (h) * 64 * K) + boff[_i]), (unsigned*)((char*)(P_) + tid * 16 + _i * 8192), 16, 0, 0); } while (0)
#define G_LDA(dst, b, h) _Pragma("unroll") for (int m = 0; m < 4; ++m) _Pragma("unroll") for (int k = 0; k < 2; ++k) \
    dst[m][k] = *reinterpret_cast<const bf16x8*>((char*)SA(b, h) + lds_byte(wr * 64 + m * 16 + fr, k * 32 + fq * 8))
#define G_LDB(dst, b, h) _Pragma("unroll") for (int n = 0; n < 2; ++n) _Pragma("unroll") for (int k = 0; k < 2; ++k) \
    dst[n][k] = *reinterpret_cast<const bf16x8*>((char*)SB(b, h) + lds_byte(wc * 32 + n * 16 + fr, k * 32 + fq * 8))
#define G_MMA(ai, bj, At_, Bt_) do { __builtin_amdgcn_s_setprio(1); \
    _Pragma("unroll") for (int m = 0; m < 4; ++m) _Pragma("unroll") for (int n = 0; n < 2; ++n) _Pragma("unroll") for (int k = 0; k < 2; ++k) \
      acc[ai][bj][m][n] = __builtin_amdgcn_mfma_f32_16x16x32_bf16(Bt_[n][k], At_[m][k], acc[ai][bj][m][n], 0, 0, 0); \
    __builtin_amdgcn_s_setprio(0); } while (0)
#define WAIT_V(n) asm volatile("s_waitcnt vmcnt(" #n ")" ::: "memory")
#define WAIT_L(n) asm volatile("s_waitcnt lgkmcnt(" #n ")" ::: "memory")
#define BAR __builtin_amdgcn_s_barrier()
#define SCHED __builtin_amdgcn_sched_barrier(0)

typedef f32x4 AccT[2][2][4][2];

template <class RowSrc, class Epi>
__device__ __forceinline__ void gemm_tile(const bf16_t* __restrict__ A, const bf16_t* __restrict__ Bt, const int K,
                                          const int bcol, const RowSrc& rs, const Epi& epi, const int wv, const int ntl = 0) {
    const int tid = hidden_tid(wv);
    int wid = tid >> 6, lane = tid & 63, wr = wid >> 2, wc = wid & 3, fr = lane & 15, fq = lane >> 4;
    unsigned aoff[2][2], boff[2];
#pragma unroll
    for (int i = 0; i < 2; ++i) {
        int R, C; stage_rc(tid * 16 + i * 8192, R, C);
        boff[i] = (unsigned)(((bcol + (R >> 5) * 64 + (R & 31)) * K + C) * 2);
        if (RowSrc::DENSE) { aoff[0][i] = (unsigned)((R * K + C) * 2); aoff[1][i] = 0u; }
        else {
#pragma unroll
            for (int h = 0; h < 2; ++h) aoff[h][i] = (unsigned)((rs(h * 128 + R) * K + C) * 2);
        }
    }
    AccT acc = {};
    bf16x8 At[4][2], B0[2][2], B1[2][2];
    const int nt = ntl ? ntl : K / 64;
    G_STAGE_B(SB(0, 0), 0, 0); G_STAGE_A(SA(0, 0), 0, 0);
    G_STAGE_B(SB(0, 1), 1, 0); G_STAGE_A(SA(0, 1), 1, 0);
    if (wr == 1) BAR;
    WAIT_V(4); BAR;
    G_STAGE_B(SB(1, 0), 0, 1); G_STAGE_A(SA(1, 0), 0, 1); G_STAGE_B(SB(1, 1), 1, 1);
    WAIT_V(6); BAR;
    for (int t = 0; t < nt - 2; t += 2) {
        G_LDB(B0, 0, 0); SCHED; G_LDA(At, 0, 0); G_STAGE_A(SA(1, 1), 1, t + 1);
        WAIT_L(8); BAR; WAIT_L(0); G_MMA(0, 0, At, B0); BAR; SCHED;
        G_LDB(B1, 0, 1); G_STAGE_B(SB(0, 0), 0, t + 2);
        BAR; WAIT_L(0); G_MMA(0, 1, At, B1); BAR;
        G_LDA(At, 0, 1); G_STAGE_A(SA(0, 0), 0, t + 2);
        BAR; WAIT_L(0); G_MMA(1, 0, At, B0); BAR; SCHED;
        G_STAGE_B(SB(0, 1), 1, t + 2);
        WAIT_V(6); BAR; G_MMA(1, 1, At, B1); BAR;
        G_LDB(B0, 1, 0); SCHED; G_LDA(At, 1, 0); G_STAGE_A(SA(0, 1), 1, t + 2);
        WAIT_L(8); BAR; WAIT_L(0); G_MMA(0, 0, At, B0); BAR; SCHED;
        G_LDB(B1, 1, 1); G_STAGE_B(SB(1, 0), 0, t + 3);
        BAR; WAIT_L(0); G_MMA(0, 1, At, B1); BAR;
        G_LDA(At, 1, 1); G_STAGE_A(SA(1, 0), 0, t + 3);
        BAR; WAIT_L(0); G_MMA(1, 0, At, B0); BAR; SCHED;
        G_STAGE_B(SB(1, 1), 1, t + 3);
        WAIT_V(6); BAR; G_MMA(1, 1, At, B1); BAR;
    }
    { G_LDB(B0, 0, 0); WAIT_V(0); G_LDA(At, 0, 0); G_STAGE_A(SA(1, 1), 1, nt - 1);
      BAR; WAIT_L(0); G_MMA(0, 0, At, B0); BAR;
      G_LDB(B1, 0, 1); BAR; WAIT_L(0); G_MMA(0, 1, At, B1); BAR;
      G_LDA(At, 0, 1); WAIT_V(4); BAR; WAIT_L(0); G_MMA(1, 0, At, B0); G_MMA(1, 1, At, B1); BAR; }
    { G_LDB(B0, 1, 0); G_LDA(At, 1, 0); WAIT_V(2); BAR; WAIT_L(0); G_MMA(0, 0, At, B0); BAR;
      G_LDB(B1, 1, 1); WAIT_V(0); BAR; WAIT_L(0); G_MMA(0, 1, At, B1); BAR;
      G_LDA(At, 1, 1); BAR; WAIT_L(0); G_MMA(1, 0, At, B0); G_MMA(1, 1, At, B1); BAR; }
    if (wr == 0) BAR;
    int tz = hidden_tid(wv); wid = tz >> 6; lane = tz & 63; wr = wid >> 2; wc = wid & 3; fr = lane & 15; fq = lane >> 4;
    epi(acc, wr * 64 + fr, bcol + wc * 64 + fq * 4);
}

struct RowIdent { static constexpr bool DENSE = true; __device__ __forceinline__ int operator()(int r) const { return r; } };

__device__ __forceinline__ void st_bf16x4(bf16_t* p, const f32x4& v) { u32x2 w; w.x = cvt_pk_bf16(v[0], v[1]); w.y = cvt_pk_bf16(v[2], v[3]); *(u32x2*)p = w; }
__device__ __forceinline__ void st_chan4(bf16_t* q, size_t ld, const f32x4& v) {
    const unsigned a = cvt_pk_bf16(v[0], v[1]), b = cvt_pk_bf16(v[2], v[3]);
    q[0] = (bf16_t)(a & 0xffff); q[ld] = (bf16_t)(a >> 16); q[2 * ld] = (bf16_t)(b & 0xffff); q[3 * ld] = (bf16_t)(b >> 16);
}
constexpr int BJS = 32;
#define EPI_LOOP_AM _Pragma("unroll") for (int ai = 0; ai < 2; ++ai) _Pragma("unroll") for (int m = 0; m < 4; ++m)
#define EPI_LOOP_BN _Pragma("unroll") for (int bj = 0; bj < 2; ++bj) _Pragma("unroll") for (int n = 0; n < 2; ++n)
struct EpiRes {
    bf16_t* XB; int brow; float* ssp; int lane;
    __device__ __forceinline__ void operator()(AccT& acc, int r0, int c0) const {
        u32x2 xv[2][4][4];
        EPI_LOOP_AM {
            const bf16_t* qb = XB + (size_t)(brow + r0 + ai * 128 + m * 16) * D + c0;
            EPI_LOOP_BN xv[ai][m][bj * 2 + n] = *(const u32x2*)(qb + bj * BJS + n * 16);
        }
        EPI_LOOP_AM {
            const int row = brow + r0 + ai * 128 + m * 16;
            bf16_t* qb = XB + (size_t)row * D + c0;
            float ss = 0.f;
            EPI_LOOP_BN {
                const u32x2 x = xv[ai][m][bj * 2 + n];
                const f32x4 t = (f32x4){bflo(x.x), bfhi(x.x), bflo(x.y), bfhi(x.y)} + acc[ai][bj][m][n];
                const unsigned a0 = cvt_pk_bf16(t[0], t[1]), a1 = cvt_pk_bf16(t[2], t[3]);
                *(u32x2*)(qb + bj * BJS + n * 16) = (u32x2){a0, a1};
                const float r0f = bflo(a0), r1f = bfhi(a0), r2f = bflo(a1), r3f = bfhi(a1);
                ss += (r0f * r0f + r1f * r1f) + (r2f * r2f + r3f * r3f);
            }
            if (ssp) { ss += shx(ss, 16, lane); ss += shx(ss, 32, lane); if ((lane >> 4) == 0) ssp[(size_t)row * 16 + (c0 >> 6)] = ss; }
        }
    }
};
struct EpiSplit {
    bf16_t* Ca; bf16_t* T; bf16_t* Cb; int c0s, c1s, ldT; size_t ldC; int brow; const float* rs;
    __device__ __forceinline__ void chan(AccT& acc, bf16_t* base, int r0, int c, const float (&scv)[2][4]) const {
        EPI_LOOP_AM { const int row = brow + r0 + ai * 128 + m * 16; const float sc = scv[ai][m];
            bf16_t* q = base + (size_t)c * ldC + row;
            EPI_LOOP_BN st_chan4(q + (size_t)(bj * BJS + n * 16) * ldC, ldC, acc[ai][bj][m][n] * sc); }
    }
    __device__ __forceinline__ void operator()(AccT& acc, int r0, int c0) const {
        const int tilec = __builtin_amdgcn_readfirstlane(c0) & ~255;
        float scv[2][4];
        EPI_LOOP_AM scv[ai][m] = rs ? rs[brow + r0 + ai * 128 + m * 16] : 1.0f;
        if (tilec < c0s) chan(acc, Ca, r0, c0, scv);
        else if (tilec < c1s) {
            EPI_LOOP_AM { const int row = brow + r0 + ai * 128 + m * 16; const float sc = scv[ai][m];
                bf16_t* q = T + (size_t)row * ldT + (c0 - c0s);
                EPI_LOOP_BN st_bf16x4(q + bj * BJS + n * 16, acc[ai][bj][m][n] * sc); }
        } else chan(acc, Cb, r0, c0 - c1s, scv);
    }
};
struct EpiTokRstd {
    bf16_t* T; int ldT, brow; const float* ssp; int lane;
    __device__ __forceinline__ void operator()(AccT& acc, int r0, int c0) const {
        f32x4 pv[2][4];
        EPI_LOOP_AM pv[ai][m] = *(const f32x4*)(ssp + (size_t)(brow + r0 + ai * 128 + m * 16) * 16 + (lane >> 4) * 4);
        EPI_LOOP_AM {
            const int row = brow + r0 + ai * 128 + m * 16;
            float ssq = (pv[ai][m][0] + pv[ai][m][1]) + (pv[ai][m][2] + pv[ai][m][3]);
            ssq += shx(ssq, 16, lane); ssq += shx(ssq, 32, lane);
            const float rs = rsqrtf(ssq * (1.0f / 1024.0f) + EPS);
            bf16_t* q = T + (size_t)row * ldT + c0;
            EPI_LOOP_BN st_bf16x4(q + bj * BJS + n * 16, acc[ai][bj][m][n] * rs);
        }
    }
};
struct EpiGateUp {
    bf16_t* act; const int* list; int cnt, pos0; const float* rp;
    __device__ __forceinline__ void operator()(AccT& acc, int r0, int c0) const {
        int av[2][4]; float rv[2][4];
        EPI_LOOP_AM { const int pos = pos0 + r0 + ai * 128 + m * 16, pc = pos < cnt ? pos : cnt - 1; av[ai][m] = list[pc]; rv[ai][m] = rp[pc]; }
        EPI_LOOP_AM {
            const int pos = pos0 + r0 + ai * 128 + m * 16;
            if (pos < cnt) {
                const int a = av[ai][m];
                const float rs = rv[ai][m];
#pragma unroll
                for (int bj = 0; bj < 2; ++bj) {
                    const f32x4 g = acc[ai][bj][m][0] * rs, u = acc[ai][bj][m][1] * rs; f32x4 o;
#pragma unroll
                    for (int j = 0; j < 4; ++j) o[j] = g[j] * __builtin_amdgcn_rcpf(1.0f + __builtin_amdgcn_exp2f(g[j] * -1.4426950408889634f)) * u[j];
                    const int col = c0 + bj * BJS;
                    const unsigned long long wv8 = ((unsigned long long)cvt_pk_bf16(o[2], o[3]) << 32) | cvt_pk_bf16(o[0], o[1]);
                    __hip_atomic_store((unsigned long long*)(act + (size_t)a * EH + (col >> 5) * 16 + (col & 15)), wv8, __ATOMIC_RELAXED, __HIP_MEMORY_SCOPE_AGENT);
                }
            }
        }
    }
};
struct EpiDown {
    bf16_t* y; const int* list; int cnt, pos0;
    __device__ __forceinline__ void operator()(AccT& acc, int r0, int c0) const {
        int av[2][4];
        EPI_LOOP_AM { const int pos = pos0 + r0 + ai * 128 + m * 16, pc = pos < cnt ? pos : cnt - 1; av[ai][m] = list[pc]; }
        EPI_LOOP_AM {
            const int pos = pos0 + r0 + ai * 128 + m * 16;
            if (pos < cnt) { bf16_t* q = y + (size_t)av[ai][m] * D + c0; EPI_LOOP_BN st_bf16x4(q + bj * BJS + n * 16, acc[ai][bj][m][n]); }
        }
    }
};
struct EpiNull {
    float* sink; int flag; int brow;
    __device__ __forceinline__ void operator()(AccT& acc, int r0, int c0) const {
        if (flag) { f32x4 t = {0.f, 0.f, 0.f, 0.f}; EPI_LOOP_AM EPI_LOOP_BN t += acc[ai][bj][m][n]; *(f32x4*)(sink + (size_t)(brow + r0) * 4 + c0) = t; }
    }
};
struct RowTok { static constexpr bool DENSE = false; const int* list; int cnt, pos0; __device__ __forceinline__ int operator()(int r) const { const int pos = pos0 + r; return pos < cnt ? (list[pos] >> 1) : NTOK; } };
struct RowAsg { static constexpr bool DENSE = false; const int* list; int cnt, pos0; __device__ __forceinline__ int operator()(int r) const { const int pos = pos0 + r; return pos < cnt ? list[pos] : 2 * NTOK; } };

constexpr int ATT_VOFF = 16384;
template <int MODE> struct ACfg;
template <> struct ACfg<0> { static constexpr int DQK = 64, DV = 128, NMAP = 2, KBLK = 2; };
template <> struct ACfg<1> { static constexpr int DQK = 64, DV = 64, NMAP = 1, KBLK = 1; };
template <> struct ACfg<2> { static constexpr int DQK = 128, DV = 128, NMAP = 1, KBLK = 2; };

template <int MODE, bool ALT = false>
__device__ __forceinline__ void attn_unit(const bf16_t* __restrict__ Qp, const int ldq,
                                          const bf16_t* __restrict__ Kp, const int ldk,
                                          const bf16_t* __restrict__ Vt, const size_t ldvt,
                                          const int q0, const int kbeg, const int kend,
                                          const float scale, const float slope, const float m_init, const float l_init,
                                          bf16_t* __restrict__ Op, const int ldo,
                                          const float lam, const float outscale, const float* __restrict__ subln, const int wv) {
    constexpr int DQK = ACfg<MODE>::DQK, DV = ACfg<MODE>::DV, NMAP = ACfg<MODE>::NMAP, KBLK = ACfg<MODE>::KBLK;
    const int tid = hidden_tid(wv), w = tid >> 6, lane = tid & 63, fr = lane & 15, fq = lane >> 4;
    const int qrow = q0 + w * 16 + fr;
    bf16x8 Qf[NMAP][DQK / 32];
#pragma unroll
    for (int m = 0; m < NMAP; ++m)
#pragma unroll
        for (int kk = 0; kk < DQK / 32; ++kk) Qf[m][kk] = *(const bf16x8*)(Qp + (size_t)qrow * ldq + m * DQK + kk * 32 + fq * 8);
    constexpr float LOG2E = 1.4426950408889634f;
    const float scale2 = scale * LOG2E, slope2 = slope * LOG2E, kappa = slope / scale;
    f32x4 O[NMAP][DV / 16], Ol[NMAP];
    float mrun[NMAP];
#pragma unroll
    for (int m = 0; m < NMAP; ++m) {
        mrun[m] = m_init * LOG2E; Ol[m] = (f32x4){(fq == 0) ? l_init : 0.f, 0.f, 0.f, 0.f};
#pragma unroll
        for (int et = 0; et < DV / 16; ++et) O[m][et] = (f32x4){0.f, 0.f, 0.f, 0.f};
    }
    const unsigned onesw = (fr == 0) ? 0x3f803f80u : 0u;
    const bf16x8 onesf = __builtin_bit_cast(bf16x8, (u32x4){onesw, onesw, onesw, onesw});
    char* const lds = (char*)shm;
    constexpr int KN = KBLK, VN = DV / 64;
    u32x4 kreg[KN], vreg[VN];
#define ATT_LOAD(k0_) do { \
        _Pragma("unroll") for (int i_ = 0; i_ < KN; ++i_) { const int c_ = tid + i_ * NT; const int key_ = c_ / (KBLK * 8), col_ = (c_ % (KBLK * 8)) * 8; \
            kreg[i_] = *(const u32x4*)(Kp + (size_t)((k0_) + key_) * ldk + col_); } \
        _Pragma("unroll") for (int i_ = 0; i_ < VN; ++i_) { const int c_ = tid + i_ * NT; const int e_ = c_ >> 3, kc_ = c_ & 7; \
            vreg[i_] = *(const u32x4*)(Vt + (size_t)e_ * ldvt + (k0_) + kc_ * 8); } } while (0)
    ATT_LOAD(kbeg);
    const int qw0 = q0 + w * 16;
    constexpr int VBYTES = DV * 160;
    bf16x8 Pf[NMAP][2];
#define ATT_PV_C(voff_, c) do { \
            bf16x8 vf[DV / 16]; \
            _Pragma("unroll") for (int et = 0; et < DV / 16; ++et) vf[et] = *(const bf16x8*)(lds + (voff_) + (et * 16 + fr) * 160 + (c) * 64 + fq * 16); \
            _Pragma("unroll") for (int m = 0; m < NMAP; ++m) Ol[m] = __builtin_amdgcn_mfma_f32_16x16x32_bf16(onesf, Pf[m][c], Ol[m], 0, 0, 0); \
            _Pragma("unroll") for (int et = 0; et < DV / 16; ++et) \
                _Pragma("unroll") for (int m = 0; m < NMAP; ++m) O[m][et] = __builtin_amdgcn_mfma_f32_16x16x32_bf16(vf[et], Pf[m][c], O[m][et], 0, 0, 0); \
        } while (0)
    int vcur = ATT_VOFF;
    for (int k0 = kbeg; k0 < kend; k0 += 64) {
        __syncthreads();
#pragma unroll
        for (int i = 0; i < KN; ++i) { const int c = tid + i * NT; const int key = c / (KBLK * 8), col = (c % (KBLK * 8)) * 8;
            *(u32x4*)(lds + (col >> 6) * 8192 + lds_byte(key, col & 63)) = kreg[i]; }
#pragma unroll
        for (int i = 0; i < VN; ++i) { const int c = tid + i * NT; const int e = c >> 3, kc = c & 7;
            char* vd = lds + vcur + e * 160 + (kc >> 2) * 64 + (kc & 1) * 32 + ((kc >> 1) & 1) * 8;
            *(u32x2*)vd = (u32x2){vreg[i].x, vreg[i].y}; *(u32x2*)(vd + 16) = (u32x2){vreg[i].z, vreg[i].w}; }
        __syncthreads();
        if (k0 + 64 < kend) ATT_LOAD(k0 + 64);
        const int vprev = vcur ^ ATT_VOFF ^ (ATT_VOFF + VBYTES);
        const float dq = (float)(qrow - k0);
        bool gen;
        if (MODE == 2) gen = false;
        else if (MODE == 1) gen = !((k0 + 63 <= qw0 && qw0 + 15 - k0 <= 128) || (k0 >= qw0 + 15 && k0 + 63 - qw0 <= 128));
        else gen = !(k0 + 63 <= qw0 || k0 >= qw0 + 15);
        const bool pos = (MODE == 2) || (k0 + 63 <= qw0);
        f32x4 Cin[4]; float off;
        if (MODE == 2) {
#pragma unroll
            for (int t = 0; t < 4; ++t) Cin[t] = (f32x4){0.f, 0.f, 0.f, 0.f};
            off = 0.f;
        } else if (gen) {
#pragma unroll
            for (int t = 0; t < 4; ++t)
#pragma unroll
                for (int r = 0; r < 4; ++r) Cin[t][r] = -kappa * fabsf(dq - (float)(16 * t + 4 * fq + r));
            off = 0.f;
        } else {
            const float sk = pos ? kappa : -kappa, cb = sk * (float)(4 * fq);
#pragma unroll
            for (int t = 0; t < 4; ++t)
#pragma unroll
                for (int r = 0; r < 4; ++r) Cin[t][r] = sk * (float)(16 * t + r) + cb;
            off = pos ? -slope2 * dq : slope2 * dq;
        }
        f32x4 s[NMAP][4];
#pragma unroll
        for (int m = 0; m < NMAP; ++m) {
            bf16x8 kf[4][DQK / 32];
#pragma unroll
            for (int t = 0; t < 4; ++t)
#pragma unroll
                for (int kk = 0; kk < DQK / 32; ++kk) {
                    const int blk = (MODE == 2) ? (kk >> 1) : m, kcol = (MODE == 2) ? (kk & 1) * 32 : kk * 32;
                    kf[t][kk] = *(const bf16x8*)(lds + blk * 8192 + lds_byte(t * 16 + fr, kcol + fq * 8));
                }
#pragma unroll
            for (int t = 0; t < 4; ++t) {
                s[m][t] = Cin[t];
#pragma unroll
                for (int kk = 0; kk < DQK / 32; ++kk) s[m][t] = __builtin_amdgcn_mfma_f32_16x16x32_bf16(kf[t][kk], Qf[m][kk], s[m][t], 0, 0, 0);
            }
        }
        float mx[NMAP], mx1[NMAP];
#pragma unroll
        for (int m = 0; m < NMAP; ++m) {
            if (MODE == 1 && gen) {
#pragma unroll
                for (int t = 0; t < 4; ++t)
#pragma unroll
                    for (int r = 0; r < 4; ++r) s[m][t][r] = (fabsf(dq - (float)(16 * t + 4 * fq + r)) > 128.0f) ? -1e30f : s[m][t][r];
            }
            float v = fmaxf(fmaxf(s[m][0][0], s[m][0][1]), fmaxf(s[m][0][2], s[m][0][3]));
#pragma unroll
            for (int t = 1; t < 4; ++t) v = fmaxf(v, fmaxf(fmaxf(s[m][t][0], s[m][t][1]), fmaxf(s[m][t][2], s[m][t][3])));
            mx[m] = v; mx1[m] = shx(v, 16, lane);
        }
        __builtin_amdgcn_sched_barrier(0);
        if (k0 > kbeg) ATT_PV_C(vprev, 0);
        __builtin_amdgcn_sched_barrier(0);
#pragma unroll
        for (int m = 0; m < NMAP; ++m) { mx[m] = fmaxf(mx[m], mx1[m]); mx1[m] = shx(mx[m], 32, lane); }
        __builtin_amdgcn_sched_barrier(0);
        if (k0 > kbeg) ATT_PV_C(vprev, 1);
        __builtin_amdgcn_sched_barrier(0);
#pragma unroll
        for (int m = 0; m < NMAP; ++m) {
            const float mxx = fmaxf(mx[m], mx1[m]);
            const float mtile = fmaxf(mxx * scale2 + off, -1e30f);
            const float mnew = fmaxf(mrun[m], mtile), alpha = __builtin_amdgcn_exp2f(mrun[m] - mnew);
            mrun[m] = mnew;
            const float sub = off - mnew;
#pragma unroll
            for (int t = 0; t < 4; ++t)
#pragma unroll
                for (int r = 0; r < 4; ++r) s[m][t][r] = __builtin_amdgcn_exp2f(s[m][t][r] * scale2 + sub);
            if (__builtin_amdgcn_ballot_w64(alpha != 1.0f) != 0ull) {
                Ol[m] *= alpha;
#pragma unroll
                for (int et = 0; et < DV / 16; ++et) O[m][et] *= alpha;
            }
#pragma unroll
            for (int c = 0; c < 2; ++c) {
                u32x4 pk; pk.x = cvt_pk_bf16(s[m][2 * c][0], s[m][2 * c][1]); pk.y = cvt_pk_bf16(s[m][2 * c][2], s[m][2 * c][3]);
                pk.z = cvt_pk_bf16(s[m][2 * c + 1][0], s[m][2 * c + 1][1]); pk.w = cvt_pk_bf16(s[m][2 * c + 1][2], s[m][2 * c + 1][3]);
                Pf[m][c] = __builtin_bit_cast(bf16x8, pk);
            }
        }
        vcur = vprev;
    }
    { const int vlast = vcur ^ ATT_VOFF ^ (ATT_VOFF + VBYTES); ATT_PV_C(vlast, 0); ATT_PV_C(vlast, 1); }
    float linv[NMAP];
#pragma unroll
    for (int m = 0; m < NMAP; ++m) linv[m] = 1.0f / shl(Ol[m][0], fr);
    const int tid2 = hidden_tid(wv); const int qrow_o = q0 + (tid2 >> 6) * 16 + (tid2 & 15);
    if (MODE == 0) {
        float ss = 0.f;
#pragma unroll
        for (int et = 0; et < DV / 16; ++et)
#pragma unroll
            for (int r = 0; r < 4; ++r) { const float v = O[0][et][r] * linv[0] - lam * (O[NMAP - 1][et][r] * linv[NMAP - 1]); O[0][et][r] = v; ss += v * v; }
        ss += shx(ss, 16, lane); ss += shx(ss, 32, lane);
        const float rs = rsqrtf(ss * (1.0f / 128.0f) + EPS) * outscale;
#pragma unroll
        for (int et = 0; et < DV / 16; ++et) {
            const f32x4 g = *(const f32x4*)(subln + et * 16 + fq * 4);
            st_bf16x4(Op + (size_t)qrow_o * ldo + et * 16 + fq * 4, O[0][et] * rs * g);
        }
    } else {
#pragma unroll
        for (int et = 0; et < DV / 16; ++et) st_bf16x4(Op + (size_t)qrow_o * ldo + et * 16 + fq * 4, O[0][et] * linv[0]);
    }
}

template <int MODE>
__device__ __forceinline__ void attn2_unit(const bf16_t* __restrict__ Qp, const int ldq, const bf16_t* __restrict__ Kp, const int ldk,
                                           const bf16_t* __restrict__ Vt, const size_t ldvt, const int q0, const int kbeg, const int kend,
                                           const float scale, const float* __restrict__ sinkp, const int hq0, bf16_t* __restrict__ Op, const int ldo, const int wv) {
    constexpr int DQK = ACfg<MODE>::DQK, DV = ACfg<MODE>::DV, KBLK = ACfg<MODE>::KBLK, RT = 2;
    const int tid = hidden_tid(wv), w = tid >> 6, lane = tid & 63, fr = lane & 15, fq = lane >> 4;
    const int hl = (MODE == 1) ? (w >> 1) : 0, qsub = (MODE == 1) ? (w & 1) * 32 : w * 32;
    const float slope = (MODE == 1) ? exp2f(-0.5f * (float)(hq0 + hl + 1)) : 0.f;
    const float m_init = (MODE == 1) ? sinkp[hl] : -1e30f, l_init = (MODE == 1) ? 1.0f : 0.f;
    constexpr float LOG2E = 1.4426950408889634f;
    const float scale2 = scale * LOG2E, slope2 = slope * LOG2E, kappa = slope / scale;
    bf16x8 Qf[RT][DQK / 32];
#pragma unroll
    for (int rt = 0; rt < RT; ++rt)
#pragma unroll
        for (int kk = 0; kk < DQK / 32; ++kk) Qf[rt][kk] = *(const bf16x8*)(Qp + (size_t)(q0 + qsub + 16 * rt + fr) * ldq + hl * 64 + kk * 32 + fq * 8);
    f32x4 O[RT][DV / 16], Ol[RT];
    float mrun[RT];
#pragma unroll
    for (int rt = 0; rt < RT; ++rt) {
        mrun[rt] = m_init * LOG2E; Ol[rt] = (f32x4){(fq == 0) ? l_init : 0.f, 0.f, 0.f, 0.f};
#pragma unroll
        for (int et = 0; et < DV / 16; ++et) O[rt][et] = (f32x4){0.f, 0.f, 0.f, 0.f};
    }
    const unsigned onesw = (fr == 0) ? 0x3f803f80u : 0u;
    const bf16x8 onesf = __builtin_bit_cast(bf16x8, (u32x4){onesw, onesw, onesw, onesw});
    char* const lds = (char*)shm;
    constexpr int KN = KBLK, VN = DV / 64;
    u32x4 kreg[KN], vreg[VN];
#define ATT2_LOAD(k0_) do { \
        _Pragma("unroll") for (int i_ = 0; i_ < KN; ++i_) { const int c_ = tid + i_ * NT; const int key_ = c_ / (KBLK * 8), col_ = (c_ % (KBLK * 8)) * 8; \
            kreg[i_] = *(const u32x4*)(Kp + (size_t)((k0_) + key_) * ldk + col_); } \
        _Pragma("unroll") for (int i_ = 0; i_ < VN; ++i_) { const int c_ = tid + i_ * NT; const int e_ = c_ >> 3, kc_ = c_ & 7; \
            vreg[i_] = *(const u32x4*)(Vt + (size_t)e_ * ldvt + (k0_) + kc_ * 8); } } while (0)
    ATT2_LOAD(kbeg);
    constexpr int VBYTES = DV * 160;
    bf16x8 Pf[RT][2];
#define ATT2_PV_C(voff_, c) do { \
            bf16x8 vf[DV / 16]; \
            _Pragma("unroll") for (int et = 0; et < DV / 16; ++et) vf[et] = *(const bf16x8*)(lds + (voff_) + (et * 16 + fr) * 160 + (c) * 64 + fq * 16); \
            _Pragma("unroll") for (int rt = 0; rt < RT; ++rt) Ol[rt] = __builtin_amdgcn_mfma_f32_16x16x32_bf16(onesf, Pf[rt][c], Ol[rt], 0, 0, 0); \
            _Pragma("unroll") for (int et = 0; et < DV / 16; ++et) \
                _Pragma("unroll") for (int rt = 0; rt < RT; ++rt) O[rt][et] = __builtin_amdgcn_mfma_f32_16x16x32_bf16(vf[et], Pf[rt][c], O[rt][et], 0, 0, 0); \
        } while (0)
    int vcur = ATT_VOFF;
    for (int k0 = kbeg; k0 < kend; k0 += 64) {
        __syncthreads();
#pragma unroll
        for (int i = 0; i < KN; ++i) { const int c = tid + i * NT; const int key = c / (KBLK * 8), col = (c % (KBLK * 8)) * 8;
            *(u32x4*)(lds + (col >> 6) * 8192 + lds_byte(key, col & 63)) = kreg[i]; }
#pragma unroll
        for (int i = 0; i < VN; ++i) { const int c = tid + i * NT; const int e = c >> 3, kc = c & 7;
            char* vd = lds + vcur + e * 160 + (kc >> 2) * 64 + (kc & 1) * 32 + ((kc >> 1) & 1) * 8;
            *(u32x2*)vd = (u32x2){vreg[i].x, vreg[i].y}; *(u32x2*)(vd + 16) = (u32x2){vreg[i].z, vreg[i].w}; }
        __syncthreads();
        if (k0 + 64 < kend) ATT2_LOAD(k0 + 64);
        const int vprev = vcur ^ ATT_VOFF ^ (ATT_VOFF + VBYTES);
        f32x4 s[RT][4]; float off[RT], dqv[RT]; bool genv[RT];
#pragma unroll
        for (int rt = 0; rt < RT; ++rt) {
            const int qw0 = q0 + qsub + 16 * rt;
            const float dq = (float)(qw0 + fr - k0); dqv[rt] = dq;
            const bool gen = (MODE == 1) && !((k0 + 63 <= qw0 && qw0 + 15 - k0 <= 128) || (k0 >= qw0 + 15 && k0 + 63 - qw0 <= 128));
            const bool pos = (MODE == 2) || (k0 + 63 <= qw0);
            genv[rt] = gen;
            if (MODE == 2) {
#pragma unroll
                for (int t = 0; t < 4; ++t) s[rt][t] = (f32x4){0.f, 0.f, 0.f, 0.f};
                off[rt] = 0.f;
            } else if (gen) {
#pragma unroll
                for (int t = 0; t < 4; ++t)
#pragma unroll
                    for (int r = 0; r < 4; ++r) s[rt][t][r] = -kappa * fabsf(dq - (float)(16 * t + 4 * fq + r));
                off[rt] = 0.f;
            } else {
                const float sk = pos ? kappa : -kappa; float cb = sk * (float)(4 * fq);
                asm volatile("" : "+v"(cb));
#pragma unroll
                for (int t = 0; t < 4; ++t)
#pragma unroll
                    for (int r = 0; r < 4; ++r) s[rt][t][r] = sk * (float)(16 * t + r) + cb;
                off[rt] = pos ? -slope2 * dq : slope2 * dq;
            }
        }
#pragma unroll
        for (int t = 0; t < 4; ++t) {
            bf16x8 kf[DQK / 32];
#pragma unroll
            for (int kk = 0; kk < DQK / 32; ++kk) {
                const int blk = (MODE == 2) ? (kk >> 1) : 0, kcol = (MODE == 2) ? (kk & 1) * 32 : kk * 32;
                kf[kk] = *(const bf16x8*)(lds + blk * 8192 + lds_byte(t * 16 + fr, kcol + fq * 8));
            }
#pragma unroll
            for (int rt = 0; rt < RT; ++rt)
#pragma unroll
                for (int kk = 0; kk < DQK / 32; ++kk) s[rt][t] = __builtin_amdgcn_mfma_f32_16x16x32_bf16(kf[kk], Qf[rt][kk], s[rt][t], 0, 0, 0);
        }
        float mx[RT], mx1[RT];
#pragma unroll
        for (int rt = 0; rt < RT; ++rt) {
            if (MODE == 1 && genv[rt]) {
#pragma unroll
                for (int t = 0; t < 4; ++t)
#pragma unroll
                    for (int r = 0; r < 4; ++r) s[rt][t][r] = (fabsf(dqv[rt] - (float)(16 * t + 4 * fq + r)) > 128.0f) ? -1e30f : s[rt][t][r];
            }
            float v = fmaxf(fmaxf(s[rt][0][0], s[rt][0][1]), fmaxf(s[rt][0][2], s[rt][0][3]));
#pragma unroll
            for (int t = 1; t < 4; ++t) v = fmaxf(v, fmaxf(fmaxf(s[rt][t][0], s[rt][t][1]), fmaxf(s[rt][t][2], s[rt][t][3])));
            mx[rt] = v; mx1[rt] = shx(v, 16, lane);
        }
        __builtin_amdgcn_sched_barrier(0);
        if (k0 > kbeg) ATT2_PV_C(vprev, 0);
        __builtin_amdgcn_sched_barrier(0);
#pragma unroll
        for (int rt = 0; rt < RT; ++rt) { mx[rt] = fmaxf(mx[rt], mx1[rt]); mx1[rt] = shx(mx[rt], 32, lane); }
        __builtin_amdgcn_sched_barrier(0);
        if (k0 > kbeg) ATT2_PV_C(vprev, 1);
        __builtin_amdgcn_sched_barrier(0);
#pragma unroll
        for (int rt = 0; rt < RT; ++rt) {
            const float mxx = fmaxf(mx[rt], mx1[rt]);
            const float mtile = fmaxf(mxx * scale2 + off[rt], -1e30f);
            const float mnew = fmaxf(mrun[rt], mtile), alpha = __builtin_amdgcn_exp2f(mrun[rt] - mnew);
            mrun[rt] = mnew;
            const float sub = off[rt] - mnew;
#pragma unroll
            for (int t = 0; t < 4; ++t)
#pragma unroll
                for (int r = 0; r < 4; ++r) s[rt][t][r] = __builtin_amdgcn_exp2f(s[rt][t][r] * scale2 + sub);
            if (__builtin_amdgcn_ballot_w64(alpha != 1.0f) != 0ull) {
                Ol[rt] *= alpha;
#pragma unroll
                for (int et = 0; et < DV / 16; ++et) O[rt][et] *= alpha;
            }
#pragma unroll
            for (int c = 0; c < 2; ++c) {
                u32x4 pk; pk.x = cvt_pk_bf16(s[rt][2 * c][0], s[rt][2 * c][1]); pk.y = cvt_pk_bf16(s[rt][2 * c][2], s[rt][2 * c][3]);
                pk.z = cvt_pk_bf16(s[rt][2 * c + 1][0], s[rt][2 * c + 1][1]); pk.w = cvt_pk_bf16(s[rt][2 * c + 1][2], s[rt][2 * c + 1][3]);
                Pf[rt][c] = __builtin_bit_cast(bf16x8, pk);
            }
        }
        vcur = vprev;
    }
    { const int vlast = vcur ^ ATT_VOFF ^ (ATT_VOFF + VBYTES); ATT2_PV_C(vlast, 0); ATT2_PV_C(vlast, 1); }
    const int tid2 = hidden_tid(wv), w2 = tid2 >> 6, fr2 = tid2 & 15;
    const int hl2 = (MODE == 1) ? (w2 >> 1) : 0, qsub2 = (MODE == 1) ? (w2 & 1) * 32 : w2 * 32;
#pragma unroll
    for (int rt = 0; rt < RT; ++rt) {
        const float linv = 1.0f / shl(Ol[rt][0], fr);
        bf16_t* orow = Op + (size_t)(q0 + qsub2 + 16 * rt + fr2) * ldo + hl2 * 64;
#pragma unroll
        for (int et = 0; et < DV / 16; ++et) st_bf16x4(orow + et * 16 + fq * 4, O[rt][et] * linv);
    }
#undef ATT2_LOAD
#undef ATT2_PV_C
}

constexpr int HZ_RS = 4896;
constexpr int HZ_PAD = 192;
constexpr int H_CPS = 8256;
constexpr int H_ZOFF = 0, H_CPOFF = 8 * HZ_RS, H_RAWOFF = H_CPOFF + 8 * H_CPS;

template <bool ALT>
__device__ __forceinline__ void hyena_unit(const Params& p, const int lj  , const int c, const int wv) {
    const int tid = hidden_tid(wv), w = tid >> 6, lane = tid & 63, fr = lane & 15, fq = lane >> 4;
    char* const lds = (char*)shm;
    const bf16_t* hyT = (const bf16_t*)(p.ws + WS_PROJ + PR_HYT);
    const float* cw = p.in[4] + (size_t)lj * 3 * 1536; const float* cb = p.in[5] + (size_t)lj * 1536;
    const int nb = fr >> 1, tbp = fr & 1;
    __syncthreads();
    for (int i = tid; i < 8 * 2 * (HZ_PAD / 8); i += NT) {
        const int b = i / (2 * (HZ_PAD / 8)), r = i % (2 * (HZ_PAD / 8)), side = r / (HZ_PAD / 8), k = r % (HZ_PAD / 8);
        unsigned zz0 = 0u; asm volatile("" : "+v"(zz0));
        *(u32x4*)(lds + H_ZOFF + b * HZ_RS + (side ? (HZ_PAD + 2048) * 2 : 0) + k * 16) = (u32x4){zz0, zz0, zz0, zz0};
        if (i < 2) *(u32x4*)(lds + H_RAWOFF + 8192 + i * 16) = (u32x4){zz0, zz0, zz0, zz0};
    }
    {
        const float w0 = cw[c], w1 = cw[1536 + c], w2 = cw[2 * 1536 + c], bb = cb[c];
        const bf16_t* src = hyT + (size_t)c * NTOK;
        u32x4 v[4]; unsigned short um[4], up[4];
#pragma unroll
        for (int k = 0; k < 4; ++k) {
            const int i = tid + k * NT, b = i >> 8, s0 = (i & 255) * 8;
            const bf16_t* q = src + b * S + s0;
            v[k] = *(const u32x4*)q; um[k] = q[s0 > 0 ? -1 : 0]; up[k] = q[s0 + 8 < S ? 8 : 7];
        }
#pragma unroll
        for (int k = 0; k < 4; ++k) {
            const int i = tid + k * NT, b = i >> 8, s0 = (i & 255) * 8;
            float u[10];
            u[0] = (s0 > 0) ? bf2f(um[k]) : 0.f; u[9] = (s0 + 8 < S) ? bf2f(up[k]) : 0.f;
            u[1] = bflo(v[k].x); u[2] = bfhi(v[k].x); u[3] = bflo(v[k].y); u[4] = bfhi(v[k].y); u[5] = bflo(v[k].z); u[6] = bfhi(v[k].z); u[7] = bflo(v[k].w); u[8] = bfhi(v[k].w);
            float o[8];
#pragma unroll
            for (int j = 0; j < 8; ++j) o[j] = w0 * u[j] + w1 * u[j + 1] + w2 * u[j + 2] + bb;
            u32x4 ov; ov.x = cvt_pk_bf16(o[0], o[1]); ov.y = cvt_pk_bf16(o[2], o[3]); ov.z = cvt_pk_bf16(o[4], o[5]); ov.w = cvt_pk_bf16(o[6], o[7]);
            *(u32x4*)(lds + H_ZOFF + b * HZ_RS + (HZ_PAD + s0) * 2) = ov;
        }
    }
#pragma unroll 1
    for (int order = 0; order < 2; ++order) {
        const int gch = 512 * (order + 1) + c;
        const bf16_t* gsrc = hyT + (size_t)gch * NTOK;
        u32x2 gv[2][4]; unsigned short gm[2][4], gp[2][4];
        u32x4 rawv;
        {
            const bf16_t* f = (const bf16_t*)(p.ws + WS_FILT) + ((size_t)(lj * 2 + order) * 512 + c) * 4096;
            rawv = *(const u32x4*)(f + tid * 8);
#pragma unroll
            for (int ci = 0; ci < 2; ++ci)
#pragma unroll
                for (int mt = 0; mt < 4; ++mt) {
                    const int t = 64 * (4 * w + 2 * ci + tbp) + 16 * mt + 4 * fq;
                    const bf16_t* gq = gsrc + nb * S + t;
                    gv[ci][mt] = *(const u32x2*)gq; gm[ci][mt] = gq[t > 0 ? -1 : 0]; gp[ci][mt] = gq[t + 4 < S ? 4 : 3];
                }
        }
        *(u32x4*)(lds + H_RAWOFF + tid * 16) = rawv;
        __syncthreads();
        {
            const bf16_t* raw = (const bf16_t*)(lds + H_RAWOFF);
            const int o = w;
#pragma unroll
            for (int k = 0; k < 8; ++k) {
                const int a = lane + 64 * k;
                unsigned short e[8];
#pragma unroll
                for (int j = 0; j < 8; ++j) e[j] = raw[8 * a + o + j];
                u32x4 ov; ov.x = e[0] | ((unsigned)e[1] << 16); ov.y = e[2] | ((unsigned)e[3] << 16); ov.z = e[4] | ((unsigned)e[5] << 16); ov.w = e[6] | ((unsigned)e[7] << 16);
                *(u32x4*)(lds + H_CPOFF + o * H_CPS + a * 16) = ov;
            }
        }
        __syncthreads();
        f32x4 acc[2][4];
#pragma unroll
        for (int ci = 0; ci < 2; ++ci)
#pragma unroll
            for (int mt = 0; mt < 4; ++mt) acc[ci][mt] = (f32x4){0.f, 0.f, 0.f, 0.f};
        {
            const int acp = H_CPOFF + (7 - (fr & 7)) * H_CPS + (255 - (fr >> 3) + fq) * 16;
            const int zb = H_ZOFF + nb * HZ_RS + (HZ_PAD + 8 * fq) * 2;
            for (int dl = 4 * w - 31; dl <= ((ALT && DUPSEL >= 5) ? 4 * w - 31 : 4 * w + 3); ++dl) {
#pragma unroll
                for (int kh = 0; kh < 2; ++kh) {
                    bf16x8 Bf[2];
#pragma unroll
                    for (int ci = 0; ci < 2; ++ci) {
                        const int sblk = 4 * w + 2 * ci + tbp - dl;
                        Bf[ci] = *(const bf16x8*)(lds + zb + (64 * sblk + 32 * kh) * 2);
                    }
#pragma unroll
                    for (int mt = 0; mt < 4; ++mt) {
                        const int q = 4 * dl + mt - 2 * kh;
                        const bf16x8 Af = *(const bf16x8*)(lds + acp - 32 * q);
#pragma unroll
                        for (int ci = 0; ci < 2; ++ci) acc[ci][mt] = __builtin_amdgcn_mfma_f32_16x16x32_bf16(Af, Bf[ci], acc[ci][mt], 0, 0, 0);
                    }
                }
            }
        }
        const float hb = p.in[12][(size_t)(lj * 2 + order) * 512 + c];
        const float w0 = cw[gch], w1 = cw[1536 + gch], w2 = cw[2 * 1536 + gch], bb = cb[gch];
        u32x2 zout[2][4];
#pragma unroll
        for (int ci = 0; ci < 2; ++ci)
#pragma unroll
            for (int mt = 0; mt < 4; ++mt) {
                const int t = 64 * (4 * w + 2 * ci + tbp) + 16 * mt + 4 * fq;
                const u32x2 zz = *(const u32x2*)(lds + H_ZOFF + nb * HZ_RS + (HZ_PAD + t) * 2);
                float u[6];
                u[0] = (t > 0) ? bf2f(gm[ci][mt]) : 0.f; u[5] = (t + 4 < S) ? bf2f(gp[ci][mt]) : 0.f;
                u[1] = bflo(gv[ci][mt].x); u[2] = bfhi(gv[ci][mt].x); u[3] = bflo(gv[ci][mt].y); u[4] = bfhi(gv[ci][mt].y);
                const float z[4] = {bflo(zz.x), bfhi(zz.x), bflo(zz.y), bfhi(zz.y)};
                float o[4];
#pragma unroll
                for (int r = 0; r < 4; ++r) {
                    const float gate = w0 * u[r] + w1 * u[r + 1] + w2 * u[r + 2] + bb;
                    o[r] = gate * (acc[ci][mt][r] + hb * z[r]);
                }
                zout[ci][mt].x = cvt_pk_bf16(o[0], o[1]); zout[ci][mt].y = cvt_pk_bf16(o[2], o[3]);
            }
        __syncthreads();
        if (order == 0) {
#pragma unroll
            for (int ci = 0; ci < 2; ++ci)
#pragma unroll
                for (int mt = 0; mt < 4; ++mt) {
                    const int t = 64 * (4 * w + 2 * ci + tbp) + 16 * mt + 4 * fq;
                    *(u32x2*)(lds + H_ZOFF + nb * HZ_RS + (HZ_PAD + t) * 2) = zout[ci][mt];
                }
        } else {
            bf16_t* yt = (bf16_t*)(p.ws + WS_QX) + (size_t)c * NTOK;
#pragma unroll
            for (int ci = 0; ci < 2; ++ci)
#pragma unroll
                for (int mt = 0; mt < 4; ++mt) {
                    const int t = 64 * (4 * w + 2 * ci + tbp) + 16 * mt + 4 * fq;
                    *(u32x2*)(yt + nb * S + t) = zout[ci][mt];
                }
        }
        __syncthreads();
    }
}

struct Row16 { f32x4 v[4]; };
__device__ __forceinline__ void ld_row(Row16& r, const float* src, int lane) {
#pragma unroll
    for (int i = 0; i < 4; ++i) r.v[i] = *(const f32x4*)(src + 256 * i + 4 * lane);
}
__device__ __forceinline__ void ld_row_bf(Row16& r, const bf16_t* src, int lane) {
#pragma unroll
    for (int i = 0; i < 4; ++i) { const u32x2 v = *(const u32x2*)(src + 256 * i + 4 * lane); r.v[i] = (f32x4){bflo(v.x), bfhi(v.x), bflo(v.y), bfhi(v.y)}; }
}
__device__ __forceinline__ float row_rstd(const Row16& r, int lane) {
    float ss = 0.f;
#pragma unroll
    for (int i = 0; i < 4; ++i) ss += r.v[i][0] * r.v[i][0] + r.v[i][1] * r.v[i][1] + r.v[i][2] * r.v[i][2] + r.v[i][3] * r.v[i][3];
    ss = wave_sum(ss, lane);
    return rsqrtf(ss * (1.0f / 1024.0f) + EPS);
}
template <int KIND  , bool ALT = false>
__device__ __forceinline__ void norm_phase(const Params& p, const int layer, const float* __restrict__ gain, const int bid, const int nb, const int wv) {
    const int tid_ = hidden_tid(wv), lane = tid_ & 63, w = tid_ >> 6;
    bf16_t* XB = (bf16_t*)(p.ws + WS_XB);
    bf16_t* XBo = ALT ? (bf16_t*)(p.ws + WS_PROJ) : XB;
    float* RS1 = (float*)(p.ws + (ALT ? WS_QX : WS_RS1));
    const bf16_t* Y = (const bf16_t*)(p.ws + WS_Y);
    const float* WT = (const float*)(p.ws + WS_WT);
    Row16 g;
    if (KIND == 2) ld_row(g, gain, lane);
    for (int tok = bid * 8 + w; tok < NTOK; tok += nb * 8) {
        Row16 x;
        if (KIND == 0 && layer == 0) ld_row(x, p.in[0] + (size_t)tok * D, lane); else ld_row_bf(x, XB + (size_t)tok * D, lane);
        if ((KIND == 0 && layer > 0) || KIND == 2) {
            const float w0 = WT[2 * tok], w1 = WT[2 * tok + 1];
            const bf16_t* y0 = Y + (size_t)(2 * tok) * D; const bf16_t* y1 = y0 + D;
#pragma unroll
            for (int i = 0; i < 4; ++i) {
                const u32x2 a = *(const u32x2*)(y0 + 256 * i + 4 * lane), b = *(const u32x2*)(y1 + 256 * i + 4 * lane);
                x.v[i][0] += w0 * bflo(a.x) + w1 * bflo(b.x); x.v[i][1] += w0 * bfhi(a.x) + w1 * bfhi(b.x);
                x.v[i][2] += w0 * bflo(a.y) + w1 * bflo(b.y); x.v[i][3] += w0 * bfhi(a.y) + w1 * bfhi(b.y);
            }
        }
        if (KIND == 2) {
            const float rstd = row_rstd(x, lane);
#pragma unroll
            for (int i = 0; i < 4; ++i) *(f32x4*)(p.out + (size_t)tok * D + 256 * i + 4 * lane) = x.v[i] * rstd * g.v[i];
        } else {
#pragma unroll
            for (int i = 0; i < 4; ++i) {
                const unsigned a0 = cvt_pk_bf16(x.v[i][0], x.v[i][1]), a1 = cvt_pk_bf16(x.v[i][2], x.v[i][3]);
                *(u32x2*)(XBo + (size_t)tok * D + 256 * i + 4 * lane) = (u32x2){a0, a1};
                x.v[i] = (f32x4){bflo(a0), bfhi(a0), bflo(a1), bfhi(a1)};
            }
            const float rstd = row_rstd(x, lane);
            if (lane == 0) RS1[tok] = rstd;
        }
    }
}

template <bool ALT>
__device__ __forceinline__ void route_tail(const Params& p, const int layer, const int chunk, f32x4 (&acc)[4][3], float (&ssq)[4], const int wv) {
    const int tid = hidden_tid(wv), lane = tid & 63, w = tid >> 6, fr = lane & 15, fq = lane >> 4;
    float* part = (float*)shm;
    float* ssql = part + 8 * 64 * 49;
    float* lgl = ssql + 8 * 64;
    int* cntl = (int*)((char*)shm + LDS_ROUTE);
    int* basel = cntl + 32;
    int* sel = basel + 32;
    int* posl = sel + 128;
    float* rsl = (float*)(posl + 128);
    float* WT = (float*)(p.ws + (ALT ? WS_ACT + (size_t)4 * 1024 * 1024 : WS_WT));
    float* RSTD = (float*)(p.ws + (ALT ? WS_ACT + (size_t)5 * 1024 * 1024 : WS_RSTD));
    int* LIST = (int*)(p.ws + (ALT ? WS_ACT : WS_LIST));
    float* RP = (float*)(p.ws + (ALT ? WS_ACT + (size_t)2 * 1024 * 1024 : WS_RP));
    int* CNT = (int*)(p.ws + WS_CNT) + (layer + (ALT ? 4 : 0)) * NEXP * CNT_STRIDE;
    const float* bg = p.in[26] + layer * 4; const float* be = p.in[28] + layer * NEXP;
    const char* const Xc = (const char*)(p.ws + WS_XB);
    const char* const Whc = (const char*)(p.ws + WS_WRT) + (size_t)layer * 2 * 48 * 1024 * 2; const char* const Wlc = Whc + 48 * 1024 * 2;
#pragma unroll
    for (int mt = 0; mt < 4; ++mt) {
        float sq = ssq[mt]; sq += shx(sq, 16, lane); sq += shx(sq, 32, lane);
        if (fq == 0) ssql[w * 64 + mt * 16 + fr] = sq;
#pragma unroll
        for (int nt = 0; nt < 3; ++nt)
#pragma unroll
            for (int r = 0; r < 4; ++r) part[(w * 64 + mt * 16 + fq * 4 + r) * 49 + nt * 16 + fr] = acc[mt][nt][r];
    }
    __syncthreads();
    {
        const int tl = tid & 63;
        for (int j = tid >> 6; j < 36; j += 8) {
            float s = 0.f;
#pragma unroll
            for (int ww = 0; ww < 8; ++ww) s += part[(ww * 64 + tl) * 49 + j];
            lgl[tl * 37 + j] = s;
        }
    }
    __syncthreads();
    if (tid < 64) {
        const int tl = tid, tk = chunk * 64 + tl;
        float sq = 0.f;
#pragma unroll
        for (int ww = 0; ww < 8; ++ww) sq += ssql[ww * 64 + tl];
        const float rstd = rsqrtf(sq * (1.0f / 1024.0f) + EPS);
        float lg[36];
#pragma unroll
        for (int j = 0; j < 36; ++j) lg[j] = lgl[tl * 37 + j] * rstd;
        float g0 = lg[0] + bg[0], g1 = lg[1] + bg[1], g2 = lg[2] + bg[2], g3 = lg[3] + bg[3];
        int gs = 0; float gm = g0;
        if (g1 > gm) { gm = g1; gs = 1; } if (g2 > gm) { gm = g2; gs = 2; } if (g3 > gm) { gm = g3; gs = 3; }
        const float gden = __expf(g0 - gm) + __expf(g1 - gm) + __expf(g2 - gm) + __expf(g3 - gm);
        const float ggate = 1.0f / gden;
        float ev[8];
#pragma unroll
        for (int j = 0; j < 8; ++j) {
            const float a0 = lg[4 + j] + be[j], a1 = lg[12 + j] + be[8 + j], a2 = lg[20 + j] + be[16 + j], a3 = lg[28 + j] + be[24 + j];
            ev[j] = gs == 0 ? a0 : gs == 1 ? a1 : gs == 2 ? a2 : a3;
        }
        int i0 = 0; float v0 = ev[0];
#pragma unroll
        for (int j = 1; j < 8; ++j) if (ev[j] > v0) { v0 = ev[j]; i0 = j; }
        int i1 = -1; float v1 = -3.0e38f;
#pragma unroll
        for (int j = 0; j < 8; ++j) if (j != i0 && ev[j] > v1) { v1 = ev[j]; i1 = j; }
        const float e1 = __expf(v1 - v0), sden = 1.0f / (1.0f + e1);
        const int ea = gs * 8 + i0, eb = gs * 8 + i1;
        sel[2 * tl] = ea; posl[2 * tl] = atomicAdd(&cntl[ea], 1);
        sel[2 * tl + 1] = eb; posl[2 * tl + 1] = atomicAdd(&cntl[eb], 1);
        WT[2 * tk] = ggate * sden; WT[2 * tk + 1] = ggate * e1 * sden;
        RSTD[tk] = rstd; rsl[tl] = rstd;
    }
    __syncthreads();
    if (tid < 32) { const int c = cntl[tid]; basel[tid] = (ALT && DUPSEL == 1) ? chunk * 4 : (c > 0 ? atomicAdd(&CNT[tid * CNT_STRIDE], c) : 0); }
    __syncthreads();
    if (tid < 128) { const int e = sel[tid]; const size_t li = (size_t)e * NTOK + basel[e] + posl[tid]; LIST[li] = 128 * chunk + tid; RP[li] = rsl[tid >> 1]; }
}

template <bool ALT>
__device__ __forceinline__ void route_phase(const Params& p, const int layer, const int bid, const int nb, const int wv) {
    const int tid = hidden_tid(wv), lane = tid & 63, w = tid >> 6, fr = lane & 15, fq = lane >> 4;
    float* part = (float*)shm;
    float* ssql = part + 8 * 64 * 49;
    float* lgl = ssql + 8 * 64;
    int* cntl = (int*)((char*)shm + LDS_ROUTE);
    int* basel = cntl + 32;
    int* sel = basel + 32;
    int* posl = sel + 128;
    float* rsl = (float*)(posl + 128);
    float* WT = (float*)(p.ws + (ALT ? WS_ACT + (size_t)4 * 1024 * 1024 : WS_WT));
    float* RSTD = (float*)(p.ws + (ALT ? WS_ACT + (size_t)5 * 1024 * 1024 : WS_RSTD));
    int* LIST = (int*)(p.ws + (ALT ? WS_ACT : WS_LIST));
    float* RP = (float*)(p.ws + (ALT ? WS_ACT + (size_t)2 * 1024 * 1024 : WS_RP));
    int* CNT = (int*)(p.ws + WS_CNT) + (layer + (ALT ? 4 : 0)) * NEXP * CNT_STRIDE;
    const float* bg = p.in[26] + layer * 4; const float* be = p.in[28] + layer * NEXP;
    const char* const Xc = (const char*)(p.ws + WS_XB);
    const char* const Whc = (const char*)(p.ws + WS_WRT) + (size_t)layer * 2 * 48 * 1024 * 2; const char* const Wlc = Whc + 48 * 1024 * 2;
    for (int chunk = bid; chunk < NTOK / 64; chunk += nb) {
        __syncthreads();
        if (tid < 32) cntl[tid] = 0;
        const unsigned xoff = (unsigned)(((chunk * 64 + fr) * D + w * 128 + fq * 8) * 2), woff = (unsigned)((fr * 1024 + w * 128 + fq * 8) * 2);
        f32x4 acc[4][3];
#pragma unroll
        for (int mt = 0; mt < 4; ++mt)
#pragma unroll
            for (int nt = 0; nt < 3; ++nt) acc[mt][nt] = (f32x4){0.f, 0.f, 0.f, 0.f};
        float ssq[4] = {0.f, 0.f, 0.f, 0.f};
        u32x4 xa[4][4]; bf16x8 Bh[2][3], Bl[2][3];
#pragma unroll
        for (int st = 0; st < 4; ++st)
#pragma unroll
            for (int mt = 0; mt < 4; ++mt) xa[st][mt] = *(const u32x4*)(Xc + (xoff + (unsigned)(mt * 16 * D * 2 + st * 64)));
#pragma unroll
        for (int nt = 0; nt < 3; ++nt) { Bh[0][nt] = *(const bf16x8*)(Whc + (woff + (unsigned)(nt * 16 * 2048))); Bl[0][nt] = *(const bf16x8*)(Wlc + (woff + (unsigned)(nt * 16 * 2048))); }
#pragma unroll
        for (int st = 0; st < 4; ++st) {
            if (st < 3) {
#pragma unroll
                for (int nt = 0; nt < 3; ++nt) { Bh[(st + 1) & 1][nt] = *(const bf16x8*)(Whc + (woff + (unsigned)(nt * 16 * 2048 + (st + 1) * 64))); Bl[(st + 1) & 1][nt] = *(const bf16x8*)(Wlc + (woff + (unsigned)(nt * 16 * 2048 + (st + 1) * 64))); }
            }
#pragma unroll
            for (int mt = 0; mt < 4; ++mt) {
                const u32x4 xb = xa[st][mt];
                const f32x4 x0 = {bflo(xb.x), bfhi(xb.x), bflo(xb.y), bfhi(xb.y)}, x1 = {bflo(xb.z), bfhi(xb.z), bflo(xb.w), bfhi(xb.w)};
                ssq[mt] += x0[0] * x0[0] + x0[1] * x0[1] + x0[2] * x0[2] + x0[3] * x0[3] + x1[0] * x1[0] + x1[1] * x1[1] + x1[2] * x1[2] + x1[3] * x1[3];
                const bf16x8 Ah = __builtin_bit_cast(bf16x8, xb);
#pragma unroll
                for (int nt = 0; nt < 3; ++nt) {
                    acc[mt][nt] = __builtin_amdgcn_mfma_f32_16x16x32_bf16(Ah, Bh[st & 1][nt], acc[mt][nt], 0, 0, 0);
                    acc[mt][nt] = __builtin_amdgcn_mfma_f32_16x16x32_bf16(Ah, Bl[st & 1][nt], acc[mt][nt], 0, 0, 0);
                }
            }
            __builtin_amdgcn_sched_barrier(0);
        }
        route_tail<ALT>(p, layer, chunk, acc, ssq, wv);
    }
}

constexpr int GOR_PITCH = 1040;
template <bool ALT>
__device__ __forceinline__ void gor_phase(const Params& p, const int layer, const int bid, const int nb, const int wv) {
    const int tid = hidden_tid(wv), lane = tid & 63, w = tid >> 6, fr = lane & 15, fq = lane >> 4;
    char* const lds = (char*)shm;
    int* cntl = (int*)((char*)shm + LDS_ROUTE);
    const bf16_t* OXp = (const bf16_t*)(p.ws + WS_OX);
    bf16_t* XB = (bf16_t*)(p.ws + WS_XB);
    const char* const Wo = (const char*)(p.ws + WS_W_CO) + (size_t)layer * 1024 * 512 * 2;
    const char* const Whc = (const char*)(p.ws + WS_WRT) + (size_t)layer * 2 * 48 * 1024 * 2; const char* const Wlc = Whc + 48 * 1024 * 2;
    for (int chunk = bid; chunk < NTOK / 64; chunk += nb) {
        const int r0 = chunk * 64;
        __syncthreads();
        if (tid < 32) cntl[tid] = 0;
        {
            u32x4 v[8];
#pragma unroll
            for (int i = 0; i < 8; ++i) { const int pc = tid + i * NT; v[i] = *(const u32x4*)(OXp + (size_t)(r0 + (pc >> 6)) * 512 + (pc & 63) * 8); }
#pragma unroll
            for (int i = 0; i < 8; ++i) { const int pc = tid + i * NT; *(u32x4*)(lds + (pc >> 6) * GOR_PITCH + (pc & 63) * 16) = v[i]; }
        }
        __syncthreads();
        f32x4 accr[4][3];
#pragma unroll
        for (int mt = 0; mt < 4; ++mt)
#pragma unroll
            for (int nt = 0; nt < 3; ++nt) accr[mt][nt] = (f32x4){0.f, 0.f, 0.f, 0.f};
        float ssq[4] = {0.f, 0.f, 0.f, 0.f};
        const int aoffl = fr * GOR_PITCH + fq * 16;
#pragma unroll 1
        for (int half = 0; half < 2; ++half) {
            const int cb = w * 128 + half * 64;
            const unsigned boff = (unsigned)((cb >> 4) * 16 * 1024 + lane * 16);
            const unsigned woff = (unsigned)((fr * 1024 + cb + fq * 8) * 2);
            f32x4 acc[4][4];
#pragma unroll
            for (int i = 0; i < 4; ++i)
#pragma unroll
                for (int j = 0; j < 4; ++j) acc[i][j] = (f32x4){0.f, 0.f, 0.f, 0.f};
            bf16x8 Bq[3][4];
#define GOR_LDB(s_) do { _Pragma("unroll") for (int j = 0; j < 4; ++j) Bq[(s_) % 3][j] = *(const bf16x8*)(Wo + (boff + (unsigned)(j * 16 * 1024 + (s_) * 1024))); } while (0)
            GOR_LDB(0); GOR_LDB(1);
            u32x2 xres[4][4];
            bf16x8 Wh[2][3], Wl[2][3];
#pragma unroll
            for (int s = 0; s < 16; ++s) {
                if (s + 2 < 16) GOR_LDB(s + 2);
                if (s == 15) {
#pragma unroll
                    for (int i = 0; i < 4; ++i)
#pragma unroll
                        for (int j = 0; j < 4; ++j) xres[i][j] = *(const u32x2*)(XB + (size_t)(r0 + 16 * i + fr) * D + cb + 16 * j + 4 * fq);
                }
                bf16x8 Af[4];
#pragma unroll
                for (int i = 0; i < 4; ++i) Af[i] = *(const bf16x8*)(lds + aoffl + i * 16 * GOR_PITCH + s * 64);
#pragma unroll
                for (int j = 0; j < 4; ++j)
#pragma unroll
                    for (int i = 0; i < 4; ++i) acc[i][j] = __builtin_amdgcn_mfma_f32_16x16x32_bf16(Bq[s % 3][j], Af[i], acc[i][j], 0, 0, 0);
                __builtin_amdgcn_sched_barrier(0);
            }
#undef GOR_LDB
#pragma unroll
            for (int pp = 0; pp < 2; ++pp)
#pragma unroll
                for (int nt = 0; nt < 3; ++nt) { Wh[pp][nt] = *(const bf16x8*)(Whc + (woff + (unsigned)(nt * 16 * 2048 + pp * 64))); Wl[pp][nt] = *(const bf16x8*)(Wlc + (woff + (unsigned)(nt * 16 * 2048 + pp * 64))); }
#pragma unroll
            for (int i = 0; i < 4; ++i) {
                bf16_t* qb = XB + (size_t)(r0 + 16 * i + fr) * D + cb + 4 * fq;
                unsigned pk[4][2];
#pragma unroll
                for (int j = 0; j < 4; ++j) {
                    const u32x2 x = xres[i][j];
                    const f32x4 t = (f32x4){bflo(x.x), bfhi(x.x), bflo(x.y), bfhi(x.y)} + acc[i][j];
                    const unsigned a0 = cvt_pk_bf16(t[0], t[1]), a1 = cvt_pk_bf16(t[2], t[3]);
                    *(u32x2*)(qb + 16 * j) = (u32x2){a0, a1};
                    const float r0f = bflo(a0), r1f = bfhi(a0), r2f = bflo(a1), r3f = bfhi(a1);
                    ssq[i] += (r0f * r0f + r1f * r1f) + (r2f * r2f + r3f * r3f);
                    pk[j][0] = a0; pk[j][1] = a1;
                }
#pragma unroll
                for (int pp = 0; pp < 2; ++pp) {
                    const bf16x8 Ah = __builtin_bit_cast(bf16x8, (u32x4){pk[2 * pp][0], pk[2 * pp][1], pk[2 * pp + 1][0], pk[2 * pp + 1][1]});
#pragma unroll
                    for (int nt = 0; nt < 3; ++nt) {
                        accr[i][nt] = __builtin_amdgcn_mfma_f32_16x16x32_bf16(Ah, Wh[pp][nt], accr[i][nt], 0, 0, 0);
                        accr[i][nt] = __builtin_amdgcn_mfma_f32_16x16x32_bf16(Ah, Wl[pp][nt], accr[i][nt], 0, 0, 0);
                    }
                }
            }
        }
        __syncthreads();
        route_tail<ALT>(p, layer, chunk, accr, ssq, wv);
    }
}

template <int MODE>
__device__ __forceinline__ void cvt_job(const float* __restrict__ src, bf16_t* __restrict__ dst, const int K, const int N, const int nmat,
                                        const size_t dst_mat_stride, const int bid, const int nb, const int wv, const float* __restrict__ kgain = nullptr, const int gshift = 0) {
    float* T = (float*)shm;
    const int tid = hidden_tid(wv);
    const int tk = K / 128, tn = N / 128, per = tk * tn, total = per * nmat;
    f32x4 v[8];
#define CVT_LOAD(t_) do { const int mat_ = (t_) / per, r_ = (t_) % per, k0_ = (r_ / tn) * 128, n0_ = (r_ % tn) * 128; \
        const float* s_ = src + (size_t)mat_ * K * N + (size_t)k0_ * N + n0_; \
        _Pragma("unroll") for (int i = 0; i < 8; ++i) v[i] = *(const f32x4*)(s_ + (size_t)((tid >> 5) + 16 * i) * N + (tid & 31) * 4); } while (0)
    if (bid < total) CVT_LOAD(bid);
    for (int t = bid; t < total; t += nb) {
        const int mat = t / per, r = t % per, k0 = (r / tn) * 128, n0 = (r % tn) * 128;
        bf16_t* d = dst + (size_t)mat * dst_mat_stride;
        if (kgain) {
#pragma unroll
            for (int i = 0; i < 8; ++i) v[i] *= kgain[(size_t)(mat >> gshift) * D + k0 + (tid >> 5) + 16 * i];
        }
        __syncthreads();
#pragma unroll
        for (int i = 0; i < 8; ++i) {
            float* q = T + ((tid >> 5) + 16 * i) * 129 + (tid & 31) * 4;
            q[0] = v[i][0]; q[1] = v[i][1]; q[2] = v[i][2]; q[3] = v[i][3];
        }
        __syncthreads();
        if (t + nb < total) CVT_LOAD(t + nb);
#pragma unroll
        for (int j = 0; j < 4; ++j) {
            const int n = (tid >> 4) + 32 * j, kc = (tid & 15) * 8;
            float e[8];
#pragma unroll
            for (int jj = 0; jj < 8; ++jj) e[jj] = T[(kc + jj) * 129 + n];
            u32x4 ov; ov.x = cvt_pk_bf16(e[0], e[1]); ov.y = cvt_pk_bf16(e[2], e[3]); ov.z = cvt_pk_bf16(e[4], e[5]); ov.w = cvt_pk_bf16(e[6], e[7]);
            const int ng = n0 + n;
            if (MODE == 3) {
                const int kk = k0 + kc;
                *(u32x4*)(d + ((size_t)((ng >> 4) * (K >> 5) + (kk >> 5)) * 64 + ((kk >> 3) & 3) * 16 + (ng & 15)) * 8) = ov;
            } else {
            const int row = (MODE == 0) ? ng : ((ng >> 4) * 32 + (ng & 15) + (MODE == 2 ? 16 : 0));
            *(u32x4*)(d + (size_t)row * K + k0 + kc) = ov;
            }
        }
    }
#undef CVT_LOAD
}

__device__ __forceinline__ void prologue0(const Params& p, const int bid, const int nb, const int wv) {
    unsigned char* ws = p.ws;
    cvt_job<0>(p.in[3], (bf16_t*)(ws + WS_W_EIN), 1024, 3072, 2, (size_t)3072 * 1024, bid, nb, wv, p.in[2]);
    cvt_job<0>(p.in[15], (bf16_t*)(ws + WS_W_EOUT), 1024, 1024, 2, (size_t)1024 * 1024, bid, nb, wv);
    cvt_job<0>(p.in[17], (bf16_t*)(ws + WS_W_OIN), 1024, 1536, 2, (size_t)1536 * 1024, bid, nb, wv, p.in[16]);
    cvt_job<0>(p.in[19], (bf16_t*)(ws + WS_W_OOUT), 1024, 1024, 2, (size_t)1024 * 1024, bid, nb, wv);
    cvt_job<0>(p.in[21], (bf16_t*)(ws + WS_W_CQ), 1024, 512, 4, (size_t)512 * 1024, bid, nb, wv, p.in[20]);
    cvt_job<0>(p.in[22], (bf16_t*)(ws + WS_W_CKV), 1024, 1024, 4, (size_t)1024 * 1024, bid, nb, wv);
    cvt_job<3>(p.in[23], (bf16_t*)(ws + WS_W_CO), 512, 1024, 4, (size_t)1024 * 512, bid, nb, wv);
    cvt_job<1>(p.in[29], (bf16_t*)(ws + WS_W_GU), 1024, 512, 128, (size_t)1024 * 1024, bid, nb, wv, p.in[24], 5);
    cvt_job<2>(p.in[30], (bf16_t*)(ws + WS_W_GU), 1024, 512, 128, (size_t)1024 * 1024, bid, nb, wv, p.in[24], 5);
    cvt_job<0>(p.in[31], (bf16_t*)(ws + WS_W_DN), 512, 1024, 128, (size_t)1024 * 512, bid, nb, wv);
    const int tid = hidden_tid(wv), lane = tid & 63, w = tid >> 6;
    {
        Row16 g; ld_row(g, p.in[32], lane);
        bf16_t* MN = (bf16_t*)(ws + WS_MEMN);
        for (int r = bid * 8 + w; r < Bb * MEM; r += nb * 8) {
            Row16 x; ld_row(x, p.in[1] + (size_t)r * D, lane);
            const float rstd = row_rstd(x, lane);
#pragma unroll
            for (int i = 0; i < 4; ++i) st_bf16x4(MN + (size_t)r * D + 256 * i + 4 * lane, x.v[i] * rstd * g.v[i]);
        }
    }
    {
        float* A2 = (float*)(ws + WS_A2);
        for (int r = bid * 8 + w; r < 2 * S; r += nb * 8) {
            const int lj = r / S, pos = r % S;
            const float* w1 = p.in[6] + (size_t)lj * 33 * 64; const float* b1 = p.in[7] + lj * 64;
            const float* w2 = p.in[8] + (size_t)lj * 64 * 64; const float* b2 = p.in[9] + lj * 64;
            const float fr_ = p.in[11][lj * 64 + lane];
            float a = ((float)pos / 2047.0f) * w1[lane];
#pragma unroll 1
            for (int k = 0; k < 16; ++k) {
                const float band = 1e-4f + (float)k * ((15.0f - 1e-4f) / 15.0f);
                const float ang = band * (6.283185307179586f * (float)pos / 2048.0f);
                a += cosf(ang) * w1[(1 + k) * 64 + lane] - sinf(ang) * w1[(17 + k) * 64 + lane];
            }
            const float a1 = sinf(fr_ * (a + b1[lane]));
            float a2 = 0.f;
#pragma unroll 1
            for (int i = 0; i < 64; ++i) a2 += shl(a1, i) * w2[i * 64 + lane];
            A2[(size_t)r * 64 + lane] = sinf(fr_ * (a2 + b2[lane]));
        }
    }
    {
        bf16_t* WR = (bf16_t*)(ws + WS_WRT);
        for (int i = bid * NT + tid; i < 4 * 48 * 1024; i += nb * NT) {
            const int l = i / (48 * 1024), r = i % (48 * 1024), j = r >> 10, kp = r & 1023;
            const int k = (kp & ~31) + (((kp & 7) < 4) ? 4 * ((kp >> 3) & 3) + (kp & 7) : 16 + 4 * ((kp >> 3) & 3) + (kp & 7) - 4);
            float v = 0.f;
            if (j < 4) v = p.in[25][((size_t)l * D + k) * 4 + j]; else if (j < 36) v = p.in[27][((size_t)l * D + k) * NEXP + (j - 4)];
            v *= p.in[24][(size_t)l * D + k];
            const unsigned h = cvt_pk_bf16(v, 0.f) & 0xffffu;
            const unsigned lo = cvt_pk_bf16(v - bflo(h), 0.f) & 0xffffu;
            WR[(size_t)l * 2 * 48 * 1024 + r] = (bf16_t)h; WR[(size_t)l * 2 * 48 * 1024 + 48 * 1024 + r] = (bf16_t)lo;
        }
    }
    if (bid == 0) {
        if (tid < 2) {
            const float* lm = p.in[13] + (size_t)tid * 4 * 64;
            float s01 = 0.f, s23 = 0.f;
            for (int i = 0; i < 64; ++i) { s01 += lm[i] * lm[64 + i]; s23 += lm[128 + i] * lm[192 + i]; }
            const float lam_init = 0.8f - 0.6f * expf(-0.3f * (float)(2 * tid));
            ((float*)(ws + WS_MISC))[tid] = expf(s01) - expf(s23) + lam_init;
            ((float*)(ws + WS_MISC))[2 + tid] = 1.0f - lam_init;
        }
        bf16_t* hz = (bf16_t*)(ws + WS_XB) + (size_t)NTOK * D; bf16_t* az = (bf16_t*)(ws + WS_ACT) + (size_t)2 * NTOK * EH;
        for (int i = tid; i < D; i += NT) hz[i] = 0;
        for (int i = tid; i < EH; i += NT) az[i] = 0;
    }
}

__device__ __forceinline__ void filter_taps(const Params& p, const int bid, const int nb, const int wv) {
    const int tid = hidden_tid(wv), w = tid >> 6, lane = tid & 63, fr = lane & 15, fq = lane >> 4;
    const float* A2 = (const float*)(p.ws + WS_A2);
    bf16_t* FL = (bf16_t*)(p.ws + WS_FILT);
    const float mind = logf(1e-2f) / 1.5f, maxd = logf(1e-2f) / 0.3f;
    for (int job = bid; job < 2 * 4 * 8 * 32; job += nb) {
        const int pt = job & 31, ct = (job >> 5) & 7, od = (job >> 8) & 3, lj = job >> 10;
        const int pos0 = pt * 64 + (w >> 2) * 32, ch0 = ct * 64 + (w & 3) * 16, order = od >> 1, dir = od & 1;
        const float* w3 = p.in[10] + (size_t)lj * 64 * 2048 + od * 512 + ch0 + fr;
        bf16x8 Af[2], Bf[2][2];
#pragma unroll
        for (int ks = 0; ks < 2; ++ks) {
            float e[8];
#pragma unroll
            for (int jj = 0; jj < 8; ++jj) e[jj] = w3[(size_t)(ks * 32 + fq * 8 + jj) * 2048];
            u32x4 pk; pk.x = cvt_pk_bf16(e[0], e[1]); pk.y = cvt_pk_bf16(e[2], e[3]); pk.z = cvt_pk_bf16(e[4], e[5]); pk.w = cvt_pk_bf16(e[6], e[7]);
            Af[ks] = __builtin_bit_cast(bf16x8, pk);
#pragma unroll
            for (int nt = 0; nt < 2; ++nt) {
                const float* ap = A2 + ((size_t)lj * S + pos0 + nt * 16 + fr) * 64 + ks * 32 + fq * 8;
                const f32x4 v0 = *(const f32x4*)ap, v1 = *(const f32x4*)(ap + 4);
                u32x4 pb; pb.x = cvt_pk_bf16(v0[0], v0[1]); pb.y = cvt_pk_bf16(v0[2], v0[3]); pb.z = cvt_pk_bf16(v1[0], v1[1]); pb.w = cvt_pk_bf16(v1[2], v1[3]);
                Bf[nt][ks] = __builtin_bit_cast(bf16x8, pb);
            }
        }
#pragma unroll
        for (int nt = 0; nt < 2; ++nt) {
            f32x4 acc = {0.f, 0.f, 0.f, 0.f};
            acc = __builtin_amdgcn_mfma_f32_16x16x32_bf16(Af[0], Bf[nt][0], acc, 0, 0, 0);
            acc = __builtin_amdgcn_mfma_f32_16x16x32_bf16(Af[1], Bf[nt][1], acc, 0, 0, 0);
            const int pos = pos0 + nt * 16 + fr;
            const float tpos = (float)pos / 2047.0f;
#pragma unroll
            for (int r = 0; r < 4; ++r) {
                const int ch = ch0 + fq * 4 + r;
                const float delta = mind + (float)ch * ((maxd - mind) / 511.0f);
                const float v = acc[r] * __builtin_amdgcn_exp2f(-tpos * fabsf(delta) * 1.4426950408889634f);
                bf16_t* f = FL + ((size_t)(lj * 2 + order) * 512 + ch) * 4096;
                const unsigned short hv = (unsigned short)(cvt_pk_bf16(v, 0.f) & 0xffff);
                if (dir == 0) f[2047 - pos] = hv;
                else { if (pos >= 1) f[2047 + pos] = hv; if (pos == 2047) f[4095] = 0; }
            }
        }
    }
}

enum { PH_P0 = 0, PH_P1, PH_N1, PH_GIN, PH_MIX, PH_GOUT, PH_N2, PH_GQ, PH_XATT, PH_GO, PH_ROUTE, PH_G1, PH_G2, PH_FINAL, PH_TR, PH_GOR, PH_COUNT };

template <class Epi>
__device__ __forceinline__ void gemm_dense(const bf16_t* A, const bf16_t* Bt, const int K, const int nM, const int nN, Epi epi, const int bid, const int nb, const int wv, const int ntl = 0) {
    for (int u = bid; u < nM * nN; u += nb) {
        const int pm = u / nN, pn = u % nN;
        epi.brow = pm * 256;
        gemm_tile(A + (size_t)pm * 256 * K, Bt, K, pn * 256, RowIdent{}, epi, wv, ntl);
    }
}

typedef const __attribute__((address_space(4))) Params* ParamsK;
#define PHASE_FN __forceinline__
template <int PH, bool ALT = false>
__device__ PHASE_FN void run_phase(ParamsK pk_, const int layer, const int bid_, const int nb_, const int wv_) {
    ParamsK pk = pk_; asm volatile("" : "+s"(pk));
    int bid = bid_, nb = nb_, wv = wv_; asm volatile("" : "+s"(bid), "+s"(nb), "+s"(wv));
    const Params& p = *(const Params*)pk;
    unsigned char* ws = p.ws;
    const int lj = layer >> 1; const bool even = (layer & 1) == 0;
    bf16_t* H = (bf16_t*)(ws + WS_H);
    float* X = (float*)(ws + WS_X);
    bf16_t* YMIX = (bf16_t*)(ws + WS_YMIX);
    bf16_t* QX = (bf16_t*)(ws + WS_QX);
    bf16_t* OX = (bf16_t*)(ws + WS_OX);
    if constexpr (PH == PH_P0) { prologue0(p, bid, nb, wv); }
    if constexpr (PH == PH_N1) {
        norm_phase<0, ALT>(p, layer, nullptr, bid, nb, wv);
        if (layer == 0 && !ALT) filter_taps(p, bid, nb, wv);
    }
    if constexpr (PH == PH_GIN) {
        const bf16_t* XBc = (const bf16_t*)(ws + WS_XB); const float* RS1 = (const float*)(ws + WS_RS1);
        if (ALT && DUPSEL >= 1) {
            int fl = bid; asm volatile("" : "+s"(fl));
            EpiNull e{(float*)(ws + WS_X), fl == 0x7fffffff, 0};
            gemm_dense(XBc, (const bf16_t*)(ws + (even ? WS_W_EIN : WS_W_OIN)) + (size_t)lj * (even ? 3072 : 1536) * 1024, 1024, 64, even ? 12 : 6, e, bid, nb, wv, DUPSEL == 2 ? 8 : 0);
        } else if (even) {
            EpiSplit e{(bf16_t*)(ws + WS_PROJ + PR_HYT), (bf16_t*)(ws + WS_PROJ + PR_QK), (bf16_t*)(ws + WS_PROJ + PR_VT), 1536, 2560, 1024, (size_t)NTOK, 0, RS1};
            gemm_dense(XBc, (const bf16_t*)(ws + WS_W_EIN) + (size_t)lj * 3072 * 1024, 1024, 64, 12, e, bid, nb, wv);
        } else {
            EpiSplit e{nullptr, (bf16_t*)(ws + WS_PROJ), (bf16_t*)(ws + WS_PROJ + PR_OVT), 0, 1280, 1280, (size_t)NTOK, 0, RS1};
            gemm_dense(XBc, (const bf16_t*)(ws + WS_W_OIN) + (size_t)lj * 1536 * 1024, 1024, 64, 6, e, bid, nb, wv);
        }
    }
    if constexpr (PH == PH_MIX) {
        if (even) {
            const bf16_t* qk = (const bf16_t*)(ws + WS_PROJ + PR_QK);
            const bf16_t* vT = (const bf16_t*)(ws + WS_PROJ + PR_VT);
            const float lam = uni(((const float*)(ws + WS_MISC))[lj]);
            const float oscale = uni(((const float*)(ws + WS_MISC))[2 + lj]);
            for (int u = bid + ((ALT && (DUPSEL == 4 || DUPSEL >= 7)) ? 512 : 0); u < ((ALT && (DUPSEL == 3 || DUPSEL == 5 || DUPSEL == 6)) ? 512 : 1024); u += nb) {
                if (u < 512) hyena_unit<ALT>(p, lj, u, wv);
                else {
                    const int id = u - 512, b = id >> 6, h = (id >> 4) & 3, qb = id & 15;
                    attn_unit<0, ALT>(qk + (size_t)(b * S) * 1024 + 2 * h * 64, 1024, qk + (size_t)(b * S) * 1024 + 512 + 2 * h * 64, 1024,
                                 vT + (size_t)(h * 128) * NTOK + b * S, (size_t)NTOK, qb * 128, 0, S,
                                 0.125f, uni(exp2f(-2.0f * (float)(h + 1))), -1e30f, 0.f,
                                 (ALT ? (bf16_t*)(ws + WS_Y) : YMIX) + (size_t)(b * S) * D + 512 + h * 128, D, lam, oscale, p.in[14] + (size_t)lj * 128, wv);
                }
            }
        } else {
            const bf16_t* qk = (const bf16_t*)(ws + WS_PROJ);
            const bf16_t* vT = (const bf16_t*)(ws + WS_PROJ + PR_OVT);
            for (int u = bid; u < 1024; u += nb) {
                const int b = u >> 7, kv = (u >> 5) & 3, qb = u & 31, q0 = qb * 64;
                const int kbeg = q0 - 128 < 0 ? 0 : q0 - 128, kend = q0 + 192 > S ? S : q0 + 192;
                attn2_unit<1>(qk + (size_t)(b * S) * 1280 + kv * 256, 1280, qk + (size_t)(b * S) * 1280 + 1024 + kv * 64, 1280,
                              vT + (size_t)(kv * 64) * NTOK + b * S, (size_t)NTOK, q0, kbeg, kend,
                              0.125f, p.in[18] + lj * 16 + kv * 4, kv * 4, YMIX + (size_t)(b * S) * D + kv * 256, D, wv);
            }
        }
    }
    if constexpr (PH == PH_TR) {
        const int tid = hidden_tid(wv);
        const bf16_t* yt = (const bf16_t*)(ws + WS_QX);
        bf16_t* T = shm;
        for (int t = bid; t < 8 * 256; t += nb) {
            const int c0 = (t & 7) * 64, tk0 = (t >> 3) * 64;
            const u32x4 v = *(const u32x4*)(yt + (size_t)(c0 + (tid >> 3)) * NTOK + tk0 + (tid & 7) * 8);
            __syncthreads();
            *(u32x4*)((char*)T + (tid >> 3) * 144 + (tid & 7) * 16) = v;
            __syncthreads();
            const int tok = tid >> 3, cg = (tid & 7) * 8;
            unsigned short e[8];
#pragma unroll
            for (int j = 0; j < 8; ++j) e[j] = T[(cg + j) * 72 + tok];
            u32x4 ov; ov.x = e[0] | ((unsigned)e[1] << 16); ov.y = e[2] | ((unsigned)e[3] << 16); ov.z = e[4] | ((unsigned)e[5] << 16); ov.w = e[6] | ((unsigned)e[7] << 16);
            *(u32x4*)(YMIX + (size_t)(tk0 + tok) * D + c0 + cg) = ov;
        }
    }
    if constexpr (PH == PH_GOUT) {
        EpiRes e{(bf16_t*)(ws + (ALT ? WS_Y : WS_XB)), 0, (float*)(ws + WS_SSP), hidden_tid(wv) & 63};
        gemm_dense(YMIX, (const bf16_t*)(ws + (even ? WS_W_EOUT : WS_W_OOUT)) + (size_t)lj * 1024 * 1024, 1024, 64, 4, e, bid, nb, wv);
    }
    if constexpr (PH == PH_GQ) {
        for (int u = bid; u < 128 + 32; u += nb) {
            if (u < 128) {
                const int pm = u >> 1, pn = u & 1;
                EpiTokRstd e{QX, 512, pm * 256, (const float*)(ws + WS_SSP), hidden_tid(wv) & 63};
                gemm_tile((const bf16_t*)(ws + WS_XB) + (size_t)pm * 256 * 1024, (const bf16_t*)(ws + WS_W_CQ) + (size_t)layer * 512 * 1024, 1024, pn * 256, RowIdent{}, e, wv);
            } else {
                const int v = u - 128, pm = v >> 2, pn = v & 3;
                EpiSplit e{nullptr, (bf16_t*)(ws + WS_XK) + (size_t)layer * 2048 * 512, (bf16_t*)(ws + WS_XVT) + (size_t)layer * 512 * 2048, 0, 512, 512, (size_t)2048, pm * 256, nullptr};
                gemm_tile((const bf16_t*)(ws + WS_MEMN) + (size_t)pm * 256 * 1024, (const bf16_t*)(ws + WS_W_CKV) + (size_t)layer * 1024 * 1024, 1024, pn * 256, RowIdent{}, e, wv);
            }
        }
    }
    if constexpr (PH == PH_XATT) {
        const bf16_t* xk = (const bf16_t*)(ws + WS_XK) + (size_t)layer * 2048 * 512;
        const bf16_t* xvt = (const bf16_t*)(ws + WS_XVT) + (size_t)layer * 512 * 2048;
        for (int u = bid; u < 256; u += nb) {
            const int b = u >> 5, h = (u >> 3) & 3, qb = u & 7;
            attn2_unit<2>(QX + (size_t)(b * S) * 512 + h * 128, 512, xk + (size_t)(b * MEM) * 512 + h * 128, 512,
                          xvt + (size_t)(h * 128) * 2048 + b * MEM, (size_t)2048, qb * 256, 0, MEM,
                          0.08838834764831845f, nullptr, 0, OX + (size_t)(b * S) * 512 + h * 128, 512, wv);
        }
    }
    if constexpr (PH == PH_GO) {
        EpiRes e{(bf16_t*)(ws + (ALT ? WS_Y : WS_XB)), 0, nullptr, hidden_tid(wv) & 63};
        gemm_dense(OX, (const bf16_t*)(ws + WS_W_CO) + (size_t)layer * 1024 * 512, 512, 64, 4, e, bid, nb, wv);
    }
    if constexpr (PH == PH_ROUTE) { route_phase<ALT>(p, layer, bid, nb, wv); }
    if constexpr (PH == PH_GOR) { gor_phase<ALT>(p, layer, bid, nb, wv); }
    if constexpr (PH == PH_G1) {
        const int* CNT = (const int*)(ws + WS_CNT) + layer * NEXP * CNT_STRIDE;
        const int* LIST = (const int*)(ws + WS_LIST);
        unsigned* head = (unsigned*)(ws + WS_QHEAD) + layer * 64;
        unsigned* done = (unsigned*)(ws + WS_DONE) + layer * 32 * 64;
        int* uq = (int*)((char*)shm + LDS_ROUTE + 1024);
        int* pre = uq + 16;
        int* cn = pre + 40;
        const int tid = hidden_tid(wv);
        __syncthreads();
        if (tid < 64) {
            const int lane = tid;
            const int c = lane < 32 ? CNT[lane * CNT_STRIDE] : 0;
            int incl = ((c + 255) >> 8) * 4;
#pragma unroll
            for (int d = 1; d < 32; d <<= 1) { const int v = __builtin_amdgcn_ds_bpermute(((lane - d) & 63) << 2, incl); if (lane >= d) incl += v; }
            if (lane < 32) { pre[lane + 1] = incl; cn[lane] = c; }
            if (lane == 0) pre[0] = 0;
        }
        typedef __attribute__((address_space(1))) unsigned gu32_t;
        unsigned nxt_v = 0u;
        if (tid == 0) nxt_v = __hip_atomic_fetch_add((gu32_t*)head, 1u, __ATOMIC_RELAXED, __HIP_MEMORY_SCOPE_AGENT);
        __syncthreads();
        const int total = __builtin_amdgcn_readfirstlane(pre[32]);
        for (;;) {
            if (tid == 0) *uq = (int)nxt_v;
            __syncthreads();
            const int uall = __builtin_amdgcn_readfirstlane(*uq);
            if (uall >= 2 * total) break;
            if (tid == 0) nxt_v = __hip_atomic_fetch_add((gu32_t*)head, 1u, __ATOMIC_RELAXED, __HIP_MEMORY_SCOPE_AGENT);
            const bool second = uall >= total;
            const int u = second ? uall - total : uall;
            int e, base, tl, cnt;
            {
                const int l5 = hidden_tid(wv) & 31;
                const int lo = pre[l5], hi = pre[l5 + 1];
                const unsigned long long bal = __builtin_amdgcn_ballot_w64(u >= lo && u < hi);
                e = __builtin_amdgcn_readfirstlane((int)__builtin_ctzll(bal));
                base = __builtin_amdgcn_readfirstlane(pre[e]); cnt = __builtin_amdgcn_readfirstlane(cn[e]); tl = (cnt + 255) >> 8;
            }
            const int r = u - base, pn = r / tl, pm = r % tl;
            const int* list = LIST + (size_t)e * NTOK;
            if (!second) {
                EpiGateUp ep{(bf16_t*)(ws + WS_ACT), list, cnt, pm * 256, (const float*)(ws + WS_RP) + (size_t)e * NTOK};
                gemm_tile((const bf16_t*)(ws + WS_XB), (const bf16_t*)(ws + WS_W_GU) + ((size_t)layer * NEXP + e) * 1024 * 1024, 1024, pn * 256, RowTok{list, cnt, pm * 256}, ep, wv);
                asm volatile("s_waitcnt vmcnt(0)" ::: "memory");
                if ((hidden_tid(wv) & 63) == 0) (void)__hip_atomic_fetch_add(done + e * 64 + pm, 1u, __ATOMIC_RELAXED, __HIP_MEMORY_SCOPE_AGENT);
            } else {
                if (tid < 64) {
                    unsigned spins = 0;
                    while ((unsigned)__builtin_amdgcn_readfirstlane(__hip_atomic_load(done + e * 64 + pm, __ATOMIC_RELAXED, __HIP_MEMORY_SCOPE_AGENT)) < 32u) {
                        __builtin_amdgcn_s_sleep(2);
                        if (++spins > (1u << 24)) break;
                    }
                    __builtin_amdgcn_fence(__ATOMIC_ACQUIRE, "agent");
                    asm volatile("s_waitcnt vmcnt(0)" ::: "memory");
                }
                __syncthreads();
                EpiDown ep{(bf16_t*)(ws + WS_Y), list, cnt, pm * 256};
                gemm_tile((const bf16_t*)(ws + WS_ACT), (const bf16_t*)(ws + WS_W_DN) + ((size_t)layer * NEXP + e) * 1024 * 512, 512, pn * 256, RowAsg{list, cnt, pm * 256}, ep, wv);
            }
        }
    }
    if constexpr (PH == PH_FINAL) { norm_phase<2>(p, DEPTH, p.in[33], bid, nb, wv); }
}

#if ONE_LAUNCH
__global__ void __launch_bounds__(NT, 2) k_mega(Params p_) {
    ParamsK p = (ParamsK)__builtin_amdgcn_kernarg_segment_ptr();
    volatile LAS unsigned* st = (volatile LAS unsigned*)((char*)shm + LDS_XB);
    if (threadIdx.x < 4) st[threadIdx.x] = 0u;
    __syncthreads();
    const XcdBarrier bar = xcd_barrier_post((unsigned*)(p->ws + WS_BAR), st);
    const int bid = blockIdx.x, nb = gridDim.x, wv = __builtin_amdgcn_readfirstlane(threadIdx.x >> 6);
    run_phase<PH_P0>(p, 0, bid, nb, wv); xcd_barrier(bar); if (DUP == PH_P0) { run_phase<PH_P0, true>(p, 0, bid, nb, wv); xcd_barrier(bar); }
#pragma unroll 1
    for (int layer = 0; layer < DEPTH; ++layer) {
        run_phase<PH_N1>(p, layer, bid, nb, wv); xcd_barrier(bar); if (DUP == PH_N1) { run_phase<PH_N1, true>(p, layer, bid, nb, wv); xcd_barrier(bar); }
        run_phase<PH_GIN>(p, layer, bid, nb, wv); xcd_barrier(bar); if (DUP == PH_GIN) { run_phase<PH_GIN, true>(p, layer, bid, nb, wv); xcd_barrier(bar); }
        run_phase<PH_MIX>(p, layer, bid, nb, wv); xcd_barrier(bar); if (DUP == PH_MIX && (DUPSEL == 0 || (DUPSEL != 2 && (layer & 1) == 0) || (DUPSEL == 2 && (layer & 1) == 1))) { run_phase<PH_MIX, true>(p, layer, bid, nb, wv); xcd_barrier(bar); }
        if ((layer & 1) == 0) { run_phase<PH_TR>(p, layer, bid, nb, wv); xcd_barrier(bar); }
        run_phase<PH_GOUT>(p, layer, bid, nb, wv); xcd_barrier(bar); if (DUP == PH_GOUT) { run_phase<PH_GOUT, true>(p, layer, bid, nb, wv); xcd_barrier(bar); }
        run_phase<PH_GQ>(p, layer, bid, nb, wv); xcd_barrier(bar); if (DUP == PH_GQ) { run_phase<PH_GQ, true>(p, layer, bid, nb, wv); xcd_barrier(bar); }
        run_phase<PH_XATT>(p, layer, bid, nb, wv); xcd_barrier(bar); if (DUP == PH_XATT) { run_phase<PH_XATT, true>(p, layer, bid, nb, wv); xcd_barrier(bar); }
        run_phase<PH_GOR>(p, layer, bid, nb, wv); xcd_barrier(bar);
        run_phase<PH_G1>(p, layer, bid, nb, wv); xcd_barrier(bar); if (DUP == PH_G1) { run_phase<PH_G1, true>(p, layer, bid, nb, wv); xcd_barrier(bar); }
    }
    run_phase<PH_FINAL>(p, DEPTH, bid, nb, wv);
}
#else
template <int PH>
__global__ void __launch_bounds__(NT, 2) k_phase(Params p_, int layer) {
    run_phase<PH>((ParamsK)__builtin_amdgcn_kernarg_segment_ptr(), layer, blockIdx.x, gridDim.x, __builtin_amdgcn_readfirstlane(threadIdx.x >> 6));
}
template <int PH> static void launch_phase(const Params& p, int layer, int grid, hipStream_t stream) {
    static bool init = false;
    if (!init) { (void)hipFuncSetAttribute((const void*)k_phase<PH>, hipFuncAttributeMaxDynamicSharedMemorySize, LDS_BYTES); init = true; }
    hipLaunchKernelGGL(k_phase<PH>, dim3(grid), dim3(NT), LDS_BYTES, stream, p, layer);
}
#endif

extern "C" void kernel_launch(void* const* d_in, const int* in_sizes, int n_in, void* d_out, int out_size, void* d_ws, size_t ws_size, hipStream_t stream) {
    if (n_in != 34 || ws_size < WS_END) { fprintf(stderr, "kernel_launch: unexpected n_in %d or ws_size %zu (need %zu)\n", n_in, ws_size, (size_t)WS_END); return; }
    Params p{};
    for (int i = 0; i < 34; ++i) p.in[i] = (const float*)d_in[i];
    p.out = (float*)d_out; p.ws = (unsigned char*)d_ws;
    (void)hipMemsetAsync(d_ws, 0, WS_ZERO_BYTES, stream);
#if ONE_LAUNCH
    static int grid = 0;
    if (grid == 0) {
        int dev = 0, cus = 0, per_cu = 0;
        (void)hipGetDevice(&dev); (void)hipDeviceGetAttribute(&cus, hipDeviceAttributeMultiprocessorCount, dev);
        (void)hipFuncSetAttribute((const void*)k_mega, hipFuncAttributeMaxDynamicSharedMemorySize, LDS_BYTES);
        (void)hipOccupancyMaxActiveBlocksPerMultiprocessor(&per_cu, (const void*)k_mega, NT, LDS_BYTES);
        (void)hipGetLastError();
        grid = cus > 0 ? cus : 256;
    }
    hipLaunchKernelGGL(k_mega, dim3(grid), dim3(NT), LDS_BYTES, stream, p);
#else
    const int grid = 256;
    launch_phase<PH_P0>(p, 0, grid, stream);
    for (int layer = 0; layer < DEPTH; ++layer) {
        launch_phase<PH_N1>(p, layer, grid, stream);
        launch_phase<PH_GIN>(p, layer, grid, stream);
        launch_phase<PH_MIX>(p, layer, grid, stream);
        if ((layer & 1) == 0) launch_phase<PH_TR>(p, layer, grid, stream);
        launch_phase<PH_GOUT>(p, layer, grid, stream);
        launch_phase<PH_GQ>(p, layer, grid, stream);
        launch_phase<PH_XATT>(p, layer, grid, stream);
        launch_phase<PH_GOR>(p, layer, grid, stream);
        launch_phase<PH_G1>(p, layer, grid, stream);
    }
    launch_phase<PH_FINAL>(p, DEPTH, grid, stream);
#endif
}
```

```cpp
#include <hip/hip_runtime.h>
#include <stdint.h>
#include <stdio.h>

#ifndef RD_N
#define RD_N 1
#endif
#ifndef RD_E
#define RD_E 1
#endif
#ifndef RD_R
#define RD_R 1
#endif
#ifndef DUP
#define DUP -1
#endif
#ifndef DUPSEL
#define DUPSEL 0
#endif
#ifndef ONE_LAUNCH
#define ONE_LAUNCH 1
#endif

typedef unsigned short bf16_t;
typedef short bf16x8 __attribute__((ext_vector_type(8)));
typedef float f32x4 __attribute__((ext_vector_type(4)));
typedef unsigned u32x4 __attribute__((ext_vector_type(4)));
typedef unsigned u32x2 __attribute__((ext_vector_type(2)));

constexpr int Bb = 8, S = 2048, D = 1024, NTOK = Bb * S, DEPTH = 4, MEM = 256;
constexpr int NEXP = 32, EH = 512;
constexpr int NT = 512;
constexpr float EPS = 1e-6f;

constexpr size_t al256(size_t x) { return (x + 255) & ~(size_t)255; }
constexpr size_t WS_BAR   = 0;
constexpr size_t WS_CNT   = 16384;
constexpr int    CNT_STRIDE = 64;
constexpr size_t WS_QHEAD = 16384 + 65536;
constexpr size_t WS_DONE  = WS_QHEAD + 4096;
constexpr size_t WS_ZERO_BYTES = WS_DONE + (size_t)4 * 32 * 64 * 4;
constexpr size_t WS_MISC  = WS_ZERO_BYTES;
constexpr size_t WS_W_EIN = 131072;
constexpr size_t WS_W_EOUT = WS_W_EIN + (size_t)2 * 3072 * 1024 * 2;
constexpr size_t WS_W_OIN = WS_W_EOUT + (size_t)2 * 1024 * 1024 * 2;
constexpr size_t WS_W_OOUT = WS_W_OIN + (size_t)2 * 1536 * 1024 * 2;
constexpr size_t WS_W_CQ  = WS_W_OOUT + (size_t)2 * 1024 * 1024 * 2;
constexpr size_t WS_W_CKV = WS_W_CQ + (size_t)4 * 512 * 1024 * 2;
constexpr size_t WS_W_CO  = WS_W_CKV + (size_t)4 * 1024 * 1024 * 2;
constexpr size_t WS_W_GU  = WS_W_CO + (size_t)4 * 1024 * 512 * 2;
constexpr size_t WS_W_DN  = WS_W_GU + (size_t)4 * 32 * 1024 * 1024 * 2;
constexpr size_t WS_MEMN  = WS_W_DN + (size_t)4 * 32 * 1024 * 512 * 2;
constexpr size_t WS_XK    = WS_MEMN + (size_t)2048 * 1024 * 2;
constexpr size_t WS_XVT   = WS_XK + (size_t)4 * 2048 * 512 * 2;
constexpr size_t WS_A2    = WS_XVT + (size_t)4 * 2048 * 512 * 2;
constexpr size_t WS_FILT  = WS_A2 + (size_t)2 * 2048 * 64 * 4;
constexpr size_t WS_X     = WS_FILT + (size_t)2 * 2 * 512 * 4096 * 2;
constexpr size_t WS_H     = WS_X + (size_t)NTOK * D * 4;
constexpr size_t WS_PROJ  = WS_H + al256((size_t)(NTOK + 1) * D * 2);
constexpr size_t WS_YMIX  = WS_PROJ + (size_t)NTOK * 3072 * 2;
constexpr size_t WS_QX    = WS_YMIX + (size_t)NTOK * D * 2;
constexpr size_t WS_OX    = WS_QX + (size_t)NTOK * 512 * 2;
constexpr size_t WS_ACT   = WS_OX + (size_t)NTOK * 512 * 2;
constexpr size_t WS_Y     = WS_ACT + al256((size_t)(2 * NTOK + 1) * EH * 2);
constexpr size_t WS_LIST  = WS_Y + (size_t)2 * NTOK * D * 2;
constexpr size_t WS_WT    = WS_LIST + (size_t)NEXP * NTOK * 4;
constexpr size_t WS_RSTD  = WS_WT + (size_t)2 * NTOK * 4;
constexpr size_t WS_WRT   = WS_RSTD + (size_t)NTOK * 4;
constexpr size_t WS_XB    = WS_WRT + (size_t)4 * 2 * 48 * 1024 * 2;
constexpr size_t WS_SSP   = WS_XB + al256((size_t)(NTOK + 1) * D * 2);
constexpr size_t WS_RS1   = WS_SSP + (size_t)NTOK * 16 * 4;
constexpr size_t WS_RP    = WS_RS1 + (size_t)NTOK * 4;
constexpr size_t WS_END   = WS_RP + (size_t)NEXP * NTOK * 4;
constexpr size_t PR_HYT   = 0;
constexpr size_t PR_QK    = (size_t)1536 * NTOK * 2;
constexpr size_t PR_VT    = PR_QK + (size_t)NTOK * 1024 * 2;
constexpr size_t PR_OVT   = (size_t)NTOK * 1280 * 2;

constexpr int LDS_XB = 147456;
constexpr int LDS_ROUTE = LDS_XB + 64;
constexpr int LDS_BYTES = LDS_ROUTE + 2048;

struct Params {
    const float* in[34];
    float* out;
    unsigned char* ws;
};

extern __shared__ __attribute__((aligned(16))) bf16_t shm[];

typedef float f32x2 __attribute__((ext_vector_type(2)));
typedef __bf16 bf16x2v __attribute__((ext_vector_type(2)));
__device__ __forceinline__ unsigned cvt_pk_bf16(float lo, float hi) { const f32x2 v = {lo, hi}; return __builtin_bit_cast(unsigned, __builtin_convertvector(v, bf16x2v)); }
__device__ __forceinline__ float bf2f(unsigned short b) { return __uint_as_float((unsigned)b << 16); }
__device__ __forceinline__ float bflo(unsigned w) { return __uint_as_float(w << 16); }
__device__ __forceinline__ float bfhi(unsigned w) { return __uint_as_float(w & 0xffff0000u); }
__device__ __forceinline__ float shx(float v, int m, int lane) { return __int_as_float(__builtin_amdgcn_ds_bpermute((lane ^ m) << 2, __float_as_int(v))); }
__device__ __forceinline__ float shl(float v, int src) { return __int_as_float(__builtin_amdgcn_ds_bpermute(src << 2, __float_as_int(v))); }
__device__ __forceinline__ float wave_sum(float v, int lane) {
    v += shx(v, 1, lane); v += shx(v, 2, lane); v += shx(v, 4, lane); v += shx(v, 8, lane); v += shx(v, 16, lane); v += shx(v, 32, lane); return v;
}

__device__ __forceinline__ float uni(float x) { return __builtin_bit_cast(float, __builtin_amdgcn_readfirstlane(__builtin_bit_cast(int, x))); }
__device__ __forceinline__ int hidden_tid(int wv) { int l; asm volatile("v_mbcnt_lo_u32_b32 %0, -1, 0\n\tv_mbcnt_hi_u32_b32 %0, -1, %0" : "=&v"(l)); return (wv << 6) | l; }

#define XB_TMO      128
#define XB_XCNT(j)  (256  + 64 * (j))
#define XB_XSUB(j)  (1280 + 64 * (j))
#define XB_XGEN(j)  (2304 + 64 * (j))
#define XB_TOP      3328
#define XB_TOPGEN   3392
#define XCD_BAR_WORDS 3456
#define XB_SPIN_CAP (1u << 22)
#define LAS __attribute__((address_space(3)))

__device__ __forceinline__ unsigned xb_ld(unsigned* p)              { return __hip_atomic_load(p, __ATOMIC_RELAXED, __HIP_MEMORY_SCOPE_AGENT); }
__device__ __forceinline__ unsigned xb_add(unsigned* p, unsigned v) { return __hip_atomic_fetch_add(p, v, __ATOMIC_RELAXED, __HIP_MEMORY_SCOPE_AGENT); }
__device__ __forceinline__ unsigned xb_xcc_id() { return (unsigned)__builtin_amdgcn_s_getreg((3 << 11) | 20) & 0xFu; }
#define XB_SPIN(cond, bar) do { unsigned _sp = 0; while (cond) { __builtin_amdgcn_s_sleep(1); \
    if ((++_sp & 255u) == 0u) { if (xb_ld(&(bar)[XB_TMO])) break; if (_sp > XB_SPIN_CAP) { atomicAdd(&(bar)[XB_TMO], 1u); break; } } } } while (0)

struct XcdBarrier { unsigned* bar; unsigned x; volatile LAS unsigned* st; };

__device__ __forceinline__ XcdBarrier xcd_barrier_post(unsigned* bar, volatile LAS unsigned* st) {
    XcdBarrier b; b.bar = bar; b.x = xb_xcc_id(); b.st = st;
    if (threadIdx.x == 0) (void)xb_add(&bar[XB_XCNT(b.x)], 1u);
    return b;
}
__device__ __forceinline__ void xcd_barrier_complete(unsigned* bar, unsigned x, unsigned& nloc, unsigned& nx) {
    const unsigned G = gridDim.x * gridDim.y * gridDim.z;
    unsigned sum, cnt, mine, sp = 0u;
    for (;;) {
        sum = 0u; cnt = 0u; mine = 0u;
#pragma unroll
        for (unsigned j = 0; j < 16; ++j) { const unsigned c = xb_ld(&bar[XB_XCNT(j)]); sum += c; cnt += (c > 0u) ? 1u : 0u; mine = (j == x) ? c : mine; }
        if (sum == G) break;
        __builtin_amdgcn_s_sleep(1);
        if ((++sp & 255u) == 0u) { if (xb_ld(&bar[XB_TMO])) break; if (sp > XB_SPIN_CAP) { atomicAdd(&bar[XB_TMO], 1u); break; } }
    }
    nloc = mine > 0u ? mine : 1u; nx = cnt > 0u ? cnt : 1u;
}
__device__ __forceinline__ void xcd_barrier(const XcdBarrier& b) {
    asm volatile("s_waitcnt vmcnt(0)" ::: "memory");
    __syncthreads();
    if (threadIdx.x == 0) {
        unsigned* bar = b.bar; unsigned bx = b.x;
        asm volatile("" : "+s"(bar), "+s"(bx));
        __builtin_amdgcn_s_waitcnt(0);
        unsigned nloc = b.st[0], nx = b.st[1];
        if (nloc == 0u) { xcd_barrier_complete(bar, bx, nloc, nx); b.st[0] = nloc; b.st[1] = nx; }
        const unsigned old = xb_add(&bar[XB_XSUB(bx)], 1u);
        const unsigned gen = old / nloc;
        if (old + 1u == (gen + 1u) * nloc) {
            __builtin_amdgcn_fence(__ATOMIC_RELEASE, "agent");
            asm volatile("s_waitcnt vmcnt(0)" ::: "memory");
            const unsigned og = xb_add(&bar[XB_TOP], 1u);
            const unsigned tg = og / nx;
            if (og + 1u == (tg + 1u) * nx) xb_add(&bar[XB_TOPGEN], 1u);
            else XB_SPIN(xb_ld(&bar[XB_TOPGEN]) == tg, bar);
            __builtin_amdgcn_fence(__ATOMIC_ACQUIRE, "agent");
            xb_add(&bar[XB_XGEN(bx)], 1u);
            asm volatile("s_waitcnt vmcnt(0)" ::: "memory");
        } else {
            XB_SPIN(xb_ld(&bar[XB_XGEN(bx)]) == gen, bar);
            __builtin_amdgcn_fence(__ATOMIC_ACQUIRE, "agent");
            asm volatile("s_waitcnt vmcnt(0)" ::: "memory");
        }
    }
    __syncthreads();
}

constexpr int HT = 128 * 64;
__device__ __forceinline__ int lds_byte(int r, int c) {
    int st = (r >> 4) * 2 + (c >> 5), rr = r & 15, cc = c & 31, ob = rr * 64 + cc * 2;
    return st * 1024 + (ob ^ (((ob >> 9) & 1) << 5));
}
__device__ __forceinline__ void stage_rc(int b, int& R, int& C) {
    int st = b / 1024, sb = b % 1024, swz = sb ^ (((sb >> 9) & 1) << 5);
    R = (st >> 1) * 16 + swz / 64; C = (st & 1) * 32 + (swz % 64) / 2;
}
#define SA(b, h) (shm + ((b) * 2 + (h)) * HT)
#define SB(b, h) (shm + (4 + (b) * 2 + (h)) * HT)
#define G_STAGE_A(P_, h, kt) do { _Pragma("unroll") for (int _i = 0; _i < 2; ++_i) \
    __builtin_amdgcn_global_load_lds((const unsigned*)((const char*)A + (size_t)((kt) * 128 + (RowSrc::DENSE ? (h) * 256 * K : 0)) + aoff[RowSrc::DENSE ? 0 : (h)][_i]), (unsigned*)((char*)(P_) + tid * 16 + _i * 8192), 16, 0, 0); } while (0)
#define G_STAGE_B(P_, h, kt) do { _Pragma("unroll") for (int _i = 0; _i < 2; ++_i) \
    __builtin_amdgcn_global_load_lds((const unsigned*)((const char*)Bt + (size_t)((kt) * 128 + (h) * 64 * K) + boff[_i]), (unsigned*)((char*)(P_) + tid * 16 + _i * 8192), 16, 0, 0); } while (0)
#define G_LDA(dst, b, h) _Pragma("unroll") for (int m = 0; m < 4; ++m) _Pragma("unroll") for (int k = 0; k < 2; ++k) \
    dst[m][k] = *reinterpret_cast<const bf16x8*>((char*)SA(b, h) + lds_byte(wr * 64 + m * 16 + fr, k * 32 + fq * 8))
#define G_LDB(dst, b, h) _Pragma("unroll") for (int n = 0; n < 2; ++n) _Pragma("unroll") for (int k = 0; k < 2; ++k) \
    dst[n][k] = *reinterpret_cast<const bf16x8*>((char*)SB(b, h) + lds_byte(wc * 32 + n * 16 + fr, k * 32 + fq * 8))
#define G_MMA(ai, bj, At_, Bt_) do { __builtin_amdgcn_s_setprio(1); \
    _Pragma("unroll") for (int m = 0; m < 4; ++m) _Pragma("unroll") for (int n = 0; n < 2; ++n) _Pragma("unroll") for (int k = 0; k < 2; ++k) \
      acc[ai][bj][m][n] = __builtin_amdgcn_mfma_f32_16x16x32_bf16(Bt_[n][k], At_[m][k], acc[ai][bj][m][n], 0, 0, 0); \
    __builtin_amdgcn_s_setprio(0); } while (0)
#define WAIT_V(n) asm volatile("s_waitcnt vmcnt(" #n ")" ::: "memory")
#define WAIT_L(n) asm volatile("s_waitcnt lgkmcnt(" #n ")" ::: "memory")
#define BAR __builtin_amdgcn_s_barrier()
#define SCHED __builtin_amdgcn_sched_barrier(0)

typedef f32x4 AccT[2][2][4][2];

template <class RowSrc, class Epi>
__device__ __forceinline__ void gemm_tile(const bf16_t* __restrict__ A, const bf16_t* __restrict__ Bt, const int K,
                                          const int bcol, const RowSrc& rs, const Epi& epi, const int wv, const int ntl = 0) {
    const int tid = hidden_tid(wv);
    int wid = tid >> 6, lane = tid & 63, wr = wid >> 2, wc = wid & 3, fr = lane & 15, fq = lane >> 4;
    unsigned aoff[2][2], boff[2];
#pragma unroll
    for (int i = 0; i < 2; ++i) {
        int R, C; stage_rc(tid * 16 + i * 8192, R, C);
        boff[i] = (unsigned)(((bcol + (R >> 5) * 64 + (R & 31)) * K + C) * 2);
        if (RowSrc::DENSE) { aoff[0][i] = (unsigned)((R * K + C) * 2); aoff[1][i] = 0u; }
        else {
#pragma unroll
            for (int h = 0; h < 2; ++h) aoff[h][i] = (unsigned)((rs(h * 128 + R) * K + C) * 2);
        }
    }
    AccT acc = {};
    bf16x8 At[4][2], B0[2][2], B1[2][2];
    const int nt = ntl ? ntl : K / 64;
    G_STAGE_B(SB(0, 0), 0, 0); G_STAGE_A(SA(0, 0), 0, 0);
    G_STAGE_B(SB(0, 1), 1, 0); G_STAGE_A(SA(0, 1), 1, 0);
    if (wr == 1) BAR;
    WAIT_V(4); BAR;
    G_STAGE_B(SB(1, 0), 0, 1); G_STAGE_A(SA(1, 0), 0, 1); G_STAGE_B(SB(1, 1), 1, 1);
    WAIT_V(6); BAR;
    for (int t = 0; t < nt - 2; t += 2) {
        G_LDB(B0, 0, 0); SCHED; G_LDA(At, 0, 0); G_STAGE_A(SA(1, 1), 1, t + 1);
        WAIT_L(8); BAR; WAIT_L(0); G_MMA(0, 0, At, B0); BAR; SCHED;
        G_LDB(B1, 0, 1); G_STAGE_B(SB(0, 0), 0, t + 2);
        BAR; WAIT_L(0); G_MMA(0, 1, At, B1); BAR;
        G_LDA(At, 0, 1); G_STAGE_A(SA(0, 0), 0, t + 2);
        BAR; WAIT_L(0); G_MMA(1, 0, At, B0); BAR; SCHED;
        G_STAGE_B(SB(0, 1), 1, t + 2);
        WAIT_V(6); BAR; G_MMA(1, 1, At, B1); BAR;
        G_LDB(B0, 1, 0); SCHED; G_LDA(At, 1, 0); G_STAGE_A(SA(0, 1), 1, t + 2);
        WAIT_L(8); BAR; WAIT_L(0); G_MMA(0, 0, At, B0); BAR; SCHED;
        G_LDB(B1, 1, 1); G_STAGE_B(SB(1, 0), 0, t + 3);
        BAR; WAIT_L(0); G_MMA(0, 1, At, B1); BAR;
        G_LDA(At, 1, 1); G_STAGE_A(SA(1, 0), 0, t + 3);
        BAR; WAIT_L(0); G_MMA(1, 0, At, B0); BAR; SCHED;
        G_STAGE_B(SB(1, 1), 1, t + 3);
        WAIT_V(6); BAR; G_MMA(1, 1, At, B1); BAR;
    }
    { G_LDB(B0, 0, 0); WAIT_V(0); G_LDA(At, 0, 0); G_STAGE_A(SA(1, 1), 1, nt - 1);
      BAR; WAIT_L(0); G_MMA(0, 0, At, B0); BAR;
      G_LDB(B1, 0, 1); BAR; WAIT_L(0); G_MMA(0, 1, At, B1); BAR;
      G_LDA(At, 0, 1); WAIT_V(4); BAR; WAIT_L(0); G_MMA(1, 0, At, B0); G_MMA(1, 1, At, B1); BAR; }
    { G_LDB(B0, 1, 0); G_LDA(At, 1, 0); WAIT_V(2); BAR; WAIT_L(0); G_MMA(0, 0, At, B0); BAR;
      G_LDB(B1, 1, 1); WAIT_V(0); BAR; WAIT_L(0); G_MMA(0, 1, At, B1); BAR;
      G_LDA(At, 1, 1); BAR; WAIT_L(0); G_MMA(1, 0, At, B0); G_MMA(1, 1, At, B1); BAR; }
    if (wr == 0) BAR;
    int tz = hidden_tid(wv); wid = tz >> 6; lane = tz & 63; wr = wid >> 2; wc = wid & 3; fr = lane & 15; fq = lane >> 4;
    epi(acc, wr * 64 + fr, bcol + wc * 64 + fq * 4);
}

struct RowIdent { static constexpr bool DENSE = true; __device__ __forceinline__ int operator()(int r) const { return r; } };

__device__ __forceinline__ void st_bf16x4(bf16_t* p, const f32x4& v) { u32x2 w; w.x = cvt_pk_bf16(v[0], v[1]); w.y = cvt_pk_bf16(v[2], v[3]); *(u32x2*)p = w; }
__device__ __forceinline__ void st_chan4(bf16_t* q, size_t ld, const f32x4& v) {
    const unsigned a = cvt_pk_bf16(v[0], v[1]), b = cvt_pk_bf16(v[2], v[3]);
    q[0] = (bf16_t)(a & 0xffff); q[ld] = (bf16_t)(a >> 16); q[2 * ld] = (bf16_t)(b & 0xffff); q[3 * ld] = (bf16_t)(b >> 16);
}
constexpr int BJS = 32;
#define EPI_LOOP_AM _Pragma("unroll") for (int ai = 0; ai < 2; ++ai) _Pragma("unroll") for (int m = 0; m < 4; ++m)
#define EPI_LOOP_BN _Pragma("unroll") for (int bj = 0; bj < 2; ++bj) _Pragma("unroll") for (int n = 0; n < 2; ++n)
struct EpiRes {
    bf16_t* XB; int brow; float* ssp; int lane;
    __device__ __forceinline__ void operator()(AccT& acc, int r0, int c0) const {
        u32x2 xv[2][4][4];
        EPI_LOOP_AM {
            const bf16_t* qb = XB + (size_t)(brow + r0 + ai * 128 + m * 16) * D + c0;
            EPI_LOOP_BN xv[ai][m][bj * 2 + n] = *(const u32x2*)(qb + bj * BJS + n * 16);
        }
        EPI_LOOP_AM {
            const int row = brow + r0 + ai * 128 + m * 16;
            bf16_t* qb = XB + (size_t)row * D + c0;
            float ss = 0.f;
            EPI_LOOP_BN {
                const u32x2 x = xv[ai][m][bj * 2 + n];
                const f32x4 t = (f32x4){bflo(x.x), bfhi(x.x), bflo(x.y), bfhi(x.y)} + acc[ai][bj][m][n];
                const unsigned a0 = cvt_pk_bf16(t[0], t[1]), a1 = cvt_pk_bf16(t[2], t[3]);
                *(u32x2*)(qb + bj * BJS + n * 16) = (u32x2){a0, a1};
                const float r0f = bflo(a0), r1f = bfhi(a0), r2f = bflo(a1), r3f = bfhi(a1);
                ss += (r0f * r0f + r1f * r1f) + (r2f * r2f + r3f * r3f);
            }
            if (ssp) { ss += shx(ss, 16, lane); ss += shx(ss, 32, lane); if ((lane >> 4) == 0) ssp[(size_t)row * 16 + (c0 >> 6)] = ss; }
        }
    }
};
struct EpiSplit {
    bf16_t* Ca; bf16_t* T; bf16_t* Cb; int c0s, c1s, ldT; size_t ldC; int brow; const float* rs;
    __device__ __forceinline__ void chan(AccT& acc, bf16_t* base, int r0, int c, const float (&scv)[2][4]) const {
        EPI_LOOP_AM { const int row = brow + r0 + ai * 128 + m * 16; const float sc = scv[ai][m];
            bf16_t* q = base + (size_t)c * ldC + row;
            EPI_LOOP_BN st_chan4(q + (size_t)(bj * BJS + n * 16) * ldC, ldC, acc[ai][bj][m][n] * sc); }
    }
    __device__ __forceinline__ void operator()(AccT& acc, int r0, int c0) const {
        const int tilec = __builtin_amdgcn_readfirstlane(c0) & ~255;
        float scv[2][4];
        EPI_LOOP_AM scv[ai][m] = rs ? rs[brow + r0 + ai * 128 + m * 16] : 1.0f;
        if (tilec < c0s) chan(acc, Ca, r0, c0, scv);
        else if (tilec < c1s) {
            EPI_LOOP_AM { const int row = brow + r0 + ai * 128 + m * 16; const float sc = scv[ai][m];
                bf16_t* q = T + (size_t)row * ldT + (c0 - c0s);
                EPI_LOOP_BN st_bf16x4(q + bj * BJS + n * 16, acc[ai][bj][m][n] * sc); }
        } else chan(acc, Cb, r0, c0 - c1s, scv);
    }
};
struct EpiTokRstd {
    bf16_t* T; int ldT, brow; const float* ssp; int lane;
    __device__ __forceinline__ void operator()(AccT& acc, int r0, int c0) const {
        f32x4 pv[2][4];
        EPI_LOOP_AM pv[ai][m] = *(const f32x4*)(ssp + (size_t)(brow + r0 + ai * 128 + m * 16) * 16 + (lane >> 4) * 4);
        EPI_LOOP_AM {
            const int row = brow + r0 + ai * 128 + m * 16;
            float ssq = (pv[ai][m][0] + pv[ai][m][1]) + (pv[ai][m][2] + pv[ai][m][3]);
            ssq += shx(ssq, 16, lane); ssq += shx(ssq, 32, lane);
            const float rs = rsqrtf(ssq * (1.0f / 1024.0f) + EPS);
            bf16_t* q = T + (size_t)row * ldT + c0;
            EPI_LOOP_BN st_bf16x4(q + bj * BJS + n * 16, acc[ai][bj][m][n] * rs);
        }
    }
};
struct EpiGateUp {
    bf16_t* act; const int* list; int cnt, pos0; const float* rp;
    __device__ __forceinline__ void operator()(AccT& acc, int r0, int c0) const {
        int av[2][4]; float rv[2][4];
        EPI_LOOP_AM { const int pos = pos0 + r0 + ai * 128 + m * 16, pc = pos < cnt ? pos : cnt - 1; av[ai][m] = list[pc]; rv[ai][m] = rp[pc]; }
        EPI_LOOP_AM {
            const int pos = pos0 + r0 + ai * 128 + m * 16;
            if (pos < cnt) {
                const int a = av[ai][m];
                const float rs = rv[ai][m];
#pragma unroll
                for (int bj = 0; bj < 2; ++bj) {
                    const f32x4 g = acc[ai][bj][m][0] * rs, u = acc[ai][bj][m][1] * rs; f32x4 o;
#pragma unroll
                    for (int j = 0; j < 4; ++j) o[j] = g[j] * __builtin_amdgcn_rcpf(1.0f + __builtin_amdgcn_exp2f(g[j] * -1.4426950408889634f)) * u[j];
                    const int col = c0 + bj * BJS;
                    const unsigned long long wv8 = ((unsigned long long)cvt_pk_bf16(o[2], o[3]) << 32) | cvt_pk_bf16(o[0], o[1]);
                    __hip_atomic_store((unsigned long long*)(act + (size_t)a * EH + (col >> 5) * 16 + (col & 15)), wv8, __ATOMIC_RELAXED, __HIP_MEMORY_SCOPE_AGENT);
                }
            }
        }
    }
};
struct EpiDown {
    bf16_t* y; const int* list; int cnt, pos0;
    __device__ __forceinline__ void operator()(AccT& acc, int r0, int c0) const {
        int av[2][4];
        EPI_LOOP_AM { const int pos = pos0 + r0 + ai * 128 + m * 16, pc = pos < cnt ? pos : cnt - 1; av[ai][m] = list[pc]; }
        EPI_LOOP_AM {
            const int pos = pos0 + r0 + ai * 128 + m * 16;
            if (pos < cnt) { bf16_t* q = y + (size_t)av[ai][m] * D + c0; EPI_LOOP_BN st_bf16x4(q + bj * BJS + n * 16, acc[ai][bj][m][n]); }
        }
    }
};
struct EpiNull {
    float* sink; int flag; int brow;
    __device__ __forceinline__ void operator()(AccT& acc, int r0, int c0) const {
        if (flag) { f32x4 t = {0.f, 0.f, 0.f, 0.f}; EPI_LOOP_AM EPI_LOOP_BN t += acc[ai][bj][m][n]; *(f32x4*)(sink + (size_t)(brow + r0) * 4 + c0) = t; }
    }
};
struct RowTok { static constexpr bool DENSE = false; const int* list; int cnt, pos0; __device__ __forceinline__ int operator()(int r) const { const int pos = pos0 + r; return pos < cnt ? (list[pos] >> 1) : NTOK; } };
struct RowAsg { static constexpr bool DENSE = false; const int* list; int cnt, pos0; __device__ __forceinline__ int operator()(int r) const { const int pos = pos0 + r; return pos < cnt ? list[pos] : 2 * NTOK; } };

constexpr int ATT_VOFF = 16384;
template <int MODE> struct ACfg;
template <> struct ACfg<0> { static constexpr int DQK = 64, DV = 128, NMAP = 2, KBLK = 2; };
template <> struct ACfg<1> { static constexpr int DQK = 64, DV = 64, NMAP = 1, KBLK = 1; };
template <> struct ACfg<2> { static constexpr int DQK = 128, DV = 128, NMAP = 1, KBLK = 2; };

template <int MODE, bool ALT = false>
__device__ __forceinline__ void attn_unit(const bf16_t* __restrict__ Qp, const int ldq,
                                          const bf16_t* __restrict__ Kp, const int ldk,
                                          const bf16_t* __restrict__ Vt, const size_t ldvt,
                                          const int q0, const int kbeg, const int kend,
                                          const float scale, const float slope, const float m_init, const float l_init,
                                          bf16_t* __restrict__ Op, const int ldo,
                                          const float lam, const float outscale, const float* __restrict__ subln, const int wv) {
    constexpr int DQK = ACfg<MODE>::DQK, DV = ACfg<MODE>::DV, NMAP = ACfg<MODE>::NMAP, KBLK = ACfg<MODE>::KBLK;
    const int tid = hidden_tid(wv), w = tid >> 6, lane = tid & 63, fr = lane & 15, fq = lane >> 4;
    const int qrow = q0 + w * 16 + fr;
    bf16x8 Qf[NMAP][DQK / 32];
#pragma unroll
    for (int m = 0; m < NMAP; ++m)
#pragma unroll
        for (int kk = 0; kk < DQK / 32; ++kk) Qf[m][kk] = *(const bf16x8*)(Qp + (size_t)qrow * ldq + m * DQK + kk * 32 + fq * 8);
    constexpr float LOG2E = 1.4426950408889634f;
    const float scale2 = scale * LOG2E, slope2 = slope * LOG2E, kappa = slope / scale;
    f32x4 O[NMAP][DV / 16], Ol[NMAP];
    float mrun[NMAP];
#pragma unroll
    for (int m = 0; m < NMAP; ++m) {
        mrun[m] = m_init * LOG2E; Ol[m] = (f32x4){(fq == 0) ? l_init : 0.f, 0.f, 0.f, 0.f};
#pragma unroll
        for (int et = 0; et < DV / 16; ++et) O[m][et] = (f32x4){0.f, 0.f, 0.f, 0.f};
    }
    const unsigned onesw = (fr == 0) ? 0x3f803f80u : 0u;
    const bf16x8 onesf = __builtin_bit_cast(bf16x8, (u32x4){onesw, onesw, onesw, onesw});
    char* const lds = (char*)shm;
    constexpr int KN = KBLK, VN = DV / 64;
    u32x4 kreg[KN], vreg[VN];
#define ATT_LOAD(k0_) do { \
        _Pragma("unroll") for (int i_ = 0; i_ < KN; ++i_) { const int c_ = tid + i_ * NT; const int key_ = c_ / (KBLK * 8), col_ = (c_ % (KBLK * 8)) * 8; \
            kreg[i_] = *(const u32x4*)(Kp + (size_t)((k0_) + key_) * ldk + col_); } \
        _Pragma("unroll") for (int i_ = 0; i_ < VN; ++i_) { const int c_ = tid + i_ * NT; const int e_ = c_ >> 3, kc_ = c_ & 7; \
            vreg[i_] = *(const u32x4*)(Vt + (size_t)e_ * ldvt + (k0_) + kc_ * 8); } } while (0)
    ATT_LOAD(kbeg);
    const int qw0 = q0 + w * 16;
    constexpr int VBYTES = DV * 160;
    bf16x8 Pf[NMAP][2];
#define ATT_PV_C(voff_, c) do { \
            bf16x8 vf[DV / 16]; \
            _Pragma("unroll") for (int et = 0; et < DV / 16; ++et) vf[et] = *(const bf16x8*)(lds + (voff_) + (et * 16 + fr) * 160 + (c) * 64 + fq * 16); \
            _Pragma("unroll") for (int m = 0; m < NMAP; ++m) Ol[m] = __builtin_amdgcn_mfma_f32_16x16x32_bf16(onesf, Pf[m][c], Ol[m], 0, 0, 0); \
            _Pragma("unroll") for (int et = 0; et < DV / 16; ++et) \
                _Pragma("unroll") for (int m = 0; m < NMAP; ++m) O[m][et] = __builtin_amdgcn_mfma_f32_16x16x32_bf16(vf[et], Pf[m][c], O[m][et], 0, 0, 0); \
        } while (0)
    int vcur = ATT_VOFF;
    for (int k0 = kbeg; k0 < kend; k0 += 64) {
        __syncthreads();
#pragma unroll
        for (int i = 0; i < KN; ++i) { const int c = tid + i * NT; const int key = c / (KBLK * 8), col = (c % (KBLK * 8)) * 8;
            *(u32x4*)(lds + (col >> 6) * 8192 + lds_byte(key, col & 63)) = kreg[i]; }
#pragma unroll
        for (int i = 0; i < VN; ++i) { const int c = tid + i * NT; const int e = c >> 3, kc = c & 7;
            char* vd = lds + vcur + e * 160 + (kc >> 2) * 64 + (kc & 1) * 32 + ((kc >> 1) & 1) * 8;
            *(u32x2*)vd = (u32x2){vreg[i].x, vreg[i].y}; *(u32x2*)(vd + 16) = (u32x2){vreg[i].z, vreg[i].w}; }
        __syncthreads();
        if (k0 + 64 < kend) ATT_LOAD(k0 + 64);
        const int vprev = vcur ^ ATT_VOFF ^ (ATT_VOFF + VBYTES);
        const float dq = (float)(qrow - k0);
        bool gen;
        if (MODE == 2) gen = false;
        else if (MODE == 1) gen = !((k0 + 63 <= qw0 && qw0 + 15 - k0 <= 128) || (k0 >= qw0 + 15 && k0 + 63 - qw0 <= 128));
        else gen = !(k0 + 63 <= qw0 || k0 >= qw0 + 15);
        const bool pos = (MODE == 2) || (k0 + 63 <= qw0);
        f32x4 Cin[4]; float off;
        if (MODE == 2) {
#pragma unroll
            for (int t = 0; t < 4; ++t) Cin[t] = (f32x4){0.f, 0.f, 0.f, 0.f};
            off = 0.f;
        } else if (gen) {
#pragma unroll
            for (int t = 0; t < 4; ++t)
#pragma unroll
                for (int r = 0; r < 4; ++r) Cin[t][r] = -kappa * fabsf(dq - (float)(16 * t + 4 * fq + r));
            off = 0.f;
        } else {
            const float sk = pos ? kappa : -kappa, cb = sk * (float)(4 * fq);
#pragma unroll
            for (int t = 0; t < 4; ++t)
#pragma unroll
                for (int r = 0; r < 4; ++r) Cin[t][r] = sk * (float)(16 * t + r) + cb;
            off = pos ? -slope2 * dq : slope2 * dq;
        }
        f32x4 s[NMAP][4];
#pragma unroll
        for (int m = 0; m < NMAP; ++m) {
            bf16x8 kf[4][DQK / 32];
#pragma unroll
            for (int t = 0; t < 4; ++t)
#pragma unroll
                for (int kk = 0; kk < DQK / 32; ++kk) {
                    const int blk = (MODE == 2) ? (kk >> 1) : m, kcol = (MODE == 2) ? (kk & 1) * 32 : kk * 32;
                    kf[t][kk] = *(const bf16x8*)(lds + blk * 8192 + lds_byte(t * 16 + fr, kcol + fq * 8));
                }
#pragma unroll
            for (int t = 0; t < 4; ++t) {
                s[m][t] = Cin[t];
#pragma unroll
                for (int kk = 0; kk < DQK / 32; ++kk) s[m][t] = __builtin_amdgcn_mfma_f32_16x16x32_bf16(kf[t][kk], Qf[m][kk], s[m][t], 0, 0, 0);
            }
        }
        float mx[NMAP], mx1[NMAP];
#pragma unroll
        for (int m = 0; m < NMAP; ++m) {
            if (MODE == 1 && gen) {
#pragma unroll
                for (int t = 0; t < 4; ++t)
#pragma unroll
                    for (int r = 0; r < 4; ++r) s[m][t][r] = (fabsf(dq - (float)(16 * t + 4 * fq + r)) > 128.0f) ? -1e30f : s[m][t][r];
            }
            float v = fmaxf(fmaxf(s[m][0][0], s[m][0][1]), fmaxf(s[m][0][2], s[m][0][3]));
#pragma unroll
            for (int t = 1; t < 4; ++t) v = fmaxf(v, fmaxf(fmaxf(s[m][t][0], s[m][t][1]), fmaxf(s[m][t][2], s[m][t][3])));
            mx[m] = v; mx1[m] = shx(v, 16, lane);
        }
        __builtin_amdgcn_sched_barrier(0);
        if (k0 > kbeg) ATT_PV_C(vprev, 0);
        __builtin_amdgcn_sched_barrier(0);
#pragma unroll
        for (int m = 0; m < NMAP; ++m) { mx[m] = fmaxf(mx[m], mx1[m]); mx1[m] = shx(mx[m], 32, lane); }
        __builtin_amdgcn_sched_barrier(0);
        if (k0 > kbeg) ATT_PV_C(vprev, 1);
        __builtin_amdgcn_sched_barrier(0);
#pragma unroll
        for (int m = 0; m < NMAP; ++m) {
            const float mxx = fmaxf(mx[m], mx1[m]);
            const float mtile = fmaxf(mxx * scale2 + off, -1e30f);
            const float mnew = fmaxf(mrun[m], mtile), alpha = __builtin_amdgcn_exp2f(mrun[m] - mnew);
            mrun[m] = mnew;
            const float sub = off - mnew;
#pragma unroll
            for (int t = 0; t < 4; ++t)
#pragma unroll
                for (int r = 0; r < 4; ++r) s[m][t][r] = __builtin_amdgcn_exp2f(s[m][t][r] * scale2 + sub);
            if (__builtin_amdgcn_ballot_w64(alpha != 1.0f) != 0ull) {
                Ol[m] *= alpha;
#pragma unroll
                for (int et = 0; et < DV / 16; ++et) O[m][et] *= alpha;
            }
#pragma unroll
            for (int c = 0; c < 2; ++c) {
                u32x4 pk; pk.x = cvt_pk_bf16(s[m][2 * c][0], s[m][2 * c][1]); pk.y = cvt_pk_bf16(s[m][2 * c][2], s[m][2 * c][3]);
                pk.z = cvt_pk_bf16(s[m][2 * c + 1][0], s[m][2 * c + 1][1]); pk.w = cvt_pk_bf16(s[m][2 * c + 1][2], s[m][2 * c + 1][3]);
                Pf[m][c] = __builtin_bit_cast(bf16x8, pk);
            }
        }
        vcur = vprev;
    }
    { const int vlast = vcur ^ ATT_VOFF ^ (ATT_VOFF + VBYTES); ATT_PV_C(vlast, 0); ATT_PV_C(vlast, 1); }
    float linv[NMAP];
#pragma unroll
    for (int m = 0; m < NMAP; ++m) linv[m] = 1.0f / shl(Ol[m][0], fr);
    const int tid2 = hidden_tid(wv); const int qrow_o = q0 + (tid2 >> 6) * 16 + (tid2 & 15);
    if (MODE == 0) {
        float ss = 0.f;
#pragma unroll
        for (int et = 0; et < DV / 16; ++et)
#pragma unroll
            for (int r = 0; r < 4; ++r) { const float v = O[0][et][r] * linv[0] - lam * (O[NMAP - 1][et][r] * linv[NMAP - 1]); O[0][et][r] = v; ss += v * v; }
        ss += shx(ss, 16, lane); ss += shx(ss, 32, lane);
        const float rs = rsqrtf(ss * (1.0f / 128.0f) + EPS) * outscale;
#pragma unroll
        for (int et = 0; et < DV / 16; ++et) {
            const f32x4 g = *(const f32x4*)(subln + et * 16 + fq * 4);
            st_bf16x4(Op + (size_t)qrow_o * ldo + et * 16 + fq * 4, O[0][et] * rs * g);
        }
    } else {
#pragma unroll
        for (int et = 0; et < DV / 16; ++et) st_bf16x4(Op + (size_t)qrow_o * ldo + et * 16 + fq * 4, O[0][et] * linv[0]);
    }
}

template <int MODE>
__device__ __forceinline__ void attn2_unit(const bf16_t* __restrict__ Qp, const int ldq, const bf16_t* __restrict__ Kp, const int ldk,
                                           const bf16_t* __restrict__ Vt, const size_t ldvt, const int q0, const int kbeg, const int kend,
                                           const float scale, const float* __restrict__ sinkp, const int hq0, bf16_t* __restrict__ Op, const int ldo, const int wv) {
    constexpr int DQK = ACfg<MODE>::DQK, DV = ACfg<MODE>::DV, KBLK = ACfg<MODE>::KBLK, RT = 2;
    const int tid = hidden_tid(wv), w = tid >> 6, lane = tid & 63, fr = lane & 15, fq = lane >> 4;
    const int hl = (MODE == 1) ? (w >> 1) : 0, qsub = (MODE == 1) ? (w & 1) * 32 : w * 32;
    const float slope = (MODE == 1) ? exp2f(-0.5f * (float)(hq0 + hl + 1)) : 0.f;
    const float m_init = (MODE == 1) ? sinkp[hl] : -1e30f, l_init = (MODE == 1) ? 1.0f : 0.f;
    constexpr float LOG2E = 1.4426950408889634f;
    const float scale2 = scale * LOG2E, slope2 = slope * LOG2E, kappa = slope / scale;
    bf16x8 Qf[RT][DQK / 32];
#pragma unroll
    for (int rt = 0; rt < RT; ++rt)
#pragma unroll
        for (int kk = 0; kk < DQK / 32; ++kk) Qf[rt][kk] = *(const bf16x8*)(Qp + (size_t)(q0 + qsub + 16 * rt + fr) * ldq + hl * 64 + kk * 32 + fq * 8);
    f32x4 O[RT][DV / 16], Ol[RT];
    float mrun[RT];
#pragma unroll
    for (int rt = 0; rt < RT; ++rt) {
        mrun[rt] = m_init * LOG2E; Ol[rt] = (f32x4){(fq == 0) ? l_init : 0.f, 0.f, 0.f, 0.f};
#pragma unroll
        for (int et = 0; et < DV / 16; ++et) O[rt][et] = (f32x4){0.f, 0.f, 0.f, 0.f};
    }
    const unsigned onesw = (fr == 0) ? 0x3f803f80u : 0u;
    const bf16x8 onesf = __builtin_bit_cast(bf16x8, (u32x4){onesw, onesw, onesw, onesw});
    char* const lds = (char*)shm;
    constexpr int KN = KBLK, VN = DV / 64;
    u32x4 kreg[KN], vreg[VN];
#define ATT2_LOAD(k0_) do { \
        _Pragma("unroll") for (int i_ = 0; i_ < KN; ++i_) { const int c_ = tid + i_ * NT; const int key_ = c_ / (KBLK * 8), col_ = (c_ % (KBLK * 8)) * 8; \
            kreg[i_] = *(const u32x4*)(Kp + (size_t)((k0_) + key_) * ldk + col_); } \
        _Pragma("unroll") for (int i_ = 0; i_ < VN; ++i_) { const int c_ = tid + i_ * NT; const int e_ = c_ >> 3, kc_ = c_ & 7; \
            vreg[i_] = *(const u32x4*)(Vt + (size_t)e_ * ldvt + (k0_) + kc_ * 8); } } while (0)
    ATT2_LOAD(kbeg);
    constexpr int VBYTES = DV * 160;
    bf16x8 Pf[RT][2];
#define ATT2_PV_C(voff_, c) do { \
            bf16x8 vf[DV / 16]; \
            _Pragma("unroll") for (int et = 0; et < DV / 16; ++et) vf[et] = *(const bf16x8*)(lds + (voff_) + (et * 16 + fr) * 160 + (c) * 64 + fq * 16); \
            _Pragma("unroll") for (int rt = 0; rt < RT; ++rt) Ol[rt] = __builtin_amdgcn_mfma_f32_16x16x32_bf16(onesf, Pf[rt][c], Ol[rt], 0, 0, 0); \
            _Pragma("unroll") for (int et = 0; et < DV / 16; ++et) \
                _Pragma("unroll") for (int rt = 0; rt < RT; ++rt) O[rt][et] = __builtin_amdgcn_mfma_f32_16x16x32_bf16(vf[et], Pf[rt][c], O[rt][et], 0, 0, 0); \
        } while (0)
    int vcur = ATT_VOFF;
    for (int k0 = kbeg; k0 < kend; k0 += 64) {
        __syncthreads();
#pragma unroll
        for (int i = 0; i < KN; ++i) { const int c = tid + i * NT; const int key = c / (KBLK * 8), col = (c % (KBLK * 8)) * 8;
            *(u32x4*)(lds + (col >> 6) * 8192 + lds_byte(key, col & 63)) = kreg[i]; }
#pragma unroll
        for (int i = 0; i < VN; ++i) { const int c = tid + i * NT; const int e = c >> 3, kc = c & 7;
            char* vd = lds + vcur + e * 160 + (kc >> 2) * 64 + (kc & 1) * 32 + ((kc >> 1) & 1) * 8;
            *(u32x2*)vd = (u32x2){vreg[i].x, vreg[i].y}; *(u32x2*)(vd + 16) = (u32x2){vreg[i].z, vreg[i].w}; }
        __syncthreads();
        if (k0 + 64 < kend) ATT2_LOAD(k0 + 64);
        const int vprev = vcur ^ ATT_VOFF ^ (ATT_VOFF + VBYTES);
        f32x4 s[RT][4]; float off[RT], dqv[RT]; bool genv[RT];
#pragma unroll
        for (int rt = 0; rt < RT; ++rt) {
            const int qw0 = q0 + qsub + 16 * rt;
            const float dq = (float)(qw0 + fr - k0); dqv[rt] = dq;
            const bool gen = (MODE == 1) && !((k0 + 63 <= qw0 && qw0 + 15 - k0 <= 128) || (k0 >= qw0 + 15 && k0 + 63 - qw0 <= 128));
            const bool pos = (MODE == 2) || (k0 + 63 <= qw0);
            genv[rt] = gen;
            if (MODE == 2) {
#pragma unroll
                for (int t = 0; t < 4; ++t) s[rt][t] = (f32x4){0.f, 0.f, 0.f, 0.f};
                off[rt] = 0.f;
            } else if (gen) {
#pragma unroll
                for (int t = 0; t < 4; ++t)
#pragma unroll
                    for (int r = 0; r < 4; ++r) s[rt][t][r] = -kappa * fabsf(dq - (float)(16 * t + 4 * fq + r));
                off[rt] = 0.f;
            } else {
                const float sk = pos ? kappa : -kappa; float cb = sk * (float)(4 * fq);
                asm volatile("" : "+v"(cb));
#pragma unroll
                for (int t = 0; t < 4; ++t)
#pragma unroll
                    for (int r = 0; r < 4; ++r) s[rt][t][r] = sk * (float)(16 * t + r) + cb;
                off[rt] = pos ? -slope2 * dq : slope2 * dq;
            }
        }
#pragma unroll
        for (int t = 0; t < 4; ++t) {
            bf16x8 kf[DQK / 32];
#pragma unroll
            for (int kk = 0; kk < DQK / 32; ++kk) {
                const int blk = (MODE == 2) ? (kk >> 1) : 0, kcol = (MODE == 2) ? (kk & 1) * 32 : kk * 32;
                kf[kk] = *(const bf16x8*)(lds + blk * 8192 + lds_byte(t * 16 + fr, kcol + fq * 8));
            }
#pragma unroll
            for (int rt = 0; rt < RT; ++rt)
#pragma unroll
                for (int kk = 0; kk < DQK / 32; ++kk) s[rt][t] = __builtin_amdgcn_mfma_f32_16x16x32_bf16(kf[kk], Qf[rt][kk], s[rt][t], 0, 0, 0);
        }
        float mx[RT], mx1[RT];
#pragma unroll
        for (int rt = 0; rt < RT; ++rt) {
            if (MODE == 1 && genv[rt]) {
#pragma unroll
                for (int t = 0; t < 4; ++t)
#pragma unroll
                    for (int r = 0; r < 4; ++r) s[rt][t][r] = (fabsf(dqv[rt] - (float)(16 * t + 4 * fq + r)) > 128.0f) ? -1e30f : s[rt][t][r];
            }
            float v = fmaxf(fmaxf(s[rt][0][0], s[rt][0][1]), fmaxf(s[rt][0][2], s[rt][0][3]));
#pragma unroll
            for (int t = 1; t < 4; ++t) v = fmaxf(v, fmaxf(fmaxf(s[rt][t][0], s[rt][t][1]), fmaxf(s[rt][t][2], s[rt][t][3])));
            mx[rt] = v; mx1[rt] = shx(v, 16, lane);
        }
        __builtin_amdgcn_sched_barrier(0);
        if (k0 > kbeg) ATT2_PV_C(vprev, 0);
        __builtin_amdgcn_sched_barrier(0);
#pragma unroll
        for (int rt = 0; rt < RT; ++rt) { mx[rt] = fmaxf(mx[rt], mx1[rt]); mx1[rt] = shx(mx[rt], 32, lane); }
        __builtin_amdgcn_sched_barrier(0);
        if (k0 > kbeg) ATT2_PV_C(vprev, 1);
        __builtin_amdgcn_sched_barrier(0);
#pragma unroll
        for (int rt = 0; rt < RT; ++rt) {
            const float mxx = fmaxf(mx[rt], mx1[rt]);
            const float mtile = fmaxf(mxx * scale2 + off[rt], -1e30f);
            const float mnew = fmaxf(mrun[rt], mtile), alpha = __builtin_amdgcn_exp2f(mrun[rt] - mnew);
            mrun[rt] = mnew;
            const float sub = off[rt] - mnew;
#pragma unroll
            for (int t = 0; t < 4; ++t)
#pragma unroll
                for (int r = 0; r < 4; ++r) s[rt][t][r] = __builtin_amdgcn_exp2f(s[rt][t][r] * scale2 + sub);
            if (__builtin_amdgcn_ballot_w64(alpha != 1.0f) != 0ull) {
                Ol[rt] *= alpha;
#pragma unroll
                for (int et = 0; et < DV / 16; ++et) O[rt][et] *= alpha;
            }
#pragma unroll
            for (int c = 0; c < 2; ++c) {
                u32x4 pk; pk.x = cvt_pk_bf16(s[rt][2 * c][0], s[rt][2 * c][1]); pk.y = cvt_pk_bf16(s[rt][2 * c][2], s[rt][2 * c][3]);
                pk.z = cvt_pk_bf16(s[rt][2 * c + 1][0], s[rt][2 * c + 1][1]); pk.w = cvt_pk_bf16(s[rt][2 * c + 1][2], s[rt][2 * c + 1][3]);
                Pf[rt][c] = __builtin_bit_cast(bf16x8, pk);
            }
        }
        vcur = vprev;
    }
    { const int vlast = vcur ^ ATT_VOFF ^ (ATT_VOFF + VBYTES); ATT2_PV_C(vlast, 0); ATT2_PV_C(vlast, 1); }
    const int tid2 = hidden_tid(wv), w2 = tid2 >> 6, fr2 = tid2 & 15;
    const int hl2 = (MODE == 1) ? (w2 >> 1) : 0, qsub2 = (MODE == 1) ? (w2 & 1) * 32 : w2 * 32;
#pragma unroll
    for (int rt = 0; rt < RT; ++rt) {
        const float linv = 1.0f / shl(Ol[rt][0], fr);
        bf16_t* orow = Op + (size_t)(q0 + qsub2 + 16 * rt + fr2) * ldo + hl2 * 64;
#pragma unroll
        for (int et = 0; et < DV / 16; ++et) st_bf16x4(orow + et * 16 + fq * 4, O[rt][et] * linv);
    }
#undef ATT2_LOAD
#undef ATT2_PV_C
}

constexpr int HZ_RS = 4896;
constexpr int HZ_PAD = 192;
constexpr int H_CPS = 8256;
constexpr int H_ZOFF = 0, H_CPOFF = 8 * HZ_RS, H_RAWOFF = H_CPOFF + 8 * H_CPS;

template <bool ALT>
__device__ __forceinline__ void hyena_unit(const Params& p, const int lj  , const int c, const int wv) {
    const int tid = hidden_tid(wv), w = tid >> 6, lane = tid & 63, fr = lane & 15, fq = lane >> 4;
    char* const lds = (char*)shm;
    const bf16_t* hyT = (const bf16_t*)(p.ws + WS_PROJ + PR_HYT);
    const float* cw = p.in[4] + (size_t)lj * 3 * 1536; const float* cb = p.in[5] + (size_t)lj * 1536;
    const int nb = fr >> 1, tbp = fr & 1;
    __syncthreads();
    for (int i = tid; i < 8 * 2 * (HZ_PAD / 8); i += NT) {
        const int b = i / (2 * (HZ_PAD / 8)), r = i % (2 * (HZ_PAD / 8)), side = r / (HZ_PAD / 8), k = r % (HZ_PAD / 8);
        unsigned zz0 = 0u; asm volatile("" : "+v"(zz0));
        *(u32x4*)(lds + H_ZOFF + b * HZ_RS + (side ? (HZ_PAD + 2048) * 2 : 0) + k * 16) = (u32x4){zz0, zz0, zz0, zz0};
        if (i < 2) *(u32x4*)(lds + H_RAWOFF + 8192 + i * 16) = (u32x4){zz0, zz0, zz0, zz0};
    }
    {
        const float w0 = cw[c], w1 = cw[1536 + c], w2 = cw[2 * 1536 + c], bb = cb[c];
        const bf16_t* src = hyT + (size_t)c * NTOK;
        u32x4 v[4]; unsigned short um[4], up[4];
#pragma unroll
        for (int k = 0; k < 4; ++k) {
            const int i = tid + k * NT, b = i >> 8, s0 = (i & 255) * 8;
            const bf16_t* q = src + b * S + s0;
            v[k] = *(const u32x4*)q; um[k] = q[s0 > 0 ? -1 : 0]; up[k] = q[s0 + 8 < S ? 8 : 7];
        }
#pragma unroll
        for (int k = 0; k < 4; ++k) {
            const int i = tid + k * NT, b = i >> 8, s0 = (i & 255) * 8;
            float u[10];
            u[0] = (s0 > 0) ? bf2f(um[k]) : 0.f; u[9] = (s0 + 8 < S) ? bf2f(up[k]) : 0.f;
            u[1] = bflo(v[k].x); u[2] = bfhi(v[k].x); u[3] = bflo(v[k].y); u[4] = bfhi(v[k].y); u[5] = bflo(v[k].z); u[6] = bfhi(v[k].z); u[7] = bflo(v[k].w); u[8] = bfhi(v[k].w);
            float o[8];
#pragma unroll
            for (int j = 0; j < 8; ++j) o[j] = w0 * u[j] + w1 * u[j + 1] + w2 * u[j + 2] + bb;
            u32x4 ov; ov.x = cvt_pk_bf16(o[0], o[1]); ov.y = cvt_pk_bf16(o[2], o[3]); ov.z = cvt_pk_bf16(o[4], o[5]); ov.w = cvt_pk_bf16(o[6], o[7]);
            *(u32x4*)(lds + H_ZOFF + b * HZ_RS + (HZ_PAD + s0) * 2) = ov;
        }
    }
#pragma unroll 1
    for (int order = 0; order < 2; ++order) {
        const int gch = 512 * (order + 1) + c;
        const bf16_t* gsrc = hyT + (size_t)gch * NTOK;
        u32x2 gv[2][4]; unsigned short gm[2][4], gp[2][4];
        u32x4 rawv;
        {
            const bf16_t* f = (const bf16_t*)(p.ws + WS_FILT) + ((size_t)(lj * 2 + order) * 512 + c) * 4096;
            rawv = *(const u32x4*)(f + tid * 8);
#pragma unroll
            for (int ci = 0; ci < 2; ++ci)
#pragma unroll
                for (int mt = 0; mt < 4; ++mt) {
                    const int t = 64 * (4 * w + 2 * ci + tbp) + 16 * mt + 4 * fq;
                    const bf16_t* gq = gsrc + nb * S + t;
                    gv[ci][mt] = *(const u32x2*)gq; gm[ci][mt] = gq[t > 0 ? -1 : 0]; gp[ci][mt] = gq[t + 4 < S ? 4 : 3];
                }
        }
        *(u32x4*)(lds + H_RAWOFF + tid * 16) = rawv;
        __syncthreads();
        {
            const bf16_t* raw = (const bf16_t*)(lds + H_RAWOFF);
            const int o = w;
#pragma unroll
            for (int k = 0; k < 8; ++k) {
                const int a = lane + 64 * k;
                unsigned short e[8];
#pragma unroll
                for (int j = 0; j < 8; ++j) e[j] = raw[8 * a + o + j];
                u32x4 ov; ov.x = e[0] | ((unsigned)e[1] << 16); ov.y = e[2] | ((unsigned)e[3] << 16); ov.z = e[4] | ((unsigned)e[5] << 16); ov.w = e[6] | ((unsigned)e[7] << 16);
                *(u32x4*)(lds + H_CPOFF + o * H_CPS + a * 16) = ov;
            }
        }
        __syncthreads();
        f32x4 acc[2][4];
#pragma unroll
        for (int ci = 0; ci < 2; ++ci)
#pragma unroll
            for (int mt = 0; mt < 4; ++mt) acc[ci][mt] = (f32x4){0.f, 0.f, 0.f, 0.f};
        {
            const int acp = H_CPOFF + (7 - (fr & 7)) * H_CPS + (255 - (fr >> 3) + fq) * 16;
            const int zb = H_ZOFF + nb * HZ_RS + (HZ_PAD + 8 * fq) * 2;
            for (int dl = 4 * w - 31; dl <= ((ALT && DUPSEL >= 5) ? 4 * w - 31 : 4 * w + 3); ++dl) {
#pragma unroll
                for (int kh = 0; kh < 2; ++kh) {
                    bf16x8 Bf[2];
#pragma unroll
                    for (int ci = 0; ci < 2; ++ci) {
                        const int sblk = 4 * w + 2 * ci + tbp - dl;
                        Bf[ci] = *(const bf16x8*)(lds + zb + (64 * sblk + 32 * kh) * 2);
                    }
#pragma unroll
                    for (int mt = 0; mt < 4; ++mt) {
                        const int q = 4 * dl + mt - 2 * kh;
                        const bf16x8 Af = *(const bf16x8*)(lds + acp - 32 * q);
#pragma unroll
                        for (int ci = 0; ci < 2; ++ci) acc[ci][mt] = __builtin_amdgcn_mfma_f32_16x16x32_bf16(Af, Bf[ci], acc[ci][mt], 0, 0, 0);
                    }
                }
            }
        }
        const float hb = p.in[12][(size_t)(lj * 2 + order) * 512 + c];
        const float w0 = cw[gch], w1 = cw[1536 + gch], w2 = cw[2 * 1536 + gch], bb = cb[gch];
        u32x2 zout[2][4];
#pragma unroll
        for (int ci = 0; ci < 2; ++ci)
#pragma unroll
            for (int mt = 0; mt < 4; ++mt) {
                const int t = 64 * (4 * w + 2 * ci + tbp) + 16 * mt + 4 * fq;
                const u32x2 zz = *(const u32x2*)(lds + H_ZOFF + nb * HZ_RS + (HZ_PAD + t) * 2);
                float u[6];
                u[0] = (t > 0) ? bf2f(gm[ci][mt]) : 0.f; u[5] = (t + 4 < S) ? bf2f(gp[ci][mt]) : 0.f;
                u[1] = bflo(gv[ci][mt].x); u[2] = bfhi(gv[ci][mt].x); u[3] = bflo(gv[ci][mt].y); u[4] = bfhi(gv[ci][mt].y);
                const float z[4] = {bflo(zz.x), bfhi(zz.x), bflo(zz.y), bfhi(zz.y)};
                float o[4];
#pragma unroll
                for (int r = 0; r < 4; ++r) {
                    const float gate = w0 * u[r] + w1 * u[r + 1] + w2 * u[r + 2] + bb;
                    o[r] = gate * (acc[ci][mt][r] + hb * z[r]);
                }
                zout[ci][mt].x = cvt_pk_bf16(o[0], o[1]); zout[ci][mt].y = cvt_pk_bf16(o[2], o[3]);
            }
        __syncthreads();
        if (order == 0) {
#pragma unroll
            for (int ci = 0; ci < 2; ++ci)
#pragma unroll
                for (int mt = 0; mt < 4; ++mt) {
                    const int t = 64 * (4 * w + 2 * ci + tbp) + 16 * mt + 4 * fq;
                    *(u32x2*)(lds + H_ZOFF + nb * HZ_RS + (HZ_PAD + t) * 2) = zout[ci][mt];
                }
        } else {
            bf16_t* yt = (bf16_t*)(p.ws + WS_QX) + (size_t)c * NTOK;
#pragma unroll
            for (int ci = 0; ci < 2; ++ci)
#pragma unroll
                for (int mt = 0; mt < 4; ++mt) {
                    const int t = 64 * (4 * w + 2 * ci + tbp) + 16 * mt + 4 * fq;
                    *(u32x2*)(yt + nb * S + t) = zout[ci][mt];
                }
        }
        __syncthreads();
    }
}

struct Row16 { f32x4 v[4]; };
__device__ __forceinline__ void ld_row(Row16& r, const float* src, int lane) {
#pragma unroll
    for (int i = 0; i < 4; ++i) r.v[i] = *(const f32x4*)(src + 256 * i + 4 * lane);
}
__device__ __forceinline__ void ld_row_bf(Row16& r, const bf16_t* src, int lane) {
#pragma unroll
    for (int i = 0; i < 4; ++i) { const u32x2 v = *(const u32x2*)(src + 256 * i + 4 * lane); r.v[i] = (f32x4){bflo(v.x), bfhi(v.x), bflo(v.y), bfhi(v.y)}; }
}
__device__ __forceinline__ float row_rstd(const Row16& r, int lane) {
    float ss = 0.f;
#pragma unroll
    for (int i = 0; i < 4; ++i) ss += r.v[i][0] * r.v[i][0] + r.v[i][1] * r.v[i][1] + r.v[i][2] * r.v[i][2] + r.v[i][3] * r.v[i][3];
    ss = wave_sum(ss, lane);
    return rsqrtf(ss * (1.0f / 1024.0f) + EPS);
}
template <int KIND  , bool ALT = false>
__device__ __forceinline__ void norm_phase(const Params& p, const int layer, const float* __restrict__ gain, const int bid, const int nb, const int wv) {
    const int tid_ = hidden_tid(wv), lane = tid_ & 63, w = tid_ >> 6;
    bf16_t* XB = (bf16_t*)(p.ws + WS_XB);
    bf16_t* XBo = ALT ? (bf16_t*)(p.ws + WS_PROJ) : XB;
    float* RS1 = (float*)(p.ws + (ALT ? WS_QX : WS_RS1));
    const bf16_t* Y = (const bf16_t*)(p.ws + WS_Y);
    const float* WT = (const float*)(p.ws + WS_WT);
    Row16 g;
    if (KIND == 2) ld_row(g, gain, lane);
    for (int tok = bid * 8 + w; tok < NTOK; tok += nb * 8) {
        Row16 x;
        if (KIND == 0 && layer == 0) ld_row(x, p.in[0] + (size_t)tok * D, lane); else ld_row_bf(x, XB + (size_t)tok * D, lane);
        if ((KIND == 0 && layer > 0) || KIND == 2) {
            const float w0 = WT[2 * tok], w1 = WT[2 * tok + 1];
            const bf16_t* y0 = Y + (size_t)(2 * tok) * D; const bf16_t* y1 = y0 + D;
#pragma unroll
            for (int i = 0; i < 4; ++i) {
                const u32x2 a = *(const u32x2*)(y0 + 256 * i + 4 * lane), b = *(const u32x2*)(y1 + 256 * i + 4 * lane);
                x.v[i][0] += w0 * bflo(a.x) + w1 * bflo(b.x); x.v[i][1] += w0 * bfhi(a.x) + w1 * bfhi(b.x);
                x.v[i][2] += w0 * bflo(a.y) + w1 * bflo(b.y); x.v[i][3] += w0 * bfhi(a.y) + w1 * bfhi(b.y);
            }
        }
        if (KIND == 2) {
            const float rstd = row_rstd(x, lane);
#pragma unroll
            for (int i = 0; i < 4; ++i) *(f32x4*)(p.out + (size_t)tok * D + 256 * i + 4 * lane) = x.v[i] * rstd * g.v[i];
        } else {
#pragma unroll
            for (int i = 0; i < 4; ++i) {
                const unsigned a0 = cvt_pk_bf16(x.v[i][0], x.v[i][1]), a1 = cvt_pk_bf16(x.v[i][2], x.v[i][3]);
                *(u32x2*)(XBo + (size_t)tok * D + 256 * i + 4 * lane) = (u32x2){a0, a1};
                x.v[i] = (f32x4){bflo(a0), bfhi(a0), bflo(a1), bfhi(a1)};
            }
            const float rstd = row_rstd(x, lane);
            if (lane == 0) RS1[tok] = rstd;
        }
    }
}

template <bool ALT>
__device__ __forceinline__ void route_tail(const Params& p, const int layer, const int chunk, f32x4 (&acc)[4][3], float (&ssq)[4], const int wv) {
    const int tid = hidden_tid(wv), lane = tid & 63, w = tid >> 6, fr = lane & 15, fq = lane >> 4;
    float* part = (float*)shm;
    float* ssql = part + 8 * 64 * 49;
    float* lgl = ssql + 8 * 64;
    int* cntl = (int*)((char*)shm + LDS_ROUTE);
    int* basel = cntl + 32;
    int* sel = basel + 32;
    int* posl = sel + 128;
    float* rsl = (float*)(posl + 128);
    float* WT = (float*)(p.ws + (ALT ? WS_ACT + (size_t)4 * 1024 * 1024 : WS_WT));
    float* RSTD = (float*)(p.ws + (ALT ? WS_ACT + (size_t)5 * 1024 * 1024 : WS_RSTD));
    int* LIST = (int*)(p.ws + (ALT ? WS_ACT : WS_LIST));
    float* RP = (float*)(p.ws + (ALT ? WS_ACT + (size_t)2 * 1024 * 1024 : WS_RP));
    int* CNT = (int*)(p.ws + WS_CNT) + (layer + (ALT ? 4 : 0)) * NEXP * CNT_STRIDE;
    const float* bg = p.in[26] + layer * 4; const float* be = p.in[28] + layer * NEXP;
    const char* const Xc = (const char*)(p.ws + WS_XB);
    const char* const Whc = (const char*)(p.ws + WS_WRT) + (size_t)layer * 2 * 48 * 1024 * 2; const char* const Wlc = Whc + 48 * 1024 * 2;
#pragma unroll
    for (int mt = 0; mt < 4; ++mt) {
        float sq = ssq[mt]; sq += shx(sq, 16, lane); sq += shx(sq, 32, lane);
        if (fq == 0) ssql[w * 64 + mt * 16 + fr] = sq;
#pragma unroll
        for (int nt = 0; nt < 3; ++nt)
#pragma unroll
            for (int r = 0; r < 4; ++r) part[(w * 64 + mt * 16 + fq * 4 + r) * 49 + nt * 16 + fr] = acc[mt][nt][r];
    }
    __syncthreads();
    {
        const int tl = tid & 63;
        for (int j = tid >> 6; j < 36; j += 8) {
            float s = 0.f;
#pragma unroll
            for (int ww = 0; ww < 8; ++ww) s += part[(ww * 64 + tl) * 49 + j];
            lgl[tl * 37 + j] = s;
        }
    }
    __syncthreads();
    if (tid < 64) {
        const int tl = tid, tk = chunk * 64 + tl;
        float sq = 0.f;
#pragma unroll
        for (int ww = 0; ww < 8; ++ww) sq += ssql[ww * 64 + tl];
        const float rstd = rsqrtf(sq * (1.0f / 1024.0f) + EPS);
        float lg[36];
#pragma unroll
        for (int j = 0; j < 36; ++j) lg[j] = lgl[tl * 37 + j] * rstd;
        float g0 = lg[0] + bg[0], g1 = lg[1] + bg[1], g2 = lg[2] + bg[2], g3 = lg[3] + bg[3];
        int gs = 0; float gm = g0;
        if (g1 > gm) { gm = g1; gs = 1; } if (g2 > gm) { gm = g2; gs = 2; } if (g3 > gm) { gm = g3; gs = 3; }
        const float gden = __expf(g0 - gm) + __expf(g1 - gm) + __expf(g2 - gm) + __expf(g3 - gm);
        const float ggate = 1.0f / gden;
        float ev[8];
#pragma unroll
        for (int j = 0; j < 8; ++j) {
            const float a0 = lg[4 + j] + be[j], a1 = lg[12 + j] + be[8 + j], a2 = lg[20 + j] + be[16 + j], a3 = lg[28 + j] + be[24 + j];
            ev[j] = gs == 0 ? a0 : gs == 1 ? a1 : gs == 2 ? a2 : a3;
        }
        int i0 = 0; float v0 = ev[0];
#pragma unroll
        for (int j = 1; j < 8; ++j) if (ev[j] > v0) { v0 = ev[j]; i0 = j; }
        int i1 = -1; float v1 = -3.0e38f;
#pragma unroll
        for (int j = 0; j < 8; ++j) if (j != i0 && ev[j] > v1) { v1 = ev[j]; i1 = j; }
        const float e1 = __expf(v1 - v0), sden = 1.0f / (1.0f + e1);
        const int ea = gs * 8 + i0, eb = gs * 8 + i1;
        sel[2 * tl] = ea; posl[2 * tl] = atomicAdd(&cntl[ea], 1);
        sel[2 * tl + 1] = eb; posl[2 * tl + 1] = atomicAdd(&cntl[eb], 1);
        WT[2 * tk] = ggate * sden; WT[2 * tk + 1] = ggate * e1 * sden;
        RSTD[tk] = rstd; rsl[tl] = rstd;
    }
    __syncthreads();
    if (tid < 32) { const int c = cntl[tid]; basel[tid] = (ALT && DUPSEL == 1) ? chunk * 4 : (c > 0 ? atomicAdd(&CNT[tid * CNT_STRIDE], c) : 0); }
    __syncthreads();
    if (tid < 128) { const int e = sel[tid]; const size_t li = (size_t)e * NTOK + basel[e] + posl[tid]; LIST[li] = 128 * chunk + tid; RP[li] = rsl[tid >> 1]; }
}

template <bool ALT>
__device__ __forceinline__ void route_phase(const Params& p, const int layer, const int bid, const int nb, const int wv) {
    const int tid = hidden_tid(wv), lane = tid & 63, w = tid >> 6, fr = lane & 15, fq = lane >> 4;
    float* part = (float*)shm;
    float* ssql = part + 8 * 64 * 49;
    float* lgl = ssql + 8 * 64;
    int* cntl = (int*)((char*)shm + LDS_ROUTE);
    int* basel = cntl + 32;
    int* sel = basel + 32;
    int* posl = sel + 128;
    float* rsl = (float*)(posl + 128);
    float* WT = (float*)(p.ws + (ALT ? WS_ACT + (size_t)4 * 1024 * 1024 : WS_WT));
    float* RSTD = (float*)(p.ws + (ALT ? WS_ACT + (size_t)5 * 1024 * 1024 : WS_RSTD));
    int* LIST = (int*)(p.ws + (ALT ? WS_ACT : WS_LIST));
    float* RP = (float*)(p.ws + (ALT ? WS_ACT + (size_t)2 * 1024 * 1024 : WS_RP));
    int* CNT = (int*)(p.ws + WS_CNT) + (layer + (ALT ? 4 : 0)) * NEXP * CNT_STRIDE;
    const float* bg = p.in[26] + layer * 4; const float* be = p.in[28] + layer * NEXP;
    const char* const Xc = (const char*)(p.ws + WS_XB);
    const char* const Whc = (const char*)(p.ws + WS_WRT) + (size_t)layer * 2 * 48 * 1024 * 2; const char* const Wlc = Whc + 48 * 1024 * 2;
    for (int chunk = bid; chunk < NTOK / 64; chunk += nb) {
        __syncthreads();
        if (tid < 32) cntl[tid] = 0;
        const unsigned xoff = (unsigned)(((chunk * 64 + fr) * D + w * 128 + fq * 8) * 2), woff = (unsigned)((fr * 1024 + w * 128 + fq * 8) * 2);
        f32x4 acc[4][3];
#pragma unroll
        for (int mt = 0; mt < 4; ++mt)
#pragma unroll
            for (int nt = 0; nt < 3; ++nt) acc[mt][nt] = (f32x4){0.f, 0.f, 0.f, 0.f};
        float ssq[4] = {0.f, 0.f, 0.f, 0.f};
        u32x4 xa[4][4]; bf16x8 Bh[2][3], Bl[2][3];
#pragma unroll
        for (int st = 0; st < 4; ++st)
#pragma unroll
            for (int mt = 0; mt < 4; ++mt) xa[st][mt] = *(const u32x4*)(Xc + (xoff + (unsigned)(mt * 16 * D * 2 + st * 64)));
#pragma unroll
        for (int nt = 0; nt < 3; ++nt) { Bh[0][nt] = *(const bf16x8*)(Whc + (woff + (unsigned)(nt * 16 * 2048))); Bl[0][nt] = *(const bf16x8*)(Wlc + (woff + (unsigned)(nt * 16 * 2048))); }
#pragma unroll
        for (int st = 0; st < 4; ++st) {
            if (st < 3) {
#pragma unroll
                for (int nt = 0; nt < 3; ++nt) { Bh[(st + 1) & 1][nt] = *(const bf16x8*)(Whc + (woff + (unsigned)(nt * 16 * 2048 + (st + 1) * 64))); Bl[(st + 1) & 1][nt] = *(const bf16x8*)(Wlc + (woff + (unsigned)(nt * 16 * 2048 + (st + 1) * 64))); }
            }
#pragma unroll
            for (int mt = 0; mt < 4; ++mt) {
                const u32x4 xb = xa[st][mt];
                const f32x4 x0 = {bflo(xb.x), bfhi(xb.x), bflo(xb.y), bfhi(xb.y)}, x1 = {bflo(xb.z), bfhi(xb.z), bflo(xb.w), bfhi(xb.w)};
                ssq[mt] += x0[0] * x0[0] + x0[1] * x0[1] + x0[2] * x0[2] + x0[3] * x0[3] + x1[0] * x1[0] + x1[1] * x1[1] + x1[2] * x1[2] + x1[3] * x1[3];
                const bf16x8 Ah = __builtin_bit_cast(bf16x8, xb);
#pragma unroll
                for (int nt = 0; nt < 3; ++nt) {
                    acc[mt][nt] = __builtin_amdgcn_mfma_f32_16x16x32_bf16(Ah, Bh[st & 1][nt], acc[mt][nt], 0, 0, 0);
                    acc[mt][nt] = __builtin_amdgcn_mfma_f32_16x16x32_bf16(Ah, Bl[st & 1][nt], acc[mt][nt], 0, 0, 0);
                }
            }
            __builtin_amdgcn_sched_barrier(0);
        }
        route_tail<ALT>(p, layer, chunk, acc, ssq, wv);
    }
}

constexpr int GOR_PITCH = 1040;
template <bool ALT>
__device__ __forceinline__ void gor_phase(const Params& p, const int layer, const int bid, const int nb, const int wv) {
    const int tid = hidden_tid(wv), lane = tid & 63, w = tid >> 6, fr = lane & 15, fq = lane >> 4;
    char* const lds = (char*)shm;
    int* cntl = (int*)((char*)shm + LDS_ROUTE);
    const bf16_t* OXp = (const bf16_t*)(p.ws + WS_OX);
    bf16_t* XB = (bf16_t*)(p.ws + WS_XB);
    const char* const Wo = (const char*)(p.ws + WS_W_CO) + (size_t)layer * 1024 * 512 * 2;
    const char* const Whc = (const char*)(p.ws + WS_WRT) + (size_t)layer * 2 * 48 * 1024 * 2; const char* const Wlc = Whc + 48 * 1024 * 2;
    for (int chunk = bid; chunk < NTOK / 64; chunk += nb) {
        const int r0 = chunk * 64;
        __syncthreads();
        if (tid < 32) cntl[tid] = 0;
        {
            u32x4 v[8];
#pragma unroll
            for (int i = 0; i < 8; ++i) { const int pc = tid + i * NT; v[i] = *(const u32x4*)(OXp + (size_t)(r0 + (pc >> 6)) * 512 + (pc & 63) * 8); }
#pragma unroll
            for (int i = 0; i < 8; ++i) { const int pc = tid + i * NT; *(u32x4*)(lds + (pc >> 6) * GOR_PITCH + (pc & 63) * 16) = v[i]; }
        }
        __syncthreads();
        f32x4 accr[4][3];
#pragma unroll
        for (int mt = 0; mt < 4; ++mt)
#pragma unroll
            for (int nt = 0; nt < 3; ++nt) accr[mt][nt] = (f32x4){0.f, 0.f, 0.f, 0.f};
        float ssq[4] = {0.f, 0.f, 0.f, 0.f};
        const int aoffl = fr * GOR_PITCH + fq * 16;
        const int kst = (bid >> 3) & 15;
#pragma unroll 1
        for (int half = 0; half < 2; ++half) {
            const int cb = w * 128 + half * 64;
            const unsigned boff = (unsigned)((cb >> 4) * 16 * 1024 + lane * 16);
            const unsigned woff = (unsigned)((fr * 1024 + cb + fq * 8) * 2);
            f32x4 acc[4][4];
#pragma unroll
            for (int i = 0; i < 4; ++i)
#pragma unroll
                for (int j = 0; j < 4; ++j) acc[i][j] = (f32x4){0.f, 0.f, 0.f, 0.f};
            bf16x8 Bq[4][4];
#define GOR_LDB(s_) do { _Pragma("unroll") for (int j = 0; j < 4; ++j) Bq[(s_) & 3][j] = *(const bf16x8*)(Wo + (boff + (unsigned)(j * 16 * 1024 + (((s_) + kst) & 15) * 1024))); } while (0)
            GOR_LDB(0); GOR_LDB(1); GOR_LDB(2);
            u32x2 xres[4][4];
            bf16x8 Wh[2][3], Wl[2][3];
#pragma unroll
            for (int s = 0; s < 16; ++s) {
                if (s + 3 < 16) GOR_LDB(s + 3);
                if (s == 15) {
#pragma unroll
                    for (int i = 0; i < 4; ++i)
#pragma unroll
                        for (int j = 0; j < 4; ++j) xres[i][j] = *(const u32x2*)(XB + (size_t)(r0 + 16 * i + fr) * D + cb + 16 * j + 4 * fq);
                }
                bf16x8 Af[4];
#pragma unroll
                for (int i = 0; i < 4; ++i) Af[i] = *(const bf16x8*)(lds + aoffl + i * 16 * GOR_PITCH + ((s + kst) & 15) * 64);
#pragma unroll
                for (int j = 0; j < 4; ++j)
#pragma unroll
                    for (int i = 0; i < 4; ++i) acc[i][j] = __builtin_amdgcn_mfma_f32_16x16x32_bf16(Bq[s & 3][j], Af[i], acc[i][j], 0, 0, 0);
                __builtin_amdgcn_sched_barrier(0);
            }
#undef GOR_LDB
#pragma unroll
            for (int pp = 0; pp < 2; ++pp)
#pragma unroll
                for (int nt = 0; nt < 3; ++nt) { Wh[pp][nt] = *(const bf16x8*)(Whc + (woff + (unsigned)(nt * 16 * 2048 + pp * 64))); Wl[pp][nt] = *(const bf16x8*)(Wlc + (woff + (unsigned)(nt * 16 * 2048 + pp * 64))); }
#pragma unroll
            for (int i = 0; i < 4; ++i) {
                bf16_t* qb = XB + (size_t)(r0 + 16 * i + fr) * D + cb + 4 * fq;
                unsigned pk[4][2];
#pragma unroll
                for (int j = 0; j < 4; ++j) {
                    const u32x2 x = xres[i][j];
                    const f32x4 t = (f32x4){bflo(x.x), bfhi(x.x), bflo(x.y), bfhi(x.y)} + acc[i][j];
                    const unsigned a0 = cvt_pk_bf16(t[0], t[1]), a1 = cvt_pk_bf16(t[2], t[3]);
                    *(u32x2*)(qb + 16 * j) = (u32x2){a0, a1};
                    const float r0f = bflo(a0), r1f = bfhi(a0), r2f = bflo(a1), r3f = bfhi(a1);
                    ssq[i] += (r0f * r0f + r1f * r1f) + (r2f * r2f + r3f * r3f);
                    pk[j][0] = a0; pk[j][1] = a1;
                }
#pragma unroll
                for (int pp = 0; pp < 2; ++pp) {
                    const bf16x8 Ah = __builtin_bit_cast(bf16x8, (u32x4){pk[2 * pp][0], pk[2 * pp][1], pk[2 * pp + 1][0], pk[2 * pp + 1][1]});
#pragma unroll
                    for (int nt = 0; nt < 3; ++nt) {
                        accr[i][nt] = __builtin_amdgcn_mfma_f32_16x16x32_bf16(Ah, Wh[pp][nt], accr[i][nt], 0, 0, 0);
                        accr[i][nt] = __builtin_amdgcn_mfma_f32_16x16x32_bf16(Ah, Wl[pp][nt], accr[i][nt], 0, 0, 0);
                    }
                }
            }
        }
        __syncthreads();
        route_tail<ALT>(p, layer, chunk, accr, ssq, wv);
    }
}

template <int MODE>
__device__ __forceinline__ void cvt_job(const float* __restrict__ src, bf16_t* __restrict__ dst, const int K, const int N, const int nmat,
                                        const size_t dst_mat_stride, const int bid, const int nb, const int wv, const float* __restrict__ kgain = nullptr, const int gshift = 0) {
    float* T = (float*)shm;
    const int tid = hidden_tid(wv);
    const int tk = K / 128, tn = N / 128, per = tk * tn, total = per * nmat;
    f32x4 v[8];
#define CVT_LOAD(t_) do { const int mat_ = (t_) / per, r_ = (t_) % per, k0_ = (r_ / tn) * 128, n0_ = (r_ % tn) * 128; \
        const float* s_ = src + (size_t)mat_ * K * N + (size_t)k0_ * N + n0_; \
        _Pragma("unroll") for (int i = 0; i < 8; ++i) v[i] = *(const f32x4*)(s_ + (size_t)((tid >> 5) + 16 * i) * N + (tid & 31) * 4); } while (0)
    if (bid < total) CVT_LOAD(bid);
    for (int t = bid; t < total; t += nb) {
        const int mat = t / per, r = t % per, k0 = (r / tn) * 128, n0 = (r % tn) * 128;
        bf16_t* d = dst + (size_t)mat * dst_mat_stride;
        if (kgain) {
#pragma unroll
            for (int i = 0; i < 8; ++i) v[i] *= kgain[(size_t)(mat >> gshift) * D + k0 + (tid >> 5) + 16 * i];
        }
        __syncthreads();
#pragma unroll
        for (int i = 0; i < 8; ++i) {
            float* q = T + ((tid >> 5) + 16 * i) * 129 + (tid & 31) * 4;
            q[0] = v[i][0]; q[1] = v[i][1]; q[2] = v[i][2]; q[3] = v[i][3];
        }
        __syncthreads();
        if (t + nb < total) CVT_LOAD(t + nb);
#pragma unroll
        for (int j = 0; j < 4; ++j) {
            const int n = (tid >> 4) + 32 * j, kc = (tid & 15) * 8;
            float e[8];
#pragma unroll
            for (int jj = 0; jj < 8; ++jj) e[jj] = T[(kc + jj) * 129 + n];
            u32x4 ov; ov.x = cvt_pk_bf16(e[0], e[1]); ov.y = cvt_pk_bf16(e[2], e[3]); ov.z = cvt_pk_bf16(e[4], e[5]); ov.w = cvt_pk_bf16(e[6], e[7]);
            const int ng = n0 + n;
            if (MODE == 3) {
                const int kk = k0 + kc;
                *(u32x4*)(d + ((size_t)((ng >> 4) * (K >> 5) + (kk >> 5)) * 64 + ((kk >> 3) & 3) * 16 + (ng & 15)) * 8) = ov;
            } else {
            const int row = (MODE == 0) ? ng : ((ng >> 4) * 32 + (ng & 15) + (MODE == 2 ? 16 : 0));
            *(u32x4*)(d + (size_t)row * K + k0 + kc) = ov;
            }
        }
    }
#undef CVT_LOAD
}

__device__ __forceinline__ void prologue0(const Params& p, const int bid, const int nb, const int wv) {
    unsigned char* ws = p.ws;
    cvt_job<0>(p.in[3], (bf16_t*)(ws + WS_W_EIN), 1024, 3072, 2, (size_t)3072 * 1024, bid, nb, wv, p.in[2]);
    cvt_job<0>(p.in[15], (bf16_t*)(ws + WS_W_EOUT), 1024, 1024, 2, (size_t)1024 * 1024, bid, nb, wv);
    cvt_job<0>(p.in[17], (bf16_t*)(ws + WS_W_OIN), 1024, 1536, 2, (size_t)1536 * 1024, bid, nb, wv, p.in[16]);
    cvt_job<0>(p.in[19], (bf16_t*)(ws + WS_W_OOUT), 1024, 1024, 2, (size_t)1024 * 1024, bid, nb, wv);
    cvt_job<0>(p.in[21], (bf16_t*)(ws + WS_W_CQ), 1024, 512, 4, (size_t)512 * 1024, bid, nb, wv, p.in[20]);
    cvt_job<0>(p.in[22], (bf16_t*)(ws + WS_W_CKV), 1024, 1024, 4, (size_t)1024 * 1024, bid, nb, wv);
    cvt_job<3>(p.in[23], (bf16_t*)(ws + WS_W_CO), 512, 1024, 4, (size_t)1024 * 512, bid, nb, wv);
    cvt_job<1>(p.in[29], (bf16_t*)(ws + WS_W_GU), 1024, 512, 128, (size_t)1024 * 1024, bid, nb, wv, p.in[24], 5);
    cvt_job<2>(p.in[30], (bf16_t*)(ws + WS_W_GU), 1024, 512, 128, (size_t)1024 * 1024, bid, nb, wv, p.in[24], 5);
    cvt_job<0>(p.in[31], (bf16_t*)(ws + WS_W_DN), 512, 1024, 128, (size_t)1024 * 512, bid, nb, wv);
    const int tid = hidden_tid(wv), lane = tid & 63, w = tid >> 6;
    {
        Row16 g; ld_row(g, p.in[32], lane);
        bf16_t* MN = (bf16_t*)(ws + WS_MEMN);
        for (int r = bid * 8 + w; r < Bb * MEM; r += nb * 8) {
            Row16 x; ld_row(x, p.in[1] + (size_t)r * D, lane);
            const float rstd = row_rstd(x, lane);
#pragma unroll
            for (int i = 0; i < 4; ++i) st_bf16x4(MN + (size_t)r * D + 256 * i + 4 * lane, x.v[i] * rstd * g.v[i]);
        }
    }
    {
        float* A2 = (float*)(ws + WS_A2);
        for (int r = bid * 8 + w; r < 2 * S; r += nb * 8) {
            const int lj = r / S, pos = r % S;
            const float* w1 = p.in[6] + (size_t)lj * 33 * 64; const float* b1 = p.in[7] + lj * 64;
            const float* w2 = p.in[8] + (size_t)lj * 64 * 64; const float* b2 = p.in[9] + lj * 64;
            const float fr_ = p.in[11][lj * 64 + lane];
            float a = ((float)pos / 2047.0f) * w1[lane];
#pragma unroll 1
            for (int k = 0; k < 16; ++k) {
                const float band = 1e-4f + (float)k * ((15.0f - 1e-4f) / 15.0f);
                const float ang = band * (6.283185307179586f * (float)pos / 2048.0f);
                a += cosf(ang) * w1[(1 + k) * 64 + lane] - sinf(ang) * w1[(17 + k) * 64 + lane];
            }
            const float a1 = sinf(fr_ * (a + b1[lane]));
            float a2 = 0.f;
#pragma unroll 1
            for (int i = 0; i < 64; ++i) a2 += shl(a1, i) * w2[i * 64 + lane];
            A2[(size_t)r * 64 + lane] = sinf(fr_ * (a2 + b2[lane]));
        }
    }
    {
        bf16_t* WR = (bf16_t*)(ws + WS_WRT);
        for (int i = bid * NT + tid; i < 4 * 48 * 1024; i += nb * NT) {
            const int l = i / (48 * 1024), r = i % (48 * 1024), j = r >> 10, kp = r & 1023;
            const int k = (kp & ~31) + (((kp & 7) < 4) ? 4 * ((kp >> 3) & 3) + (kp & 7) : 16 + 4 * ((kp >> 3) & 3) + (kp & 7) - 4);
            float v = 0.f;
            if (j < 4) v = p.in[25][((size_t)l * D + k) * 4 + j]; else if (j < 36) v = p.in[27][((size_t)l * D + k) * NEXP + (j - 4)];
            v *= p.in[24][(size_t)l * D + k];
            const unsigned h = cvt_pk_bf16(v, 0.f) & 0xffffu;
            const unsigned lo = cvt_pk_bf16(v - bflo(h), 0.f) & 0xffffu;
            WR[(size_t)l * 2 * 48 * 1024 + r] = (bf16_t)h; WR[(size_t)l * 2 * 48 * 1024 + 48 * 1024 + r] = (bf16_t)lo;
        }
    }
    if (bid == 0) {
        if (tid < 2) {
            const float* lm = p.in[13] + (size_t)tid * 4 * 64;
            float s01 = 0.f, s23 = 0.f;
            for (int i = 0; i < 64; ++i) { s01 += lm[i] * lm[64 + i]; s23 += lm[128 + i] * lm[192 + i]; }
            const float lam_init = 0.8f - 0.6f * expf(-0.3f * (float)(2 * tid));
            ((float*)(ws + WS_MISC))[tid] = expf(s01) - expf(s23) + lam_init;
            ((float*)(ws + WS_MISC))[2 + tid] = 1.0f - lam_init;
        }
        bf16_t* hz = (bf16_t*)(ws + WS_XB) + (size_t)NTOK * D; bf16_t* az = (bf16_t*)(ws + WS_ACT) + (size_t)2 * NTOK * EH;
        for (int i = tid; i < D; i += NT) hz[i] = 0;
        for (int i = tid; i < EH; i += NT) az[i] = 0;
    }
}

__device__ __forceinline__ void filter_taps(const Params& p, const int bid, const int nb, const int wv) {
    const int tid = hidden_tid(wv), w = tid >> 6, lane = tid & 63, fr = lane & 15, fq = lane >> 4;
    const float* A2 = (const float*)(p.ws + WS_A2);
    bf16_t* FL = (bf16_t*)(p.ws + WS_FILT);
    const float mind = logf(1e-2f) / 1.5f, maxd = logf(1e-2f) / 0.3f;
    for (int job = bid; job < 2 * 4 * 8 * 32; job += nb) {
        const int pt = job & 31, ct = (job >> 5) & 7, od = (job >> 8) & 3, lj = job >> 10;
        const int pos0 = pt * 64 + (w >> 2) * 32, ch0 = ct * 64 + (w & 3) * 16, order = od >> 1, dir = od & 1;
        const float* w3 = p.in[10] + (size_t)lj * 64 * 2048 + od * 512 + ch0 + fr;
        bf16x8 Af[2], Bf[2][2];
#pragma unroll
        for (int ks = 0; ks < 2; ++ks) {
            float e[8];
#pragma unroll
            for (int jj = 0; jj < 8; ++jj) e[jj] = w3[(size_t)(ks * 32 + fq * 8 + jj) * 2048];
            u32x4 pk; pk.x = cvt_pk_bf16(e[0], e[1]); pk.y = cvt_pk_bf16(e[2], e[3]); pk.z = cvt_pk_bf16(e[4], e[5]); pk.w = cvt_pk_bf16(e[6], e[7]);
            Af[ks] = __builtin_bit_cast(bf16x8, pk);
#pragma unroll
            for (int nt = 0; nt < 2; ++nt) {
                const float* ap = A2 + ((size_t)lj * S + pos0 + nt * 16 + fr) * 64 + ks * 32 + fq * 8;
                const f32x4 v0 = *(const f32x4*)ap, v1 = *(const f32x4*)(ap + 4);
                u32x4 pb; pb.x = cvt_pk_bf16(v0[0], v0[1]); pb.y = cvt_pk_bf16(v0[2], v0[3]); pb.z = cvt_pk_bf16(v1[0], v1[1]); pb.w = cvt_pk_bf16(v1[2], v1[3]);
                Bf[nt][ks] = __builtin_bit_cast(bf16x8, pb);
            }
        }
#pragma unroll
        for (int nt = 0; nt < 2; ++nt) {
            f32x4 acc = {0.f, 0.f, 0.f, 0.f};
            acc = __builtin_amdgcn_mfma_f32_16x16x32_bf16(Af[0], Bf[nt][0], acc, 0, 0, 0);
            acc = __builtin_amdgcn_mfma_f32_16x16x32_bf16(Af[1], Bf[nt][1], acc, 0, 0, 0);
            const int pos = pos0 + nt * 16 + fr;
            const float tpos = (float)pos / 2047.0f;
#pragma unroll
            for (int r = 0; r < 4; ++r) {
                const int ch = ch0 + fq * 4 + r;
                const float delta = mind + (float)ch * ((maxd - mind) / 511.0f);
                const float v = acc[r] * __builtin_amdgcn_exp2f(-tpos * fabsf(delta) * 1.4426950408889634f);
                bf16_t* f = FL + ((size_t)(lj * 2 + order) * 512 + ch) * 4096;
                const unsigned short hv = (unsigned short)(cvt_pk_bf16(v, 0.f) & 0xffff);
                if (dir == 0) f[2047 - pos] = hv;
                else { if (pos >= 1) f[2047 + pos] = hv; if (pos == 2047) f[4095] = 0; }
            }
        }
    }
}

enum { PH_P0 = 0, PH_P1, PH_N1, PH_GIN, PH_MIX, PH_GOUT, PH_N2, PH_GQ, PH_XATT, PH_GO, PH_ROUTE, PH_G1, PH_G2, PH_FINAL, PH_TR, PH_GOR, PH_COUNT };

template <class Epi>
__device__ __forceinline__ void gemm_dense(const bf16_t* A, const bf16_t* Bt, const int K, const int nM, const int nN, Epi epi, const int bid, const int nb, const int wv, const int ntl = 0) {
    for (int u = bid; u < nM * nN; u += nb) {
        const int pm = u / nN, pn = u % nN;
        epi.brow = pm * 256;
        gemm_tile(A + (size_t)pm * 256 * K, Bt, K, pn * 256, RowIdent{}, epi, wv, ntl);
    }
}

typedef const __attribute__((address_space(4))) Params* ParamsK;
#define PHASE_FN __forceinline__
template <int PH, bool ALT = false>
__device__ PHASE_FN void run_phase(ParamsK pk_, const int layer, const int bid_, const int nb_, const int wv_) {
    ParamsK pk = pk_; asm volatile("" : "+s"(pk));
    int bid = bid_, nb = nb_, wv = wv_; asm volatile("" : "+s"(bid), "+s"(nb), "+s"(wv));
    const Params& p = *(const Params*)pk;
    unsigned char* ws = p.ws;
    const int lj = layer >> 1; const bool even = (layer & 1) == 0;
    bf16_t* H = (bf16_t*)(ws + WS_H);
    float* X = (float*)(ws + WS_X);
    bf16_t* YMIX = (bf16_t*)(ws + WS_YMIX);
    bf16_t* QX = (bf16_t*)(ws + WS_QX);
    bf16_t* OX = (bf16_t*)(ws + WS_OX);
    if constexpr (PH == PH_P0) { prologue0(p, bid, nb, wv); }
    if constexpr (PH == PH_N1) {
        norm_phase<0, ALT>(p, layer, nullptr, bid, nb, wv);
        if (layer == 0 && !ALT) filter_taps(p, bid, nb, wv);
    }
    if constexpr (PH == PH_GIN) {
        const bf16_t* XBc = (const bf16_t*)(ws + WS_XB); const float* RS1 = (const float*)(ws + WS_RS1);
        if (ALT && DUPSEL >= 1) {
            int fl = bid; asm volatile("" : "+s"(fl));
            EpiNull e{(float*)(ws + WS_X), fl == 0x7fffffff, 0};
            gemm_dense(XBc, (const bf16_t*)(ws + (even ? WS_W_EIN : WS_W_OIN)) + (size_t)lj * (even ? 3072 : 1536) * 1024, 1024, 64, even ? 12 : 6, e, bid, nb, wv, DUPSEL == 2 ? 8 : 0);
        } else if (even) {
            EpiSplit e{(bf16_t*)(ws + WS_PROJ + PR_HYT), (bf16_t*)(ws + WS_PROJ + PR_QK), (bf16_t*)(ws + WS_PROJ + PR_VT), 1536, 2560, 1024, (size_t)NTOK, 0, RS1};
            gemm_dense(XBc, (const bf16_t*)(ws + WS_W_EIN) + (size_t)lj * 3072 * 1024, 1024, 64, 12, e, bid, nb, wv);
        } else {
            EpiSplit e{nullptr, (bf16_t*)(ws + WS_PROJ), (bf16_t*)(ws + WS_PROJ + PR_OVT), 0, 1280, 1280, (size_t)NTOK, 0, RS1};
            gemm_dense(XBc, (const bf16_t*)(ws + WS_W_OIN) + (size_t)lj * 1536 * 1024, 1024, 64, 6, e, bid, nb, wv);
        }
    }
    if constexpr (PH == PH_MIX) {
        if (even) {
            const bf16_t* qk = (const bf16_t*)(ws + WS_PROJ + PR_QK);
            const bf16_t* vT = (const bf16_t*)(ws + WS_PROJ + PR_VT);
            const float lam = uni(((const float*)(ws + WS_MISC))[lj]);
            const float oscale = uni(((const float*)(ws + WS_MISC))[2 + lj]);
            for (int u = bid + ((ALT && (DUPSEL == 4 || DUPSEL >= 7)) ? 512 : 0); u < ((ALT && (DUPSEL == 3 || DUPSEL == 5 || DUPSEL == 6)) ? 512 : 1024); u += nb) {
                if (u < 512) hyena_unit<ALT>(p, lj, u, wv);
                else {
                    const int id = u - 512, b = id >> 6, h = (id >> 4) & 3, qb = id & 15;
                    attn_unit<0, ALT>(qk + (size_t)(b * S) * 1024 + 2 * h * 64, 1024, qk + (size_t)(b * S) * 1024 + 512 + 2 * h * 64, 1024,
                                 vT + (size_t)(h * 128) * NTOK + b * S, (size_t)NTOK, qb * 128, 0, S,
                                 0.125f, uni(exp2f(-2.0f * (float)(h + 1))), -1e30f, 0.f,
                                 (ALT ? (bf16_t*)(ws + WS_Y) : YMIX) + (size_t)(b * S) * D + 512 + h * 128, D, lam, oscale, p.in[14] + (size_t)lj * 128, wv);
                }
            }
        } else {
            const bf16_t* qk = (const bf16_t*)(ws + WS_PROJ);
            const bf16_t* vT = (const bf16_t*)(ws + WS_PROJ + PR_OVT);
            for (int u = bid; u < 1024; u += nb) {
                const int b = u >> 7, kv = (u >> 5) & 3, qb = u & 31, q0 = qb * 64;
                const int kbeg = q0 - 128 < 0 ? 0 : q0 - 128, kend = q0 + 192 > S ? S : q0 + 192;
                attn2_unit<1>(qk + (size_t)(b * S) * 1280 + kv * 256, 1280, qk + (size_t)(b * S) * 1280 + 1024 + kv * 64, 1280,
                              vT + (size_t)(kv * 64) * NTOK + b * S, (size_t)NTOK, q0, kbeg, kend,
                              0.125f, p.in[18] + lj * 16 + kv * 4, kv * 4, YMIX + (size_t)(b * S) * D + kv * 256, D, wv);
            }
        }
    }
    if constexpr (PH == PH_TR) {
        const int tid = hidden_tid(wv);
        const bf16_t* yt = (const bf16_t*)(ws + WS_QX);
        bf16_t* T = shm;
        for (int t = bid; t < 8 * 256; t += nb) {
            const int c0 = (t & 7) * 64, tk0 = (t >> 3) * 64;
            const u32x4 v = *(const u32x4*)(yt + (size_t)(c0 + (tid >> 3)) * NTOK + tk0 + (tid & 7) * 8);
            __syncthreads();
            *(u32x4*)((char*)T + (tid >> 3) * 144 + (tid & 7) * 16) = v;
            __syncthreads();
            const int tok = tid >> 3, cg = (tid & 7) * 8;
            unsigned short e[8];
#pragma unroll
            for (int j = 0; j < 8; ++j) e[j] = T[(cg + j) * 72 + tok];
            u32x4 ov; ov.x = e[0] | ((unsigned)e[1] << 16); ov.y = e[2] | ((unsigned)e[3] << 16); ov.z = e[4] | ((unsigned)e[5] << 16); ov.w = e[6] | ((unsigned)e[7] << 16);
            *(u32x4*)(YMIX + (size_t)(tk0 + tok) * D + c0 + cg) = ov;
        }
    }
    if constexpr (PH == PH_GOUT) {
        EpiRes e{(bf16_t*)(ws + (ALT ? WS_Y : WS_XB)), 0, (float*)(ws + WS_SSP), hidden_tid(wv) & 63};
        gemm_dense(YMIX, (const bf16_t*)(ws + (even ? WS_W_EOUT : WS_W_OOUT)) + (size_t)lj * 1024 * 1024, 1024, 64, 4, e, bid, nb, wv);
    }
    if constexpr (PH == PH_GQ) {
        for (int u = bid; u < 128 + 32; u += nb) {
            if (u < 128) {
                const int pm = u >> 1, pn = u & 1;
                EpiTokRstd e{QX, 512, pm * 256, (const float*)(ws + WS_SSP), hidden_tid(wv) & 63};
                gemm_tile((const bf16_t*)(ws + WS_XB) + (size_t)pm * 256 * 1024, (const bf16_t*)(ws + WS_W_CQ) + (size_t)layer * 512 * 1024, 1024, pn * 256, RowIdent{}, e, wv);
            } else {
                const int v = u - 128, pm = v >> 2, pn = v & 3;
                EpiSplit e{nullptr, (bf16_t*)(ws + WS_XK) + (size_t)layer * 2048 * 512, (bf16_t*)(ws + WS_XVT) + (size_t)layer * 512 * 2048, 0, 512, 512, (size_t)2048, pm * 256, nullptr};
                gemm_tile((const bf16_t*)(ws + WS_MEMN) + (size_t)pm * 256 * 1024, (const bf16_t*)(ws + WS_W_CKV) + (size_t)layer * 1024 * 1024, 1024, pn * 256, RowIdent{}, e, wv);
            }
        }
    }
    if constexpr (PH == PH_XATT) {
        const bf16_t* xk = (const bf16_t*)(ws + WS_XK) + (size_t)layer * 2048 * 512;
        const bf16_t* xvt = (const bf16_t*)(ws + WS_XVT) + (size_t)layer * 512 * 2048;
        for (int u = bid; u < 256; u += nb) {
            const int b = u >> 5, h = (u >> 3) & 3, qb = u & 7;
            attn2_unit<2>(QX + (size_t)(b * S) * 512 + h * 128, 512, xk + (size_t)(b * MEM) * 512 + h * 128, 512,
                          xvt + (size_t)(h * 128) * 2048 + b * MEM, (size_t)2048, qb * 256, 0, MEM,
                          0.08838834764831845f, nullptr, 0, OX + (size_t)(b * S) * 512 + h * 128, 512, wv);
        }
    }
    if constexpr (PH == PH_GO) {
        EpiRes e{(bf16_t*)(ws + (ALT ? WS_Y : WS_XB)), 0, nullptr, hidden_tid(wv) & 63};
        gemm_dense(OX, (const bf16_t*)(ws + WS_W_CO) + (size_t)layer * 1024 * 512, 512, 64, 4, e, bid, nb, wv);
    }
    if constexpr (PH == PH_ROUTE) { route_phase<ALT>(p, layer, bid, nb, wv); }
    if constexpr (PH == PH_GOR) { gor_phase<ALT>(p, layer, bid, nb, wv); }
    if constexpr (PH == PH_G1) {
        const int* CNT = (const int*)(ws + WS_CNT) + layer * NEXP * CNT_STRIDE;
        const int* LIST = (const int*)(ws + WS_LIST);
        unsigned* head = (unsigned*)(ws + WS_QHEAD) + layer * 64;
        unsigned* done = (unsigned*)(ws + WS_DONE) + layer * 32 * 64;
        int* uq = (int*)((char*)shm + LDS_ROUTE + 1024);
        int* pre = uq + 16;
        int* cn = pre + 40;
        const int tid = hidden_tid(wv);
        __syncthreads();
        if (tid < 64) {
            const int lane = tid;
            const int c = lane < 32 ? CNT[lane * CNT_STRIDE] : 0;
            int incl = ((c + 255) >> 8) * 4;
#pragma unroll
            for (int d = 1; d < 32; d <<= 1) { const int v = __builtin_amdgcn_ds_bpermute(((lane - d) & 63) << 2, incl); if (lane >= d) incl += v; }
            if (lane < 32) { pre[lane + 1] = incl; cn[lane] = c; }
            if (lane == 0) pre[0] = 0;
        }
        typedef __attribute__((address_space(1))) unsigned gu32_t;
        unsigned nxt_v = 0u;
        if (tid == 0) nxt_v = __hip_atomic_fetch_add((gu32_t*)head, 1u, __ATOMIC_RELAXED, __HIP_MEMORY_SCOPE_AGENT);
        __syncthreads();
        const int total = __builtin_amdgcn_readfirstlane(pre[32]);
        for (;;) {
            if (tid == 0) *uq = (int)nxt_v;
            __syncthreads();
            const int uall = __builtin_amdgcn_readfirstlane(*uq);
            if (uall >= 2 * total) break;
            if (tid == 0) nxt_v = __hip_atomic_fetch_add((gu32_t*)head, 1u, __ATOMIC_RELAXED, __HIP_MEMORY_SCOPE_AGENT);
            const bool second = uall >= total;
            const int u = second ? uall - total : uall;
            int e, base, tl, cnt;
            {
                const int l5 = hidden_tid(wv) & 31;
                const int lo = pre[l5], hi = pre[l5 + 1];
                const unsigned long long bal = __builtin_amdgcn_ballot_w64(u >= lo && u < hi);
                e = __builtin_amdgcn_readfirstlane((int)__builtin_ctzll(bal));
                base = __builtin_amdgcn_readfirstlane(pre[e]); cnt = __builtin_amdgcn_readfirstlane(cn[e]); tl = (cnt + 255) >> 8;
            }
            const int r = u - base, pn = r / tl, pm = r % tl;
            const int* list = LIST + (size_t)e * NTOK;
            if (!second) {
                EpiGateUp ep{(bf16_t*)(ws + WS_ACT), list, cnt, pm * 256, (const float*)(ws + WS_RP) + (size_t)e * NTOK};
                gemm_tile((const bf16_t*)(ws + WS_XB), (const bf16_t*)(ws + WS_W_GU) + ((size_t)layer * NEXP + e) * 1024 * 1024, 1024, pn * 256, RowTok{list, cnt, pm * 256}, ep, wv);
                asm volatile("s_waitcnt vmcnt(0)" ::: "memory");
                if ((hidden_tid(wv) & 63) == 0) (void)__hip_atomic_fetch_add(done + e * 64 + pm, 1u, __ATOMIC_RELAXED, __HIP_MEMORY_SCOPE_AGENT);
            } else {
                if (tid < 64) {
                    unsigned spins = 0;
                    while ((unsigned)__builtin_amdgcn_readfirstlane(__hip_atomic_load(done + e * 64 + pm, __ATOMIC_RELAXED, __HIP_MEMORY_SCOPE_AGENT)) < 32u) {
                        __builtin_amdgcn_s_sleep(2);
                        if (++spins > (1u << 24)) break;
                    }
                    __builtin_amdgcn_fence(__ATOMIC_ACQUIRE, "agent");
                    asm volatile("s_waitcnt vmcnt(0)" ::: "memory");
                }
                __syncthreads();
                EpiDown ep{(bf16_t*)(ws + WS_Y), list, cnt, pm * 256};
                gemm_tile((const bf16_t*)(ws + WS_ACT), (const bf16_t*)(ws + WS_W_DN) + ((size_t)layer * NEXP + e) * 1024 * 512, 512, pn * 256, RowAsg{list, cnt, pm * 256}, ep, wv);
            }
        }
    }
    if constexpr (PH == PH_FINAL) { norm_phase<2>(p, DEPTH, p.in[33], bid, nb, wv); }
}

#if ONE_LAUNCH
__global__ void __launch_bounds__(NT, 2) k_mega(Params p_) {
    ParamsK p = (ParamsK)__builtin_amdgcn_kernarg_segment_ptr();
    volatile LAS unsigned* st = (volatile LAS unsigned*)((char*)shm + LDS_XB);
    if (threadIdx.x < 4) st[threadIdx.x] = 0u;
    __syncthreads();
    const XcdBarrier bar = xcd_barrier_post((unsigned*)(p->ws + WS_BAR), st);
    const int bid = blockIdx.x, nb = gridDim.x, wv = __builtin_amdgcn_readfirstlane(threadIdx.x >> 6);
    run_phase<PH_P0>(p, 0, bid, nb, wv); xcd_barrier(bar); if (DUP == PH_P0) { run_phase<PH_P0, true>(p, 0, bid, nb, wv); xcd_barrier(bar); }
#pragma unroll 1
    for (int layer = 0; layer < DEPTH; ++layer) {
        run_phase<PH_N1>(p, layer, bid, nb, wv); xcd_barrier(bar); if (DUP == PH_N1) { run_phase<PH_N1, true>(p, layer, bid, nb, wv); xcd_barrier(bar); }
        run_phase<PH_GIN>(p, layer, bid, nb, wv); xcd_barrier(bar); if (DUP == PH_GIN) { run_phase<PH_GIN, true>(p, layer, bid, nb, wv); xcd_barrier(bar); }
        run_phase<PH_MIX>(p, layer, bid, nb, wv); xcd_barrier(bar); if (DUP == PH_MIX && (DUPSEL == 0 || (DUPSEL != 2 && (layer & 1) == 0) || (DUPSEL == 2 && (layer & 1) == 1))) { run_phase<PH_MIX, true>(p, layer, bid, nb, wv); xcd_barrier(bar); }
        if ((layer & 1) == 0) { run_phase<PH_TR>(p, layer, bid, nb, wv); xcd_barrier(bar); }
        run_phase<PH_GOUT>(p, layer, bid, nb, wv); xcd_barrier(bar); if (DUP == PH_GOUT) { run_phase<PH_GOUT, true>(p, layer, bid, nb, wv); xcd_barrier(bar); }
        run_phase<PH_GQ>(p, layer, bid, nb, wv); xcd_barrier(bar); if (DUP == PH_GQ) { run_phase<PH_GQ, true>(p, layer, bid, nb, wv); xcd_barrier(bar); }
        run_phase<PH_XATT>(p, layer, bid, nb, wv); xcd_barrier(bar); if (DUP == PH_XATT) { run_phase<PH_XATT, true>(p, layer, bid, nb, wv); xcd_barrier(bar); }
        run_phase<PH_GOR>(p, layer, bid, nb, wv); xcd_barrier(bar);
        run_phase<PH_G1>(p, layer, bid, nb, wv); xcd_barrier(bar); if (DUP == PH_G1) { run_phase<PH_G1, true>(p, layer, bid, nb, wv); xcd_barrier(bar); }
    }
    run_phase<PH_FINAL>(p, DEPTH, bid, nb, wv);
}
#else
template <int PH>
__global__ void __launch_bounds__(NT, 2) k_phase(Params p_, int layer) {
    run_phase<PH>((ParamsK)__builtin_amdgcn_kernarg_segment_ptr(), layer, blockIdx.x, gridDim.x, __builtin_amdgcn_readfirstlane(threadIdx.x >> 6));
}
template <int PH> static void launch_phase(const Params& p, int layer, int grid, hipStream_t stream) {
    static bool init = false;
    if (!init) { (void)hipFuncSetAttribute((const void*)k_phase<PH>, hipFuncAttributeMaxDynamicSharedMemorySize, LDS_BYTES); init = true; }
    hipLaunchKernelGGL(k_phase<PH>, dim3(grid), dim3(NT), LDS_BYTES, stream, p, layer);
}
#endif

extern "C" void kernel_launch(void* const* d_in, const int* in_sizes, int n_in, void* d_out, int out_size, void* d_ws, size_t ws_size, hipStream_t stream) {
    if (n_in != 34 || ws_size < WS_END) { fprintf(stderr, "kernel_launch: unexpected n_in %d or ws_size %zu (need %zu)\n", n_in, ws_size, (size_t)WS_END); return; }
    Params p{};
    for (int i = 0; i < 34; ++i) p.in[i] = (const float*)d_in[i];
    p.out = (float*)d_out; p.ws = (unsigned char*)d_ws;
    (void)hipMemsetAsync(d_ws, 0, WS_ZERO_BYTES, stream);
#if ONE_LAUNCH
    static int grid = 0;
    if (grid == 0) {
        int dev = 0, cus = 0, per_cu = 0;
        (void)hipGetDevice(&dev); (void)hipDeviceGetAttribute(&cus, hipDeviceAttributeMultiprocessorCount, dev);
        (void)hipFuncSetAttribute((const void*)k_mega, hipFuncAttributeMaxDynamicSharedMemorySize, LDS_BYTES);
        (void)hipOccupancyMaxActiveBlocksPerMultiprocessor(&per_cu, (const void*)k_mega, NT, LDS_BYTES);
        (void)hipGetLastError();
        grid = cus > 0 ? cus : 256;
    }
    hipLaunchKernelGGL(k_mega, dim3(grid), dim3(NT), LDS_BYTES, stream, p);
#else
    const int grid = 256;
    launch_phase<PH_P0>(p, 0, grid, stream);
    for (int layer = 0; layer < DEPTH; ++layer) {
        launch_phase<PH_N1>(p, layer, grid, stream);
        launch_phase<PH_GIN>(p, layer, grid, stream);
        launch_phase<PH_MIX>(p, layer, grid, stream);
        if ((layer & 1) == 0) launch_phase<PH_TR>(p, layer, grid, stream);
        launch_phase<PH_GOUT>(p, layer, grid, stream);
        launch_phase<PH_GQ>(p, layer, grid, stream);
        launch_phase<PH_XATT>(p, layer, grid, stream);
        launch_phase<PH_GOR>(p, layer, grid, stream);
        launch_phase<PH_G1>(p, layer, grid, stream);
    }
    launch_phase<PH_FINAL>(p, DEPTH, grid, stream);
#endif
}
```

```cpp
#include <hip/hip_runtime.h>
#include <stdint.h>
#include <stdio.h>

#ifndef RD_N
#define RD_N 1
#endif
#ifndef RD_E
#define RD_E 1
#endif
#ifndef RD_R
#define RD_R 1
#endif
#ifndef DUP
#define DUP -1
#endif
#ifndef DUPSEL
#define DUPSEL 0
#endif
#ifndef ONE_LAUNCH
#define ONE_LAUNCH 1
#endif

typedef unsigned short bf16_t;
typedef short bf16x8 __attribute__((ext_vector_type(8)));
typedef float f32x4 __attribute__((ext_vector_type(4)));
typedef unsigned u32x4 __attribute__((ext_vector_type(4)));
typedef unsigned u32x2 __attribute__((ext_vector_type(2)));

constexpr int Bb = 8, S = 2048, D = 1024, NTOK = Bb * S, DEPTH = 4, MEM = 256;
constexpr int NEXP = 32, EH = 512;
constexpr int NT = 512;
constexpr float EPS = 1e-6f;

constexpr size_t al256(size_t x) { return (x + 255) & ~(size_t)255; }
constexpr size_t WS_BAR   = 0;
constexpr size_t WS_CNT   = 16384;
constexpr int    CNT_STRIDE = 64;
constexpr size_t WS_QHEAD = 16384 + 65536;
constexpr size_t WS_DONE  = WS_QHEAD + 4096;
constexpr size_t WS_ZERO_BYTES = WS_DONE + (size_t)4 * 32 * 64 * 4;
constexpr size_t WS_MISC  = WS_ZERO_BYTES;
constexpr size_t WS_W_EIN = 131072;
constexpr size_t WS_W_EOUT = WS_W_EIN + (size_t)2 * 3072 * 1024 * 2;
constexpr size_t WS_W_OIN = WS_W_EOUT + (size_t)2 * 1024 * 1024 * 2;
constexpr size_t WS_W_OOUT = WS_W_OIN + (size_t)2 * 1536 * 1024 * 2;
constexpr size_t WS_W_CQ  = WS_W_OOUT + (size_t)2 * 1024 * 1024 * 2;
constexpr size_t WS_W_CKV = WS_W_CQ + (size_t)4 * 512 * 1024 * 2;
constexpr size_t WS_W_CO  = WS_W_CKV + (size_t)4 * 1024 * 1024 * 2;
constexpr size_t WS_W_GU  = WS_W_CO + (size_t)4 * 1024 * 512 * 2;
constexpr size_t WS_W_DN  = WS_W_GU + (size_t)4 * 32 * 1024 * 1024 * 2;
constexpr size_t WS_MEMN  = WS_W_DN + (size_t)4 * 32 * 1024 * 512 * 2;
constexpr size_t WS_XK    = WS_MEMN + (size_t)2048 * 1024 * 2;
constexpr size_t WS_XVT   = WS_XK + (size_t)4 * 2048 * 512 * 2;
constexpr size_t WS_A2    = WS_XVT + (size_t)4 * 2048 * 512 * 2;
constexpr size_t WS_FILT  = WS_A2 + (size_t)2 * 2048 * 64 * 4;
constexpr size_t WS_X     = WS_FILT + (size_t)2 * 2 * 512 * 4096 * 2;
constexpr size_t WS_H     = WS_X + (size_t)NTOK * D * 4;
constexpr size_t WS_PROJ  = WS_H + al256((size_t)(NTOK + 1) * D * 2);
constexpr size_t WS_YMIX  = WS_PROJ + (size_t)NTOK * 3072 * 2;
constexpr size_t WS_QX    = WS_YMIX + (size_t)NTOK * D * 2;
constexpr size_t WS_OX    = WS_QX + (size_t)NTOK * 512 * 2;
constexpr size_t WS_ACT   = WS_OX + (size_t)NTOK * 512 * 2;
constexpr size_t WS_Y     = WS_ACT + al256((size_t)(2 * NTOK + 1) * EH * 2);
constexpr size_t WS_LIST  = WS_Y + (size_t)2 * NTOK * D * 2;
constexpr size_t WS_WT    = WS_LIST + (size_t)NEXP * NTOK * 4;
constexpr size_t WS_RSTD  = WS_WT + (size_t)2 * NTOK * 4;
constexpr size_t WS_WRT   = WS_RSTD + (size_t)NTOK * 4;
constexpr size_t WS_XB    = WS_WRT + (size_t)4 * 2 * 48 * 1024 * 2;
constexpr size_t WS_SSP   = WS_XB + al256((size_t)(NTOK + 1) * D * 2);
constexpr size_t WS_RS1   = WS_SSP + (size_t)NTOK * 16 * 4;
constexpr size_t WS_RP    = WS_RS1 + (size_t)NTOK * 4;
constexpr size_t WS_END   = WS_RP + (size_t)NEXP * NTOK * 4;
constexpr size_t PR_HYT   = 0;
constexpr size_t PR_QK    = (size_t)1536 * NTOK * 2;
constexpr size_t PR_VT    = PR_QK + (size_t)NTOK * 1024 * 2;
constexpr size_t PR_OVT   = (size_t)NTOK * 1280 * 2;

constexpr int LDS_XB = 147456;
constexpr int LDS_ROUTE = LDS_XB + 64;
constexpr int LDS_BYTES = LDS_ROUTE + 2048;

struct Params {
    const float* in[34];
    float* out;
    unsigned char* ws;
};

extern __shared__ __attribute__((aligned(16))) bf16_t shm[];

typedef float f32x2 __attribute__((ext_vector_type(2)));
typedef __bf16 bf16x2v __attribute__((ext_vector_type(2)));
__device__ __forceinline__ unsigned cvt_pk_bf16(float lo, float hi) { const f32x2 v = {lo, hi}; return __builtin_bit_cast(unsigned, __builtin_convertvector(v, bf16x2v)); }
__device__ __forceinline__ float bf2f(unsigned short b) { return __uint_as_float((unsigned)b << 16); }
__device__ __forceinline__ float bflo(unsigned w) { return __uint_as_float(w << 16); }
__device__ __forceinline__ float bfhi(unsigned w) { return __uint_as_float(w & 0xffff0000u); }
__device__ __forceinline__ float shx(float v, int m, int lane) { return __int_as_float(__builtin_amdgcn_ds_bpermute((lane ^ m) << 2, __float_as_int(v))); }
__device__ __forceinline__ float shl(float v, int src) { return __int_as_float(__builtin_amdgcn_ds_bpermute(src << 2, __float_as_int(v))); }
__device__ __forceinline__ float wave_sum(float v, int lane) {
    v += shx(v, 1, lane); v += shx(v, 2, lane); v += shx(v, 4, lane); v += shx(v, 8, lane); v += shx(v, 16, lane); v += shx(v, 32, lane); return v;
}

__device__ __forceinline__ float uni(float x) { return __builtin_bit_cast(float, __builtin_amdgcn_readfirstlane(__builtin_bit_cast(int, x))); }
__device__ __forceinline__ int hidden_tid(int wv) { int l; asm volatile("v_mbcnt_lo_u32_b32 %0, -1, 0\n\tv_mbcnt_hi_u32_b32 %0, -1, %0" : "=&v"(l)); return (wv << 6) | l; }

#define XB_TMO      128
#define XB_XCNT(j)  (256  + 64 * (j))
#define XB_XSUB(j)  (1280 + 64 * (j))
#define XB_XGEN(j)  (2304 + 64 * (j))
#define XB_TOP      3328
#define XB_TOPGEN   3392
#define XCD_BAR_WORDS 3456
#define XB_SPIN_CAP (1u << 22)
#define LAS __attribute__((address_space(3)))

__device__ __forceinline__ unsigned xb_ld(unsigned* p)              { return __hip_atomic_load(p, __ATOMIC_RELAXED, __HIP_MEMORY_SCOPE_AGENT); }
__device__ __forceinline__ unsigned xb_add(unsigned* p, unsigned v) { return __hip_atomic_fetch_add(p, v, __ATOMIC_RELAXED, __HIP_MEMORY_SCOPE_AGENT); }
__device__ __forceinline__ unsigned xb_xcc_id() { return (unsigned)__builtin_amdgcn_s_getreg((3 << 11) | 20) & 0xFu; }
#define XB_SPIN(cond, bar) do { unsigned _sp = 0; while (cond) { __builtin_amdgcn_s_sleep(1); \
    if ((++_sp & 255u) == 0u) { if (xb_ld(&(bar)[XB_TMO])) break; if (_sp > XB_SPIN_CAP) { atomicAdd(&(bar)[XB_TMO], 1u); break; } } } } while (0)

struct XcdBarrier { unsigned* bar; unsigned x; volatile LAS unsigned* st; };

__device__ __forceinline__ XcdBarrier xcd_barrier_post(unsigned* bar, volatile LAS unsigned* st) {
    XcdBarrier b; b.bar = bar; b.x = xb_xcc_id(); b.st = st;
    if (threadIdx.x == 0) (void)xb_add(&bar[XB_XCNT(b.x)], 1u);
    return b;
}
__device__ __forceinline__ void xcd_barrier_complete(unsigned* bar, unsigned x, unsigned& nloc, unsigned& nx) {
    const unsigned G = gridDim.x * gridDim.y * gridDim.z;
    unsigned sum, cnt, mine, sp = 0u;
    for (;;) {
        sum = 0u; cnt = 0u; mine = 0u;
#pragma unroll
        for (unsigned j = 0; j < 16; ++j) { const unsigned c = xb_ld(&bar[XB_XCNT(j)]); sum += c; cnt += (c > 0u) ? 1u : 0u; mine = (j == x) ? c : mine; }
        if (sum == G) break;
        __builtin_amdgcn_s_sleep(1);
        if ((++sp & 255u) == 0u) { if (xb_ld(&bar[XB_TMO])) break; if (sp > XB_SPIN_CAP) { atomicAdd(&bar[XB_TMO], 1u); break; } }
    }
    nloc = mine > 0u ? mine : 1u; nx = cnt > 0u ? cnt : 1u;
}
__device__ __forceinline__ void xcd_barrier(const XcdBarrier& b) {
    asm volatile("s_waitcnt vmcnt(0)" ::: "memory");
    __syncthreads();
    if (threadIdx.x == 0) {
        unsigned* bar = b.bar; unsigned bx = b.x;
        asm volatile("" : "+s"(bar), "+s"(bx));
        __builtin_amdgcn_s_waitcnt(0);
        unsigned nloc = b.st[0], nx = b.st[1];
        if (nloc == 0u) { xcd_barrier_complete(bar, bx, nloc, nx); b.st[0] = nloc; b.st[1] = nx; }
        const unsigned old = xb_add(&bar[XB_XSUB(bx)], 1u);
        const unsigned gen = old / nloc;
        if (old + 1u == (gen + 1u) * nloc) {
            __builtin_amdgcn_fence(__ATOMIC_RELEASE, "agent");
            asm volatile("s_waitcnt vmcnt(0)" ::: "memory");
            const unsigned og = xb_add(&bar[XB_TOP], 1u);
            const unsigned tg = og / nx;
            if (og + 1u == (tg + 1u) * nx) xb_add(&bar[XB_TOPGEN], 1u);
            else XB_SPIN(xb_ld(&bar[XB_TOPGEN]) == tg, bar);
            __builtin_amdgcn_fence(__ATOMIC_ACQUIRE, "agent");
            xb_add(&bar[XB_XGEN(bx)], 1u);
            asm volatile("s_waitcnt vmcnt(0)" ::: "memory");
        } else {
            XB_SPIN(xb_ld(&bar[XB_XGEN(bx)]) == gen, bar);
            __builtin_amdgcn_fence(__ATOMIC_ACQUIRE, "agent");
            asm volatile("s_waitcnt vmcnt(0)" ::: "memory");
        }
    }
    __syncthreads();
}

constexpr int HT = 128 * 64;
__device__ __forceinline__ int lds_byte(int r, int c) {
    int st = (r >> 4) * 2 + (c >> 5), rr = r & 15, cc = c & 31, ob = rr * 64 + cc * 2;
    return st * 1024 + (ob ^ (((ob >> 9) & 1) << 5));
}
__device__ __forceinline__ void stage_rc(int b, int& R, int& C) {
    int st = b / 1024, sb = b % 1024, swz = sb ^ (((sb >> 9) & 1) << 5);
    R = (st >> 1) * 16 + swz / 64; C = (st & 1) * 32 + (swz % 64) / 2;
}
#define SA(b, h) (shm + ((b) * 2 + (h)) * HT)
#define SB(b, h) (shm + (4 + (b) * 2 + (h)) * HT)
#define G_STAGE_A(P_, h, kt) do { _Pragma("unroll") for (int _i = 0; _i < 2; ++_i) \
    __builtin_amdgcn_global_load_lds((const unsigned*)((const char*)A + (size_t)((kt) * 128 + (RowSrc::DENSE ? (h) * 256 * K : 0)) + aoff[RowSrc::DENSE ? 0 : (h)][_i]), (unsigned*)((char*)(P_) + tid * 16 + _i * 8192), 16, 0, 0); } while (0)
#define G_STAGE_B(P_, h, kt) do { _Pragma("unroll") for (int _i = 0; _i < 2; ++_i) \
    __builtin_amdgcn_global_load_lds((const unsigned*)((const char*)Bt + (size_t)((kt) * 128 + (h) * 64 * K) + boff[_i]), (unsigned*)((char*)(P_) + tid * 16 + _i * 8192), 16, 0, 0); } while (0)
#define G_LDA(dst, b, h) _Pragma("unroll") for (int m = 0; m < 4; ++m) _Pragma("unroll") for (int k = 0; k < 2; ++k) \
    dst[m][k] = *reinterpret_cast<const bf16x8*>((char*)SA(b, h) + lds_byte(wr * 64 + m * 16 + fr, k * 32 + fq * 8))
#define G_LDB(dst, b, h) _Pragma("unroll") for (int n = 0; n < 2; ++n) _Pragma("unroll") for (int k = 0; k < 2; ++k) \
    dst[n][k] = *reinterpret_cast<const bf16x8*>((char*)SB(b, h) + lds_byte(wc * 32 + n * 16 + fr, k * 32 + fq * 8))
#define G_MMA(ai, bj, At_, Bt_) do { __builtin_amdgcn_s_setprio(1); \
    _Pragma("unroll") for (int m = 0; m < 4; ++m) _Pragma("unroll") for (int n = 0; n < 2; ++n) _Pragma("unroll") for (int k = 0; k < 2; ++k) \
      acc[ai][bj][m][n] = __builtin_amdgcn_mfma_f32_16x16x32_bf16(Bt_[n][k], At_[m][k], acc[ai][bj][m][n], 0, 0, 0); \
    __builtin_amdgcn_s_setprio(0); } while (0)
#define WAIT_V(n) asm volatile("s_waitcnt vmcnt(" #n ")" ::: "memory")
#define WAIT_L(n) asm volatile("s_waitcnt lgkmcnt(" #n ")" ::: "memory")
#define BAR __builtin_amdgcn_s_barrier()
#define SCHED __builtin_amdgcn_sched_barrier(0)

typedef f32x4 AccT[2][2][4][2];

template <class RowSrc, class Epi>
__device__ __forceinline__ void gemm_tile(const bf16_t* __restrict__ A, const bf16_t* __restrict__ Bt, const int K,
                                          const int bcol, const RowSrc& rs, const Epi& epi, const int wv, const int ntl = 0) {
    const int tid = hidden_tid(wv);
    int wid = tid >> 6, lane = tid & 63, wr = wid >> 2, wc = wid & 3, fr = lane & 15, fq = lane >> 4;
    unsigned aoff[2][2], boff[2];
#pragma unroll
    for (int i = 0; i < 2; ++i) {
        int R, C; stage_rc(tid * 16 + i * 8192, R, C);
        boff[i] = (unsigned)(((bcol + (R >> 5) * 64 + (R & 31)) * K + C) * 2);
        if (RowSrc::DENSE) { aoff[0][i] = (unsigned)((R * K + C) * 2); aoff[1][i] = 0u; }
        else {
#pragma unroll
            for (int h = 0; h < 2; ++h) aoff[h][i] = (unsigned)((rs(h * 128 + R) * K + C) * 2);
        }
    }
    AccT acc = {};
    bf16x8 At[4][2], B0[2][2], B1[2][2];
    const int nt = ntl ? ntl : K / 64;
    G_STAGE_B(SB(0, 0), 0, 0); G_STAGE_A(SA(0, 0), 0, 0);
    G_STAGE_B(SB(0, 1), 1, 0); G_STAGE_A(SA(0, 1), 1, 0);
    if (wr == 1) BAR;
    WAIT_V(4); BAR;
    G_STAGE_B(SB(1, 0), 0, 1); G_STAGE_A(SA(1, 0), 0, 1); G_STAGE_B(SB(1, 1), 1, 1);
    WAIT_V(6); BAR;
    for (int t = 0; t < nt - 2; t += 2) {
        G_LDB(B0, 0, 0); SCHED; G_LDA(At, 0, 0); G_STAGE_A(SA(1, 1), 1, t + 1);
        WAIT_L(8); BAR; WAIT_L(0); G_MMA(0, 0, At, B0); BAR; SCHED;
        G_LDB(B1, 0, 1); G_STAGE_B(SB(0, 0), 0, t + 2);
        BAR; WAIT_L(0); G_MMA(0, 1, At, B1); BAR;
        G_LDA(At, 0, 1); G_STAGE_A(SA(0, 0), 0, t + 2);
        BAR; WAIT_L(0); G_MMA(1, 0, At, B0); BAR; SCHED;
        G_STAGE_B(SB(0, 1), 1, t + 2);
        WAIT_V(6); BAR; G_MMA(1, 1, At, B1); BAR;
        G_LDB(B0, 1, 0); SCHED; G_LDA(At, 1, 0); G_STAGE_A(SA(0, 1), 1, t + 2);
        WAIT_L(8); BAR; WAIT_L(0); G_MMA(0, 0, At, B0); BAR; SCHED;
        G_LDB(B1, 1, 1); G_STAGE_B(SB(1, 0), 0, t + 3);
        BAR; WAIT_L(0); G_MMA(0, 1, At, B1); BAR;
        G_LDA(At, 1, 1); G_STAGE_A(SA(1, 0), 0, t + 3);
        BAR; WAIT_L(0); G_MMA(1, 0, At, B0); BAR; SCHED;
        G_STAGE_B(SB(1, 1), 1, t + 3);
        WAIT_V(6); BAR; G_MMA(1, 1, At, B1); BAR;
    }
    { G_LDB(B0, 0, 0); WAIT_V(0); G_LDA(At, 0, 0); G_STAGE_A(SA(1, 1), 1, nt - 1);
      BAR; WAIT_L(0); G_MMA(0, 0, At, B0); BAR;
      G_LDB(B1, 0, 1); BAR; WAIT_L(0); G_MMA(0, 1, At, B1); BAR;
      G_LDA(At, 0, 1); WAIT_V(4); BAR; WAIT_L(0); G_MMA(1, 0, At, B0); G_MMA(1, 1, At, B1); BAR; }
    { G_LDB(B0, 1, 0); G_LDA(At, 1, 0); WAIT_V(2); BAR; WAIT_L(0); G_MMA(0, 0, At, B0); BAR;
      G_LDB(B1, 1, 1); WAIT_V(0); BAR; WAIT_L(0); G_MMA(0, 1, At, B1); BAR;
      G_LDA(At, 1, 1); BAR; WAIT_L(0); G_MMA(1, 0, At, B0); G_MMA(1, 1, At, B1); BAR; }
    if (wr == 0) BAR;
    int tz = hidden_tid(wv); wid = tz >> 6; lane = tz & 63; wr = wid >> 2; wc = wid & 3; fr = lane & 15; fq = lane >> 4;
    epi(acc, wr * 64 + fr, bcol + wc * 64 + fq * 4);
}

struct RowIdent { static constexpr bool DENSE = true; __device__ __forceinline__ int operator()(int r) const { return r; } };

__device__ __forceinline__ void st_bf16x4(bf16_t* p, const f32x4& v) { u32x2 w; w.x = cvt_pk_bf16(v[0], v[1]); w.y = cvt_pk_bf16(v[2], v[3]); *(u32x2*)p = w; }
__device__ __forceinline__ void st_chan4(bf16_t* q, size_t ld, const f32x4& v) {
    const unsigned a = cvt_pk_bf16(v[0], v[1]), b = cvt_pk_bf16(v[2], v[3]);
    q[0] = (bf16_t)(a & 0xffff); q[ld] = (bf16_t)(a >> 16); q[2 * ld] = (bf16_t)(b & 0xffff); q[3 * ld] = (bf16_t)(b >> 16);
}
constexpr int BJS = 32;
#define EPI_LOOP_AM _Pragma("unroll") for (int ai = 0; ai < 2; ++ai) _Pragma("unroll") for (int m = 0; m < 4; ++m)
#define EPI_LOOP_BN _Pragma("unroll") for (int bj = 0; bj < 2; ++bj) _Pragma("unroll") for (int n = 0; n < 2; ++n)
struct EpiRes {
    bf16_t* XB; int brow; float* ssp; int lane;
    __device__ __forceinline__ void operator()(AccT& acc, int r0, int c0) const {
        u32x2 xv[2][4][4];
        EPI_LOOP_AM {
            const bf16_t* qb = XB + (size_t)(brow + r0 + ai * 128 + m * 16) * D + c0;
            EPI_LOOP_BN xv[ai][m][bj * 2 + n] = *(const u32x2*)(qb + bj * BJS + n * 16);
        }
        EPI_LOOP_AM {
            const int row = brow + r0 + ai * 128 + m * 16;
            bf16_t* qb = XB + (size_t)row * D + c0;
            float ss = 0.f;
            EPI_LOOP_BN {
                const u32x2 x = xv[ai][m][bj * 2 + n];
                const f32x4 t = (f32x4){bflo(x.x), bfhi(x.x), bflo(x.y), bfhi(x.y)} + acc[ai][bj][m][n];
                const unsigned a0 = cvt_pk_bf16(t[0], t[1]), a1 = cvt_pk_bf16(t[2], t[3]);
                *(u32x2*)(qb + bj * BJS + n * 16) = (u32x2){a0, a1};
                const float r0f = bflo(a0), r1f = bfhi(a0), r2f = bflo(a1), r3f = bfhi(a1);
                ss += (r0f * r0f + r1f * r1f) + (r2f * r2f + r3f * r3f);
            }
            if (ssp) { ss += shx(ss, 16, lane); ss += shx(ss, 32, lane); if ((lane >> 4) == 0) ssp[(size_t)row * 16 + (c0 >> 6)] = ss; }
        }
    }
};
struct EpiSplit {
    bf16_t* Ca; bf16_t* T; bf16_t* Cb; int c0s, c1s, ldT; size_t ldC; int brow; const float* rs;
    __device__ __forceinline__ void chan(AccT& acc, bf16_t* base, int r0, int c, const float (&scv)[2][4]) const {
        EPI_LOOP_AM { const int row = brow + r0 + ai * 128 + m * 16; const float sc = scv[ai][m];
            bf16_t* q = base + (size_t)c * ldC + row;
            EPI_LOOP_BN st_chan4(q + (size_t)(bj * BJS + n * 16) * ldC, ldC, acc[ai][bj][m][n] * sc); }
    }
    __device__ __forceinline__ void operator()(AccT& acc, int r0, int c0) const {
        const int tilec = __builtin_amdgcn_readfirstlane(c0) & ~255;
        float scv[2][4];
        EPI_LOOP_AM scv[ai][m] = rs ? rs[brow + r0 + ai * 128 + m * 16] : 1.0f;
        if (tilec < c0s) chan(acc, Ca, r0, c0, scv);
        else if (tilec < c1s) {
            EPI_LOOP_AM { const int row = brow + r0 + ai * 128 + m * 16; const float sc = scv[ai][m];
                bf16_t* q = T + (size_t)row * ldT + (c0 - c0s);
                EPI_LOOP_BN st_bf16x4(q + bj * BJS + n * 16, acc[ai][bj][m][n] * sc); }
        } else chan(acc, Cb, r0, c0 - c1s, scv);
    }
};
struct EpiTokRstd {
    bf16_t* T; int ldT, brow; const float* ssp; int lane;
    __device__ __forceinline__ void operator()(AccT& acc, int r0, int c0) const {
        f32x4 pv[2][4];
        EPI_LOOP_AM pv[ai][m] = *(const f32x4*)(ssp + (size_t)(brow + r0 + ai * 128 + m * 16) * 16 + (lane >> 4) * 4);
        EPI_LOOP_AM {
            const int row = brow + r0 + ai * 128 + m * 16;
            float ssq = (pv[ai][m][0] + pv[ai][m][1]) + (pv[ai][m][2] + pv[ai][m][3]);
            ssq += shx(ssq, 16, lane); ssq += shx(ssq, 32, lane);
            const float rs = rsqrtf(ssq * (1.0f / 1024.0f) + EPS);
            bf16_t* q = T + (size_t)row * ldT + c0;
            EPI_LOOP_BN st_bf16x4(q + bj * BJS + n * 16, acc[ai][bj][m][n] * rs);
        }
    }
};
struct EpiGateUp {
    bf16_t* act; const int* list; int cnt, pos0; const float* rp;
    __device__ __forceinline__ void operator()(AccT& acc, int r0, int c0) const {
        int av[2][4]; float rv[2][4];
        EPI_LOOP_AM { const int pos = pos0 + r0 + ai * 128 + m * 16, pc = pos < cnt ? pos : cnt - 1; av[ai][m] = list[pc]; rv[ai][m] = rp[pc]; }
        EPI_LOOP_AM {
            const int pos = pos0 + r0 + ai * 128 + m * 16;
            if (pos < cnt) {
                const int a = av[ai][m];
                const float rs = rv[ai][m];
                u32x4 ov;
#pragma unroll
                for (int bj = 0; bj < 2; ++bj) {
                    const f32x4 g = acc[ai][bj][m][0] * rs, u = acc[ai][bj][m][1] * rs; f32x4 o;
#pragma unroll
                    for (int j = 0; j < 4; ++j) o[j] = g[j] * __builtin_amdgcn_rcpf(1.0f + __builtin_amdgcn_exp2f(g[j] * -1.4426950408889634f)) * u[j];
                    if (bj == 0) { ov.x = cvt_pk_bf16(o[0], o[1]); ov.y = cvt_pk_bf16(o[2], o[3]); } else { ov.z = cvt_pk_bf16(o[0], o[1]); ov.w = cvt_pk_bf16(o[2], o[3]); }
                }
                bf16_t* dst = act + (size_t)a * EH + (c0 >> 6) * 32 + ((c0 >> 2) & 3) * 8;
                asm volatile("global_store_dwordx4 %0, %1, off sc1\n\ts_nop 1" :: "v"(dst), "v"(ov) : "memory");
            }
        }
    }
};
struct EpiDown {
    bf16_t* y; const int* list; int cnt, pos0;
    __device__ __forceinline__ void operator()(AccT& acc, int r0, int c0) const {
        int av[2][4];
        EPI_LOOP_AM { const int pos = pos0 + r0 + ai * 128 + m * 16, pc = pos < cnt ? pos : cnt - 1; av[ai][m] = list[pc]; }
        EPI_LOOP_AM {
            const int pos = pos0 + r0 + ai * 128 + m * 16;
            if (pos < cnt) { bf16_t* q = y + (size_t)av[ai][m] * D + c0; EPI_LOOP_BN st_bf16x4(q + bj * BJS + n * 16, acc[ai][bj][m][n]); }
        }
    }
};
struct EpiNull {
    float* sink; int flag; int brow;
    __device__ __forceinline__ void operator()(AccT& acc, int r0, int c0) const {
        if (flag) { f32x4 t = {0.f, 0.f, 0.f, 0.f}; EPI_LOOP_AM EPI_LOOP_BN t += acc[ai][bj][m][n]; *(f32x4*)(sink + (size_t)(brow + r0) * 4 + c0) = t; }
    }
};
struct RowTok { static constexpr bool DENSE = false; const int* list; int cnt, pos0; __device__ __forceinline__ int operator()(int r) const { const int pos = pos0 + r; return pos < cnt ? (list[pos] >> 1) : NTOK; } };
struct RowAsg { static constexpr bool DENSE = false; const int* list; int cnt, pos0; __device__ __forceinline__ int operator()(int r) const { const int pos = pos0 + r; return pos < cnt ? list[pos] : 2 * NTOK; } };

constexpr int ATT_VOFF = 16384;
template <int MODE> struct ACfg;
template <> struct ACfg<0> { static constexpr int DQK = 64, DV = 128, NMAP = 2, KBLK = 2; };
template <> struct ACfg<1> { static constexpr int DQK = 64, DV = 64, NMAP = 1, KBLK = 1; };
template <> struct ACfg<2> { static constexpr int DQK = 128, DV = 128, NMAP = 1, KBLK = 2; };

template <int MODE, bool ALT = false>
__device__ __forceinline__ void attn_unit(const bf16_t* __restrict__ Qp, const int ldq,
                                          const bf16_t* __restrict__ Kp, const int ldk,
                                          const bf16_t* __restrict__ Vt, const size_t ldvt,
                                          const int q0, const int kbeg, const int kend,
                                          const float scale, const float slope, const float m_init, const float l_init,
                                          bf16_t* __restrict__ Op, const int ldo,
                                          const float lam, const float outscale, const float* __restrict__ subln, const int wv) {
    constexpr int DQK = ACfg<MODE>::DQK, DV = ACfg<MODE>::DV, NMAP = ACfg<MODE>::NMAP, KBLK = ACfg<MODE>::KBLK;
    const int tid = hidden_tid(wv), w = tid >> 6, lane = tid & 63, fr = lane & 15, fq = lane >> 4;
    const int qrow = q0 + w * 16 + fr;
    bf16x8 Qf[NMAP][DQK / 32];
#pragma unroll
    for (int m = 0; m < NMAP; ++m)
#pragma unroll
        for (int kk = 0; kk < DQK / 32; ++kk) Qf[m][kk] = *(const bf16x8*)(Qp + (size_t)qrow * ldq + m * DQK + kk * 32 + fq * 8);
    constexpr float LOG2E = 1.4426950408889634f;
    const float scale2 = scale * LOG2E, slope2 = slope * LOG2E, kappa = slope / scale;
    f32x4 O[NMAP][DV / 16], Ol[NMAP];
    float mrun[NMAP];
#pragma unroll
    for (int m = 0; m < NMAP; ++m) {
        mrun[m] = m_init * LOG2E; Ol[m] = (f32x4){(fq == 0) ? l_init : 0.f, 0.f, 0.f, 0.f};
#pragma unroll
        for (int et = 0; et < DV / 16; ++et) O[m][et] = (f32x4){0.f, 0.f, 0.f, 0.f};
    }
    const unsigned onesw = (fr == 0) ? 0x3f803f80u : 0u;
    const bf16x8 onesf = __builtin_bit_cast(bf16x8, (u32x4){onesw, onesw, onesw, onesw});
    char* const lds = (char*)shm;
    constexpr int KN = KBLK, VN = DV / 64;
    u32x4 kreg[KN], vreg[VN];
#define ATT_LOAD(k0_) do { \
        _Pragma("unroll") for (int i_ = 0; i_ < KN; ++i_) { const int c_ = tid + i_ * NT; const int key_ = c_ / (KBLK * 8), col_ = (c_ % (KBLK * 8)) * 8; \
            kreg[i_] = *(const u32x4*)(Kp + (size_t)((k0_) + key_) * ldk + col_); } \
        _Pragma("unroll") for (int i_ = 0; i_ < VN; ++i_) { const int c_ = tid + i_ * NT; const int e_ = c_ >> 3, kc_ = c_ & 7; \
            vreg[i_] = *(const u32x4*)(Vt + (size_t)e_ * ldvt + (k0_) + kc_ * 8); } } while (0)
    ATT_LOAD(kbeg);
    const int qw0 = q0 + w * 16;
    constexpr int VBYTES = DV * 160;
    bf16x8 Pf[NMAP][2];
#define ATT_PV_C(voff_, c) do { \
            bf16x8 vf[DV / 16]; \
            _Pragma("unroll") for (int et = 0; et < DV / 16; ++et) vf[et] = *(const bf16x8*)(lds + (voff_) + (et * 16 + fr) * 160 + (c) * 64 + fq * 16); \
            _Pragma("unroll") for (int m = 0; m < NMAP; ++m) Ol[m] = __builtin_amdgcn_mfma_f32_16x16x32_bf16(onesf, Pf[m][c], Ol[m], 0, 0, 0); \
            _Pragma("unroll") for (int et = 0; et < DV / 16; ++et) \
                _Pragma("unroll") for (int m = 0; m < NMAP; ++m) O[m][et] = __builtin_amdgcn_mfma_f32_16x16x32_bf16(vf[et], Pf[m][c], O[m][et], 0, 0, 0); \
        } while (0)
    int vcur = ATT_VOFF;
    for (int k0 = kbeg; k0 < kend; k0 += 64) {
        __syncthreads();
#pragma unroll
        for (int i = 0; i < KN; ++i) { const int c = tid + i * NT; const int key = c / (KBLK * 8), col = (c % (KBLK * 8)) * 8;
            *(u32x4*)(lds + (col >> 6) * 8192 + lds_byte(key, col & 63)) = kreg[i]; }
#pragma unroll
        for (int i = 0; i < VN; ++i) { const int c = tid + i * NT; const int e = c >> 3, kc = c & 7;
            char* vd = lds + vcur + e * 160 + (kc >> 2) * 64 + (kc & 1) * 32 + ((kc >> 1) & 1) * 8;
            *(u32x2*)vd = (u32x2){vreg[i].x, vreg[i].y}; *(u32x2*)(vd + 16) = (u32x2){vreg[i].z, vreg[i].w}; }
        __syncthreads();
        if (k0 + 64 < kend) ATT_LOAD(k0 + 64);
        const int vprev = vcur ^ ATT_VOFF ^ (ATT_VOFF + VBYTES);
        const float dq = (float)(qrow - k0);
        bool gen;
        if (MODE == 2) gen = false;
        else if (MODE == 1) gen = !((k0 + 63 <= qw0 && qw0 + 15 - k0 <= 128) || (k0 >= qw0 + 15 && k0 + 63 - qw0 <= 128));
        else gen = !(k0 + 63 <= qw0 || k0 >= qw0 + 15);
        const bool pos = (MODE == 2) || (k0 + 63 <= qw0);
        f32x4 Cin[4]; float off;
        if (MODE == 2) {
#pragma unroll
            for (int t = 0; t < 4; ++t) Cin[t] = (f32x4){0.f, 0.f, 0.f, 0.f};
            off = 0.f;
        } else if (gen) {
#pragma unroll
            for (int t = 0; t < 4; ++t)
#pragma unroll
                for (int r = 0; r < 4; ++r) Cin[t][r] = -kappa * fabsf(dq - (float)(16 * t + 4 * fq + r));
            off = 0.f;
        } else {
            const float sk = pos ? kappa : -kappa, cb = sk * (float)(4 * fq);
#pragma unroll
            for (int t = 0; t < 4; ++t)
#pragma unroll
                for (int r = 0; r < 4; ++r) Cin[t][r] = sk * (float)(16 * t + r) + cb;
            off = pos ? -slope2 * dq : slope2 * dq;
        }
        f32x4 s[NMAP][4];
#pragma unroll
        for (int m = 0; m < NMAP; ++m) {
            bf16x8 kf[4][DQK / 32];
#pragma unroll
            for (int t = 0; t < 4; ++t)
#pragma unroll
                for (int kk = 0; kk < DQK / 32; ++kk) {
                    const int blk = (MODE == 2) ? (kk >> 1) : m, kcol = (MODE == 2) ? (kk & 1) * 32 : kk * 32;
                    kf[t][kk] = *(const bf16x8*)(lds + blk * 8192 + lds_byte(t * 16 + fr, kcol + fq * 8));
                }
#pragma unroll
            for (int t = 0; t < 4; ++t) {
                s[m][t] = Cin[t];
#pragma unroll
                for (int kk = 0; kk < DQK / 32; ++kk) s[m][t] = __builtin_amdgcn_mfma_f32_16x16x32_bf16(kf[t][kk], Qf[m][kk], s[m][t], 0, 0, 0);
            }
        }
        float mx[NMAP], mx1[NMAP];
#pragma unroll
        for (int m = 0; m < NMAP; ++m) {
            if (MODE == 1 && gen) {
#pragma unroll
                for (int t = 0; t < 4; ++t)
#pragma unroll
                    for (int r = 0; r < 4; ++r) s[m][t][r] = (fabsf(dq - (float)(16 * t + 4 * fq + r)) > 128.0f) ? -1e30f : s[m][t][r];
            }
            float v = fmaxf(fmaxf(s[m][0][0], s[m][0][1]), fmaxf(s[m][0][2], s[m][0][3]));
#pragma unroll
            for (int t = 1; t < 4; ++t) v = fmaxf(v, fmaxf(fmaxf(s[m][t][0], s[m][t][1]), fmaxf(s[m][t][2], s[m][t][3])));
            mx[m] = v; mx1[m] = shx(v, 16, lane);
        }
        __builtin_amdgcn_sched_barrier(0);
        if (k0 > kbeg) ATT_PV_C(vprev, 0);
        __builtin_amdgcn_sched_barrier(0);
#pragma unroll
        for (int m = 0; m < NMAP; ++m) { mx[m] = fmaxf(mx[m], mx1[m]); mx1[m] = shx(mx[m], 32, lane); }
        __builtin_amdgcn_sched_barrier(0);
        if (k0 > kbeg) ATT_PV_C(vprev, 1);
        __builtin_amdgcn_sched_barrier(0);
#pragma unroll
        for (int m = 0; m < NMAP; ++m) {
            const float mxx = fmaxf(mx[m], mx1[m]);
            const float mtile = fmaxf(mxx * scale2 + off, -1e30f);
            const float mnew = fmaxf(mrun[m], mtile), alpha = __builtin_amdgcn_exp2f(mrun[m] - mnew);
            mrun[m] = mnew;
            const float sub = off - mnew;
#pragma unroll
            for (int t = 0; t < 4; ++t)
#pragma unroll
                for (int r = 0; r < 4; ++r) s[m][t][r] = __builtin_amdgcn_exp2f(s[m][t][r] * scale2 + sub);
            if (__builtin_amdgcn_ballot_w64(alpha != 1.0f) != 0ull) {
                Ol[m] *= alpha;
#pragma unroll
                for (int et = 0; et < DV / 16; ++et) O[m][et] *= alpha;
            }
#pragma unroll
            for (int c = 0; c < 2; ++c) {
                u32x4 pk; pk.x = cvt_pk_bf16(s[m][2 * c][0], s[m][2 * c][1]); pk.y = cvt_pk_bf16(s[m][2 * c][2], s[m][2 * c][3]);
                pk.z = cvt_pk_bf16(s[m][2 * c + 1][0], s[m][2 * c + 1][1]); pk.w = cvt_pk_bf16(s[m][2 * c + 1][2], s[m][2 * c + 1][3]);
                Pf[m][c] = __builtin_bit_cast(bf16x8, pk);
            }
        }
        vcur = vprev;
    }
    { const int vlast = vcur ^ ATT_VOFF ^ (ATT_VOFF + VBYTES); ATT_PV_C(vlast, 0); ATT_PV_C(vlast, 1); }
    float linv[NMAP];
#pragma unroll
    for (int m = 0; m < NMAP; ++m) linv[m] = 1.0f / shl(Ol[m][0], fr);
    const int tid2 = hidden_tid(wv); const int qrow_o = q0 + (tid2 >> 6) * 16 + (tid2 & 15);
    if (MODE == 0) {
        float ss = 0.f;
#pragma unroll
        for (int et = 0; et < DV / 16; ++et)
#pragma unroll
            for (int r = 0; r < 4; ++r) { const float v = O[0][et][r] * linv[0] - lam * (O[NMAP - 1][et][r] * linv[NMAP - 1]); O[0][et][r] = v; ss += v * v; }
        ss += shx(ss, 16, lane); ss += shx(ss, 32, lane);
        const float rs = rsqrtf(ss * (1.0f / 128.0f) + EPS) * outscale;
#pragma unroll
        for (int et = 0; et < DV / 16; ++et) {
            const f32x4 g = *(const f32x4*)(subln + et * 16 + fq * 4);
            st_bf16x4(Op + (size_t)qrow_o * ldo + et * 16 + fq * 4, O[0][et] * rs * g);
        }
    } else {
#pragma unroll
        for (int et = 0; et < DV / 16; ++et) st_bf16x4(Op + (size_t)qrow_o * ldo + et * 16 + fq * 4, O[0][et] * linv[0]);
    }
}

template <int MODE>
__device__ __forceinline__ void attn2_unit(const bf16_t* __restrict__ Qp, const int ldq, const bf16_t* __restrict__ Kp, const int ldk,
                                           const bf16_t* __restrict__ Vt, const size_t ldvt, const int q0, const int kbeg, const int kend,
                                           const float scale, const float* __restrict__ sinkp, const int hq0, bf16_t* __restrict__ Op, const int ldo, const int wv) {
    constexpr int DQK = ACfg<MODE>::DQK, DV = ACfg<MODE>::DV, KBLK = ACfg<MODE>::KBLK, RT = 2;
    const int tid = hidden_tid(wv), w = tid >> 6, lane = tid & 63, fr = lane & 15, fq = lane >> 4;
    const int hl = (MODE == 1) ? (w >> 1) : 0, qsub = (MODE == 1) ? (w & 1) * 32 : w * 32;
    const float slope = (MODE == 1) ? exp2f(-0.5f * (float)(hq0 + hl + 1)) : 0.f;
    const float m_init = (MODE == 1) ? sinkp[hl] : -1e30f, l_init = (MODE == 1) ? 1.0f : 0.f;
    constexpr float LOG2E = 1.4426950408889634f;
    const float scale2 = scale * LOG2E, slope2 = slope * LOG2E, kappa = slope / scale;
    bf16x8 Qf[RT][DQK / 32];
#pragma unroll
    for (int rt = 0; rt < RT; ++rt)
#pragma unroll
        for (int kk = 0; kk < DQK / 32; ++kk) Qf[rt][kk] = *(const bf16x8*)(Qp + (size_t)(q0 + qsub + 16 * rt + fr) * ldq + hl * 64 + kk * 32 + fq * 8);
    f32x4 O[RT][DV / 16], Ol[RT];
    float mrun[RT];
#pragma unroll
    for (int rt = 0; rt < RT; ++rt) {
        mrun[rt] = m_init * LOG2E; Ol[rt] = (f32x4){(fq == 0) ? l_init : 0.f, 0.f, 0.f, 0.f};
#pragma unroll
        for (int et = 0; et < DV / 16; ++et) O[rt][et] = (f32x4){0.f, 0.f, 0.f, 0.f};
    }
    const unsigned onesw = (fr == 0) ? 0x3f803f80u : 0u;
    const bf16x8 onesf = __builtin_bit_cast(bf16x8, (u32x4){onesw, onesw, onesw, onesw});
    char* const lds = (char*)shm;
    constexpr int KN = KBLK, VN = DV / 64;
    u32x4 kreg[KN], vreg[VN];
#define ATT2_LOAD(k0_) do { \
        _Pragma("unroll") for (int i_ = 0; i_ < KN; ++i_) { const int c_ = tid + i_ * NT; const int key_ = c_ / (KBLK * 8), col_ = (c_ % (KBLK * 8)) * 8; \
            kreg[i_] = *(const u32x4*)(Kp + (size_t)((k0_) + key_) * ldk + col_); } \
        _Pragma("unroll") for (int i_ = 0; i_ < VN; ++i_) { const int c_ = tid + i_ * NT; const int e_ = c_ >> 3, kc_ = c_ & 7; \
            vreg[i_] = *(const u32x4*)(Vt + (size_t)e_ * ldvt + (k0_) + kc_ * 8); } } while (0)
    ATT2_LOAD(kbeg);
    constexpr int VBYTES = DV * 160;
    bf16x8 Pf[RT][2];
#define ATT2_PV_C(voff_, c) do { \
            bf16x8 vf[DV / 16]; \
            _Pragma("unroll") for (int et = 0; et < DV / 16; ++et) vf[et] = *(const bf16x8*)(lds + (voff_) + (et * 16 + fr) * 160 + (c) * 64 + fq * 16); \
            _Pragma("unroll") for (int rt = 0; rt < RT; ++rt) Ol[rt] = __builtin_amdgcn_mfma_f32_16x16x32_bf16(onesf, Pf[rt][c], Ol[rt], 0, 0, 0); \
            _Pragma("unroll") for (int et = 0; et < DV / 16; ++et) \
                _Pragma("unroll") for (int rt = 0; rt < RT; ++rt) O[rt][et] = __builtin_amdgcn_mfma_f32_16x16x32_bf16(vf[et], Pf[rt][c], O[rt][et], 0, 0, 0); \
        } while (0)
    int vcur = ATT_VOFF;
    for (int k0 = kbeg; k0 < kend; k0 += 64) {
        __syncthreads();
#pragma unroll
        for (int i = 0; i < KN; ++i) { const int c = tid + i * NT; const int key = c / (KBLK * 8), col = (c % (KBLK * 8)) * 8;
            *(u32x4*)(lds + (col >> 6) * 8192 + lds_byte(key, col & 63)) = kreg[i]; }
#pragma unroll
        for (int i = 0; i < VN; ++i) { const int c = tid + i * NT; const int e = c >> 3, kc = c & 7;
            char* vd = lds + vcur + e * 160 + (kc >> 2) * 64 + (kc & 1) * 32 + ((kc >> 1) & 1) * 8;
            *(u32x2*)vd = (u32x2){vreg[i].x, vreg[i].y}; *(u32x2*)(vd + 16) = (u32x2){vreg[i].z, vreg[i].w}; }
        __syncthreads();
        if (k0 + 64 < kend) ATT2_LOAD(k0 + 64);
        const int vprev = vcur ^ ATT_VOFF ^ (ATT_VOFF + VBYTES);
        f32x4 s[RT][4]; float off[RT], dqv[RT]; bool genv[RT];
#pragma unroll
        for (int rt = 0; rt < RT; ++rt) {
            const int qw0 = q0 + qsub + 16 * rt;
            const float dq = (float)(qw0 + fr - k0); dqv[rt] = dq;
            const bool gen = (MODE == 1) && !((k0 + 63 <= qw0 && qw0 + 15 - k0 <= 128) || (k0 >= qw0 + 15 && k0 + 63 - qw0 <= 128));
            const bool pos = (MODE == 2) || (k0 + 63 <= qw0);
            genv[rt] = gen;
            if (MODE == 2) {
#pragma unroll
                for (int t = 0; t < 4; ++t) s[rt][t] = (f32x4){0.f, 0.f, 0.f, 0.f};
                off[rt] = 0.f;
            } else if (gen) {
#pragma unroll
                for (int t = 0; t < 4; ++t)
#pragma unroll
                    for (int r = 0; r < 4; ++r) s[rt][t][r] = -kappa * fabsf(dq - (float)(16 * t + 4 * fq + r));
                off[rt] = 0.f;
            } else {
                const float sk = pos ? kappa : -kappa; float cb = sk * (float)(4 * fq);
                asm volatile("" : "+v"(cb));
#pragma unroll
                for (int t = 0; t < 4; ++t)
#pragma unroll
                    for (int r = 0; r < 4; ++r) s[rt][t][r] = sk * (float)(16 * t + r) + cb;
                off[rt] = pos ? -slope2 * dq : slope2 * dq;
            }
        }
#pragma unroll
        for (int t = 0; t < 4; ++t) {
            bf16x8 kf[DQK / 32];
#pragma unroll
            for (int kk = 0; kk < DQK / 32; ++kk) {
                const int blk = (MODE == 2) ? (kk >> 1) : 0, kcol = (MODE == 2) ? (kk & 1) * 32 : kk * 32;
                kf[kk] = *(const bf16x8*)(lds + blk * 8192 + lds_byte(t * 16 + fr, kcol + fq * 8));
            }
#pragma unroll
            for (int rt = 0; rt < RT; ++rt)
#pragma unroll
                for (int kk = 0; kk < DQK / 32; ++kk) s[rt][t] = __builtin_amdgcn_mfma_f32_16x16x32_bf16(kf[kk], Qf[rt][kk], s[rt][t], 0, 0, 0);
        }
        float mx[RT], mx1[RT];
#pragma unroll
        for (int rt = 0; rt < RT; ++rt) {
            if (MODE == 1 && genv[rt]) {
#pragma unroll
                for (int t = 0; t < 4; ++t)
#pragma unroll
                    for (int r = 0; r < 4; ++r) s[rt][t][r] = (fabsf(dqv[rt] - (float)(16 * t + 4 * fq + r)) > 128.0f) ? -1e30f : s[rt][t][r];
            }
            float v = fmaxf(fmaxf(s[rt][0][0], s[rt][0][1]), fmaxf(s[rt][0][2], s[rt][0][3]));
#pragma unroll
            for (int t = 1; t < 4; ++t) v = fmaxf(v, fmaxf(fmaxf(s[rt][t][0], s[rt][t][1]), fmaxf(s[rt][t][2], s[rt][t][3])));
            mx[rt] = v; mx1[rt] = shx(v, 16, lane);
        }
        __builtin_amdgcn_sched_barrier(0);
        if (k0 > kbeg) ATT2_PV_C(vprev, 0);
        __builtin_amdgcn_sched_barrier(0);
#pragma unroll
        for (int rt = 0; rt < RT; ++rt) { mx[rt] = fmaxf(mx[rt], mx1[rt]); mx1[rt] = shx(mx[rt], 32, lane); }
        __builtin_amdgcn_sched_barrier(0);
        if (k0 > kbeg) ATT2_PV_C(vprev, 1);
        __builtin_amdgcn_sched_barrier(0);
#pragma unroll
        for (int rt = 0; rt < RT; ++rt) {
            const float mxx = fmaxf(mx[rt], mx1[rt]);
            const float mtile = fmaxf(mxx * scale2 + off[rt], -1e30f);
            const float mnew = fmaxf(mrun[rt], mtile), alpha = __builtin_amdgcn_exp2f(mrun[rt] - mnew);
            mrun[rt] = mnew;
            const float sub = off[rt] - mnew;
#pragma unroll
            for (int t = 0; t < 4; ++t)
#pragma unroll
                for (int r = 0; r < 4; ++r) s[rt][t][r] = __builtin_amdgcn_exp2f(s[rt][t][r] * scale2 + sub);
            if (__builtin_amdgcn_ballot_w64(alpha != 1.0f) != 0ull) {
                Ol[rt] *= alpha;
#pragma unroll
                for (int et = 0; et < DV / 16; ++et) O[rt][et] *= alpha;
            }
#pragma unroll
            for (int c = 0; c < 2; ++c) {
                u32x4 pk; pk.x = cvt_pk_bf16(s[rt][2 * c][0], s[rt][2 * c][1]); pk.y = cvt_pk_bf16(s[rt][2 * c][2], s[rt][2 * c][3]);
                pk.z = cvt_pk_bf16(s[rt][2 * c + 1][0], s[rt][2 * c + 1][1]); pk.w = cvt_pk_bf16(s[rt][2 * c + 1][2], s[rt][2 * c + 1][3]);
                Pf[rt][c] = __builtin_bit_cast(bf16x8, pk);
            }
        }
        vcur = vprev;
    }
    { const int vlast = vcur ^ ATT_VOFF ^ (ATT_VOFF + VBYTES); ATT2_PV_C(vlast, 0); ATT2_PV_C(vlast, 1); }
    const int tid2 = hidden_tid(wv), w2 = tid2 >> 6, fr2 = tid2 & 15;
    const int hl2 = (MODE == 1) ? (w2 >> 1) : 0, qsub2 = (MODE == 1) ? (w2 & 1) * 32 : w2 * 32;
#pragma unroll
    for (int rt = 0; rt < RT; ++rt) {
        const float linv = 1.0f / shl(Ol[rt][0], fr);
        bf16_t* orow = Op + (size_t)(q0 + qsub2 + 16 * rt + fr2) * ldo + hl2 * 64;
#pragma unroll
        for (int et = 0; et < DV / 16; ++et) st_bf16x4(orow + et * 16 + fq * 4, O[rt][et] * linv);
    }
#undef ATT2_LOAD
#undef ATT2_PV_C
}

constexpr int HZ_RS = 4896;
constexpr int HZ_PAD = 192;
constexpr int H_CPS = 8256;
constexpr int H_ZOFF = 0, H_CPOFF = 8 * HZ_RS, H_RAWOFF = H_CPOFF + 8 * H_CPS;

template <bool ALT>
__device__ __forceinline__ void hyena_unit(const Params& p, const int lj  , const int c, const int wv) {
    const int tid = hidden_tid(wv), w = tid >> 6, lane = tid & 63, fr = lane & 15, fq = lane >> 4;
    char* const lds = (char*)shm;
    const bf16_t* hyT = (const bf16_t*)(p.ws + WS_PROJ + PR_HYT);
    const float* cw = p.in[4] + (size_t)lj * 3 * 1536; const float* cb = p.in[5] + (size_t)lj * 1536;
    const int nb = fr >> 1, tbp = fr & 1;
    __syncthreads();
    for (int i = tid; i < 8 * 2 * (HZ_PAD / 8); i += NT) {
        const int b = i / (2 * (HZ_PAD / 8)), r = i % (2 * (HZ_PAD / 8)), side = r / (HZ_PAD / 8), k = r % (HZ_PAD / 8);
        unsigned zz0 = 0u; asm volatile("" : "+v"(zz0));
        *(u32x4*)(lds + H_ZOFF + b * HZ_RS + (side ? (HZ_PAD + 2048) * 2 : 0) + k * 16) = (u32x4){zz0, zz0, zz0, zz0};
        if (i < 2) *(u32x4*)(lds + H_RAWOFF + 8192 + i * 16) = (u32x4){zz0, zz0, zz0, zz0};
    }
    {
        const float w0 = cw[c], w1 = cw[1536 + c], w2 = cw[2 * 1536 + c], bb = cb[c];
        const bf16_t* src = hyT + (size_t)c * NTOK;
        u32x4 v[4]; unsigned short um[4], up[4];
#pragma unroll
        for (int k = 0; k < 4; ++k) {
            const int i = tid + k * NT, b = i >> 8, s0 = (i & 255) * 8;
            const bf16_t* q = src + b * S + s0;
            v[k] = *(const u32x4*)q; um[k] = q[s0 > 0 ? -1 : 0]; up[k] = q[s0 + 8 < S ? 8 : 7];
        }
#pragma unroll
        for (int k = 0; k < 4; ++k) {
            const int i = tid + k * NT, b = i >> 8, s0 = (i & 255) * 8;
            float u[10];
            u[0] = (s0 > 0) ? bf2f(um[k]) : 0.f; u[9] = (s0 + 8 < S) ? bf2f(up[k]) : 0.f;
            u[1] = bflo(v[k].x); u[2] = bfhi(v[k].x); u[3] = bflo(v[k].y); u[4] = bfhi(v[k].y); u[5] = bflo(v[k].z); u[6] = bfhi(v[k].z); u[7] = bflo(v[k].w); u[8] = bfhi(v[k].w);
            float o[8];
#pragma unroll
            for (int j = 0; j < 8; ++j) o[j] = w0 * u[j] + w1 * u[j + 1] + w2 * u[j + 2] + bb;
            u32x4 ov; ov.x = cvt_pk_bf16(o[0], o[1]); ov.y = cvt_pk_bf16(o[2], o[3]); ov.z = cvt_pk_bf16(o[4], o[5]); ov.w = cvt_pk_bf16(o[6], o[7]);
            *(u32x4*)(lds + H_ZOFF + b * HZ_RS + (HZ_PAD + s0) * 2) = ov;
        }
    }
#pragma unroll 1
    for (int order = 0; order < 2; ++order) {
        const int gch = 512 * (order + 1) + c;
        const bf16_t* gsrc = hyT + (size_t)gch * NTOK;
        u32x2 gv[2][4]; unsigned short gm[2][4], gp[2][4];
        u32x4 rawv;
        {
            const bf16_t* f = (const bf16_t*)(p.ws + WS_FILT) + ((size_t)(lj * 2 + order) * 512 + c) * 4096;
            rawv = *(const u32x4*)(f + tid * 8);
#pragma unroll
            for (int ci = 0; ci < 2; ++ci)
#pragma unroll
                for (int mt = 0; mt < 4; ++mt) {
                    const int t = 64 * (4 * w + 2 * ci + tbp) + 16 * mt + 4 * fq;
                    const bf16_t* gq = gsrc + nb * S + t;
                    gv[ci][mt] = *(const u32x2*)gq; gm[ci][mt] = gq[t > 0 ? -1 : 0]; gp[ci][mt] = gq[t + 4 < S ? 4 : 3];
                }
        }
        *(u32x4*)(lds + H_RAWOFF + tid * 16) = rawv;
        __syncthreads();
        {
            const bf16_t* raw = (const bf16_t*)(lds + H_RAWOFF);
            const int o = w;
#pragma unroll
            for (int k = 0; k < 8; ++k) {
                const int a = lane + 64 * k;
                unsigned short e[8];
#pragma unroll
                for (int j = 0; j < 8; ++j) e[j] = raw[8 * a + o + j];
                u32x4 ov; ov.x = e[0] | ((unsigned)e[1] << 16); ov.y = e[2] | ((unsigned)e[3] << 16); ov.z = e[4] | ((unsigned)e[5] << 16); ov.w = e[6] | ((unsigned)e[7] << 16);
                *(u32x4*)(lds + H_CPOFF + o * H_CPS + a * 16) = ov;
            }
        }
        __syncthreads();
        f32x4 acc[2][4];
#pragma unroll
        for (int ci = 0; ci < 2; ++ci)
#pragma unroll
            for (int mt = 0; mt < 4; ++mt) acc[ci][mt] = (f32x4){0.f, 0.f, 0.f, 0.f};
        {
            const int acp = H_CPOFF + (7 - (fr & 7)) * H_CPS + (255 - (fr >> 3) + fq) * 16;
            const int zb = H_ZOFF + nb * HZ_RS + (HZ_PAD + 8 * fq) * 2;
            for (int dl = 4 * w - 31; dl <= ((ALT && DUPSEL >= 5) ? 4 * w - 31 : 4 * w + 3); ++dl) {
#pragma unroll
                for (int kh = 0; kh < 2; ++kh) {
                    bf16x8 Bf[2];
#pragma unroll
                    for (int ci = 0; ci < 2; ++ci) {
                        const int sblk = 4 * w + 2 * ci + tbp - dl;
                        Bf[ci] = *(const bf16x8*)(lds + zb + (64 * sblk + 32 * kh) * 2);
                    }
#pragma unroll
                    for (int mt = 0; mt < 4; ++mt) {
                        const int q = 4 * dl + mt - 2 * kh;
                        const bf16x8 Af = *(const bf16x8*)(lds + acp - 32 * q);
#pragma unroll
                        for (int ci = 0; ci < 2; ++ci) acc[ci][mt] = __builtin_amdgcn_mfma_f32_16x16x32_bf16(Af, Bf[ci], acc[ci][mt], 0, 0, 0);
                    }
                }
            }
        }
        const float hb = p.in[12][(size_t)(lj * 2 + order) * 512 + c];
        const float w0 = cw[gch], w1 = cw[1536 + gch], w2 = cw[2 * 1536 + gch], bb = cb[gch];
        u32x2 zout[2][4];
#pragma unroll
        for (int ci = 0; ci < 2; ++ci)
#pragma unroll
            for (int mt = 0; mt < 4; ++mt) {
                const int t = 64 * (4 * w + 2 * ci + tbp) + 16 * mt + 4 * fq;
                const u32x2 zz = *(const u32x2*)(lds + H_ZOFF + nb * HZ_RS + (HZ_PAD + t) * 2);
                float u[6];
                u[0] = (t > 0) ? bf2f(gm[ci][mt]) : 0.f; u[5] = (t + 4 < S) ? bf2f(gp[ci][mt]) : 0.f;
                u[1] = bflo(gv[ci][mt].x); u[2] = bfhi(gv[ci][mt].x); u[3] = bflo(gv[ci][mt].y); u[4] = bfhi(gv[ci][mt].y);
                const float z[4] = {bflo(zz.x), bfhi(zz.x), bflo(zz.y), bfhi(zz.y)};
                float o[4];
#pragma unroll
                for (int r = 0; r < 4; ++r) {
                    const float gate = w0 * u[r] + w1 * u[r + 1] + w2 * u[r + 2] + bb;
                    o[r] = gate * (acc[ci][mt][r] + hb * z[r]);
                }
                zout[ci][mt].x = cvt_pk_bf16(o[0], o[1]); zout[ci][mt].y = cvt_pk_bf16(o[2], o[3]);
            }
        __syncthreads();
        if (order == 0) {
#pragma unroll
            for (int ci = 0; ci < 2; ++ci)
#pragma unroll
                for (int mt = 0; mt < 4; ++mt) {
                    const int t = 64 * (4 * w + 2 * ci + tbp) + 16 * mt + 4 * fq;
                    *(u32x2*)(lds + H_ZOFF + nb * HZ_RS + (HZ_PAD + t) * 2) = zout[ci][mt];
                }
        } else {
            bf16_t* yt = (bf16_t*)(p.ws + WS_QX) + (size_t)c * NTOK;
#pragma unroll
            for (int ci = 0; ci < 2; ++ci)
#pragma unroll
                for (int mt = 0; mt < 4; ++mt) {
                    const int t = 64 * (4 * w + 2 * ci + tbp) + 16 * mt + 4 * fq;
                    *(u32x2*)(yt + nb * S + t) = zout[ci][mt];
                }
        }
        __syncthreads();
    }
}

struct Row16 { f32x4 v[4]; };
__device__ __forceinline__ void ld_row(Row16& r, const float* src, int lane) {
#pragma unroll
    for (int i = 0; i < 4; ++i) r.v[i] = *(const f32x4*)(src + 256 * i + 4 * lane);
}
__device__ __forceinline__ void ld_row_bf(Row16& r, const bf16_t* src, int lane) {
#pragma unroll
    for (int i = 0; i < 4; ++i) { const u32x2 v = *(const u32x2*)(src + 256 * i + 4 * lane); r.v[i] = (f32x4){bflo(v.x), bfhi(v.x), bflo(v.y), bfhi(v.y)}; }
}
__device__ __forceinline__ float row_rstd(const Row16& r, int lane) {
    float ss = 0.f;
#pragma unroll
    for (int i = 0; i < 4; ++i) ss += r.v[i][0] * r.v[i][0] + r.v[i][1] * r.v[i][1] + r.v[i][2] * r.v[i][2] + r.v[i][3] * r.v[i][3];
    ss = wave_sum(ss, lane);
    return rsqrtf(ss * (1.0f / 1024.0f) + EPS);
}
template <int KIND  , bool ALT = false>
__device__ __forceinline__ void norm_phase(const Params& p, const int layer, const float* __restrict__ gain, const int bid, const int nb, const int wv) {
    const int tid_ = hidden_tid(wv), lane = tid_ & 63, w = tid_ >> 6;
    bf16_t* XB = (bf16_t*)(p.ws + WS_XB);
    bf16_t* XBo = ALT ? (bf16_t*)(p.ws + WS_PROJ) : XB;
    float* RS1 = (float*)(p.ws + (ALT ? WS_QX : WS_RS1));
    const bf16_t* Y = (const bf16_t*)(p.ws + WS_Y);
    const float* WT = (const float*)(p.ws + WS_WT);
    Row16 g;
    if (KIND == 2) ld_row(g, gain, lane);
    for (int tok = bid * 8 + w; tok < NTOK; tok += nb * 8) {
        Row16 x;
        if (KIND == 0 && layer == 0) ld_row(x, p.in[0] + (size_t)tok * D, lane); else ld_row_bf(x, XB + (size_t)tok * D, lane);
        if ((KIND == 0 && layer > 0) || KIND == 2) {
            const float w0 = WT[2 * tok], w1 = WT[2 * tok + 1];
            const bf16_t* y0 = Y + (size_t)(2 * tok) * D; const bf16_t* y1 = y0 + D;
#pragma unroll
            for (int i = 0; i < 4; ++i) {
                const u32x2 a = *(const u32x2*)(y0 + 256 * i + 4 * lane), b = *(const u32x2*)(y1 + 256 * i + 4 * lane);
                x.v[i][0] += w0 * bflo(a.x) + w1 * bflo(b.x); x.v[i][1] += w0 * bfhi(a.x) + w1 * bfhi(b.x);
                x.v[i][2] += w0 * bflo(a.y) + w1 * bflo(b.y); x.v[i][3] += w0 * bfhi(a.y) + w1 * bfhi(b.y);
            }
        }
        if (KIND == 2) {
            const float rstd = row_rstd(x, lane);
#pragma unroll
            for (int i = 0; i < 4; ++i) *(f32x4*)(p.out + (size_t)tok * D + 256 * i + 4 * lane) = x.v[i] * rstd * g.v[i];
        } else {
#pragma unroll
            for (int i = 0; i < 4; ++i) {
                const unsigned a0 = cvt_pk_bf16(x.v[i][0], x.v[i][1]), a1 = cvt_pk_bf16(x.v[i][2], x.v[i][3]);
                *(u32x2*)(XBo + (size_t)tok * D + 256 * i + 4 * lane) = (u32x2){a0, a1};
                x.v[i] = (f32x4){bflo(a0), bfhi(a0), bflo(a1), bfhi(a1)};
            }
            const float rstd = row_rstd(x, lane);
            if (lane == 0) RS1[tok] = rstd;
        }
    }
}

template <bool ALT>
__device__ __forceinline__ void route_tail(const Params& p, const int layer, const int chunk, f32x4 (&acc)[4][3], float (&ssq)[4], const int wv) {
    const int tid = hidden_tid(wv), lane = tid & 63, w = tid >> 6, fr = lane & 15, fq = lane >> 4;
    float* part = (float*)shm;
    float* ssql = part + 8 * 64 * 49;
    float* lgl = ssql + 8 * 64;
    int* cntl = (int*)((char*)shm + LDS_ROUTE);
    int* basel = cntl + 32;
    int* sel = basel + 32;
    int* posl = sel + 128;
    float* rsl = (float*)(posl + 128);
    float* WT = (float*)(p.ws + (ALT ? WS_ACT + (size_t)4 * 1024 * 1024 : WS_WT));
    float* RSTD = (float*)(p.ws + (ALT ? WS_ACT + (size_t)5 * 1024 * 1024 : WS_RSTD));
    int* LIST = (int*)(p.ws + (ALT ? WS_ACT : WS_LIST));
    float* RP = (float*)(p.ws + (ALT ? WS_ACT + (size_t)2 * 1024 * 1024 : WS_RP));
    int* CNT = (int*)(p.ws + WS_CNT) + (layer + (ALT ? 4 : 0)) * NEXP * CNT_STRIDE;
    const float* bg = p.in[26] + layer * 4; const float* be = p.in[28] + layer * NEXP;
    const char* const Xc = (const char*)(p.ws + WS_XB);
    const char* const Whc = (const char*)(p.ws + WS_WRT) + (size_t)layer * 2 * 48 * 1024 * 2; const char* const Wlc = Whc + 48 * 1024 * 2;
#pragma unroll
    for (int mt = 0; mt < 4; ++mt) {
        float sq = ssq[mt]; sq += shx(sq, 16, lane); sq += shx(sq, 32, lane);
        if (fq == 0) ssql[w * 64 + mt * 16 + fr] = sq;
#pragma unroll
        for (int nt = 0; nt < 3; ++nt)
#pragma unroll
            for (int r = 0; r < 4; ++r) part[(w * 64 + mt * 16 + fq * 4 + r) * 49 + nt * 16 + fr] = acc[mt][nt][r];
    }
    __syncthreads();
    {
        const int tl = tid & 63;
        for (int j = tid >> 6; j < 36; j += 8) {
            float s = 0.f;
#pragma unroll
            for (int ww = 0; ww < 8; ++ww) s += part[(ww * 64 + tl) * 49 + j];
            lgl[tl * 37 + j] = s;
        }
    }
    __syncthreads();
    if (tid < 64) {
        const int tl = tid, tk = chunk * 64 + tl;
        float sq = 0.f;
#pragma unroll
        for (int ww = 0; ww < 8; ++ww) sq += ssql[ww * 64 + tl];
        const float rstd = rsqrtf(sq * (1.0f / 1024.0f) + EPS);
        float lg[36];
#pragma unroll
        for (int j = 0; j < 36; ++j) lg[j] = lgl[tl * 37 + j] * rstd;
        float g0 = lg[0] + bg[0], g1 = lg[1] + bg[1], g2 = lg[2] + bg[2], g3 = lg[3] + bg[3];
        int gs = 0; float gm = g0;
        if (g1 > gm) { gm = g1; gs = 1; } if (g2 > gm) { gm = g2; gs = 2; } if (g3 > gm) { gm = g3; gs = 3; }
        const float gden = __expf(g0 - gm) + __expf(g1 - gm) + __expf(g2 - gm) + __expf(g3 - gm);
        const float ggate = 1.0f / gden;
        float ev[8];
#pragma unroll
        for (int j = 0; j < 8; ++j) {
            const float a0 = lg[4 + j] + be[j], a1 = lg[12 + j] + be[8 + j], a2 = lg[20 + j] + be[16 + j], a3 = lg[28 + j] + be[24 + j];
            ev[j] = gs == 0 ? a0 : gs == 1 ? a1 : gs == 2 ? a2 : a3;
        }
        int i0 = 0; float v0 = ev[0];
#pragma unroll
        for (int j = 1; j < 8; ++j) if (ev[j] > v0) { v0 = ev[j]; i0 = j; }
        int i1 = -1; float v1 = -3.0e38f;
#pragma unroll
        for (int j = 0; j < 8; ++j) if (j != i0 && ev[j] > v1) { v1 = ev[j]; i1 = j; }
        const float e1 = __expf(v1 - v0), sden = 1.0f / (1.0f + e1);
        const int ea = gs * 8 + i0, eb = gs * 8 + i1;
        sel[2 * tl] = ea; posl[2 * tl] = atomicAdd(&cntl[ea], 1);
        sel[2 * tl + 1] = eb; posl[2 * tl + 1] = atomicAdd(&cntl[eb], 1);
        WT[2 * tk] = ggate * sden; WT[2 * tk + 1] = ggate * e1 * sden;
        RSTD[tk] = rstd; rsl[tl] = rstd;
    }
    __syncthreads();
    if (tid < 32) { const int c = cntl[tid]; basel[tid] = (ALT && DUPSEL == 1) ? chunk * 4 : (c > 0 ? atomicAdd(&CNT[tid * CNT_STRIDE], c) : 0); }
    __syncthreads();
    if (tid < 128) { const int e = sel[tid]; const size_t li = (size_t)e * NTOK + basel[e] + posl[tid]; LIST[li] = 128 * chunk + tid; RP[li] = rsl[tid >> 1]; }
}

template <bool ALT>
__device__ __forceinline__ void route_phase(const Params& p, const int layer, const int bid, const int nb, const int wv) {
    const int tid = hidden_tid(wv), lane = tid & 63, w = tid >> 6, fr = lane & 15, fq = lane >> 4;
    float* part = (float*)shm;
    float* ssql = part + 8 * 64 * 49;
    float* lgl = ssql + 8 * 64;
    int* cntl = (int*)((char*)shm + LDS_ROUTE);
    int* basel = cntl + 32;
    int* sel = basel + 32;
    int* posl = sel + 128;
    float* rsl = (float*)(posl + 128);
    float* WT = (float*)(p.ws + (ALT ? WS_ACT + (size_t)4 * 1024 * 1024 : WS_WT));
    float* RSTD = (float*)(p.ws + (ALT ? WS_ACT + (size_t)5 * 1024 * 1024 : WS_RSTD));
    int* LIST = (int*)(p.ws + (ALT ? WS_ACT : WS_LIST));
    float* RP = (float*)(p.ws + (ALT ? WS_ACT + (size_t)2 * 1024 * 1024 : WS_RP));
    int* CNT = (int*)(p.ws + WS_CNT) + (layer + (ALT ? 4 : 0)) * NEXP * CNT_STRIDE;
    const float* bg = p.in[26] + layer * 4; const float* be = p.in[28] + layer * NEXP;
    const char* const Xc = (const char*)(p.ws + WS_XB);
    const char* const Whc = (const char*)(p.ws + WS_WRT) + (size_t)layer * 2 * 48 * 1024 * 2; const char* const Wlc = Whc + 48 * 1024 * 2;
    for (int chunk = bid; chunk < NTOK / 64; chunk += nb) {
        __syncthreads();
        if (tid < 32) cntl[tid] = 0;
        const unsigned xoff = (unsigned)(((chunk * 64 + fr) * D + w * 128 + fq * 8) * 2), woff = (unsigned)((fr * 1024 + w * 128 + fq * 8) * 2);
        f32x4 acc[4][3];
#pragma unroll
        for (int mt = 0; mt < 4; ++mt)
#pragma unroll
            for (int nt = 0; nt < 3; ++nt) acc[mt][nt] = (f32x4){0.f, 0.f, 0.f, 0.f};
        float ssq[4] = {0.f, 0.f, 0.f, 0.f};
        u32x4 xa[4][4]; bf16x8 Bh[2][3], Bl[2][3];
#pragma unroll
        for (int st = 0; st < 4; ++st)
#pragma unroll
            for (int mt = 0; mt < 4; ++mt) xa[st][mt] = *(const u32x4*)(Xc + (xoff + (unsigned)(mt * 16 * D * 2 + st * 64)));
#pragma unroll
        for (int nt = 0; nt < 3; ++nt) { Bh[0][nt] = *(const bf16x8*)(Whc + (woff + (unsigned)(nt * 16 * 2048))); Bl[0][nt] = *(const bf16x8*)(Wlc + (woff + (unsigned)(nt * 16 * 2048))); }
#pragma unroll
        for (int st = 0; st < 4; ++st) {
            if (st < 3) {
#pragma unroll
                for (int nt = 0; nt < 3; ++nt) { Bh[(st + 1) & 1][nt] = *(const bf16x8*)(Whc + (woff + (unsigned)(nt * 16 * 2048 + (st + 1) * 64))); Bl[(st + 1) & 1][nt] = *(const bf16x8*)(Wlc + (woff + (unsigned)(nt * 16 * 2048 + (st + 1) * 64))); }
            }
#pragma unroll
            for (int mt = 0; mt < 4; ++mt) {
                const u32x4 xb = xa[st][mt];
                const f32x4 x0 = {bflo(xb.x), bfhi(xb.x), bflo(xb.y), bfhi(xb.y)}, x1 = {bflo(xb.z), bfhi(xb.z), bflo(xb.w), bfhi(xb.w)};
                ssq[mt] += x0[0] * x0[0] + x0[1] * x0[1] + x0[2] * x0[2] + x0[3] * x0[3] + x1[0] * x1[0] + x1[1] * x1[1] + x1[2] * x1[2] + x1[3] * x1[3];
                const bf16x8 Ah = __builtin_bit_cast(bf16x8, xb);
#pragma unroll
                for (int nt = 0; nt < 3; ++nt) {
                    acc[mt][nt] = __builtin_amdgcn_mfma_f32_16x16x32_bf16(Ah, Bh[st & 1][nt], acc[mt][nt], 0, 0, 0);
                    acc[mt][nt] = __builtin_amdgcn_mfma_f32_16x16x32_bf16(Ah, Bl[st & 1][nt], acc[mt][nt], 0, 0, 0);
                }
            }
            __builtin_amdgcn_sched_barrier(0);
        }
        route_tail<ALT>(p, layer, chunk, acc, ssq, wv);
    }
}

constexpr int GOR_PITCH = 1040;
template <bool ALT>
__device__ __forceinline__ void gor_phase(const Params& p, const int layer, const int bid, const int nb, const int wv) {
    const int tid = hidden_tid(wv), lane = tid & 63, w = tid >> 6, fr = lane & 15, fq = lane >> 4;
    char* const lds = (char*)shm;
    int* cntl = (int*)((char*)shm + LDS_ROUTE);
    const bf16_t* OXp = (const bf16_t*)(p.ws + WS_OX);
    bf16_t* XB = (bf16_t*)(p.ws + WS_XB);
    const char* const Wo = (const char*)(p.ws + WS_W_CO) + (size_t)layer * 1024 * 512 * 2;
    const char* const Whc = (const char*)(p.ws + WS_WRT) + (size_t)layer * 2 * 48 * 1024 * 2; const char* const Wlc = Whc + 48 * 1024 * 2;
    for (int chunk = bid; chunk < NTOK / 64; chunk += nb) {
        const int r0 = chunk * 64;
        __syncthreads();
        if (tid < 32) cntl[tid] = 0;
        {
            u32x4 v[8];
#pragma unroll
            for (int i = 0; i < 8; ++i) { const int pc = tid + i * NT; v[i] = *(const u32x4*)(OXp + (size_t)(r0 + (pc >> 6)) * 512 + (pc & 63) * 8); }
#pragma unroll
            for (int i = 0; i < 8; ++i) { const int pc = tid + i * NT; *(u32x4*)(lds + (pc >> 6) * GOR_PITCH + (pc & 63) * 16) = v[i]; }
        }
        __syncthreads();
        f32x4 accr[4][3];
#pragma unroll
        for (int mt = 0; mt < 4; ++mt)
#pragma unroll
            for (int nt = 0; nt < 3; ++nt) accr[mt][nt] = (f32x4){0.f, 0.f, 0.f, 0.f};
        float ssq[4] = {0.f, 0.f, 0.f, 0.f};
        const int aoffl = fr * GOR_PITCH + fq * 16;
        const int kst = (bid >> 3) & 15;
#pragma unroll 1
        for (int half = 0; half < 2; ++half) {
            const int cb = w * 128 + half * 64;
            const unsigned boff = (unsigned)((cb >> 4) * 16 * 1024 + lane * 16);
            const unsigned woff = (unsigned)((fr * 1024 + cb + fq * 8) * 2);
            f32x4 acc[4][4];
#pragma unroll
            for (int i = 0; i < 4; ++i)
#pragma unroll
                for (int j = 0; j < 4; ++j) acc[i][j] = (f32x4){0.f, 0.f, 0.f, 0.f};
            bf16x8 Bq[4][4];
#define GOR_LDB(s_) do { _Pragma("unroll") for (int j = 0; j < 4; ++j) Bq[(s_) & 3][j] = *(const bf16x8*)(Wo + (boff + (unsigned)(j * 16 * 1024 + (((s_) + kst) & 15) * 1024))); } while (0)
            GOR_LDB(0); GOR_LDB(1); GOR_LDB(2);
            u32x2 xres[4][4];
            bf16x8 Wh[2][3], Wl[2][3];
#pragma unroll
            for (int s = 0; s < 16; ++s) {
                if (s + 3 < 16) GOR_LDB(s + 3);
                if (s == 15) {
#pragma unroll
                    for (int i = 0; i < 4; ++i)
#pragma unroll
                        for (int j = 0; j < 4; ++j) xres[i][j] = *(const u32x2*)(XB + (size_t)(r0 + 16 * i + fr) * D + cb + 16 * j + 4 * fq);
                }
                bf16x8 Af[4];
#pragma unroll
                for (int i = 0; i < 4; ++i) Af[i] = *(const bf16x8*)(lds + aoffl + i * 16 * GOR_PITCH + ((s + kst) & 15) * 64);
#pragma unroll
                for (int j = 0; j < 4; ++j)
#pragma unroll
                    for (int i = 0; i < 4; ++i) acc[i][j] = __builtin_amdgcn_mfma_f32_16x16x32_bf16(Bq[s & 3][j], Af[i], acc[i][j], 0, 0, 0);
                __builtin_amdgcn_sched_barrier(0);
            }
#undef GOR_LDB
#pragma unroll
            for (int pp = 0; pp < 2; ++pp)
#pragma unroll
                for (int nt = 0; nt < 3; ++nt) { Wh[pp][nt] = *(const bf16x8*)(Whc + (woff + (unsigned)(nt * 16 * 2048 + pp * 64))); Wl[pp][nt] = *(const bf16x8*)(Wlc + (woff + (unsigned)(nt * 16 * 2048 + pp * 64))); }
#pragma unroll
            for (int i = 0; i < 4; ++i) {
                bf16_t* qb = XB + (size_t)(r0 + 16 * i + fr) * D + cb + 4 * fq;
                unsigned pk[4][2];
#pragma unroll
                for (int j = 0; j < 4; ++j) {
                    const u32x2 x = xres[i][j];
                    const f32x4 t = (f32x4){bflo(x.x), bfhi(x.x), bflo(x.y), bfhi(x.y)} + acc[i][j];
                    const unsigned a0 = cvt_pk_bf16(t[0], t[1]), a1 = cvt_pk_bf16(t[2], t[3]);
                    *(u32x2*)(qb + 16 * j) = (u32x2){a0, a1};
                    const float r0f = bflo(a0), r1f = bfhi(a0), r2f = bflo(a1), r3f = bfhi(a1);
                    ssq[i] += (r0f * r0f + r1f * r1f) + (r2f * r2f + r3f * r3f);
                    pk[j][0] = a0; pk[j][1] = a1;
                }
#pragma unroll
                for (int pp = 0; pp < 2; ++pp) {
                    const bf16x8 Ah = __builtin_bit_cast(bf16x8, (u32x4){pk[2 * pp][0], pk[2 * pp][1], pk[2 * pp + 1][0], pk[2 * pp + 1][1]});
#pragma unroll
                    for (int nt = 0; nt < 3; ++nt) {
                        accr[i][nt] = __builtin_amdgcn_mfma_f32_16x16x32_bf16(Ah, Wh[pp][nt], accr[i][nt], 0, 0, 0);
                        accr[i][nt] = __builtin_amdgcn_mfma_f32_16x16x32_bf16(Ah, Wl[pp][nt], accr[i][nt], 0, 0, 0);
                    }
                }
            }
        }
        __syncthreads();
        route_tail<ALT>(p, layer, chunk, accr, ssq, wv);
    }
}

template <int MODE>
__device__ __forceinline__ void cvt_job(const float* __restrict__ src, bf16_t* __restrict__ dst, const int K, const int N, const int nmat,
                                        const size_t dst_mat_stride, const int bid, const int nb, const int wv, const float* __restrict__ kgain = nullptr, const int gshift = 0) {
    float* T = (float*)shm;
    const int tid = hidden_tid(wv);
    const int tk = K / 128, tn = N / 128, per = tk * tn, total = per * nmat;
    f32x4 v[8];
#define CVT_LOAD(t_) do { const int mat_ = (t_) / per, r_ = (t_) % per, k0_ = (r_ / tn) * 128, n0_ = (r_ % tn) * 128; \
        const float* s_ = src + (size_t)mat_ * K * N + (size_t)k0_ * N + n0_; \
        _Pragma("unroll") for (int i = 0; i < 8; ++i) v[i] = *(const f32x4*)(s_ + (size_t)((tid >> 5) + 16 * i) * N + (tid & 31) * 4); } while (0)
    if (bid < total) CVT_LOAD(bid);
    for (int t = bid; t < total; t += nb) {
        const int mat = t / per, r = t % per, k0 = (r / tn) * 128, n0 = (r % tn) * 128;
        bf16_t* d = dst + (size_t)mat * dst_mat_stride;
        if (kgain) {
#pragma unroll
            for (int i = 0; i < 8; ++i) v[i] *= kgain[(size_t)(mat >> gshift) * D + k0 + (tid >> 5) + 16 * i];
        }
        __syncthreads();
#pragma unroll
        for (int i = 0; i < 8; ++i) {
            float* q = T + ((tid >> 5) + 16 * i) * 129 + (tid & 31) * 4;
            q[0] = v[i][0]; q[1] = v[i][1]; q[2] = v[i][2]; q[3] = v[i][3];
        }
        __syncthreads();
        if (t + nb < total) CVT_LOAD(t + nb);
#pragma unroll
        for (int j = 0; j < 4; ++j) {
            const int n = (tid >> 4) + 32 * j, kc = (tid & 15) * 8;
            float e[8];
#pragma unroll
            for (int jj = 0; jj < 8; ++jj) e[jj] = T[(kc + jj) * 129 + n];
            u32x4 ov; ov.x = cvt_pk_bf16(e[0], e[1]); ov.y = cvt_pk_bf16(e[2], e[3]); ov.z = cvt_pk_bf16(e[4], e[5]); ov.w = cvt_pk_bf16(e[6], e[7]);
            const int ng = n0 + n;
            if (MODE == 3) {
                const int kk = k0 + kc;
                *(u32x4*)(d + ((size_t)((ng >> 4) * (K >> 5) + (kk >> 5)) * 64 + ((kk >> 3) & 3) * 16 + (ng & 15)) * 8) = ov;
            } else {
            const int row = (MODE == 0) ? ng : ((ng >> 5) * 64 + ((ng >> 2) & 1) * 32 + (MODE == 2 ? 16 : 0) + ((ng >> 3) & 3) * 4 + (ng & 3));
            *(u32x4*)(d + (size_t)row * K + k0 + kc) = ov;
            }
        }
    }
#undef CVT_LOAD
}

__device__ __forceinline__ void prologue0(const Params& p, const int bid, const int nb, const int wv) {
    unsigned char* ws = p.ws;
    cvt_job<0>(p.in[3], (bf16_t*)(ws + WS_W_EIN), 1024, 3072, 2, (size_t)3072 * 1024, bid, nb, wv, p.in[2]);
    cvt_job<0>(p.in[15], (bf16_t*)(ws + WS_W_EOUT), 1024, 1024, 2, (size_t)1024 * 1024, bid, nb, wv);
    cvt_job<0>(p.in[17], (bf16_t*)(ws + WS_W_OIN), 1024, 1536, 2, (size_t)1536 * 1024, bid, nb, wv, p.in[16]);
    cvt_job<0>(p.in[19], (bf16_t*)(ws + WS_W_OOUT), 1024, 1024, 2, (size_t)1024 * 1024, bid, nb, wv);
    cvt_job<0>(p.in[21], (bf16_t*)(ws + WS_W_CQ), 1024, 512, 4, (size_t)512 * 1024, bid, nb, wv, p.in[20]);
    cvt_job<0>(p.in[22], (bf16_t*)(ws + WS_W_CKV), 1024, 1024, 4, (size_t)1024 * 1024, bid, nb, wv);
    cvt_job<3>(p.in[23], (bf16_t*)(ws + WS_W_CO), 512, 1024, 4, (size_t)1024 * 512, bid, nb, wv);
    cvt_job<1>(p.in[29], (bf16_t*)(ws + WS_W_GU), 1024, 512, 128, (size_t)1024 * 1024, bid, nb, wv, p.in[24], 5);
    cvt_job<2>(p.in[30], (bf16_t*)(ws + WS_W_GU), 1024, 512, 128, (size_t)1024 * 1024, bid, nb, wv, p.in[24], 5);
    cvt_job<0>(p.in[31], (bf16_t*)(ws + WS_W_DN), 512, 1024, 128, (size_t)1024 * 512, bid, nb, wv);
    const int tid = hidden_tid(wv), lane = tid & 63, w = tid >> 6;
    {
        Row16 g; ld_row(g, p.in[32], lane);
        bf16_t* MN = (bf16_t*)(ws + WS_MEMN);
        for (int r = bid * 8 + w; r < Bb * MEM; r += nb * 8) {
            Row16 x; ld_row(x, p.in[1] + (size_t)r * D, lane);
            const float rstd = row_rstd(x, lane);
#pragma unroll
            for (int i = 0; i < 4; ++i) st_bf16x4(MN + (size_t)r * D + 256 * i + 4 * lane, x.v[i] * rstd * g.v[i]);
        }
    }
    {
        float* A2 = (float*)(ws + WS_A2);
        for (int r = bid * 8 + w; r < 2 * S; r += nb * 8) {
            const int lj = r / S, pos = r % S;
            const float* w1 = p.in[6] + (size_t)lj * 33 * 64; const float* b1 = p.in[7] + lj * 64;
            const float* w2 = p.in[8] + (size_t)lj * 64 * 64; const float* b2 = p.in[9] + lj * 64;
            const float fr_ = p.in[11][lj * 64 + lane];
            float a = ((float)pos / 2047.0f) * w1[lane];
#pragma unroll 1
            for (int k = 0; k < 16; ++k) {
                const float band = 1e-4f + (float)k * ((15.0f - 1e-4f) / 15.0f);
                const float ang = band * (6.283185307179586f * (float)pos / 2048.0f);
                a += cosf(ang) * w1[(1 + k) * 64 + lane] - sinf(ang) * w1[(17 + k) * 64 + lane];
            }
            const float a1 = sinf(fr_ * (a + b1[lane]));
            float a2 = 0.f;
#pragma unroll 1
            for (int i = 0; i < 64; ++i) a2 += shl(a1, i) * w2[i * 64 + lane];
            A2[(size_t)r * 64 + lane] = sinf(fr_ * (a2 + b2[lane]));
        }
    }
    {
        bf16_t* WR = (bf16_t*)(ws + WS_WRT);
        for (int i = bid * NT + tid; i < 4 * 48 * 1024; i += nb * NT) {
            const int l = i / (48 * 1024), r = i % (48 * 1024), j = r >> 10, kp = r & 1023;
            const int k = (kp & ~31) + (((kp & 7) < 4) ? 4 * ((kp >> 3) & 3) + (kp & 7) : 16 + 4 * ((kp >> 3) & 3) + (kp & 7) - 4);
            float v = 0.f;
            if (j < 4) v = p.in[25][((size_t)l * D + k) * 4 + j]; else if (j < 36) v = p.in[27][((size_t)l * D + k) * NEXP + (j - 4)];
            v *= p.in[24][(size_t)l * D + k];
            const unsigned h = cvt_pk_bf16(v, 0.f) & 0xffffu;
            const unsigned lo = cvt_pk_bf16(v - bflo(h), 0.f) & 0xffffu;
            WR[(size_t)l * 2 * 48 * 1024 + r] = (bf16_t)h; WR[(size_t)l * 2 * 48 * 1024 + 48 * 1024 + r] = (bf16_t)lo;
        }
    }
    if (bid == 0) {
        if (tid < 2) {
            const float* lm = p.in[13] + (size_t)tid * 4 * 64;
            float s01 = 0.f, s23 = 0.f;
            for (int i = 0; i < 64; ++i) { s01 += lm[i] * lm[64 + i]; s23 += lm[128 + i] * lm[192 + i]; }
            const float lam_init = 0.8f - 0.6f * expf(-0.3f * (float)(2 * tid));
            ((float*)(ws + WS_MISC))[tid] = expf(s01) - expf(s23) + lam_init;
            ((float*)(ws + WS_MISC))[2 + tid] = 1.0f - lam_init;
        }
        bf16_t* hz = (bf16_t*)(ws + WS_XB) + (size_t)NTOK * D; bf16_t* az = (bf16_t*)(ws + WS_ACT) + (size_t)2 * NTOK * EH;
        for (int i = tid; i < D; i += NT) hz[i] = 0;
        for (int i = tid; i < EH; i += NT) az[i] = 0;
    }
}

__device__ __forceinline__ void filter_taps(const Params& p, const int bid, const int nb, const int wv) {
    const int tid = hidden_tid(wv), w = tid >> 6, lane = tid & 63, fr = lane & 15, fq = lane >> 4;
    const float* A2 = (const float*)(p.ws + WS_A2);
    bf16_t* FL = (bf16_t*)(p.ws + WS_FILT);
    const float mind = logf(1e-2f) / 1.5f, maxd = logf(1e-2f) / 0.3f;
    for (int job = bid; job < 2 * 4 * 8 * 32; job += nb) {
        const int pt = job & 31, ct = (job >> 5) & 7, od = (job >> 8) & 3, lj = job >> 10;
        const int pos0 = pt * 64 + (w >> 2) * 32, ch0 = ct * 64 + (w & 3) * 16, order = od >> 1, dir = od & 1;
        const float* w3 = p.in[10] + (size_t)lj * 64 * 2048 + od * 512 + ch0 + fr;
        bf16x8 Af[2], Bf[2][2];
#pragma unroll
        for (int ks = 0; ks < 2; ++ks) {
            float e[8];
#pragma unroll
            for (int jj = 0; jj < 8; ++jj) e[jj] = w3[(size_t)(ks * 32 + fq * 8 + jj) * 2048];
            u32x4 pk; pk.x = cvt_pk_bf16(e[0], e[1]); pk.y = cvt_pk_bf16(e[2], e[3]); pk.z = cvt_pk_bf16(e[4], e[5]); pk.w = cvt_pk_bf16(e[6], e[7]);
            Af[ks] = __builtin_bit_cast(bf16x8, pk);
#pragma unroll
            for (int nt = 0; nt < 2; ++nt) {
                const float* ap = A2 + ((size_t)lj * S + pos0 + nt * 16 + fr) * 64 + ks * 32 + fq * 8;
                const f32x4 v0 = *(const f32x4*)ap, v1 = *(const f32x4*)(ap + 4);
                u32x4 pb; pb.x = cvt_pk_bf16(v0[0], v0[1]); pb.y = cvt_pk_bf16(v0[2], v0[3]); pb.z = cvt_pk_bf16(v1[0], v1[1]); pb.w = cvt_pk_bf16(v1[2], v1[3]);
                Bf[nt][ks] = __builtin_bit_cast(bf16x8, pb);
            }
        }
#pragma unroll
        for (int nt = 0; nt < 2; ++nt) {
            f32x4 acc = {0.f, 0.f, 0.f, 0.f};
            acc = __builtin_amdgcn_mfma_f32_16x16x32_bf16(Af[0], Bf[nt][0], acc, 0, 0, 0);
            acc = __builtin_amdgcn_mfma_f32_16x16x32_bf16(Af[1], Bf[nt][1], acc, 0, 0, 0);
            const int pos = pos0 + nt * 16 + fr;
            const float tpos = (float)pos / 2047.0f;
#pragma unroll
            for (int r = 0; r < 4; ++r) {
                const int ch = ch0 + fq * 4 + r;
                const float delta = mind + (float)ch * ((maxd - mind) / 511.0f);
                const float v = acc[r] * __builtin_amdgcn_exp2f(-tpos * fabsf(delta) * 1.4426950408889634f);
                bf16_t* f = FL + ((size_t)(lj * 2 + order) * 512 + ch) * 4096;
                const unsigned short hv = (unsigned short)(cvt_pk_bf16(v, 0.f) & 0xffff);
                if (dir == 0) f[2047 - pos] = hv;
                else { if (pos >= 1) f[2047 + pos] = hv; if (pos == 2047) f[4095] = 0; }
            }
        }
    }
}

enum { PH_P0 = 0, PH_P1, PH_N1, PH_GIN, PH_MIX, PH_GOUT, PH_N2, PH_GQ, PH_XATT, PH_GO, PH_ROUTE, PH_G1, PH_G2, PH_FINAL, PH_TR, PH_GOR, PH_COUNT };

template <class Epi>
__device__ __forceinline__ void gemm_dense(const bf16_t* A, const bf16_t* Bt, const int K, const int nM, const int nN, Epi epi, const int bid, const int nb, const int wv, const int ntl = 0) {
    for (int u = bid; u < nM * nN; u += nb) {
        const int pm = u / nN, pn = u % nN;
        epi.brow = pm * 256;
        gemm_tile(A + (size_t)pm * 256 * K, Bt, K, pn * 256, RowIdent{}, epi, wv, ntl);
    }
}

typedef const __attribute__((address_space(4))) Params* ParamsK;
#define PHASE_FN __forceinline__
template <int PH, bool ALT = false>
__device__ PHASE_FN void run_phase(ParamsK pk_, const int layer, const int bid_, const int nb_, const int wv_) {
    ParamsK pk = pk_; asm volatile("" : "+s"(pk));
    int bid = bid_, nb = nb_, wv = wv_; asm volatile("" : "+s"(bid), "+s"(nb), "+s"(wv));
    const Params& p = *(const Params*)pk;
    unsigned char* ws = p.ws;
    const int lj = layer >> 1; const bool even = (layer & 1) == 0;
    bf16_t* H = (bf16_t*)(ws + WS_H);
    float* X = (float*)(ws + WS_X);
    bf16_t* YMIX = (bf16_t*)(ws + WS_YMIX);
    bf16_t* QX = (bf16_t*)(ws + WS_QX);
    bf16_t* OX = (bf16_t*)(ws + WS_OX);
    if constexpr (PH == PH_P0) { prologue0(p, bid, nb, wv); }
    if constexpr (PH == PH_N1) {
        norm_phase<0, ALT>(p, layer, nullptr, bid, nb, wv);
        if (layer == 0 && !ALT) filter_taps(p, bid, nb, wv);
    }
    if constexpr (PH == PH_GIN) {
        const bf16_t* XBc = (const bf16_t*)(ws + WS_XB); const float* RS1 = (const float*)(ws + WS_RS1);
        if (ALT && DUPSEL >= 1) {
            int fl = bid; asm volatile("" : "+s"(fl));
            EpiNull e{(float*)(ws + WS_X), fl == 0x7fffffff, 0};
            gemm_dense(XBc, (const bf16_t*)(ws + (even ? WS_W_EIN : WS_W_OIN)) + (size_t)lj * (even ? 3072 : 1536) * 1024, 1024, 64, even ? 12 : 6, e, bid, nb, wv, DUPSEL == 2 ? 8 : 0);
        } else if (even) {
            EpiSplit e{(bf16_t*)(ws + WS_PROJ + PR_HYT), (bf16_t*)(ws + WS_PROJ + PR_QK), (bf16_t*)(ws + WS_PROJ + PR_VT), 1536, 2560, 1024, (size_t)NTOK, 0, RS1};
            gemm_dense(XBc, (const bf16_t*)(ws + WS_W_EIN) + (size_t)lj * 3072 * 1024, 1024, 64, 12, e, bid, nb, wv);
        } else {
            EpiSplit e{nullptr, (bf16_t*)(ws + WS_PROJ), (bf16_t*)(ws + WS_PROJ + PR_OVT), 0, 1280, 1280, (size_t)NTOK, 0, RS1};
            gemm_dense(XBc, (const bf16_t*)(ws + WS_W_OIN) + (size_t)lj * 1536 * 1024, 1024, 64, 6, e, bid, nb, wv);
        }
    }
    if constexpr (PH == PH_MIX) {
        if (even) {
            const bf16_t* qk = (const bf16_t*)(ws + WS_PROJ + PR_QK);
            const bf16_t* vT = (const bf16_t*)(ws + WS_PROJ + PR_VT);
            const float lam = uni(((const float*)(ws + WS_MISC))[lj]);
            const float oscale = uni(((const float*)(ws + WS_MISC))[2 + lj]);
            for (int u = bid + ((ALT && (DUPSEL == 4 || DUPSEL >= 7)) ? 512 : 0); u < ((ALT && (DUPSEL == 3 || DUPSEL == 5 || DUPSEL == 6)) ? 512 : 1024); u += nb) {
                if (u < 512) hyena_unit<ALT>(p, lj, u, wv);
                else {
                    const int id = u - 512, b = id >> 6, h = (id >> 4) & 3, qb = id & 15;
                    attn_unit<0, ALT>(qk + (size_t)(b * S) * 1024 + 2 * h * 64, 1024, qk + (size_t)(b * S) * 1024 + 512 + 2 * h * 64, 1024,
                                 vT + (size_t)(h * 128) * NTOK + b * S, (size_t)NTOK, qb * 128, 0, S,
                                 0.125f, uni(exp2f(-2.0f * (float)(h + 1))), -1e30f, 0.f,
                                 (ALT ? (bf16_t*)(ws + WS_Y) : YMIX) + (size_t)(b * S) * D + 512 + h * 128, D, lam, oscale, p.in[14] + (size_t)lj * 128, wv);
                }
            }
        } else {
            const bf16_t* qk = (const bf16_t*)(ws + WS_PROJ);
            const bf16_t* vT = (const bf16_t*)(ws + WS_PROJ + PR_OVT);
            for (int u = bid; u < 1024; u += nb) {
                const int b = u >> 7, kv = (u >> 5) & 3, qb = u & 31, q0 = qb * 64;
                const int kbeg = q0 - 128 < 0 ? 0 : q0 - 128, kend = q0 + 192 > S ? S : q0 + 192;
                attn2_unit<1>(qk + (size_t)(b * S) * 1280 + kv * 256, 1280, qk + (size_t)(b * S) * 1280 + 1024 + kv * 64, 1280,
                              vT + (size_t)(kv * 64) * NTOK + b * S, (size_t)NTOK, q0, kbeg, kend,
                              0.125f, p.in[18] + lj * 16 + kv * 4, kv * 4, YMIX + (size_t)(b * S) * D + kv * 256, D, wv);
            }
        }
    }
    if constexpr (PH == PH_TR) {
        const int tid = hidden_tid(wv);
        const bf16_t* yt = (const bf16_t*)(ws + WS_QX);
        bf16_t* T = shm;
        for (int t = bid; t < 8 * 256; t += nb) {
            const int c0 = (t & 7) * 64, tk0 = (t >> 3) * 64;
            const u32x4 v = *(const u32x4*)(yt + (size_t)(c0 + (tid >> 3)) * NTOK + tk0 + (tid & 7) * 8);
            __syncthreads();
            *(u32x4*)((char*)T + (tid >> 3) * 144 + (tid & 7) * 16) = v;
            __syncthreads();
            const int tok = tid >> 3, cg = (tid & 7) * 8;
            unsigned short e[8];
#pragma unroll
            for (int j = 0; j < 8; ++j) e[j] = T[(cg + j) * 72 + tok];
            u32x4 ov; ov.x = e[0] | ((unsigned)e[1] << 16); ov.y = e[2] | ((unsigned)e[3] << 16); ov.z = e[4] | ((unsigned)e[5] << 16); ov.w = e[6] | ((unsigned)e[7] << 16);
            *(u32x4*)(YMIX + (size_t)(tk0 + tok) * D + c0 + cg) = ov;
        }
    }
    if constexpr (PH == PH_GOUT) {
        EpiRes e{(bf16_t*)(ws + (ALT ? WS_Y : WS_XB)), 0, (float*)(ws + WS_SSP), hidden_tid(wv) & 63};
        gemm_dense(YMIX, (const bf16_t*)(ws + (even ? WS_W_EOUT : WS_W_OOUT)) + (size_t)lj * 1024 * 1024, 1024, 64, 4, e, bid, nb, wv);
    }
    if constexpr (PH == PH_GQ) {
        for (int u = bid; u < 128 + 32; u += nb) {
            if (u < 128) {
                const int pm = u >> 1, pn = u & 1;
                EpiTokRstd e{QX, 512, pm * 256, (const float*)(ws + WS_SSP), hidden_tid(wv) & 63};
                gemm_tile((const bf16_t*)(ws + WS_XB) + (size_t)pm * 256 * 1024, (const bf16_t*)(ws + WS_W_CQ) + (size_t)layer * 512 * 1024, 1024, pn * 256, RowIdent{}, e, wv);
            } else {
                const int v = u - 128, pm = v >> 2, pn = v & 3;
                EpiSplit e{nullptr, (bf16_t*)(ws + WS_XK) + (size_t)layer * 2048 * 512, (bf16_t*)(ws + WS_XVT) + (size_t)layer * 512 * 2048, 0, 512, 512, (size_t)2048, pm * 256, nullptr};
                gemm_tile((const bf16_t*)(ws + WS_MEMN) + (size_t)pm * 256 * 1024, (const bf16_t*)(ws + WS_W_CKV) + (size_t)layer * 1024 * 1024, 1024, pn * 256, RowIdent{}, e, wv);
            }
        }
    }
    if constexpr (PH == PH_XATT) {
        const bf16_t* xk = (const bf16_t*)(ws + WS_XK) + (size_t)layer * 2048 * 512;
        const bf16_t* xvt = (const bf16_t*)(ws + WS_XVT) + (size_t)layer * 512 * 2048;
        for (int u = bid; u < 256; u += nb) {
            const int b = u >> 5, h = (u >> 3) & 3, qb = u & 7;
            attn2_unit<2>(QX + (size_t)(b * S) * 512 + h * 128, 512, xk + (size_t)(b * MEM) * 512 + h * 128, 512,
                          xvt + (size_t)(h * 128) * 2048 + b * MEM, (size_t)2048, qb * 256, 0, MEM,
                          0.08838834764831845f, nullptr, 0, OX + (size_t)(b * S) * 512 + h * 128, 512, wv);
        }
    }
    if constexpr (PH == PH_GO) {
        EpiRes e{(bf16_t*)(ws + (ALT ? WS_Y : WS_XB)), 0, nullptr, hidden_tid(wv) & 63};
        gemm_dense(OX, (const bf16_t*)(ws + WS_W_CO) + (size_t)layer * 1024 * 512, 512, 64, 4, e, bid, nb, wv);
    }
    if constexpr (PH == PH_ROUTE) { route_phase<ALT>(p, layer, bid, nb, wv); }
    if constexpr (PH == PH_GOR) { gor_phase<ALT>(p, layer, bid, nb, wv); }
    if constexpr (PH == PH_G1) {
        const int* CNT = (const int*)(ws + WS_CNT) + layer * NEXP * CNT_STRIDE;
        const int* LIST = (const int*)(ws + WS_LIST);
        unsigned* head = (unsigned*)(ws + WS_QHEAD) + layer * 64;
        unsigned* done = (unsigned*)(ws + WS_DONE) + layer * 32 * 64;
        int* uq = (int*)((char*)shm + LDS_ROUTE + 1024);
        int* pre = uq + 16;
        int* cn = pre + 40;
        const int tid = hidden_tid(wv);
        __syncthreads();
        if (tid < 64) {
            const int lane = tid;
            const int c = lane < 32 ? CNT[lane * CNT_STRIDE] : 0;
            int incl = ((c + 255) >> 8) * 4;
#pragma unroll
            for (int d = 1; d < 32; d <<= 1) { const int v = __builtin_amdgcn_ds_bpermute(((lane - d) & 63) << 2, incl); if (lane >= d) incl += v; }
            if (lane < 32) { pre[lane + 1] = incl; cn[lane] = c; }
            if (lane == 0) pre[0] = 0;
        }
        typedef __attribute__((address_space(1))) unsigned gu32_t;
        unsigned nxt_v = 0u;
        if (tid == 0) nxt_v = __hip_atomic_fetch_add((gu32_t*)head, 1u, __ATOMIC_RELAXED, __HIP_MEMORY_SCOPE_AGENT);
        __syncthreads();
        const int total = __builtin_amdgcn_readfirstlane(pre[32]);
        for (;;) {
            if (tid == 0) *uq = (int)nxt_v;
            __syncthreads();
            const int uall = __builtin_amdgcn_readfirstlane(*uq);
            if (uall >= 2 * total) break;
            if (tid == 0) nxt_v = __hip_atomic_fetch_add((gu32_t*)head, 1u, __ATOMIC_RELAXED, __HIP_MEMORY_SCOPE_AGENT);
            const bool second = uall >= total;
            const int u = second ? uall - total : uall;
            int e, base, tl, cnt;
            {
                const int l5 = hidden_tid(wv) & 31;
                const int lo = pre[l5], hi = pre[l5 + 1];
                const unsigned long long bal = __builtin_amdgcn_ballot_w64(u >= lo && u < hi);
                e = __builtin_amdgcn_readfirstlane((int)__builtin_ctzll(bal));
                base = __builtin_amdgcn_readfirstlane(pre[e]); cnt = __builtin_amdgcn_readfirstlane(cn[e]); tl = (cnt + 255) >> 8;
            }
            const int r = u - base, pn = r / tl, pm = r % tl;
            const int* list = LIST + (size_t)e * NTOK;
            if (!second) {
                EpiGateUp ep{(bf16_t*)(ws + WS_ACT), list, cnt, pm * 256, (const float*)(ws + WS_RP) + (size_t)e * NTOK};
                gemm_tile((const bf16_t*)(ws + WS_XB), (const bf16_t*)(ws + WS_W_GU) + ((size_t)layer * NEXP + e) * 1024 * 1024, 1024, pn * 256, RowTok{list, cnt, pm * 256}, ep, wv);
                asm volatile("s_waitcnt vmcnt(0)" ::: "memory");
                if ((hidden_tid(wv) & 63) == 0) (void)__hip_atomic_fetch_add(done + e * 64 + pm, 1u, __ATOMIC_RELAXED, __HIP_MEMORY_SCOPE_AGENT);
            } else {
                if (tid < 64) {
                    unsigned spins = 0;
                    while ((unsigned)__builtin_amdgcn_readfirstlane(__hip_atomic_load(done + e * 64 + pm, __ATOMIC_RELAXED, __HIP_MEMORY_SCOPE_AGENT)) < 32u) {
                        __builtin_amdgcn_s_sleep(2);
                        if (++spins > (1u << 24)) break;
                    }
                    __builtin_amdgcn_fence(__ATOMIC_ACQUIRE, "agent");
                    asm volatile("s_waitcnt vmcnt(0)" ::: "memory");
                }
                __syncthreads();
                EpiDown ep{(bf16_t*)(ws + WS_Y), list, cnt, pm * 256};
                gemm_tile((const bf16_t*)(ws + WS_ACT), (const bf16_t*)(ws + WS_W_DN) + ((size_t)layer * NEXP + e) * 1024 * 512, 512, pn * 256, RowAsg{list, cnt, pm * 256}, ep, wv);
            }
        }
    }
    if constexpr (PH == PH_FINAL) { norm_phase<2>(p, DEPTH, p.in[33], bid, nb, wv); }
}

#if ONE_LAUNCH
__global__ void __launch_bounds__(NT, 2) k_mega(Params p_) {
    ParamsK p = (ParamsK)__builtin_amdgcn_kernarg_segment_ptr();
    volatile LAS unsigned* st = (volatile LAS unsigned*)((char*)shm + LDS_XB);
    if (threadIdx.x < 4) st[threadIdx.x] = 0u;
    __syncthreads();
    const XcdBarrier bar = xcd_barrier_post((unsigned*)(p->ws + WS_BAR), st);
    const int bid = blockIdx.x, nb = gridDim.x, wv = __builtin_amdgcn_readfirstlane(threadIdx.x >> 6);
    run_phase<PH_P0>(p, 0, bid, nb, wv); xcd_barrier(bar); if (DUP == PH_P0) { run_phase<PH_P0, true>(p, 0, bid, nb, wv); xcd_barrier(bar); }
#pragma unroll 1
    for (int layer = 0; layer < DEPTH; ++layer) {
        run_phase<PH_N1>(p, layer, bid, nb, wv); xcd_barrier(bar); if (DUP == PH_N1) { run_phase<PH_N1, true>(p, layer, bid, nb, wv); xcd_barrier(bar); }
        run_phase<PH_GIN>(p, layer, bid, nb, wv); xcd_barrier(bar); if (DUP == PH_GIN) { run_phase<PH_GIN, true>(p, layer, bid, nb, wv); xcd_barrier(bar); }
        run_phase<PH_MIX>(p, layer, bid, nb, wv); xcd_barrier(bar); if (DUP == PH_MIX && (DUPSEL == 0 || (DUPSEL != 2 && (layer & 1) == 0) || (DUPSEL == 2 && (layer & 1) == 1))) { run_phase<PH_MIX, true>(p, layer, bid, nb, wv); xcd_barrier(bar); }
        if ((layer & 1) == 0) { run_phase<PH_TR>(p, layer, bid, nb, wv); xcd_barrier(bar); }
        run_phase<PH_GOUT>(p, layer, bid, nb, wv); xcd_barrier(bar); if (DUP == PH_GOUT) { run_phase<PH_GOUT, true>(p, layer, bid, nb, wv); xcd_barrier(bar); }
        run_phase<PH_GQ>(p, layer, bid, nb, wv); xcd_barrier(bar); if (DUP == PH_GQ) { run_phase<PH_GQ, true>(p, layer, bid, nb, wv); xcd_barrier(bar); }
        run_phase<PH_XATT>(p, layer, bid, nb, wv); xcd_barrier(bar); if (DUP == PH_XATT) { run_phase<PH_XATT, true>(p, layer, bid, nb, wv); xcd_barrier(bar); }
        run_phase<PH_GOR>(p, layer, bid, nb, wv); xcd_barrier(bar);
        run_phase<PH_G1>(p, layer, bid, nb, wv); xcd_barrier(bar); if (DUP == PH_G1) { run_phase<PH_G1, true>(p, layer, bid, nb, wv); xcd_barrier(bar); }
    }
    run_phase<PH_FINAL>(p, DEPTH, bid, nb, wv);
}
#else
template <int PH>
__global__ void __launch_bounds__(NT, 2) k_phase(Params p_, int layer) {
    run_phase<PH>((ParamsK)__builtin_amdgcn_kernarg_segment_ptr(), layer, blockIdx.x, gridDim.x, __builtin_amdgcn_readfirstlane(threadIdx.x >> 6));
}
template <int PH> static void launch_phase(const Params& p, int layer, int grid, hipStream_t stream) {
    static bool init = false;
    if (!init) { (void)hipFuncSetAttribute((const void*)k_phase<PH>, hipFuncAttributeMaxDynamicSharedMemorySize, LDS_BYTES); init = true; }
    hipLaunchKernelGGL(k_phase<PH>, dim3(grid), dim3(NT), LDS_BYTES, stream, p, layer);
}
#endif

extern "C" void kernel_launch(void* const* d_in, const int* in_sizes, int n_in, void* d_out, int out_size, void* d_ws, size_t ws_size, hipStream_t stream) {
    if (n_in != 34 || ws_size < WS_END) { fprintf(stderr, "kernel_launch: unexpected n_in %d or ws_size %zu (need %zu)\n", n_in, ws_size, (size_t)WS_END); return; }
    Params p{};
    for (int i = 0; i < 34; ++i) p.in[i] = (const float*)d_in[i];
    p.out = (float*)d_out; p.ws = (unsigned char*)d_ws;
    (void)hipMemsetAsync(d_ws, 0, WS_ZERO_BYTES, stream);
#if ONE_LAUNCH
    static int grid = 0;
    if (grid == 0) {
        int dev = 0, cus = 0, per_cu = 0;
        (void)hipGetDevice(&dev); (void)hipDeviceGetAttribute(&cus, hipDeviceAttributeMultiprocessorCount, dev);
        (void)hipFuncSetAttribute((const void*)k_mega, hipFuncAttributeMaxDynamicSharedMemorySize, LDS_BYTES);
        (void)hipOccupancyMaxActiveBlocksPerMultiprocessor(&per_cu, (const void*)k_mega, NT, LDS_BYTES);
        (void)hipGetLastError();
        grid = cus > 0 ? cus : 256;
    }
    hipLaunchKernelGGL(k_mega, dim3(grid), dim3(NT), LDS_BYTES, stream, p);
#else
    const int grid = 256;
    launch_phase<PH_P0>(p, 0, grid, stream);
    for (int layer = 0; layer < DEPTH; ++layer) {
        launch_phase<PH_N1>(p, layer, grid, stream);
        launch_phase<PH_GIN>(p, layer, grid, stream);
        launch_phase<PH_MIX>(p, layer, grid, stream);
        if ((layer & 1) == 0) launch_phase<PH_TR>(p, layer, grid, stream);
        launch_phase<PH_GOUT>(p, layer, grid, stream);
        launch_phase<PH_GQ>(p, layer, grid, stream);
        launch_phase<PH_XATT>(p, layer, grid, stream);
        launch_phase<PH_GOR>(p, layer, grid, stream);
        launch_phase<PH_G1>(p, layer, grid, stream);
    }
    launch_phase<PH_FINAL>(p, DEPTH, grid, stream);
#endif
}
```

```cpp
#include <hip/hip_runtime.h>
#include <stdint.h>
#include <stdio.h>

#ifndef RD_N
#define RD_N 1
#endif
#ifndef RD_E
#define RD_E 1
#endif
#ifndef RD_R
#define RD_R 1
#endif
#ifndef DUP
#define DUP -1
#endif
#ifndef DUPSEL
#define DUPSEL 0
#endif
#ifndef ONE_LAUNCH
#define ONE_LAUNCH 1
#endif

typedef unsigned short bf16_t;
typedef short bf16x8 __attribute__((ext_vector_type(8)));
typedef float f32x4 __attribute__((ext_vector_type(4)));
typedef float f32x16 __attribute__((ext_vector_type(16)));
typedef unsigned u32x4 __attribute__((ext_vector_type(4)));
typedef int i32x4 __attribute__((ext_vector_type(4)));
typedef unsigned u32x2 __attribute__((ext_vector_type(2)));

constexpr int Bb = 8, S = 2048, D = 1024, NTOK = Bb * S, DEPTH = 4, MEM = 256;
constexpr int NEXP = 32, EH = 512;
constexpr int NT = 512;
#ifndef NCONV_
#define NCONV_ 48
#endif
constexpr int NCONV = NCONV_;
constexpr float EPS = 1e-6f;

constexpr size_t al256(size_t x) { return (x + 255) & ~(size_t)255; }
constexpr size_t WS_BAR   = 0;
constexpr size_t WS_CNT   = 16384;
constexpr int    CNT_STRIDE = 64;
constexpr size_t WS_QHEAD = 16384 + 65536;
constexpr size_t WS_DONE  = WS_QHEAD + 4096;
constexpr size_t WS_ZERO_BYTES = WS_DONE + (size_t)4 * 32 * 64 * 4;
constexpr size_t WS_MISC  = WS_ZERO_BYTES;
constexpr size_t WS_W_EIN = 131072;
constexpr size_t WS_W_EOUT = WS_W_EIN + (size_t)2 * 3072 * 1024 * 2;
constexpr size_t WS_W_OIN = WS_W_EOUT + (size_t)2 * 1024 * 1024 * 2;
constexpr size_t WS_W_OOUT = WS_W_OIN + (size_t)2 * 1536 * 1024 * 2;
constexpr size_t WS_W_CQ  = WS_W_OOUT + (size_t)2 * 1024 * 1024 * 2;
constexpr size_t WS_W_CKV = WS_W_CQ + (size_t)4 * 512 * 1024 * 2;
constexpr size_t WS_W_CO  = WS_W_CKV + (size_t)4 * 1024 * 1024 * 2;
constexpr size_t WS_W_GU  = WS_W_CO + (size_t)4 * 1024 * 512 * 2;
constexpr size_t WS_W_DN  = WS_W_GU + (size_t)4 * 32 * 1024 * 1024 * 2;
constexpr size_t WS_MEMN  = WS_W_DN + (size_t)4 * 32 * 1024 * 512 * 2;
constexpr size_t WS_XK    = WS_MEMN + (size_t)2048 * 1024 * 2;
constexpr size_t WS_XVT   = WS_XK + (size_t)4 * 2048 * 512 * 2;
constexpr size_t WS_A2    = WS_XVT + (size_t)4 * 2048 * 512 * 2;
constexpr size_t WS_FILT  = WS_A2 + (size_t)2 * 2048 * 64 * 4;
constexpr size_t WS_X     = WS_FILT + (size_t)2 * 2 * 512 * 4096 * 2;
constexpr size_t WS_H     = WS_X + (size_t)NTOK * D * 4;
constexpr size_t WS_PROJ  = WS_H + al256((size_t)(NTOK + 1) * D * 2);
constexpr size_t WS_YMIX  = WS_PROJ + (size_t)NTOK * 3072 * 2;
constexpr size_t WS_QX    = WS_YMIX + (size_t)NTOK * D * 2;
constexpr size_t WS_OX    = WS_QX + (size_t)NTOK * 512 * 2;
constexpr size_t WS_ACT   = WS_OX + (size_t)NTOK * 512 * 2;
constexpr size_t WS_Y     = WS_ACT + al256((size_t)(2 * NTOK + 1) * EH * 2);
constexpr size_t WS_LIST  = WS_Y + (size_t)2 * NTOK * D * 2;
constexpr size_t WS_WT    = WS_LIST + (size_t)NEXP * NTOK * 4;
constexpr size_t WS_RSTD  = WS_WT + (size_t)2 * NTOK * 4;
constexpr size_t WS_WRT   = WS_RSTD + (size_t)NTOK * 4;
constexpr size_t WS_XB    = WS_WRT + (size_t)4 * 2 * 48 * 1024 * 2;
constexpr size_t WS_SSP   = WS_XB + al256((size_t)(NTOK + 1) * D * 2);
constexpr size_t WS_RS1   = WS_SSP + (size_t)NTOK * 16 * 4;
constexpr size_t WS_RP    = WS_RS1 + (size_t)NTOK * 4;
constexpr size_t WS_END   = WS_RP + (size_t)NEXP * NTOK * 4;
constexpr size_t PR_HYT   = 0;
constexpr size_t PR_QK    = (size_t)1536 * NTOK * 2;
constexpr size_t PR_VT    = PR_QK + (size_t)NTOK * 1024 * 2;
constexpr size_t PR_OVT   = (size_t)NTOK * 1280 * 2;

constexpr int LDS_XB = 147456;
constexpr int LDS_ROUTE = LDS_XB + 64;
constexpr int LDS_BYTES = LDS_ROUTE + 2048;

struct Params {
    const float* in[34];
    float* out;
    unsigned char* ws;
};

extern __shared__ __attribute__((aligned(16))) bf16_t shm[];

typedef float f32x2 __attribute__((ext_vector_type(2)));
typedef __bf16 bf16x2v __attribute__((ext_vector_type(2)));
__device__ __forceinline__ unsigned cvt_pk_bf16(float lo, float hi) { const f32x2 v = {lo, hi}; return __builtin_bit_cast(unsigned, __builtin_convertvector(v, bf16x2v)); }
__device__ __forceinline__ float bf2f(unsigned short b) { return __uint_as_float((unsigned)b << 16); }
__device__ __forceinline__ float bflo(unsigned w) { return __uint_as_float(w << 16); }
__device__ __forceinline__ float bfhi(unsigned w) { return __uint_as_float(w & 0xffff0000u); }
__device__ __forceinline__ float shx(float v, int m, int lane) { return __int_as_float(__builtin_amdgcn_ds_bpermute((lane ^ m) << 2, __float_as_int(v))); }
__device__ __forceinline__ float shl(float v, int src) { return __int_as_float(__builtin_amdgcn_ds_bpermute(src << 2, __float_as_int(v))); }
__device__ __forceinline__ float wave_sum(float v, int lane) {
    v += shx(v, 1, lane); v += shx(v, 2, lane); v += shx(v, 4, lane); v += shx(v, 8, lane); v += shx(v, 16, lane); v += shx(v, 32, lane); return v;
}

__device__ __forceinline__ float uni(float x) { return __builtin_bit_cast(float, __builtin_amdgcn_readfirstlane(__builtin_bit_cast(int, x))); }
__device__ __forceinline__ int hidden_tid(int wv) { int l; asm volatile("v_mbcnt_lo_u32_b32 %0, -1, 0\n\tv_mbcnt_hi_u32_b32 %0, -1, %0" : "=&v"(l)); return (wv << 6) | l; }

#define XB_TMO      128
#define XB_XCNT(j)  (256  + 64 * (j))
#define XB_XSUB(j)  (1280 + 64 * (j))
#define XB_XGEN(j)  (2304 + 64 * (j))
#define XB_TOP      3328
#define XB_TOPGEN   3392
#define XCD_BAR_WORDS 3456
#define XB_SPIN_CAP (1u << 22)
#define LAS __attribute__((address_space(3)))

__device__ __forceinline__ unsigned xb_ld(unsigned* p)              { return __hip_atomic_load(p, __ATOMIC_RELAXED, __HIP_MEMORY_SCOPE_AGENT); }
__device__ __forceinline__ unsigned xb_add(unsigned* p, unsigned v) { return __hip_atomic_fetch_add(p, v, __ATOMIC_RELAXED, __HIP_MEMORY_SCOPE_AGENT); }
__device__ __forceinline__ unsigned xb_xcc_id() { return (unsigned)__builtin_amdgcn_s_getreg((3 << 11) | 20) & 0xFu; }
#define XB_SPIN(cond, bar) do { unsigned _sp = 0; while (cond) { __builtin_amdgcn_s_sleep(1); \
    if ((++_sp & 255u) == 0u) { if (xb_ld(&(bar)[XB_TMO])) break; if (_sp > XB_SPIN_CAP) { atomicAdd(&(bar)[XB_TMO], 1u); break; } } } } while (0)

struct XcdBarrier { unsigned* bar; unsigned x; volatile LAS unsigned* st; };

__device__ __forceinline__ XcdBarrier xcd_barrier_post(unsigned* bar, volatile LAS unsigned* st) {
    XcdBarrier b; b.bar = bar; b.x = xb_xcc_id(); b.st = st;
    if (threadIdx.x == 0) (void)xb_add(&bar[XB_XCNT(b.x)], 1u);
    return b;
}
__device__ __forceinline__ void xcd_barrier_complete(unsigned* bar, unsigned x, unsigned& nloc, unsigned& nx) {
    const unsigned G = gridDim.x * gridDim.y * gridDim.z;
    unsigned sum, cnt, mine, sp = 0u;
    for (;;) {
        sum = 0u; cnt = 0u; mine = 0u;
#pragma unroll
        for (unsigned j = 0; j < 16; ++j) { const unsigned c = xb_ld(&bar[XB_XCNT(j)]); sum += c; cnt += (c > 0u) ? 1u : 0u; mine = (j == x) ? c : mine; }
        if (sum == G) break;
        __builtin_amdgcn_s_sleep(1);
        if ((++sp & 255u) == 0u) { if (xb_ld(&bar[XB_TMO])) break; if (sp > XB_SPIN_CAP) { atomicAdd(&bar[XB_TMO], 1u); break; } }
    }
    nloc = mine > 0u ? mine : 1u; nx = cnt > 0u ? cnt : 1u;
}
__device__ __forceinline__ void xcd_barrier(const XcdBarrier& b) {
    asm volatile("s_waitcnt vmcnt(0)" ::: "memory");
    __syncthreads();
    if (threadIdx.x == 0) {
        unsigned* bar = b.bar; unsigned bx = b.x;
        asm volatile("" : "+s"(bar), "+s"(bx));
        __builtin_amdgcn_s_waitcnt(0);
        unsigned nloc = b.st[0], nx = b.st[1];
        if (nloc == 0u) { xcd_barrier_complete(bar, bx, nloc, nx); b.st[0] = nloc; b.st[1] = nx; }
        const unsigned old = xb_add(&bar[XB_XSUB(bx)], 1u);
        const unsigned gen = old / nloc;
        if (old + 1u == (gen + 1u) * nloc) {
            __builtin_amdgcn_fence(__ATOMIC_RELEASE, "agent");
            asm volatile("s_waitcnt vmcnt(0)" ::: "memory");
            const unsigned og = xb_add(&bar[XB_TOP], 1u);
            const unsigned tg = og / nx;
            if (og + 1u == (tg + 1u) * nx) xb_add(&bar[XB_TOPGEN], 1u);
            else XB_SPIN(xb_ld(&bar[XB_TOPGEN]) == tg, bar);
            __builtin_amdgcn_fence(__ATOMIC_ACQUIRE, "agent");
            xb_add(&bar[XB_XGEN(bx)], 1u);
            asm volatile("s_waitcnt vmcnt(0)" ::: "memory");
        } else {
            XB_SPIN(xb_ld(&bar[XB_XGEN(bx)]) == gen, bar);
            __builtin_amdgcn_fence(__ATOMIC_ACQUIRE, "agent");
            asm volatile("s_waitcnt vmcnt(0)" ::: "memory");
        }
    }
    __syncthreads();
}

constexpr int HT = 128 * 64;
constexpr int EPI_PRE_OFF = 131072;
__device__ __forceinline__ int lds_byte(int r, int c) {
    int st = (r >> 4) * 2 + (c >> 5), rr = r & 15, cc = c & 31, ob = rr * 64 + cc * 2;
    return st * 1024 + (ob ^ (((ob >> 9) & 1) << 5));
}
__device__ __forceinline__ void stage_rc(int b, int& R, int& C) {
    int st = b / 1024, sb = b % 1024, swz = sb ^ (((sb >> 9) & 1) << 5);
    R = (st >> 1) * 16 + swz / 64; C = (st & 1) * 32 + (swz % 64) / 2;
}
__device__ __forceinline__ int lds_byteG(int r, int c) { return r * 128 + ((((c >> 3) ^ (r >> 1)) & 7) << 4) + (c & 7) * 2; }
__device__ __forceinline__ void stage_rcG(int b, int& R, int& C) { R = b >> 7; C = ((((b >> 4) ^ (R >> 1)) & 7)) * 8; }
#define SA(b, h) (shm + ((b) * 2 + (h)) * HT)
#define SB(b, h) (shm + (4 + (b) * 2 + (h)) * HT)
#define G_STAGE_A(P_, h, kt) do { _Pragma("unroll") for (int _i = 0; _i < 2; ++_i) \
    __builtin_amdgcn_global_load_lds((const unsigned*)((const char*)A + (size_t)((kt) * 128 + (RowSrc::DENSE ? (h) * 256 * K + _i * 128 * K : 0)) + aoff[RowSrc::DENSE ? 0 : (h)][RowSrc::DENSE ? 0 : _i]), (unsigned*)((char*)(P_) + tid * 16 + _i * 8192), 16, 0, 0); } while (0)
#define G_STAGE_B(P_, h, kt) do { _Pragma("unroll") for (int _i = 0; _i < 2; ++_i) \
    __builtin_amdgcn_global_load_lds((const unsigned*)((const char*)Bt + (size_t)((kt) * 128 + (HALFN ? 0 : (h) * 64 * K) + _i * (HALFN ? 128 : 256) * K) + boff[0]), (unsigned*)((char*)(P_) + tid * 16 + _i * 8192), 16, 0, 0); } while (0)
#define G_LDA(dst, b, h) if (!RAG || actv[h]) _Pragma("unroll") for (int m = 0; m < 4; ++m) _Pragma("unroll") for (int k = 0; k < 2; ++k) \
    dst[m][k] = *reinterpret_cast<const bf16x8*>((char*)SA(b, h) + (faA ^ (k * 64)) + m * 2048)
#define G_LDB(dst, b, h) _Pragma("unroll") for (int n = 0; n < 2; ++n) _Pragma("unroll") for (int k = 0; k < 2; ++k) \
    dst[n][k] = *reinterpret_cast<const bf16x8*>((char*)SB(b, h) + (faB ^ (k * 64)) + n * 2048)
#define G_MMA(ai, bj, At_, Bt_) do { if (RAG && !actv[ai]) break; __builtin_amdgcn_s_setprio(1); \
    _Pragma("unroll") for (int m = 0; m < 4; ++m) _Pragma("unroll") for (int n = 0; n < 2; ++n) _Pragma("unroll") for (int k = 0; k < 2; ++k) \
      acc[ai][bj][m][n] = SWAP ? __builtin_amdgcn_mfma_f32_16x16x32_bf16(At_[m][k], Bt_[n][k], acc[ai][bj][m][n], 0, 0, 0) \
                               : __builtin_amdgcn_mfma_f32_16x16x32_bf16(Bt_[n][k], At_[m][k], acc[ai][bj][m][n], 0, 0, 0); \
    __builtin_amdgcn_s_setprio(0); } while (0)
#define G_MMB1(ai) do { if (!HALFN) G_MMA(ai, 1, At, B1); } while (0)
#define WAIT_V(n) asm volatile("s_waitcnt vmcnt(" #n ")" ::: "memory")
#define WAIT_L(n) asm volatile("s_waitcnt lgkmcnt(" #n ")" ::: "memory")
#define BAR __builtin_amdgcn_s_barrier()
#define SCHED __builtin_amdgcn_sched_barrier(0)

typedef f32x4 AccT[2][2][4][2];

template <class E> __device__ __forceinline__ void epi_pre(const E&, int) {}
template <class RowSrc, class Epi, bool HALFN = false, bool SWAP = false, bool RAG = false>
__device__ __forceinline__ void gemm_tile(const bf16_t* __restrict__ A, const bf16_t* __restrict__ Bt, const int K,
                                          const int bcol, const RowSrc& rs, const Epi& epi, const int wv, const int ntl = 0, const int vrows = 256) {
    const int tid = hidden_tid(wv);
    int wid = tid >> 6, lane = tid & 63, wr = wid >> 2, wc = wid & 3, fr = lane & 15, fq = lane >> 4;
    unsigned aoff[2][2], boff[2];
#pragma unroll
    for (int i = 0; i < 2; ++i) {
        int R, C; stage_rcG(tid * 16 + i * 8192, R, C);
        boff[i] = HALFN ? (unsigned)(((bcol + R) * K + C) * 2) : (unsigned)(((bcol + (R >> 5) * 64 + (R & 31)) * K + C) * 2);
        if (RowSrc::DENSE) { aoff[0][i] = (unsigned)((R * K + C) * 2); aoff[1][i] = 0u; }
        else {
#pragma unroll
            for (int h = 0; h < 2; ++h) aoff[h][i] = (unsigned)((rs(h * 128 + R) * K + C) * 2);
        }
    }
    int faA = wr * 8192 + fr * 128 + (((fq ^ (fr >> 1)) & 7) << 4), faB = wc * 4096 + fr * 128 + (((fq ^ (fr >> 1)) & 7) << 4);
    asm volatile("" : "+v"(faA), "+v"(faB));
    bool actv[2] = {true, true};
    if constexpr (RAG) { const int vr = __builtin_amdgcn_readfirstlane(vrows - (wid >> 2) * 64); actv[0] = vr > 0; actv[1] = vr > 128; }
    AccT acc = {};
    bf16x8 At[4][2], B0[2][2], B1[2][2];
    const int nt = ntl ? ntl : K / 64;
    epi_pre(epi, tid);
    G_STAGE_B(SB(0, 0), 0, 0); G_STAGE_A(SA(0, 0), 0, 0);
    G_STAGE_B(SB(0, 1), 1, 0); G_STAGE_A(SA(0, 1), 1, 0);
    if (wr == 1) BAR;
    WAIT_V(4); BAR;
    G_STAGE_B(SB(1, 0), 0, 1); G_STAGE_A(SA(1, 0), 0, 1); G_STAGE_B(SB(1, 1), 1, 1);
    WAIT_V(6); BAR;
    for (int t = 0; t < nt - 2; t += 2) {
        G_LDB(B0, 0, 0); SCHED; G_LDA(At, 0, 0); G_STAGE_A(SA(1, 1), 1, t + 1);
        WAIT_L(8); BAR; WAIT_L(0); G_MMA(0, 0, At, B0); BAR; SCHED;
        if (!HALFN) G_LDB(B1, 0, 1); G_STAGE_B(SB(0, 0), 0, t + 2);
        BAR; WAIT_L(0); G_MMB1(0); BAR;
        G_LDA(At, 0, 1); G_STAGE_A(SA(0, 0), 0, t + 2);
        BAR; WAIT_L(0); G_MMA(1, 0, At, B0); BAR; SCHED;
        G_STAGE_B(SB(0, 1), 1, t + 2);
        WAIT_V(6); BAR; G_MMB1(1); BAR;
        G_LDB(B0, 1, 0); SCHED; G_LDA(At, 1, 0); G_STAGE_A(SA(0, 1), 1, t + 2);
        WAIT_L(8); BAR; WAIT_L(0); G_MMA(0, 0, At, B0); BAR; SCHED;
        if (!HALFN) G_LDB(B1, 1, 1); G_STAGE_B(SB(1, 0), 0, t + 3);
        BAR; WAIT_L(0); G_MMB1(0); BAR;
        G_LDA(At, 1, 1); G_STAGE_A(SA(1, 0), 0, t + 3);
        BAR; WAIT_L(0); G_MMA(1, 0, At, B0); BAR; SCHED;
        G_STAGE_B(SB(1, 1), 1, t + 3);
        WAIT_V(6); BAR; G_MMB1(1); BAR;
    }
    { G_LDB(B0, 0, 0); WAIT_V(0); G_LDA(At, 0, 0); G_STAGE_A(SA(1, 1), 1, nt - 1);
      BAR; WAIT_L(0); G_MMA(0, 0, At, B0); BAR;
      if (!HALFN) G_LDB(B1, 0, 1); BAR; WAIT_L(0); G_MMB1(0); BAR;
      G_LDA(At, 0, 1); WAIT_V(4); BAR; WAIT_L(0); G_MMA(1, 0, At, B0); G_MMB1(1); BAR; }
    { G_LDB(B0, 1, 0); G_LDA(At, 1, 0); WAIT_V(2); BAR; WAIT_L(0); G_MMA(0, 0, At, B0); BAR;
      if (!HALFN) G_LDB(B1, 1, 1); WAIT_V(0); BAR; WAIT_L(0); G_MMB1(0); BAR;
      G_LDA(At, 1, 1); BAR; WAIT_L(0); G_MMA(1, 0, At, B0); G_MMB1(1); BAR; }
    if (wr == 0) BAR;
    int tz = hidden_tid(wv); wid = tz >> 6; lane = tz & 63; wr = wid >> 2; wc = wid & 3; fr = lane & 15; fq = lane >> 4;
    if constexpr (SWAP) epi(acc, wr * 64 + fq * 4, HALFN ? bcol + wc * 32 + fr : bcol + wc * 64 + fr);
    else epi(acc, wr * 64 + fr, HALFN ? bcol + wc * 32 + fq * 4 : bcol + wc * 64 + fq * 4);
}

struct RowIdent { static constexpr bool DENSE = true; __device__ __forceinline__ int operator()(int r) const { return r; } };

__device__ __forceinline__ void st_bf16x4(bf16_t* p, const f32x4& v) { u32x2 w; w.x = cvt_pk_bf16(v[0], v[1]); w.y = cvt_pk_bf16(v[2], v[3]); *(u32x2*)p = w; }
__device__ __forceinline__ void st_chan4(bf16_t* q, size_t ld, const f32x4& v) {
    const unsigned a = cvt_pk_bf16(v[0], v[1]), b = cvt_pk_bf16(v[2], v[3]);
    q[0] = (bf16_t)(a & 0xffff); q[ld] = (bf16_t)(a >> 16); q[2 * ld] = (bf16_t)(b & 0xffff); q[3 * ld] = (bf16_t)(b >> 16);
}
constexpr int BJS = 32;
#define EPI_LOOP_AM _Pragma("unroll") for (int ai = 0; ai < 2; ++ai) _Pragma("unroll") for (int m = 0; m < 4; ++m)
#define EPI_LOOP_BN _Pragma("unroll") for (int bj = 0; bj < 2; ++bj) _Pragma("unroll") for (int n = 0; n < 2; ++n)
struct EpiRes {
    bf16_t* XB; int brow; float* ssp; int lane;
    __device__ __forceinline__ void operator()(AccT& acc, int r0, int c0) const {
        u32x2 xv[2][4][4];
        EPI_LOOP_AM {
            const bf16_t* qb = XB + (size_t)(brow + r0 + ai * 128 + m * 16) * D + c0;
            EPI_LOOP_BN xv[ai][m][bj * 2 + n] = *(const u32x2*)(qb + bj * BJS + n * 16);
        }
        EPI_LOOP_AM {
            const int row = brow + r0 + ai * 128 + m * 16;
            bf16_t* qb = XB + (size_t)row * D + c0;
            float ss = 0.f;
            EPI_LOOP_BN {
                const u32x2 x = xv[ai][m][bj * 2 + n];
                const f32x4 t = (f32x4){bflo(x.x), bfhi(x.x), bflo(x.y), bfhi(x.y)} + acc[ai][bj][m][n];
                const unsigned a0 = cvt_pk_bf16(t[0], t[1]), a1 = cvt_pk_bf16(t[2], t[3]);
                *(u32x2*)(qb + bj * BJS + n * 16) = (u32x2){a0, a1};
                const float r0f = bflo(a0), r1f = bfhi(a0), r2f = bflo(a1), r3f = bfhi(a1);
                ss += (r0f * r0f + r1f * r1f) + (r2f * r2f + r3f * r3f);
            }
            if (ssp) { ss += shx(ss, 16, lane); ss += shx(ss, 32, lane); if ((lane >> 4) == 0) ssp[(size_t)row * 16 + (c0 >> 6)] = ss; }
        }
    }
};
__device__ __forceinline__ float row16_sum(float v) {
    v += __int_as_float(__builtin_amdgcn_update_dpp(0, __float_as_int(v), 0x128, 0xf, 0xf, false));
    v += __int_as_float(__builtin_amdgcn_update_dpp(0, __float_as_int(v), 0x124, 0xf, 0xf, false));
    v += __int_as_float(__builtin_amdgcn_update_dpp(0, __float_as_int(v), 0x122, 0xf, 0xf, false));
    v += __int_as_float(__builtin_amdgcn_update_dpp(0, __float_as_int(v), 0x121, 0xf, 0xf, false));
    return v;
}
struct EpiResS {
    bf16_t* XB; int brow; float* ssp; int lane;
    __device__ __forceinline__ void operator()(AccT& acc, int r0, int c0) const {
#pragma unroll
        for (int ai = 0; ai < 2; ++ai) {
            bf16_t xv[4][4][4];
#pragma unroll
            for (int m = 0; m < 4; ++m) {
                const bf16_t* qb = XB + (size_t)(brow + r0 + ai * 128 + m * 16) * D + c0;
                EPI_LOOP_BN {
#pragma unroll
                    for (int j = 0; j < 4; ++j) xv[m][bj * 2 + n][j] = qb[(size_t)j * D + bj * BJS + n * 16];
                }
            }
#pragma unroll
            for (int m = 0; m < 4; ++m) {
                const int row = brow + r0 + ai * 128 + m * 16;
                bf16_t* qb = XB + (size_t)row * D + c0;
                f32x4 ss = {0.f, 0.f, 0.f, 0.f};
                EPI_LOOP_BN {
                    f32x4 t;
#pragma unroll
                    for (int j = 0; j < 4; ++j) t[j] = __uint_as_float((unsigned)xv[m][bj * 2 + n][j] << 16) + acc[ai][bj][m][n][j];
                    const unsigned a0 = cvt_pk_bf16(t[0], t[1]), a1 = cvt_pk_bf16(t[2], t[3]);
                    bf16_t* q = qb + bj * BJS + n * 16;
                    q[0] = (bf16_t)(a0 & 0xffff); q[D] = (bf16_t)(a0 >> 16); q[2 * D] = (bf16_t)(a1 & 0xffff); q[3 * D] = (bf16_t)(a1 >> 16);
                    const f32x4 r = {bflo(a0), bfhi(a0), bflo(a1), bfhi(a1)};
                    ss += r * r;
                }
                if (ssp) {
#pragma unroll
                    for (int j = 0; j < 4; ++j) { const float sj = row16_sum(ss[j]); if ((lane & 15) == 0) ssp[(size_t)(row + j) * 16 + (c0 >> 6)] = sj; }
                }
            }
        }
    }
};
struct EpiResL {
    bf16_t* XB; int brow; float* ssp; int lane;
    __device__ __forceinline__ void operator()(AccT& acc, int r0, int c0) const {
        const int wr = __builtin_amdgcn_readfirstlane(r0 >> 6), cb = __builtin_amdgcn_readfirstlane(c0 & ~63);
        char* const pat = (char*)shm + (wr * 4 + ((cb & 255) >> 6)) * (128 * 144);
        char* const xbase = (char*)(XB + (size_t)(brow + wr * 64) * D + cb);
        const unsigned xvoff = (unsigned)((lane >> 3) * (D * 2) + (lane & 7) * 16);
        char* const pw = pat + (lane >> 3) * 144 + (lane & 7) * 16;
        u32x4 xr[16];
#pragma unroll
        for (int it = 0; it < 16; ++it) xr[it] = *(const u32x4*)(xbase + (size_t)((it >> 3) * 128 + (it & 7) * 8) * (D * 2) + xvoff);
#pragma unroll
        for (int it = 0; it < 16; ++it) *(u32x4*)(pw + it * (8 * 144)) = xr[it];
        EPI_LOOP_AM {
            const int row = brow + r0 + ai * 128 + m * 16;
            char* const q = pat + (ai * 64 + m * 16 + (r0 & 15)) * 144 + (c0 & 63) * 2;
            float ss = 0.f;
            EPI_LOOP_BN {
                const u32x2 x = *(const u32x2*)(q + (bj * BJS + n * 16) * 2);
                const f32x4 t = (f32x4){bflo(x.x), bfhi(x.x), bflo(x.y), bfhi(x.y)} + acc[ai][bj][m][n];
                const unsigned a0 = cvt_pk_bf16(t[0], t[1]), a1 = cvt_pk_bf16(t[2], t[3]);
                *(u32x2*)(q + (bj * BJS + n * 16) * 2) = (u32x2){a0, a1};
                const float r0f = bflo(a0), r1f = bfhi(a0), r2f = bflo(a1), r3f = bfhi(a1);
                ss += (r0f * r0f + r1f * r1f) + (r2f * r2f + r3f * r3f);
            }
            if (ssp) { ss += shx(ss, 16, lane); ss += shx(ss, 32, lane); if ((lane >> 4) == 0) ssp[(size_t)row * 16 + (c0 >> 6)] = ss; }
        }
#pragma unroll
        for (int it = 0; it < 16; ++it) {
            const u32x4 v = *(const u32x4*)(pw + it * (8 * 144));
            *(u32x4*)(xbase + (size_t)((it >> 3) * 128 + (it & 7) * 8) * (D * 2) + xvoff) = v;
        }
        __syncthreads();
    }
};
struct EpiSplit {
    bf16_t* Ca; bf16_t* T; bf16_t* Cb; int c0s, c1s, ldT; size_t ldC; int brow; const float* rs;
    __device__ __forceinline__ void chan(AccT& acc, bf16_t* base, int r0, int c, const float (&scv)[2][4]) const {
        EPI_LOOP_AM { const int row = brow + r0 + ai * 128 + m * 16; const float sc = scv[ai][m];
            bf16_t* q = base + (size_t)c * ldC + row;
            EPI_LOOP_BN st_chan4(q + (size_t)(bj * BJS + n * 16) * ldC, ldC, acc[ai][bj][m][n] * sc); }
    }
    __device__ __forceinline__ void operator()(AccT& acc, int r0, int c0) const {
        const int tilec = __builtin_amdgcn_readfirstlane(c0) & ~255;
        float scv[2][4];
        EPI_LOOP_AM scv[ai][m] = rs ? rs[brow + r0 + ai * 128 + m * 16] : 1.0f;
        if (tilec < c0s) chan(acc, Ca, r0, c0, scv);
        else if (tilec < c1s) {
            EPI_LOOP_AM { const int row = brow + r0 + ai * 128 + m * 16; const float sc = scv[ai][m];
                bf16_t* q = T + (size_t)row * ldT + (c0 - c0s);
                EPI_LOOP_BN st_bf16x4(q + bj * BJS + n * 16, acc[ai][bj][m][n] * sc); }
        } else chan(acc, Cb, r0, c0 - c1s, scv);
    }
};
struct EpiTokS {
    bf16_t* T; int ldT, brow, csub; const float* rs;
    __device__ __forceinline__ void operator()(AccT& acc, int r0, int c0) const {
        f32x4 scv[2][4];
        EPI_LOOP_AM scv[ai][m] = *(const f32x4*)(rs + brow + r0 + ai * 128 + m * 16);
        EPI_LOOP_AM {
            bf16_t* q = T + (size_t)(brow + r0 + ai * 128 + m * 16) * ldT + (c0 - csub);
            EPI_LOOP_BN st_chan4(q + bj * BJS + n * 16, (size_t)ldT, acc[ai][bj][m][n] * scv[ai][m]);
        }
    }
};
struct EpiTokSH {
    bf16_t* T; int ldT, brow, csub; const float* rs;
    __device__ __forceinline__ void operator()(AccT& acc, int r0, int c0) const {
        f32x4 scv[2][4];
        EPI_LOOP_AM scv[ai][m] = *(const f32x4*)(rs + brow + r0 + ai * 128 + m * 16);
        EPI_LOOP_AM {
            bf16_t* q = T + (size_t)(brow + r0 + ai * 128 + m * 16) * ldT + (c0 - csub);
#pragma unroll
            for (int n = 0; n < 2; ++n) st_chan4(q + n * 16, (size_t)ldT, acc[ai][0][m][n] * scv[ai][m]);
        }
    }
};
struct EpiSplitH {
    bf16_t* Ca; bf16_t* T; bf16_t* Cb; int c0s, c1s, ldT; size_t ldC; int brow; const float* rs;
    __device__ __forceinline__ void chan(AccT& acc, bf16_t* base, int r0, int c, const float (&scv)[2][4]) const {
        EPI_LOOP_AM { const int row = brow + r0 + ai * 128 + m * 16; const float sc = scv[ai][m];
            bf16_t* q = base + (size_t)c * ldC + row;
#pragma unroll
            for (int n = 0; n < 2; ++n) st_chan4(q + (size_t)(n * 16) * ldC, ldC, acc[ai][0][m][n] * sc); }
    }
    __device__ __forceinline__ void operator()(AccT& acc, int r0, int c0) const {
        const int tilec = __builtin_amdgcn_readfirstlane(c0) & ~127;
        float scv[2][4];
        EPI_LOOP_AM scv[ai][m] = rs ? rs[brow + r0 + ai * 128 + m * 16] : 1.0f;
        if (tilec < c0s) chan(acc, Ca, r0, c0, scv);
        else if (tilec < c1s) {
            EPI_LOOP_AM { const int row = brow + r0 + ai * 128 + m * 16; const float sc = scv[ai][m];
                bf16_t* q = T + (size_t)row * ldT + (c0 - c0s);
#pragma unroll
                for (int n = 0; n < 2; ++n) st_bf16x4(q + n * 16, acc[ai][0][m][n] * sc); }
        } else chan(acc, Cb, r0, c0 - c1s, scv);
    }
};
struct EpiTokRstd {
    bf16_t* T; int ldT, brow; const float* ssp; int lane;
    __device__ __forceinline__ void operator()(AccT& acc, int r0, int c0) const {
        f32x4 pv[2][4];
        EPI_LOOP_AM pv[ai][m] = *(const f32x4*)(ssp + (size_t)(brow + r0 + ai * 128 + m * 16) * 16 + (lane >> 4) * 4);
        EPI_LOOP_AM {
            const int row = brow + r0 + ai * 128 + m * 16;
            float ssq = (pv[ai][m][0] + pv[ai][m][1]) + (pv[ai][m][2] + pv[ai][m][3]);
            ssq += shx(ssq, 16, lane); ssq += shx(ssq, 32, lane);
            const float rs = rsqrtf(ssq * (1.0f / 1024.0f) + EPS);
            bf16_t* q = T + (size_t)row * ldT + c0;
            EPI_LOOP_BN st_bf16x4(q + bj * BJS + n * 16, acc[ai][bj][m][n] * rs);
        }
    }
};
struct EpiTokRstdH {
    bf16_t* T; int ldT, brow; const float* ssp; int lane;
    __device__ __forceinline__ void operator()(AccT& acc, int r0, int c0) const {
        f32x4 pv[2][4];
        EPI_LOOP_AM pv[ai][m] = *(const f32x4*)(ssp + (size_t)(brow + r0 + ai * 128 + m * 16) * 16 + (lane >> 4) * 4);
        EPI_LOOP_AM {
            const int row = brow + r0 + ai * 128 + m * 16;
            float ssq = (pv[ai][m][0] + pv[ai][m][1]) + (pv[ai][m][2] + pv[ai][m][3]);
            ssq += shx(ssq, 16, lane); ssq += shx(ssq, 32, lane);
            const float rs = rsqrtf(ssq * (1.0f / 1024.0f) + EPS);
            bf16_t* q = T + (size_t)row * ldT + c0;
#pragma unroll
            for (int n = 0; n < 2; ++n) st_bf16x4(q + n * 16, acc[ai][0][m][n] * rs);
        }
    }
};
struct EpiGateUp {
    bf16_t* act; const int* list; int cnt, pos0; const float* rp;
    __device__ __forceinline__ void operator()(AccT& acc, int r0, int c0) const {
        int av[2][4]; float rv[2][4];
        EPI_LOOP_AM { const int pos = pos0 + r0 + ai * 128 + m * 16, pc = pos < cnt ? pos : cnt - 1; av[ai][m] = list[pc]; rv[ai][m] = rp[pc]; }
        EPI_LOOP_AM {
            const int pos = pos0 + r0 + ai * 128 + m * 16;
            if (pos < cnt) {
                const int a = av[ai][m];
                const float rs = rv[ai][m];
                u32x4 ov;
#pragma unroll
                for (int bj = 0; bj < 2; ++bj) {
                    const f32x4 g = acc[ai][bj][m][0] * rs, u = acc[ai][bj][m][1] * rs; f32x4 o;
#pragma unroll
                    for (int j = 0; j < 4; ++j) o[j] = g[j] * __builtin_amdgcn_rcpf(1.0f + __builtin_amdgcn_exp2f(g[j] * -1.4426950408889634f)) * u[j];
                    if (bj == 0) { ov.x = cvt_pk_bf16(o[0], o[1]); ov.y = cvt_pk_bf16(o[2], o[3]); } else { ov.z = cvt_pk_bf16(o[0], o[1]); ov.w = cvt_pk_bf16(o[2], o[3]); }
                }
                bf16_t* dst = act + (size_t)a * EH + (c0 >> 6) * 32 + ((c0 >> 2) & 3) * 8;
                asm volatile("global_store_dwordx4 %0, %1, off sc1\n\ts_nop 1" :: "v"(dst), "v"(ov) : "memory");
            }
        }
    }
};
struct EpiGateUpL {
    bf16_t* act; const int* list; int cnt, pos0; const float* rp; int lane;
    __device__ __forceinline__ void operator()(AccT& acc, int r0, int c0) const {
        const int wr = __builtin_amdgcn_readfirstlane(r0 >> 6), cb = __builtin_amdgcn_readfirstlane(c0 >> 6);
        char* const pat = (char*)shm + (wr * 4 + (cb & 3)) * (128 * 80);
        float rv[2][4]; int av[8];
        const int* ldsi = (const int*)((const char*)shm + EPI_PRE_OFF); const float* ldsf = (const float*)((const char*)shm + EPI_PRE_OFF + 1024);
        EPI_LOOP_AM rv[ai][m] = ldsf[r0 + ai * 128 + m * 16];
#pragma unroll
        for (int it = 0; it < 8; ++it) av[it] = ldsi[wr * 64 + (it >> 2) * 128 + (it & 3) * 16 + (lane >> 2)];
        EPI_LOOP_AM {
            if (pos0 + wr * 64 + ai * 128 + m * 16 >= cnt) continue;
            const float rs = rv[ai][m];
            u32x4 ov;
#pragma unroll
            for (int bj = 0; bj < 2; ++bj) {
                const f32x4 g = acc[ai][bj][m][0] * rs, u = acc[ai][bj][m][1] * rs; f32x4 o;
#pragma unroll
                for (int j = 0; j < 4; ++j) o[j] = g[j] * __builtin_amdgcn_rcpf(1.0f + __builtin_amdgcn_exp2f(g[j] * -1.4426950408889634f)) * u[j];
                if (bj == 0) { ov.x = cvt_pk_bf16(o[0], o[1]); ov.y = cvt_pk_bf16(o[2], o[3]); } else { ov.z = cvt_pk_bf16(o[0], o[1]); ov.w = cvt_pk_bf16(o[2], o[3]); }
            }
            *(u32x4*)(pat + (ai * 64 + m * 16 + (r0 & 15)) * 80 + ((c0 >> 2) & 3) * 16) = ov;
        }
#pragma unroll
        for (int it = 0; it < 8; ++it) {
            const int pos = pos0 + wr * 64 + (it >> 2) * 128 + (it & 3) * 16 + (lane >> 2);
            const u32x4 ov = *(const u32x4*)(pat + (it * 16 + (lane >> 2)) * 80 + (lane & 3) * 16);
            bf16_t* dst = act + (size_t)av[it] * EH + cb * 32 + (lane & 3) * 8;
            if (pos < cnt) asm volatile("global_store_dwordx4 %0, %1, off sc1\n\ts_nop 1" :: "v"(dst), "v"(ov) : "memory");
        }
    }
};
__device__ __forceinline__ void epi_pre(const EpiGateUpL& e, int tid) {
    const int pos = e.pos0 + (tid & 255), pc = pos < e.cnt ? pos : e.cnt - 1;
    const unsigned* src = (tid < 256) ? (const unsigned*)(e.list + pc) : (const unsigned*)(e.rp + pc);
    __builtin_amdgcn_global_load_lds(src, (unsigned*)((char*)shm + EPI_PRE_OFF + tid * 4), 4, 0, 0);
}
struct EpiDown {
    bf16_t* y; const int* list; int cnt, pos0;
    __device__ __forceinline__ void operator()(AccT& acc, int r0, int c0) const {
        int av[2][4];
        EPI_LOOP_AM { const int pos = pos0 + r0 + ai * 128 + m * 16, pc = pos < cnt ? pos : cnt - 1; av[ai][m] = list[pc]; }
        EPI_LOOP_AM {
            const int pos = pos0 + r0 + ai * 128 + m * 16;
            if (pos < cnt) { bf16_t* q = y + (size_t)av[ai][m] * D + c0; EPI_LOOP_BN st_bf16x4(q + bj * BJS + n * 16, acc[ai][bj][m][n]); }
        }
    }
};
struct EpiDownS {
    bf16_t* y; const int* list; int cnt, pos0;
    __device__ __forceinline__ void operator()(AccT& acc, int r0, int c0) const {
        i32x4 av[2][4];
        const int* ldsi = (const int*)((const char*)shm + EPI_PRE_OFF);
        EPI_LOOP_AM av[ai][m] = *(const i32x4*)(ldsi + r0 + ai * 128 + m * 16);
        EPI_LOOP_AM {
            const int pos = pos0 + r0 + ai * 128 + m * 16;
            bf16_t* q0 = y + (size_t)av[ai][m][0] * D + c0; bf16_t* q1 = y + (size_t)av[ai][m][1] * D + c0;
            bf16_t* q2 = y + (size_t)av[ai][m][2] * D + c0; bf16_t* q3 = y + (size_t)av[ai][m][3] * D + c0;
            EPI_LOOP_BN {
                const f32x4 v = acc[ai][bj][m][n];
                const unsigned a = cvt_pk_bf16(v[0], v[1]), b = cvt_pk_bf16(v[2], v[3]);
                const int off = bj * BJS + n * 16;
                if (pos < cnt) q0[off] = (bf16_t)(a & 0xffff);
                if (pos + 1 < cnt) q1[off] = (bf16_t)(a >> 16);
                if (pos + 2 < cnt) q2[off] = (bf16_t)(b & 0xffff);
                if (pos + 3 < cnt) q3[off] = (bf16_t)(b >> 16);
            }
        }
    }
};
__device__ __forceinline__ void epi_pre(const EpiDownS& e, int tid) {
    const int pos = e.pos0 + (tid & 255), pc = pos < e.cnt ? pos : e.cnt - 1;
    if (tid < 256) __builtin_amdgcn_global_load_lds((const unsigned*)(e.list + pc), (unsigned*)((char*)shm + EPI_PRE_OFF + tid * 4), 4, 0, 0);
}
struct EpiDownL {
    bf16_t* y; const int* list; int cnt, pos0, lane;
    __device__ __forceinline__ void operator()(AccT& acc, int r0, int c0) const {
        const int wr = __builtin_amdgcn_readfirstlane(r0 >> 6), cb = __builtin_amdgcn_readfirstlane(c0 & ~63);
        char* const pat = (char*)shm + (wr * 4 + ((cb & 255) >> 6)) * (128 * 144);
        const int* ldsi = (const int*)((const char*)shm + LDS_ROUTE);
        EPI_LOOP_AM {
            if (pos0 + wr * 64 + ai * 128 + m * 16 >= cnt) continue;
            char* const q = pat + (ai * 64 + m * 16 + (r0 & 15)) * 144 + (c0 & 63) * 2;
            EPI_LOOP_BN { const f32x4 v = acc[ai][bj][m][n]; *(u32x2*)(q + (bj * BJS + n * 16) * 2) = (u32x2){cvt_pk_bf16(v[0], v[1]), cvt_pk_bf16(v[2], v[3])}; }
        }
        char* const pw = pat + (lane >> 3) * 144 + (lane & 7) * 16;
#pragma unroll
        for (int it = 0; it < 16; ++it) {
            const int pl = wr * 64 + (it >> 3) * 128 + (it & 7) * 8 + (lane >> 3);
            const int a = ldsi[pl];
            const u32x4 v = *(const u32x4*)(pw + it * (8 * 144));
            if (pos0 + pl < cnt) *(u32x4*)(y + (size_t)a * D + cb + (lane & 7) * 8) = v;
        }
    }
};
__device__ __forceinline__ void epi_pre(const EpiDownL& e, int tid) {
    const int pos = e.pos0 + (tid & 255), pc = pos < e.cnt ? pos : e.cnt - 1;
    if (tid < 256) __builtin_amdgcn_global_load_lds((const unsigned*)(e.list + pc), (unsigned*)((char*)shm + LDS_ROUTE + tid * 4), 4, 0, 0);
}
struct EpiNull {
    float* sink; int flag; int brow;
    __device__ __forceinline__ void operator()(AccT& acc, int r0, int c0) const {
        if (flag) { f32x4 t = {0.f, 0.f, 0.f, 0.f}; EPI_LOOP_AM EPI_LOOP_BN t += acc[ai][bj][m][n]; *(f32x4*)(sink + (size_t)(brow + r0) * 4 + c0) = t; }
    }
};
struct RowTok { static constexpr bool DENSE = false; const int* list; int cnt, pos0; __device__ __forceinline__ int operator()(int r) const { const int pos = pos0 + r; return pos < cnt ? (list[pos] >> 1) : NTOK; } };
struct RowAsg { static constexpr bool DENSE = false; const int* list; int cnt, pos0; __device__ __forceinline__ int operator()(int r) const { const int pos = pos0 + r; return pos < cnt ? list[pos] : 2 * NTOK; } };

constexpr int ATT_VOFF = 16384;
template <int MODE> struct ACfg;
template <> struct ACfg<0> { static constexpr int DQK = 64, DV = 128, NMAP = 2, KBLK = 2; };
template <> struct ACfg<1> { static constexpr int DQK = 64, DV = 64, NMAP = 1, KBLK = 1; };
template <> struct ACfg<2> { static constexpr int DQK = 128, DV = 128, NMAP = 1, KBLK = 2; };

template <int MODE, bool ALT = false>
__device__ __forceinline__ void attn_unit(const bf16_t* __restrict__ Qp, const int ldq,
                                          const bf16_t* __restrict__ Kp, const int ldk,
                                          const bf16_t* __restrict__ Vt, const size_t ldvt,
                                          const int q0, const int kbeg, const int kend,
                                          const float scale, const float slope, const float m_init, const float l_init,
                                          bf16_t* __restrict__ Op, const int ldo,
                                          const float lam, const float outscale, const float* __restrict__ subln, const int wv) {
    constexpr int DQK = ACfg<MODE>::DQK, DV = ACfg<MODE>::DV, NMAP = ACfg<MODE>::NMAP, KBLK = ACfg<MODE>::KBLK;
    const int tid = hidden_tid(wv), w = tid >> 6, lane = tid & 63, fr = lane & 15, fq = lane >> 4;
    const int qrow = q0 + w * 16 + fr;
    bf16x8 Qf[NMAP][DQK / 32];
#pragma unroll
    for (int m = 0; m < NMAP; ++m)
#pragma unroll
        for (int kk = 0; kk < DQK / 32; ++kk) Qf[m][kk] = *(const bf16x8*)(Qp + (size_t)qrow * ldq + m * DQK + kk * 32 + fq * 8);
    constexpr float LOG2E = 1.4426950408889634f;
    const float scale2 = scale * LOG2E, slope2 = slope * LOG2E, kappa = slope / scale;
    f32x4 O[NMAP][DV / 16], Ol[NMAP];
    float mrun[NMAP];
#pragma unroll
    for (int m = 0; m < NMAP; ++m) {
        mrun[m] = m_init * LOG2E; Ol[m] = (f32x4){(fq == 0) ? l_init : 0.f, 0.f, 0.f, 0.f};
#pragma unroll
        for (int et = 0; et < DV / 16; ++et) O[m][et] = (f32x4){0.f, 0.f, 0.f, 0.f};
    }
    const unsigned onesw = (fr == 0) ? 0x3f803f80u : 0u;
    const bf16x8 onesf = __builtin_bit_cast(bf16x8, (u32x4){onesw, onesw, onesw, onesw});
    char* const lds = (char*)shm;
    constexpr int KN = KBLK, VN = DV / 64;
    u32x4 kreg[KN], vreg[VN];
#define ATT_LOAD(k0_) do { \
        _Pragma("unroll") for (int i_ = 0; i_ < KN; ++i_) { const int c_ = tid + i_ * NT; const int key_ = c_ / (KBLK * 8), col_ = (c_ % (KBLK * 8)) * 8; \
            kreg[i_] = *(const u32x4*)(Kp + (size_t)((k0_) + key_) * ldk + col_); } \
        _Pragma("unroll") for (int i_ = 0; i_ < VN; ++i_) { const int c_ = tid + i_ * NT; const int e_ = c_ >> 3, kc_ = c_ & 7; \
            vreg[i_] = *(const u32x4*)(Vt + (size_t)e_ * ldvt + (k0_) + kc_ * 8); } } while (0)
    ATT_LOAD(kbeg);
    const int qw0 = q0 + w * 16;
    constexpr int VBYTES = DV * 160;
    bf16x8 Pf[NMAP][2];
#define ATT_PV_C(voff_, c) do { \
            bf16x8 vf[DV / 16]; \
            _Pragma("unroll") for (int et = 0; et < DV / 16; ++et) vf[et] = *(const bf16x8*)(lds + (voff_) + (et * 16 + fr) * 160 + (c) * 64 + fq * 16); \
            _Pragma("unroll") for (int m = 0; m < NMAP; ++m) Ol[m] = __builtin_amdgcn_mfma_f32_16x16x32_bf16(onesf, Pf[m][c], Ol[m], 0, 0, 0); \
            _Pragma("unroll") for (int et = 0; et < DV / 16; ++et) \
                _Pragma("unroll") for (int m = 0; m < NMAP; ++m) O[m][et] = __builtin_amdgcn_mfma_f32_16x16x32_bf16(vf[et], Pf[m][c], O[m][et], 0, 0, 0); \
        } while (0)
    constexpr int KB_BYTES = 16384, V_BASE = 32768;
#define ATT_WRITE(koff_, voff_) do { \
        _Pragma("unroll") for (int i = 0; i < KN; ++i) { const int c = tid + i * NT; const int key = c / (KBLK * 8), col = (c % (KBLK * 8)) * 8; \
            *(u32x4*)(lds + (koff_) + (col >> 6) * 8192 + lds_byte(key, col & 63)) = kreg[i]; } \
        _Pragma("unroll") for (int i = 0; i < VN; ++i) { const int c = tid + i * NT; const int e = c >> 3, kc = c & 7; \
            char* vd = lds + (voff_) + e * 160 + (kc >> 2) * 64 + (kc & 1) * 32 + ((kc >> 1) & 1) * 8; \
            *(u32x2*)vd = (u32x2){vreg[i].x, vreg[i].y}; *(u32x2*)(vd + 16) = (u32x2){vreg[i].z, vreg[i].w}; } } while (0)
    __syncthreads();
    ATT_WRITE(0, V_BASE);
    __syncthreads();
    if (kbeg + 64 < kend) ATT_LOAD(kbeg + 64);
    int kcur = 0, vcur = V_BASE, vprev = V_BASE + 2 * VBYTES, vnext = V_BASE + VBYTES;
    for (int k0 = kbeg; k0 < kend; k0 += 64) {
        if (k0 + 64 < kend) ATT_WRITE(kcur ^ KB_BYTES, vnext);
        if (k0 + 128 < kend) ATT_LOAD(k0 + 128);
        const float dq = (float)(qrow - k0);
        bool gen;
        if (MODE == 2) gen = false;
        else if (MODE == 1) gen = !((k0 + 63 <= qw0 && qw0 + 15 - k0 <= 128) || (k0 >= qw0 + 15 && k0 + 63 - qw0 <= 128));
        else gen = !(k0 + 63 <= qw0 || k0 >= qw0 + 15);
        const bool pos = (MODE == 2) || (k0 + 63 <= qw0);
        f32x4 Cin[4]; float off;
        if (MODE == 2) {
#pragma unroll
            for (int t = 0; t < 4; ++t) Cin[t] = (f32x4){0.f, 0.f, 0.f, 0.f};
            off = 0.f;
        } else if (gen) {
#pragma unroll
            for (int t = 0; t < 4; ++t)
#pragma unroll
                for (int r = 0; r < 4; ++r) Cin[t][r] = -kappa * fabsf(dq - (float)(16 * t + 4 * fq + r));
            off = 0.f;
        } else {
            const float sk = pos ? kappa : -kappa, cb = sk * (float)(4 * fq);
#pragma unroll
            for (int t = 0; t < 4; ++t)
#pragma unroll
                for (int r = 0; r < 4; ++r) Cin[t][r] = sk * (float)(16 * t + r) + cb;
            off = pos ? -slope2 * dq : slope2 * dq;
        }
        f32x4 s[NMAP][4];
#pragma unroll
        for (int m = 0; m < NMAP; ++m) {
            bf16x8 kf[4][DQK / 32];
#pragma unroll
            for (int t = 0; t < 4; ++t)
#pragma unroll
                for (int kk = 0; kk < DQK / 32; ++kk) {
                    const int blk = (MODE == 2) ? (kk >> 1) : m, kcol = (MODE == 2) ? (kk & 1) * 32 : kk * 32;
                    kf[t][kk] = *(const bf16x8*)(lds + kcur + blk * 8192 + lds_byte(t * 16 + fr, kcol + fq * 8));
                }
#pragma unroll
            for (int t = 0; t < 4; ++t) {
                s[m][t] = Cin[t];
#pragma unroll
                for (int kk = 0; kk < DQK / 32; ++kk) s[m][t] = __builtin_amdgcn_mfma_f32_16x16x32_bf16(kf[t][kk], Qf[m][kk], s[m][t], 0, 0, 0);
            }
        }
        float mx[NMAP], mx1[NMAP];
#pragma unroll
        for (int m = 0; m < NMAP; ++m) {
            if (MODE == 1 && gen) {
#pragma unroll
                for (int t = 0; t < 4; ++t)
#pragma unroll
                    for (int r = 0; r < 4; ++r) s[m][t][r] = (fabsf(dq - (float)(16 * t + 4 * fq + r)) > 128.0f) ? -1e30f : s[m][t][r];
            }
            float v = fmaxf(fmaxf(s[m][0][0], s[m][0][1]), fmaxf(s[m][0][2], s[m][0][3]));
#pragma unroll
            for (int t = 1; t < 4; ++t) v = fmaxf(v, fmaxf(fmaxf(s[m][t][0], s[m][t][1]), fmaxf(s[m][t][2], s[m][t][3])));
            mx[m] = v; mx1[m] = shx(v, 16, lane);
        }
        __builtin_amdgcn_sched_barrier(0);
        if (k0 > kbeg) ATT_PV_C(vprev, 0);
        __builtin_amdgcn_sched_barrier(0);
#pragma unroll
        for (int m = 0; m < NMAP; ++m) { mx[m] = fmaxf(mx[m], mx1[m]); mx1[m] = shx(mx[m], 32, lane); }
        __builtin_amdgcn_sched_barrier(0);
        if (k0 > kbeg) ATT_PV_C(vprev, 1);
        __builtin_amdgcn_sched_barrier(0);
#pragma unroll
        for (int m = 0; m < NMAP; ++m) {
            const float mxx = fmaxf(mx[m], mx1[m]);
            const float mtile = fmaxf(mxx * scale2 + off, -1e30f);
            const float mnew = fmaxf(mrun[m], mtile), alpha = __builtin_amdgcn_exp2f(mrun[m] - mnew);
            mrun[m] = mnew;
            const float sub = off - mnew;
#pragma unroll
            for (int t = 0; t < 4; ++t)
#pragma unroll
                for (int r = 0; r < 4; ++r) s[m][t][r] = __builtin_amdgcn_exp2f(s[m][t][r] * scale2 + sub);
            if (__builtin_amdgcn_ballot_w64(alpha != 1.0f) != 0ull) {
                Ol[m] *= alpha;
#pragma unroll
                for (int et = 0; et < DV / 16; ++et) O[m][et] *= alpha;
            }
#pragma unroll
            for (int c = 0; c < 2; ++c) {
                u32x4 pk; pk.x = cvt_pk_bf16(s[m][2 * c][0], s[m][2 * c][1]); pk.y = cvt_pk_bf16(s[m][2 * c][2], s[m][2 * c][3]);
                pk.z = cvt_pk_bf16(s[m][2 * c + 1][0], s[m][2 * c + 1][1]); pk.w = cvt_pk_bf16(s[m][2 * c + 1][2], s[m][2 * c + 1][3]);
                Pf[m][c] = __builtin_bit_cast(bf16x8, pk);
            }
        }
        { const int t_ = vprev; vprev = vcur; vcur = vnext; vnext = t_; kcur ^= KB_BYTES; }
        __syncthreads();
    }
    { ATT_PV_C(vprev, 0); ATT_PV_C(vprev, 1); }
#undef ATT_WRITE
    float linv[NMAP];
#pragma unroll
    for (int m = 0; m < NMAP; ++m) linv[m] = 1.0f / shl(Ol[m][0], fr);
    const int tid2 = hidden_tid(wv); const int qrow_o = q0 + (tid2 >> 6) * 16 + (tid2 & 15);
    if (MODE == 0) {
        float ss = 0.f;
#pragma unroll
        for (int et = 0; et < DV / 16; ++et)
#pragma unroll
            for (int r = 0; r < 4; ++r) { const float v = O[0][et][r] * linv[0] - lam * (O[NMAP - 1][et][r] * linv[NMAP - 1]); O[0][et][r] = v; ss += v * v; }
        ss += shx(ss, 16, lane); ss += shx(ss, 32, lane);
        const float rs = rsqrtf(ss * (1.0f / 128.0f) + EPS) * outscale;
#pragma unroll
        for (int et = 0; et < DV / 16; ++et) {
            const f32x4 g = *(const f32x4*)(subln + et * 16 + fq * 4);
            st_bf16x4(Op + (size_t)qrow_o * ldo + et * 16 + fq * 4, O[0][et] * rs * g);
        }
    } else {
#pragma unroll
        for (int et = 0; et < DV / 16; ++et) st_bf16x4(Op + (size_t)qrow_o * ldo + et * 16 + fq * 4, O[0][et] * linv[0]);
    }
}

template <int MODE>
__device__ __forceinline__ void attn2_unit(const bf16_t* __restrict__ Qp, const int ldq, const bf16_t* __restrict__ Kp, const int ldk,
                                           const bf16_t* __restrict__ Vt, const size_t ldvt, const int q0, const int kbeg, const int kend,
                                           const float scale, const float* __restrict__ sinkp, const int hq0, bf16_t* __restrict__ Op, const int ldo, const int wv) {
    constexpr int DQK = ACfg<MODE>::DQK, DV = ACfg<MODE>::DV, KBLK = ACfg<MODE>::KBLK, RT = 2;
    const int tid = hidden_tid(wv), w = tid >> 6, lane = tid & 63, fr = lane & 15, fq = lane >> 4;
    const int hl = (MODE == 1) ? (w >> 1) : 0, qsub = (MODE == 1) ? (w & 1) * 32 : w * 32;
    const float slope = (MODE == 1) ? exp2f(-0.5f * (float)(hq0 + hl + 1)) : 0.f;
    const float m_init = (MODE == 1) ? sinkp[hl] : -1e30f, l_init = (MODE == 1) ? 1.0f : 0.f;
    constexpr float LOG2E = 1.4426950408889634f;
    const float scale2 = scale * LOG2E, slope2 = slope * LOG2E, kappa = slope / scale;
    bf16x8 Qf[RT][DQK / 32];
#pragma unroll
    for (int rt = 0; rt < RT; ++rt)
#pragma unroll
        for (int kk = 0; kk < DQK / 32; ++kk) Qf[rt][kk] = *(const bf16x8*)(Qp + (size_t)(q0 + qsub + 16 * rt + fr) * ldq + hl * 64 + kk * 32 + fq * 8);
    f32x4 O[RT][DV / 16], Ol[RT];
    float mrun[RT];
#pragma unroll
    for (int rt = 0; rt < RT; ++rt) {
        mrun[rt] = m_init * LOG2E; Ol[rt] = (f32x4){(fq == 0) ? l_init : 0.f, 0.f, 0.f, 0.f};
#pragma unroll
        for (int et = 0; et < DV / 16; ++et) O[rt][et] = (f32x4){0.f, 0.f, 0.f, 0.f};
    }
    const unsigned onesw = (fr == 0) ? 0x3f803f80u : 0u;
    const bf16x8 onesf = __builtin_bit_cast(bf16x8, (u32x4){onesw, onesw, onesw, onesw});
    char* const lds = (char*)shm;
    constexpr int KN = KBLK, VN = DV / 64;
    u32x4 kreg[KN], vreg[VN];
#define ATT2_LOAD(k0_) do { \
        _Pragma("unroll") for (int i_ = 0; i_ < KN; ++i_) { const int c_ = tid + i_ * NT; const int key_ = c_ / (KBLK * 8), col_ = (c_ % (KBLK * 8)) * 8; \
            kreg[i_] = *(const u32x4*)(Kp + (size_t)((k0_) + key_) * ldk + col_); } \
        _Pragma("unroll") for (int i_ = 0; i_ < VN; ++i_) { const int c_ = tid + i_ * NT; const int e_ = c_ >> 3, kc_ = c_ & 7; \
            vreg[i_] = *(const u32x4*)(Vt + (size_t)e_ * ldvt + (k0_) + kc_ * 8); } } while (0)
    ATT2_LOAD(kbeg);
    constexpr int VBYTES = DV * 160;
    bf16x8 Pf[RT][2];
#define ATT2_PV_C(voff_, c) do { \
            bf16x8 vf[DV / 16]; \
            _Pragma("unroll") for (int et = 0; et < DV / 16; ++et) vf[et] = *(const bf16x8*)(lds + (voff_) + (et * 16 + fr) * 160 + (c) * 64 + fq * 16); \
            _Pragma("unroll") for (int rt = 0; rt < RT; ++rt) Ol[rt] = __builtin_amdgcn_mfma_f32_16x16x32_bf16(onesf, Pf[rt][c], Ol[rt], 0, 0, 0); \
            _Pragma("unroll") for (int et = 0; et < DV / 16; ++et) \
                _Pragma("unroll") for (int rt = 0; rt < RT; ++rt) O[rt][et] = __builtin_amdgcn_mfma_f32_16x16x32_bf16(vf[et], Pf[rt][c], O[rt][et], 0, 0, 0); \
        } while (0)
    int vcur = ATT_VOFF;
    for (int k0 = kbeg; k0 < kend; k0 += 64) {
        __syncthreads();
#pragma unroll
        for (int i = 0; i < KN; ++i) { const int c = tid + i * NT; const int key = c / (KBLK * 8), col = (c % (KBLK * 8)) * 8;
            *(u32x4*)(lds + (col >> 6) * 8192 + lds_byte(key, col & 63)) = kreg[i]; }
#pragma unroll
        for (int i = 0; i < VN; ++i) { const int c = tid + i * NT; const int e = c >> 3, kc = c & 7;
            char* vd = lds + vcur + e * 160 + (kc >> 2) * 64 + (kc & 1) * 32 + ((kc >> 1) & 1) * 8;
            *(u32x2*)vd = (u32x2){vreg[i].x, vreg[i].y}; *(u32x2*)(vd + 16) = (u32x2){vreg[i].z, vreg[i].w}; }
        __syncthreads();
        if (k0 + 64 < kend) ATT2_LOAD(k0 + 64);
        const int vprev = vcur ^ ATT_VOFF ^ (ATT_VOFF + VBYTES);
        f32x4 s[RT][4]; float off[RT], dqv[RT]; bool genv[RT];
#pragma unroll
        for (int rt = 0; rt < RT; ++rt) {
            const int qw0 = q0 + qsub + 16 * rt;
            const float dq = (float)(qw0 + fr - k0); dqv[rt] = dq;
            const bool gen = (MODE == 1) && !((k0 + 63 <= qw0 && qw0 + 15 - k0 <= 128) || (k0 >= qw0 + 15 && k0 + 63 - qw0 <= 128));
            const bool pos = (MODE == 2) || (k0 + 63 <= qw0);
            genv[rt] = gen;
            if (MODE == 2) {
#pragma unroll
                for (int t = 0; t < 4; ++t) s[rt][t] = (f32x4){0.f, 0.f, 0.f, 0.f};
                off[rt] = 0.f;
            } else if (gen) {
#pragma unroll
                for (int t = 0; t < 4; ++t)
#pragma unroll
                    for (int r = 0; r < 4; ++r) s[rt][t][r] = -kappa * fabsf(dq - (float)(16 * t + 4 * fq + r));
                off[rt] = 0.f;
            } else {
                const float sk = pos ? kappa : -kappa; float cb = sk * (float)(4 * fq);
                asm volatile("" : "+v"(cb));
#pragma unroll
                for (int t = 0; t < 4; ++t)
#pragma unroll
                    for (int r = 0; r < 4; ++r) s[rt][t][r] = sk * (float)(16 * t + r) + cb;
                off[rt] = pos ? -slope2 * dq : slope2 * dq;
            }
        }
#pragma unroll
        for (int t = 0; t < 4; ++t) {
            bf16x8 kf[DQK / 32];
#pragma unroll
            for (int kk = 0; kk < DQK / 32; ++kk) {
                const int blk = (MODE == 2) ? (kk >> 1) : 0, kcol = (MODE == 2) ? (kk & 1) * 32 : kk * 32;
                kf[kk] = *(const bf16x8*)(lds + blk * 8192 + lds_byte(t * 16 + fr, kcol + fq * 8));
            }
#pragma unroll
            for (int rt = 0; rt < RT; ++rt)
#pragma unroll
                for (int kk = 0; kk < DQK / 32; ++kk) s[rt][t] = __builtin_amdgcn_mfma_f32_16x16x32_bf16(kf[kk], Qf[rt][kk], s[rt][t], 0, 0, 0);
        }
        float mx[RT], mx1[RT];
#pragma unroll
        for (int rt = 0; rt < RT; ++rt) {
            if (MODE == 1 && genv[rt]) {
#pragma unroll
                for (int t = 0; t < 4; ++t)
#pragma unroll
                    for (int r = 0; r < 4; ++r) s[rt][t][r] = (fabsf(dqv[rt] - (float)(16 * t + 4 * fq + r)) > 128.0f) ? -1e30f : s[rt][t][r];
            }
            float v = fmaxf(fmaxf(s[rt][0][0], s[rt][0][1]), fmaxf(s[rt][0][2], s[rt][0][3]));
#pragma unroll
            for (int t = 1; t < 4; ++t) v = fmaxf(v, fmaxf(fmaxf(s[rt][t][0], s[rt][t][1]), fmaxf(s[rt][t][2], s[rt][t][3])));
            mx[rt] = v; mx1[rt] = shx(v, 16, lane);
        }
        __builtin_amdgcn_sched_barrier(0);
        if (k0 > kbeg) ATT2_PV_C(vprev, 0);
        __builtin_amdgcn_sched_barrier(0);
#pragma unroll
        for (int rt = 0; rt < RT; ++rt) { mx[rt] = fmaxf(mx[rt], mx1[rt]); mx1[rt] = shx(mx[rt], 32, lane); }
        __builtin_amdgcn_sched_barrier(0);
        if (k0 > kbeg) ATT2_PV_C(vprev, 1);
        __builtin_amdgcn_sched_barrier(0);
#pragma unroll
        for (int rt = 0; rt < RT; ++rt) {
            const float mxx = fmaxf(mx[rt], mx1[rt]);
            const float mtile = fmaxf(mxx * scale2 + off[rt], -1e30f);
            const float mnew = fmaxf(mrun[rt], mtile), alpha = __builtin_amdgcn_exp2f(mrun[rt] - mnew);
            mrun[rt] = mnew;
            const float sub = off[rt] - mnew;
#pragma unroll
            for (int t = 0; t < 4; ++t)
#pragma unroll
                for (int r = 0; r < 4; ++r) s[rt][t][r] = __builtin_amdgcn_exp2f(s[rt][t][r] * scale2 + sub);
            if (__builtin_amdgcn_ballot_w64(alpha != 1.0f) != 0ull) {
                Ol[rt] *= alpha;
#pragma unroll
                for (int et = 0; et < DV / 16; ++et) O[rt][et] *= alpha;
            }
#pragma unroll
            for (int c = 0; c < 2; ++c) {
                u32x4 pk; pk.x = cvt_pk_bf16(s[rt][2 * c][0], s[rt][2 * c][1]); pk.y = cvt_pk_bf16(s[rt][2 * c][2], s[rt][2 * c][3]);
                pk.z = cvt_pk_bf16(s[rt][2 * c + 1][0], s[rt][2 * c + 1][1]); pk.w = cvt_pk_bf16(s[rt][2 * c + 1][2], s[rt][2 * c + 1][3]);
                Pf[rt][c] = __builtin_bit_cast(bf16x8, pk);
            }
        }
        vcur = vprev;
    }
    { const int vlast = vcur ^ ATT_VOFF ^ (ATT_VOFF + VBYTES); ATT2_PV_C(vlast, 0); ATT2_PV_C(vlast, 1); }
    const int tid2 = hidden_tid(wv), w2 = tid2 >> 6, fr2 = tid2 & 15;
    const int hl2 = (MODE == 1) ? (w2 >> 1) : 0, qsub2 = (MODE == 1) ? (w2 & 1) * 32 : w2 * 32;
    constexpr int OPITCH = DV * 2 + 16, PPR = DV / 8, RPI = 64 / PPR;
    const int lane2 = tid2 & 63, fq2 = lane2 >> 4;
    char* const stg = (char*)shm + 65536 + w2 * (32 * OPITCH);
#pragma unroll
    for (int rt = 0; rt < RT; ++rt) {
        const float linv = 1.0f / shl(Ol[rt][0], fr);
#pragma unroll
        for (int et = 0; et < DV / 16; ++et) {
            const f32x4 v = O[rt][et] * linv;
            *(u32x2*)(stg + (16 * rt + fr2) * OPITCH + et * 32 + fq2 * 8) = (u32x2){cvt_pk_bf16(v[0], v[1]), cvt_pk_bf16(v[2], v[3])};
        }
    }
#pragma unroll
    for (int it = 0; it < 32 / RPI; ++it) {
        const int row = it * RPI + lane2 / PPR, pc = lane2 % PPR;
        const u32x4 v = *(const u32x4*)(stg + row * OPITCH + pc * 16);
        *(u32x4*)(Op + (size_t)(q0 + qsub2 + row) * ldo + hl2 * 64 + pc * 8) = v;
    }
    if (MODE == 2) __syncthreads();
#undef ATT2_LOAD
#undef ATT2_PV_C
}

constexpr int DA_VROW = 144;
constexpr int DA_VBYTES = 128 * DA_VROW;
__device__ __forceinline__ void dattn_unit(const bf16_t* __restrict__ Qp, const int ldq, const bf16_t* __restrict__ Kp, const int ldk,
                                           const bf16_t* __restrict__ Vt, const size_t ldvt, const int q0, const int kbeg, const int kend,
                                           const float scale, const float slope, bf16_t* __restrict__ Op, const int ldo,
                                           const float lam, const float outscale, const float* __restrict__ subln, const int wv) {
    constexpr int KN = 2, VN = 2, KBLK = 2;
    const int tid = hidden_tid(wv), w = tid >> 6, lane = tid & 63, j = lane & 31, hi = lane >> 5;
    const int m = w & 1, qw0 = q0 + 32 * (w >> 1);
    const int qrow = qw0 + j;
    constexpr float LOG2E = 1.4426950408889634f;
    const float scale2 = scale * LOG2E, slope2 = slope * LOG2E, kappa = slope / scale;
    bf16x8 Qf[4];
#pragma unroll
    for (int ds = 0; ds < 4; ++ds) Qf[ds] = *(const bf16x8*)(Qp + (size_t)qrow * ldq + m * 64 + ds * 16 + hi * 8);
    const unsigned kbf = cvt_pk_bf16(kappa, 0.f) & 0xffffu;
    bf16x8 Ab[2];
#pragma unroll
    for (int kb = 0; kb < 2; ++kb) { const unsigned v = (hi == 0) ? (cvt_pk_bf16((float)(32 * kb + j), 0.f) & 0xffffu) : 0u; Ab[kb] = __builtin_bit_cast(bf16x8, (u32x4){v, 0u, 0u, 0u}); }
    f32x16 O[4];
#pragma unroll
    for (int eb = 0; eb < 4; ++eb)
#pragma unroll
        for (int r = 0; r < 16; ++r) O[eb][r] = 0.f;
    float mrun = 12.0f, lrun = 0.f;
    char* const lds = (char*)shm;
    u32x4 kreg[KN], vreg[VN];
#define DA_LOAD(k0_) do { \
        _Pragma("unroll") for (int i_ = 0; i_ < KN; ++i_) { const int c_ = tid + i_ * NT; const int key_ = c_ / (KBLK * 8), col_ = (c_ % (KBLK * 8)) * 8; \
            kreg[i_] = *(const u32x4*)(Kp + (size_t)((k0_) + key_) * ldk + col_); } \
        _Pragma("unroll") for (int i_ = 0; i_ < VN; ++i_) { const int c_ = tid + i_ * NT; const int e_ = c_ >> 3, kc_ = c_ & 7; \
            vreg[i_] = *(const u32x4*)(Vt + (size_t)e_ * ldvt + (k0_) + kc_ * 8); } } while (0)
    constexpr int KB_BYTES = 16384, V_BASE = 32768;
#define DA_WRITE(koff_, voff_) do { \
        _Pragma("unroll") for (int i = 0; i < KN; ++i) { const int c = tid + i * NT; const int key = c / (KBLK * 8), col = (c % (KBLK * 8)) * 8; \
            *(u32x4*)(lds + (koff_) + (col >> 6) * 8192 + lds_byte(key, col & 63)) = kreg[i]; } \
        _Pragma("unroll") for (int i = 0; i < VN; ++i) { const int c = tid + i * NT; const int e = c >> 3, kc = c & 7; \
            char* vd = lds + (voff_) + e * DA_VROW + (kc >> 1) * 32 + (kc & 1) * 8;        \
            *(u32x2*)vd = (u32x2){vreg[i].x, vreg[i].y}; *(u32x2*)(vd + 16) = (u32x2){vreg[i].z, vreg[i].w}; } } while (0)
    DA_LOAD(kbeg);
    __syncthreads();
    DA_WRITE(0, V_BASE);
    __syncthreads();
    if (kbeg + 64 < kend) DA_LOAD(kbeg + 64);
    int kcur = 0, vcur = V_BASE, vnext = V_BASE + DA_VBYTES, vthird = V_BASE + 2 * DA_VBYTES;
    for (int k0 = kbeg; k0 < kend; k0 += 64) {
        if (k0 + 64 < kend) DA_WRITE(kcur ^ KB_BYTES, vnext);
        if (k0 + 128 < kend) DA_LOAD(k0 + 128);
        const bool pos = (k0 + 63 <= qw0), neg = (k0 >= qw0 + 31);
        const float dq = (float)(qrow - k0);
        f32x16 S[2];
        const unsigned bsg = pos ? kbf : (kbf | 0x8000u);
        const bf16x8 Bb = __builtin_bit_cast(bf16x8, (u32x4){(hi == 0 && (pos || neg)) ? bsg : 0u, 0u, 0u, 0u});
        {
            bf16x8 kf[2][4];
#pragma unroll
            for (int kb = 0; kb < 2; ++kb)
#pragma unroll
                for (int ds = 0; ds < 4; ++ds) kf[kb][ds] = *(const bf16x8*)(lds + kcur + m * 8192 + lds_byte(32 * kb + j, ds * 16 + hi * 8));
#pragma unroll
            for (int kb = 0; kb < 2; ++kb) {
#pragma unroll
                for (int r = 0; r < 16; ++r) S[kb][r] = 0.f;
                S[kb] = __builtin_amdgcn_mfma_f32_32x32x16_bf16(Ab[kb], Bb, S[kb], 0, 0, 0);
            }
#pragma unroll
            for (int ds = 0; ds < 4; ++ds)
#pragma unroll
                for (int kb = 0; kb < 2; ++kb) S[kb] = __builtin_amdgcn_mfma_f32_32x32x16_bf16(kf[kb][ds], Qf[ds], S[kb], 0, 0, 0);
        }
        __builtin_amdgcn_sched_barrier(0);
        bf16x8 vfa[2][4];
#pragma unroll
        for (int eb = 0; eb < 2; ++eb)
#pragma unroll
            for (int kk = 0; kk < 4; ++kk) vfa[eb][kk] = *(const bf16x8*)(lds + vcur + (32 * eb + j) * DA_VROW + kk * 32 + hi * 16);
        __builtin_amdgcn_sched_barrier(0);
        float off;
        if (pos) off = -slope2 * dq; else if (neg) off = slope2 * dq;
        else {
            off = 0.f;
#pragma unroll
            for (int kb = 0; kb < 2; ++kb)
#pragma unroll
                for (int r = 0; r < 16; ++r) S[kb][r] -= kappa * fabsf(dq - (float)(32 * kb + (r & 3) + 8 * (r >> 2) + 4 * hi));
        }
        float mx = S[0][0];
#pragma unroll
        for (int r = 1; r < 16; ++r) mx = fmaxf(mx, S[0][r]);
#pragma unroll
        for (int r = 0; r < 16; ++r) mx = fmaxf(mx, S[1][r]);
        mx = fmaxf(mx, shx(mx, 32, lane));
        const float mtile = mx * scale2 + off;
        const float mnew = fmaxf(mrun, mtile), alpha = __builtin_amdgcn_exp2f(mrun - mnew), sub = off - mnew;
        mrun = mnew;
        float ps = 0.f;
#pragma unroll
        for (int kb = 0; kb < 2; ++kb)
#pragma unroll
            for (int r = 0; r < 16; ++r) { S[kb][r] = __builtin_amdgcn_exp2f(S[kb][r] * scale2 + sub); ps += S[kb][r]; }
        lrun = lrun * alpha + ps;
        if (__builtin_amdgcn_ballot_w64(alpha != 1.0f) != 0ull) {
#pragma unroll
            for (int eb = 0; eb < 4; ++eb)
#pragma unroll
                for (int r = 0; r < 16; ++r) O[eb][r] *= alpha;
        }
        bf16x8 Pf[4];
#pragma unroll
        for (int kk = 0; kk < 4; ++kk) {
            const int kb = kk >> 1, r0 = 8 * (kk & 1);
            u32x4 pk; pk.x = cvt_pk_bf16(S[kb][r0], S[kb][r0 + 1]); pk.y = cvt_pk_bf16(S[kb][r0 + 2], S[kb][r0 + 3]);
            pk.z = cvt_pk_bf16(S[kb][r0 + 4], S[kb][r0 + 5]); pk.w = cvt_pk_bf16(S[kb][r0 + 6], S[kb][r0 + 7]);
            Pf[kk] = __builtin_bit_cast(bf16x8, pk);
        }
        __builtin_amdgcn_sched_barrier(0);
        {
            bf16x8 vfb[2][4];
#pragma unroll
            for (int eb = 0; eb < 2; ++eb)
#pragma unroll
                for (int kk = 0; kk < 4; ++kk) vfb[eb][kk] = *(const bf16x8*)(lds + vcur + (32 * (eb + 2) + j) * DA_VROW + kk * 32 + hi * 16);
            __builtin_amdgcn_sched_barrier(0);
#pragma unroll
            for (int kk = 0; kk < 4; ++kk)
#pragma unroll
                for (int eb = 0; eb < 2; ++eb) O[eb] = __builtin_amdgcn_mfma_f32_32x32x16_bf16(vfa[eb][kk], Pf[kk], O[eb], 0, 0, 0);
            __builtin_amdgcn_sched_barrier(0);
#pragma unroll
            for (int kk = 0; kk < 4; ++kk)
#pragma unroll
                for (int eb = 0; eb < 2; ++eb) O[eb + 2] = __builtin_amdgcn_mfma_f32_32x32x16_bf16(vfb[eb][kk], Pf[kk], O[eb + 2], 0, 0, 0);
        }
        { const int t_ = vcur; vcur = vnext; vnext = vthird; vthird = t_; kcur ^= KB_BYTES; }
        __syncthreads();
    }
#undef DA_LOAD
#undef DA_WRITE
    const float linv = 1.0f / fmaxf(lrun + shx(lrun, 32, lane), 1e-37f);
    float* xb = (float*)lds + (size_t)(w >> 1) * 64 * 64;
    if (m == 1) {
#pragma unroll
        for (int eb = 0; eb < 4; ++eb)
#pragma unroll
            for (int r = 0; r < 16; ++r) xb[(eb * 16 + r) * 64 + lane] = O[eb][r] * linv;
    }
    __syncthreads();
    if (m == 0) {
        float ss = 0.f;
#pragma unroll
        for (int eb = 0; eb < 4; ++eb)
#pragma unroll
            for (int r = 0; r < 16; ++r) { const float v = O[eb][r] * linv - lam * xb[(eb * 16 + r) * 64 + lane]; O[eb][r] = v; ss += v * v; }
        ss += shx(ss, 32, lane);
        const float rs = rsqrtf(ss * (1.0f / 128.0f) + EPS) * outscale;
        const int l2 = hidden_tid(wv) & 63;
        char* const stg = (char*)xb;
#pragma unroll
        for (int eb = 0; eb < 4; ++eb)
#pragma unroll
            for (int rq = 0; rq < 4; ++rq) {
                const int e0 = 32 * eb + 8 * rq;
                const f32x4 g = *(const f32x4*)(subln + e0 + 4 * (l2 >> 5));
                const f32x4 v = {O[eb][4 * rq] * rs * g[0], O[eb][4 * rq + 1] * rs * g[1], O[eb][4 * rq + 2] * rs * g[2], O[eb][4 * rq + 3] * rs * g[3]};
                *(u32x2*)(stg + (l2 & 31) * 272 + (e0 + 4 * (l2 >> 5)) * 2) = (u32x2){cvt_pk_bf16(v[0], v[1]), cvt_pk_bf16(v[2], v[3])};
            }
#pragma unroll
        for (int it = 0; it < 8; ++it) {
            const int row = it * 4 + (l2 >> 4), pc = l2 & 15;
            const u32x4 v = *(const u32x4*)(stg + row * 272 + pc * 16);
            *(u32x4*)(Op + (size_t)(q0 + 32 * (w >> 1) + row) * ldo + pc * 8) = v;
        }
    }
    __syncthreads();
}

constexpr int HZ_RS = 4896;
constexpr int HZ_PAD = 192;
constexpr int H_CPS = 8256;
constexpr int H_ZOFF = 0, H_CPOFF = 8 * HZ_RS, H_RAWOFF = H_CPOFF + 8 * H_CPS;

template <bool ALT>
__device__ __forceinline__ void hyena_unit(const Params& p, const int lj  , const int c, const int wv) {
    const int tid = hidden_tid(wv), w = tid >> 6, lane = tid & 63, fr = lane & 15, fq = lane >> 4;
    char* const lds = (char*)shm;
    const bf16_t* hyT = (const bf16_t*)(p.ws + WS_PROJ + PR_HYT);
    const float* cw = p.in[4] + (size_t)lj * 3 * 1536; const float* cb = p.in[5] + (size_t)lj * 1536;
    const int nb = fr >> 1, tbp = fr & 1;
    __syncthreads();
    for (int i = tid; i < 8 * 2 * (HZ_PAD / 8); i += NT) {
        const int b = i / (2 * (HZ_PAD / 8)), r = i % (2 * (HZ_PAD / 8)), side = r / (HZ_PAD / 8), k = r % (HZ_PAD / 8);
        unsigned zz0 = 0u; asm volatile("" : "+v"(zz0));
        *(u32x4*)(lds + H_ZOFF + b * HZ_RS + (side ? (HZ_PAD + 2048) * 2 : 0) + k * 16) = (u32x4){zz0, zz0, zz0, zz0};
        if (i < 2) *(u32x4*)(lds + H_RAWOFF + 8192 + i * 16) = (u32x4){zz0, zz0, zz0, zz0};
    }
    {
        const float w0 = cw[c], w1 = cw[1536 + c], w2 = cw[2 * 1536 + c], bb = cb[c];
        const bf16_t* src = hyT + (size_t)c * NTOK;
        u32x4 v[4]; unsigned short um[4], up[4];
#pragma unroll
        for (int k = 0; k < 4; ++k) {
            const int i = tid + k * NT, b = i >> 8, s0 = (i & 255) * 8;
            const bf16_t* q = src + b * S + s0;
            v[k] = *(const u32x4*)q; um[k] = q[s0 > 0 ? -1 : 0]; up[k] = q[s0 + 8 < S ? 8 : 7];
        }
#pragma unroll
        for (int k = 0; k < 4; ++k) {
            const int i = tid + k * NT, b = i >> 8, s0 = (i & 255) * 8;
            float u[10];
            u[0] = (s0 > 0) ? bf2f(um[k]) : 0.f; u[9] = (s0 + 8 < S) ? bf2f(up[k]) : 0.f;
            u[1] = bflo(v[k].x); u[2] = bfhi(v[k].x); u[3] = bflo(v[k].y); u[4] = bfhi(v[k].y); u[5] = bflo(v[k].z); u[6] = bfhi(v[k].z); u[7] = bflo(v[k].w); u[8] = bfhi(v[k].w);
            float o[8];
#pragma unroll
            for (int j = 0; j < 8; ++j) o[j] = w0 * u[j] + w1 * u[j + 1] + w2 * u[j + 2] + bb;
            u32x4 ov; ov.x = cvt_pk_bf16(o[0], o[1]); ov.y = cvt_pk_bf16(o[2], o[3]); ov.z = cvt_pk_bf16(o[4], o[5]); ov.w = cvt_pk_bf16(o[6], o[7]);
            *(u32x4*)(lds + H_ZOFF + b * HZ_RS + (HZ_PAD + s0) * 2) = ov;
        }
    }
#pragma unroll 1
    for (int order = 0; order < 2; ++order) {
        const int gch = 512 * (order + 1) + c;
        const bf16_t* gsrc = hyT + (size_t)gch * NTOK;
        u32x2 gv[2][4]; unsigned short gm[2][4], gp[2][4];
        u32x4 rawv;
        {
            const bf16_t* f = (const bf16_t*)(p.ws + WS_FILT) + ((size_t)(lj * 2 + order) * 512 + c) * 4096;
            rawv = *(const u32x4*)(f + tid * 8);
#pragma unroll
            for (int ci = 0; ci < 2; ++ci)
#pragma unroll
                for (int mt = 0; mt < 4; ++mt) {
                    const int frL = lane >> 2, fqL = lane & 3;
                    const int t = 64 * (4 * w + 2 * ci + (frL & 1)) + 16 * mt + 4 * fqL;
                    const bf16_t* gq = gsrc + (frL >> 1) * S + t;
                    gv[ci][mt] = *(const u32x2*)gq; gm[ci][mt] = gq[t > 0 ? -1 : 0]; gp[ci][mt] = gq[t + 4 < S ? 4 : 3];
                }
        }
        *(u32x4*)(lds + H_RAWOFF + tid * 16) = rawv;
        __syncthreads();
        {
            const bf16_t* raw = (const bf16_t*)(lds + H_RAWOFF);
            const int o = w;
#pragma unroll
            for (int k = 0; k < 8; ++k) {
                const int a = lane + 64 * k;
                unsigned short e[8];
#pragma unroll
                for (int j = 0; j < 8; ++j) e[j] = raw[8 * a + o + j];
                u32x4 ov; ov.x = e[0] | ((unsigned)e[1] << 16); ov.y = e[2] | ((unsigned)e[3] << 16); ov.z = e[4] | ((unsigned)e[5] << 16); ov.w = e[6] | ((unsigned)e[7] << 16);
                *(u32x4*)(lds + H_CPOFF + o * H_CPS + a * 16) = ov;
            }
        }
        __syncthreads();
        f32x4 acc[2][4];
#pragma unroll
        for (int ci = 0; ci < 2; ++ci)
#pragma unroll
            for (int mt = 0; mt < 4; ++mt) acc[ci][mt] = (f32x4){0.f, 0.f, 0.f, 0.f};
        {
            const int acp = H_CPOFF + (7 - (fr & 7)) * H_CPS + (255 - (fr >> 3) + fq) * 16;
            const int zb = H_ZOFF + nb * HZ_RS + (HZ_PAD + 8 * fq) * 2;
            for (int dl = 4 * w - 31; dl <= ((ALT && DUPSEL >= 5) ? 4 * w - 31 : 4 * w + 3); ++dl) {
#pragma unroll
                for (int kh = 0; kh < 2; ++kh) {
                    bf16x8 Bf[2];
#pragma unroll
                    for (int ci = 0; ci < 2; ++ci) {
                        const int sblk = 4 * w + 2 * ci + tbp - dl;
                        Bf[ci] = *(const bf16x8*)(lds + zb + (64 * sblk + 32 * kh) * 2);
                    }
#pragma unroll
                    for (int mt = 0; mt < 4; ++mt) {
                        const int q = 4 * dl + mt - 2 * kh;
                        const bf16x8 Af = *(const bf16x8*)(lds + acp - 32 * q);
#pragma unroll
                        for (int ci = 0; ci < 2; ++ci) acc[ci][mt] = __builtin_amdgcn_mfma_f32_16x16x32_bf16(Af, Bf[ci], acc[ci][mt], 0, 0, 0);
                    }
                }
            }
        }
        const float hb = p.in[12][(size_t)(lj * 2 + order) * 512 + c];
        const float w0 = cw[gch], w1 = cw[1536 + gch], w2 = cw[2 * 1536 + gch], bb = cb[gch];
        u32x2 zout[2][4];
        {
            const int srcl = ((fr << 2) | fq) << 2;
#pragma unroll
            for (int ci = 0; ci < 2; ++ci)
#pragma unroll
                for (int mt = 0; mt < 4; ++mt) {
                    gv[ci][mt].x = (unsigned)__builtin_amdgcn_ds_bpermute(srcl, (int)gv[ci][mt].x); gv[ci][mt].y = (unsigned)__builtin_amdgcn_ds_bpermute(srcl, (int)gv[ci][mt].y);
                    const unsigned pk = (unsigned)__builtin_amdgcn_ds_bpermute(srcl, (int)((unsigned)gm[ci][mt] | ((unsigned)gp[ci][mt] << 16)));
                    gm[ci][mt] = (unsigned short)(pk & 0xffff); gp[ci][mt] = (unsigned short)(pk >> 16);
                }
        }
#pragma unroll
        for (int ci = 0; ci < 2; ++ci)
#pragma unroll
            for (int mt = 0; mt < 4; ++mt) {
                const int t = 64 * (4 * w + 2 * ci + tbp) + 16 * mt + 4 * fq;
                const u32x2 zz = *(const u32x2*)(lds + H_ZOFF + nb * HZ_RS + (HZ_PAD + t) * 2);
                float u[6];
                u[0] = (t > 0) ? bf2f(gm[ci][mt]) : 0.f; u[5] = (t + 4 < S) ? bf2f(gp[ci][mt]) : 0.f;
                u[1] = bflo(gv[ci][mt].x); u[2] = bfhi(gv[ci][mt].x); u[3] = bflo(gv[ci][mt].y); u[4] = bfhi(gv[ci][mt].y);
                const float z[4] = {bflo(zz.x), bfhi(zz.x), bflo(zz.y), bfhi(zz.y)};
                float o[4];
#pragma unroll
                for (int r = 0; r < 4; ++r) {
                    const float gate = w0 * u[r] + w1 * u[r + 1] + w2 * u[r + 2] + bb;
                    o[r] = gate * (acc[ci][mt][r] + hb * z[r]);
                }
                zout[ci][mt].x = cvt_pk_bf16(o[0], o[1]); zout[ci][mt].y = cvt_pk_bf16(o[2], o[3]);
            }
        __syncthreads();
        if (order == 0) {
#pragma unroll
            for (int ci = 0; ci < 2; ++ci)
#pragma unroll
                for (int mt = 0; mt < 4; ++mt) {
                    const int t = 64 * (4 * w + 2 * ci + tbp) + 16 * mt + 4 * fq;
                    *(u32x2*)(lds + H_ZOFF + nb * HZ_RS + (HZ_PAD + t) * 2) = zout[ci][mt];
                }
        } else {
            bf16_t* yt = (bf16_t*)(p.ws + WS_QX) + (size_t)c * NTOK;
#pragma unroll
            for (int ci = 0; ci < 2; ++ci)
#pragma unroll
                for (int mt = 0; mt < 4; ++mt) {
                    const int frL = lane >> 2, fqL = lane & 3, srcl = ((fqL << 4) | frL) << 2;
                    const int t = 64 * (4 * w + 2 * ci + (frL & 1)) + 16 * mt + 4 * fqL;
                    u32x2 zo; zo.x = (unsigned)__builtin_amdgcn_ds_bpermute(srcl, (int)zout[ci][mt].x); zo.y = (unsigned)__builtin_amdgcn_ds_bpermute(srcl, (int)zout[ci][mt].y);
                    *(u32x2*)(yt + (frL >> 1) * S + t) = zo;
                }
        }
        __syncthreads();
    }
}

struct Row16 { f32x4 v[4]; };
__device__ __forceinline__ void ld_row(Row16& r, const float* src, int lane) {
#pragma unroll
    for (int i = 0; i < 4; ++i) r.v[i] = *(const f32x4*)(src + 256 * i + 4 * lane);
}
__device__ __forceinline__ void ld_row_bf(Row16& r, const bf16_t* src, int lane) {
#pragma unroll
    for (int i = 0; i < 4; ++i) { const u32x2 v = *(const u32x2*)(src + 256 * i + 4 * lane); r.v[i] = (f32x4){bflo(v.x), bfhi(v.x), bflo(v.y), bfhi(v.y)}; }
}
__device__ __forceinline__ float row_rstd(const Row16& r, int lane) {
    float ss = 0.f;
#pragma unroll
    for (int i = 0; i < 4; ++i) ss += r.v[i][0] * r.v[i][0] + r.v[i][1] * r.v[i][1] + r.v[i][2] * r.v[i][2] + r.v[i][3] * r.v[i][3];
    ss = wave_sum(ss, lane);
    return rsqrtf(ss * (1.0f / 1024.0f) + EPS);
}
template <int KIND  , bool ALT = false>
__device__ __forceinline__ void norm_phase(const Params& p, const int layer, const float* __restrict__ gain, const int bid, const int nb, const int wv) {
    const int tid_ = hidden_tid(wv), lane = tid_ & 63, w = tid_ >> 6;
    bf16_t* XB = (bf16_t*)(p.ws + WS_XB);
    bf16_t* XBo = ALT ? (bf16_t*)(p.ws + WS_PROJ) : XB;
    float* RS1 = (float*)(p.ws + (ALT ? WS_QX : WS_RS1));
    const bf16_t* Y = (const bf16_t*)(p.ws + WS_Y);
    const float* WT = (const float*)(p.ws + WS_WT);
    Row16 g;
    if (KIND == 2) ld_row(g, gain, lane);
    for (int tok = bid * 8 + w; tok < NTOK; tok += nb * 8) {
        Row16 x;
        if (KIND == 0 && layer == 0) ld_row(x, p.in[0] + (size_t)tok * D, lane); else ld_row_bf(x, XB + (size_t)tok * D, lane);
        if ((KIND == 0 && layer > 0) || KIND == 2) {
            const float w0 = WT[2 * tok], w1 = WT[2 * tok + 1];
            const bf16_t* y0 = Y + (size_t)(2 * tok) * D; const bf16_t* y1 = y0 + D;
#pragma unroll
            for (int i = 0; i < 4; ++i) {
                const u32x2 a = *(const u32x2*)(y0 + 256 * i + 4 * lane), b = *(const u32x2*)(y1 + 256 * i + 4 * lane);
                x.v[i][0] += w0 * bflo(a.x) + w1 * bflo(b.x); x.v[i][1] += w0 * bfhi(a.x) + w1 * bfhi(b.x);
                x.v[i][2] += w0 * bflo(a.y) + w1 * bflo(b.y); x.v[i][3] += w0 * bfhi(a.y) + w1 * bfhi(b.y);
            }
        }
        if (KIND == 2) {
            const float rstd = row_rstd(x, lane);
#pragma unroll
            for (int i = 0; i < 4; ++i) *(f32x4*)(p.out + (size_t)tok * D + 256 * i + 4 * lane) = x.v[i] * rstd * g.v[i];
        } else {
#pragma unroll
            for (int i = 0; i < 4; ++i) {
                const unsigned a0 = cvt_pk_bf16(x.v[i][0], x.v[i][1]), a1 = cvt_pk_bf16(x.v[i][2], x.v[i][3]);
                *(u32x2*)(XBo + (size_t)tok * D + 256 * i + 4 * lane) = (u32x2){a0, a1};
                x.v[i] = (f32x4){bflo(a0), bfhi(a0), bflo(a1), bfhi(a1)};
            }
            const float rstd = row_rstd(x, lane);
            if (lane == 0) RS1[tok] = rstd;
        }
    }
}

template <bool ALT>
__device__ __forceinline__ void route_tail(const Params& p, const int layer, const int chunk, f32x4 (&acc)[4][3], float (&ssq)[4], const int wv) {
    const int tid = hidden_tid(wv), lane = tid & 63, w = tid >> 6, fr = lane & 15, fq = lane >> 4;
    float* part = (float*)shm;
    float* ssql = part + 8 * 64 * 49;
    float* lgl = ssql + 8 * 64;
    int* cntl = (int*)((char*)shm + LDS_ROUTE);
    int* basel = cntl + 32;
    int* sel = basel + 32;
    int* posl = sel + 128;
    float* rsl = (float*)(posl + 128);
    float* WT = (float*)(p.ws + (ALT ? WS_ACT + (size_t)4 * 1024 * 1024 : WS_WT));
    float* RSTD = (float*)(p.ws + (ALT ? WS_ACT + (size_t)5 * 1024 * 1024 : WS_RSTD));
    int* LIST = (int*)(p.ws + (ALT ? WS_ACT : WS_LIST));
    float* RP = (float*)(p.ws + (ALT ? WS_ACT + (size_t)2 * 1024 * 1024 : WS_RP));
    int* CNT = (int*)(p.ws + WS_CNT) + (layer + (ALT ? 4 : 0)) * NEXP * CNT_STRIDE;
    const float* bg = p.in[26] + layer * 4; const float* be = p.in[28] + layer * NEXP;
    const char* const Xc = (const char*)(p.ws + WS_XB);
    const char* const Whc = (const char*)(p.ws + WS_WRT) + (size_t)layer * 2 * 48 * 1024 * 2; const char* const Wlc = Whc + 48 * 1024 * 2;
#pragma unroll
    for (int mt = 0; mt < 4; ++mt) {
        float sq = ssq[mt]; sq += shx(sq, 16, lane); sq += shx(sq, 32, lane);
        if (fq == 0) ssql[w * 64 + mt * 16 + fr] = sq;
#pragma unroll
        for (int nt = 0; nt < 3; ++nt)
#pragma unroll
            for (int r = 0; r < 4; ++r) part[(w * 64 + mt * 16 + fq * 4 + r) * 49 + nt * 16 + fr] = acc[mt][nt][r];
    }
    __syncthreads();
    {
        const int tl = tid & 63;
        for (int j = tid >> 6; j < 36; j += 8) {
            float s = 0.f;
#pragma unroll
            for (int ww = 0; ww < 8; ++ww) s += part[(ww * 64 + tl) * 49 + j];
            lgl[tl * 37 + j] = s;
        }
    }
    __syncthreads();
    if (tid < 64) {
        const int tl = tid, tk = chunk * 64 + tl;
        float sq = 0.f;
#pragma unroll
        for (int ww = 0; ww < 8; ++ww) sq += ssql[ww * 64 + tl];
        const float rstd = rsqrtf(sq * (1.0f / 1024.0f) + EPS);
        float lg[36];
#pragma unroll
        for (int j = 0; j < 36; ++j) lg[j] = lgl[tl * 37 + j] * rstd;
        float g0 = lg[0] + bg[0], g1 = lg[1] + bg[1], g2 = lg[2] + bg[2], g3 = lg[3] + bg[3];
        int gs = 0; float gm = g0;
        if (g1 > gm) { gm = g1; gs = 1; } if (g2 > gm) { gm = g2; gs = 2; } if (g3 > gm) { gm = g3; gs = 3; }
        const float gden = __expf(g0 - gm) + __expf(g1 - gm) + __expf(g2 - gm) + __expf(g3 - gm);
        const float ggate = 1.0f / gden;
        float ev[8];
#pragma unroll
        for (int j = 0; j < 8; ++j) {
            const float a0 = lg[4 + j] + be[j], a1 = lg[12 + j] + be[8 + j], a2 = lg[20 + j] + be[16 + j], a3 = lg[28 + j] + be[24 + j];
            ev[j] = gs == 0 ? a0 : gs == 1 ? a1 : gs == 2 ? a2 : a3;
        }
        int i0 = 0; float v0 = ev[0];
#pragma unroll
        for (int j = 1; j < 8; ++j) if (ev[j] > v0) { v0 = ev[j]; i0 = j; }
        int i1 = -1; float v1 = -3.0e38f;
#pragma unroll
        for (int j = 0; j < 8; ++j) if (j != i0 && ev[j] > v1) { v1 = ev[j]; i1 = j; }
        const float e1 = __expf(v1 - v0), sden = 1.0f / (1.0f + e1);
        const int ea = gs * 8 + i0, eb = gs * 8 + i1;
        sel[2 * tl] = ea; posl[2 * tl] = atomicAdd(&cntl[ea], 1);
        sel[2 * tl + 1] = eb; posl[2 * tl + 1] = atomicAdd(&cntl[eb], 1);
        WT[2 * tk] = ggate * sden; WT[2 * tk + 1] = ggate * e1 * sden;
        RSTD[tk] = rstd; rsl[tl] = rstd;
    }
    __syncthreads();
    if (tid < 32) { const int c = cntl[tid]; basel[tid] = (ALT && DUPSEL == 1) ? chunk * 4 : (c > 0 ? atomicAdd(&CNT[tid * CNT_STRIDE], c) : 0); }
    __syncthreads();
    if (tid < 128) { const int e = sel[tid]; const size_t li = (size_t)e * NTOK + basel[e] + posl[tid]; LIST[li] = 128 * chunk + tid; RP[li] = rsl[tid >> 1]; }
}

template <bool ALT>
__device__ __forceinline__ void route_phase(const Params& p, const int layer, const int bid, const int nb, const int wv) {
    const int tid = hidden_tid(wv), lane = tid & 63, w = tid >> 6, fr = lane & 15, fq = lane >> 4;
    float* part = (float*)shm;
    float* ssql = part + 8 * 64 * 49;
    float* lgl = ssql + 8 * 64;
    int* cntl = (int*)((char*)shm + LDS_ROUTE);
    int* basel = cntl + 32;
    int* sel = basel + 32;
    int* posl = sel + 128;
    float* rsl = (float*)(posl + 128);
    float* WT = (float*)(p.ws + (ALT ? WS_ACT + (size_t)4 * 1024 * 1024 : WS_WT));
    float* RSTD = (float*)(p.ws + (ALT ? WS_ACT + (size_t)5 * 1024 * 1024 : WS_RSTD));
    int* LIST = (int*)(p.ws + (ALT ? WS_ACT : WS_LIST));
    float* RP = (float*)(p.ws + (ALT ? WS_ACT + (size_t)2 * 1024 * 1024 : WS_RP));
    int* CNT = (int*)(p.ws + WS_CNT) + (layer + (ALT ? 4 : 0)) * NEXP * CNT_STRIDE;
    const float* bg = p.in[26] + layer * 4; const float* be = p.in[28] + layer * NEXP;
    const char* const Xc = (const char*)(p.ws + WS_XB);
    const char* const Whc = (const char*)(p.ws + WS_WRT) + (size_t)layer * 2 * 48 * 1024 * 2; const char* const Wlc = Whc + 48 * 1024 * 2;
    for (int chunk = bid; chunk < NTOK / 64; chunk += nb) {
        __syncthreads();
        if (tid < 32) cntl[tid] = 0;
        const unsigned xoff = (unsigned)(((chunk * 64 + fr) * D + w * 128 + fq * 8) * 2), woff = (unsigned)((fr * 1024 + w * 128 + fq * 8) * 2);
        f32x4 acc[4][3];
#pragma unroll
        for (int mt = 0; mt < 4; ++mt)
#pragma unroll
            for (int nt = 0; nt < 3; ++nt) acc[mt][nt] = (f32x4){0.f, 0.f, 0.f, 0.f};
        float ssq[4] = {0.f, 0.f, 0.f, 0.f};
        u32x4 xa[4][4]; bf16x8 Bh[2][3], Bl[2][3];
#pragma unroll
        for (int st = 0; st < 4; ++st)
#pragma unroll
            for (int mt = 0; mt < 4; ++mt) xa[st][mt] = *(const u32x4*)(Xc + (xoff + (unsigned)(mt * 16 * D * 2 + st * 64)));
#pragma unroll
        for (int nt = 0; nt < 3; ++nt) { Bh[0][nt] = *(const bf16x8*)(Whc + (woff + (unsigned)(nt * 16 * 2048))); Bl[0][nt] = *(const bf16x8*)(Wlc + (woff + (unsigned)(nt * 16 * 2048))); }
#pragma unroll
        for (int st = 0; st < 4; ++st) {
            if (st < 3) {
#pragma unroll
                for (int nt = 0; nt < 3; ++nt) { Bh[(st + 1) & 1][nt] = *(const bf16x8*)(Whc + (woff + (unsigned)(nt * 16 * 2048 + (st + 1) * 64))); Bl[(st + 1) & 1][nt] = *(const bf16x8*)(Wlc + (woff + (unsigned)(nt * 16 * 2048 + (st + 1) * 64))); }
            }
#pragma unroll
            for (int mt = 0; mt < 4; ++mt) {
                const u32x4 xb = xa[st][mt];
                const f32x4 x0 = {bflo(xb.x), bfhi(xb.x), bflo(xb.y), bfhi(xb.y)}, x1 = {bflo(xb.z), bfhi(xb.z), bflo(xb.w), bfhi(xb.w)};
                ssq[mt] += x0[0] * x0[0] + x0[1] * x0[1] + x0[2] * x0[2] + x0[3] * x0[3] + x1[0] * x1[0] + x1[1] * x1[1] + x1[2] * x1[2] + x1[3] * x1[3];
                const bf16x8 Ah = __builtin_bit_cast(bf16x8, xb);
#pragma unroll
                for (int nt = 0; nt < 3; ++nt) {
                    acc[mt][nt] = __builtin_amdgcn_mfma_f32_16x16x32_bf16(Ah, Bh[st & 1][nt], acc[mt][nt], 0, 0, 0);
                    acc[mt][nt] = __builtin_amdgcn_mfma_f32_16x16x32_bf16(Ah, Bl[st & 1][nt], acc[mt][nt], 0, 0, 0);
                }
            }
            __builtin_amdgcn_sched_barrier(0);
        }
        route_tail<ALT>(p, layer, chunk, acc, ssq, wv);
    }
}

constexpr int GOR_PITCH = 1040;
template <bool ALT>
__device__ __forceinline__ void gor_phase(const Params& p, const int layer, const int bid, const int nb, const int wv) {
    const int tid = hidden_tid(wv), lane = tid & 63, w = tid >> 6, fr = lane & 15, fq = lane >> 4;
    char* const lds = (char*)shm;
    int* cntl = (int*)((char*)shm + LDS_ROUTE);
    const bf16_t* OXp = (const bf16_t*)(p.ws + WS_OX);
    bf16_t* XB = (bf16_t*)(p.ws + WS_XB);
    const char* const Wo = (const char*)(p.ws + WS_W_CO) + (size_t)layer * 1024 * 512 * 2;
    const char* const Whc = (const char*)(p.ws + WS_WRT) + (size_t)layer * 2 * 48 * 1024 * 2; const char* const Wlc = Whc + 48 * 1024 * 2;
    for (int chunk = bid; chunk < NTOK / 64; chunk += nb) {
        const int r0 = chunk * 64;
        __syncthreads();
        if (tid < 32) cntl[tid] = 0;
        {
            u32x4 v[8];
#pragma unroll
            for (int i = 0; i < 8; ++i) { const int pc = tid + i * NT; v[i] = *(const u32x4*)(OXp + (size_t)(r0 + (pc >> 6)) * 512 + (pc & 63) * 8); }
#pragma unroll
            for (int i = 0; i < 8; ++i) { const int pc = tid + i * NT; *(u32x4*)(lds + (pc >> 6) * GOR_PITCH + (pc & 63) * 16) = v[i]; }
        }
        __syncthreads();
        f32x4 accr[4][3];
#pragma unroll
        for (int mt = 0; mt < 4; ++mt)
#pragma unroll
            for (int nt = 0; nt < 3; ++nt) accr[mt][nt] = (f32x4){0.f, 0.f, 0.f, 0.f};
        float ssq[4] = {0.f, 0.f, 0.f, 0.f};
        const int aoffl = fr * GOR_PITCH + fq * 16;
        const int kst = (bid >> 3) & 15;
#pragma unroll 1
        for (int half = 0; half < 2; ++half) {
            const int cb = w * 128 + half * 64;
            const unsigned boff = (unsigned)((cb >> 4) * 16 * 1024 + lane * 16);
            const unsigned woff = (unsigned)((cb >> 5) * 1024 + lane * 16);
            f32x4 acc[4][4];
#pragma unroll
            for (int i = 0; i < 4; ++i)
#pragma unroll
                for (int j = 0; j < 4; ++j) acc[i][j] = (f32x4){0.f, 0.f, 0.f, 0.f};
            bf16x8 Bq[4][4];
#define GOR_LDB(s_) do { _Pragma("unroll") for (int j = 0; j < 4; ++j) Bq[(s_) & 3][j] = *(const bf16x8*)(Wo + (boff + (unsigned)(j * 16 * 1024 + (((s_) + kst) & 15) * 1024))); } while (0)
            GOR_LDB(0); GOR_LDB(1); GOR_LDB(2);
            u32x4 xrow[8];
            char* const xbase = (char*)(XB + (size_t)r0 * D + __builtin_amdgcn_readfirstlane(cb));
            const unsigned xvoff = (unsigned)((lane >> 3) * (D * 2) + (lane & 7) * 16);
            bf16x8 Wh[2][3], Wl[2][3];
#pragma unroll
            for (int s = 0; s < 16; ++s) {
                if (s + 3 < 16) GOR_LDB(s + 3);
                if (s == 15) {
#pragma unroll
                    for (int it = 0; it < 8; ++it) xrow[it] = *(const u32x4*)(xbase + (size_t)it * (8 * D * 2) + xvoff);
                }
                bf16x8 Af[4];
#pragma unroll
                for (int i = 0; i < 4; ++i) Af[i] = *(const bf16x8*)(lds + aoffl + i * 16 * GOR_PITCH + ((s + kst) & 15) * 64);
#pragma unroll
                for (int j = 0; j < 4; ++j)
#pragma unroll
                    for (int i = 0; i < 4; ++i) acc[i][j] = __builtin_amdgcn_mfma_f32_16x16x32_bf16(Bq[s & 3][j], Af[i], acc[i][j], 0, 0, 0);
                __builtin_amdgcn_sched_barrier(0);
            }
#undef GOR_LDB
            char* const pat = lds + 64 * GOR_PITCH + w * (64 * 144);
#pragma unroll
            for (int it = 0; it < 8; ++it) *(u32x4*)(pat + (it * 8 + (lane >> 3)) * 144 + (lane & 7) * 16) = xrow[it];
            __builtin_amdgcn_sched_barrier(0);
#pragma unroll
            for (int pp = 0; pp < 2; ++pp)
#pragma unroll
                for (int nt = 0; nt < 3; ++nt) { Wh[pp][nt] = *(const bf16x8*)(Whc + (woff + (unsigned)(nt * 32 * 1024 + pp * 1024))); Wl[pp][nt] = *(const bf16x8*)(Wlc + (woff + (unsigned)(nt * 32 * 1024 + pp * 1024))); }
#pragma unroll
            for (int i = 0; i < 4; ++i) {
                char* const qb = pat + (16 * i + fr) * 144 + 8 * fq;
                unsigned pk[4][2];
#pragma unroll
                for (int j = 0; j < 4; ++j) {
                    const u32x2 x = *(const u32x2*)(qb + 32 * j);
                    const f32x4 t = (f32x4){bflo(x.x), bfhi(x.x), bflo(x.y), bfhi(x.y)} + acc[i][j];
                    const unsigned a0 = cvt_pk_bf16(t[0], t[1]), a1 = cvt_pk_bf16(t[2], t[3]);
                    *(u32x2*)(qb + 32 * j) = (u32x2){a0, a1};
                    const float r0f = bflo(a0), r1f = bfhi(a0), r2f = bflo(a1), r3f = bfhi(a1);
                    ssq[i] += (r0f * r0f + r1f * r1f) + (r2f * r2f + r3f * r3f);
                    pk[j][0] = a0; pk[j][1] = a1;
                }
#pragma unroll
                for (int pp = 0; pp < 2; ++pp) {
                    const bf16x8 Ah = __builtin_bit_cast(bf16x8, (u32x4){pk[2 * pp][0], pk[2 * pp][1], pk[2 * pp + 1][0], pk[2 * pp + 1][1]});
#pragma unroll
                    for (int nt = 0; nt < 3; ++nt) {
                        accr[i][nt] = __builtin_amdgcn_mfma_f32_16x16x32_bf16(Ah, Wh[pp][nt], accr[i][nt], 0, 0, 0);
                        accr[i][nt] = __builtin_amdgcn_mfma_f32_16x16x32_bf16(Ah, Wl[pp][nt], accr[i][nt], 0, 0, 0);
                    }
                }
            }
#pragma unroll
            for (int it = 0; it < 8; ++it) {
                const u32x4 v = *(const u32x4*)(pat + (it * 8 + (lane >> 3)) * 144 + (lane & 7) * 16);
                *(u32x4*)(xbase + (size_t)it * (8 * D * 2) + xvoff) = v;
            }
        }
        __syncthreads();
        route_tail<ALT>(p, layer, chunk, accr, ssq, wv);
    }
}

template <int MODE, int PF = 1>
__device__ __forceinline__ void cvt_job(const float* __restrict__ src, bf16_t* __restrict__ dst, const int K, const int N, const int nmat,
                                        const size_t dst_mat_stride, const int bid, const int nb, const int wv, const float* __restrict__ kgain = nullptr, const int gshift = 0, const int tlimit = 0x7fffffff) {
    unsigned* Dl0 = (unsigned*)shm;
    int par = 0;
    __syncthreads();
    const int tid = hidden_tid(wv);
    const int tk = K / 128, tn = N / 128, per = tk * tn, total = (per * nmat < tlimit) ? per * nmat : tlimit;
    const int cg = tid & 31, rg = tid >> 5;
    f32x4 v[PF][8];
#define CVT_ROW(i_) (2 * rg + ((i_) & 1) + 32 * ((i_) >> 1))
#define CVT_LOAD(s_, t_) do { const int mat_ = (t_) / per, r_ = (t_) % per, k0_ = (r_ / tn) * 128, n0_ = (r_ % tn) * 128; \
        const float* sp_ = src + (size_t)mat_ * K * N + (size_t)k0_ * N + n0_; \
        _Pragma("unroll") for (int i = 0; i < 8; ++i) v[s_][i] = *(const f32x4*)(sp_ + (size_t)CVT_ROW(i) * N + cg * 4); } while (0)
#pragma unroll
    for (int s0 = 0; s0 < PF; ++s0) if (bid + s0 * nb < total) CVT_LOAD(s0, bid + s0 * nb);
    for (int t0 = bid; t0 < total; t0 += PF * nb) {
#pragma unroll
        for (int s0 = 0; s0 < PF; ++s0) {
            const int t = t0 + s0 * nb;
            if (t >= total) break;
            const int mat = t / per, r = t % per, k0 = (r / tn) * 128, n0 = (r % tn) * 128;
            bf16_t* d = dst + (size_t)mat * dst_mat_stride;
            if (kgain) {
#pragma unroll
                for (int i = 0; i < 8; ++i) v[s0][i] *= kgain[(size_t)(mat >> gshift) * D + k0 + CVT_ROW(i)];
            }
            unsigned* Dl = Dl0 + par * 8192; par ^= 1;
#pragma unroll
            for (int ip = 0; ip < 4; ++ip) {
                const int kp = rg + 16 * ip;
                u32x4 w;
                w.x = cvt_pk_bf16(v[s0][2 * ip][0], v[s0][2 * ip + 1][0]); w.y = cvt_pk_bf16(v[s0][2 * ip][1], v[s0][2 * ip + 1][1]);
                w.z = cvt_pk_bf16(v[s0][2 * ip][2], v[s0][2 * ip + 1][2]); w.w = cvt_pk_bf16(v[s0][2 * ip][3], v[s0][2 * ip + 1][3]);
                *(u32x4*)(Dl + kp * 128 + ((4 * cg) ^ (((kp >> 2) & 7) << 2))) = w;
            }
            __syncthreads();
            if (t + PF * nb < total) CVT_LOAD(s0, t + PF * nb);
#pragma unroll
            for (int j = 0; j < 4; ++j) {
                const int n = (tid >> 4) + 32 * j, kc = (tid & 15) * 8, kp0 = (tid & 15) * 4, sw = ((tid & 15) & 7) << 2;
                u32x4 ov;
                ov.x = Dl[(kp0 + 0) * 128 + (n ^ sw)]; ov.y = Dl[(kp0 + 1) * 128 + (n ^ sw)]; ov.z = Dl[(kp0 + 2) * 128 + (n ^ sw)]; ov.w = Dl[(kp0 + 3) * 128 + (n ^ sw)];
                const int ng = n0 + n;
                if (MODE == 3) {
                    const int kk = k0 + kc;
                    *(u32x4*)(d + ((size_t)((ng >> 4) * (K >> 5) + (kk >> 5)) * 64 + ((kk >> 3) & 3) * 16 + (ng & 15)) * 8) = ov;
                } else {
                    const int row = (MODE == 0) ? ng : ((ng >> 5) * 64 + ((ng >> 2) & 1) * 32 + (MODE == 2 ? 16 : 0) + ((ng >> 3) & 3) * 4 + (ng & 3));
                    *(u32x4*)(d + (size_t)row * K + k0 + kc) = ov;
                }
            }
        }
    }
#undef CVT_LOAD
#undef CVT_ROW
}

__device__ __forceinline__ void prologue0(const Params& p, const int bid, const int nb, const int wv) {
    unsigned char* ws = p.ws;
    cvt_job<0>(p.in[3], (bf16_t*)(ws + WS_W_EIN), 1024, 3072, 2, (size_t)3072 * 1024, bid, nb, wv, p.in[2]);
    cvt_job<0>(p.in[15], (bf16_t*)(ws + WS_W_EOUT), 1024, 1024, 2, (size_t)1024 * 1024, bid, nb, wv);
    cvt_job<0>(p.in[17], (bf16_t*)(ws + WS_W_OIN), 1024, 1536, 2, (size_t)1536 * 1024, bid, nb, wv, p.in[16]);
    cvt_job<0>(p.in[19], (bf16_t*)(ws + WS_W_OOUT), 1024, 1024, 2, (size_t)1024 * 1024, bid, nb, wv);
    cvt_job<0>(p.in[21], (bf16_t*)(ws + WS_W_CQ), 1024, 512, 4, (size_t)512 * 1024, bid, nb, wv, p.in[20]);
    cvt_job<0>(p.in[22], (bf16_t*)(ws + WS_W_CKV), 1024, 1024, 4, (size_t)1024 * 1024, bid, nb, wv);
    cvt_job<3>(p.in[23], (bf16_t*)(ws + WS_W_CO), 512, 1024, 4, (size_t)1024 * 512, bid, nb, wv);
    if (!(NCONV > 0 && nb > 2 * NCONV)) {
        cvt_job<1>(p.in[29], (bf16_t*)(ws + WS_W_GU), 1024, 512, 128, (size_t)1024 * 1024, bid, nb, wv, p.in[24], 5);
        cvt_job<2>(p.in[30], (bf16_t*)(ws + WS_W_GU), 1024, 512, 128, (size_t)1024 * 1024, bid, nb, wv, p.in[24], 5);
        cvt_job<0>(p.in[31], (bf16_t*)(ws + WS_W_DN), 512, 1024, 128, (size_t)1024 * 512, bid, nb, wv);
    }
    const int tid = hidden_tid(wv), lane = tid & 63, w = tid >> 6;
    {
        Row16 g; ld_row(g, p.in[32], lane);
        bf16_t* MN = (bf16_t*)(ws + WS_MEMN);
        for (int r = bid * 8 + w; r < Bb * MEM; r += nb * 8) {
            Row16 x; ld_row(x, p.in[1] + (size_t)r * D, lane);
            const float rstd = row_rstd(x, lane);
#pragma unroll
            for (int i = 0; i < 4; ++i) st_bf16x4(MN + (size_t)r * D + 256 * i + 4 * lane, x.v[i] * rstd * g.v[i]);
        }
    }
    {
        float* A2 = (float*)(ws + WS_A2);
#pragma unroll 1
        for (int lj = 0; lj < 2; ++lj) {
            const int rbeg = lj * S + bid * 8 + w;
            if (rbeg < (lj + 1) * S) {
                const float* w1 = p.in[6] + (size_t)lj * 33 * 64; const float* w2 = p.in[8] + (size_t)lj * 64 * 64;
                float w1c[33], w2c[64];
#pragma unroll
                for (int j = 0; j < 33; ++j) w1c[j] = w1[j * 64 + lane];
#pragma unroll
                for (int i = 0; i < 64; ++i) w2c[i] = w2[i * 64 + lane];
                const float b1v = p.in[7][lj * 64 + lane], b2v = p.in[9][lj * 64 + lane], fr_ = p.in[11][lj * 64 + lane];
                for (int r = rbeg; r < (lj + 1) * S; r += nb * 8) {
                    const int pos = r - lj * S;
                    float a = ((float)pos / 2047.0f) * w1c[0];
#pragma unroll
                    for (int k = 0; k < 16; ++k) {
                        const float band = 1e-4f + (float)k * ((15.0f - 1e-4f) / 15.0f);
                        const float rev = band * ((float)pos * (1.0f / 2048.0f));
                        const float rf = rev - floorf(rev);
                        a += __builtin_amdgcn_cosf(rf) * w1c[1 + k] - __builtin_amdgcn_sinf(rf) * w1c[17 + k];
                    }
                    const float a1 = sinf(fr_ * (a + b1v));
                    float a2 = 0.f;
#pragma unroll
                    for (int i = 0; i < 64; ++i) a2 += shl(a1, i) * w2c[i];
                    A2[(size_t)r * 64 + lane] = sinf(fr_ * (a2 + b2v));
                }
            }
        }
    }
    {
        bf16_t* WR = (bf16_t*)(ws + WS_WRT);
        for (int i = bid * NT + tid; i < 4 * 48 * 1024; i += nb * NT) {
            const int l = i / (48 * 1024), r = i % (48 * 1024), j = r >> 10, kp = r & 1023;
            const int k = (kp & ~31) + (((kp & 7) < 4) ? 4 * ((kp >> 3) & 3) + (kp & 7) : 16 + 4 * ((kp >> 3) & 3) + (kp & 7) - 4);
            float v = 0.f;
            if (j < 4) v = p.in[25][((size_t)l * D + k) * 4 + j]; else if (j < 36) v = p.in[27][((size_t)l * D + k) * NEXP + (j - 4)];
            v *= p.in[24][(size_t)l * D + k];
            const unsigned h = cvt_pk_bf16(v, 0.f) & 0xffffu;
            const unsigned lo = cvt_pk_bf16(v - bflo(h), 0.f) & 0xffffu;
            const int rf = ((((j >> 4) * 32 + (kp >> 5)) * 64 + ((kp >> 3) & 3) * 16 + (j & 15)) << 3) + (kp & 7);
            WR[(size_t)l * 2 * 48 * 1024 + rf] = (bf16_t)h; WR[(size_t)l * 2 * 48 * 1024 + 48 * 1024 + rf] = (bf16_t)lo;
        }
    }
    if (bid == 0) {
        if (tid < 128) {
            const int lj = tid >> 6, i = tid & 63;
            const float* lm = p.in[13] + (size_t)lj * 4 * 64;
            const float s01 = wave_sum(lm[i] * lm[64 + i], i), s23 = wave_sum(lm[128 + i] * lm[192 + i], i);
            if (i == 0) {
                const float lam_init = 0.8f - 0.6f * expf(-0.3f * (float)(2 * lj));
                ((float*)(ws + WS_MISC))[lj] = expf(s01) - expf(s23) + lam_init;
                ((float*)(ws + WS_MISC))[2 + lj] = 1.0f - lam_init;
            }
        }
        bf16_t* hz = (bf16_t*)(ws + WS_XB) + (size_t)NTOK * D; bf16_t* az = (bf16_t*)(ws + WS_ACT) + (size_t)2 * NTOK * EH;
        for (int i = tid; i < D; i += NT) hz[i] = 0;
        for (int i = tid; i < EH; i += NT) az[i] = 0;
    }
}

__device__ __forceinline__ void filter_taps(const Params& p, const int bid, const int nb, const int wv) {
    const int tid = hidden_tid(wv), w = tid >> 6, lane = tid & 63, fr = lane & 15, fq = lane >> 4;
    const float* A2 = (const float*)(p.ws + WS_A2);
    bf16_t* FL = (bf16_t*)(p.ws + WS_FILT);
    const float mind = logf(1e-2f) / 1.5f, maxd = logf(1e-2f) / 0.3f;
    for (int job = bid; job < 2 * 4 * 8 * 32; job += nb) {
        const int pt = job & 31, ct = (job >> 5) & 7, od = (job >> 8) & 3, lj = job >> 10;
        const int pos0 = pt * 64 + (w >> 2) * 32, ch0 = ct * 64 + (w & 3) * 16, order = od >> 1, dir = od & 1;
        const float* w3 = p.in[10] + (size_t)lj * 64 * 2048 + od * 512 + ch0 + fr;
        bf16x8 Af[2], Bf[2][2];
#pragma unroll
        for (int ks = 0; ks < 2; ++ks) {
            float e[8];
#pragma unroll
            for (int jj = 0; jj < 8; ++jj) e[jj] = w3[(size_t)(ks * 32 + fq * 8 + jj) * 2048];
            u32x4 pk; pk.x = cvt_pk_bf16(e[0], e[1]); pk.y = cvt_pk_bf16(e[2], e[3]); pk.z = cvt_pk_bf16(e[4], e[5]); pk.w = cvt_pk_bf16(e[6], e[7]);
            Af[ks] = __builtin_bit_cast(bf16x8, pk);
#pragma unroll
            for (int nt = 0; nt < 2; ++nt) {
                const float* ap = A2 + ((size_t)lj * S + pos0 + nt * 16 + fr) * 64 + ks * 32 + fq * 8;
                const f32x4 v0 = *(const f32x4*)ap, v1 = *(const f32x4*)(ap + 4);
                u32x4 pb; pb.x = cvt_pk_bf16(v0[0], v0[1]); pb.y = cvt_pk_bf16(v0[2], v0[3]); pb.z = cvt_pk_bf16(v1[0], v1[1]); pb.w = cvt_pk_bf16(v1[2], v1[3]);
                Bf[nt][ks] = __builtin_bit_cast(bf16x8, pb);
            }
        }
#pragma unroll
        for (int nt = 0; nt < 2; ++nt) {
            f32x4 acc = {0.f, 0.f, 0.f, 0.f};
            acc = __builtin_amdgcn_mfma_f32_16x16x32_bf16(Af[0], Bf[nt][0], acc, 0, 0, 0);
            acc = __builtin_amdgcn_mfma_f32_16x16x32_bf16(Af[1], Bf[nt][1], acc, 0, 0, 0);
            const int pos = pos0 + nt * 16 + fr;
            const float tpos = (float)pos / 2047.0f;
#pragma unroll
            for (int r = 0; r < 4; ++r) {
                const int ch = ch0 + fq * 4 + r;
                const float delta = mind + (float)ch * ((maxd - mind) / 511.0f);
                const float v = acc[r] * __builtin_amdgcn_exp2f(-tpos * fabsf(delta) * 1.4426950408889634f);
                bf16_t* f = FL + ((size_t)(lj * 2 + order) * 512 + ch) * 4096;
                const unsigned short hv = (unsigned short)(cvt_pk_bf16(v, 0.f) & 0xffff);
                if (dir == 0) f[2047 - pos] = hv;
                else { if (pos >= 1) f[2047 + pos] = hv; if (pos == 2047) f[4095] = 0; }
            }
        }
    }
}

enum { PH_P0 = 0, PH_P1, PH_N1, PH_GIN, PH_MIX, PH_GOUT, PH_N2, PH_GQ, PH_XATT, PH_GO, PH_ROUTE, PH_G1, PH_G2, PH_FINAL, PH_TR, PH_GOR, PH_COUNT };

template <class Epi>
__device__ __forceinline__ void gemm_dense(const bf16_t* A, const bf16_t* Bt, const int K, const int nM, const int nN, Epi epi, const int bid, const int nb, const int wv, const int ntl = 0) {
    for (int u = bid; u < nM * nN; u += nb) {
        const int pm = u / nN, pn = u % nN;
        epi.brow = pm * 256;
        gemm_tile(A + (size_t)pm * 256 * K, Bt, K, pn * 256, RowIdent{}, epi, wv, ntl);
    }
}

constexpr int CV_CH = 4;
constexpr int CV_CPJ = 64 * 32 / CV_CH;
constexpr int CV_CHUNKS = 3 * CV_CPJ;
__device__ __forceinline__ void moe_convert_chunk(const Params& p, const int lp, const int c, const int wv) {
    unsigned char* ws = p.ws;
    const size_t mo = (size_t)64 * lp;
    const int job = c / CV_CPJ, t0 = (c % CV_CPJ) * CV_CH;
    if (job == 0)      cvt_job<1, 4>(p.in[29] + mo * 1024 * 512, (bf16_t*)(ws + WS_W_GU) + mo * 1024 * 1024, 1024, 512, 64, (size_t)1024 * 1024, t0, 1, wv, p.in[24] + (size_t)(2 * lp) * D, 5, t0 + CV_CH);
    else if (job == 1) cvt_job<2, 4>(p.in[30] + mo * 1024 * 512, (bf16_t*)(ws + WS_W_GU) + mo * 1024 * 1024, 1024, 512, 64, (size_t)1024 * 1024, t0, 1, wv, p.in[24] + (size_t)(2 * lp) * D, 5, t0 + CV_CH);
    else               cvt_job<0, 4>(p.in[31] + mo * 512 * 1024, (bf16_t*)(ws + WS_W_DN) + mo * 1024 * 512, 512, 1024, 64, (size_t)1024 * 512, t0, 1, wv, nullptr, 0, t0 + CV_CH);
}

__device__ __forceinline__ void conv_queue_loop(const Params& p, const int lp, unsigned* chead, const int wv) {
    typedef __attribute__((address_space(1))) unsigned gu32_t;
    int* uq = (int*)((char*)shm + LDS_ROUTE + 1024);
    const int tid = hidden_tid(wv);
    for (;;) {
        __syncthreads();
        if (tid == 0) *uq = (int)__hip_atomic_fetch_add((gu32_t*)chead, 1u, __ATOMIC_RELAXED, __HIP_MEMORY_SCOPE_AGENT);
        __syncthreads();
        const int c = __builtin_amdgcn_readfirstlane(*uq);
        if (c >= CV_CHUNKS) break;
        moe_convert_chunk(p, lp, c, wv);
    }
}

__device__ __forceinline__ void kv_unit(unsigned char* ws, const int lkv, const int v, const int wv) {
    const int pm = v >> 2, pn = v & 3;
    EpiSplit e{nullptr, (bf16_t*)(ws + WS_XK) + (size_t)lkv * 2048 * 512, (bf16_t*)(ws + WS_XVT) + (size_t)lkv * 512 * 2048, 0, 512, 512, (size_t)2048, pm * 256, nullptr};
    gemm_tile((const bf16_t*)(ws + WS_MEMN) + (size_t)pm * 256 * 1024, (const bf16_t*)(ws + WS_W_CKV) + (size_t)lkv * 1024 * 1024, 1024, pn * 256, RowIdent{}, e, wv);
}

typedef const __attribute__((address_space(4))) Params* ParamsK;
#define PHASE_FN __forceinline__
template <int PH, bool ALT = false>
__device__ PHASE_FN void run_phase(ParamsK pk_, const int layer, const int bid_, const int nb_, const int wv_) {
    ParamsK pk = pk_; asm volatile("" : "+s"(pk));
    int bid = bid_, nb = nb_, wv = wv_; asm volatile("" : "+s"(bid), "+s"(nb), "+s"(wv));
    const Params& p = *(const Params*)pk;
    unsigned char* ws = p.ws;
    const int lj = layer >> 1; const bool even = (layer & 1) == 0;
    bf16_t* H = (bf16_t*)(ws + WS_H);
    float* X = (float*)(ws + WS_X);
    bf16_t* YMIX = (bf16_t*)(ws + WS_YMIX);
    bf16_t* QX = (bf16_t*)(ws + WS_QX);
    bf16_t* OX = (bf16_t*)(ws + WS_OX);
    if constexpr (PH == PH_P0) { prologue0(p, bid, nb, wv); }
    if constexpr (PH == PH_N1) {
        norm_phase<0, ALT>(p, layer, nullptr, bid, nb, wv);
        if (layer == 0 && !ALT) {
            if (nb > 64) {
                if (bid < 32) kv_unit(ws, 0, bid, wv); else filter_taps(p, bid - 32, nb - 32, wv);
            } else {
                filter_taps(p, bid, nb, wv);
                for (int v = bid; v < 32; v += nb) kv_unit(ws, 0, v, wv);
            }
        }
    }
    if constexpr (PH == PH_GIN) {
        const bf16_t* XBc = (const bf16_t*)(ws + WS_XB); const float* RS1 = (const float*)(ws + WS_RS1);
        if (ALT && DUPSEL >= 1) {
            int fl = bid; asm volatile("" : "+s"(fl));
            EpiNull e{(float*)(ws + WS_X), fl == 0x7fffffff, 0};
            gemm_dense(XBc, (const bf16_t*)(ws + (even ? WS_W_EIN : WS_W_OIN)) + (size_t)lj * (even ? 3072 : 1536) * 1024, 1024, 64, even ? 12 : 6, e, bid, nb, wv, DUPSEL == 2 ? 8 : 0);
        } else if (even) {
            const bf16_t* We_ = (const bf16_t*)(ws + WS_W_EIN) + (size_t)lj * 3072 * 1024;
            for (int u = bid; u < 64 * 12; u += nb) {
                const int pm = u / 12, pn = u % 12;
                if (pn >= 6 && pn < 10) {
                    EpiTokS e{(bf16_t*)(ws + WS_PROJ + PR_QK), 1024, pm * 256, 1536, RS1};
                    gemm_tile<RowIdent, EpiTokS, false, true>(XBc + (size_t)pm * 256 * 1024, We_, 1024, pn * 256, RowIdent{}, e, wv);
                } else {
                    EpiSplit e{(bf16_t*)(ws + WS_PROJ + PR_HYT), nullptr, (bf16_t*)(ws + WS_PROJ + PR_VT), 1536, 2560, 1024, (size_t)NTOK, pm * 256, RS1};
                    gemm_tile(XBc + (size_t)pm * 256 * 1024, We_, 1024, pn * 256, RowIdent{}, e, wv);
                }
            }
        } else {
            const bf16_t* Wo_ = (const bf16_t*)(ws + WS_W_OIN) + (size_t)lj * 1536 * 1024;
            if (nb == 256 && !ALT) {
                {
                    const int pm = bid / 6, pn = bid % 6;
                    if (pn < 5) {
                        EpiTokS e{(bf16_t*)(ws + WS_PROJ), 1280, pm * 256, 0, RS1};
                        gemm_tile<RowIdent, EpiTokS, false, true>(XBc + (size_t)pm * 256 * 1024, Wo_, 1024, pn * 256, RowIdent{}, e, wv);
                    } else {
                        EpiSplit e{nullptr, (bf16_t*)(ws + WS_PROJ), (bf16_t*)(ws + WS_PROJ + PR_OVT), 0, 1280, 1280, (size_t)NTOK, pm * 256, RS1};
                        gemm_tile(XBc + (size_t)pm * 256 * 1024, Wo_, 1024, pn * 256, RowIdent{}, e, wv);
                    }
                }
                {
                    const int t = 256 + (bid >> 1), pm = t / 6, pn = t % 6;
                    if (pn < 5) {
                        EpiTokSH e{(bf16_t*)(ws + WS_PROJ), 1280, pm * 256, 0, RS1};
                        gemm_tile<RowIdent, EpiTokSH, true, true>(XBc + (size_t)pm * 256 * 1024, Wo_, 1024, pn * 256 + (bid & 1) * 128, RowIdent{}, e, wv);
                    } else {
                        EpiSplitH e{nullptr, (bf16_t*)(ws + WS_PROJ), (bf16_t*)(ws + WS_PROJ + PR_OVT), 0, 1280, 1280, (size_t)NTOK, pm * 256, RS1};
                        gemm_tile<RowIdent, EpiSplitH, true>(XBc + (size_t)pm * 256 * 1024, Wo_, 1024, pn * 256 + (bid & 1) * 128, RowIdent{}, e, wv);
                    }
                }
            } else {
                EpiSplit e{nullptr, (bf16_t*)(ws + WS_PROJ), (bf16_t*)(ws + WS_PROJ + PR_OVT), 0, 1280, 1280, (size_t)NTOK, 0, RS1};
                gemm_dense(XBc, Wo_, 1024, 64, 6, e, bid, nb, wv);
            }
        }
    }
    if constexpr (PH == PH_MIX) {
        if (even) {
            const bf16_t* qk = (const bf16_t*)(ws + WS_PROJ + PR_QK);
            const bf16_t* vT = (const bf16_t*)(ws + WS_PROJ + PR_VT);
            const float lam = uni(((const float*)(ws + WS_MISC))[lj]);
            const float oscale = uni(((const float*)(ws + WS_MISC))[2 + lj]);
            const bool convq = NCONV > 0 && nb > 2 * NCONV, isconv = convq && bid >= nb - NCONV;
            unsigned* chead = (unsigned*)(ws + WS_QHEAD) + (6 + lj) * 64;
            if (isconv) conv_queue_loop(p, lj, chead, wv);
            typedef __attribute__((address_space(1))) unsigned gu32_t;
            unsigned* mhead = (unsigned*)(ws + WS_QHEAD) + (4 + lj) * 64;
            int* uq = (int*)((char*)shm + LDS_ROUTE + 1024);
            const int tid = hidden_tid(wv);
            unsigned nxt_v = 0u;
            if (tid == 0) nxt_v = __hip_atomic_fetch_add((gu32_t*)mhead, 1u, __ATOMIC_RELAXED, __HIP_MEMORY_SCOPE_AGENT);
            for (;;) {
                __syncthreads();
                if (tid == 0) *uq = (int)nxt_v;
                __syncthreads();
                const int u = __builtin_amdgcn_readfirstlane(*uq);
                if (u >= 1024) break;
                if (tid == 0) nxt_v = __hip_atomic_fetch_add((gu32_t*)mhead, 1u, __ATOMIC_RELAXED, __HIP_MEMORY_SCOPE_AGENT);
                const int uu = u ^ 512;
                if (uu < 512) hyena_unit<ALT>(p, lj, uu, wv);
                else {
                    const int id = uu - 512, b = id >> 6, h = (id >> 4) & 3, qb = id & 15;
                    dattn_unit(qk + (size_t)(b * S) * 1024 + 2 * h * 64, 1024, qk + (size_t)(b * S) * 1024 + 512 + 2 * h * 64, 1024,
                               vT + (size_t)(h * 128) * NTOK + b * S, (size_t)NTOK, qb * 128, 0, S,
                               0.125f, uni(exp2f(-2.0f * (float)(h + 1))),
                               (ALT ? (bf16_t*)(ws + WS_Y) : YMIX) + (size_t)(b * S) * D + 512 + h * 128, D, lam, oscale, p.in[14] + (size_t)lj * 128, wv);
                }
            }
            if (convq && !isconv) conv_queue_loop(p, lj, chead, wv);
        } else {
            const bf16_t* qk = (const bf16_t*)(ws + WS_PROJ);
            const bf16_t* vT = (const bf16_t*)(ws + WS_PROJ + PR_OVT);
            for (int u = bid; u < 1024; u += nb) {
                const int b = u >> 7, kv = (u >> 5) & 3, qb = u & 31, q0 = qb * 64;
                const int kbeg = q0 - 128 < 0 ? 0 : q0 - 128, kend = q0 + 192 > S ? S : q0 + 192;
                attn2_unit<1>(qk + (size_t)(b * S) * 1280 + kv * 256, 1280, qk + (size_t)(b * S) * 1280 + 1024 + kv * 64, 1280,
                              vT + (size_t)(kv * 64) * NTOK + b * S, (size_t)NTOK, q0, kbeg, kend,
                              0.125f, p.in[18] + lj * 16 + kv * 4, kv * 4, YMIX + (size_t)(b * S) * D + kv * 256, D, wv);
            }
        }
    }
    if constexpr (PH == PH_TR) {
        const int tid = hidden_tid(wv);
        const bf16_t* yt = (const bf16_t*)(ws + WS_QX);
        bf16_t* T = shm;
        for (int t0 = bid; t0 < 8 * 256; t0 += 8 * nb) {
            u32x4 v[8];
#pragma unroll
            for (int i = 0; i < 8; ++i) { const int t = t0 + i * nb; const int c0 = (t & 7) * 64, tk0 = (t >> 3) * 64;
                if (t < 8 * 256) v[i] = *(const u32x4*)(yt + (size_t)(c0 + (tid >> 3)) * NTOK + tk0 + (tid & 7) * 8); }
            __syncthreads();
#pragma unroll
            for (int i = 0; i < 8; ++i) *(u32x4*)((char*)T + i * 9216 + (tid >> 3) * 144 + (tid & 7) * 16) = v[i];
            __syncthreads();
#pragma unroll
            for (int i = 0; i < 8; ++i) {
                const int t = t0 + i * nb; const int c0 = (t & 7) * 64, tk0 = (t >> 3) * 64;
                const int tok = tid >> 3, cg = (tid & 7) * 8;
                unsigned short e[8];
#pragma unroll
                for (int j = 0; j < 8; ++j) e[j] = T[i * 4608 + (cg + j) * 72 + tok];
                u32x4 ov; ov.x = e[0] | ((unsigned)e[1] << 16); ov.y = e[2] | ((unsigned)e[3] << 16); ov.z = e[4] | ((unsigned)e[5] << 16); ov.w = e[6] | ((unsigned)e[7] << 16);
                if (t < 8 * 256) *(u32x4*)(YMIX + (size_t)(tk0 + tok) * D + c0 + cg) = ov;
            }
        }
    }
    if constexpr (PH == PH_GOUT) {
        EpiResL e{(bf16_t*)(ws + (ALT ? WS_Y : WS_XB)), 0, (float*)(ws + WS_SSP), hidden_tid(wv) & 63};
        gemm_dense(YMIX, (const bf16_t*)(ws + (even ? WS_W_EOUT : WS_W_OOUT)) + (size_t)lj * 1024 * 1024, 1024, 64, 4, e, bid, nb, wv);
    }
    if constexpr (PH == PH_GQ) {
        for (int u = bid; u < 128 + 32; u += nb) {
            if (u < 128) {
                const int pm = u >> 1, pn = u & 1;
                EpiTokRstd e{QX, 512, pm * 256, (const float*)(ws + WS_SSP), hidden_tid(wv) & 63};
                gemm_tile((const bf16_t*)(ws + WS_XB) + (size_t)pm * 256 * 1024, (const bf16_t*)(ws + WS_W_CQ) + (size_t)layer * 512 * 1024, 1024, pn * 256, RowIdent{}, e, wv);
            } else {
                const int v = u - 128, pm = v >> 2, pn = v & 3;
                EpiSplit e{nullptr, (bf16_t*)(ws + WS_XK) + (size_t)layer * 2048 * 512, (bf16_t*)(ws + WS_XVT) + (size_t)layer * 512 * 2048, 0, 512, 512, (size_t)2048, pm * 256, nullptr};
                gemm_tile((const bf16_t*)(ws + WS_MEMN) + (size_t)pm * 256 * 1024, (const bf16_t*)(ws + WS_W_CKV) + (size_t)layer * 1024 * 1024, 1024, pn * 256, RowIdent{}, e, wv);
            }
        }
    }
    if constexpr (PH == PH_XATT) {
        const bf16_t* xk = (const bf16_t*)(ws + WS_XK) + (size_t)layer * 2048 * 512;
        const bf16_t* xvt = (const bf16_t*)(ws + WS_XVT) + (size_t)layer * 512 * 2048;
        for (int u = bid; u < 256; u += nb) {
            const int b = u >> 5, h = (u >> 3) & 3, qb = u & 7, pm = b * 8 + qb;
            bf16_t* const qlds = (bf16_t*)((char*)shm + 65536);
            EpiTokRstdH e{qlds - (size_t)(pm * 256) * 136 - h * 128, 136, pm * 256, (const float*)(ws + WS_SSP), hidden_tid(wv) & 63};
            gemm_tile<RowIdent, EpiTokRstdH, true>((const bf16_t*)(ws + WS_XB) + (size_t)pm * 256 * 1024, (const bf16_t*)(ws + WS_W_CQ) + (size_t)layer * 512 * 1024, 1024, h * 128, RowIdent{}, e, wv);
            __syncthreads();
            attn2_unit<2>(qlds - (size_t)(qb * 256) * 136, 136, xk + (size_t)(b * MEM) * 512 + h * 128, 512,
                          xvt + (size_t)(h * 128) * 2048 + b * MEM, (size_t)2048, qb * 256, 0, MEM,
                          0.08838834764831845f, nullptr, 0, OX + (size_t)(b * S) * 512 + h * 128, 512, wv);
        }
    }
    if constexpr (PH == PH_GO) {
        EpiRes e{(bf16_t*)(ws + (ALT ? WS_Y : WS_XB)), 0, nullptr, hidden_tid(wv) & 63};
        gemm_dense(OX, (const bf16_t*)(ws + WS_W_CO) + (size_t)layer * 1024 * 512, 512, 64, 4, e, bid, nb, wv);
    }
    if constexpr (PH == PH_ROUTE) { route_phase<ALT>(p, layer, bid, nb, wv); }
    if constexpr (PH == PH_GOR) { gor_phase<ALT>(p, layer, bid, nb, wv); }
    if constexpr (PH == PH_G1) {
        const int* CNT = (const int*)(ws + WS_CNT) + layer * NEXP * CNT_STRIDE;
        const int* LIST = (const int*)(ws + WS_LIST);
        unsigned* head = (unsigned*)(ws + WS_QHEAD) + layer * 64;
        unsigned* done = (unsigned*)(ws + WS_DONE) + layer * 32 * 64;
        int* uq = (int*)((char*)shm + LDS_ROUTE + 1024);
        int* pre = uq + 16;
        int* cn = pre + 40;
        const int tid = hidden_tid(wv);
        __syncthreads();
        if (tid < 64) {
            const int lane = tid;
            const int c = lane < 32 ? CNT[lane * CNT_STRIDE] : 0;
            int incl = ((c + 255) >> 8) * 4;
#pragma unroll
            for (int d = 1; d < 32; d <<= 1) { const int v = __builtin_amdgcn_ds_bpermute(((lane - d) & 63) << 2, incl); if (lane >= d) incl += v; }
            if (lane < 32) { pre[lane + 1] = incl; cn[lane] = c; }
            if (lane == 0) pre[0] = 0;
        }
        typedef __attribute__((address_space(1))) unsigned gu32_t;
        unsigned nxt_v = 0u;
        if (tid == 0) nxt_v = __hip_atomic_fetch_add((gu32_t*)head, 1u, __ATOMIC_RELAXED, __HIP_MEMORY_SCOPE_AGENT);
        __syncthreads();
        const int total = __builtin_amdgcn_readfirstlane(pre[32]);
        for (;;) {
            if (tid == 0) *uq = (int)nxt_v;
            __syncthreads();
            const int nkv = (layer + 1 < DEPTH) ? 32 : 0;
            const int uraw = __builtin_amdgcn_readfirstlane(*uq);
            if (uraw >= 2 * total + nkv) break;
            const int uall = uraw - nkv;
            if (tid == 0) nxt_v = __hip_atomic_fetch_add((gu32_t*)head, 1u, __ATOMIC_RELAXED, __HIP_MEMORY_SCOPE_AGENT);
            if (uall < 0) { kv_unit(ws, layer + 1, uraw, wv); continue; }
            const bool second = uall >= total;
            const int u = second ? uall - total : uall;
            int e, base, tl, cnt;
            {
                const int l5 = hidden_tid(wv) & 31;
                const int lo = pre[l5], hi = pre[l5 + 1];
                const unsigned long long bal = __builtin_amdgcn_ballot_w64(u >= lo && u < hi);
                e = __builtin_amdgcn_readfirstlane((int)__builtin_ctzll(bal));
                base = __builtin_amdgcn_readfirstlane(pre[e]); cnt = __builtin_amdgcn_readfirstlane(cn[e]); tl = (cnt + 255) >> 8;
            }
            const int r = u - base, pn = r / tl, pm = r % tl;
            const int* list = LIST + (size_t)e * NTOK;
            if (!second) {
                EpiGateUpL ep{(bf16_t*)(ws + WS_ACT), list, cnt, pm * 256, (const float*)(ws + WS_RP) + (size_t)e * NTOK, hidden_tid(wv) & 63};
                gemm_tile<RowTok, EpiGateUpL, false, false, true>((const bf16_t*)(ws + WS_XB), (const bf16_t*)(ws + WS_W_GU) + ((size_t)layer * NEXP + e) * 1024 * 1024, 1024, pn * 256, RowTok{list, cnt, pm * 256}, ep, wv, 0, cnt - pm * 256);
                asm volatile("s_waitcnt vmcnt(0)" ::: "memory");
                if ((hidden_tid(wv) & 63) == 0) (void)__hip_atomic_fetch_add(done + e * 64 + pm, 1u, __ATOMIC_RELAXED, __HIP_MEMORY_SCOPE_AGENT);
            } else {
                if (tid < 64) {
                    unsigned spins = 0;
                    while ((unsigned)__builtin_amdgcn_readfirstlane(__hip_atomic_load(done + e * 64 + pm, __ATOMIC_RELAXED, __HIP_MEMORY_SCOPE_AGENT)) < 32u) {
                        __builtin_amdgcn_s_sleep(2);
                        if (++spins > (1u << 24)) break;
                    }
                    __builtin_amdgcn_fence(__ATOMIC_ACQUIRE, "agent");
                    asm volatile("s_waitcnt vmcnt(0)" ::: "memory");
                }
                __syncthreads();
                EpiDownL ep{(bf16_t*)(ws + WS_Y), list, cnt, pm * 256, hidden_tid(wv) & 63};
                gemm_tile<RowAsg, EpiDownL, false, false, true>((const bf16_t*)(ws + WS_ACT), (const bf16_t*)(ws + WS_W_DN) + ((size_t)layer * NEXP + e) * 1024 * 512, 512, pn * 256, RowAsg{list, cnt, pm * 256}, ep, wv, 0, cnt - pm * 256);
            }
        }
    }
    if constexpr (PH == PH_FINAL) { norm_phase<2>(p, DEPTH, p.in[33], bid, nb, wv); }
}

#if ONE_LAUNCH
__global__ void __launch_bounds__(NT, 2) k_mega(Params p_) {
    ParamsK p = (ParamsK)__builtin_amdgcn_kernarg_segment_ptr();
    volatile LAS unsigned* st = (volatile LAS unsigned*)((char*)shm + LDS_XB);
    if (threadIdx.x < 4) st[threadIdx.x] = 0u;
    __syncthreads();
    const XcdBarrier bar = xcd_barrier_post((unsigned*)(p->ws + WS_BAR), st);
    const int bid = blockIdx.x, nb = gridDim.x, wv = __builtin_amdgcn_readfirstlane(threadIdx.x >> 6);
    run_phase<PH_P0>(p, 0, bid, nb, wv); xcd_barrier(bar); if (DUP == PH_P0) { run_phase<PH_P0, true>(p, 0, bid, nb, wv); xcd_barrier(bar); }
#pragma unroll 1
    for (int layer = 0; layer < DEPTH; ++layer) {
        run_phase<PH_N1>(p, layer, bid, nb, wv); xcd_barrier(bar); if (DUP == PH_N1) { run_phase<PH_N1, true>(p, layer, bid, nb, wv); xcd_barrier(bar); }
        run_phase<PH_GIN>(p, layer, bid, nb, wv); xcd_barrier(bar); if (DUP == PH_GIN) { run_phase<PH_GIN, true>(p, layer, bid, nb, wv); xcd_barrier(bar); }
        run_phase<PH_MIX>(p, layer, bid, nb, wv); xcd_barrier(bar); if (DUP == PH_MIX && (DUPSEL == 0 || (DUPSEL != 2 && (layer & 1) == 0) || (DUPSEL == 2 && (layer & 1) == 1))) { run_phase<PH_MIX, true>(p, layer, bid, nb, wv); xcd_barrier(bar); }
        if ((layer & 1) == 0) { run_phase<PH_TR>(p, layer, bid, nb, wv); xcd_barrier(bar); }
        run_phase<PH_GOUT>(p, layer, bid, nb, wv); xcd_barrier(bar); if (DUP == PH_GOUT) { run_phase<PH_GOUT, true>(p, layer, bid, nb, wv); xcd_barrier(bar); }
        run_phase<PH_XATT>(p, layer, bid, nb, wv); xcd_barrier(bar); if (DUP == PH_XATT) { run_phase<PH_XATT, true>(p, layer, bid, nb, wv); xcd_barrier(bar); }
        run_phase<PH_GOR>(p, layer, bid, nb, wv); xcd_barrier(bar);
        run_phase<PH_G1>(p, layer, bid, nb, wv); xcd_barrier(bar); if (DUP == PH_G1) { run_phase<PH_G1, true>(p, layer, bid, nb, wv); xcd_barrier(bar); }
    }
    run_phase<PH_FINAL>(p, DEPTH, bid, nb, wv);
}
#else
template <int PH>
__global__ void __launch_bounds__(NT, 2) k_phase(Params p_, int layer) {
    run_phase<PH>((ParamsK)__builtin_amdgcn_kernarg_segment_ptr(), layer, blockIdx.x, gridDim.x, __builtin_amdgcn_readfirstlane(threadIdx.x >> 6));
}
template <int PH> static void launch_phase(const Params& p, int layer, int grid, hipStream_t stream) {
    static bool init = false;
    if (!init) { (void)hipFuncSetAttribute((const void*)k_phase<PH>, hipFuncAttributeMaxDynamicSharedMemorySize, LDS_BYTES); init = true; }
    hipLaunchKernelGGL(k_phase<PH>, dim3(grid), dim3(NT), LDS_BYTES, stream, p, layer);
}
#endif

extern "C" void kernel_launch(void* const* d_in, const int* in_sizes, int n_in, void* d_out, int out_size, void* d_ws, size_t ws_size, hipStream_t stream) {
    if (n_in != 34 || ws_size < WS_END) { fprintf(stderr, "kernel_launch: unexpected n_in %d or ws_size %zu (need %zu)\n", n_in, ws_size, (size_t)WS_END); return; }
    Params p{};
    for (int i = 0; i < 34; ++i) p.in[i] = (const float*)d_in[i];
    p.out = (float*)d_out; p.ws = (unsigned char*)d_ws;
    (void)hipMemsetAsync(d_ws, 0, WS_ZERO_BYTES, stream);
#if ONE_LAUNCH
    static int grid = 0;
    if (grid == 0) {
        int dev = 0, cus = 0, per_cu = 0;
        (void)hipGetDevice(&dev); (void)hipDeviceGetAttribute(&cus, hipDeviceAttributeMultiprocessorCount, dev);
        (void)hipFuncSetAttribute((const void*)k_mega, hipFuncAttributeMaxDynamicSharedMemorySize, LDS_BYTES);
        (void)hipOccupancyMaxActiveBlocksPerMultiprocessor(&per_cu, (const void*)k_mega, NT, LDS_BYTES);
        (void)hipGetLastError();
        grid = cus > 0 ? cus : 256;
    }
    hipLaunchKernelGGL(k_mega, dim3(grid), dim3(NT), LDS_BYTES, stream, p);
#else
    const int grid = 256;
    launch_phase<PH_P0>(p, 0, grid, stream);
    for (int layer = 0; layer < DEPTH; ++layer) {
        launch_phase<PH_N1>(p, layer, grid, stream);
        launch_phase<PH_GIN>(p, layer, grid, stream);
        launch_phase<PH_MIX>(p, layer, grid, stream);
        if ((layer & 1) == 0) launch_phase<PH_TR>(p, layer, grid, stream);
        launch_phase<PH_GOUT>(p, layer, grid, stream);
        launch_phase<PH_XATT>(p, layer, grid, stream);
        launch_phase<PH_GOR>(p, layer, grid, stream);
        launch_phase<PH_G1>(p, layer, grid, stream);
    }
    launch_phase<PH_FINAL>(p, DEPTH, grid, stream);
#endif
}
```
